# Optimizing an MI355X kernel written in HIP

```python
import jax, jax.numpy as jnp
from jax import lax
import numpy as np

D_MODEL = 1024
BATCH = 4
SEQ = 8192
DEPTH = 1

CHUNK = 64
HEAD_DIM = 64
ATT_WIDTH = D_MODEL // 2
ATT_HEADS = ATT_WIDTH // HEAD_DIM
LEFT_CHUNKS = 8
BAND = LEFT_CHUNKS + 1
MAX_LEFT_REL = 128
REL_TABLE = MAX_LEFT_REL + CHUNK
RWKV_HEAD = 64
RWKV_WIDTH = D_MODEL - ATT_WIDTH
RWKV_HEADS = RWKV_WIDTH // RWKV_HEAD
DECAY_LORA = 64
AAA_LORA = 64
GATE_LORA = 128
RWKV_COLS = 3 * RWKV_WIDTH + DECAY_LORA + AAA_LORA + GATE_LORA
IN_COLS = 3 * ATT_WIDTH + RWKV_COLS
MIX_WIDTH = ATT_WIDTH + RWKV_WIDTH
LN_X_EPS = 64e-5
N_EXPERTS = 32
TOP_K = 4
D_EXPERT = D_MODEL
SWIGLU_ALPHA = 1.702
SWIGLU_LIMIT = 7.0
MOE_BLOCK = 256
NORM_EPS = 1e-6

kernel_name = "hymba_chunkattn_rwkv7_moe_block"


def rms_norm(x, g):
    xf = x.astype(jnp.float32)
    y = xf * lax.rsqrt(jnp.mean(xf * xf, axis=-1, keepdims=True) + NORM_EPS)
    return (y * g.astype(jnp.float32)).astype(x.dtype)


def chunk_band_attention(q, k, v, rel_bias):
    B, S = q.shape[:2]
    NC = S // CHUNK

    def to_chunks(t):
        return t.reshape(B, NC, CHUNK, ATT_HEADS, HEAD_DIM).transpose(0, 3, 1, 2, 4)

    qc = to_chunks(q) * (HEAD_DIM ** -0.5)
    pad = ((0, 0), (0, 0), (LEFT_CHUNKS, 0), (0, 0), (0, 0))
    kp = jnp.pad(to_chunks(k), pad)
    vp = jnp.pad(to_chunks(v), pad)
    scores = jnp.stack(
        [jnp.einsum('bhncd,bhnkd->bhnck', qc, kp[:, :, j:j + NC]) for j in range(BAND)],
        axis=-2).astype(jnp.float32)
    qi = jnp.arange(CHUNK)[:, None, None]
    bj = jnp.arange(BAND)[None, :, None]
    kc = jnp.arange(CHUNK)[None, None, :]
    rel = (bj - LEFT_CHUNKS) * CHUNK + kc - qi
    idx = jnp.clip(rel, -MAX_LEFT_REL, CHUNK - 1) + MAX_LEFT_REL
    bias = rel_bias[:, idx].astype(jnp.float32)
    valid = (jnp.arange(NC)[:, None] + jnp.arange(BAND)[None, :]) >= LEFT_CHUNKS
    scores = jnp.where(valid[None, None, :, None, :, None],
                       scores + bias[None, :, None],
                       jnp.finfo(jnp.float32).min)
    probs = jax.nn.softmax(scores.reshape(B, ATT_HEADS, NC, CHUNK, BAND * CHUNK), axis=-1)
    probs = probs.reshape(scores.shape).astype(v.dtype)
    out = jnp.einsum('bhnck,bhnkd->bhncd', probs[..., 0, :], vp[:, :, 0:NC])
    for j in range(1, BAND):
        out = out + jnp.einsum('bhnck,bhnkd->bhncd', probs[..., j, :], vp[:, :, j:j + NC])
    return out.transpose(0, 2, 3, 1, 4).reshape(B, S, ATT_WIDTH)


def rwkv7_scan(r, w, k, v, kk, a):
    B, S, H, N = r.shape

    def step(state, inp):
        r_t, w_t, k_t, v_t, kk_t, a_t = inp
        sa = jnp.einsum('bhvk,bhk->bhv', state, -kk_t)
        state = (state * w_t[:, :, None, :]
                 + sa[..., None] * (kk_t * a_t)[:, :, None, :]
                 + v_t[..., None] * k_t[:, :, None, :])
        y = jnp.einsum('bhvk,bhk->bhv', state, r_t)
        return state, y

    xs = tuple(jnp.moveaxis(t, 1, 0) for t in (r, w, k, v, kk, a))
    state0 = jnp.zeros((B, H, N, N), jnp.float32)
    _, ys = lax.scan(step, state0, xs)
    return jnp.moveaxis(ys, 0, 1)


def rwkv7_mixer(p, mu, w0, w_decay_up, a0, w_aaa_up, w_gate_up, k_k, k_a, r_k, ln_g, ln_b):
    B, S, _ = p.shape
    f32 = jnp.float32
    prev = jnp.pad(p, ((0, 0), (1, 0), (0, 0)))[:, :S]
    p = p + (prev - p) * mu
    C = RWKV_WIDTH
    r, k, v, wd, ad, gd = jnp.split(
        p, [C, 2 * C, 3 * C, 3 * C + DECAY_LORA, 3 * C + DECAY_LORA + AAA_LORA], axis=-1)
    w_logit = (w0 + jnp.tanh(wd) @ w_decay_up).astype(f32)
    decay = jnp.exp(-jnp.exp(-jax.nn.softplus(-w_logit) - 0.5))
    a = jax.nn.sigmoid((a0 + ad @ w_aaa_up).astype(f32))
    g = jax.nn.sigmoid(gd) @ w_gate_up

    def heads(t):
        return t.reshape(B, S, RWKV_HEADS, RWKV_HEAD).astype(f32)

    r, k, v, decay, a = heads(r), heads(k), heads(v), heads(decay), heads(a)
    kk = k * k_k.astype(f32)
    kk = kk / jnp.maximum(jnp.linalg.norm(kk, axis=-1, keepdims=True), 1e-12)
    k = k * (1.0 + (a - 1.0) * k_a.astype(f32))
    y = rwkv7_scan(r, decay, k, v, kk, a)
    mean = jnp.mean(y, axis=-1, keepdims=True)
    var = jnp.mean(jnp.square(y - mean), axis=-1, keepdims=True)
    y = ((y - mean) * lax.rsqrt(var + LN_X_EPS)).reshape(B, S, C)
    y = y * ln_g.astype(f32) + ln_b.astype(f32)
    bonus = jnp.sum(r * k * r_k.astype(f32), axis=-1, keepdims=True) * v
    y = (y + bonus.reshape(B, S, C)) * g.astype(f32)
    return y.astype(p.dtype)


def moe_ffn(xn, w_router, b_router, w_up, b_up, w_down, b_down):
    B, S, D = xn.shape
    T = B * S
    xf = xn.reshape(T, D)
    logits = (xf @ w_router).astype(jnp.float32) + b_router.astype(jnp.float32)
    top_vals, top_idx = lax.top_k(logits, TOP_K)
    gates = jax.nn.softmax(top_vals, axis=-1).astype(xn.dtype)
    A = T * TOP_K
    e_flat = top_idx.reshape(A).astype(jnp.int32)
    t_flat = jnp.repeat(jnp.arange(T, dtype=jnp.int32), TOP_K)
    g_flat = gates.reshape(A)
    counts = jnp.bincount(e_flat, length=N_EXPERTS).astype(jnp.int32)
    padded = (counts + MOE_BLOCK - 1) // MOE_BLOCK * MOE_BLOCK
    pad_end = jnp.cumsum(padded)
    pad_start = pad_end - padded
    start = jnp.cumsum(counts) - counts
    order = jnp.argsort(e_flat)
    e_sorted = e_flat[order]
    dest = pad_start[e_sorted] + jnp.arange(A, dtype=jnp.int32) - start[e_sorted]
    n_blocks = -(-A // MOE_BLOCK) + N_EXPERTS
    n_rows = n_blocks * MOE_BLOCK
    row_tok = jnp.full((n_rows,), T, jnp.int32).at[dest].set(t_flat[order])
    row_gate = jnp.zeros((n_rows,), xn.dtype).at[dest].set(g_flat[order])
    blk_start = jnp.arange(n_blocks, dtype=jnp.int32) * MOE_BLOCK
    blk_expert = jnp.minimum(jnp.searchsorted(pad_end, blk_start, side='right'), N_EXPERTS - 1)
    x_pad = jnp.concatenate([xf, jnp.zeros((1, D), xf.dtype)], axis=0)

    def expert_block(args):
        tok, gate, e = args
        h = x_pad[tok] @ w_up[e] + b_up[e]
        h_glu = jnp.minimum(h[:, :D_EXPERT], SWIGLU_LIMIT)
        h_lin = jnp.clip(h[:, D_EXPERT:], -SWIGLU_LIMIT, SWIGLU_LIMIT)
        act = h_glu * jax.nn.sigmoid(SWIGLU_ALPHA * h_glu) * (h_lin + 1.0)
        return (act @ w_down[e] + b_down[e]) * gate[:, None]

    y_rows = lax.map(expert_block, (row_tok.reshape(n_blocks, MOE_BLOCK),
                                    row_gate.reshape(n_blocks, MOE_BLOCK),
                                    blk_expert))
    y = jax.ops.segment_sum(y_rows.reshape(n_rows, D), row_tok, num_segments=T + 1)[:T]
    return y.reshape(B, S, D).astype(xn.dtype)


def setup_inputs(seed: int = 0) -> dict:
    key = jax.random.key(seed)
    ks = jax.random.split(key, 32)
    L = DEPTH

    def nrm(k, shape, scale):
        return jax.random.normal(k, shape, jnp.float32) * scale

    return {
        "x": nrm(ks[0], (BATCH, SEQ, D_MODEL), 1.0),
        "norm1_g": 1.0 + nrm(ks[1], (L, D_MODEL), 0.01),
        "w_in": nrm(ks[2], (L, D_MODEL, IN_COLS), D_MODEL ** -0.5),
        "tshift_mu": jax.random.uniform(ks[3], (L, RWKV_COLS), jnp.float32),
        "q_norm_g": 1.0 + nrm(ks[4], (L, HEAD_DIM), 0.01),
        "k_norm_g": 1.0 + nrm(ks[5], (L, HEAD_DIM), 0.01),
        "rel_bias": nrm(ks[6], (L, ATT_HEADS, REL_TABLE), 0.5),
        "w0": nrm(ks[7], (L, RWKV_WIDTH), 0.5),
        "w_decay_up": nrm(ks[8], (L, DECAY_LORA, RWKV_WIDTH), 0.5 * DECAY_LORA ** -0.5),
        "a0": nrm(ks[9], (L, RWKV_WIDTH), 0.5),
        "w_aaa_up": nrm(ks[10], (L, AAA_LORA, RWKV_WIDTH), 0.5 * AAA_LORA ** -0.5),
        "w_gate_up": nrm(ks[11], (L, GATE_LORA, RWKV_WIDTH), GATE_LORA ** -0.5),
        "k_k": 1.0 + nrm(ks[12], (L, RWKV_HEADS, RWKV_HEAD), 0.1),
        "k_a": 1.0 + nrm(ks[13], (L, RWKV_HEADS, RWKV_HEAD), 0.1),
        "r_k": nrm(ks[14], (L, RWKV_HEADS, RWKV_HEAD), 0.1),
        "ln_x_g": 1.0 + nrm(ks[15], (L, RWKV_WIDTH), 0.01),
        "ln_x_b": nrm(ks[16], (L, RWKV_WIDTH), 0.01),
        "w_out": nrm(ks[17], (L, MIX_WIDTH, D_MODEL), MIX_WIDTH ** -0.5),
        "norm2_g": 1.0 + nrm(ks[18], (L, D_MODEL), 0.01),
        "w_router": nrm(ks[19], (L, D_MODEL, N_EXPERTS), D_MODEL ** -0.5),
        "b_router": nrm(ks[20], (L, N_EXPERTS), 0.01),
        "w_up": nrm(ks[21], (L, N_EXPERTS, D_MODEL, 2 * D_EXPERT), D_MODEL ** -0.5),
        "b_up": nrm(ks[22], (L, N_EXPERTS, 2 * D_EXPERT), 0.01),
        "w_down": nrm(ks[23], (L, N_EXPERTS, D_EXPERT, D_MODEL), D_EXPERT ** -0.5),
        "b_down": nrm(ks[24], (L, N_EXPERTS, D_MODEL), 0.01),
    }


def reference(x, norm1_g, w_in, tshift_mu, q_norm_g, k_norm_g, rel_bias, w0, w_decay_up,
              a0, w_aaa_up, w_gate_up, k_k, k_a, r_k, ln_x_g, ln_x_b, w_out, norm2_g,
              w_router, b_router, w_up, b_up, w_down, b_down):
    B, S, _ = x.shape
    for l in range(DEPTH):
        h = rms_norm(x, norm1_g[l])
        proj = h @ w_in[l]
        aq, ak, av, p_rwkv = jnp.split(proj, [ATT_WIDTH, 2 * ATT_WIDTH, 3 * ATT_WIDTH], axis=-1)
        q = rms_norm(aq.reshape(B, S, ATT_HEADS, HEAD_DIM), q_norm_g[l])
        k = rms_norm(ak.reshape(B, S, ATT_HEADS, HEAD_DIM), k_norm_g[l])
        v = av.reshape(B, S, ATT_HEADS, HEAD_DIM)
        att = chunk_band_attention(q, k, v, rel_bias[l])
        rwk = rwkv7_mixer(p_rwkv, tshift_mu[l], w0[l], w_decay_up[l], a0[l], w_aaa_up[l],
                          w_gate_up[l], k_k[l], k_a[l], r_k[l], ln_x_g[l], ln_x_b[l])
        x = x + (jnp.concatenate([att, rwk], axis=-1) @ w_out[l]).astype(x.dtype)
        x = x + moe_ffn(rms_norm(x, norm2_g[l]), w_router[l], b_router[l], w_up[l], b_up[l],
                        w_down[l], b_down[l])
    return x
```

```cpp
#define NAIVE_RWKV 0
#define NAIVE_ATT 0
#define MK_N_LAUNCHES 1
#include <hip/hip_runtime.h>
#include <cstdio>
#include <cstdint>

#ifndef MK_N_LAUNCHES
#define MK_N_LAUNCHES 1
#endif
#ifndef NAIVE_RWKV
#define NAIVE_RWKV 0
#endif
#ifndef NAIVE_ATT
#define NAIVE_ATT 0
#endif

namespace pg8 {
#define PG8_LAS __attribute__((address_space(3)))
typedef unsigned short bf16_t;
typedef short bf16x8 __attribute__((ext_vector_type(8)));
typedef float f32x4 __attribute__((ext_vector_type(4)));
typedef unsigned u32x4 __attribute__((ext_vector_type(4)));
typedef unsigned u32x2 __attribute__((ext_vector_type(2)));
typedef float f32x2e __attribute__((ext_vector_type(2)));
constexpr int BM = 256, BK = 64, HALF = 128, HTB = HALF * BK * 2  , STAGE_BYTES = 8 * HTB, NXCD = 8, WGM = 8;

__host__ __device__ __forceinline__ int lds_byte(int r, int c) { const int st = (r >> 4) * 2 + (c >> 5), rr = r & 15, cc = c & 31, ob = rr * 64 + cc * 2; return st * 1024 + (ob ^ (((ob >> 9) & 1) << 5)); }
__host__ __device__ __forceinline__ void stage_rc(int b, int& R, int& C) { const int st = b / 1024, sb = b % 1024, swz = sb ^ (((sb >> 9) & 1) << 5); R = (st >> 1) * 16 + swz / 64; C = (st & 1) * 32 + (swz % 64) / 2; }
__host__ __device__ __forceinline__ int perm32(int rho) { const int n = rho >> 4, i = rho & 15; return 8 * (i >> 2) + 4 * n + (i & 3); }

struct Unit { int pm, pn, e; };
struct Gemm { const bf16_t* A; const bf16_t* Bt; int M, N, K; };

__device__ __forceinline__ bool tile_of(int i, int G, int c, int nM, int nN, int& pm, int& pn) {
    const int nwg = nM * nN; const long L = (long)i * G + c; if (L >= nwg) return false;
    int wgid = (int)L; { const int q = nwg / NXCD, r = nwg % NXCD, xcd = wgid % NXCD, off = wgid / NXCD; wgid = (xcd < r ? xcd * (q + 1) : r * (q + 1) + (xcd - r) * q) + off; }
    const int nig = WGM * nN, gid = wgid / nig, fm = gid * WGM, gsz = (nM - fm) < WGM ? (nM - fm) : WGM;
    pm = fm + ((wgid % nig) % gsz); pn = (wgid % nig) / gsz; return true;
}
struct StaticOrder {
    int nM, nN, G, c;
    __device__ void init(int M, int N, int G_, int c_) { nM = M / BM; nN = N / BM; G = G_; c = c_; }
    __device__ __forceinline__ bool next(int i, Unit& u) const { u.e = 0; return tile_of(i, G, c, nM, nN, u.pm, u.pn); }
    __device__ __forceinline__ const char* a_base(const Gemm& g, const Unit& u) const { return (const char*)g.A + (size_t)u.pm * BM * g.K * 2; }
    __device__ __forceinline__ const char* b_base(const Gemm& g, const Unit& u) const { return (const char*)g.Bt + (size_t)u.pn * BM * g.K * 2; }
    __device__ __forceinline__ void a_off(const Gemm& g, const Unit&, const int (&R)[2], const int (&C)[2], unsigned (&vo)[2][2]) const {
#pragma unroll
        for (int h = 0; h < 2; ++h)
#pragma unroll
            for (int i = 0; i < 2; ++i) vo[h][i] = (unsigned)((h * HALF + R[i]) * g.K + C[i]) * 2u; }
    __device__ __forceinline__ void a_ready(const Unit&) const {}
    __device__ __forceinline__ void done(const Unit&) const {}
};
struct MoeOrder {
    const int* meta; int nN, G, c;
    __device__ __forceinline__ bool next(int i, Unit& u) const {
        const int nM = __builtin_amdgcn_readfirstlane(meta[0]);
        if (!tile_of(i, G, c, nM, nN, u.pm, u.pn)) return false;
        u.e = __builtin_amdgcn_readfirstlane(meta[16 + u.pm]); return true;
    }
    const int* rowtok;
    __device__ __forceinline__ const char* a_base(const Gemm& g, const Unit& u) const { return rowtok ? (const char*)g.A : (const char*)g.A + (size_t)u.pm * BM * g.K * 2; }
    __device__ __forceinline__ const char* b_base(const Gemm& g, const Unit& u) const { return (const char*)g.Bt + ((size_t)u.e * g.N + (size_t)u.pn * BM) * g.K * 2; }
    __device__ __forceinline__ void a_off(const Gemm& g, const Unit& u, const int (&R)[2], const int (&C)[2], unsigned (&vo)[2][2]) const {
#pragma unroll
        for (int h = 0; h < 2; ++h)
#pragma unroll
            for (int i = 0; i < 2; ++i) { const int r = h * HALF + R[i]; vo[h][i] = (unsigned)((rowtok ? rowtok[u.pm * BM + r] : r) * g.K + C[i]) * 2u; } }
    __device__ __forceinline__ void a_ready(const Unit&) const {}
    __device__ __forceinline__ void done(const Unit&) const {}
};

__device__ __forceinline__ unsigned cvt_pk_bf16(float lo, float hi) { unsigned r; asm volatile("v_cvt_pk_bf16_f32 %0, %1, %2" : "=v"(r) : "v"(lo), "v"(hi)); return r; }

struct EpiBf16 {
    static constexpr bool PERM = true, AFTER_DRAIN = false;
    bf16_t* O; int ldc;
    __device__ __forceinline__ void operator()(const f32x4 (&acc)[2][2][4][2], const Unit& u, int wr, int wc, int fr, int fq) const {
        const int row0 = u.pm * BM + wr * 64 + fr, col0 = u.pn * BM + wc * 32 + 8 * fq;
#pragma unroll
        for (int ai = 0; ai < 2; ++ai)
#pragma unroll
            for (int m = 0; m < 4; ++m) { bf16_t* rowp = O + (size_t)(row0 + ai * HALF + m * 16) * ldc + col0;
#pragma unroll
                for (int bj = 0; bj < 2; ++bj) { const f32x4 v0 = acc[ai][bj][m][0], v1 = acc[ai][bj][m][1];
                    u32x4 w; w.x = cvt_pk_bf16(v0[0], v0[1]); w.y = cvt_pk_bf16(v0[2], v0[3]); w.z = cvt_pk_bf16(v1[0], v1[1]); w.w = cvt_pk_bf16(v1[2], v1[3]);
                    *(u32x4*)(rowp + bj * HALF) = w; } }
    }
};
struct EpiResid {
    static constexpr bool PERM = false, AFTER_DRAIN = false;
    const float* base; float* out; bf16_t* xb; int ldc;
    __device__ __forceinline__ void operator()(const f32x4 (&acc)[2][2][4][2], const Unit& u, int wr, int wc, int fr, int fq) const {
        const int row0 = u.pm * BM + wr * 64 + fr, col0 = u.pn * BM + wc * 32 + 4 * fq;
        f32x4 nb[4][2][2];
#define PG8_RES_LOAD(g_) do { const size_t off_ = (size_t)(row0 + ((g_) >> 2) * HALF + ((g_) & 3) * 16) * ldc + col0; _Pragma("unroll") for (int bj = 0; bj < 2; ++bj) _Pragma("unroll") for (int n = 0; n < 2; ++n) \
            nb[(g_) & 3][bj][n] = __builtin_nontemporal_load((const f32x4*)(base + off_ + bj * HALF + n * 16)); } while (0)
        PG8_RES_LOAD(0); PG8_RES_LOAD(1); PG8_RES_LOAD(2);
#pragma unroll
        for (int g = 0; g < 8; ++g) { const int ai = g >> 2, m = g & 3; const size_t off = (size_t)(row0 + ai * HALF + m * 16) * ldc + col0;
            if (g + 3 < 8) PG8_RES_LOAD(g + 3);
#pragma unroll
            for (int bj = 0; bj < 2; ++bj)
#pragma unroll
                for (int n = 0; n < 2; ++n) { const f32x4 o = nb[g & 3][bj][n] + acc[ai][bj][m][n];
                    if (out) *(f32x4*)(out + off + bj * HALF + n * 16) = o;
                    u32x2 w; w.x = cvt_pk_bf16(o[0], o[1]); w.y = cvt_pk_bf16(o[2], o[3]); *(u32x2*)(xb + off + bj * HALF + n * 16) = w; }
            asm volatile("" ::: "memory"); }
#undef PG8_RES_LOAD
    }
};
struct EpiSwiGLU {
    static constexpr bool PERM = true, AFTER_DRAIN = false;
    bf16_t* O; const float* b_up; const float* rowrstd;
    __device__ __forceinline__ void operator()(const f32x4 (&acc)[2][2][4][2], const Unit& u, int wr, int wc, int fr, int fq) const {
        const int row0 = u.pm * BM + wr * 64 + fr, f0 = u.pn * HALF + wc * 32 + 8 * fq;
        const float* bg = b_up + (size_t)u.e * 2048 + f0; const float* bl = bg + 1024;
        const f32x4 bg0 = *(const f32x4*)bg, bg1 = *(const f32x4*)(bg + 4), bl0 = *(const f32x4*)bl, bl1 = *(const f32x4*)(bl + 4);
        float rsv[2][4];
#pragma unroll
        for (int ai = 0; ai < 2; ++ai)
#pragma unroll
            for (int m = 0; m < 4; ++m) rsv[ai][m] = rowrstd[row0 + ai * HALF + m * 16];
#pragma unroll
        for (int ai = 0; ai < 2; ++ai)
#pragma unroll
            for (int m = 0; m < 4; ++m) { const int row = row0 + ai * HALF + m * 16; const float rs = rsv[ai][m];
                float a[8];
#pragma unroll
                for (int n = 0; n < 2; ++n)
#pragma unroll
                    for (int j = 0; j < 4; j += 2) {
                        const f32x2e ag2 = {acc[ai][0][m][n][j], acc[ai][0][m][n][j + 1]}, al2 = {acc[ai][1][m][n][j], acc[ai][1][m][n][j + 1]};
                        const f32x2e bg2 = n ? (f32x2e){bg1[j], bg1[j + 1]} : (f32x2e){bg0[j], bg0[j + 1]}, bl2 = n ? (f32x2e){bl1[j], bl1[j + 1]} : (f32x2e){bl0[j], bl0[j + 1]};
                        f32x2e hg = ag2 * rs + bg2, hl = al2 * rs + bl2;
                        hg.x = fminf(hg.x, 7.0f); hg.y = fminf(hg.y, 7.0f); hl.x = fminf(fmaxf(hl.x, -7.0f), 7.0f); hl.y = fminf(fmaxf(hl.y, -7.0f), 7.0f);
                        const f32x2e t = hg * (-1.702f * 1.4426950408889634f);
                        f32x2e e; e.x = __builtin_amdgcn_exp2f(t.x); e.y = __builtin_amdgcn_exp2f(t.y);
                        const f32x2e d = e + 1.0f; f32x2e sg; sg.x = __builtin_amdgcn_rcpf(d.x); sg.y = __builtin_amdgcn_rcpf(d.y);
                        const f32x2e o = (hg * sg) * (hl + 1.0f);
                        a[n * 4 + j] = o.x; a[n * 4 + j + 1] = o.y; }
                u32x4 w; w.x = cvt_pk_bf16(a[0], a[1]); w.y = cvt_pk_bf16(a[2], a[3]); w.z = cvt_pk_bf16(a[4], a[5]); w.w = cvt_pk_bf16(a[6], a[7]);
                *(u32x4*)(O + (size_t)row * 1024 + f0) = w; }
    }
};
struct EpiDown {
    static constexpr bool PERM = true, AFTER_DRAIN = false;
    bf16_t* O; const float* b_dn;
    __device__ __forceinline__ void operator()(const f32x4 (&acc)[2][2][4][2], const Unit& u, int wr, int wc, int fr, int fq) const {
        const int row0 = u.pm * BM + wr * 64 + fr, col0 = u.pn * BM + wc * 32 + 8 * fq;
        const float* bp = b_dn + (size_t)u.e * 1024 + col0;
        f32x4 bv[2][2];
#pragma unroll
        for (int bj = 0; bj < 2; ++bj)
#pragma unroll
            for (int n = 0; n < 2; ++n) bv[bj][n] = *(const f32x4*)(bp + bj * HALF + 4 * n);
#pragma unroll
        for (int ai = 0; ai < 2; ++ai)
#pragma unroll
            for (int m = 0; m < 4; ++m) { bf16_t* rowp = O + (size_t)(row0 + ai * HALF + m * 16) * 1024 + col0;
#pragma unroll
                for (int bj = 0; bj < 2; ++bj) { const f32x4 v0 = acc[ai][bj][m][0] + bv[bj][0], v1 = acc[ai][bj][m][1] + bv[bj][1];
                    u32x4 w; w.x = cvt_pk_bf16(v0[0], v0[1]); w.y = cvt_pk_bf16(v0[2], v0[3]); w.z = cvt_pk_bf16(v1[0], v1[1]); w.w = cvt_pk_bf16(v1[2], v1[3]);
                    *(u32x4*)(rowp + bj * HALF) = w; } }
    }
};

template <class Epi, class Sched, bool ALIGN_EPI = false, bool SP2 = false>
__device__ __forceinline__ void gemm_phase(PG8_LAS unsigned char* lds, const Gemm g, const Sched& S, const Epi& E) {
    int tid = threadIdx.x; asm volatile("" : "+v"(tid));
    const int wid = __builtin_amdgcn_readfirstlane(tid >> 6), lane = tid & 63, wr = wid >> 2, wc = wid & 3, fr = lane & 15, fq = lane >> 4;
    const int K = g.K, nt = K / BK;
    unsigned voffB[2]; int sR[2], sC[2];
#pragma unroll
    for (int i = 0; i < 2; ++i) { int R, C; stage_rc(tid * 16 + i * 8192, R, C); const int Rb = Epi::PERM ? ((R & ~31) + perm32(R & 31)) : R;
        sR[i] = R; sC[i] = C; voffB[i] = (unsigned)(Rb * K + C) * 2u; }
    const size_t kstep = (size_t)(BK * 2);
    const size_t hstep = (size_t)HALF * K * 2;
    const unsigned ldsw = (unsigned)wid * 1024u;
    const int aoff = lds_byte(wr * 64 + fr, fq * 8), boff = lds_byte(wc * 32 + fr, fq * 8);
#define PG8_SA(b, h) (((b) * 2 + (h)) * HTB)
#define PG8_SB(b, h) ((4 + (b) * 2 + (h)) * HTB)
#define PG8_STAGE(bufoff, gbase, voff) do { _Pragma("unroll") for (int _i = 0; _i < 2; ++_i) \
        __builtin_amdgcn_global_load_lds((const unsigned*)((const char*)(gbase) + (voff)[_i]), (PG8_LAS unsigned*)(lds + (bufoff) + ldsw + _i * 8192), 16, 0, 0); } while (0)
#define PG8_STAGE_A(bufoff, gbase, vo, h) do { _Pragma("unroll") for (int _i = 0; _i < 2; ++_i) \
        __builtin_amdgcn_global_load_lds((const unsigned*)((const char*)(gbase) + (vo)[h][_i]), (PG8_LAS unsigned*)(lds + (bufoff) + ldsw + _i * 8192), 16, 0, 0); } while (0)
#define PG8_LDA(dst, b, h) do { _Pragma("unroll") for (int m = 0; m < 4; ++m) _Pragma("unroll") for (int k = 0; k < 2; ++k) dst[m][k] = *(const PG8_LAS bf16x8*)(lds + PG8_SA(b, h) + aoff + m * 2048 + k * 1024); } while (0)
#define PG8_LDB(dst, b, h) do { _Pragma("unroll") for (int n = 0; n < 2; ++n) _Pragma("unroll") for (int k = 0; k < 2; ++k) dst[n][k] = *(const PG8_LAS bf16x8*)(lds + PG8_SB(b, h) + boff + n * 2048 + k * 1024); } while (0)
#define PG8_MMA(ai, bj, At, Bt) do { __builtin_amdgcn_s_setprio(1); _Pragma("unroll") for (int m = 0; m < 4; ++m) _Pragma("unroll") for (int n = 0; n < 2; ++n) _Pragma("unroll") for (int k = 0; k < 2; ++k) \
        acc[ai][bj][m][n] = __builtin_amdgcn_mfma_f32_16x16x32_bf16(Bt[n][k], At[m][k], acc[ai][bj][m][n], 0, 0, 0); __builtin_amdgcn_s_setprio(0); } while (0)
#define PG8_WAIT_V(n) asm volatile("s_waitcnt vmcnt(" #n ")" ::: "memory")
#define PG8_WAIT_L(n) asm volatile("s_waitcnt lgkmcnt(" #n ")" ::: "memory")
#define PG8_BAR __builtin_amdgcn_s_barrier()
#define PG8_SCHED __builtin_amdgcn_sched_barrier(0)
    Unit cur, nxt; int ui = 0;
    if (!S.next(0, cur)) return;
    f32x4 acc[2][2][4][2];
#pragma unroll
    for (int a = 0; a < 2; ++a)
#pragma unroll
        for (int b = 0; b < 2; ++b)
#pragma unroll
            for (int m = 0; m < 4; ++m)
#pragma unroll
                for (int n = 0; n < 2; ++n) acc[a][b][m][n] = (f32x4){0.f, 0.f, 0.f, 0.f};
    bf16x8 At[4][2], B0[2][2], B1[2][2];
    const char* cA = S.a_base(g, cur); const char* cB = S.b_base(g, cur);
    unsigned voC[2][2], voN[2][2];
    S.a_off(g, cur, sR, sC, voC);
    S.a_ready(cur);
    static_assert(SP2, "only the two-MFMA-blocks-per-barrier-pair loop is kept");
    PG8_STAGE(PG8_SB(0, 0), cB, voffB); PG8_STAGE(PG8_SB(0, 1), cB + hstep, voffB); PG8_STAGE_A(PG8_SA(0, 0), cA, voC, 0); PG8_STAGE_A(PG8_SA(0, 1), cA, voC, 1);
    if (wr == 1) PG8_BAR;
    PG8_WAIT_V(2); PG8_BAR;
    PG8_STAGE(PG8_SB(1, 0), cB + kstep, voffB); PG8_STAGE_A(PG8_SA(1, 0), cA + kstep, voC, 0); PG8_STAGE(PG8_SB(1, 1), cB + hstep + kstep, voffB);
    PG8_WAIT_V(6); PG8_BAR;
    for (;;) {
        const bool has_next = S.next(ui + 1, nxt);
        const char* nA = has_next ? S.a_base(g, nxt) : cA; const char* nB = has_next ? S.b_base(g, nxt) : cB;
        if (has_next) S.a_off(g, nxt, sR, sC, voN); else {
#pragma unroll
            for (int h_ = 0; h_ < 2; ++h_) { voN[h_][0] = voC[h_][0]; voN[h_][1] = voC[h_][1]; } }
        for (int t = 0; t < nt; t += 2) {
            const bool last = (t == nt - 2);
            const char* a1 = cA + (size_t)(t + 1) * kstep;
            const char* a2 = last ? nA : cA + (size_t)(t + 2) * kstep; const char* b2 = last ? nB : cB + (size_t)(t + 2) * kstep;
            const char* a3 = a2 + kstep; const char* b3 = b2 + kstep;
            if (last && has_next) S.a_ready(nxt);
            unsigned vo2[2][2];
#pragma unroll
            for (int h_ = 0; h_ < 2; ++h_) { vo2[h_][0] = last ? voN[h_][0] : voC[h_][0]; vo2[h_][1] = last ? voN[h_][1] : voC[h_][1]; }
            PG8_LDB(B0, 0, 0); PG8_LDB(B1, 0, 1); PG8_SCHED; PG8_LDA(At, 0, 0); PG8_STAGE_A(PG8_SA(1, 1), a1, voC, 1);
            PG8_WAIT_V(8); PG8_WAIT_L(0); PG8_BAR; PG8_MMA(0, 0, At, B0); PG8_MMA(0, 1, At, B1); PG8_BAR; PG8_SCHED;
            PG8_LDA(At, 0, 1); PG8_STAGE(PG8_SB(0, 0), b2, voffB); PG8_STAGE(PG8_SB(0, 1), b2 + hstep, voffB); PG8_STAGE_A(PG8_SA(0, 0), a2, vo2, 0);
            PG8_WAIT_V(8); PG8_WAIT_L(0); PG8_BAR; PG8_MMA(1, 0, At, B0); PG8_MMA(1, 1, At, B1); PG8_BAR; PG8_SCHED;
            PG8_LDB(B0, 1, 0); PG8_LDB(B1, 1, 1); PG8_SCHED; PG8_LDA(At, 1, 0); PG8_STAGE_A(PG8_SA(0, 1), a2, vo2, 1);
            PG8_WAIT_V(8); PG8_WAIT_L(0); PG8_BAR; PG8_MMA(0, 0, At, B0); PG8_MMA(0, 1, At, B1); PG8_BAR; PG8_SCHED;
            PG8_LDA(At, 1, 1); PG8_STAGE(PG8_SB(1, 0), b3, voffB); PG8_STAGE(PG8_SB(1, 1), b3 + hstep, voffB); PG8_STAGE_A(PG8_SA(1, 0), a3, vo2, 0);
            PG8_WAIT_V(8); PG8_WAIT_L(0); PG8_BAR; PG8_MMA(1, 0, At, B0); PG8_MMA(1, 1, At, B1); PG8_BAR; PG8_SCHED;
        }
        if constexpr (ALIGN_EPI) { if (wr == 0) PG8_BAR; }
        if constexpr (!Epi::AFTER_DRAIN) { E(acc, cur, wr, wc, fr, fq); S.done(cur); }
        if (!has_next) break;
#pragma unroll
        for (int a = 0; a < 2; ++a)
#pragma unroll
            for (int b = 0; b < 2; ++b)
#pragma unroll
                for (int m = 0; m < 4; ++m)
#pragma unroll
                    for (int n = 0; n < 2; ++n) acc[a][b][m][n] = (f32x4){0.f, 0.f, 0.f, 0.f};
        cur = nxt; cA = nA; cB = nB; ++ui;
#pragma unroll
        for (int h_ = 0; h_ < 2; ++h_) { voC[h_][0] = voN[h_][0]; voC[h_][1] = voN[h_][1]; }
        if constexpr (ALIGN_EPI) { if (wr == 1) PG8_BAR; }
    }
    PG8_WAIT_V(0);
    if constexpr (!ALIGN_EPI) { if (wr == 0) PG8_BAR; }
    PG8_BAR;
    if constexpr (Epi::AFTER_DRAIN) { E.fused(acc, cur, wr, wc, fr, fq, lds, wid, lane); S.done(cur); }
#undef PG8_SA
#undef PG8_SB
#undef PG8_STAGE
#undef PG8_STAGE_A
#undef PG8_LDA
#undef PG8_LDB
#undef PG8_MMA
#undef PG8_WAIT_V
#undef PG8_WAIT_L
#undef PG8_BAR
#undef PG8_SCHED
}
}

constexpr int NWAVES = 8;
constexpr int T = 32768, D = 1024, SEQ = 8192, NBATCH = 4, NCHUNK = SEQ / 64;
constexpr int INC = 3328;
constexpr int PRW = 1536;
constexpr int NEXP = 32, TOPK = 4;
constexpr int NRB_MAX = T * TOPK / 256 + NEXP;
constexpr int NROWS_MAX = NRB_MAX * 256;
constexpr int NITEM = NBATCH * NCHUNK * 8;

constexpr size_t MiB = 1u << 20, KiB = 1u << 10;
constexpr size_t WS_CTL = 0, CTL_ZERO_BYTES = 1 * MiB;
constexpr size_t WS_META = 1 * MiB;
constexpr size_t WS_CNT = 1 * MiB + 64 * KiB;
constexpr size_t WS_EIDX = 2 * MiB, WS_GATE = 2 * MiB + 512 * KiB, WS_LRANK = 3 * MiB, WS_INV = 3 * MiB + 512 * KiB;
constexpr size_t WS_RSTD = 4 * MiB, WS_ROWRSTD = 4 * MiB + 256 * KiB;
constexpr size_t WS_WRT = 5 * MiB;
constexpr size_t WS_PAR = 5 * MiB + 128 * KiB;
constexpr size_t WS_WDEC = 5 * MiB + 256 * KiB, WS_WAAA = WS_WDEC + 64 * KiB, WS_WGATE = WS_WAAA + 64 * KiB;
constexpr size_t WS_WIN = 6 * MiB, WS_WOUT = 13 * MiB;
constexpr size_t WS_ROWTOK = 15 * MiB;
constexpr size_t WS_WUP = 16 * MiB, WS_WDN = 144 * MiB;
constexpr size_t WS_XN = 208 * MiB;
constexpr size_t WS_PROJ = 272 * MiB;
constexpr size_t WS_MIX = 480 * MiB;
constexpr size_t WS_RW = 544 * MiB;
constexpr size_t WS_XG = 272 * MiB, WS_ACT = 544 * MiB, WS_YR = WS_XG;
constexpr size_t WS_END = 1000 * MiB;
constexpr int CW_ATT = 8192;
constexpr int CW_BAR = 4096;

constexpr int RING_BYTES = 131072;
constexpr int LDS_BYTES = 163840;
constexpr int MISC_OFF = LDS_BYTES - 256;

#define GAS __attribute__((address_space(1)))
#define LAS __attribute__((address_space(3)))
#define DI __device__ __forceinline__
typedef unsigned short bf16;
typedef unsigned v4u __attribute__((ext_vector_type(4)));
typedef unsigned v2u __attribute__((ext_vector_type(2)));
typedef float f32x4 __attribute__((ext_vector_type(4)));
typedef float f32x2 __attribute__((ext_vector_type(2)));
typedef short bf16x8 __attribute__((ext_vector_type(8)));
typedef __bf16 bf16x2_t __attribute__((ext_vector_type(2)));
#define LDS_WAIT() asm volatile("s_waitcnt lgkmcnt(0)" ::: "memory")
#define VM_WAIT() asm volatile("s_waitcnt vmcnt(0)" ::: "memory")
DI unsigned pk2(float lo, float hi) { const f32x2 v = {lo, hi}; const bf16x2_t b = __builtin_convertvector(v, bf16x2_t); return __builtin_bit_cast(unsigned, b); }
DI float bf2f(unsigned short b) { return __uint_as_float((unsigned)b << 16); }
DI float bflo(unsigned w) { return __uint_as_float(w << 16); }
DI float bfhi(unsigned w) { return __uint_as_float(w & 0xffff0000u); }
DI float wave_sum(float v) {
#pragma unroll
    for (int o = 1; o < 64; o <<= 1) v += __shfl_xor(v, o);
    return v;
}
DI float wave_max(float v) {
#pragma unroll
    for (int o = 1; o < 64; o <<= 1) v = fmaxf(v, __shfl_xor(v, o));
    return v;
}
DI float sigmoidf_(float x) { return 1.0f / (1.0f + __expf(-x)); }
#define XB_TMO      128
#define XB_XCNT(j)  (256  + 64 * (j))
#define XB_XSUB(j)  (1280 + 64 * (j))
#define XB_XGEN(j)  (2304 + 64 * (j))
#define XB_TOP      3328
#define XB_TOPGEN   3392
#define XCD_BAR_WORDS 3456
#define XB_SPIN_CAP (NAIVE_RWKV ? (1u << 25) : (1u << 20))

__device__ __forceinline__ unsigned xb_ld(unsigned* p)              { return __hip_atomic_load(p, __ATOMIC_RELAXED, __HIP_MEMORY_SCOPE_AGENT); }
__device__ __forceinline__ unsigned xb_add(unsigned* p, unsigned v) { return __hip_atomic_fetch_add(p, v, __ATOMIC_RELAXED, __HIP_MEMORY_SCOPE_AGENT); }
__device__ __forceinline__ unsigned xb_xcc_id() { return (unsigned)__builtin_amdgcn_s_getreg((3 << 11) | 20) & 0xFu; }
#define XB_SPIN(cond, bar) do { unsigned _sp = 0; while (cond) { __builtin_amdgcn_s_sleep(1); \
    if ((++_sp & 255u) == 0u) { if (xb_ld(&(bar)[XB_TMO])) break; if (_sp > XB_SPIN_CAP) { atomicAdd(&(bar)[XB_TMO], 1u); break; } } } } while (0)

struct XcdBarrier {
    unsigned* bar; unsigned x;
    volatile LAS unsigned* st;
};

__device__ __forceinline__ XcdBarrier xcd_barrier_post(unsigned* bar, volatile LAS unsigned* st) {
    XcdBarrier b; b.bar = bar; b.x = xb_xcc_id(); b.st = st;
    if (threadIdx.x == 0) (void)xb_add(&bar[XB_XCNT(b.x)], 1u);
    return b;
}
__device__ __forceinline__ void xcd_barrier_complete(unsigned* bar, unsigned x, unsigned& nloc, unsigned& nx) {
    const unsigned G = gridDim.x * gridDim.y * gridDim.z;
    unsigned sum, cnt, mine, sp = 0u;
    for (;;) {
        sum = 0u; cnt = 0u; mine = 0u;
#pragma unroll
        for (unsigned j = 0; j < 16; ++j) { const unsigned c = xb_ld(&bar[XB_XCNT(j)]); sum += c; cnt += (c > 0u) ? 1u : 0u; mine = (j == x) ? c : mine; }
        if (sum == G) break;
        __builtin_amdgcn_s_sleep(1);
        if ((++sp & 255u) == 0u) { if (xb_ld(&bar[XB_TMO])) break; if (sp > XB_SPIN_CAP) { atomicAdd(&bar[XB_TMO], 1u); break; } }
    }
    nloc = mine > 0u ? mine : 1u; nx = cnt > 0u ? cnt : 1u;
}

__device__ __forceinline__ void xcd_barrier(const XcdBarrier& b) {
    asm volatile("s_waitcnt vmcnt(0)" ::: "memory");
    __syncthreads();
    if (threadIdx.x == 0) {
        unsigned* bar = b.bar;
        __builtin_amdgcn_s_waitcnt(0);
        unsigned nloc = b.st[0], nx = b.st[1];
        if (nloc == 0u) { xcd_barrier_complete(bar, b.x, nloc, nx); b.st[0] = nloc; b.st[1] = nx; }
        const unsigned old = xb_add(&bar[XB_XSUB(b.x)], 1u);
        const unsigned gen = old / nloc;
        if (old + 1u == (gen + 1u) * nloc) {
            __builtin_amdgcn_fence(__ATOMIC_RELEASE, "agent");
            asm volatile("s_waitcnt vmcnt(0)" ::: "memory");
            const unsigned og = xb_add(&bar[XB_TOP], 1u);
            const unsigned tg = og / nx;
            if (og + 1u == (tg + 1u) * nx) xb_add(&bar[XB_TOPGEN], 1u);
            else XB_SPIN(xb_ld(&bar[XB_TOPGEN]) == tg, bar);
            __builtin_amdgcn_fence(__ATOMIC_ACQUIRE, "agent");
            xb_add(&bar[XB_XGEN(b.x)], 1u);
            asm volatile("s_waitcnt vmcnt(0)" ::: "memory");
        } else {
            XB_SPIN(xb_ld(&bar[XB_XGEN(b.x)]) == gen, bar);
            __builtin_amdgcn_fence(__ATOMIC_ACQUIRE, "agent");
            asm volatile("s_waitcnt vmcnt(0)" ::: "memory");
        }
    }
    __syncthreads();
}

struct Args {
    const float* in[25]; float* out; unsigned char* ws; int ph_lo, ph_hi, ph_rep, pad_;
};
enum { I_X = 0, I_N1G, I_WIN, I_MU, I_QG, I_KG, I_RELB, I_W0, I_WDEC, I_A0, I_WAAA, I_WGATE, I_KK, I_KA, I_RK, I_LNG, I_LNB, I_WOUT, I_N2G, I_WR, I_BR, I_WUP, I_BUP, I_WDN, I_BDN };
struct Frame {
    LAS unsigned char* lds;
    int tid, lane, wave, G, bid;
};


struct TrRegs { f32x4 v[8]; bf16* dst; int ldo; };
DI void tr_load(TrRegs& t, const float* __restrict__ W, int ldw, int k0, int n0, bf16* WT, int ldo, long drow, int lane) {
    const int r8 = lane >> 3, c4 = lane & 7;
    const float* src = W + (size_t)(k0 + 8 * r8) * ldw + n0 + 4 * c4;
#pragma unroll
    for (int i = 0; i < 8; ++i) t.v[i] = __builtin_nontemporal_load((const f32x4*)(src + (size_t)i * ldw));
    t.dst = WT + (size_t)(drow + 4 * c4) * ldo + k0 + 8 * r8; t.ldo = ldo;
}
DI void tr_store(const TrRegs& t, const float* __restrict__ ksc8) {
    f32x4 s0 = {1.f, 1.f, 1.f, 1.f}, s1 = s0;
    if (ksc8) { s0 = *(const f32x4*)ksc8; s1 = *(const f32x4*)(ksc8 + 4); }
#pragma unroll
    for (int j = 0; j < 4; ++j) { const v4u o = {pk2(t.v[0][j] * s0[0], t.v[1][j] * s0[1]), pk2(t.v[2][j] * s0[2], t.v[3][j] * s0[3]), pk2(t.v[4][j] * s1[0], t.v[5][j] * s1[1]), pk2(t.v[6][j] * s1[2], t.v[7][j] * s1[3])};
        __builtin_nontemporal_store(o, (v4u*)(t.dst + (size_t)j * t.ldo)); }
}
DI void tr_item(const float* __restrict__ W, int ldw, int k0, int n0, bf16* WT, int ldo, long drow, LAS float* scr, int lane, const float* __restrict__ ksc) {
    (void)scr; TrRegs t; tr_load(t, W, ldw, k0, n0, WT, ldo, drow, lane); tr_store(t, ksc ? ksc + k0 + 8 * (lane >> 3) : nullptr);
}
constexpr int MOE_TR_UP = NEXP * 16 * 64, MOE_TR_DN = NEXP * 16 * 32, MOE_TR_ALL = MOE_TR_UP + MOE_TR_DN;
DI const float* moe_tr_load(TrRegs& t, const Args& a, int r, int lane) {
    unsigned char* ws = a.ws;
    if (r < MOE_TR_UP) { const int e = r / 1024, kb = (r % 1024) / 64, nb = r % 64, n0 = 32 * nb; const int n1 = n0 & 1023;
        const long drow = (long)(n1 / 128) * 256 + (n0 >= 1024 ? 128 : 0) + (n1 % 128);
        tr_load(t, a.in[I_WUP] + (size_t)e * 1024 * 2048, 2048, 64 * kb, n0, (bf16*)(ws + WS_WUP) + (size_t)e * 2048 * 1024, 1024, drow, lane);
        return a.in[I_N2G] + 64 * kb + 8 * (lane >> 3); }
    r -= MOE_TR_UP; const int e = r / 512, kb = (r % 512) / 32, nb = r % 32;
    tr_load(t, a.in[I_WDN] + (size_t)e * 1024 * 1024, 1024, 64 * kb, 32 * nb, (bf16*)(ws + WS_WDN) + (size_t)e * 1024 * 1024, 1024, 32 * nb, lane);
    return nullptr;
}
DI void moe_tr_item(const Args& a, int r, LAS float* scr, int lane) { (void)scr; TrRegs t; const float* s = moe_tr_load(t, a, r, lane); tr_store(t, s); }
DI void moe_tr_batch(const Args& a, int batch, int wave, int lane) {
    const int base = batch * 64 + wave * 8;
    for (int i = 0; i < 8; i += 4) { TrRegs t[4]; const float* sc[4];
#pragma unroll
        for (int j = 0; j < 4; ++j) sc[j] = moe_tr_load(t[j], a, base + i + j, lane);
#pragma unroll
        for (int j = 0; j < 4; ++j) tr_store(t[j], sc[j]); }
}
constexpr int MOE_TR_BATCHES = MOE_TR_ALL / 64, MOE_TR_EARLY = 256;

#if !NAIVE_ATT
constexpr int ATT_KS = 144;
constexpr int ATT_TILE = 64 * ATT_KS;
constexpr int ATT_BIAS_OFF = 4 * ATT_TILE;
constexpr int ATT_NSLOT = (NBATCH * 8 * (NCHUNK / 2) / 8) * 11;
static_assert(NBATCH * 8 * (NCHUNK / 2) == 2048 && MOE_TR_ALL == 256 * 3 * 64, "attention / conversion work queue");
DI int att_pos(int key) { return (key & 32) + 8 * ((key >> 2) & 3) + 4 * ((key >> 4) & 1) + (key & 3); }
DI void attn_phase(const Frame& F, const Args& a, const int qid = 0) {
    const bf16* proj = (const bf16*)(a.ws + WS_PROJ); bf16* mix = (bf16*)(a.ws + WS_MIX);
    LAS unsigned char* lds = F.lds; LAS float* sbias = (LAS float*)(lds + ATT_BIAS_OFF);
    const int l = F.lane, n16 = l & 15, q = l >> 4, w = F.wave;
    const float LOG2E = 1.4426950408889634f;
    const int srow = F.tid >> 3, spc = F.tid & 7;
    float kgv[8];
#pragma unroll
    for (int j = 0; j < 8; ++j) kgv[j] = a.in[I_KG][8 * spc + j];
    const int spos = att_pos(srow);
    LAS int* s_item = (LAS int*)(lds + ATT_BIAS_OFF + 1024);
    unsigned* qhead = (unsigned*)(a.ws + WS_CTL) + CW_ATT + 64 * qid;
    for (;;) {
        __syncthreads();
        if (F.tid == 0) *s_item = (int)__hip_atomic_fetch_add(qhead, 1u, __ATOMIC_RELAXED, __HIP_MEMORY_SCOPE_AGENT);
        __syncthreads();
        const int slot = *s_item;
        if (slot >= ATT_NSLOT) break;
        const int grp = slot / 11, sub = slot % 11;
        if (sub >= 8) { const int base = (grp * 3 + (sub - 8)) * 64 + w * 8;
            (void)base; moe_tr_batch(a, grp * 3 + (sub - 8), w, l);
            continue; }
        const int item = grp * 8 + sub;
        const int b = item / (8 * (NCHUNK / 2)), h = (item / (NCHUNK / 2)) & 7, n0 = 2 * (item % (NCHUNK / 2));
        if (F.tid < 192) sbias[F.tid] = a.in[I_RELB][h * 192 + F.tid] * LOG2E;
        const int nq = n0 + (w >> 2), qpos = 16 * (w & 3) + n16;
        const size_t qtok = (size_t)b * SEQ + nq * 64 + qpos;
        bf16x8 qf[2];
        { const v4u q0 = *(const v4u*)(proj + qtok * INC + h * 64 + 8 * q), q1 = *(const v4u*)(proj + qtok * INC + h * 64 + 32 + 8 * q);
          float f[16]; const unsigned ww[8] = {q0.x, q0.y, q0.z, q0.w, q1.x, q1.y, q1.z, q1.w};
          float ss = 0.f;
#pragma unroll
          for (int e = 0; e < 8; ++e) { f[2 * e] = bflo(ww[e]); f[2 * e + 1] = bfhi(ww[e]); ss += f[2 * e] * f[2 * e] + f[2 * e + 1] * f[2 * e + 1]; }
          ss += __shfl_xor(ss, 16); ss += __shfl_xor(ss, 32);
          const float rs = (1.0f / sqrtf(ss * (1.f / 64.f) + 1e-6f)) * 0.125f * LOG2E;
          unsigned pk[8];
#pragma unroll
          for (int e = 0; e < 8; ++e) { const int d = (e < 4 ? 0 : 32) + 8 * q + 2 * (e & 3); pk[e] = pk2(f[2 * e] * rs * a.in[I_QG][d], f[2 * e + 1] * rs * a.in[I_QG][d + 1]); }
          const v4u p0 = {pk[0], pk[1], pk[2], pk[3]}, p1 = {pk[4], pk[5], pk[6], pk[7]};
          qf[0] = __builtin_bit_cast(bf16x8, p0); qf[1] = __builtin_bit_cast(bf16x8, p1); }
        f32x4 o[4];
#pragma unroll
        for (int dt = 0; dt < 4; ++dt) o[dt] = (f32x4){0.f, 0.f, 0.f, 0.f};
        float m_run = -3.0e38f, l_run = 0.f;
        v4u kreg, vreg;
        auto gload = [&](int jc) { const int kc = n0 - 8 + jc; if (kc >= 0) { const size_t tok = (size_t)b * SEQ + kc * 64 + srow;
            kreg = *(const v4u*)(proj + tok * INC + 512 + h * 64 + 8 * spc); vreg = *(const v4u*)(proj + tok * INC + 1024 + h * 64 + 8 * spc); } };
        auto lstore = [&](int jc) { const int kc = n0 - 8 + jc; if (kc >= 0) { LAS unsigned char* kb = lds + (jc & 1) * 2 * ATT_TILE; LAS unsigned char* vb = kb + ATT_TILE;
            const unsigned ww[4] = {kreg.x, kreg.y, kreg.z, kreg.w}; float f[8]; float ss = 0.f;
#pragma unroll
            for (int e = 0; e < 4; ++e) { f[2 * e] = bflo(ww[e]); f[2 * e + 1] = bfhi(ww[e]); ss += f[2 * e] * f[2 * e] + f[2 * e + 1] * f[2 * e + 1]; }
            ss += __builtin_bit_cast(float, __builtin_amdgcn_update_dpp(0, __builtin_bit_cast(int, ss), 0xB1, 0xf, 0xf, true));
            ss += __builtin_bit_cast(float, __builtin_amdgcn_update_dpp(0, __builtin_bit_cast(int, ss), 0x4E, 0xf, 0xf, true));
            ss += __builtin_bit_cast(float, __builtin_amdgcn_update_dpp(0, __builtin_bit_cast(int, ss), 0x141, 0xf, 0xf, true));
            const float rs = 1.0f / sqrtf(ss * (1.f / 64.f) + 1e-6f);
            v4u kk; kk.x = pk2(f[0] * rs * kgv[0], f[1] * rs * kgv[1]); kk.y = pk2(f[2] * rs * kgv[2], f[3] * rs * kgv[3]); kk.z = pk2(f[4] * rs * kgv[4], f[5] * rs * kgv[5]); kk.w = pk2(f[6] * rs * kgv[6], f[7] * rs * kgv[7]);
            *(LAS v4u*)(kb + srow * ATT_KS + 16 * spc) = kk;
            const unsigned vv[4] = {vreg.x, vreg.y, vreg.z, vreg.w};
#pragma unroll
            for (int e = 0; e < 4; ++e) { *(LAS unsigned short*)(vb + (8 * spc + 2 * e) * ATT_KS + 2 * spos) = (unsigned short)(vv[e] & 0xffffu);
                                          *(LAS unsigned short*)(vb + (8 * spc + 2 * e + 1) * ATT_KS + 2 * spos) = (unsigned short)(vv[e] >> 16); } } };
        gload(0); lstore(0);
        __syncthreads();
        for (int jc = 0; jc < 10; ++jc) {
            if (jc + 1 < 10) gload(jc + 1);
            const int kc = n0 - 8 + jc, dj = jc - (w >> 2);
            if (kc >= 0 && dj >= 0 && dj <= 8) {
                const LAS unsigned char* kb = lds + (jc & 1) * 2 * ATT_TILE; const LAS unsigned char* vb = kb + ATT_TILE;
                f32x4 sc[4];
#pragma unroll
                for (int mt = 0; mt < 4; ++mt) { sc[mt] = (f32x4){0.f, 0.f, 0.f, 0.f};
#pragma unroll
                    for (int ks = 0; ks < 2; ++ks) { const bf16x8 kf = *(const LAS bf16x8*)(kb + (16 * mt + n16) * ATT_KS + 64 * ks + 16 * q);
                        sc[mt] = __builtin_amdgcn_mfma_f32_16x16x32_bf16(kf, qf[ks], sc[mt], 0, 0, 0); } }
                float boff = 0.f;
                if (dj <= 5) boff = sbias[0];
                else { const int base = (dj - 8) * 64 - qpos + 128;
#pragma unroll
                    for (int mt = 0; mt < 4; ++mt)
#pragma unroll
                        for (int i = 0; i < 4; ++i) { int idx = base + 16 * mt + 4 * q + i; idx = idx < 0 ? 0 : idx; sc[mt][i] += sbias[idx]; } }
                float mx = sc[0][0];
#pragma unroll
                for (int mt = 0; mt < 4; ++mt)
#pragma unroll
                    for (int i = 0; i < 4; ++i) mx = fmaxf(mx, sc[mt][i]);
                mx = fmaxf(mx, __shfl_xor(mx, 16)); mx = fmaxf(mx, __shfl_xor(mx, 32));
                const float m_new = fmaxf(m_run, mx + boff), alpha = __builtin_amdgcn_exp2f(m_run - m_new), msub = m_new - boff;
                const bool moved = __builtin_amdgcn_ballot_w64(m_new != m_run) != 0ull;
                m_run = m_new; float ls = 0.f;
#pragma unroll
                for (int mt = 0; mt < 4; ++mt)
#pragma unroll
                    for (int i = 0; i < 4; ++i) { sc[mt][i] = __builtin_amdgcn_exp2f(sc[mt][i] - msub); ls += sc[mt][i]; }
                if (moved) { l_run *= alpha;
#pragma unroll
                    for (int dt = 0; dt < 4; ++dt) o[dt] = o[dt] * alpha; }
                l_run += ls;
#pragma unroll
                for (int s = 0; s < 2; ++s) {
                    const v4u pp = {pk2(sc[2 * s][0], sc[2 * s][1]), pk2(sc[2 * s][2], sc[2 * s][3]), pk2(sc[2 * s + 1][0], sc[2 * s + 1][1]), pk2(sc[2 * s + 1][2], sc[2 * s + 1][3])};
                    const bf16x8 pf = __builtin_bit_cast(bf16x8, pp);
#pragma unroll
                    for (int dt = 0; dt < 4; ++dt) { const bf16x8 vf = *(const LAS bf16x8*)(vb + (16 * dt + n16) * ATT_KS + 64 * s + 16 * q);
                        o[dt] = __builtin_amdgcn_mfma_f32_16x16x32_bf16(vf, pf, o[dt], 0, 0, 0); } }
            }
            if (jc + 1 < 10) lstore(jc + 1);
            __syncthreads();
        }
        l_run += __shfl_xor(l_run, 16); l_run += __shfl_xor(l_run, 32);
        const float inv = 1.0f / l_run;
#pragma unroll
        for (int dt = 0; dt < 4; ++dt) { v2u ov; ov.x = pk2(o[dt][0] * inv, o[dt][1] * inv); ov.y = pk2(o[dt][2] * inv, o[dt][3] * inv);
            *(v2u*)(mix + qtok * 1024 + h * 64 + 16 * dt + 4 * q) = ov; }
    }
}
#endif

#if !NAIVE_RWKV
constexpr int RA_HALF = 80896;
constexpr int RA_RT = 0, RA_KT = 9216, RA_BT = 18432, RA_AT = 27648;
constexpr int RA_VT = 36864, RA_KH = 46080, RA_BH = 55296;
constexpr int RA_AAB = 64512;
constexpr int RA_XWD = 0, RA_XAD = 9216, RA_XGD = 18432;
constexpr int RA_RHS2 = 0, RA_GEND = 17408;
constexpr int RA_W1T = 18432, RA_W2T = 27648;
constexpr int RA_WT = RA_AAB;
constexpr int RB_REC = 65536, RB_YLT = 0, RB_PCT = 8192, RB_G1T = 16384, RB_E2T = 24576, RB_MC = 32768, RB_CC = 40960, RB_SC = 57344;
static_assert(2 * RA_HALF <= MISC_OFF, "rwkv phase A LDS");

DI void ld8f(const bf16* p, float (&f)[8]) { const v4u w = *(const v4u*)p; f[0] = bflo(w.x); f[1] = bfhi(w.x); f[2] = bflo(w.y); f[3] = bfhi(w.y); f[4] = bflo(w.z); f[5] = bfhi(w.z); f[6] = bflo(w.w); f[7] = bfhi(w.w); }
DI void ld4f(const bf16* p, float (&f)[4]) { const v2u w = *(const v2u*)p; f[0] = bflo(w.x); f[1] = bfhi(w.x); f[2] = bflo(w.y); f[3] = bfhi(w.y); }
DI bf16x8 pack8(const f32x4& a, const f32x4& b) { const v4u p = {pk2(a[0], a[1]), pk2(a[2], a[3]), pk2(b[0], b[1]), pk2(b[2], b[3])}; return __builtin_bit_cast(bf16x8, p); }
DI float fast_sigmoid(float x) { return __builtin_amdgcn_rcpf(1.0f + __builtin_amdgcn_exp2f(-1.4426950408889634f * x)); }
DI float fast_tanh(float x) { return 1.0f - 2.0f * __builtin_amdgcn_rcpf(1.0f + __builtin_amdgcn_exp2f(2.8853900817779268f * x)); }
#define MFMA16(a, b, c) __builtin_amdgcn_mfma_f32_16x16x32_bf16((a), (b), (c), 0, 0, 0)

DI void rwkv_phase_a(const Frame& F, const Args& a) {
    unsigned char* ws = a.ws; unsigned char* rb = ws + WS_RW;
    const bf16* wdec = (const bf16*)(ws + WS_WDEC); const bf16* waaa = (const bf16*)(ws + WS_WAAA); const bf16* wgate = (const bf16*)(ws + WS_WGATE);
    const float* mu = a.in[I_MU]; const float* par = (const float*)(ws + WS_PAR);
    const int hb = F.wave >> 2, w4 = F.wave & 3;
    LAS unsigned char* hbase = F.lds + hb * RA_HALF;
    const float LOG2E = 1.4426950408889634f;
    v4u s0c[4];
#define RA_REQUEST(pair_) do { const int item_ = 2 * (pair_) + hb, c_ = (item_ >> 3) & 127, b_ = item_ >> 10; const size_t tok0_ = (size_t)b_ * SEQ + c_ * 64; \
        int lq_ = F.lane; asm volatile("" : "+v"(lq_)); size_t wsq_ = (size_t)ws; asm volatile("" : "+s"(wsq_)); const int t9q_ = (hb << 8) | (w4 << 6) | lq_; \
        const bf16* cur_ = (const bf16*)(wsq_ + WS_PROJ) + (tok0_ + (t9q_ >> 3)) * INC + PRW + 1536 + 32 * (t9q_ & 7); \
        _Pragma("unroll") for (int g8 = 0; g8 < 4; ++g8) s0c[g8] = *(const v4u*)(cur_ + 8 * g8); } while (0)
    if (F.bid < NITEM / 2) RA_REQUEST(F.bid);
    for (int pair = F.bid; pair < NITEM / 2; pair += F.G) {
        size_t wsb = (size_t)ws; asm volatile("" : "+s"(wsb)); const bf16* proj = (const bf16*)(wsb + WS_PROJ);
        int l = F.lane; asm volatile("" : "+v"(l));
        const int n16 = l & 15, q = l >> 4, t4 = (hb << 8 | (F.wave & 3) << 6 | l) & 255;
        const int tokl = 16 * w4 + n16;
        const int tslot = (tokl & 32) + 8 * ((tokl >> 2) & 3) + 4 * ((tokl >> 4) & 1) + (tokl & 3);
        const int item = 2 * pair + hb, h = item & 7, c = (item >> 3) & 127, b = item >> 10;
        const size_t tok0 = (size_t)b * SEQ + c * 64; unsigned char* rbi = rb + (size_t)item * RB_REC;
        const int t9 = (hb << 8) | t4, tk0 = t9 >> 3, part = t9 & 7;
        v4u s0p[4];
        { const bool first = (c == 0 && tk0 == 0); const bf16* prv = proj + (tok0 + tk0) * INC + PRW + 1536 + 32 * part - INC;
#pragma unroll
          for (int g8 = 0; g8 < 4; ++g8) { s0p[g8] = (v4u){0u, 0u, 0u, 0u}; if (!first) s0p[g8] = *(const v4u*)(prv + 8 * g8); } }
        v2u rawc[3][4], rawp[3][4];
        { const bool first = (c == 0 && tokl == 0); const bf16* cur = proj + (tok0 + tokl) * INC + PRW + h * 64 + 4 * q; const bf16* prv = cur - INC;
#pragma unroll
          for (int m = 0; m < 3; ++m)
#pragma unroll
              for (int ct = 0; ct < 4; ++ct) { rawc[m][ct] = *(const v2u*)(cur + 512 * m + 16 * ct); rawp[m][ct] = (v2u){0u, 0u}; if (!first) rawp[m][ct] = *(const v2u*)(prv + 512 * m + 16 * ct); } }
        bf16x8 wfr[2][8];
#define RA_WLOAD(dst, ctv) do { const int row_ = h * 64 + 16 * (ctv) + n16; \
            dst[0] = *(const bf16x8*)(wdec + row_ * 64 + 8 * q); dst[1] = *(const bf16x8*)(wdec + row_ * 64 + 32 + 8 * q); \
            dst[2] = *(const bf16x8*)(waaa + row_ * 64 + 8 * q); dst[3] = *(const bf16x8*)(waaa + row_ * 64 + 32 + 8 * q); \
            _Pragma("unroll") for (int ks_ = 0; ks_ < 4; ++ks_) dst[4 + ks_] = *(const bf16x8*)(wgate + row_ * 128 + 32 * ks_ + 8 * q); } while (0)
        RA_WLOAD(wfr[0], 0); RA_WLOAD(wfr[1], 1);
        __syncthreads();
        { const float esc = part < 2 ? 2.8853900817779268f : -1.4426950408889634f;
          LAS unsigned char* dst = F.lds + (part < 2 ? RA_XWD + tk0 * 144 + part * 64 : (part < 4 ? RA_XAD + tk0 * 144 + (part - 2) * 64 : RA_XGD + tk0 * 272 + (part - 4) * 64));
#pragma unroll
          for (int g8 = 0; g8 < 4; ++g8) {
              const unsigned xw[4] = {s0c[g8].x, s0c[g8].y, s0c[g8].z, s0c[g8].w}, pw[4] = {s0p[g8].x, s0p[g8].y, s0p[g8].z, s0p[g8].w};
              const f32x4 m0 = *(const f32x4*)(mu + 1536 + 32 * part + 8 * g8), m1 = *(const f32x4*)(mu + 1536 + 32 * part + 8 * g8 + 4);
              float y[8];
#pragma unroll
              for (int j = 0; j < 8; ++j) { const float x = (j & 1) ? bfhi(xw[j >> 1]) : bflo(xw[j >> 1]), p = (j & 1) ? bfhi(pw[j >> 1]) : bflo(pw[j >> 1]);
                  const float xs = x + (p - x) * (j < 4 ? m0[j & 3] : m1[j & 3]);
                  const float rc = __builtin_amdgcn_rcpf(1.0f + __builtin_amdgcn_exp2f(esc * xs));
                  y[j] = part < 2 ? 1.0f - 2.0f * rc : (part < 4 ? xs : rc); }
              const v4u o = {pk2(y[0], y[1]), pk2(y[2], y[3]), pk2(y[4], y[5]), pk2(y[6], y[7])};
              *(LAS v4u*)(dst + 16 * g8) = o; } }
        v2u shv[3][4];
#pragma unroll
        for (int m = 0; m < 3; ++m)
#pragma unroll
            for (int ct = 0; ct < 4; ++ct) { const v2u xw = rawc[m][ct], pw = rawp[m][ct];
                const f32x4 mm = *(const f32x4*)(mu + 512 * m + h * 64 + 16 * ct + 4 * q);
                const float x0 = bflo(xw.x), x1 = bfhi(xw.x), x2 = bflo(xw.y), x3 = bfhi(xw.y);
                shv[m][ct].x = pk2(x0 + (bflo(pw.x) - x0) * mm[0], x1 + (bfhi(pw.x) - x1) * mm[1]); shv[m][ct].y = pk2(x2 + (bflo(pw.y) - x2) * mm[2], x3 + (bfhi(pw.y) - x3) * mm[3]); }
        __syncthreads();
        f32x4 awl[4], aal[4], ag[4];
        { bf16x8 bwd[2], bad[2], bgd[4], wf2[2][8];
          RA_WLOAD(wf2[0], 2); RA_WLOAD(wf2[1], 3);
#pragma unroll
          for (int ks = 0; ks < 2; ++ks) { bwd[ks] = *(const LAS bf16x8*)(F.lds + RA_XWD + tokl * 144 + 64 * ks + 16 * q); bad[ks] = *(const LAS bf16x8*)(F.lds + RA_XAD + tokl * 144 + 64 * ks + 16 * q); }
#pragma unroll
          for (int ks = 0; ks < 4; ++ks) bgd[ks] = *(const LAS bf16x8*)(F.lds + RA_XGD + tokl * 272 + 64 * ks + 16 * q);
#pragma unroll
          for (int ct = 0; ct < 4; ++ct) { const bf16x8* wv = ct < 2 ? wfr[ct] : wf2[ct - 2];
              awl[ct] = (f32x4){0.f, 0.f, 0.f, 0.f}; aal[ct] = awl[ct]; ag[ct] = awl[ct];
#pragma unroll
              for (int ks = 0; ks < 2; ++ks) { awl[ct] = MFMA16(wv[ks], bwd[ks], awl[ct]); aal[ct] = MFMA16(wv[2 + ks], bad[ks], aal[ct]); }
#pragma unroll
              for (int ks = 0; ks < 4; ++ks) ag[ct] = MFMA16(wv[4 + ks], bgd[ks], ag[ct]); } }
#undef RA_WLOAD
        v2u rtp[4];
        {
#define RA_SHIFT(dst, pcol, ctv) do { const v2u w_ = shv[(pcol) / 512][ctv]; dst[0] = bflo(w_.x); dst[1] = bfhi(w_.x); dst[2] = bflo(w_.y); dst[3] = bfhi(w_.y); } while (0)
          float nrm = 0.f, bd = 0.f;
#pragma unroll
          for (int ct = 0; ct < 4; ++ct) { const int ch = h * 64 + 16 * ct + 4 * q;
              float r4[4], k4[4]; RA_SHIFT(r4, 0, ct); RA_SHIFT(k4, 512, ct);
              const f32x4 a0v = *(const f32x4*)(par + 512 + ch), kkv = *(const f32x4*)(par + 1024 + ch), kav = *(const f32x4*)(par + 1536 + ch), rkv = *(const f32x4*)(par + 2048 + ch);
#pragma unroll
              for (int i = 0; i < 4; ++i) { const float av = fast_sigmoid(a0v[i] + aal[ct][i]); const float kk = k4[i] * kkv[i]; nrm += kk * kk;
                  bd += r4[i] * (k4[i] * (1.0f + (av - 1.0f) * kav[i])) * rkv[i]; } }
          nrm += __shfl_xor(nrm, 16); nrm += __shfl_xor(nrm, 32); bd += __shfl_xor(bd, 16); bd += __shfl_xor(bd, 32);
          const float kinv = 1.0f / fmaxf(sqrtf(nrm), 1e-12f);
          float lw[4][4], lg[4][4], lgend[4][4];
#pragma unroll
          for (int ct = 0; ct < 4; ++ct) { const f32x4 w0v = *(const f32x4*)(par + h * 64 + 16 * ct + 4 * q);
#pragma unroll
              for (int i = 0; i < 4; ++i) { lw[ct][i] = (-0.6065306597126334f * LOG2E) * fast_sigmoid(w0v[i] + awl[ct][i]); float x = lw[ct][i];
                  x += __builtin_bit_cast(float, __builtin_amdgcn_update_dpp(0, __builtin_bit_cast(int, x), 0x111, 0xf, 0xf, false));
                  x += __builtin_bit_cast(float, __builtin_amdgcn_update_dpp(0, __builtin_bit_cast(int, x), 0x112, 0xf, 0xf, false));
                  x += __builtin_bit_cast(float, __builtin_amdgcn_update_dpp(0, __builtin_bit_cast(int, x), 0x114, 0xf, 0xf, false));
                  x += __builtin_bit_cast(float, __builtin_amdgcn_update_dpp(0, __builtin_bit_cast(int, x), 0x118, 0xf, 0xf, false));
                  lg[ct][i] = x; } }
          LAS float* wt = (LAS float*)(hbase + RA_WT);
          if (n16 == 15) {
#pragma unroll
              for (int ct = 0; ct < 4; ++ct) *(LAS f32x4*)(wt + w4 * 64 + 16 * ct + 4 * q) = (f32x4){lg[ct][0], lg[ct][1], lg[ct][2], lg[ct][3]}; }
          __syncthreads();
#pragma unroll
          for (int ct = 0; ct < 4; ++ct) { f32x4 off = {0.f, 0.f, 0.f, 0.f}, tot = {0.f, 0.f, 0.f, 0.f};
#pragma unroll
              for (int w = 0; w < 4; ++w) { const f32x4 t = *(const LAS f32x4*)(wt + w * 64 + 16 * ct + 4 * q); tot = tot + t; if (w < w4) off = off + t; }
#pragma unroll
              for (int i = 0; i < 4; ++i) { lg[ct][i] += off[i]; lgend[ct][i] = tot[i]; } }
#pragma unroll
          for (int ct = 0; ct < 4; ++ct) { const int ch = h * 64 + 16 * ct + 4 * q;
              float r4[4], k4[4], v4[4]; RA_SHIFT(r4, 0, ct); RA_SHIFT(k4, 512, ct); RA_SHIFT(v4, 1024, ct);
              const f32x4 a0v = *(const f32x4*)(par + 512 + ch), kkv = *(const f32x4*)(par + 1024 + ch), kav = *(const f32x4*)(par + 1536 + ch);
              const f32x4 lg_ = *(const f32x4*)(par + 2560 + ch), lb_ = *(const f32x4*)(par + 3072 + ch);
              float rtl[4], ktl[4], btl[4], atl[4], khh[4], bhh[4], g1[4], e2[4];
#pragma unroll
              for (int i = 0; i < 4; ++i) {
                  const float av = fast_sigmoid(a0v[i] + aal[ct][i]); const float k2 = k4[i] * (1.0f + (av - 1.0f) * kav[i]);
                  const float kkn = k4[i] * kkv[i] * kinv, bb = kkn * av;
                  const float gam = __builtin_amdgcn_exp2f(lg[ct][i]), gpv = __builtin_amdgcn_exp2f(lg[ct][i] - lw[ct][i]), gin = __builtin_amdgcn_exp2f(-lg[ct][i]), ger = __builtin_amdgcn_exp2f(lgend[ct][i] - lg[ct][i]);
                  rtl[i] = r4[i] * gam; ktl[i] = k2 * gin; btl[i] = bb * gin; atl[i] = -kkn * gpv; khh[i] = k2 * ger; bhh[i] = bb * ger;
                  const float g = ag[ct][i]; g1[i] = lg_[i] * g; e2[i] = (lb_[i] + bd * v4[i]) * g;
              }
              const int fo = ((w4 * 4 + ct) * 64 + l) * 8;
              v2u o; o.x = pk2(g1[0], g1[1]); o.y = pk2(g1[2], g1[3]); __builtin_nontemporal_store(o, (v2u*)(rbi + RB_G1T + fo));
              o.x = pk2(e2[0], e2[1]); o.y = pk2(e2[2], e2[3]); __builtin_nontemporal_store(o, (v2u*)(rbi + RB_E2T + fo));
              const int co = tokl * 144 + (16 * ct + 4 * q) * 2;
              o.x = pk2(rtl[0], rtl[1]); o.y = pk2(rtl[2], rtl[3]); *(LAS v2u*)(hbase + RA_RT + co) = o; rtp[ct] = o;
              o.x = pk2(ktl[0], ktl[1]); o.y = pk2(ktl[2], ktl[3]); *(LAS v2u*)(hbase + RA_KT + co) = o;
              o.x = pk2(btl[0], btl[1]); o.y = pk2(btl[2], btl[3]); *(LAS v2u*)(hbase + RA_BT + co) = o;
              o.x = pk2(atl[0], atl[1]); o.y = pk2(atl[2], atl[3]); *(LAS v2u*)(hbase + RA_AT + co) = o;
#pragma unroll
              for (int i = 0; i < 4; ++i) { const int ro = (16 * ct + 4 * q + i) * 144 + 2 * tslot;
                  if (tokl == 0) *(LAS float*)(hbase + RA_VT + (16 * ct + 4 * q + i) * 144 + 128) = __builtin_amdgcn_exp2f(lgend[ct][i]);
                  *(LAS unsigned short*)(hbase + RA_VT + ro) = (unsigned short)(pk2(v4[i], 0.f) & 0xffffu);
                  *(LAS unsigned short*)(hbase + RA_KH + ro) = (unsigned short)(pk2(khh[i], 0.f) & 0xffffu);
                  *(LAS unsigned short*)(hbase + RA_BH + ro) = (unsigned short)(pk2(bhh[i], 0.f) & 0xffffu); }
              asm volatile("" ::: "memory");
          }
#undef RA_SHIFT
        }
        __syncthreads();
        bf16x8 akp[2], rkp[2], rbp[2];
        { bf16x8 fa[2], fr[2];
#pragma unroll
          for (int ks = 0; ks < 2; ++ks) { fa[ks] = *(const LAS bf16x8*)(hbase + RA_AT + tokl * 144 + 64 * ks + 16 * q); fr[ks] = *(const LAS bf16x8*)(hbase + RA_RT + tokl * 144 + 64 * ks + 16 * q); }
          f32x4 aak[4], arkk[4], arb[4];
#pragma unroll
          for (int jt = 0; jt < 4; ++jt) {
              f32x4 tab = {0.f, 0.f, 0.f, 0.f}; aak[jt] = tab; arkk[jt] = tab; arb[jt] = tab;
              if (jt <= w4) {
#pragma unroll
                  for (int ks = 0; ks < 2; ++ks) { const bf16x8 fk = *(const LAS bf16x8*)(hbase + RA_KT + (16 * jt + n16) * 144 + 64 * ks + 16 * q), fb = *(const LAS bf16x8*)(hbase + RA_BT + (16 * jt + n16) * 144 + 64 * ks + 16 * q);
                      aak[jt] = MFMA16(fk, fa[ks], aak[jt]); tab = MFMA16(fb, fa[ks], tab); arkk[jt] = MFMA16(fk, fr[ks], arkk[jt]); arb[jt] = MFMA16(fb, fr[ks], arb[jt]); }
                  if (jt == w4) {
#pragma unroll
                      for (int i = 0; i < 4; ++i) { const int j = 4 * q + i; if (j >= n16) { aak[jt][i] = 0.f; tab[i] = 0.f; } if (j > n16) { arkk[jt][i] = 0.f; arb[jt][i] = 0.f; } } }
                  *(LAS f32x4*)(hbase + RA_AAB + tokl * 256 + (16 * jt + 4 * q) * 4) = tab;
              }
          }
#pragma unroll
          for (int s = 0; s < 2; ++s) { akp[s] = pack8(aak[2 * s], aak[2 * s + 1]); rkp[s] = pack8(arkk[2 * s], arkk[2 * s + 1]); rbp[s] = pack8(arb[2 * s], arb[2 * s + 1]); } }
        { f32x4 akv[4];
#pragma unroll
          for (int vt = 0; vt < 4; ++vt) { akv[vt] = (f32x4){0.f, 0.f, 0.f, 0.f};
#pragma unroll
              for (int s = 0; s < 2; ++s) { const bf16x8 fv = *(const LAS bf16x8*)(hbase + RA_VT + (16 * vt + n16) * 144 + 64 * s + 16 * q); akv[vt] = MFMA16(akp[s], fv, akv[vt]); } }
          __syncthreads();
#pragma unroll
          for (int vt = 0; vt < 4; ++vt) *(LAS f32x4*)(hbase + RA_RHS2 + (16 * vt + n16) * 272 + (16 * w4 + 4 * q) * 4) = akv[vt]; }
        if (pair + F.G < NITEM / 2) RA_REQUEST(pair + F.G);
        { const LAS unsigned char* aab = hbase + RA_AAB + (16 * w4) * 256 + (16 * w4) * 4;
          LAS unsigned char* ti = hbase + RA_BT;
          if (q == 0) { float t[16];
#pragma unroll
              for (int r_ = 0; r_ < 16; ++r_) { float acc = (r_ == n16) ? 1.0f : 0.0f;
#pragma unroll
                  for (int j4 = 0; j4 < (r_ + 3) / 4; ++j4) { const f32x4 av = *(const LAS f32x4*)(aab + r_ * 256 + j4 * 16);
#pragma unroll
                      for (int e = 0; e < 4; ++e) if (4 * j4 + e < r_) acc += av[e] * t[4 * j4 + e]; }
                  t[r_] = acc; *(LAS unsigned short*)(ti + w4 * 512 + r_ * 32 + 2 * n16) = (unsigned short)(pk2(acc, 0.f) & 0xffffu); } }
          __syncthreads();
          bf16x8 a10, a20, a30, a31, tf[4];
          { const LAS unsigned char* ab = hbase + RA_AAB + n16 * 256 + 16 * q; const f32x4 z4 = {0.f, 0.f, 0.f, 0.f};
            const f32x4 l10 = *(const LAS f32x4*)(ab + 16 * 256), l20 = *(const LAS f32x4*)(ab + 32 * 256), l21 = *(const LAS f32x4*)(ab + 32 * 256 + 64);
            const f32x4 l30 = *(const LAS f32x4*)(ab + 48 * 256), l31 = *(const LAS f32x4*)(ab + 48 * 256 + 64), l32 = *(const LAS f32x4*)(ab + 48 * 256 + 128);
            a10 = pack8(l10, z4); a20 = pack8(l20, l21); a30 = pack8(l30, l31); a31 = pack8(l32, z4);
#pragma unroll
            for (int I = 0; I < 4; ++I) { const v2u tw = *(const LAS v2u*)(ti + I * 512 + n16 * 32 + 8 * q); const v4u t4 = {tw.x, tw.y, 0u, 0u}; tf[I] = __builtin_bit_cast(bf16x8, t4); } }
          v4u xw[2][2];
#pragma unroll
          for (int m = 0; m < 2; ++m) {
              v4u x0 = {0u, 0u, 0u, 0u}, x1 = {0u, 0u, 0u, 0u};
#pragma unroll
              for (int I = 0; I < 4; ++I) {
                  f32x4 z;
                  if (m == 0) {
#pragma unroll
                      for (int i = 0; i < 4; ++i) z[i] = bf2f(*(const LAS unsigned short*)(hbase + RA_AT + (16 * I + 4 * q + i) * 144 + 2 * tokl)); }
                  else z = *(const LAS f32x4*)(hbase + RA_RHS2 + tokl * 272 + (16 * I + 4 * q) * 4);
                  if (I == 1) z = MFMA16(a10, __builtin_bit_cast(bf16x8, x0), z);
                  if (I == 2) z = MFMA16(a20, __builtin_bit_cast(bf16x8, x0), z);
                  if (I == 3) { z = MFMA16(a30, __builtin_bit_cast(bf16x8, x0), z); z = MFMA16(a31, __builtin_bit_cast(bf16x8, x1), z); }
                  const v4u zb = {pk2(z[0], z[1]), pk2(z[2], z[3]), 0u, 0u};
                  const f32x4 x = MFMA16(tf[I], __builtin_bit_cast(bf16x8, zb), ((f32x4){0.f, 0.f, 0.f, 0.f}));
                  const unsigned p0 = pk2(x[0], x[1]), p1 = pk2(x[2], x[3]);
                  if (I == 0) { x0.x = p0; x0.y = p1; } if (I == 1) { x0.z = p0; x0.w = p1; } if (I == 2) { x1.x = p0; x1.y = p1; } if (I == 3) { x1.z = p0; x1.w = p1; }
              }
              xw[m][0] = x0; xw[m][1] = x1;
          }
          __syncthreads();
#pragma unroll
          for (int s = 0; s < 2; ++s) { *(LAS v4u*)(hbase + RA_W1T + tokl * 144 + 64 * s + 16 * q) = xw[0][s]; *(LAS v4u*)(hbase + RA_W2T + tokl * 144 + 64 * s + 16 * q) = xw[1][s]; }
        }
        __syncthreads();
        {
          f32x4 pc[4], y0[4];
#pragma unroll
          for (int t = 0; t < 4; ++t) { pc[t] = (f32x4){bflo(rtp[t].x), bfhi(rtp[t].x), bflo(rtp[t].y), bfhi(rtp[t].y)}; y0[t] = (f32x4){0.f, 0.f, 0.f, 0.f};
#pragma unroll
              for (int s = 0; s < 2; ++s) { y0[t] = MFMA16(*(const LAS bf16x8*)(hbase + RA_VT + (16 * t + n16) * 144 + 64 * s + 16 * q), rkp[s], y0[t]);
                                            y0[t] = MFMA16(*(const LAS bf16x8*)(hbase + RA_W2T + (16 * t + n16) * 144 + 64 * s + 16 * q), rbp[s], y0[t]);
                                            pc[t] = MFMA16(*(const LAS bf16x8*)(hbase + RA_W1T + (16 * t + n16) * 144 + 64 * s + 16 * q), rbp[s], pc[t]); } }
#pragma unroll
          for (int vt = 0; vt < 4; ++vt) { v2u o; o.x = pk2(y0[vt][0], y0[vt][1]); o.y = pk2(y0[vt][2], y0[vt][3]); __builtin_nontemporal_store(o, (v2u*)(rbi + RB_YLT + ((w4 * 4 + vt) * 64 + l) * 8)); }
#pragma unroll
          for (int s = 0; s < 2; ++s) __builtin_nontemporal_store(pack8(pc[2 * s], pc[2 * s + 1]), (bf16x8*)(rbi + RB_PCT + ((w4 * 2 + s) * 64 + l) * 16));
          f32x4 mc[4]; bf16x8 fb[2], fvv[2];
#pragma unroll
          for (int s = 0; s < 2; ++s) { fb[s] = *(const LAS bf16x8*)(hbase + RA_BH + tokl * 144 + 64 * s + 16 * q); fvv[s] = *(const LAS bf16x8*)(hbase + RA_VT + tokl * 144 + 64 * s + 16 * q); }
          const float gend_k = *(const LAS float*)(hbase + RA_VT + tokl * 144 + 128);
#pragma unroll
          for (int t = 0; t < 4; ++t) { mc[t] = (f32x4){0.f, 0.f, 0.f, 0.f};
#pragma unroll
              for (int s = 0; s < 2; ++s) mc[t] = MFMA16(*(const LAS bf16x8*)(hbase + RA_W1T + (16 * t + n16) * 144 + 64 * s + 16 * q), fb[s], mc[t]);
              if (t == w4) {
#pragma unroll
                  for (int i = 0; i < 4; ++i) if (4 * q + i == n16) mc[t][i] += gend_k; } }
#pragma unroll
          for (int s = 0; s < 2; ++s) __builtin_nontemporal_store(pack8(mc[2 * s], mc[2 * s + 1]), (bf16x8*)(rbi + RB_MC + ((w4 * 2 + s) * 64 + l) * 16));
          bf16x8 fw2[2];
#pragma unroll
          for (int s = 0; s < 2; ++s) fw2[s] = *(const LAS bf16x8*)(hbase + RA_W2T + tokl * 144 + 64 * s + 16 * q);
#pragma unroll
          for (int kt = 0; kt < 4; ++kt) { f32x4 cc = {0.f, 0.f, 0.f, 0.f};
#pragma unroll
              for (int s = 0; s < 2; ++s) { cc = MFMA16(*(const LAS bf16x8*)(hbase + RA_KH + (16 * kt + n16) * 144 + 64 * s + 16 * q), fvv[s], cc);
                                            cc = MFMA16(*(const LAS bf16x8*)(hbase + RA_BH + (16 * kt + n16) * 144 + 64 * s + 16 * q), fw2[s], cc); }
              v2u cw; cw.x = pk2(cc[0], cc[1]); cw.y = pk2(cc[2], cc[3]); __builtin_nontemporal_store(cw, (v2u*)(rbi + RB_CC + ((w4 * 4 + kt) * 64 + l) * 8)); } }
    }
}

constexpr int RBK_NS = 9, RBK_D = 8, RBK_SLOT = 16384, RBK_BLOCKS = 32;
static_assert(RBK_NS * RBK_SLOT <= MISC_OFF && RBK_D == RBK_NS - 1, "phase B ring");
DI void rwkv_phase_b(const Frame& F, const Args& a) {
    if (F.bid >= RBK_BLOCKS) return;
    unsigned char* rb = a.ws + WS_RW; const int l = F.lane, w = F.wave;
    const int h = F.bid & 7, b = F.bid >> 3;
    LAS unsigned char* lds = F.lds;
    if (w >= 4) {
        const int j = w - 4;
#define RBK_ISSUE(cc_) do { const int c_ = (cc_) < NCHUNK ? (cc_) : NCHUNK - 1; const unsigned char* r_ = rb + (size_t)(((b * 128 + c_) << 3) + h) * RB_REC; \
            LAS unsigned char* slot_ = lds + ((cc_) % RBK_NS) * RBK_SLOT; \
            _Pragma("unroll") for (int k_ = 0; k_ < 4; ++k_) { const int blk_ = 4 * j + k_; \
                const unsigned char* src_ = blk_ < 8 ? r_ + RB_MC + blk_ * 1024 : r_ + RB_CC + (blk_ - 8) * 1024; \
                __builtin_amdgcn_global_load_lds((const unsigned*)(src_ + l * 16), (LAS unsigned*)(slot_ + blk_ * 1024), 16, 0, 0); } } while (0)
        for (int c = 0; c < RBK_D; ++c) RBK_ISSUE(c);
        for (int c = 0; c < NCHUNK; ++c) {
            asm volatile("s_waitcnt vmcnt(28)" ::: "memory");
            __builtin_amdgcn_s_barrier();
            RBK_ISSUE(c + RBK_D);
        }
        asm volatile("s_waitcnt vmcnt(0)" ::: "memory");
        __builtin_amdgcn_s_barrier();
#undef RBK_ISSUE
    } else {
        const int vs = w;
        f32x4 st[4];
#pragma unroll
        for (int kt = 0; kt < 4; ++kt) st[kt] = (f32x4){0.f, 0.f, 0.f, 0.f};
        for (int c = 0; c < NCHUNK; ++c) {
            unsigned char* rbi = rb + (size_t)(((b * 128 + c) << 3) + h) * RB_REC;
            bf16x8 sb[2];
#pragma unroll
            for (int s = 0; s < 2; ++s) { sb[s] = pack8(st[2 * s], st[2 * s + 1]); *(bf16x8*)(rbi + RB_SC + ((vs * 2 + s) * 64 + l) * 16) = sb[s]; }
            __builtin_amdgcn_s_barrier();
            const LAS unsigned char* slot = lds + (c % RBK_NS) * RBK_SLOT;
#pragma unroll
            for (int kt = 0; kt < 4; ++kt) { const v2u cw = *(const LAS v2u*)(slot + 8192 + ((vs * 4 + kt) * 64 + l) * 8);
                f32x4 n = {bflo(cw.x), bfhi(cw.x), bflo(cw.y), bfhi(cw.y)};
#pragma unroll
                for (int s = 0; s < 2; ++s) n = MFMA16(*(const LAS bf16x8*)(slot + ((kt * 2 + s) * 64 + l) * 16), sb[s], n);
                st[kt] = n; }
        }
        __builtin_amdgcn_s_barrier();
    }
}

struct RcOps { bf16x8 pc[2]; v2u yl[4]; bf16x8 sc[4][2]; v2u g1[4], e2[4]; };
DI void rc_load(RcOps& o, const unsigned char* rb, int task, int l) {
    const int item = task >> 2, it = task & 3; const unsigned char* rbi = rb + (size_t)item * RB_REC;
#pragma unroll
    for (int s = 0; s < 2; ++s) o.pc[s] = __builtin_nontemporal_load((const bf16x8*)(rbi + RB_PCT + ((it * 2 + s) * 64 + l) * 16));
#pragma unroll
    for (int vt = 0; vt < 4; ++vt) { const int fo = ((it * 4 + vt) * 64 + l) * 8;
        o.yl[vt] = __builtin_nontemporal_load((const v2u*)(rbi + RB_YLT + fo)); o.g1[vt] = __builtin_nontemporal_load((const v2u*)(rbi + RB_G1T + fo)); o.e2[vt] = __builtin_nontemporal_load((const v2u*)(rbi + RB_E2T + fo));
#pragma unroll
        for (int s = 0; s < 2; ++s) o.sc[vt][s] = __builtin_nontemporal_load((const bf16x8*)(rbi + RB_SC + ((vt * 2 + s) * 64 + l) * 16)); }
}
DI void rwkv_phase_c(const Frame& F, const Args& a) {
    const unsigned char* rb = a.ws + WS_RW; bf16* mix = (bf16*)(a.ws + WS_MIX);
    const int l = F.lane, n16 = l & 15, q = l >> 4;
    const int gw = F.bid * NWAVES + F.wave, NGW = F.G * NWAVES;
    RcOps cur, nxt;
    if (gw < NITEM * 4) rc_load(cur, rb, gw, l);
    for (int task = gw; task < NITEM * 4; task += NGW) {
        const int item = task >> 2, it = task & 3, h = item & 7, c = (item >> 3) & 127, b = item >> 10;
        if (task + NGW < NITEM * 4) rc_load(nxt, rb, task + NGW, l);
        f32x4 y[4]; float sum = 0.f;
#pragma unroll
        for (int vt = 0; vt < 4; ++vt) { y[vt] = (f32x4){bflo(cur.yl[vt].x), bfhi(cur.yl[vt].x), bflo(cur.yl[vt].y), bfhi(cur.yl[vt].y)};
#pragma unroll
            for (int s = 0; s < 2; ++s) y[vt] = MFMA16(cur.sc[vt][s], cur.pc[s], y[vt]);
            sum += (y[vt][0] + y[vt][1]) + (y[vt][2] + y[vt][3]); }
        sum += __shfl_xor(sum, 16); sum += __shfl_xor(sum, 32);
        const float mean = sum * (1.f / 64.f); float sq = 0.f;
#pragma unroll
        for (int vt = 0; vt < 4; ++vt) { y[vt] = y[vt] - mean; sq += (y[vt][0] * y[vt][0] + y[vt][1] * y[vt][1]) + (y[vt][2] * y[vt][2] + y[vt][3] * y[vt][3]); }
        sq += __shfl_xor(sq, 16); sq += __shfl_xor(sq, 32);
        const float rstd = 1.0f / sqrtf(sq * (1.f / 64.f) + 64e-5f);
        const size_t tok = (size_t)b * SEQ + c * 64 + 16 * it + n16;
#pragma unroll
        for (int vt = 0; vt < 4; ++vt) { const v2u g = cur.g1[vt], e = cur.e2[vt];
            v2u o; o.x = pk2(y[vt][0] * rstd * bflo(g.x) + bflo(e.x), y[vt][1] * rstd * bfhi(g.x) + bfhi(e.x)); o.y = pk2(y[vt][2] * rstd * bflo(g.y) + bflo(e.y), y[vt][3] * rstd * bfhi(g.y) + bfhi(e.y));
            *(v2u*)(mix + tok * 1024 + 512 + h * 64 + 16 * vt + 4 * q) = o; }
        cur = nxt;
    }
}
#endif

DI void p0_prologue(const Frame& F, const Args& a) {
    unsigned char* ws = a.ws;
    LAS float* scr = (LAS float*)(F.lds + F.wave * 16384);
    const int gw = F.bid * NWAVES + F.wave, NGW = F.G * NWAVES;
    constexpr int I_IN = 16 * 104, I_OUT = 16 * 32, I_DEC = 16, I_AAA = 16, I_GATE = 32;
    constexpr int NITEMS = I_IN + I_OUT + I_DEC + I_AAA + I_GATE;
    for (int it = gw; it < NITEMS; it += NGW) {
        int r = it;
        if (r < I_IN) { const int kb = r / 104, nb = r % 104; tr_item(a.in[I_WIN], INC, 64 * kb, 32 * nb, (bf16*)(ws + WS_WIN), 1024, 32 * nb, scr, F.lane, nullptr); continue; } r -= I_IN;
        if (r < I_OUT) { const int kb = r / 32, nb = r % 32; tr_item(a.in[I_WOUT], 1024, 64 * kb, 32 * nb, (bf16*)(ws + WS_WOUT), 1024, 32 * nb, scr, F.lane, nullptr); continue; } r -= I_OUT;
        if (r < I_DEC) { tr_item(a.in[I_WDEC], 512, 0, 32 * r, (bf16*)(ws + WS_WDEC), 64, 32 * r, scr, F.lane, nullptr); continue; } r -= I_DEC;
        if (r < I_AAA) { tr_item(a.in[I_WAAA], 512, 0, 32 * r, (bf16*)(ws + WS_WAAA), 64, 32 * r, scr, F.lane, nullptr); continue; } r -= I_AAA;
        { const int kb = r / 16, nb = r % 16; tr_item(a.in[I_WGATE], 512, 64 * kb, 32 * nb, (bf16*)(ws + WS_WGATE), 128, 32 * nb, scr, F.lane, nullptr); }
    }
    { float* wrt = (float*)(ws + WS_WRT); const float* wr = a.in[I_WR]; const float* g2 = a.in[I_N2G];
      for (int i = F.bid * 512 + F.tid; i < 32 * 1024; i += F.G * 512) { const int e = i >> 10, k = i & 1023; wrt[i] = g2[k] * wr[k * 32 + e]; } }
    { float* par = (float*)(ws + WS_PAR); const int srcs[7] = {I_W0, I_A0, I_KK, I_KA, I_RK, I_LNG, I_LNB};
      for (int i = F.bid * 512 + F.tid; i < 7 * 512; i += F.G * 512) { const int k = i >> 9; float v = 0.f;
#pragma unroll
          for (int j = 0; j < 7; ++j) if (k == j) v = a.in[srcs[j]][i & 511];
          par[i] = v; } }
    { const float* x = a.in[I_X]; const float* g1 = a.in[I_N1G]; bf16* xn = (bf16*)(ws + WS_XN);
      f32x4 gv[4];
#pragma unroll
      for (int j = 0; j < 4; ++j) gv[j] = *((const f32x4*)g1 + F.lane + 64 * j);
      for (int m0 = 2 * gw; m0 < T; m0 += 2 * NGW) {
          f32x4 v[2][4];
#pragma unroll
          for (int r = 0; r < 2; ++r) { const f32x4* xr = (const f32x4*)(x + (size_t)(m0 + r) * D) + F.lane;
#pragma unroll
              for (int j = 0; j < 4; ++j) v[r][j] = __builtin_nontemporal_load(xr + 64 * j); }
#pragma unroll
          for (int r = 0; r < 2; ++r) { float s = 0.f;
#pragma unroll
              for (int j = 0; j < 4; ++j) s += (v[r][j].x * v[r][j].x + v[r][j].y * v[r][j].y) + (v[r][j].z * v[r][j].z + v[r][j].w * v[r][j].w);
              const float rs = 1.0f / sqrtf(wave_sum(s) * (1.f / D) + 1e-6f);
              v2u* o8 = (v2u*)(xn + (size_t)(m0 + r) * D) + F.lane;
#pragma unroll
              for (int j = 0; j < 4; ++j) { v2u o; o.x = pk2(v[r][j].x * rs * gv[j].x, v[r][j].y * rs * gv[j].y); o.y = pk2(v[r][j].z * rs * gv[j].z, v[r][j].w * rs * gv[j].w); o8[64 * j] = o; } }
      } }
}

#if NAIVE_RWKV
DI void rwkv_naive_prep(const Frame& F, const Args& a) {
    const bf16* proj = (const bf16*)(a.ws + WS_PROJ); LAS float* sx = (LAS float*)F.lds;
    float* RW = (float*)(a.ws + WS_RW); float* GG = (float*)(a.ws + WS_XN);
    const float* mu = a.in[I_MU]; const int c = F.tid;
    for (int t = F.bid; t < T; t += F.G) {
        const bool first = (t % SEQ) == 0; const bf16* cur = proj + (size_t)t * INC + PRW; const bf16* prv = cur - INC;
#define SH_(col) ({ const float x_ = bf2f(cur[col]); const float p_ = first ? 0.f : bf2f(prv[col]); x_ + (p_ - x_) * mu[col]; })
        if (c < 256) { const float v = SH_(1536 + c); sx[c] = c < 64 ? tanhf(v) : (c < 128 ? v : sigmoidf_(v)); }
        __syncthreads();
        const float r = SH_(c), k = SH_(512 + c), v = SH_(1024 + c);
#undef SH_
        float wl = a.in[I_W0][c], al = a.in[I_A0][c], g = 0.f;
        const float* wdec = a.in[I_WDEC] + c; const float* waaa = a.in[I_WAAA] + c; const float* wgate = a.in[I_WGATE] + c;
#pragma unroll 4
        for (int j = 0; j < 64; ++j) { wl += sx[j] * wdec[j * 512]; al += sx[64 + j] * waaa[j * 512]; }
#pragma unroll 4
        for (int j = 0; j < 128; ++j) g += sx[128 + j] * wgate[j * 512];
        const float dec = __expf(-0.6065306597126334f * sigmoidf_(wl)), av = sigmoidf_(al);
        float kk = k * a.in[I_KK][c]; const float n2 = wave_sum(kk * kk); kk = kk / fmaxf(sqrtf(n2), 1e-12f);
        const float k2 = k * (1.0f + (av - 1.0f) * a.in[I_KA][c]);
        const size_t o = (size_t)t * 512 + c; const size_t S1 = (size_t)T * 512;
        RW[o] = r; RW[S1 + o] = dec; RW[2 * S1 + o] = k2; RW[3 * S1 + o] = v; RW[4 * S1 + o] = kk; RW[5 * S1 + o] = av; GG[o] = g;
        __syncthreads();
    }
}
DI void rwkv_naive_scan(const Frame& F, const Args& a) {
    if (F.bid >= 32 || F.wave != 0) return;
    const int b = F.bid >> 3, h = F.bid & 7, l = F.lane, c = h * 64 + l;
    const float* RW = (const float*)(a.ws + WS_RW); const float* GG = (const float*)(a.ws + WS_XN); bf16* mix = (bf16*)(a.ws + WS_MIX);
    const size_t S1 = (size_t)T * 512; LAS float* sh = (LAS float*)F.lds;
    LAS float* st = sh + 512 + l;
    for (int k = 0; k < 64; ++k) st[64 * k] = 0.f;
    const float rk = a.in[I_RK][c], lg = a.in[I_LNG][c], lb = a.in[I_LNB][c];
    for (int s = 0; s < SEQ; ++s) {
        const size_t o = (size_t)(b * SEQ + s) * 512 + c;
        const float r = RW[o], w = RW[S1 + o], k2 = RW[2 * S1 + o], v = RW[3 * S1 + o], kk = RW[4 * S1 + o], av = RW[5 * S1 + o], g = GG[o];
        sh[l] = r; sh[64 + l] = w; sh[128 + l] = k2; sh[192 + l] = kk; sh[256 + l] = kk * av;
        LDS_WAIT();
        float sa = 0.f;
#pragma unroll 8
        for (int k = 0; k < 64; ++k) sa -= st[64 * k] * sh[192 + k];
        float y = 0.f;
#pragma unroll 8
        for (int k = 0; k < 64; ++k) { const float nv = st[64 * k] * sh[64 + k] + sa * sh[256 + k] + v * sh[128 + k]; st[64 * k] = nv; y += nv * sh[k]; }
        LDS_WAIT();
        const float mean = wave_sum(y) * (1.f / 64.f); const float d = y - mean; const float var = wave_sum(d * d) * (1.f / 64.f);
        const float yn = d * (1.0f / sqrtf(var + 64e-5f));
        const float bonus = wave_sum(r * k2 * rk) * v;
        const float outv = (yn * lg + lb + bonus) * g;
        mix[(size_t)(b * SEQ + s) * 1024 + 512 + c] = (bf16)(pk2(outv, 0.f) & 0xffffu);
    }
}
#endif
#if NAIVE_ATT
DI void attn_naive(const Frame& F, const Args& a) {
    const bf16* proj = (const bf16*)(a.ws + WS_PROJ); bf16* mix = (bf16*)(a.ws + WS_MIX);
    LAS float* sq = (LAS float*)(F.lds + F.wave * 1024);
    const int gw = F.bid * NWAVES + F.wave, NGW = F.G * NWAVES, l = F.lane;
    const float qg = a.in[I_QG][l];
    for (int it = gw; it < T * 8; it += NGW) {
        const int t = it >> 3, h = it & 7, b = t / SEQ, s = t % SEQ, n = s >> 6;
        const float qd = bf2f(proj[(size_t)t * INC + h * 64 + l]);
        const float qn = qd * (1.0f / sqrtf(wave_sum(qd * qd) * (1.f / 64.f) + 1e-6f)) * qg * 0.125f;
        sq[l] = qn; LDS_WAIT();
        float sc[9]; float mx = -3.0e38f;
#pragma unroll
        for (int r = 0; r < 9; ++r) {
            const int kp = (n - 8) * 64 + 64 * r + l; float v = -3.0e38f;
            if (kp >= 0) {
                const v4u* kr = (const v4u*)(proj + (size_t)(b * SEQ + kp) * INC + 512 + h * 64);
                float ss = 0.f, dot = 0.f;
#pragma unroll
                for (int j = 0; j < 8; ++j) { const v4u w = kr[j]; const unsigned ww[4] = {w.x, w.y, w.z, w.w};
#pragma unroll
                    for (int e = 0; e < 4; ++e) { const float k0 = bflo(ww[e]), k1 = bfhi(ww[e]); const int d0 = 8 * j + 2 * e;
                        ss += k0 * k0 + k1 * k1; dot += sq[d0] * a.in[I_KG][d0] * k0 + sq[d0 + 1] * a.in[I_KG][d0 + 1] * k1; } }
                int rel = kp - s; rel = rel < -128 ? -128 : (rel > 63 ? 63 : rel);
                v = dot * (1.0f / sqrtf(ss * (1.f / 64.f) + 1e-6f)) + a.in[I_RELB][h * 192 + rel + 128];
            }
            sc[r] = v; mx = fmaxf(mx, v);
        }
        mx = wave_max(mx); float sum = 0.f;
#pragma unroll
        for (int r = 0; r < 9; ++r) { sc[r] = (sc[r] > -1.0e38f) ? __expf(sc[r] - mx) : 0.f; sum += sc[r]; }
        sum = wave_sum(sum);
        float o = 0.f;
#pragma unroll
        for (int r = 0; r < 9; ++r) {
            const int kp0 = (n - 8) * 64 + 64 * r;
            if (kp0 >= 0) {
                const bf16* vp = proj + (size_t)(b * SEQ + kp0) * INC + 1024 + h * 64 + l;
                for (int key = 0; key < 64; ++key) o += __shfl(sc[r], key) * bf2f(vp[(size_t)key * INC]);
            }
        }
        mix[(size_t)t * 1024 + h * 64 + l] = (bf16)(pk2(o / sum, 0.f) & 0xffffu);
        LDS_WAIT();
    }
}
#endif

DI void p6_router(const Frame& F, const Args& a) {
    unsigned char* ws = a.ws; const bf16* x1 = (const bf16*)(ws + WS_XN); const float* wrt = (const float*)(ws + WS_WRT); const float* br = a.in[I_BR];
    int* eidx = (int*)(ws + WS_EIDX); float* gate = (float*)(ws + WS_GATE); int* lrank = (int*)(ws + WS_LRANK); float* rstd = (float*)(ws + WS_RSTD); int* cnt = (int*)(ws + WS_CNT);
    constexpr int WROW = 2064, WIMG = 32 * WROW;
    LAS int* hist = (LAS int*)(F.lds + 2 * WIMG);
    const int n = F.lane & 15, q = F.lane >> 4;
    for (int i = F.tid; i < 32 * 256; i += NWAVES * 64) { const int e = i >> 8, c4 = i & 255; const f32x4 w = *((const f32x4*)(wrt + (size_t)e * D) + c4);
        v2u hi, lo; hi.x = pk2(w[0], w[1]); hi.y = pk2(w[2], w[3]);
        lo.x = pk2(w[0] - bflo(hi.x), w[1] - bfhi(hi.x)); lo.y = pk2(w[2] - bflo(hi.y), w[3] - bfhi(hi.y));
        *(LAS v2u*)(F.lds + e * WROW + c4 * 8) = hi; *(LAS v2u*)(F.lds + WIMG + e * WROW + c4 * 8) = lo; }
    __syncthreads();
    for (int tile = F.bid; tile < T / 128; tile += F.G) {
        if (F.tid < 32) hist[F.tid] = 0;
        __syncthreads();
        const int tok = tile * 128 + F.wave * 16 + n;
        const v4u* xr = (const v4u*)(x1 + (size_t)tok * D) + q; const LAS unsigned char* w0 = F.lds + n * WROW + 16 * q;
        f32x4 acc0 = {0.f, 0.f, 0.f, 0.f}, acc1 = {0.f, 0.f, 0.f, 0.f}; float ssq = 0.f;
        for (int S0 = 0; S0 < 32; S0 += 16) {
            v4u xw[16];
#pragma unroll
            for (int s = 0; s < 16; ++s) xw[s] = xr[4 * (S0 + s)];
#pragma unroll
            for (int s = 0; s < 16; ++s) { const bf16x8 xb8 = __builtin_bit_cast(bf16x8, xw[s]); const LAS unsigned char* wp = w0 + (S0 + s) * 64;
                const unsigned u[4] = {xw[s].x, xw[s].y, xw[s].z, xw[s].w};
#pragma unroll
                for (int j = 0; j < 4; ++j) { const float a = bflo(u[j]), b = bfhi(u[j]); ssq += a * a + b * b; }
                acc0 = __builtin_amdgcn_mfma_f32_16x16x32_bf16(*(const LAS bf16x8*)(wp), xb8, acc0, 0, 0, 0);
                acc0 = __builtin_amdgcn_mfma_f32_16x16x32_bf16(*(const LAS bf16x8*)(wp + WIMG), xb8, acc0, 0, 0, 0);
                acc1 = __builtin_amdgcn_mfma_f32_16x16x32_bf16(*(const LAS bf16x8*)(wp + 16 * WROW), xb8, acc1, 0, 0, 0);
                acc1 = __builtin_amdgcn_mfma_f32_16x16x32_bf16(*(const LAS bf16x8*)(wp + WIMG + 16 * WROW), xb8, acc1, 0, 0, 0); }
        }
        ssq += __shfl_xor(ssq, 16); ssq += __shfl_xor(ssq, 32);
        const float rs = 1.0f / sqrtf(ssq * (1.f / D) + 1e-6f);
        float lg[8];
#pragma unroll
        for (int i = 0; i < 4; ++i) { lg[i] = acc0[i] * rs + br[4 * q + i]; lg[4 + i] = acc1[i] * rs + br[16 + 4 * q + i]; }
        float tv[4]; int ti[4];
#pragma unroll
        for (int r = 0; r < 4; ++r) {
            float bv = -3.0e38f; int bi = 0;
#pragma unroll
            for (int j = 0; j < 8; ++j) { const int e = (j < 4 ? 0 : 16) + 4 * q + (j & 3); if (lg[j] > bv) { bv = lg[j]; bi = e; } }
#pragma unroll
            for (int o = 16; o <= 32; o <<= 1) { const float ov = __shfl_xor(bv, o); const int oi = __shfl_xor(bi, o); if (ov > bv || (ov == bv && oi < bi)) { bv = ov; bi = oi; } }
            tv[r] = bv; ti[r] = bi;
#pragma unroll
            for (int j = 0; j < 8; ++j) { const int e = (j < 4 ? 0 : 16) + 4 * q + (j & 3); if (e == bi) lg[j] = -3.0e38f; }
        }
        if (q == 0) {
            const float e1 = __expf(tv[1] - tv[0]), e2 = __expf(tv[2] - tv[0]), e3 = __expf(tv[3] - tv[0]); const float inv = 1.0f / (1.0f + e1 + e2 + e3);
            int lr[4];
#pragma unroll
            for (int r = 0; r < 4; ++r) lr[r] = atomicAdd((int*)&hist[ti[r]], 1);
            *(int4*)(eidx + (size_t)tok * 4) = make_int4(ti[0], ti[1], ti[2], ti[3]);
            *(float4*)(gate + (size_t)tok * 4) = make_float4(inv, e1 * inv, e2 * inv, e3 * inv);
            *(int4*)(lrank + (size_t)tok * 4) = make_int4(lr[0], lr[1], lr[2], lr[3]);
            rstd[tok] = rs;
        }
        __syncthreads();
        if (F.tid < 32) cnt[tile * 32 + F.tid] = hist[F.tid];
        __syncthreads();
    }
}

DI void p7_permute(const Frame& F, const Args& a) {
    unsigned char* ws = a.ws; const int* cnt = (const int*)(ws + WS_CNT); int* meta = (int*)(ws + WS_META);
    const int* eidx = (const int*)(ws + WS_EIDX); const int* lrank = (const int*)(ws + WS_LRANK); int* inv = (int*)(ws + WS_INV);
    const float* rstd = (const float*)(ws + WS_RSTD); float* rowrstd = (float*)(ws + WS_ROWRSTD);
    bf16* xb = (bf16*)(ws + WS_XN); int* rowtok = (int*)(ws + WS_ROWTOK);
    LAS int* s_tot = (LAS int*)F.lds; LAS int* s_pst = s_tot + 32; LAS int* s_base = s_tot + 64; LAS int* s_part = s_tot + 128;
    { const int e = F.tid & 31, part = F.tid >> 5; int s = 0; for (int t = part * 16; t < part * 16 + 16; ++t) s += cnt[t * 32 + e]; s_part[part * 32 + e] = s; }
    __syncthreads();
    if (F.tid < 32) { int s = 0; for (int p = 0; p < 16; ++p) s += s_part[p * 32 + F.tid]; s_tot[F.tid] = s; }
    __syncthreads();
    if (F.tid < 32) { int ps = 0; for (int e = 0; e < F.tid; ++e) ps += (s_tot[e] + 255) / 256 * 256; s_pst[F.tid] = ps; }
    __syncthreads();
    if (F.bid == 0 && F.tid < 32) { const int e = F.tid, nb = (s_tot[e] + 255) / 256, rb0 = s_pst[e] / 256; for (int i = 0; i < nb; ++i) meta[16 + rb0 + i] = e; if (e == 31) meta[0] = rb0 + nb; }
    if (F.bid < 32) { const int e = F.bid, r0 = s_pst[e] + s_tot[e], r1 = s_pst[e] + (s_tot[e] + 255) / 256 * 256;
        for (int r = r0 + F.tid; r < r1; r += NWAVES * 64) { rowtok[r] = T; rowrstd[r] = 0.f; } }
    if (F.bid == 0 && F.tid < 128) { const v4u z = {0u, 0u, 0u, 0u}; *((v4u*)(xb + (size_t)T * D) + F.tid) = z; }
    for (int tile = F.bid; tile < T / 128; tile += F.G) {
        __syncthreads();
        if (F.tid < 32) { int s = 0; for (int t = 0; t < tile; ++t) s += cnt[t * 32 + F.tid]; s_base[F.tid] = s_pst[F.tid] + s; }
        __syncthreads();
        { const int i = F.tid;
            const int tok = tile * 128 + (i >> 2), k = i & 3; const int e = eidx[tok * 4 + k]; const int dest = s_base[e] + lrank[tok * 4 + k];
            inv[tok * 4 + k] = dest; rowtok[dest] = tok; rowrstd[dest] = rstd[tok];
        }
    }
}

DI void p10_combine(const Frame& F, const Args& a) {
    unsigned char* ws = a.ws; const int* inv = (const int*)(ws + WS_INV); const float* gate = (const float*)(ws + WS_GATE); const bf16* yr = (const bf16*)(ws + WS_YR); const bf16* xb = (const bf16*)(ws + WS_XN); float* out = a.out;
    const int gw = F.bid * NWAVES + F.wave, NGW = F.G * NWAVES;
    for (int t = gw; t < T; t += NGW) {
        const int4 iv = *(const int4*)(inv + (size_t)t * 4); const float4 gv = *(const float4*)(gate + (size_t)t * 4);
        const int rows[4] = {iv.x, iv.y, iv.z, iv.w}; const float gs[4] = {gv.x, gv.y, gv.z, gv.w};
        f32x4* o = (f32x4*)(out + (size_t)t * D) + F.lane; const v2u* xr = (const v2u*)(xb + (size_t)t * D) + F.lane;
#pragma unroll
        for (int j = 0; j < 4; ++j) {
            const v2u xw = xr[64 * j]; f32x4 acc = {bflo(xw.x), bfhi(xw.x), bflo(xw.y), bfhi(xw.y)};
#pragma unroll
            for (int k = 0; k < 4; ++k) { const v2u w = __builtin_nontemporal_load((const v2u*)(yr + (size_t)rows[k] * D) + F.lane + 64 * j);
                acc.x += gs[k] * bflo(w.x); acc.y += gs[k] * bfhi(w.x); acc.z += gs[k] * bflo(w.y); acc.w += gs[k] * bfhi(w.y); }
            __builtin_nontemporal_store(acc, o + 64 * j);
        }
    }
}

constexpr int N_PHASES = 11;
__global__ void __launch_bounds__(NWAVES * 64, 2) fwd(Args args) {
    extern __shared__ __attribute__((aligned(16))) unsigned char lds[];
    Frame F;
    F.lds = (LAS unsigned char*)lds;
    F.tid = threadIdx.x; F.lane = F.tid & 63; F.wave = __builtin_amdgcn_readfirstlane(F.tid >> 6);
    F.G = gridDim.x; F.bid = blockIdx.x;
    volatile LAS unsigned* MISC = (volatile LAS unsigned*)(F.lds + MISC_OFF);
    if (F.tid < 64) MISC[F.tid] = 0u;
    __syncthreads();
    unsigned char* ws = args.ws;
    unsigned* ctl = (unsigned*)(ws + WS_CTL);
    XcdBarrier bar; bar.bar = ctl + CW_BAR; bar.x = 0; bar.st = nullptr;
    if (MK_N_LAUNCHES == 1) bar = xcd_barrier_post(ctl + CW_BAR, MISC + 8);
    const int lo = args.ph_lo, hi = args.ph_hi;
#ifndef PHASE_MASK
#define PHASE_MASK 0xffff
#endif
#define IN(k) (((PHASE_MASK >> (k)) & 1) && lo <= (k) && (k) < hi)
#ifndef DUP_PHASE
#define DUP_PHASE -1
#endif
#define REPS(k) ((DUP_PHASE >= 0 && (k) == DUP_PHASE) ? args.ph_rep : 1)
#define SEAM(k) do { if (IN(k) && IN((k) + 1)) xcd_barrier(bar); { int t_ = threadIdx.x; asm volatile("" : "+v"(t_)); F.tid = t_; F.lane = t_ & 63; } } while (0)

    for (int rep_ = 0; rep_ < REPS(0); ++rep_) { if (rep_) xcd_barrier(bar);
    if (IN(0)) { p0_prologue(F, args); } } SEAM(0);

    for (int rep_ = 0; rep_ < REPS(1); ++rep_) { if (rep_) xcd_barrier(bar);
    if (IN(1)) {
        pg8::Gemm g{(const bf16*)(ws + WS_XN), (const bf16*)(ws + WS_WIN), T, INC, D}; pg8::StaticOrder S; S.init(T, INC, F.G, F.bid);
        pg8::EpiBf16 E{(bf16*)(ws + WS_PROJ), INC};
        pg8::gemm_phase<pg8::EpiBf16, pg8::StaticOrder, true, true>(F.lds, g, S, E);
    } } SEAM(1);

    for (int rep_ = 0; rep_ < REPS(2); ++rep_) { if (rep_) xcd_barrier(bar);
    if (IN(2)) {
#if NAIVE_RWKV
        rwkv_naive_prep(F, args);
#else
        rwkv_phase_a(F, args);
#endif
    } } SEAM(2);

    for (int rep_ = 0; rep_ < REPS(3); ++rep_) { if (rep_) xcd_barrier(bar);
    if (IN(3)) {
#if NAIVE_RWKV
        rwkv_naive_scan(F, args);
#else
        rwkv_phase_b(F, args);
#endif
        __syncthreads();
#if NAIVE_ATT
        attn_naive(F, args);
#else
        attn_phase(F, args, rep_);
#endif
    } } SEAM(3);

    for (int rep_ = 0; rep_ < REPS(4); ++rep_) { if (rep_) xcd_barrier(bar);
    if (IN(4)) {
#if !NAIVE_RWKV
        rwkv_phase_c(F, args);
#endif
    } } SEAM(4);

    for (int rep_ = 0; rep_ < REPS(5); ++rep_) { if (rep_) xcd_barrier(bar);
    if (IN(5)) {
        pg8::Gemm g{(const bf16*)(ws + WS_MIX), (const bf16*)(ws + WS_WOUT), T, D, D}; pg8::StaticOrder S; S.init(T, D, F.G, F.bid);
        pg8::EpiResid E{args.in[I_X], nullptr, (bf16*)(ws + WS_XN), D};
        pg8::gemm_phase<pg8::EpiResid, pg8::StaticOrder, true, true>(F.lds, g, S, E);
    } } SEAM(5);

    for (int rep_ = 0; rep_ < REPS(6); ++rep_) { if (rep_) xcd_barrier(bar);
    if (IN(6)) { p6_router(F, args); } } SEAM(6);
    for (int rep_ = 0; rep_ < REPS(7); ++rep_) { if (rep_) xcd_barrier(bar);
    if (IN(7)) { p7_permute(F, args); } } SEAM(7);

    for (int rep_ = 0; rep_ < REPS(8); ++rep_) { if (rep_) xcd_barrier(bar);
    if (IN(8)) {
        pg8::Gemm g{(const bf16*)(ws + WS_XN), (const bf16*)(ws + WS_WUP), NROWS_MAX, 2048, D}; pg8::MoeOrder S{(const int*)(ws + WS_META), 8, F.G, F.bid, (const int*)(ws + WS_ROWTOK)};
        pg8::EpiSwiGLU E{(bf16*)(ws + WS_ACT), args.in[I_BUP], (const float*)(ws + WS_ROWRSTD)};
        pg8::gemm_phase<pg8::EpiSwiGLU, pg8::MoeOrder, true, true>(F.lds, g, S, E);
    } } SEAM(8);

    for (int rep_ = 0; rep_ < REPS(9); ++rep_) { if (rep_) xcd_barrier(bar);
    if (IN(9)) {
        pg8::Gemm g{(const bf16*)(ws + WS_ACT), (const bf16*)(ws + WS_WDN), NROWS_MAX, 1024, D}; pg8::MoeOrder S{(const int*)(ws + WS_META), 4, F.G, F.bid, nullptr};
        pg8::EpiDown E{(bf16*)(ws + WS_YR), args.in[I_BDN]};
        pg8::gemm_phase<pg8::EpiDown, pg8::MoeOrder, true, true>(F.lds, g, S, E);
    } } SEAM(9);

    if (IN(10)) { p10_combine(F, args); }
#undef IN
#undef SEAM
}

extern "C" void kernel_launch(void* const* d_in, const int* in_sizes, int n_in, void* d_out, int out_size, void* d_ws, size_t ws_size, hipStream_t stream) {
    static int grid = 0;
    if (grid == 0) {
        if (n_in != 25 || out_size != T * D || ws_size < WS_END) { fprintf(stderr, "kernel_launch: unexpected shapes (n_in %d out %d ws %zu)\n", n_in, out_size, ws_size); grid = -1; return; }
        int dev = 0, cus = 0, per_cu = 0;
        if (hipGetDevice(&dev) != hipSuccess || hipDeviceGetAttribute(&cus, hipDeviceAttributeMultiprocessorCount, dev) != hipSuccess) { grid = -1; return; }
        if (hipFuncSetAttribute((const void*)fwd, hipFuncAttributeMaxDynamicSharedMemorySize, LDS_BYTES) != hipSuccess) { fprintf(stderr, "kernel_launch: hipFuncSetAttribute failed\n"); grid = -1; return; }
        if (hipOccupancyMaxActiveBlocksPerMultiprocessor(&per_cu, (const void*)fwd, NWAVES * 64, LDS_BYTES) != hipSuccess || per_cu < 1) { fprintf(stderr, "kernel_launch: occupancy query says %d\n", per_cu); }
        (void)hipGetLastError();
        grid = cus;
    }
    if (grid < 0) return;
    (void)hipMemsetAsync((char*)d_ws + WS_CTL, 0, CTL_ZERO_BYTES, stream);
    Args a{};
    for (int i = 0; i < 25; ++i) a.in[i] = (const float*)d_in[i];
    a.out = (float*)d_out; a.ws = (unsigned char*)d_ws;
#if MK_N_LAUNCHES == 1
    a.ph_lo = 0; a.ph_hi = N_PHASES; a.ph_rep = 2;
    hipLaunchKernelGGL(fwd, dim3(grid), dim3(NWAVES * 64), LDS_BYTES, stream, a);
#else
    for (int p = 0; p < N_PHASES; ++p) { a.ph_lo = p; a.ph_hi = p + 1; hipLaunchKernelGGL(fwd, dim3(grid), dim3(NWAVES * 64), LDS_BYTES, stream, a); }
#endif
}
```

```cpp
#define NAIVE_RWKV 0
#define NAIVE_ATT 0
#define MK_N_LAUNCHES 1
#include <hip/hip_runtime.h>
#include <cstdio>
#include <cstdint>

#ifndef MK_N_LAUNCHES
#define MK_N_LAUNCHES 1
#endif
#ifndef NAIVE_RWKV
#define NAIVE_RWKV 0
#endif
#ifndef NAIVE_ATT
#define NAIVE_ATT 0
#endif

namespace pg8 {
#define PG8_LAS __attribute__((address_space(3)))
typedef unsigned short bf16_t;
typedef short bf16x8 __attribute__((ext_vector_type(8)));
typedef float f32x4 __attribute__((ext_vector_type(4)));
typedef unsigned u32x4 __attribute__((ext_vector_type(4)));
typedef unsigned u32x2 __attribute__((ext_vector_type(2)));
typedef float f32x2e __attribute__((ext_vector_type(2)));
typedef int i32x4 __attribute__((ext_vector_type(4)));
constexpr int BM = 256, BK = 64, HALF = 128, HTB = HALF * BK * 2  , STAGE_BYTES = 8 * HTB, NXCD = 8, WGM = 8;

__host__ __device__ __forceinline__ int lds_byte(int r, int c) { const int st = (r >> 4) * 2 + (c >> 5), rr = r & 15, cc = c & 31, ob = rr * 64 + cc * 2; return st * 1024 + (ob ^ (((ob >> 9) & 1) << 5)); }
__host__ __device__ __forceinline__ void stage_rc(int b, int& R, int& C) { const int st = b / 1024, sb = b % 1024, swz = sb ^ (((sb >> 9) & 1) << 5); R = (st >> 1) * 16 + swz / 64; C = (st & 1) * 32 + (swz % 64) / 2; }
__host__ __device__ __forceinline__ int perm32(int rho) { const int n = rho >> 4, i = rho & 15; return 8 * (i >> 2) + 4 * n + (i & 3); }

struct Unit { int pm, pn, e; };
struct Gemm { const bf16_t* A; const bf16_t* Bt; int M, N, K; };

__device__ __forceinline__ bool tile_of(int i, int G, int c, int nM, int nN, int& pm, int& pn) {
    const int nwg = nM * nN; const long L = (long)i * G + c; if (L >= nwg) return false;
    int wgid = (int)L; { const int q = nwg / NXCD, r = nwg % NXCD, xcd = wgid % NXCD, off = wgid / NXCD; wgid = (xcd < r ? xcd * (q + 1) : r * (q + 1) + (xcd - r) * q) + off; }
    const int nig = WGM * nN, gid = wgid / nig, fm = gid * WGM, gsz = (nM - fm) < WGM ? (nM - fm) : WGM;
    pm = fm + ((wgid % nig) % gsz); pn = (wgid % nig) / gsz; return true;
}
struct StaticOrder {
    int nM, nN, G, c;
    __device__ void init(int M, int N, int G_, int c_) { nM = M / BM; nN = N / BM; G = G_; c = c_; }
    __device__ __forceinline__ bool next(int i, Unit& u) const { u.e = 0; return tile_of(i, G, c, nM, nN, u.pm, u.pn); }
    __device__ __forceinline__ const char* a_base(const Gemm& g, const Unit& u) const { return (const char*)g.A + (size_t)u.pm * BM * g.K * 2; }
    __device__ __forceinline__ const char* b_base(const Gemm& g, const Unit& u) const { return (const char*)g.Bt + (size_t)u.pn * BM * g.K * 2; }
    __device__ __forceinline__ void a_off(const Gemm& g, const Unit&, const int (&R)[2], const int (&C)[2], unsigned (&vo)[2][2]) const {
#pragma unroll
        for (int h = 0; h < 2; ++h)
#pragma unroll
            for (int i = 0; i < 2; ++i) vo[h][i] = (unsigned)((h * HALF + R[i]) * g.K + C[i]) * 2u; }
    __device__ __forceinline__ void a_ready(const Unit&) const {}
    __device__ __forceinline__ void done(const Unit&) const {}
};
struct MoeOrder {
    const int* meta; int nN, G, c;
    __device__ __forceinline__ bool next(int i, Unit& u) const {
        const int nM = __builtin_amdgcn_readfirstlane(meta[0]);
        if (!tile_of(i, G, c, nM, nN, u.pm, u.pn)) return false;
        u.e = __builtin_amdgcn_readfirstlane(meta[16 + u.pm]); return true;
    }
    const int* rowtok;
    __device__ __forceinline__ const char* a_base(const Gemm& g, const Unit& u) const { return rowtok ? (const char*)g.A : (const char*)g.A + (size_t)u.pm * BM * g.K * 2; }
    __device__ __forceinline__ const char* b_base(const Gemm& g, const Unit& u) const { return (const char*)g.Bt + ((size_t)u.e * g.N + (size_t)u.pn * BM) * g.K * 2; }
    __device__ __forceinline__ void a_off(const Gemm& g, const Unit& u, const int (&R)[2], const int (&C)[2], unsigned (&vo)[2][2]) const {
#pragma unroll
        for (int h = 0; h < 2; ++h)
#pragma unroll
            for (int i = 0; i < 2; ++i) { const int r = h * HALF + R[i]; vo[h][i] = (unsigned)((rowtok ? rowtok[u.pm * BM + r] : r) * g.K + C[i]) * 2u; } }
    __device__ __forceinline__ void a_ready(const Unit&) const {}
    __device__ __forceinline__ void done(const Unit&) const {}
};

__device__ __forceinline__ unsigned cvt_pk_bf16(float lo, float hi) { unsigned r; asm volatile("v_cvt_pk_bf16_f32 %0, %1, %2" : "=v"(r) : "v"(lo), "v"(hi)); return r; }

struct EpiBf16 {
    static constexpr bool PERM = true, AFTER_DRAIN = false, I8 = false;
    bf16_t* O; int ldc;
    __device__ __forceinline__ void operator()(const f32x4 (&acc)[2][2][4][2], const Unit& u, int wr, int wc, int fr, int fq) const {
        const int row0 = u.pm * BM + wr * 64 + fr, col0 = u.pn * BM + wc * 32 + 8 * fq;
#pragma unroll
        for (int ai = 0; ai < 2; ++ai)
#pragma unroll
            for (int m = 0; m < 4; ++m) { bf16_t* rowp = O + (size_t)(row0 + ai * HALF + m * 16) * ldc + col0;
#pragma unroll
                for (int bj = 0; bj < 2; ++bj) { const f32x4 v0 = acc[ai][bj][m][0], v1 = acc[ai][bj][m][1];
                    u32x4 w; w.x = cvt_pk_bf16(v0[0], v0[1]); w.y = cvt_pk_bf16(v0[2], v0[3]); w.z = cvt_pk_bf16(v1[0], v1[1]); w.w = cvt_pk_bf16(v1[2], v1[3]);
                    *(u32x4*)(rowp + bj * HALF) = w; } }
    }
};
struct EpiResid {
    static constexpr bool PERM = false, AFTER_DRAIN = false, I8 = false;
    const float* base; float* out; bf16_t* xb; int ldc;
    __device__ __forceinline__ void operator()(const f32x4 (&acc)[2][2][4][2], const Unit& u, int wr, int wc, int fr, int fq) const {
        const int row0 = u.pm * BM + wr * 64 + fr, col0 = u.pn * BM + wc * 32 + 4 * fq;
        f32x4 nb[4][2][2];
#define PG8_RES_LOAD(g_) do { const size_t off_ = (size_t)(row0 + ((g_) >> 2) * HALF + ((g_) & 3) * 16) * ldc + col0; _Pragma("unroll") for (int bj = 0; bj < 2; ++bj) _Pragma("unroll") for (int n = 0; n < 2; ++n) \
            nb[(g_) & 3][bj][n] = __builtin_nontemporal_load((const f32x4*)(base + off_ + bj * HALF + n * 16)); } while (0)
        PG8_RES_LOAD(0); PG8_RES_LOAD(1); PG8_RES_LOAD(2);
#pragma unroll
        for (int g = 0; g < 8; ++g) { const int ai = g >> 2, m = g & 3; const size_t off = (size_t)(row0 + ai * HALF + m * 16) * ldc + col0;
            if (g + 3 < 8) PG8_RES_LOAD(g + 3);
#pragma unroll
            for (int bj = 0; bj < 2; ++bj)
#pragma unroll
                for (int n = 0; n < 2; ++n) { const f32x4 o = nb[g & 3][bj][n] + acc[ai][bj][m][n];
                    if (out) *(f32x4*)(out + off + bj * HALF + n * 16) = o;
                    u32x2 w; w.x = cvt_pk_bf16(o[0], o[1]); w.y = cvt_pk_bf16(o[2], o[3]); *(u32x2*)(xb + off + bj * HALF + n * 16) = w; }
            asm volatile("" ::: "memory"); }
#undef PG8_RES_LOAD
    }
};
__device__ __forceinline__ float acc_i2f(float bits) { return (float)__builtin_bit_cast(int, bits); }
struct EpiSwiGLU {
    static constexpr bool PERM = true, AFTER_DRAIN = false, I8 = true;
    bf16_t* O; const float* b_up; const float* rowrstd; const float* colsc;
    __device__ __forceinline__ void operator()(const f32x4 (&acc)[2][2][4][2], const Unit& u, int wr, int wc, int fr, int fq) const {
        const int row0 = u.pm * BM + wr * 64 + fr, f0 = u.pn * HALF + wc * 32 + 8 * fq;
        const float* bg = b_up + (size_t)u.e * 2048 + f0; const float* bl = bg + 1024;
        const f32x4 bg0 = *(const f32x4*)bg, bg1 = *(const f32x4*)(bg + 4), bl0 = *(const f32x4*)bl, bl1 = *(const f32x4*)(bl + 4);
        const float* cg = colsc + (size_t)u.e * 2048 + f0; const float* cl = cg + 1024;
        const f32x4 cg0 = *(const f32x4*)cg, cg1 = *(const f32x4*)(cg + 4), cl0 = *(const f32x4*)cl, cl1 = *(const f32x4*)(cl + 4);
        float rsv[2][4];
#pragma unroll
        for (int ai = 0; ai < 2; ++ai)
#pragma unroll
            for (int m = 0; m < 4; ++m) rsv[ai][m] = rowrstd[row0 + ai * HALF + m * 16];
#pragma unroll
        for (int ai = 0; ai < 2; ++ai)
#pragma unroll
            for (int m = 0; m < 4; ++m) { const int row = row0 + ai * HALF + m * 16; const float rs = rsv[ai][m];
                float a[8];
#pragma unroll
                for (int n = 0; n < 2; ++n)
#pragma unroll
                    for (int j = 0; j < 4; j += 2) {
                        const f32x2e ag2 = {acc_i2f(acc[ai][0][m][n][j]), acc_i2f(acc[ai][0][m][n][j + 1])}, al2 = {acc_i2f(acc[ai][1][m][n][j]), acc_i2f(acc[ai][1][m][n][j + 1])};
                        const f32x2e cg2 = n ? (f32x2e){cg1[j], cg1[j + 1]} : (f32x2e){cg0[j], cg0[j + 1]}, cl2 = n ? (f32x2e){cl1[j], cl1[j + 1]} : (f32x2e){cl0[j], cl0[j + 1]};
                        const f32x2e bg2 = n ? (f32x2e){bg1[j], bg1[j + 1]} : (f32x2e){bg0[j], bg0[j + 1]}, bl2 = n ? (f32x2e){bl1[j], bl1[j + 1]} : (f32x2e){bl0[j], bl0[j + 1]};
                        f32x2e hg = (ag2 * rs) * cg2 + bg2, hl = (al2 * rs) * cl2 + bl2;
                        hg.x = fminf(hg.x, 7.0f); hg.y = fminf(hg.y, 7.0f); hl.x = fminf(fmaxf(hl.x, -7.0f), 7.0f); hl.y = fminf(fmaxf(hl.y, -7.0f), 7.0f);
                        const f32x2e t = hg * (-1.702f * 1.4426950408889634f);
                        f32x2e e; e.x = __builtin_amdgcn_exp2f(t.x); e.y = __builtin_amdgcn_exp2f(t.y);
                        const f32x2e d = e + 1.0f; f32x2e sg; sg.x = __builtin_amdgcn_rcpf(d.x); sg.y = __builtin_amdgcn_rcpf(d.y);
                        const f32x2e o = (hg * sg) * (hl + 1.0f);
                        a[n * 4 + j] = o.x; a[n * 4 + j + 1] = o.y; }
                u32x4 w; w.x = cvt_pk_bf16(a[0], a[1]); w.y = cvt_pk_bf16(a[2], a[3]); w.z = cvt_pk_bf16(a[4], a[5]); w.w = cvt_pk_bf16(a[6], a[7]);
                *(u32x4*)(O + (size_t)row * 1024 + f0) = w; }
    }
};
struct EpiDown {
    static constexpr bool PERM = true, AFTER_DRAIN = false, I8 = false;
    bf16_t* O; const float* b_dn;
    __device__ __forceinline__ void operator()(const f32x4 (&acc)[2][2][4][2], const Unit& u, int wr, int wc, int fr, int fq) const {
        const int row0 = u.pm * BM + wr * 64 + fr, col0 = u.pn * BM + wc * 32 + 8 * fq;
        const float* bp = b_dn + (size_t)u.e * 1024 + col0;
        f32x4 bv[2][2];
#pragma unroll
        for (int bj = 0; bj < 2; ++bj)
#pragma unroll
            for (int n = 0; n < 2; ++n) bv[bj][n] = *(const f32x4*)(bp + bj * HALF + 4 * n);
#pragma unroll
        for (int ai = 0; ai < 2; ++ai)
#pragma unroll
            for (int m = 0; m < 4; ++m) { bf16_t* rowp = O + (size_t)(row0 + ai * HALF + m * 16) * 1024 + col0;
#pragma unroll
                for (int bj = 0; bj < 2; ++bj) { const f32x4 v0 = acc[ai][bj][m][0] + bv[bj][0], v1 = acc[ai][bj][m][1] + bv[bj][1];
                    u32x4 w; w.x = cvt_pk_bf16(v0[0], v0[1]); w.y = cvt_pk_bf16(v0[2], v0[3]); w.z = cvt_pk_bf16(v1[0], v1[1]); w.w = cvt_pk_bf16(v1[2], v1[3]);
                    *(u32x4*)(rowp + bj * HALF) = w; } }
    }
};

template <class Epi, class Sched, bool ALIGN_EPI = false, bool SP2 = false>
__device__ __forceinline__ void gemm_phase(PG8_LAS unsigned char* lds, const Gemm g, const Sched& S, const Epi& E) {
    int tid = threadIdx.x; asm volatile("" : "+v"(tid));
    const int wid = __builtin_amdgcn_readfirstlane(tid >> 6), lane = tid & 63, wr = wid >> 2, wc = wid & 3, fr = lane & 15, fq = lane >> 4;
    const int K = g.K, nt = K / BK;
    unsigned voffB[2]; int sR[2], sC[2];
#pragma unroll
    for (int i = 0; i < 2; ++i) { int R, C; stage_rc(tid * 16 + i * 8192, R, C); const int Rb = Epi::PERM ? ((R & ~31) + perm32(R & 31)) : R;
        sR[i] = R; sC[i] = C; voffB[i] = (unsigned)(Rb * K + C) * 2u; }
    const size_t kstep = (size_t)(BK * 2);
    const size_t hstep = (size_t)HALF * K * 2;
    const unsigned ldsw = (unsigned)wid * 1024u;
    const int aoff = lds_byte(wr * 64 + fr, fq * 8), boff = lds_byte(wc * 32 + fr, fq * 8);
#define PG8_SA(b, h) (((b) * 2 + (h)) * HTB)
#define PG8_SB(b, h) ((4 + (b) * 2 + (h)) * HTB)
#define PG8_STAGE(bufoff, gbase, voff) do { _Pragma("unroll") for (int _i = 0; _i < 2; ++_i) \
        __builtin_amdgcn_global_load_lds((const unsigned*)((const char*)(gbase) + (voff)[_i]), (PG8_LAS unsigned*)(lds + (bufoff) + ldsw + _i * 8192), 16, 0, 0); } while (0)
#define PG8_STAGE_A(bufoff, gbase, vo, h) do { _Pragma("unroll") for (int _i = 0; _i < 2; ++_i) \
        __builtin_amdgcn_global_load_lds((const unsigned*)((const char*)(gbase) + (vo)[h][_i]), (PG8_LAS unsigned*)(lds + (bufoff) + ldsw + _i * 8192), 16, 0, 0); } while (0)
#define PG8_LDA(dst, b, h) do { _Pragma("unroll") for (int m = 0; m < 4; ++m) _Pragma("unroll") for (int k = 0; k < 2; ++k) dst[m][k] = *(const PG8_LAS bf16x8*)(lds + PG8_SA(b, h) + aoff + m * 2048 + k * 1024); } while (0)
#define PG8_LDB(dst, b, h) do { _Pragma("unroll") for (int n = 0; n < 2; ++n) _Pragma("unroll") for (int k = 0; k < 2; ++k) dst[n][k] = *(const PG8_LAS bf16x8*)(lds + PG8_SB(b, h) + boff + n * 2048 + k * 1024); } while (0)
#define PG8_MMA(ai, bj, At, Bt) do { __builtin_amdgcn_s_setprio(1); _Pragma("unroll") for (int m = 0; m < 4; ++m) _Pragma("unroll") for (int n = 0; n < 2; ++n) _Pragma("unroll") for (int k = 0; k < 2; ++k) { \
        if constexpr (Epi::I8) acc[ai][bj][m][n] = __builtin_bit_cast(f32x4, __builtin_amdgcn_mfma_i32_16x16x64_i8(__builtin_bit_cast(i32x4, Bt[n][k]), __builtin_bit_cast(i32x4, At[m][k]), __builtin_bit_cast(i32x4, acc[ai][bj][m][n]), 0, 0, 0)); \
        else acc[ai][bj][m][n] = __builtin_amdgcn_mfma_f32_16x16x32_bf16(Bt[n][k], At[m][k], acc[ai][bj][m][n], 0, 0, 0); } __builtin_amdgcn_s_setprio(0); } while (0)
#define PG8_WAIT_V(n) asm volatile("s_waitcnt vmcnt(" #n ")" ::: "memory")
#define PG8_WAIT_L(n) asm volatile("s_waitcnt lgkmcnt(" #n ")" ::: "memory")
#define PG8_BAR __builtin_amdgcn_s_barrier()
#define PG8_SCHED __builtin_amdgcn_sched_barrier(0)
    Unit cur, nxt; int ui = 0;
#ifdef GEMM_TIME
    long long gacc_ = 0;
#endif
    if (!S.next(0, cur)) return;
    f32x4 acc[2][2][4][2];
#pragma unroll
    for (int a = 0; a < 2; ++a)
#pragma unroll
        for (int b = 0; b < 2; ++b)
#pragma unroll
            for (int m = 0; m < 4; ++m)
#pragma unroll
                for (int n = 0; n < 2; ++n) acc[a][b][m][n] = (f32x4){0.f, 0.f, 0.f, 0.f};
    bf16x8 At[4][2], B0[2][2], B1[2][2];
    const char* cA = S.a_base(g, cur); const char* cB = S.b_base(g, cur);
    unsigned voC[2][2], voN[2][2];
    S.a_off(g, cur, sR, sC, voC);
    S.a_ready(cur);
    static_assert(SP2, "only the two-MFMA-blocks-per-barrier-pair loop is kept");
    PG8_STAGE(PG8_SB(0, 0), cB, voffB); PG8_STAGE(PG8_SB(0, 1), cB + hstep, voffB); PG8_STAGE_A(PG8_SA(0, 0), cA, voC, 0); PG8_STAGE_A(PG8_SA(0, 1), cA, voC, 1);
    if (wr == 1) PG8_BAR;
    PG8_WAIT_V(2); PG8_BAR;
    PG8_STAGE(PG8_SB(1, 0), cB + kstep, voffB); PG8_STAGE_A(PG8_SA(1, 0), cA + kstep, voC, 0); PG8_STAGE(PG8_SB(1, 1), cB + hstep + kstep, voffB);
    PG8_WAIT_V(6); PG8_BAR;
    for (;;) {
        const bool has_next = S.next(ui + 1, nxt);
        const char* nA = has_next ? S.a_base(g, nxt) : cA; const char* nB = has_next ? S.b_base(g, nxt) : cB;
        if (has_next) S.a_off(g, nxt, sR, sC, voN); else {
#pragma unroll
            for (int h_ = 0; h_ < 2; ++h_) { voN[h_][0] = voC[h_][0]; voN[h_][1] = voC[h_][1]; } }
        for (int t = 0; t < nt; t += 2) {
            const bool last = (t == nt - 2);
            const char* a1 = cA + (size_t)(t + 1) * kstep;
            const char* a2 = last ? nA : cA + (size_t)(t + 2) * kstep; const char* b2 = last ? nB : cB + (size_t)(t + 2) * kstep;
            const char* a3 = a2 + kstep; const char* b3 = b2 + kstep;
            if (last && has_next) S.a_ready(nxt);
            unsigned vo2[2][2];
#pragma unroll
            for (int h_ = 0; h_ < 2; ++h_) { vo2[h_][0] = last ? voN[h_][0] : voC[h_][0]; vo2[h_][1] = last ? voN[h_][1] : voC[h_][1]; }
            PG8_LDB(B0, 0, 0); PG8_LDB(B1, 0, 1); PG8_SCHED; PG8_LDA(At, 0, 0); PG8_STAGE_A(PG8_SA(1, 1), a1, voC, 1);
            PG8_WAIT_V(8); PG8_WAIT_L(0); PG8_BAR; PG8_MMA(0, 0, At, B0); PG8_MMA(0, 1, At, B1); PG8_BAR; PG8_SCHED;
            PG8_LDA(At, 0, 1); PG8_STAGE(PG8_SB(0, 0), b2, voffB); PG8_STAGE(PG8_SB(0, 1), b2 + hstep, voffB); PG8_STAGE_A(PG8_SA(0, 0), a2, vo2, 0);
            PG8_WAIT_V(8); PG8_WAIT_L(0); PG8_BAR; PG8_MMA(1, 0, At, B0); PG8_MMA(1, 1, At, B1); PG8_BAR; PG8_SCHED;
            PG8_LDB(B0, 1, 0); PG8_LDB(B1, 1, 1); PG8_SCHED; PG8_LDA(At, 1, 0); PG8_STAGE_A(PG8_SA(0, 1), a2, vo2, 1);
            PG8_WAIT_V(8); PG8_WAIT_L(0); PG8_BAR; PG8_MMA(0, 0, At, B0); PG8_MMA(0, 1, At, B1); PG8_BAR; PG8_SCHED;
            PG8_LDA(At, 1, 1); PG8_STAGE(PG8_SB(1, 0), b3, voffB); PG8_STAGE(PG8_SB(1, 1), b3 + hstep, voffB); PG8_STAGE_A(PG8_SA(1, 0), a3, vo2, 0);
            PG8_WAIT_V(8); PG8_WAIT_L(0); PG8_BAR; PG8_MMA(1, 0, At, B0); PG8_MMA(1, 1, At, B1); PG8_BAR; PG8_SCHED;
        }
        if constexpr (ALIGN_EPI) { if (wr == 0) PG8_BAR; }
#ifdef GEMM_TIME
        const long long gt0_ = clock64();
#endif
        if constexpr (!Epi::AFTER_DRAIN) { E(acc, cur, wr, wc, fr, fq); S.done(cur); }
#ifdef GEMM_TIME
        gacc_ += clock64() - gt0_;
#endif
        if (!has_next) break;
#pragma unroll
        for (int a = 0; a < 2; ++a)
#pragma unroll
            for (int b = 0; b < 2; ++b)
#pragma unroll
                for (int m = 0; m < 4; ++m)
#pragma unroll
                    for (int n = 0; n < 2; ++n) acc[a][b][m][n] = (f32x4){0.f, 0.f, 0.f, 0.f};
        cur = nxt; cA = nA; cB = nB; ++ui;
#pragma unroll
        for (int h_ = 0; h_ < 2; ++h_) { voC[h_][0] = voN[h_][0]; voC[h_][1] = voN[h_][1]; }
        if constexpr (ALIGN_EPI) { if (wr == 1) PG8_BAR; }
    }
    PG8_WAIT_V(0);
    if constexpr (!ALIGN_EPI) { if (wr == 0) PG8_BAR; }
    PG8_BAR;
#ifdef GEMM_TIME
    { const long long s0_ = clock64(); while (clock64() - s0_ < gacc_) __builtin_amdgcn_s_sleep(8); }
#endif
    if constexpr (Epi::AFTER_DRAIN) { E.fused(acc, cur, wr, wc, fr, fq, lds, wid, lane); S.done(cur); }
#undef PG8_SA
#undef PG8_SB
#undef PG8_STAGE
#undef PG8_STAGE_A
#undef PG8_LDA
#undef PG8_LDB
#undef PG8_MMA
#undef PG8_WAIT_V
#undef PG8_WAIT_L
#undef PG8_BAR
#undef PG8_SCHED
}
}

constexpr int NWAVES = 8;
constexpr int T = 32768, D = 1024, SEQ = 8192, NBATCH = 4, NCHUNK = SEQ / 64;
constexpr int INC = 3328;
constexpr int PRW = 1536;
constexpr int NEXP = 32, TOPK = 4;
constexpr int NRB_MAX = T * TOPK / 256 + NEXP;
constexpr int NROWS_MAX = NRB_MAX * 256;
constexpr int NITEM = NBATCH * NCHUNK * 8;

constexpr size_t MiB = 1u << 20, KiB = 1u << 10;
constexpr size_t WS_CTL = 0, CTL_ZERO_BYTES = 1 * MiB;
constexpr size_t WS_META = 1 * MiB;
constexpr size_t WS_CNT = 1 * MiB + 64 * KiB;
constexpr size_t WS_EIDX = 2 * MiB, WS_GATE = 2 * MiB + 512 * KiB, WS_LRANK = 3 * MiB, WS_INV = 3 * MiB + 512 * KiB;
constexpr size_t WS_RSTD = 4 * MiB, WS_ROWRSTD = 4 * MiB + 256 * KiB;
constexpr size_t WS_WRT = 5 * MiB;
constexpr size_t WS_PAR = 5 * MiB + 128 * KiB;
constexpr size_t WS_WDEC = 5 * MiB + 256 * KiB, WS_WAAA = WS_WDEC + 64 * KiB, WS_WGATE = WS_WAAA + 64 * KiB;
constexpr size_t WS_WIN = 6 * MiB, WS_WOUT = 13 * MiB;
constexpr size_t WS_ROWTOK = 15 * MiB;
constexpr size_t WS_WUP = 16 * MiB, WS_WDN = 144 * MiB;
constexpr size_t WS_XN = 208 * MiB;
constexpr size_t WS_PROJ = 272 * MiB;
constexpr size_t WS_MIX = 480 * MiB;
constexpr size_t WS_RW = 544 * MiB;
constexpr size_t WS_XG = 272 * MiB, WS_ACT = 544 * MiB, WS_YR = WS_XG;
constexpr size_t WS_COLSC = 15 * MiB + 640 * KiB;
constexpr size_t WS_XQ = WS_MIX;
constexpr size_t WS_END = 1000 * MiB;
constexpr int CW_ATT = 8192;
constexpr int CW_BAR = 4096;

constexpr int RING_BYTES = 131072;
constexpr int LDS_BYTES = 163840;
constexpr int MISC_OFF = LDS_BYTES - 256;

#define GAS __attribute__((address_space(1)))
#define LAS __attribute__((address_space(3)))
#define DI __device__ __forceinline__
typedef unsigned short bf16;
typedef unsigned v4u __attribute__((ext_vector_type(4)));
typedef unsigned v2u __attribute__((ext_vector_type(2)));
typedef float f32x4 __attribute__((ext_vector_type(4)));
typedef float f32x2 __attribute__((ext_vector_type(2)));
typedef short bf16x8 __attribute__((ext_vector_type(8)));
typedef __bf16 bf16x2_t __attribute__((ext_vector_type(2)));
#define LDS_WAIT() asm volatile("s_waitcnt lgkmcnt(0)" ::: "memory")
#define VM_WAIT() asm volatile("s_waitcnt vmcnt(0)" ::: "memory")
DI unsigned pk2(float lo, float hi) { const f32x2 v = {lo, hi}; const bf16x2_t b = __builtin_convertvector(v, bf16x2_t); return __builtin_bit_cast(unsigned, b); }
DI float bf2f(unsigned short b) { return __uint_as_float((unsigned)b << 16); }
DI float bflo(unsigned w) { return __uint_as_float(w << 16); }
DI float bfhi(unsigned w) { return __uint_as_float(w & 0xffff0000u); }
DI float wave_sum(float v) {
#pragma unroll
    for (int o = 1; o < 64; o <<= 1) v += __shfl_xor(v, o);
    return v;
}
DI float wave_max(float v) {
#pragma unroll
    for (int o = 1; o < 64; o <<= 1) v = fmaxf(v, __shfl_xor(v, o));
    return v;
}
DI float sigmoidf_(float x) { return 1.0f / (1.0f + __expf(-x)); }

DI float quad_sum(float x) {
    const unsigned a = __builtin_bit_cast(unsigned, x); const auto r = __builtin_amdgcn_permlane32_swap(a, a, false, false);
    const float y = __builtin_bit_cast(float, (unsigned)r[0]) + __builtin_bit_cast(float, (unsigned)r[1]);
    const unsigned b = __builtin_bit_cast(unsigned, y); const auto s = __builtin_amdgcn_permlane16_swap(b, b, false, false);
    return __builtin_bit_cast(float, (unsigned)s[0]) + __builtin_bit_cast(float, (unsigned)s[1]);
}
DI float quad_max(float x) {
    const unsigned a = __builtin_bit_cast(unsigned, x); const auto r = __builtin_amdgcn_permlane32_swap(a, a, false, false);
    const float y = fmaxf(__builtin_bit_cast(float, (unsigned)r[0]), __builtin_bit_cast(float, (unsigned)r[1]));
    const unsigned b = __builtin_bit_cast(unsigned, y); const auto s = __builtin_amdgcn_permlane16_swap(b, b, false, false);
    return fmaxf(__builtin_bit_cast(float, (unsigned)s[0]), __builtin_bit_cast(float, (unsigned)s[1]));
}
#define XB_TMO      128
#define XB_XCNT(j)  (256  + 64 * (j))
#define XB_XSUB(j)  (1280 + 64 * (j))
#define XB_XGEN(j)  (2304 + 64 * (j))
#define XB_TOP      3328
#define XB_TOPGEN   3392
#define XCD_BAR_WORDS 3456
#define XB_SPIN_CAP (NAIVE_RWKV ? (1u << 25) : (1u << 20))

__device__ __forceinline__ unsigned xb_ld(unsigned* p)              { return __hip_atomic_load(p, __ATOMIC_RELAXED, __HIP_MEMORY_SCOPE_AGENT); }
__device__ __forceinline__ unsigned xb_add(unsigned* p, unsigned v) { return __hip_atomic_fetch_add(p, v, __ATOMIC_RELAXED, __HIP_MEMORY_SCOPE_AGENT); }
__device__ __forceinline__ unsigned xb_xcc_id() { return (unsigned)__builtin_amdgcn_s_getreg((3 << 11) | 20) & 0xFu; }
#define XB_SPIN(cond, bar) do { unsigned _sp = 0; while (cond) { __builtin_amdgcn_s_sleep(1); \
    if ((++_sp & 255u) == 0u) { if (xb_ld(&(bar)[XB_TMO])) break; if (_sp > XB_SPIN_CAP) { atomicAdd(&(bar)[XB_TMO], 1u); break; } } } } while (0)

struct XcdBarrier {
    unsigned* bar; unsigned x;
    volatile LAS unsigned* st;
};

__device__ __forceinline__ XcdBarrier xcd_barrier_post(unsigned* bar, volatile LAS unsigned* st) {
    XcdBarrier b; b.bar = bar; b.x = xb_xcc_id(); b.st = st;
    if (threadIdx.x == 0) (void)xb_add(&bar[XB_XCNT(b.x)], 1u);
    return b;
}
__device__ __forceinline__ void xcd_barrier_complete(unsigned* bar, unsigned x, unsigned& nloc, unsigned& nx) {
    const unsigned G = gridDim.x * gridDim.y * gridDim.z;
    unsigned sum, cnt, mine, sp = 0u;
    for (;;) {
        sum = 0u; cnt = 0u; mine = 0u;
#pragma unroll
        for (unsigned j = 0; j < 16; ++j) { const unsigned c = xb_ld(&bar[XB_XCNT(j)]); sum += c; cnt += (c > 0u) ? 1u : 0u; mine = (j == x) ? c : mine; }
        if (sum == G) break;
        __builtin_amdgcn_s_sleep(1);
        if ((++sp & 255u) == 0u) { if (xb_ld(&bar[XB_TMO])) break; if (sp > XB_SPIN_CAP) { atomicAdd(&bar[XB_TMO], 1u); break; } }
    }
    nloc = mine > 0u ? mine : 1u; nx = cnt > 0u ? cnt : 1u;
}

__device__ __forceinline__ void xcd_barrier(const XcdBarrier& b) {
    asm volatile("s_waitcnt vmcnt(0)" ::: "memory");
    __syncthreads();
    if (threadIdx.x == 0) {
        unsigned* bar = b.bar;
        __builtin_amdgcn_s_waitcnt(0);
        unsigned nloc = b.st[0], nx = b.st[1];
        if (nloc == 0u) { xcd_barrier_complete(bar, b.x, nloc, nx); b.st[0] = nloc; b.st[1] = nx; }
        const unsigned old = xb_add(&bar[XB_XSUB(b.x)], 1u);
        const unsigned gen = old / nloc;
        if (old + 1u == (gen + 1u) * nloc) {
            __builtin_amdgcn_fence(__ATOMIC_RELEASE, "agent");
            asm volatile("s_waitcnt vmcnt(0)" ::: "memory");
            const unsigned og = xb_add(&bar[XB_TOP], 1u);
            const unsigned tg = og / nx;
            if (og + 1u == (tg + 1u) * nx) xb_add(&bar[XB_TOPGEN], 1u);
            else XB_SPIN(xb_ld(&bar[XB_TOPGEN]) == tg, bar);
            __builtin_amdgcn_fence(__ATOMIC_ACQUIRE, "agent");
            xb_add(&bar[XB_XGEN(b.x)], 1u);
            asm volatile("s_waitcnt vmcnt(0)" ::: "memory");
        } else {
            XB_SPIN(xb_ld(&bar[XB_XGEN(b.x)]) == gen, bar);
            __builtin_amdgcn_fence(__ATOMIC_ACQUIRE, "agent");
            asm volatile("s_waitcnt vmcnt(0)" ::: "memory");
        }
    }
    __syncthreads();
}

struct Args {
    const float* in[25]; float* out; unsigned char* ws; int ph_lo, ph_hi, ph_rep, pad_;
};
enum { I_X = 0, I_N1G, I_WIN, I_MU, I_QG, I_KG, I_RELB, I_W0, I_WDEC, I_A0, I_WAAA, I_WGATE, I_KK, I_KA, I_RK, I_LNG, I_LNB, I_WOUT, I_N2G, I_WR, I_BR, I_WUP, I_BUP, I_WDN, I_BDN };
struct Frame {
    LAS unsigned char* lds;
    int tid, lane, wave, G, bid;
};


struct TrRegs { f32x4 v[8]; f32x4 s0, s1; bf16* dst; int ldo; };
DI void tr_load(TrRegs& t, const float* __restrict__ W, int ldw, int k0, int n0, bf16* WT, int ldo, long drow, int lane, const float* __restrict__ ksc8 = nullptr) {
    const int r8 = lane >> 3, c4 = lane & 7;
    t.s0 = (f32x4){1.f, 1.f, 1.f, 1.f}; t.s1 = t.s0; if (ksc8) { t.s0 = *(const f32x4*)ksc8; t.s1 = *(const f32x4*)(ksc8 + 4); }
    const float* src = W + (size_t)(k0 + 8 * r8) * ldw + n0 + 4 * c4;
#pragma unroll
    for (int i = 0; i < 8; ++i) t.v[i] = __builtin_nontemporal_load((const f32x4*)(src + (size_t)i * ldw));
    t.dst = WT + (size_t)(drow + 4 * c4) * ldo + k0 + 8 * r8; t.ldo = ldo;
}
DI void tr_store(const TrRegs& t, const float* __restrict__ = nullptr) {
    const f32x4 s0 = t.s0, s1 = t.s1;
#pragma unroll
    for (int j = 0; j < 4; ++j) { const v4u o = {pk2(t.v[0][j] * s0[0], t.v[1][j] * s0[1]), pk2(t.v[2][j] * s0[2], t.v[3][j] * s0[3]), pk2(t.v[4][j] * s1[0], t.v[5][j] * s1[1]), pk2(t.v[6][j] * s1[2], t.v[7][j] * s1[3])};
        __builtin_nontemporal_store(o, (v4u*)(t.dst + (size_t)j * t.ldo)); }
}
DI void tr_item(const float* __restrict__ W, int ldw, int k0, int n0, bf16* WT, int ldo, long drow, LAS float* scr, int lane, const float* __restrict__ ksc) {
    (void)scr; TrRegs t; tr_load(t, W, ldw, k0, n0, WT, ldo, drow, lane, ksc ? ksc + k0 + 8 * (lane >> 3) : nullptr); tr_store(t);
}
constexpr int MOE_TR_UP = NEXP * 16 * 64, MOE_TR_DN = NEXP * 16 * 32, MOE_TR_ALL = MOE_TR_UP + MOE_TR_DN;
DI const float* moe_tr_load(TrRegs& t, const Args& a, int r, int lane) {
    unsigned char* ws = a.ws;
    if (r < MOE_TR_UP) { const int e = r / 1024, kb = (r % 1024) / 64, nb = r % 64, n0 = 32 * nb; const int n1 = n0 & 1023;
        const long drow = (long)(n1 / 128) * 256 + (n0 >= 1024 ? 128 : 0) + (n1 % 128);
        tr_load(t, a.in[I_WUP] + (size_t)e * 1024 * 2048, 2048, 64 * kb, n0, (bf16*)(ws + WS_WUP) + (size_t)e * 2048 * 1024, 1024, drow, lane, a.in[I_N2G] + 64 * kb + 8 * (lane >> 3));
        return nullptr; }
    r -= MOE_TR_UP; const int e = r / 512, kb = (r % 512) / 32, nb = r % 32;
    tr_load(t, a.in[I_WDN] + (size_t)e * 1024 * 1024, 1024, 64 * kb, 32 * nb, (bf16*)(ws + WS_WDN) + (size_t)e * 1024 * 1024, 1024, 32 * nb, lane);
    return nullptr;
}
DI void moe_tr_item(const Args& a, int r, LAS float* scr, int lane) { (void)scr; TrRegs t; const float* s = moe_tr_load(t, a, r, lane); tr_store(t, s); }
DI unsigned q_pack4(float a, float b, float c, float d) {
    const unsigned ua = __builtin_bit_cast(unsigned, a), ub = __builtin_bit_cast(unsigned, b), uc = __builtin_bit_cast(unsigned, c), ud = __builtin_bit_cast(unsigned, d);
    return (ua & 0xffu) | ((ub & 0xffu) << 8) | ((uc & 0xffu) << 16) | (ud << 24); }
constexpr float Q_MAGIC = 12582912.0f;
DI void moe_q_batch(const Args& a, int batch, int wave, int lane, LAS float* exch) {
    unsigned char* ws = a.ws;
    const int strip = batch * 4 + (wave >> 1), half = wave & 1, e = strip >> 6, nb = strip & 63, n0 = 32 * nb, n1 = n0 & 1023;
    const int r8 = lane >> 3, c4 = lane & 7;
    const long drow = (long)(n1 / 128) * 256 + (n0 >= 1024 ? 128 : 0) + (n1 % 128);
    const float* W = a.in[I_WUP] + (size_t)e * 1024 * 2048 + (size_t)(512 * half + 8 * r8) * 2048 + n0 + 4 * c4;
    const float* gk = a.in[I_N2G] + 512 * half + 8 * r8;
    f32x4 mx = {0.f, 0.f, 0.f, 0.f};
    for (int g = 0; g < 8; g += 4) {
        f32x4 v[4][8], s0[4], s1[4];
#pragma unroll
        for (int t = 0; t < 4; ++t) { s0[t] = *(const f32x4*)(gk + 64 * (g + t)); s1[t] = *(const f32x4*)(gk + 64 * (g + t) + 4);
#pragma unroll
            for (int i = 0; i < 8; ++i) v[t][i] = *(const f32x4*)(W + (size_t)(64 * (g + t) + i) * 2048); }
#pragma unroll
        for (int t = 0; t < 4; ++t)
#pragma unroll
            for (int i = 0; i < 8; ++i) { const float s = i < 4 ? s0[t][i] : s1[t][i - 4]; const f32x4 p = v[t][i] * s;
#pragma unroll
                for (int j = 0; j < 4; ++j) mx[j] = fmaxf(mx[j], fabsf(p[j])); }
    }
#pragma unroll
    for (int j = 0; j < 4; ++j) { float m = mx[j]; m = fmaxf(m, __shfl_xor(m, 8)); m = fmaxf(m, __shfl_xor(m, 16)); m = fmaxf(m, __shfl_xor(m, 32)); mx[j] = m; }
    if (r8 == 0) *(LAS f32x4*)(exch + (wave * 8 + c4) * 4) = mx;
    __syncthreads();
    { const f32x4 o = *(const LAS f32x4*)(exch + ((wave ^ 1) * 8 + c4) * 4);
#pragma unroll
      for (int j = 0; j < 4; ++j) mx[j] = fmaxf(mx[j], o[j]); }
    if (half == 0 && r8 == 0) *(f32x4*)((float*)(ws + WS_COLSC) + (size_t)e * 2048 + n0 + 4 * c4) = mx * (1.0f / 127.0f);
    f32x4 inv;
#pragma unroll
    for (int j = 0; j < 4; ++j) inv[j] = mx[j] > 0.f ? 127.0f / mx[j] : 0.f;
    unsigned char* dst = ws + WS_WUP + ((size_t)e * 2048 + drow + 4 * c4) * 1024 + 512 * half + 8 * r8;
    for (int g = 0; g < 8; g += 2) {
        f32x4 v[2][8], s0[2], s1[2];
#pragma unroll
        for (int t = 0; t < 2; ++t) { s0[t] = *(const f32x4*)(gk + 64 * (g + t)); s1[t] = *(const f32x4*)(gk + 64 * (g + t) + 4);
#pragma unroll
            for (int i = 0; i < 8; ++i) v[t][i] = __builtin_nontemporal_load((const f32x4*)(W + (size_t)(64 * (g + t) + i) * 2048)); }
#pragma unroll
        for (int t = 0; t < 2; ++t) {
            f32x4 p[8];
#pragma unroll
            for (int i = 0; i < 8; ++i) { const float s = i < 4 ? s0[t][i] : s1[t][i - 4]; p[i] = (v[t][i] * s) * inv + Q_MAGIC; }
#pragma unroll
            for (int j = 0; j < 4; ++j) { const v2u o = {q_pack4(p[0][j], p[1][j], p[2][j], p[3][j]), q_pack4(p[4][j], p[5][j], p[6][j], p[7][j])};
                __builtin_nontemporal_store(o, (v2u*)(dst + (size_t)j * 1024 + 64 * (g + t))); } }
    }
}
DI void moe_tr_batch(const Args& a, int batch, int wave, int lane, LAS float* exch) {
    if (batch < MOE_TR_UP / 64) { moe_q_batch(a, batch, wave, lane, exch); return; }
    const int base = batch * 64 + wave * 8;
    for (int i = 0; i < 8; i += 4) { TrRegs t[4]; const float* sc[4];
#pragma unroll
        for (int j = 0; j < 4; ++j) sc[j] = moe_tr_load(t[j], a, base + i + j, lane);
#pragma unroll
        for (int j = 0; j < 4; ++j) tr_store(t[j], sc[j]); }
}
constexpr int MOE_TR_BATCHES = MOE_TR_ALL / 64, MOE_TR_EARLY = 256;

#if !NAIVE_ATT
constexpr int ATT_KS = 144;
constexpr int ATT_TILE = 64 * ATT_KS;
constexpr int ATT_BIAS_OFF = 4 * ATT_TILE;
constexpr int ATT_NSLOT = (NBATCH * 8 * (NCHUNK / 2) / 8) * 11;
static_assert(NBATCH * 8 * (NCHUNK / 2) == 2048 && MOE_TR_ALL == 256 * 3 * 64, "attention / conversion work queue");
DI int att_pos(int key) { return (key & 32) + 8 * ((key >> 2) & 3) + 4 * ((key >> 4) & 1) + (key & 3); }
DI void attn_phase(const Frame& F, const Args& a, const int qid = 0) {
    const bf16* proj = (const bf16*)(a.ws + WS_PROJ); bf16* mix = (bf16*)(a.ws + WS_MIX);
    LAS unsigned char* lds = F.lds; LAS float* sbias = (LAS float*)(lds + ATT_BIAS_OFF);
    const int l = F.lane, n16 = l & 15, q = l >> 4, w = F.wave;
    const float LOG2E = 1.4426950408889634f;
    const int srow = F.tid >> 3, spc = F.tid & 7;
    float kgv[8];
#pragma unroll
    for (int j = 0; j < 8; ++j) kgv[j] = a.in[I_KG][8 * spc + j];
    const int spos = att_pos(srow);
    LAS int* s_item = (LAS int*)(lds + ATT_BIAS_OFF + 1024);
    unsigned* qhead = (unsigned*)(a.ws + WS_CTL) + CW_ATT + 64 * qid;
    for (;;) {
        __syncthreads();
        if (F.tid == 0) *s_item = (int)__hip_atomic_fetch_add(qhead, 1u, __ATOMIC_RELAXED, __HIP_MEMORY_SCOPE_AGENT);
        __syncthreads();
        const int slot = *s_item;
        if (slot >= ATT_NSLOT) break;
        const int grp = slot / 11, sub = slot % 11;
        if (sub >= 8) { const int base = (grp * 3 + (sub - 8)) * 64 + w * 8;
            (void)base; moe_tr_batch(a, grp * 3 + (sub - 8), w, l, (LAS float*)(lds + ATT_BIAS_OFF + 2048));
            continue; }
        const int item = grp * 8 + sub;
        const int b = item / (8 * (NCHUNK / 2)), h = (item / (NCHUNK / 2)) & 7, n0 = 2 * (item % (NCHUNK / 2));
        if (F.tid < 192) sbias[F.tid] = a.in[I_RELB][h * 192 + F.tid] * LOG2E;
        const int nq = n0 + (w >> 2), qpos = 16 * (w & 3) + n16;
        const size_t qtok = (size_t)b * SEQ + nq * 64 + qpos;
        bf16x8 qf[2];
        { const v4u q0 = *(const v4u*)(proj + qtok * INC + h * 64 + 8 * q), q1 = *(const v4u*)(proj + qtok * INC + h * 64 + 32 + 8 * q);
          float f[16]; const unsigned ww[8] = {q0.x, q0.y, q0.z, q0.w, q1.x, q1.y, q1.z, q1.w};
          float ss = 0.f;
#pragma unroll
          for (int e = 0; e < 8; ++e) { f[2 * e] = bflo(ww[e]); f[2 * e + 1] = bfhi(ww[e]); ss += f[2 * e] * f[2 * e] + f[2 * e + 1] * f[2 * e + 1]; }
          ss = quad_sum(ss);
          const float rs = (1.0f / sqrtf(ss * (1.f / 64.f) + 1e-6f)) * 0.125f * LOG2E;
          unsigned pk[8];
#pragma unroll
          for (int e = 0; e < 8; ++e) { const int d = (e < 4 ? 0 : 32) + 8 * q + 2 * (e & 3); pk[e] = pk2(f[2 * e] * rs * a.in[I_QG][d], f[2 * e + 1] * rs * a.in[I_QG][d + 1]); }
          const v4u p0 = {pk[0], pk[1], pk[2], pk[3]}, p1 = {pk[4], pk[5], pk[6], pk[7]};
          qf[0] = __builtin_bit_cast(bf16x8, p0); qf[1] = __builtin_bit_cast(bf16x8, p1); }
        f32x4 o[4];
#pragma unroll
        for (int dt = 0; dt < 4; ++dt) o[dt] = (f32x4){0.f, 0.f, 0.f, 0.f};
        float m_run = -3.0e38f, l_run = 0.f;
        v4u kreg, vreg;
        auto gload = [&](int jc) { const int kc = n0 - 8 + jc; if (kc >= 0) { const size_t tok = (size_t)b * SEQ + kc * 64 + srow;
            kreg = *(const v4u*)(proj + tok * INC + 512 + h * 64 + 8 * spc); vreg = *(const v4u*)(proj + tok * INC + 1024 + h * 64 + 8 * spc); } };
        auto lstore = [&](int jc) { const int kc = n0 - 8 + jc; if (kc >= 0) { LAS unsigned char* kb = lds + (jc & 1) * 2 * ATT_TILE; LAS unsigned char* vb = kb + ATT_TILE;
            const unsigned ww[4] = {kreg.x, kreg.y, kreg.z, kreg.w}; float f[8]; float ss = 0.f;
#pragma unroll
            for (int e = 0; e < 4; ++e) { f[2 * e] = bflo(ww[e]); f[2 * e + 1] = bfhi(ww[e]); ss += f[2 * e] * f[2 * e] + f[2 * e + 1] * f[2 * e + 1]; }
            ss += __builtin_bit_cast(float, __builtin_amdgcn_update_dpp(0, __builtin_bit_cast(int, ss), 0xB1, 0xf, 0xf, true));
            ss += __builtin_bit_cast(float, __builtin_amdgcn_update_dpp(0, __builtin_bit_cast(int, ss), 0x4E, 0xf, 0xf, true));
            ss += __builtin_bit_cast(float, __builtin_amdgcn_update_dpp(0, __builtin_bit_cast(int, ss), 0x141, 0xf, 0xf, true));
            const float rs = 1.0f / sqrtf(ss * (1.f / 64.f) + 1e-6f);
            v4u kk; kk.x = pk2(f[0] * rs * kgv[0], f[1] * rs * kgv[1]); kk.y = pk2(f[2] * rs * kgv[2], f[3] * rs * kgv[3]); kk.z = pk2(f[4] * rs * kgv[4], f[5] * rs * kgv[5]); kk.w = pk2(f[6] * rs * kgv[6], f[7] * rs * kgv[7]);
            *(LAS v4u*)(kb + srow * ATT_KS + 16 * spc) = kk;
            const unsigned vv[4] = {vreg.x, vreg.y, vreg.z, vreg.w};
#pragma unroll
            for (int e = 0; e < 4; ++e) { *(LAS unsigned short*)(vb + (8 * spc + 2 * e) * ATT_KS + 2 * spos) = (unsigned short)(vv[e] & 0xffffu);
                                          *(LAS unsigned short*)(vb + (8 * spc + 2 * e + 1) * ATT_KS + 2 * spos) = (unsigned short)(vv[e] >> 16); } } };
        gload(0); lstore(0);
        __syncthreads();
        for (int jc = 0; jc < 10; ++jc) {
            if (jc + 1 < 10) gload(jc + 1);
            const int kc = n0 - 8 + jc, dj = jc - (w >> 2);
            if (kc >= 0 && dj >= 0 && dj <= 8) {
                const LAS unsigned char* kb = lds + (jc & 1) * 2 * ATT_TILE; const LAS unsigned char* vb = kb + ATT_TILE;
                f32x4 sc[4];
#pragma unroll
                for (int mt = 0; mt < 4; ++mt) { sc[mt] = (f32x4){0.f, 0.f, 0.f, 0.f};
#pragma unroll
                    for (int ks = 0; ks < 2; ++ks) { const bf16x8 kf = *(const LAS bf16x8*)(kb + (16 * mt + n16) * ATT_KS + 64 * ks + 16 * q);
                        sc[mt] = __builtin_amdgcn_mfma_f32_16x16x32_bf16(kf, qf[ks], sc[mt], 0, 0, 0); } }
                float boff = 0.f;
                if (dj <= 5) boff = sbias[0];
                else { const int base = (dj - 8) * 64 - qpos + 128;
#pragma unroll
                    for (int mt = 0; mt < 4; ++mt)
#pragma unroll
                        for (int i = 0; i < 4; ++i) { int idx = base + 16 * mt + 4 * q + i; idx = idx < 0 ? 0 : idx; const float bv_ = sbias[idx];
                            sc[mt][i] += bv_; } }
                float mx = sc[0][0];
#pragma unroll
                for (int mt = 0; mt < 4; ++mt)
#pragma unroll
                    for (int i = 0; i < 4; ++i) mx = fmaxf(mx, sc[mt][i]);
                mx = quad_max(mx);
                const float m_new = fmaxf(m_run, mx + boff), alpha = __builtin_amdgcn_exp2f(m_run - m_new), msub = m_new - boff;
                const bool moved = __builtin_amdgcn_ballot_w64(m_new != m_run) != 0ull;
                m_run = m_new; float ls = 0.f;
#pragma unroll
                for (int mt = 0; mt < 4; ++mt)
#pragma unroll
                    for (int i = 0; i < 4; ++i) { sc[mt][i] = __builtin_amdgcn_exp2f(sc[mt][i] - msub); ls += sc[mt][i]; }
                if (moved) { l_run *= alpha;
#pragma unroll
                    for (int dt = 0; dt < 4; ++dt) o[dt] = o[dt] * alpha; }
                l_run += ls;
#pragma unroll
                for (int s = 0; s < 2; ++s) {
                    const v4u pp = {pk2(sc[2 * s][0], sc[2 * s][1]), pk2(sc[2 * s][2], sc[2 * s][3]), pk2(sc[2 * s + 1][0], sc[2 * s + 1][1]), pk2(sc[2 * s + 1][2], sc[2 * s + 1][3])};
                    const bf16x8 pf = __builtin_bit_cast(bf16x8, pp);
#pragma unroll
                    for (int dt = 0; dt < 4; ++dt) { const bf16x8 vf = *(const LAS bf16x8*)(vb + (16 * dt + n16) * ATT_KS + 64 * s + 16 * q);
                        o[dt] = __builtin_amdgcn_mfma_f32_16x16x32_bf16(vf, pf, o[dt], 0, 0, 0); } }
            }
            if (jc + 1 < 10) lstore(jc + 1);
            __syncthreads();
        }
        l_run = quad_sum(l_run);
        const float inv = 1.0f / l_run;
#pragma unroll
        for (int dt = 0; dt < 4; ++dt) { v2u ov; ov.x = pk2(o[dt][0] * inv, o[dt][1] * inv); ov.y = pk2(o[dt][2] * inv, o[dt][3] * inv);
            *(v2u*)(mix + qtok * 1024 + h * 64 + 16 * dt + 4 * q) = ov; }
    }
}
#endif

#if !NAIVE_RWKV
constexpr int RA_HALF = 80896;
constexpr int RA_RT = 0, RA_KT = 9216, RA_BT = 18432, RA_AT = 27648;
constexpr int RA_VT = 36864, RA_KH = 46080, RA_BH = 55296;
constexpr int RA_AAB = 64512;
constexpr int RA_XWD = 0, RA_XAD = 9216, RA_XGD = 18432;
constexpr int RA_RHS2 = 0, RA_GEND = 17408;
constexpr int RA_W1T = 18432, RA_W2T = 27648;
constexpr int RA_WT = RA_AAB;
constexpr int RB_REC = 65536, RB_YLT = 0, RB_PCT = 8192, RB_G1T = 16384, RB_E2T = 24576, RB_MC = 32768, RB_CC = 40960, RB_SC = 57344;
static_assert(2 * RA_HALF <= MISC_OFF, "rwkv phase A LDS");

DI void ld8f(const bf16* p, float (&f)[8]) { const v4u w = *(const v4u*)p; f[0] = bflo(w.x); f[1] = bfhi(w.x); f[2] = bflo(w.y); f[3] = bfhi(w.y); f[4] = bflo(w.z); f[5] = bfhi(w.z); f[6] = bflo(w.w); f[7] = bfhi(w.w); }
DI void ld4f(const bf16* p, float (&f)[4]) { const v2u w = *(const v2u*)p; f[0] = bflo(w.x); f[1] = bfhi(w.x); f[2] = bflo(w.y); f[3] = bfhi(w.y); }
DI bf16x8 pack8(const f32x4& a, const f32x4& b) { const v4u p = {pk2(a[0], a[1]), pk2(a[2], a[3]), pk2(b[0], b[1]), pk2(b[2], b[3])}; return __builtin_bit_cast(bf16x8, p); }
DI float fast_sigmoid(float x) { return __builtin_amdgcn_rcpf(1.0f + __builtin_amdgcn_exp2f(-1.4426950408889634f * x)); }
DI float fast_tanh(float x) { return 1.0f - 2.0f * __builtin_amdgcn_rcpf(1.0f + __builtin_amdgcn_exp2f(2.8853900817779268f * x)); }
#define MFMA16(a, b, c) __builtin_amdgcn_mfma_f32_16x16x32_bf16((a), (b), (c), 0, 0, 0)

DI void rwkv_phase_a(const Frame& F, const Args& a) {
    unsigned char* ws = a.ws; unsigned char* rb = ws + WS_RW;
    const bf16* wdec = (const bf16*)(ws + WS_WDEC); const bf16* waaa = (const bf16*)(ws + WS_WAAA); const bf16* wgate = (const bf16*)(ws + WS_WGATE);
    const float* mu = a.in[I_MU]; const float* par = (const float*)(ws + WS_PAR);
    const int hb = F.wave >> 2, w4 = F.wave & 3;
    LAS unsigned char* hbase = F.lds + hb * RA_HALF;
    const float LOG2E = 1.4426950408889634f;
    v4u s0c[4];
#define RA_REQUEST(pair_) do { const int item_ = 2 * (pair_) + hb, c_ = (item_ >> 3) & 127, b_ = item_ >> 10; const size_t tok0_ = (size_t)b_ * SEQ + c_ * 64; \
        int lq_ = F.lane; asm volatile("" : "+v"(lq_)); size_t wsq_ = (size_t)ws; asm volatile("" : "+s"(wsq_)); const int t9q_ = (hb << 8) | (w4 << 6) | lq_; \
        const bf16* cur_ = (const bf16*)(wsq_ + WS_PROJ) + (tok0_ + (t9q_ >> 3)) * INC + PRW + 1536 + 32 * (t9q_ & 7); \
        _Pragma("unroll") for (int g8 = 0; g8 < 4; ++g8) s0c[g8] = *(const v4u*)(cur_ + 8 * g8); } while (0)
    if (F.bid < NITEM / 2) RA_REQUEST(F.bid);
    for (int pair = F.bid; pair < NITEM / 2; pair += F.G) {
        size_t wsb = (size_t)ws; asm volatile("" : "+s"(wsb)); const bf16* proj = (const bf16*)(wsb + WS_PROJ);
        int l = F.lane; asm volatile("" : "+v"(l));
        const int n16 = l & 15, q = l >> 4, t4 = (hb << 8 | (F.wave & 3) << 6 | l) & 255;
        const int tokl = 16 * w4 + n16;
        const int tslot = (tokl & 32) + 8 * ((tokl >> 2) & 3) + 4 * ((tokl >> 4) & 1) + (tokl & 3);
        const int item = 2 * pair + hb, h = item & 7, c = (item >> 3) & 127, b = item >> 10;
        const size_t tok0 = (size_t)b * SEQ + c * 64; unsigned char* rbi = rb + (size_t)item * RB_REC;
        const int t9 = (hb << 8) | t4, tk0 = t9 >> 3, part = t9 & 7;
        v4u s0p[4];
        { const bool first = (c == 0 && tk0 == 0); const bf16* prv = proj + (tok0 + tk0) * INC + PRW + 1536 + 32 * part - INC;
#pragma unroll
          for (int g8 = 0; g8 < 4; ++g8) { s0p[g8] = (v4u){0u, 0u, 0u, 0u}; if (!first) s0p[g8] = *(const v4u*)(prv + 8 * g8); } }
        v2u rawc[3][4], rawp[3][4];
        { const bool first = (c == 0 && tokl == 0); const bf16* cur = proj + (tok0 + tokl) * INC + PRW + h * 64 + 4 * q; const bf16* prv = cur - INC;
#pragma unroll
          for (int m = 0; m < 3; ++m)
#pragma unroll
              for (int ct = 0; ct < 4; ++ct) { rawc[m][ct] = *(const v2u*)(cur + 512 * m + 16 * ct); rawp[m][ct] = (v2u){0u, 0u}; if (!first) rawp[m][ct] = *(const v2u*)(prv + 512 * m + 16 * ct); } }
        bf16x8 wfr[2][8];
#define RA_WLOAD(dst, ctv) do { const int row_ = h * 64 + 16 * (ctv) + n16; \
            dst[0] = *(const bf16x8*)(wdec + row_ * 64 + 8 * q); dst[1] = *(const bf16x8*)(wdec + row_ * 64 + 32 + 8 * q); \
            dst[2] = *(const bf16x8*)(waaa + row_ * 64 + 8 * q); dst[3] = *(const bf16x8*)(waaa + row_ * 64 + 32 + 8 * q); \
            _Pragma("unroll") for (int ks_ = 0; ks_ < 4; ++ks_) dst[4 + ks_] = *(const bf16x8*)(wgate + row_ * 128 + 32 * ks_ + 8 * q); } while (0)
        RA_WLOAD(wfr[0], 0); RA_WLOAD(wfr[1], 1);
        __syncthreads();
        { const float esc = part < 2 ? 2.8853900817779268f : -1.4426950408889634f;
          LAS unsigned char* dst = F.lds + (part < 2 ? RA_XWD + tk0 * 144 + part * 64 : (part < 4 ? RA_XAD + tk0 * 144 + (part - 2) * 64 : RA_XGD + tk0 * 272 + (part - 4) * 64));
#pragma unroll
          for (int g8 = 0; g8 < 4; ++g8) {
              const unsigned xw[4] = {s0c[g8].x, s0c[g8].y, s0c[g8].z, s0c[g8].w}, pw[4] = {s0p[g8].x, s0p[g8].y, s0p[g8].z, s0p[g8].w};
              const f32x4 m0 = *(const f32x4*)(mu + 1536 + 32 * part + 8 * g8), m1 = *(const f32x4*)(mu + 1536 + 32 * part + 8 * g8 + 4);
              float y[8];
#pragma unroll
              for (int j = 0; j < 8; ++j) { const float x = (j & 1) ? bfhi(xw[j >> 1]) : bflo(xw[j >> 1]), p = (j & 1) ? bfhi(pw[j >> 1]) : bflo(pw[j >> 1]);
                  const float xs = x + (p - x) * (j < 4 ? m0[j & 3] : m1[j & 3]);
                  const float rc = __builtin_amdgcn_rcpf(1.0f + __builtin_amdgcn_exp2f(esc * xs));
                  y[j] = part < 2 ? 1.0f - 2.0f * rc : (part < 4 ? xs : rc); }
              const v4u o = {pk2(y[0], y[1]), pk2(y[2], y[3]), pk2(y[4], y[5]), pk2(y[6], y[7])};
              *(LAS v4u*)(dst + 16 * g8) = o; } }
        v2u shv[3][4];
#pragma unroll
        for (int m = 0; m < 3; ++m)
#pragma unroll
            for (int ct = 0; ct < 4; ++ct) { const v2u xw = rawc[m][ct], pw = rawp[m][ct];
                const f32x4 mm = *(const f32x4*)(mu + 512 * m + h * 64 + 16 * ct + 4 * q);
                const float x0 = bflo(xw.x), x1 = bfhi(xw.x), x2 = bflo(xw.y), x3 = bfhi(xw.y);
                shv[m][ct].x = pk2(x0 + (bflo(pw.x) - x0) * mm[0], x1 + (bfhi(pw.x) - x1) * mm[1]); shv[m][ct].y = pk2(x2 + (bflo(pw.y) - x2) * mm[2], x3 + (bfhi(pw.y) - x3) * mm[3]); }
        __syncthreads();
        f32x4 awl[4], aal[4], ag[4];
        { bf16x8 bwd[2], bad[2], bgd[4], wf2[2][8];
          RA_WLOAD(wf2[0], 2); RA_WLOAD(wf2[1], 3);
#pragma unroll
          for (int ks = 0; ks < 2; ++ks) { bwd[ks] = *(const LAS bf16x8*)(F.lds + RA_XWD + tokl * 144 + 64 * ks + 16 * q); bad[ks] = *(const LAS bf16x8*)(F.lds + RA_XAD + tokl * 144 + 64 * ks + 16 * q); }
#pragma unroll
          for (int ks = 0; ks < 4; ++ks) bgd[ks] = *(const LAS bf16x8*)(F.lds + RA_XGD + tokl * 272 + 64 * ks + 16 * q);
#pragma unroll
          for (int ct = 0; ct < 4; ++ct) { const bf16x8* wv = ct < 2 ? wfr[ct] : wf2[ct - 2];
              awl[ct] = (f32x4){0.f, 0.f, 0.f, 0.f}; aal[ct] = awl[ct]; ag[ct] = awl[ct];
#pragma unroll
              for (int ks = 0; ks < 2; ++ks) { awl[ct] = MFMA16(wv[ks], bwd[ks], awl[ct]); aal[ct] = MFMA16(wv[2 + ks], bad[ks], aal[ct]); }
#pragma unroll
              for (int ks = 0; ks < 4; ++ks) ag[ct] = MFMA16(wv[4 + ks], bgd[ks], ag[ct]); } }
#undef RA_WLOAD
        v2u rtp[4];
        {
#define RA_SHIFT(dst, pcol, ctv) do { const v2u w_ = shv[(pcol) / 512][ctv]; dst[0] = bflo(w_.x); dst[1] = bfhi(w_.x); dst[2] = bflo(w_.y); dst[3] = bfhi(w_.y); } while (0)
          float nrm = 0.f, bd = 0.f;
#pragma unroll
          for (int ct = 0; ct < 4; ++ct) { const int ch = h * 64 + 16 * ct + 4 * q;
              float r4[4], k4[4]; RA_SHIFT(r4, 0, ct); RA_SHIFT(k4, 512, ct);
              const f32x4 a0v = *(const f32x4*)(par + 512 + ch), kkv = *(const f32x4*)(par + 1024 + ch), kav = *(const f32x4*)(par + 1536 + ch), rkv = *(const f32x4*)(par + 2048 + ch);
#pragma unroll
              for (int i = 0; i < 4; ++i) { const float av = fast_sigmoid(a0v[i] + aal[ct][i]); const float kk = k4[i] * kkv[i]; nrm += kk * kk;
                  bd += r4[i] * (k4[i] * (1.0f + (av - 1.0f) * kav[i])) * rkv[i]; } }
          nrm = quad_sum(nrm); bd = quad_sum(bd);
          const float kinv = 1.0f / fmaxf(sqrtf(nrm), 1e-12f);
          float lw[4][4], lg[4][4], lgend[4][4];
#pragma unroll
          for (int ct = 0; ct < 4; ++ct) { const f32x4 w0v = *(const f32x4*)(par + h * 64 + 16 * ct + 4 * q);
#pragma unroll
              for (int i = 0; i < 4; ++i) { lw[ct][i] = (-0.6065306597126334f * LOG2E) * fast_sigmoid(w0v[i] + awl[ct][i]); float x = lw[ct][i];
                  x += __builtin_bit_cast(float, __builtin_amdgcn_update_dpp(0, __builtin_bit_cast(int, x), 0x111, 0xf, 0xf, false));
                  x += __builtin_bit_cast(float, __builtin_amdgcn_update_dpp(0, __builtin_bit_cast(int, x), 0x112, 0xf, 0xf, false));
                  x += __builtin_bit_cast(float, __builtin_amdgcn_update_dpp(0, __builtin_bit_cast(int, x), 0x114, 0xf, 0xf, false));
                  x += __builtin_bit_cast(float, __builtin_amdgcn_update_dpp(0, __builtin_bit_cast(int, x), 0x118, 0xf, 0xf, false));
                  lg[ct][i] = x; } }
          LAS float* wt = (LAS float*)(hbase + RA_WT);
          if (n16 == 15) {
#pragma unroll
              for (int ct = 0; ct < 4; ++ct) *(LAS f32x4*)(wt + w4 * 64 + 16 * ct + 4 * q) = (f32x4){lg[ct][0], lg[ct][1], lg[ct][2], lg[ct][3]}; }
          __syncthreads();
#pragma unroll
          for (int ct = 0; ct < 4; ++ct) { f32x4 off = {0.f, 0.f, 0.f, 0.f}, tot = {0.f, 0.f, 0.f, 0.f};
#pragma unroll
              for (int w = 0; w < 4; ++w) { const f32x4 t = *(const LAS f32x4*)(wt + w * 64 + 16 * ct + 4 * q); tot = tot + t; if (w < w4) off = off + t; }
#pragma unroll
              for (int i = 0; i < 4; ++i) { lg[ct][i] += off[i]; lgend[ct][i] = tot[i]; } }
#pragma unroll
          for (int ct = 0; ct < 4; ++ct) { const int ch = h * 64 + 16 * ct + 4 * q;
              float r4[4], k4[4], v4[4]; RA_SHIFT(r4, 0, ct); RA_SHIFT(k4, 512, ct); RA_SHIFT(v4, 1024, ct);
              const f32x4 a0v = *(const f32x4*)(par + 512 + ch), kkv = *(const f32x4*)(par + 1024 + ch), kav = *(const f32x4*)(par + 1536 + ch);
              const f32x4 lg_ = *(const f32x4*)(par + 2560 + ch), lb_ = *(const f32x4*)(par + 3072 + ch);
              float rtl[4], ktl[4], btl[4], atl[4], khh[4], bhh[4], g1[4], e2[4];
#pragma unroll
              for (int i = 0; i < 4; ++i) {
                  const float av = fast_sigmoid(a0v[i] + aal[ct][i]); const float k2 = k4[i] * (1.0f + (av - 1.0f) * kav[i]);
                  const float kkn = k4[i] * kkv[i] * kinv, bb = kkn * av;
                  const float gam = __builtin_amdgcn_exp2f(lg[ct][i]), gpv = __builtin_amdgcn_exp2f(lg[ct][i] - lw[ct][i]), gin = __builtin_amdgcn_exp2f(-lg[ct][i]), ger = __builtin_amdgcn_exp2f(lgend[ct][i] - lg[ct][i]);
                  rtl[i] = r4[i] * gam; ktl[i] = k2 * gin; btl[i] = bb * gin; atl[i] = -kkn * gpv; khh[i] = k2 * ger; bhh[i] = bb * ger;
                  const float g = ag[ct][i]; g1[i] = lg_[i] * g; e2[i] = (lb_[i] + bd * v4[i]) * g;
              }
              const int fo = ((w4 * 4 + ct) * 64 + l) * 8;
              v2u o; o.x = pk2(g1[0], g1[1]); o.y = pk2(g1[2], g1[3]); __builtin_nontemporal_store(o, (v2u*)(rbi + RB_G1T + fo));
              o.x = pk2(e2[0], e2[1]); o.y = pk2(e2[2], e2[3]); __builtin_nontemporal_store(o, (v2u*)(rbi + RB_E2T + fo));
              const int co = tokl * 144 + (16 * ct + 4 * q) * 2;
              o.x = pk2(rtl[0], rtl[1]); o.y = pk2(rtl[2], rtl[3]); *(LAS v2u*)(hbase + RA_RT + co) = o; rtp[ct] = o;
              o.x = pk2(ktl[0], ktl[1]); o.y = pk2(ktl[2], ktl[3]); *(LAS v2u*)(hbase + RA_KT + co) = o;
              o.x = pk2(btl[0], btl[1]); o.y = pk2(btl[2], btl[3]); *(LAS v2u*)(hbase + RA_BT + co) = o;
              o.x = pk2(atl[0], atl[1]); o.y = pk2(atl[2], atl[3]); *(LAS v2u*)(hbase + RA_AT + co) = o;
#pragma unroll
              for (int i = 0; i < 4; ++i) { const int ro = (16 * ct + 4 * q + i) * 144 + 2 * tslot;
                  if (tokl == 0) *(LAS float*)(hbase + RA_VT + (16 * ct + 4 * q + i) * 144 + 128) = __builtin_amdgcn_exp2f(lgend[ct][i]);
                  *(LAS unsigned short*)(hbase + RA_VT + ro) = (unsigned short)(pk2(v4[i], 0.f) & 0xffffu);
                  *(LAS unsigned short*)(hbase + RA_KH + ro) = (unsigned short)(pk2(khh[i], 0.f) & 0xffffu);
                  *(LAS unsigned short*)(hbase + RA_BH + ro) = (unsigned short)(pk2(bhh[i], 0.f) & 0xffffu); }
              asm volatile("" ::: "memory");
          }
#undef RA_SHIFT
        }
        __syncthreads();
        bf16x8 akp[2], rkp[2], rbp[2];
        { bf16x8 fa[2], fr[2];
#pragma unroll
          for (int ks = 0; ks < 2; ++ks) { fa[ks] = *(const LAS bf16x8*)(hbase + RA_AT + tokl * 144 + 64 * ks + 16 * q); fr[ks] = *(const LAS bf16x8*)(hbase + RA_RT + tokl * 144 + 64 * ks + 16 * q); }
          f32x4 aak[4], arkk[4], arb[4];
#pragma unroll
          for (int jt = 0; jt < 4; ++jt) {
              f32x4 tab = {0.f, 0.f, 0.f, 0.f}; aak[jt] = tab; arkk[jt] = tab; arb[jt] = tab;
              if (jt <= w4) {
#pragma unroll
                  for (int ks = 0; ks < 2; ++ks) { const bf16x8 fk = *(const LAS bf16x8*)(hbase + RA_KT + (16 * jt + n16) * 144 + 64 * ks + 16 * q), fb = *(const LAS bf16x8*)(hbase + RA_BT + (16 * jt + n16) * 144 + 64 * ks + 16 * q);
                      aak[jt] = MFMA16(fk, fa[ks], aak[jt]); tab = MFMA16(fb, fa[ks], tab); arkk[jt] = MFMA16(fk, fr[ks], arkk[jt]); arb[jt] = MFMA16(fb, fr[ks], arb[jt]); }
                  if (jt == w4) {
#pragma unroll
                      for (int i = 0; i < 4; ++i) { const int j = 4 * q + i; if (j >= n16) { aak[jt][i] = 0.f; tab[i] = 0.f; } if (j > n16) { arkk[jt][i] = 0.f; arb[jt][i] = 0.f; } } }
                  *(LAS f32x4*)(hbase + RA_AAB + tokl * 256 + (16 * jt + 4 * q) * 4) = tab;
              }
          }
#pragma unroll
          for (int s = 0; s < 2; ++s) { akp[s] = pack8(aak[2 * s], aak[2 * s + 1]); rkp[s] = pack8(arkk[2 * s], arkk[2 * s + 1]); rbp[s] = pack8(arb[2 * s], arb[2 * s + 1]); } }
        { f32x4 akv[4];
#pragma unroll
          for (int vt = 0; vt < 4; ++vt) { akv[vt] = (f32x4){0.f, 0.f, 0.f, 0.f};
#pragma unroll
              for (int s = 0; s < 2; ++s) { const bf16x8 fv = *(const LAS bf16x8*)(hbase + RA_VT + (16 * vt + n16) * 144 + 64 * s + 16 * q); akv[vt] = MFMA16(akp[s], fv, akv[vt]); } }
          __syncthreads();
#pragma unroll
          for (int vt = 0; vt < 4; ++vt) *(LAS f32x4*)(hbase + RA_RHS2 + (16 * vt + n16) * 272 + (16 * w4 + 4 * q) * 4) = akv[vt]; }
        if (pair + F.G < NITEM / 2) RA_REQUEST(pair + F.G);
        { const LAS unsigned char* aab = hbase + RA_AAB + (16 * w4) * 256 + (16 * w4) * 4;
          LAS unsigned char* ti = hbase + RA_BT;
          if (q == 0) { float t[16];
#pragma unroll
              for (int r_ = 0; r_ < 16; ++r_) { float acc = (r_ == n16) ? 1.0f : 0.0f;
#pragma unroll
                  for (int j4 = 0; j4 < (r_ + 3) / 4; ++j4) { const f32x4 av = *(const LAS f32x4*)(aab + r_ * 256 + j4 * 16);
#pragma unroll
                      for (int e = 0; e < 4; ++e) if (4 * j4 + e < r_) acc += av[e] * t[4 * j4 + e]; }
                  t[r_] = acc; *(LAS unsigned short*)(ti + w4 * 512 + r_ * 32 + 2 * n16) = (unsigned short)(pk2(acc, 0.f) & 0xffffu); } }
          __syncthreads();
          bf16x8 a10, a20, a30, a31, tf[4];
          { const LAS unsigned char* ab = hbase + RA_AAB + n16 * 256 + 16 * q; const f32x4 z4 = {0.f, 0.f, 0.f, 0.f};
            const f32x4 l10 = *(const LAS f32x4*)(ab + 16 * 256), l20 = *(const LAS f32x4*)(ab + 32 * 256), l21 = *(const LAS f32x4*)(ab + 32 * 256 + 64);
            const f32x4 l30 = *(const LAS f32x4*)(ab + 48 * 256), l31 = *(const LAS f32x4*)(ab + 48 * 256 + 64), l32 = *(const LAS f32x4*)(ab + 48 * 256 + 128);
            a10 = pack8(l10, z4); a20 = pack8(l20, l21); a30 = pack8(l30, l31); a31 = pack8(l32, z4);
#pragma unroll
            for (int I = 0; I < 4; ++I) { const v2u tw = *(const LAS v2u*)(ti + I * 512 + n16 * 32 + 8 * q); const v4u t4 = {tw.x, tw.y, 0u, 0u}; tf[I] = __builtin_bit_cast(bf16x8, t4); } }
          v4u xw[2][2];
#pragma unroll
          for (int m = 0; m < 2; ++m) {
              v4u x0 = {0u, 0u, 0u, 0u}, x1 = {0u, 0u, 0u, 0u};
#pragma unroll
              for (int I = 0; I < 4; ++I) {
                  f32x4 z;
                  if (m == 0) {
#pragma unroll
                      for (int i = 0; i < 4; ++i) z[i] = bf2f(*(const LAS unsigned short*)(hbase + RA_AT + (16 * I + 4 * q + i) * 144 + 2 * tokl)); }
                  else z = *(const LAS f32x4*)(hbase + RA_RHS2 + tokl * 272 + (16 * I + 4 * q) * 4);
                  if (I == 1) z = MFMA16(a10, __builtin_bit_cast(bf16x8, x0), z);
                  if (I == 2) z = MFMA16(a20, __builtin_bit_cast(bf16x8, x0), z);
                  if (I == 3) { z = MFMA16(a30, __builtin_bit_cast(bf16x8, x0), z); z = MFMA16(a31, __builtin_bit_cast(bf16x8, x1), z); }
                  const v4u zb = {pk2(z[0], z[1]), pk2(z[2], z[3]), 0u, 0u};
                  const f32x4 x = MFMA16(tf[I], __builtin_bit_cast(bf16x8, zb), ((f32x4){0.f, 0.f, 0.f, 0.f}));
                  const unsigned p0 = pk2(x[0], x[1]), p1 = pk2(x[2], x[3]);
                  if (I == 0) { x0.x = p0; x0.y = p1; } if (I == 1) { x0.z = p0; x0.w = p1; } if (I == 2) { x1.x = p0; x1.y = p1; } if (I == 3) { x1.z = p0; x1.w = p1; }
              }
              xw[m][0] = x0; xw[m][1] = x1;
          }
          __syncthreads();
#pragma unroll
          for (int s = 0; s < 2; ++s) { *(LAS v4u*)(hbase + RA_W1T + tokl * 144 + 64 * s + 16 * q) = xw[0][s]; *(LAS v4u*)(hbase + RA_W2T + tokl * 144 + 64 * s + 16 * q) = xw[1][s]; }
        }
        __syncthreads();
        {
          f32x4 pc[4], y0[4];
#pragma unroll
          for (int t = 0; t < 4; ++t) { pc[t] = (f32x4){bflo(rtp[t].x), bfhi(rtp[t].x), bflo(rtp[t].y), bfhi(rtp[t].y)}; y0[t] = (f32x4){0.f, 0.f, 0.f, 0.f};
#pragma unroll
              for (int s = 0; s < 2; ++s) { y0[t] = MFMA16(*(const LAS bf16x8*)(hbase + RA_VT + (16 * t + n16) * 144 + 64 * s + 16 * q), rkp[s], y0[t]);
                                            y0[t] = MFMA16(*(const LAS bf16x8*)(hbase + RA_W2T + (16 * t + n16) * 144 + 64 * s + 16 * q), rbp[s], y0[t]);
                                            pc[t] = MFMA16(*(const LAS bf16x8*)(hbase + RA_W1T + (16 * t + n16) * 144 + 64 * s + 16 * q), rbp[s], pc[t]); } }
#pragma unroll
          for (int vt = 0; vt < 4; ++vt) { v2u o; o.x = pk2(y0[vt][0], y0[vt][1]); o.y = pk2(y0[vt][2], y0[vt][3]); __builtin_nontemporal_store(o, (v2u*)(rbi + RB_YLT + ((w4 * 4 + vt) * 64 + l) * 8)); }
#pragma unroll
          for (int s = 0; s < 2; ++s) __builtin_nontemporal_store(pack8(pc[2 * s], pc[2 * s + 1]), (bf16x8*)(rbi + RB_PCT + ((w4 * 2 + s) * 64 + l) * 16));
          f32x4 mc[4]; bf16x8 fb[2], fvv[2];
#pragma unroll
          for (int s = 0; s < 2; ++s) { fb[s] = *(const LAS bf16x8*)(hbase + RA_BH + tokl * 144 + 64 * s + 16 * q); fvv[s] = *(const LAS bf16x8*)(hbase + RA_VT + tokl * 144 + 64 * s + 16 * q); }
          const float gend_k = *(const LAS float*)(hbase + RA_VT + tokl * 144 + 128);
#pragma unroll
          for (int t = 0; t < 4; ++t) { mc[t] = (f32x4){0.f, 0.f, 0.f, 0.f};
#pragma unroll
              for (int s = 0; s < 2; ++s) mc[t] = MFMA16(*(const LAS bf16x8*)(hbase + RA_W1T + (16 * t + n16) * 144 + 64 * s + 16 * q), fb[s], mc[t]);
              if (t == w4) {
#pragma unroll
                  for (int i = 0; i < 4; ++i) if (4 * q + i == n16) mc[t][i] += gend_k; } }
#pragma unroll
          for (int s = 0; s < 2; ++s) __builtin_nontemporal_store(pack8(mc[2 * s], mc[2 * s + 1]), (bf16x8*)(rbi + RB_MC + ((w4 * 2 + s) * 64 + l) * 16));
          bf16x8 fw2[2];
#pragma unroll
          for (int s = 0; s < 2; ++s) fw2[s] = *(const LAS bf16x8*)(hbase + RA_W2T + tokl * 144 + 64 * s + 16 * q);
#pragma unroll
          for (int kt = 0; kt < 4; ++kt) { f32x4 cc = {0.f, 0.f, 0.f, 0.f};
#pragma unroll
              for (int s = 0; s < 2; ++s) { cc = MFMA16(*(const LAS bf16x8*)(hbase + RA_KH + (16 * kt + n16) * 144 + 64 * s + 16 * q), fvv[s], cc);
                                            cc = MFMA16(*(const LAS bf16x8*)(hbase + RA_BH + (16 * kt + n16) * 144 + 64 * s + 16 * q), fw2[s], cc); }
              v2u cw; cw.x = pk2(cc[0], cc[1]); cw.y = pk2(cc[2], cc[3]); __builtin_nontemporal_store(cw, (v2u*)(rbi + RB_CC + ((w4 * 4 + kt) * 64 + l) * 8)); } }
    }
}

constexpr int RBK_NS = 9, RBK_D = 8, RBK_SLOT = 16384, RBK_BLOCKS = 32;
static_assert(RBK_NS * RBK_SLOT <= MISC_OFF && RBK_D == RBK_NS - 1, "phase B ring");
DI void rwkv_phase_b(const Frame& F, const Args& a) {
    if (F.bid >= RBK_BLOCKS) return;
    unsigned char* rb = a.ws + WS_RW; const int l = F.lane, w = F.wave;
    const int h = F.bid & 7, b = F.bid >> 3;
    LAS unsigned char* lds = F.lds;
    if (w >= 4) {
        const int j = w - 4;
#define RBK_ISSUE(cc_) do { const int c_ = (cc_) < NCHUNK ? (cc_) : NCHUNK - 1; const unsigned char* r_ = rb + (size_t)(((b * 128 + c_) << 3) + h) * RB_REC; \
            LAS unsigned char* slot_ = lds + ((cc_) % RBK_NS) * RBK_SLOT; \
            _Pragma("unroll") for (int k_ = 0; k_ < 4; ++k_) { const int blk_ = 4 * j + k_; \
                const unsigned char* src_ = blk_ < 8 ? r_ + RB_MC + blk_ * 1024 : r_ + RB_CC + (blk_ - 8) * 1024; \
                __builtin_amdgcn_global_load_lds((const unsigned*)(src_ + l * 16), (LAS unsigned*)(slot_ + blk_ * 1024), 16, 0, 0); } } while (0)
        for (int c = 0; c < RBK_D; ++c) RBK_ISSUE(c);
        for (int c = 0; c < NCHUNK; ++c) {
            asm volatile("s_waitcnt vmcnt(28)" ::: "memory");
            __builtin_amdgcn_s_barrier();
            RBK_ISSUE(c + RBK_D);
        }
        asm volatile("s_waitcnt vmcnt(0)" ::: "memory");
        __builtin_amdgcn_s_barrier();
#undef RBK_ISSUE
    } else {
        const int vs = w;
        f32x4 st[4];
#pragma unroll
        for (int kt = 0; kt < 4; ++kt) st[kt] = (f32x4){0.f, 0.f, 0.f, 0.f};
        for (int c = 0; c < NCHUNK; ++c) {
            unsigned char* rbi = rb + (size_t)(((b * 128 + c) << 3) + h) * RB_REC;
            bf16x8 sb[2];
#pragma unroll
            for (int s = 0; s < 2; ++s) { sb[s] = pack8(st[2 * s], st[2 * s + 1]); *(bf16x8*)(rbi + RB_SC + ((vs * 2 + s) * 64 + l) * 16) = sb[s]; }
            __builtin_amdgcn_s_barrier();
            const LAS unsigned char* slot = lds + (c % RBK_NS) * RBK_SLOT;
#pragma unroll
            for (int kt = 0; kt < 4; ++kt) { const v2u cw = *(const LAS v2u*)(slot + 8192 + ((vs * 4 + kt) * 64 + l) * 8);
                f32x4 n = {bflo(cw.x), bfhi(cw.x), bflo(cw.y), bfhi(cw.y)};
#pragma unroll
                for (int s = 0; s < 2; ++s) n = MFMA16(*(const LAS bf16x8*)(slot + ((kt * 2 + s) * 64 + l) * 16), sb[s], n);
                st[kt] = n; }
        }
        __builtin_amdgcn_s_barrier();
    }
}

struct RcOps { bf16x8 pc[2]; v2u yl[4]; bf16x8 sc[4][2]; v2u g1[4], e2[4]; };
DI void rc_load(RcOps& o, const unsigned char* rb, int task, int l) {
    const int item = task >> 2, it = task & 3; const unsigned char* rbi = rb + (size_t)item * RB_REC;
#pragma unroll
    for (int s = 0; s < 2; ++s) o.pc[s] = __builtin_nontemporal_load((const bf16x8*)(rbi + RB_PCT + ((it * 2 + s) * 64 + l) * 16));
#pragma unroll
    for (int vt = 0; vt < 4; ++vt) { const int fo = ((it * 4 + vt) * 64 + l) * 8;
        o.yl[vt] = __builtin_nontemporal_load((const v2u*)(rbi + RB_YLT + fo)); o.g1[vt] = __builtin_nontemporal_load((const v2u*)(rbi + RB_G1T + fo)); o.e2[vt] = __builtin_nontemporal_load((const v2u*)(rbi + RB_E2T + fo));
#pragma unroll
        for (int s = 0; s < 2; ++s) o.sc[vt][s] = __builtin_nontemporal_load((const bf16x8*)(rbi + RB_SC + ((vt * 2 + s) * 64 + l) * 16)); }
}
DI void rwkv_phase_c(const Frame& F, const Args& a) {
    const unsigned char* rb = a.ws + WS_RW; bf16* mix = (bf16*)(a.ws + WS_MIX);
    const int l = F.lane, n16 = l & 15, q = l >> 4;
    const int gw = F.bid * NWAVES + F.wave, NGW = F.G * NWAVES;
    RcOps cur, nxt;
    if (gw < NITEM * 4) rc_load(cur, rb, gw, l);
    for (int task = gw; task < NITEM * 4; task += NGW) {
        const int item = task >> 2, it = task & 3, h = item & 7, c = (item >> 3) & 127, b = item >> 10;
        if (task + NGW < NITEM * 4) rc_load(nxt, rb, task + NGW, l);
        f32x4 y[4]; float sum = 0.f;
#pragma unroll
        for (int vt = 0; vt < 4; ++vt) { y[vt] = (f32x4){bflo(cur.yl[vt].x), bfhi(cur.yl[vt].x), bflo(cur.yl[vt].y), bfhi(cur.yl[vt].y)};
#pragma unroll
            for (int s = 0; s < 2; ++s) y[vt] = MFMA16(cur.sc[vt][s], cur.pc[s], y[vt]);
            sum += (y[vt][0] + y[vt][1]) + (y[vt][2] + y[vt][3]); }
        sum = quad_sum(sum);
        const float mean = sum * (1.f / 64.f); float sq = 0.f;
#pragma unroll
        for (int vt = 0; vt < 4; ++vt) { y[vt] = y[vt] - mean; sq += (y[vt][0] * y[vt][0] + y[vt][1] * y[vt][1]) + (y[vt][2] * y[vt][2] + y[vt][3] * y[vt][3]); }
        sq = quad_sum(sq);
        const float rstd = 1.0f / sqrtf(sq * (1.f / 64.f) + 64e-5f);
        const size_t tok = (size_t)b * SEQ + c * 64 + 16 * it + n16;
#pragma unroll
        for (int vt = 0; vt < 4; ++vt) { const v2u g = cur.g1[vt], e = cur.e2[vt];
            v2u o; o.x = pk2(y[vt][0] * rstd * bflo(g.x) + bflo(e.x), y[vt][1] * rstd * bfhi(g.x) + bfhi(e.x)); o.y = pk2(y[vt][2] * rstd * bflo(g.y) + bflo(e.y), y[vt][3] * rstd * bfhi(g.y) + bfhi(e.y));
            *(v2u*)(mix + tok * 1024 + 512 + h * 64 + 16 * vt + 4 * q) = o; }
        cur = nxt;
    }
}
#endif

DI void p0_prologue(const Frame& F, const Args& a) {
    unsigned char* ws = a.ws;
    LAS float* scr = (LAS float*)(F.lds + F.wave * 16384);
    const int gw = F.bid * NWAVES + F.wave, NGW = F.G * NWAVES;
    constexpr int I_IN = 16 * 104, I_OUT = 16 * 32, I_DEC = 16, I_AAA = 16, I_GATE = 32;
    constexpr int NITEMS = I_IN + I_OUT + I_DEC + I_AAA + I_GATE;
    for (int it = gw; it < NITEMS; it += NGW) {
        int r = it;
        if (r < I_IN) { const int kb = r / 104, nb = r % 104; tr_item(a.in[I_WIN], INC, 64 * kb, 32 * nb, (bf16*)(ws + WS_WIN), 1024, 32 * nb, scr, F.lane, nullptr); continue; } r -= I_IN;
        if (r < I_OUT) { const int kb = r / 32, nb = r % 32; tr_item(a.in[I_WOUT], 1024, 64 * kb, 32 * nb, (bf16*)(ws + WS_WOUT), 1024, 32 * nb, scr, F.lane, nullptr); continue; } r -= I_OUT;
        if (r < I_DEC) { tr_item(a.in[I_WDEC], 512, 0, 32 * r, (bf16*)(ws + WS_WDEC), 64, 32 * r, scr, F.lane, nullptr); continue; } r -= I_DEC;
        if (r < I_AAA) { tr_item(a.in[I_WAAA], 512, 0, 32 * r, (bf16*)(ws + WS_WAAA), 64, 32 * r, scr, F.lane, nullptr); continue; } r -= I_AAA;
        { const int kb = r / 16, nb = r % 16; tr_item(a.in[I_WGATE], 512, 64 * kb, 32 * nb, (bf16*)(ws + WS_WGATE), 128, 32 * nb, scr, F.lane, nullptr); }
    }
    { float* wrt = (float*)(ws + WS_WRT); const float* wr = a.in[I_WR]; const float* g2 = a.in[I_N2G];
      for (int i = F.bid * 512 + F.tid; i < 32 * 1024; i += F.G * 512) { const int e = i >> 10, k = i & 1023; wrt[i] = g2[k] * wr[k * 32 + e]; } }
    { float* par = (float*)(ws + WS_PAR); const int srcs[7] = {I_W0, I_A0, I_KK, I_KA, I_RK, I_LNG, I_LNB};
      for (int i = F.bid * 512 + F.tid; i < 7 * 512; i += F.G * 512) { const int k = i >> 9; float v = 0.f;
#pragma unroll
          for (int j = 0; j < 7; ++j) if (k == j) v = a.in[srcs[j]][i & 511];
          par[i] = v; } }
    { const float* x = a.in[I_X]; const float* g1 = a.in[I_N1G]; bf16* xn = (bf16*)(ws + WS_XN);
      f32x4 gv[4];
#pragma unroll
      for (int j = 0; j < 4; ++j) gv[j] = *((const f32x4*)g1 + F.lane + 64 * j);
      for (int m0 = 2 * gw; m0 < T; m0 += 2 * NGW) {
          f32x4 v[2][4];
#pragma unroll
          for (int r = 0; r < 2; ++r) { const f32x4* xr = (const f32x4*)(x + (size_t)(m0 + r) * D) + F.lane;
#pragma unroll
              for (int j = 0; j < 4; ++j) v[r][j] = __builtin_nontemporal_load(xr + 64 * j); }
#pragma unroll
          for (int r = 0; r < 2; ++r) { float s = 0.f;
#pragma unroll
              for (int j = 0; j < 4; ++j) s += (v[r][j].x * v[r][j].x + v[r][j].y * v[r][j].y) + (v[r][j].z * v[r][j].z + v[r][j].w * v[r][j].w);
              const float rs = 1.0f / sqrtf(wave_sum(s) * (1.f / D) + 1e-6f);
              v2u* o8 = (v2u*)(xn + (size_t)(m0 + r) * D) + F.lane;
#pragma unroll
              for (int j = 0; j < 4; ++j) { v2u o; o.x = pk2(v[r][j].x * rs * gv[j].x, v[r][j].y * rs * gv[j].y); o.y = pk2(v[r][j].z * rs * gv[j].z, v[r][j].w * rs * gv[j].w); o8[64 * j] = o; } }
      } }
}

#if NAIVE_RWKV
DI void rwkv_naive_prep(const Frame& F, const Args& a) {
    const bf16* proj = (const bf16*)(a.ws + WS_PROJ); LAS float* sx = (LAS float*)F.lds;
    float* RW = (float*)(a.ws + WS_RW); float* GG = (float*)(a.ws + WS_XN);
    const float* mu = a.in[I_MU]; const int c = F.tid;
    for (int t = F.bid; t < T; t += F.G) {
        const bool first = (t % SEQ) == 0; const bf16* cur = proj + (size_t)t * INC + PRW; const bf16* prv = cur - INC;
#define SH_(col) ({ const float x_ = bf2f(cur[col]); const float p_ = first ? 0.f : bf2f(prv[col]); x_ + (p_ - x_) * mu[col]; })
        if (c < 256) { const float v = SH_(1536 + c); sx[c] = c < 64 ? tanhf(v) : (c < 128 ? v : sigmoidf_(v)); }
        __syncthreads();
        const float r = SH_(c), k = SH_(512 + c), v = SH_(1024 + c);
#undef SH_
        float wl = a.in[I_W0][c], al = a.in[I_A0][c], g = 0.f;
        const float* wdec = a.in[I_WDEC] + c; const float* waaa = a.in[I_WAAA] + c; const float* wgate = a.in[I_WGATE] + c;
#pragma unroll 4
        for (int j = 0; j < 64; ++j) { wl += sx[j] * wdec[j * 512]; al += sx[64 + j] * waaa[j * 512]; }
#pragma unroll 4
        for (int j = 0; j < 128; ++j) g += sx[128 + j] * wgate[j * 512];
        const float dec = __expf(-0.6065306597126334f * sigmoidf_(wl)), av = sigmoidf_(al);
        float kk = k * a.in[I_KK][c]; const float n2 = wave_sum(kk * kk); kk = kk / fmaxf(sqrtf(n2), 1e-12f);
        const float k2 = k * (1.0f + (av - 1.0f) * a.in[I_KA][c]);
        const size_t o = (size_t)t * 512 + c; const size_t S1 = (size_t)T * 512;
        RW[o] = r; RW[S1 + o] = dec; RW[2 * S1 + o] = k2; RW[3 * S1 + o] = v; RW[4 * S1 + o] = kk; RW[5 * S1 + o] = av; GG[o] = g;
        __syncthreads();
    }
}
DI void rwkv_naive_scan(const Frame& F, const Args& a) {
    if (F.bid >= 32 || F.wave != 0) return;
    const int b = F.bid >> 3, h = F.bid & 7, l = F.lane, c = h * 64 + l;
    const float* RW = (const float*)(a.ws + WS_RW); const float* GG = (const float*)(a.ws + WS_XN); bf16* mix = (bf16*)(a.ws + WS_MIX);
    const size_t S1 = (size_t)T * 512; LAS float* sh = (LAS float*)F.lds;
    LAS float* st = sh + 512 + l;
    for (int k = 0; k < 64; ++k) st[64 * k] = 0.f;
    const float rk = a.in[I_RK][c], lg = a.in[I_LNG][c], lb = a.in[I_LNB][c];
    for (int s = 0; s < SEQ; ++s) {
        const size_t o = (size_t)(b * SEQ + s) * 512 + c;
        const float r = RW[o], w = RW[S1 + o], k2 = RW[2 * S1 + o], v = RW[3 * S1 + o], kk = RW[4 * S1 + o], av = RW[5 * S1 + o], g = GG[o];
        sh[l] = r; sh[64 + l] = w; sh[128 + l] = k2; sh[192 + l] = kk; sh[256 + l] = kk * av;
        LDS_WAIT();
        float sa = 0.f;
#pragma unroll 8
        for (int k = 0; k < 64; ++k) sa -= st[64 * k] * sh[192 + k];
        float y = 0.f;
#pragma unroll 8
        for (int k = 0; k < 64; ++k) { const float nv = st[64 * k] * sh[64 + k] + sa * sh[256 + k] + v * sh[128 + k]; st[64 * k] = nv; y += nv * sh[k]; }
        LDS_WAIT();
        const float mean = wave_sum(y) * (1.f / 64.f); const float d = y - mean; const float var = wave_sum(d * d) * (1.f / 64.f);
        const float yn = d * (1.0f / sqrtf(var + 64e-5f));
        const float bonus = wave_sum(r * k2 * rk) * v;
        const float outv = (yn * lg + lb + bonus) * g;
        mix[(size_t)(b * SEQ + s) * 1024 + 512 + c] = (bf16)(pk2(outv, 0.f) & 0xffffu);
    }
}
#endif
#if NAIVE_ATT
DI void attn_naive(const Frame& F, const Args& a) {
    const bf16* proj = (const bf16*)(a.ws + WS_PROJ); bf16* mix = (bf16*)(a.ws + WS_MIX);
    LAS float* sq = (LAS float*)(F.lds + F.wave * 1024);
    const int gw = F.bid * NWAVES + F.wave, NGW = F.G * NWAVES, l = F.lane;
    const float qg = a.in[I_QG][l];
    for (int it = gw; it < T * 8; it += NGW) {
        const int t = it >> 3, h = it & 7, b = t / SEQ, s = t % SEQ, n = s >> 6;
        const float qd = bf2f(proj[(size_t)t * INC + h * 64 + l]);
        const float qn = qd * (1.0f / sqrtf(wave_sum(qd * qd) * (1.f / 64.f) + 1e-6f)) * qg * 0.125f;
        sq[l] = qn; LDS_WAIT();
        float sc[9]; float mx = -3.0e38f;
#pragma unroll
        for (int r = 0; r < 9; ++r) {
            const int kp = (n - 8) * 64 + 64 * r + l; float v = -3.0e38f;
            if (kp >= 0) {
                const v4u* kr = (const v4u*)(proj + (size_t)(b * SEQ + kp) * INC + 512 + h * 64);
                float ss = 0.f, dot = 0.f;
#pragma unroll
                for (int j = 0; j < 8; ++j) { const v4u w = kr[j]; const unsigned ww[4] = {w.x, w.y, w.z, w.w};
#pragma unroll
                    for (int e = 0; e < 4; ++e) { const float k0 = bflo(ww[e]), k1 = bfhi(ww[e]); const int d0 = 8 * j + 2 * e;
                        ss += k0 * k0 + k1 * k1; dot += sq[d0] * a.in[I_KG][d0] * k0 + sq[d0 + 1] * a.in[I_KG][d0 + 1] * k1; } }
                int rel = kp - s; rel = rel < -128 ? -128 : (rel > 63 ? 63 : rel);
                v = dot * (1.0f / sqrtf(ss * (1.f / 64.f) + 1e-6f)) + a.in[I_RELB][h * 192 + rel + 128];
            }
            sc[r] = v; mx = fmaxf(mx, v);
        }
        mx = wave_max(mx); float sum = 0.f;
#pragma unroll
        for (int r = 0; r < 9; ++r) { sc[r] = (sc[r] > -1.0e38f) ? __expf(sc[r] - mx) : 0.f; sum += sc[r]; }
        sum = wave_sum(sum);
        float o = 0.f;
#pragma unroll
        for (int r = 0; r < 9; ++r) {
            const int kp0 = (n - 8) * 64 + 64 * r;
            if (kp0 >= 0) {
                const bf16* vp = proj + (size_t)(b * SEQ + kp0) * INC + 1024 + h * 64 + l;
                for (int key = 0; key < 64; ++key) o += __shfl(sc[r], key) * bf2f(vp[(size_t)key * INC]);
            }
        }
        mix[(size_t)t * 1024 + h * 64 + l] = (bf16)(pk2(o / sum, 0.f) & 0xffffu);
        LDS_WAIT();
    }
}
#endif

DI void p6_router(const Frame& F, const Args& a) {
    unsigned char* ws = a.ws; const bf16* x1 = (const bf16*)(ws + WS_XN); const float* wrt = (const float*)(ws + WS_WRT); const float* br = a.in[I_BR];
    int* eidx = (int*)(ws + WS_EIDX); float* gate = (float*)(ws + WS_GATE); int* lrank = (int*)(ws + WS_LRANK); float* rstd = (float*)(ws + WS_RSTD); int* cnt = (int*)(ws + WS_CNT);
    constexpr int WROW = 2064, WIMG = 32 * WROW;
    LAS int* hist = (LAS int*)(F.lds + 2 * WIMG);
    const int n = F.lane & 15, q = F.lane >> 4;
    for (int i = F.tid; i < 32 * 256; i += NWAVES * 64) { const int e = i >> 8, c4 = i & 255; const f32x4 w = *((const f32x4*)(wrt + (size_t)e * D) + c4);
        v2u hi, lo; hi.x = pk2(w[0], w[1]); hi.y = pk2(w[2], w[3]);
        lo.x = pk2(w[0] - bflo(hi.x), w[1] - bfhi(hi.x)); lo.y = pk2(w[2] - bflo(hi.y), w[3] - bfhi(hi.y));
        *(LAS v2u*)(F.lds + e * WROW + c4 * 8) = hi; *(LAS v2u*)(F.lds + WIMG + e * WROW + c4 * 8) = lo; }
    __syncthreads();
    for (int tile = F.bid; tile < T / 128; tile += F.G) {
        if (F.tid < 32) hist[F.tid] = 0;
        __syncthreads();
        const int tok = tile * 128 + F.wave * 16 + n;
        const v4u* xr = (const v4u*)(x1 + (size_t)tok * D) + q; const LAS unsigned char* w0 = F.lds + n * WROW + 16 * q;
        f32x4 acc0 = {0.f, 0.f, 0.f, 0.f}, acc1 = {0.f, 0.f, 0.f, 0.f}; float ssq = 0.f, amax = 0.f;
        for (int S0 = 0; S0 < 32; S0 += 16) {
            v4u xw[16];
#pragma unroll
            for (int s = 0; s < 16; ++s) xw[s] = xr[4 * (S0 + s)];
#pragma unroll
            for (int s = 0; s < 16; ++s) { const bf16x8 xb8 = __builtin_bit_cast(bf16x8, xw[s]); const LAS unsigned char* wp = w0 + (S0 + s) * 64;
                const unsigned u[4] = {xw[s].x, xw[s].y, xw[s].z, xw[s].w};
#pragma unroll
                for (int j = 0; j < 4; ++j) { const float a = bflo(u[j]), b = bfhi(u[j]); ssq += a * a + b * b; amax = fmaxf(amax, fmaxf(fabsf(a), fabsf(b))); }
                acc0 = __builtin_amdgcn_mfma_f32_16x16x32_bf16(*(const LAS bf16x8*)(wp), xb8, acc0, 0, 0, 0);
                acc0 = __builtin_amdgcn_mfma_f32_16x16x32_bf16(*(const LAS bf16x8*)(wp + WIMG), xb8, acc0, 0, 0, 0);
                acc1 = __builtin_amdgcn_mfma_f32_16x16x32_bf16(*(const LAS bf16x8*)(wp + 16 * WROW), xb8, acc1, 0, 0, 0);
                acc1 = __builtin_amdgcn_mfma_f32_16x16x32_bf16(*(const LAS bf16x8*)(wp + WIMG + 16 * WROW), xb8, acc1, 0, 0, 0); }
        }
        ssq = quad_sum(ssq); amax = quad_max(amax);
        const float rs = 1.0f / sqrtf(ssq * (1.f / D) + 1e-6f);
        float lg[8];
#pragma unroll
        for (int i = 0; i < 4; ++i) { lg[i] = acc0[i] * rs + br[4 * q + i]; lg[4 + i] = acc1[i] * rs + br[16 + 4 * q + i]; }
        float tv[4]; int ti[4];
#pragma unroll
        for (int r = 0; r < 4; ++r) {
            float bv = -3.0e38f; int bi = 0;
#pragma unroll
            for (int j = 0; j < 8; ++j) { const int e = (j < 4 ? 0 : 16) + 4 * q + (j & 3); if (lg[j] > bv) { bv = lg[j]; bi = e; } }
#pragma unroll
            for (int o = 16; o <= 32; o <<= 1) { const float ov = __shfl_xor(bv, o); const int oi = __shfl_xor(bi, o); if (ov > bv || (ov == bv && oi < bi)) { bv = ov; bi = oi; } }
            tv[r] = bv; ti[r] = bi;
#pragma unroll
            for (int j = 0; j < 8; ++j) { const int e = (j < 4 ? 0 : 16) + 4 * q + (j & 3); if (e == bi) lg[j] = -3.0e38f; }
        }
        if (q == 0) {
            const float e1 = __expf(tv[1] - tv[0]), e2 = __expf(tv[2] - tv[0]), e3 = __expf(tv[3] - tv[0]); const float inv = 1.0f / (1.0f + e1 + e2 + e3);
            int lr[4];
#pragma unroll
            for (int r = 0; r < 4; ++r) lr[r] = atomicAdd((int*)&hist[ti[r]], 1);
            *(int4*)(eidx + (size_t)tok * 4) = make_int4(ti[0], ti[1], ti[2], ti[3]);
            *(float4*)(gate + (size_t)tok * 4) = make_float4(inv, e1 * inv, e2 * inv, e3 * inv);
            *(int4*)(lrank + (size_t)tok * 4) = make_int4(lr[0], lr[1], lr[2], lr[3]);
            rstd[tok] = rs * amax * (1.0f / 127.0f);
        }
        { const float qinv = amax > 0.f ? 127.0f / amax : 0.f; unsigned char* xq = ws + WS_XQ;
            for (int i0 = 0; i0 < 16; i0 += 4) { v4u xa[4], xb2[4];
#pragma unroll
                for (int i = 0; i < 4; ++i) { const v4u* p = (const v4u*)(x1 + (size_t)(tile * 128 + F.wave * 16 + i0 + i) * D) + 2 * F.lane; xa[i] = p[0]; xb2[i] = p[1]; }
#pragma unroll
                for (int i = 0; i < 4; ++i) { const float sc = __builtin_bit_cast(float, __builtin_amdgcn_readlane(__builtin_bit_cast(int, qinv), i0 + i));
                    const unsigned u[8] = {xa[i].x, xa[i].y, xa[i].z, xa[i].w, xb2[i].x, xb2[i].y, xb2[i].z, xb2[i].w}; v4u o;
#pragma unroll
                    for (int d = 0; d < 4; ++d) { const f32x2 lo = {bflo(u[2 * d]), bfhi(u[2 * d])}, hi = {bflo(u[2 * d + 1]), bfhi(u[2 * d + 1])};
                        const f32x2 ql = lo * sc + Q_MAGIC, qh = hi * sc + Q_MAGIC; o[d] = q_pack4(ql.x, ql.y, qh.x, qh.y); }
                    *((v4u*)(xq + (size_t)(tile * 128 + F.wave * 16 + i0 + i) * D) + F.lane) = o; } }
        }
        __syncthreads();
        if (F.tid < 32) cnt[tile * 32 + F.tid] = hist[F.tid];
        __syncthreads();
    }
}

DI void p7_permute(const Frame& F, const Args& a) {
    unsigned char* ws = a.ws; const int* cnt = (const int*)(ws + WS_CNT); int* meta = (int*)(ws + WS_META);
    const int* eidx = (const int*)(ws + WS_EIDX); const int* lrank = (const int*)(ws + WS_LRANK); int* inv = (int*)(ws + WS_INV);
    const float* rstd = (const float*)(ws + WS_RSTD); float* rowrstd = (float*)(ws + WS_ROWRSTD);
    bf16* xb = (bf16*)(ws + WS_XN); int* rowtok = (int*)(ws + WS_ROWTOK);
    LAS int* s_tot = (LAS int*)F.lds; LAS int* s_pst = s_tot + 32; LAS int* s_base = s_tot + 64; LAS int* s_part = s_tot + 128;
    { const int e = F.tid & 31, part = F.tid >> 5; int s = 0; for (int t = part * 16; t < part * 16 + 16; ++t) s += cnt[t * 32 + e]; s_part[part * 32 + e] = s; }
    __syncthreads();
    if (F.tid < 32) { int s = 0; for (int p = 0; p < 16; ++p) s += s_part[p * 32 + F.tid]; s_tot[F.tid] = s; }
    __syncthreads();
    if (F.tid < 32) { int ps = 0; for (int e = 0; e < F.tid; ++e) ps += (s_tot[e] + 255) / 256 * 256; s_pst[F.tid] = ps; }
    __syncthreads();
    if (F.bid == 0 && F.tid < 32) { const int e = F.tid, nb = (s_tot[e] + 255) / 256, rb0 = s_pst[e] / 256; for (int i = 0; i < nb; ++i) meta[16 + rb0 + i] = e; if (e == 31) meta[0] = rb0 + nb; }
    if (F.bid < 32) { const int e = F.bid, r0 = s_pst[e] + s_tot[e], r1 = s_pst[e] + (s_tot[e] + 255) / 256 * 256;
        for (int r = r0 + F.tid; r < r1; r += NWAVES * 64) { rowtok[r] = T; rowrstd[r] = 0.f; } }
    if (F.bid == 0 && F.tid < 64) { const v4u z = {0u, 0u, 0u, 0u}; *((v4u*)(ws + WS_XQ + (size_t)T * D) + F.tid) = z; }
    for (int tile = F.bid; tile < T / 128; tile += F.G) {
        __syncthreads();
        if (F.tid < 32) { int s = 0; for (int t = 0; t < tile; ++t) s += cnt[t * 32 + F.tid]; s_base[F.tid] = s_pst[F.tid] + s; }
        __syncthreads();
        { const int i = F.tid;
            const int tok = tile * 128 + (i >> 2), k = i & 3; const int e = eidx[tok * 4 + k]; const int dest = s_base[e] + lrank[tok * 4 + k];
            inv[tok * 4 + k] = dest; rowtok[dest] = tok; rowrstd[dest] = rstd[tok];
        }
    }
}

DI void p10_combine(const Frame& F, const Args& a) {
    unsigned char* ws = a.ws; const int* inv = (const int*)(ws + WS_INV); const float* gate = (const float*)(ws + WS_GATE); const bf16* yr = (const bf16*)(ws + WS_YR); const bf16* xb = (const bf16*)(ws + WS_XN); float* out = a.out;
    const int gw = F.bid * NWAVES + F.wave, NGW = F.G * NWAVES;
    for (int t = gw; t < T; t += NGW) {
        const int4 iv = *(const int4*)(inv + (size_t)t * 4); const float4 gv = *(const float4*)(gate + (size_t)t * 4);
        const int rows[4] = {iv.x, iv.y, iv.z, iv.w}; const float gs[4] = {gv.x, gv.y, gv.z, gv.w};
        f32x4* o = (f32x4*)(out + (size_t)t * D) + F.lane; const v2u* xr = (const v2u*)(xb + (size_t)t * D) + F.lane;
#pragma unroll
        for (int j = 0; j < 4; ++j) {
            const v2u xw = xr[64 * j]; f32x4 acc = {bflo(xw.x), bfhi(xw.x), bflo(xw.y), bfhi(xw.y)};
#pragma unroll
            for (int k = 0; k < 4; ++k) { const v2u w = __builtin_nontemporal_load((const v2u*)(yr + (size_t)rows[k] * D) + F.lane + 64 * j);
                acc.x += gs[k] * bflo(w.x); acc.y += gs[k] * bfhi(w.x); acc.z += gs[k] * bflo(w.y); acc.w += gs[k] * bfhi(w.y); }
            __builtin_nontemporal_store(acc, o + 64 * j);
        }
    }
}

constexpr int N_PHASES = 11;
__global__ void __launch_bounds__(NWAVES * 64, 2) fwd(Args args) {
    extern __shared__ __attribute__((aligned(16))) unsigned char lds[];
    Frame F;
    F.lds = (LAS unsigned char*)lds;
    F.tid = threadIdx.x; F.lane = F.tid & 63; F.wave = __builtin_amdgcn_readfirstlane(F.tid >> 6);
    F.G = gridDim.x; F.bid = blockIdx.x;
    volatile LAS unsigned* MISC = (volatile LAS unsigned*)(F.lds + MISC_OFF);
    if (F.tid < 64) MISC[F.tid] = 0u;
    __syncthreads();
    unsigned char* ws = args.ws;
    unsigned* ctl = (unsigned*)(ws + WS_CTL);
    XcdBarrier bar; bar.bar = ctl + CW_BAR; bar.x = 0; bar.st = nullptr;
    if (MK_N_LAUNCHES == 1) bar = xcd_barrier_post(ctl + CW_BAR, MISC + 8);
    const int lo = args.ph_lo, hi = args.ph_hi;
#ifndef PHASE_MASK
#define PHASE_MASK 0xffff
#endif
#define IN(k) (((PHASE_MASK >> (k)) & 1) && lo <= (k) && (k) < hi)
#ifndef DUP_PHASE
#define DUP_PHASE -1
#endif
#define REPS(k) ((DUP_PHASE >= 0 && (k) == DUP_PHASE) ? args.ph_rep : 1)
#define SEAM(k) do { if (IN(k) && IN((k) + 1)) xcd_barrier(bar); { int t_ = threadIdx.x; asm volatile("" : "+v"(t_)); F.tid = t_; F.lane = t_ & 63; } } while (0)

    for (int rep_ = 0; rep_ < REPS(0); ++rep_) { if (rep_) xcd_barrier(bar);
    if (IN(0)) { p0_prologue(F, args); } } SEAM(0);

    for (int rep_ = 0; rep_ < REPS(1); ++rep_) { if (rep_) xcd_barrier(bar);
    if (IN(1)) {
        pg8::Gemm g{(const bf16*)(ws + WS_XN), (const bf16*)(ws + WS_WIN), T, INC, D}; pg8::StaticOrder S; S.init(T, INC, F.G, F.bid);
        pg8::EpiBf16 E{(bf16*)(ws + WS_PROJ), INC};
        pg8::gemm_phase<pg8::EpiBf16, pg8::StaticOrder, true, true>(F.lds, g, S, E);
    } } SEAM(1);

    for (int rep_ = 0; rep_ < REPS(2); ++rep_) { if (rep_) xcd_barrier(bar);
    if (IN(2)) {
#if NAIVE_RWKV
        rwkv_naive_prep(F, args);
#else
        rwkv_phase_a(F, args);
#endif
    } } SEAM(2);

    for (int rep_ = 0; rep_ < REPS(3); ++rep_) { if (rep_) xcd_barrier(bar);
    if (IN(3)) {
#if NAIVE_RWKV
        rwkv_naive_scan(F, args);
#else
        rwkv_phase_b(F, args);
#endif
        __syncthreads();
#if NAIVE_ATT
        attn_naive(F, args);
#else
        attn_phase(F, args, rep_);
#endif
    } } SEAM(3);

    for (int rep_ = 0; rep_ < REPS(4); ++rep_) { if (rep_) xcd_barrier(bar);
    if (IN(4)) {
#if !NAIVE_RWKV
        rwkv_phase_c(F, args);
#endif
    } } SEAM(4);

    for (int rep_ = 0; rep_ < REPS(5); ++rep_) { if (rep_) xcd_barrier(bar);
    if (IN(5)) {
        pg8::Gemm g{(const bf16*)(ws + WS_MIX), (const bf16*)(ws + WS_WOUT), T, D, D}; pg8::StaticOrder S; S.init(T, D, F.G, F.bid);
        pg8::EpiResid E{args.in[I_X], nullptr, (bf16*)(ws + WS_XN), D};
        pg8::gemm_phase<pg8::EpiResid, pg8::StaticOrder, true, true>(F.lds, g, S, E);
    } } SEAM(5);

    for (int rep_ = 0; rep_ < REPS(6); ++rep_) { if (rep_) xcd_barrier(bar);
    if (IN(6)) { p6_router(F, args); } } SEAM(6);
    for (int rep_ = 0; rep_ < REPS(7); ++rep_) { if (rep_) xcd_barrier(bar);
    if (IN(7)) { p7_permute(F, args); } } SEAM(7);

    for (int rep_ = 0; rep_ < REPS(8); ++rep_) { if (rep_) xcd_barrier(bar);
    if (IN(8)) {
        pg8::Gemm g{(const bf16*)(ws + WS_XQ), (const bf16*)(ws + WS_WUP), NROWS_MAX, 2048, D / 2};
        pg8::MoeOrder S{(const int*)(ws + WS_META), 8, F.G, F.bid, (const int*)(ws + WS_ROWTOK)};
        pg8::EpiSwiGLU E{(bf16*)(ws + WS_ACT), args.in[I_BUP], (const float*)(ws + WS_ROWRSTD), (const float*)(ws + WS_COLSC)};
        pg8::gemm_phase<pg8::EpiSwiGLU, pg8::MoeOrder, true, true>(F.lds, g, S, E);
    } } SEAM(8);

    for (int rep_ = 0; rep_ < REPS(9); ++rep_) { if (rep_) xcd_barrier(bar);
    if (IN(9)) {
        pg8::Gemm g{(const bf16*)(ws + WS_ACT), (const bf16*)(ws + WS_WDN), NROWS_MAX, 1024, D}; pg8::MoeOrder S{(const int*)(ws + WS_META), 4, F.G, F.bid, nullptr};
        pg8::EpiDown E{(bf16*)(ws + WS_YR), args.in[I_BDN]};
        pg8::gemm_phase<pg8::EpiDown, pg8::MoeOrder, true, true>(F.lds, g, S, E);
    } } SEAM(9);

    if (IN(10)) { p10_combine(F, args); }
#undef IN
#undef SEAM
}

extern "C" void kernel_launch(void* const* d_in, const int* in_sizes, int n_in, void* d_out, int out_size, void* d_ws, size_t ws_size, hipStream_t stream) {
    static int grid = 0;
    if (grid == 0) {
        if (n_in != 25 || out_size != T * D || ws_size < WS_END) { fprintf(stderr, "kernel_launch: unexpected shapes (n_in %d out %d ws %zu)\n", n_in, out_size, ws_size); grid = -1; return; }
        int dev = 0, cus = 0, per_cu = 0;
        if (hipGetDevice(&dev) != hipSuccess || hipDeviceGetAttribute(&cus, hipDeviceAttributeMultiprocessorCount, dev) != hipSuccess) { grid = -1; return; }
        if (hipFuncSetAttribute((const void*)fwd, hipFuncAttributeMaxDynamicSharedMemorySize, LDS_BYTES) != hipSuccess) { fprintf(stderr, "kernel_launch: hipFuncSetAttribute failed\n"); grid = -1; return; }
        if (hipOccupancyMaxActiveBlocksPerMultiprocessor(&per_cu, (const void*)fwd, NWAVES * 64, LDS_BYTES) != hipSuccess || per_cu < 1) { fprintf(stderr, "kernel_launch: occupancy query says %d\n", per_cu); }
        (void)hipGetLastError();
        grid = cus;
    }
    if (grid < 0) return;
    (void)hipMemsetAsync((char*)d_ws + WS_CTL, 0, CTL_ZERO_BYTES, stream);
    Args a{};
    for (int i = 0; i < 25; ++i) a.in[i] = (const float*)d_in[i];
    a.out = (float*)d_out; a.ws = (unsigned char*)d_ws;
#if MK_N_LAUNCHES == 1
    a.ph_lo = 0; a.ph_hi = N_PHASES; a.ph_rep = 2;
    hipLaunchKernelGGL(fwd, dim3(grid), dim3(NWAVES * 64), LDS_BYTES, stream, a);
#else
    for (int p = 0; p < N_PHASES; ++p) { a.ph_lo = p; a.ph_hi = p + 1; hipLaunchKernelGGL(fwd, dim3(grid), dim3(NWAVES * 64), LDS_BYTES, stream, a); }
#endif
}
```

```cpp
#define NAIVE_RWKV 0
#define NAIVE_ATT 0
#define MK_N_LAUNCHES 1
#include <hip/hip_runtime.h>
#include <cstdio>
#include <cstdint>

#ifndef MK_N_LAUNCHES
#define MK_N_LAUNCHES 1
#endif
#ifndef NAIVE_RWKV
#define NAIVE_RWKV 0
#endif
#ifndef NAIVE_ATT
#define NAIVE_ATT 0
#endif

namespace pg8 {
#define PG8_LAS __attribute__((address_space(3)))
typedef unsigned short bf16_t;
typedef short bf16x8 __attribute__((ext_vector_type(8)));
typedef float f32x4 __attribute__((ext_vector_type(4)));
typedef unsigned u32x4 __attribute__((ext_vector_type(4)));
typedef unsigned u32x2 __attribute__((ext_vector_type(2)));
typedef float f32x2e __attribute__((ext_vector_type(2)));
typedef int i32x4 __attribute__((ext_vector_type(4)));
typedef int i32x8 __attribute__((ext_vector_type(8)));
template <bool F8> struct Frag { bf16x8 v[2]; __device__ __forceinline__ void set(bf16x8 a, bf16x8 b) { v[0] = a; v[1] = b; } };
template <> struct Frag<true> { i32x8 v; __device__ __forceinline__ void set(bf16x8 a, bf16x8 b) { v = __builtin_shufflevector(__builtin_bit_cast(i32x4, a), __builtin_bit_cast(i32x4, b), 0, 1, 2, 3, 4, 5, 6, 7); } };
__device__ __forceinline__ i32x8 cat8(bf16x8 a, bf16x8 b) { return __builtin_shufflevector(__builtin_bit_cast(i32x4, a), __builtin_bit_cast(i32x4, b), 0, 1, 2, 3, 4, 5, 6, 7); }
constexpr int BM = 256, BK = 64, HALF = 128, HTB = HALF * BK * 2  , STAGE_BYTES = 8 * HTB, NXCD = 8, WGM = 8;

__host__ __device__ __forceinline__ int lds_byte(int r, int c) { const int st = (r >> 4) * 2 + (c >> 5), rr = r & 15, cc = c & 31, ob = rr * 64 + cc * 2; return st * 1024 + (ob ^ (((ob >> 9) & 1) << 5)); }
__host__ __device__ __forceinline__ void stage_rc(int b, int& R, int& C) { const int st = b / 1024, sb = b % 1024, swz = sb ^ (((sb >> 9) & 1) << 5); R = (st >> 1) * 16 + swz / 64; C = (st & 1) * 32 + (swz % 64) / 2; }
__host__ __device__ __forceinline__ int perm32(int rho) { const int n = rho >> 4, i = rho & 15; return 8 * (i >> 2) + 4 * n + (i & 3); }

struct Unit { int pm, pn, e; };
struct Gemm { const bf16_t* A; const bf16_t* Bt; int M, N, K; };

__device__ __forceinline__ bool tile_of(int i, int G, int c, int nM, int nN, int& pm, int& pn) {
    const int nwg = nM * nN; const long L = (long)i * G + c; if (L >= nwg) return false;
    int wgid = (int)L; { const int q = nwg / NXCD, r = nwg % NXCD, xcd = wgid % NXCD, off = wgid / NXCD; wgid = (xcd < r ? xcd * (q + 1) : r * (q + 1) + (xcd - r) * q) + off; }
    const int nig = WGM * nN, gid = wgid / nig, fm = gid * WGM, gsz = (nM - fm) < WGM ? (nM - fm) : WGM;
    pm = fm + ((wgid % nig) % gsz); pn = (wgid % nig) / gsz; return true;
}
struct StaticOrder {
    int nM, nN, G, c;
    __device__ void init(int M, int N, int G_, int c_) { nM = M / BM; nN = N / BM; G = G_; c = c_; }
    __device__ __forceinline__ bool next(int i, Unit& u) const { u.e = 0; return tile_of(i, G, c, nM, nN, u.pm, u.pn); }
    __device__ __forceinline__ const char* a_base(const Gemm& g, const Unit& u) const { return (const char*)g.A + (size_t)u.pm * BM * g.K * 2; }
    __device__ __forceinline__ const char* b_base(const Gemm& g, const Unit& u) const { return (const char*)g.Bt + (size_t)u.pn * BM * g.K * 2; }
    __device__ __forceinline__ void a_off(const Gemm& g, const Unit&, const int (&R)[2], const int (&C)[2], unsigned (&vo)[2][2]) const {
#pragma unroll
        for (int h = 0; h < 2; ++h)
#pragma unroll
            for (int i = 0; i < 2; ++i) vo[h][i] = (unsigned)((h * HALF + R[i]) * g.K + C[i]) * 2u; }
    __device__ __forceinline__ void a_ready(const Unit&) const {}
    __device__ __forceinline__ void done(const Unit&) const {}
};
template <bool GATHER>
struct MoeOrder {
    const int* meta; int nN, G, c;
    __device__ __forceinline__ bool next(int i, Unit& u) const {
        const int nM = __builtin_amdgcn_readfirstlane(meta[0]);
        if (!tile_of(i, G, c, nM, nN, u.pm, u.pn)) return false;
        u.e = __builtin_amdgcn_readfirstlane(meta[16 + u.pm]); return true;
    }
    const int* rowtok;
    __device__ __forceinline__ const char* a_base(const Gemm& g, const Unit& u) const { return GATHER ? (const char*)g.A : (const char*)g.A + (size_t)u.pm * BM * g.K * 2; }
    __device__ __forceinline__ const char* b_base(const Gemm& g, const Unit& u) const { return (const char*)g.Bt + ((size_t)u.e * g.N + (size_t)u.pn * BM) * g.K * 2; }
    __device__ __forceinline__ void a_off(const Gemm& g, const Unit& u, const int (&R)[2], const int (&C)[2], unsigned (&vo)[2][2]) const {
#pragma unroll
        for (int h = 0; h < 2; ++h)
#pragma unroll
            for (int i = 0; i < 2; ++i) { const int r = h * HALF + R[i]; vo[h][i] = (unsigned)((GATHER ? rowtok[u.pm * BM + r] : r) * g.K + C[i]) * 2u; } }
    __device__ __forceinline__ void a_ready(const Unit&) const {}
    __device__ __forceinline__ void done(const Unit&) const {}
};

__device__ __forceinline__ unsigned cvt_pk_bf16(float lo, float hi) { unsigned r; asm volatile("v_cvt_pk_bf16_f32 %0, %1, %2" : "=v"(r) : "v"(lo), "v"(hi)); return r; }

struct EpiBf16 {
    static constexpr bool PERM = true, AFTER_DRAIN = false, I8 = false, F8 = false;
    bf16_t* O; int ldc;
    __device__ __forceinline__ void operator()(const f32x4 (&acc)[2][2][4][2], const Unit& u, int wr, int wc, int fr, int fq) const {
        const int row0 = u.pm * BM + wr * 64 + fr, col0 = u.pn * BM + wc * 32 + 8 * fq;
#pragma unroll
        for (int ai = 0; ai < 2; ++ai)
#pragma unroll
            for (int m = 0; m < 4; ++m) { bf16_t* rowp = O + (size_t)(row0 + ai * HALF + m * 16) * ldc + col0;
#pragma unroll
                for (int bj = 0; bj < 2; ++bj) { const f32x4 v0 = acc[ai][bj][m][0], v1 = acc[ai][bj][m][1];
                    u32x4 w; w.x = cvt_pk_bf16(v0[0], v0[1]); w.y = cvt_pk_bf16(v0[2], v0[3]); w.z = cvt_pk_bf16(v1[0], v1[1]); w.w = cvt_pk_bf16(v1[2], v1[3]);
                    *(u32x4*)(rowp + bj * HALF) = w; } }
    }
};
struct EpiResid {
    static constexpr bool PERM = false, AFTER_DRAIN = false, I8 = false, F8 = false;
    const float* base; float* out; bf16_t* xb; int ldc;
    __device__ __forceinline__ void operator()(const f32x4 (&acc)[2][2][4][2], const Unit& u, int wr, int wc, int fr, int fq) const {
        const int row0 = u.pm * BM + wr * 64 + fr, col0 = u.pn * BM + wc * 32 + 4 * fq;
        f32x4 nb[4][2][2];
#define PG8_RES_LOAD(g_) do { const size_t off_ = (size_t)(row0 + ((g_) >> 2) * HALF + ((g_) & 3) * 16) * ldc + col0; _Pragma("unroll") for (int bj = 0; bj < 2; ++bj) _Pragma("unroll") for (int n = 0; n < 2; ++n) \
            nb[(g_) & 3][bj][n] = __builtin_nontemporal_load((const f32x4*)(base + off_ + bj * HALF + n * 16)); } while (0)
        PG8_RES_LOAD(0); PG8_RES_LOAD(1); PG8_RES_LOAD(2);
#pragma unroll
        for (int g = 0; g < 8; ++g) { const int ai = g >> 2, m = g & 3; const size_t off = (size_t)(row0 + ai * HALF + m * 16) * ldc + col0;
            if (g + 3 < 8) PG8_RES_LOAD(g + 3);
#pragma unroll
            for (int bj = 0; bj < 2; ++bj)
#pragma unroll
                for (int n = 0; n < 2; ++n) { const f32x4 o = nb[g & 3][bj][n] + acc[ai][bj][m][n];
                    if (out) *(f32x4*)(out + off + bj * HALF + n * 16) = o;
                    u32x2 w; w.x = cvt_pk_bf16(o[0], o[1]); w.y = cvt_pk_bf16(o[2], o[3]); *(u32x2*)(xb + off + bj * HALF + n * 16) = w; }
            asm volatile("" ::: "memory"); }
#undef PG8_RES_LOAD
    }
};
__device__ __forceinline__ float acc_i2f(float bits) { return (float)__builtin_bit_cast(int, bits); }
struct EpiSwiGLU {
    static constexpr bool PERM = true, AFTER_DRAIN = false, I8 = true, F8 = false;
    bf16_t* O; const float* b_up; const float* rowrstd; const float* colsc;
    __device__ __forceinline__ void operator()(const f32x4 (&acc)[2][2][4][2], const Unit& u, int wr, int wc, int fr, int fq) const {
        const int row0 = u.pm * BM + wr * 64 + fr, f0 = u.pn * HALF + wc * 32 + 8 * fq;
        const float* bg = b_up + (size_t)u.e * 2048 + f0; const float* bl = bg + 1024;
        const f32x4 bg0 = *(const f32x4*)bg, bg1 = *(const f32x4*)(bg + 4), bl0 = *(const f32x4*)bl, bl1 = *(const f32x4*)(bl + 4);
        const float* cg = colsc + (size_t)u.e * 2048 + f0; const float* cl = cg + 1024;
        const f32x4 cg0 = *(const f32x4*)cg, cg1 = *(const f32x4*)(cg + 4), cl0 = *(const f32x4*)cl, cl1 = *(const f32x4*)(cl + 4);
        float rsv[2][4];
#pragma unroll
        for (int ai = 0; ai < 2; ++ai)
#pragma unroll
            for (int m = 0; m < 4; ++m) rsv[ai][m] = rowrstd[row0 + ai * HALF + m * 16];
#pragma unroll
        for (int ai = 0; ai < 2; ++ai)
#pragma unroll
            for (int m = 0; m < 4; ++m) { const int row = row0 + ai * HALF + m * 16; const float rs = rsv[ai][m];
                float a[8];
#pragma unroll
                for (int n = 0; n < 2; ++n)
#pragma unroll
                    for (int j = 0; j < 4; j += 2) {
                        const f32x2e ag2 = {acc_i2f(acc[ai][0][m][n][j]), acc_i2f(acc[ai][0][m][n][j + 1])}, al2 = {acc_i2f(acc[ai][1][m][n][j]), acc_i2f(acc[ai][1][m][n][j + 1])};
                        const f32x2e cg2 = n ? (f32x2e){cg1[j], cg1[j + 1]} : (f32x2e){cg0[j], cg0[j + 1]}, cl2 = n ? (f32x2e){cl1[j], cl1[j + 1]} : (f32x2e){cl0[j], cl0[j + 1]};
                        const f32x2e bg2 = n ? (f32x2e){bg1[j], bg1[j + 1]} : (f32x2e){bg0[j], bg0[j + 1]}, bl2 = n ? (f32x2e){bl1[j], bl1[j + 1]} : (f32x2e){bl0[j], bl0[j + 1]};
                        f32x2e hg = (ag2 * rs) * cg2 + bg2, hl = (al2 * rs) * cl2 + bl2;
                        hg.x = fminf(hg.x, 7.0f); hg.y = fminf(hg.y, 7.0f); hl.x = fminf(fmaxf(hl.x, -7.0f), 7.0f); hl.y = fminf(fmaxf(hl.y, -7.0f), 7.0f);
                        const f32x2e t = hg * (-1.702f * 1.4426950408889634f);
                        f32x2e e; e.x = __builtin_amdgcn_exp2f(t.x); e.y = __builtin_amdgcn_exp2f(t.y);
                        const f32x2e d = e + 1.0f; f32x2e sg; sg.x = __builtin_amdgcn_rcpf(d.x); sg.y = __builtin_amdgcn_rcpf(d.y);
                        const f32x2e o = (hg * sg) * (hl + 1.0f);
                        a[n * 4 + j] = o.x; a[n * 4 + j + 1] = o.y; }
                u32x2 w;
                w.x = (unsigned)__builtin_amdgcn_cvt_pk_fp8_f32(a[2], a[3], __builtin_amdgcn_cvt_pk_fp8_f32(a[0], a[1], 0, false), true);
                w.y = (unsigned)__builtin_amdgcn_cvt_pk_fp8_f32(a[6], a[7], __builtin_amdgcn_cvt_pk_fp8_f32(a[4], a[5], 0, false), true);
                *(u32x2*)((unsigned char*)O + (size_t)row * 1024 + f0) = w; }
    }
};
struct EpiDown {
    static constexpr bool PERM = true, AFTER_DRAIN = false, I8 = false, F8 = true;
    bf16_t* O; const float* b_dn; const float* colsc;
    __device__ __forceinline__ void operator()(const f32x4 (&acc)[2][2][4][2], const Unit& u, int wr, int wc, int fr, int fq) const {
        const int row0 = u.pm * BM + wr * 64 + fr, col0 = u.pn * BM + wc * 32 + 8 * fq;
        const float* bp = b_dn + (size_t)u.e * 1024 + col0;
        const float* cp = colsc + (size_t)u.e * 1024 + col0;
        f32x4 bv[2][2], cv[2][2];
#pragma unroll
        for (int bj = 0; bj < 2; ++bj)
#pragma unroll
            for (int n = 0; n < 2; ++n) { bv[bj][n] = *(const f32x4*)(bp + bj * HALF + 4 * n); cv[bj][n] = *(const f32x4*)(cp + bj * HALF + 4 * n); }
#pragma unroll
        for (int ai = 0; ai < 2; ++ai)
#pragma unroll
            for (int m = 0; m < 4; ++m) { bf16_t* rowp = O + (size_t)(row0 + ai * HALF + m * 16) * 1024 + col0;
#pragma unroll
                for (int bj = 0; bj < 2; ++bj) { const f32x4 v0 = acc[ai][bj][m][0] * cv[bj][0] + bv[bj][0], v1 = acc[ai][bj][m][1] * cv[bj][1] + bv[bj][1];
                    u32x4 w; w.x = cvt_pk_bf16(v0[0], v0[1]); w.y = cvt_pk_bf16(v0[2], v0[3]); w.z = cvt_pk_bf16(v1[0], v1[1]); w.w = cvt_pk_bf16(v1[2], v1[3]);
                    *(u32x4*)(rowp + bj * HALF) = w; } }
    }
};

template <class Epi, class Sched, bool ALIGN_EPI = false, bool SP2 = false>
__device__ __forceinline__ void gemm_phase(PG8_LAS unsigned char* lds, const Gemm g, const Sched& S, const Epi& E) {
    int tid = threadIdx.x; asm volatile("" : "+v"(tid));
    const int wid = __builtin_amdgcn_readfirstlane(tid >> 6), lane = tid & 63, wr = wid >> 2, wc = wid & 3, fr = lane & 15, fq = lane >> 4;
    const int K = g.K, nt = K / BK;
    unsigned voffB[2]; int sR[2], sC[2];
#pragma unroll
    for (int i = 0; i < 2; ++i) { int R, C; stage_rc(tid * 16 + i * 8192, R, C); const int Rb = Epi::PERM ? ((R & ~31) + perm32(R & 31)) : R;
        sR[i] = R; sC[i] = C; voffB[i] = (unsigned)(Rb * K + C) * 2u; }
    const size_t kstep = (size_t)(BK * 2);
    const size_t hstep = (size_t)HALF * K * 2;
    const unsigned ldsw = (unsigned)wid * 1024u;
    const int aoff = lds_byte(wr * 64 + fr, fq * 8), boff = lds_byte(wc * 32 + fr, fq * 8);
#define PG8_SA(b, h) (((b) * 2 + (h)) * HTB)
#define PG8_SB(b, h) ((4 + (b) * 2 + (h)) * HTB)
#define PG8_STAGE(bufoff, gbase, voff) do { _Pragma("unroll") for (int _i = 0; _i < 2; ++_i) \
        __builtin_amdgcn_global_load_lds((const unsigned*)((const char*)(gbase) + (voff)[_i]), (PG8_LAS unsigned*)(lds + (bufoff) + ldsw + _i * 8192), 16, 0, 0); } while (0)
#define PG8_STAGE_A(bufoff, gbase, vo, h) do { _Pragma("unroll") for (int _i = 0; _i < 2; ++_i) \
        __builtin_amdgcn_global_load_lds((const unsigned*)((const char*)(gbase) + (vo)[h][_i]), (PG8_LAS unsigned*)(lds + (bufoff) + ldsw + _i * 8192), 16, 0, 0); } while (0)
#define PG8_LDA(dst, b, h) do { _Pragma("unroll") for (int m = 0; m < 4; ++m) dst[m].set(*(const PG8_LAS bf16x8*)(lds + PG8_SA(b, h) + aoff + m * 2048), *(const PG8_LAS bf16x8*)(lds + PG8_SA(b, h) + aoff + m * 2048 + 1024)); } while (0)
#define PG8_LDB(dst, b, h) do { _Pragma("unroll") for (int n = 0; n < 2; ++n) dst[n].set(*(const PG8_LAS bf16x8*)(lds + PG8_SB(b, h) + boff + n * 2048), *(const PG8_LAS bf16x8*)(lds + PG8_SB(b, h) + boff + n * 2048 + 1024)); } while (0)
#define PG8_MMA(ai, bj, At, Bt) do { __builtin_amdgcn_s_setprio(1); _Pragma("unroll") for (int m = 0; m < 4; ++m) _Pragma("unroll") for (int n = 0; n < 2; ++n) { \
        if constexpr (Epi::F8) asm volatile("v_mfma_scale_f32_16x16x128_f8f6f4 %0, %1, %2, %0, %3, %3 op_sel_hi:[0,0,0]" : "+v"(acc[ai][bj][m][n]) : "v"(Bt[n].v), "v"(At[m].v), "v"(f8scale)); \
        else { _Pragma("unroll") for (int k = 0; k < 2; ++k) { \
            if constexpr (Epi::I8) acc[ai][bj][m][n] = __builtin_bit_cast(f32x4, __builtin_amdgcn_mfma_i32_16x16x64_i8(__builtin_bit_cast(i32x4, Bt[n].v[k]), __builtin_bit_cast(i32x4, At[m].v[k]), __builtin_bit_cast(i32x4, acc[ai][bj][m][n]), 0, 0, 0)); \
            else acc[ai][bj][m][n] = __builtin_amdgcn_mfma_f32_16x16x32_bf16(Bt[n].v[k], At[m].v[k], acc[ai][bj][m][n], 0, 0, 0); } } } __builtin_amdgcn_s_setprio(0); } while (0)
#define PG8_WAIT_V(n) asm volatile("s_waitcnt vmcnt(" #n ")" ::: "memory")
#define PG8_WAIT_L(n) asm volatile("s_waitcnt lgkmcnt(" #n ")" ::: "memory")
#define PG8_BAR __builtin_amdgcn_s_barrier()
#define PG8_SCHED __builtin_amdgcn_sched_barrier(0)
    Unit cur, nxt; int ui = 0;
#ifdef GEMM_TIME
    long long gacc_ = 0;
#endif
    if (!S.next(0, cur)) return;
    f32x4 acc[2][2][4][2];
#pragma unroll
    for (int a = 0; a < 2; ++a)
#pragma unroll
        for (int b = 0; b < 2; ++b)
#pragma unroll
            for (int m = 0; m < 4; ++m)
#pragma unroll
                for (int n = 0; n < 2; ++n) acc[a][b][m][n] = (f32x4){0.f, 0.f, 0.f, 0.f};
    Frag<Epi::F8> At[4], B0[2], B1[2];
    const int f8scale = 0x7f7f7f7f;
    (void)f8scale;
    const char* cA = S.a_base(g, cur); const char* cB = S.b_base(g, cur);
    unsigned voC[2][2], voN[2][2];
    S.a_off(g, cur, sR, sC, voC);
    S.a_ready(cur);
    static_assert(SP2, "only the two-MFMA-blocks-per-barrier-pair loop is kept");
    PG8_STAGE(PG8_SB(0, 0), cB, voffB); PG8_STAGE(PG8_SB(0, 1), cB + hstep, voffB); PG8_STAGE_A(PG8_SA(0, 0), cA, voC, 0); PG8_STAGE_A(PG8_SA(0, 1), cA, voC, 1);
    if (wr == 1) PG8_BAR;
    PG8_WAIT_V(2); PG8_BAR;
    PG8_STAGE(PG8_SB(1, 0), cB + kstep, voffB); PG8_STAGE_A(PG8_SA(1, 0), cA + kstep, voC, 0); PG8_STAGE(PG8_SB(1, 1), cB + hstep + kstep, voffB);
    PG8_WAIT_V(6); PG8_BAR;
    for (;;) {
        const bool has_next = S.next(ui + 1, nxt);
        const char* nA = has_next ? S.a_base(g, nxt) : cA; const char* nB = has_next ? S.b_base(g, nxt) : cB;
        if (has_next) S.a_off(g, nxt, sR, sC, voN); else {
#pragma unroll
            for (int h_ = 0; h_ < 2; ++h_) { voN[h_][0] = voC[h_][0]; voN[h_][1] = voC[h_][1]; } }
#pragma unroll 1
        for (int t = 0; t < nt; t += 2) {
            const bool last = (t == nt - 2);
            const char* a1 = cA + (size_t)(t + 1) * kstep;
            const char* a2 = last ? nA : cA + (size_t)(t + 2) * kstep; const char* b2 = last ? nB : cB + (size_t)(t + 2) * kstep;
            const char* a3 = a2 + kstep; const char* b3 = b2 + kstep;
            if (last && has_next) S.a_ready(nxt);
            unsigned vo2[2][2];
#pragma unroll
            for (int h_ = 0; h_ < 2; ++h_) { vo2[h_][0] = last ? voN[h_][0] : voC[h_][0]; vo2[h_][1] = last ? voN[h_][1] : voC[h_][1]; }
            PG8_LDB(B0, 0, 0); PG8_LDB(B1, 0, 1); PG8_SCHED; PG8_LDA(At, 0, 0); PG8_STAGE_A(PG8_SA(1, 1), a1, voC, 1);
            PG8_WAIT_V(8); PG8_WAIT_L(0); PG8_BAR; PG8_MMA(0, 0, At, B0); PG8_MMA(0, 1, At, B1); PG8_BAR; PG8_SCHED;
            PG8_LDA(At, 0, 1); PG8_STAGE(PG8_SB(0, 0), b2, voffB); PG8_STAGE(PG8_SB(0, 1), b2 + hstep, voffB); PG8_STAGE_A(PG8_SA(0, 0), a2, vo2, 0);
            PG8_WAIT_V(8); PG8_WAIT_L(0); PG8_BAR; PG8_MMA(1, 0, At, B0); PG8_MMA(1, 1, At, B1); PG8_BAR; PG8_SCHED;
            PG8_LDB(B0, 1, 0); PG8_LDB(B1, 1, 1); PG8_SCHED; PG8_LDA(At, 1, 0); PG8_STAGE_A(PG8_SA(0, 1), a2, vo2, 1);
            PG8_WAIT_V(8); PG8_WAIT_L(0); PG8_BAR; PG8_MMA(0, 0, At, B0); PG8_MMA(0, 1, At, B1); PG8_BAR; PG8_SCHED;
            PG8_LDA(At, 1, 1); PG8_STAGE(PG8_SB(1, 0), b3, voffB); PG8_STAGE(PG8_SB(1, 1), b3 + hstep, voffB); PG8_STAGE_A(PG8_SA(1, 0), a3, vo2, 0);
            PG8_WAIT_V(8); PG8_WAIT_L(0); PG8_BAR; PG8_MMA(1, 0, At, B0); PG8_MMA(1, 1, At, B1); PG8_BAR; PG8_SCHED;
        }
        if constexpr (ALIGN_EPI) { if (wr == 0) PG8_BAR; }
#ifdef GEMM_TIME
        const long long gt0_ = clock64();
#endif
        if constexpr (!Epi::AFTER_DRAIN) { E(acc, cur, wr, wc, fr, fq); S.done(cur); }
#ifdef GEMM_TIME
        gacc_ += clock64() - gt0_;
#endif
        if (!has_next) break;
#pragma unroll
        for (int a = 0; a < 2; ++a)
#pragma unroll
            for (int b = 0; b < 2; ++b)
#pragma unroll
                for (int m = 0; m < 4; ++m)
#pragma unroll
                    for (int n = 0; n < 2; ++n) acc[a][b][m][n] = (f32x4){0.f, 0.f, 0.f, 0.f};
        cur = nxt; cA = nA; cB = nB; ++ui;
#pragma unroll
        for (int h_ = 0; h_ < 2; ++h_) { voC[h_][0] = voN[h_][0]; voC[h_][1] = voN[h_][1]; }
        if constexpr (ALIGN_EPI) { if (wr == 1) PG8_BAR; }
    }
    PG8_WAIT_V(0);
    if constexpr (!ALIGN_EPI) { if (wr == 0) PG8_BAR; }
    PG8_BAR;
#ifdef GEMM_TIME
    { const long long s0_ = clock64(); while (clock64() - s0_ < gacc_) __builtin_amdgcn_s_sleep(8); }
#endif
    if constexpr (Epi::AFTER_DRAIN) { E.fused(acc, cur, wr, wc, fr, fq, lds, wid, lane); S.done(cur); }
#undef PG8_SA
#undef PG8_SB
#undef PG8_STAGE
#undef PG8_STAGE_A
#undef PG8_LDA
#undef PG8_LDB
#undef PG8_MMA
#undef PG8_WAIT_V
#undef PG8_WAIT_L
#undef PG8_BAR
#undef PG8_SCHED
}
}

constexpr int NWAVES = 8;
constexpr int T = 32768, D = 1024, SEQ = 8192, NBATCH = 4, NCHUNK = SEQ / 64;
constexpr int INC = 3328;
constexpr int PRW = 1536;
constexpr int NEXP = 32, TOPK = 4;
constexpr int NRB_MAX = T * TOPK / 256 + NEXP;
constexpr int NROWS_MAX = NRB_MAX * 256;
constexpr int NITEM = NBATCH * NCHUNK * 8;

constexpr size_t MiB = 1u << 20, KiB = 1u << 10;
constexpr size_t WS_CTL = 0, CTL_ZERO_BYTES = 1 * MiB;
constexpr size_t WS_META = 1 * MiB;
constexpr size_t WS_CNT = 1 * MiB + 64 * KiB;
constexpr size_t WS_EIDX = 2 * MiB, WS_GATE = 2 * MiB + 512 * KiB, WS_LRANK = 3 * MiB, WS_INV = 3 * MiB + 512 * KiB;
constexpr size_t WS_RSTD = 4 * MiB, WS_ROWRSTD = 4 * MiB + 256 * KiB;
constexpr size_t WS_WRT = 5 * MiB;
constexpr size_t WS_PAR = 5 * MiB + 128 * KiB;
constexpr size_t WS_WDEC = 5 * MiB + 256 * KiB, WS_WAAA = WS_WDEC + 64 * KiB, WS_WGATE = WS_WAAA + 64 * KiB;
constexpr size_t WS_WIN = 6 * MiB, WS_WOUT = 13 * MiB;
constexpr size_t WS_ROWTOK = 15 * MiB;
constexpr size_t WS_WUP = 16 * MiB, WS_WDN = 144 * MiB;
constexpr size_t WS_XN = 208 * MiB;
constexpr size_t WS_PROJ = 272 * MiB;
constexpr size_t WS_MIX = 480 * MiB;
constexpr size_t WS_RW = 544 * MiB;
constexpr size_t WS_XG = 272 * MiB, WS_ACT = 544 * MiB, WS_YR = WS_XG;
constexpr size_t WS_COLSC = 15 * MiB + 640 * KiB;
constexpr size_t WS_COLSC2 = 15 * MiB + 896 * KiB;
constexpr size_t WS_XQ = WS_MIX;
constexpr size_t WS_END = 1000 * MiB;
constexpr int CW_ATT = 8192;
constexpr int CW_BAR = 4096;

constexpr int RING_BYTES = 131072;
constexpr int LDS_BYTES = 163840;
constexpr int MISC_OFF = LDS_BYTES - 256;

#define GAS __attribute__((address_space(1)))
#define LAS __attribute__((address_space(3)))
#define DI __device__ __forceinline__
typedef unsigned short bf16;
typedef unsigned v4u __attribute__((ext_vector_type(4)));
typedef unsigned v2u __attribute__((ext_vector_type(2)));
typedef float f32x4 __attribute__((ext_vector_type(4)));
typedef float f32x2 __attribute__((ext_vector_type(2)));
typedef short bf16x8 __attribute__((ext_vector_type(8)));
typedef __bf16 bf16x2_t __attribute__((ext_vector_type(2)));
#define LDS_WAIT() asm volatile("s_waitcnt lgkmcnt(0)" ::: "memory")
#define VM_WAIT() asm volatile("s_waitcnt vmcnt(0)" ::: "memory")
DI unsigned pk2(float lo, float hi) { const f32x2 v = {lo, hi}; const bf16x2_t b = __builtin_convertvector(v, bf16x2_t); return __builtin_bit_cast(unsigned, b); }
DI float bf2f(unsigned short b) { return __uint_as_float((unsigned)b << 16); }
DI float bflo(unsigned w) { return __uint_as_float(w << 16); }
DI float bfhi(unsigned w) { return __uint_as_float(w & 0xffff0000u); }
DI float wave_sum(float v) {
#pragma unroll
    for (int o = 1; o < 64; o <<= 1) v += __shfl_xor(v, o);
    return v;
}
DI float wave_max(float v) {
#pragma unroll
    for (int o = 1; o < 64; o <<= 1) v = fmaxf(v, __shfl_xor(v, o));
    return v;
}
DI float sigmoidf_(float x) { return 1.0f / (1.0f + __expf(-x)); }

DI float quad_sum(float x) {
    const unsigned a = __builtin_bit_cast(unsigned, x); const auto r = __builtin_amdgcn_permlane32_swap(a, a, false, false);
    const float y = __builtin_bit_cast(float, (unsigned)r[0]) + __builtin_bit_cast(float, (unsigned)r[1]);
    const unsigned b = __builtin_bit_cast(unsigned, y); const auto s = __builtin_amdgcn_permlane16_swap(b, b, false, false);
    return __builtin_bit_cast(float, (unsigned)s[0]) + __builtin_bit_cast(float, (unsigned)s[1]);
}
DI float quad_max(float x) {
    const unsigned a = __builtin_bit_cast(unsigned, x); const auto r = __builtin_amdgcn_permlane32_swap(a, a, false, false);
    const float y = fmaxf(__builtin_bit_cast(float, (unsigned)r[0]), __builtin_bit_cast(float, (unsigned)r[1]));
    const unsigned b = __builtin_bit_cast(unsigned, y); const auto s = __builtin_amdgcn_permlane16_swap(b, b, false, false);
    return fmaxf(__builtin_bit_cast(float, (unsigned)s[0]), __builtin_bit_cast(float, (unsigned)s[1]));
}
#define XB_TMO      128
#define XB_XCNT(j)  (256  + 64 * (j))
#define XB_XSUB(j)  (1280 + 64 * (j))
#define XB_XGEN(j)  (2304 + 64 * (j))
#define XB_TOP      3328
#define XB_TOPGEN   3392
#define XCD_BAR_WORDS 3456
#define XB_SPIN_CAP (NAIVE_RWKV ? (1u << 25) : (1u << 20))

__device__ __forceinline__ unsigned xb_ld(unsigned* p)              { return __hip_atomic_load(p, __ATOMIC_RELAXED, __HIP_MEMORY_SCOPE_AGENT); }
__device__ __forceinline__ unsigned xb_add(unsigned* p, unsigned v) { return __hip_atomic_fetch_add(p, v, __ATOMIC_RELAXED, __HIP_MEMORY_SCOPE_AGENT); }
__device__ __forceinline__ unsigned xb_xcc_id() { return (unsigned)__builtin_amdgcn_s_getreg((3 << 11) | 20) & 0xFu; }
#define XB_SPIN(cond, bar) do { unsigned _sp = 0; while (cond) { __builtin_amdgcn_s_sleep(1); \
    if ((++_sp & 255u) == 0u) { if (xb_ld(&(bar)[XB_TMO])) break; if (_sp > XB_SPIN_CAP) { atomicAdd(&(bar)[XB_TMO], 1u); break; } } } } while (0)

struct XcdBarrier {
    unsigned* bar; unsigned x;
    volatile LAS unsigned* st;
};

__device__ __forceinline__ XcdBarrier xcd_barrier_post(unsigned* bar, volatile LAS unsigned* st) {
    XcdBarrier b; b.bar = bar; b.x = xb_xcc_id(); b.st = st;
    if (threadIdx.x == 0) (void)xb_add(&bar[XB_XCNT(b.x)], 1u);
    return b;
}
__device__ __forceinline__ void xcd_barrier_complete(unsigned* bar, unsigned x, unsigned& nloc, unsigned& nx) {
    const unsigned G = gridDim.x * gridDim.y * gridDim.z;
    unsigned sum, cnt, mine, sp = 0u;
    for (;;) {
        sum = 0u; cnt = 0u; mine = 0u;
#pragma unroll
        for (unsigned j = 0; j < 16; ++j) { const unsigned c = xb_ld(&bar[XB_XCNT(j)]); sum += c; cnt += (c > 0u) ? 1u : 0u; mine = (j == x) ? c : mine; }
        if (sum == G) break;
        __builtin_amdgcn_s_sleep(1);
        if ((++sp & 255u) == 0u) { if (xb_ld(&bar[XB_TMO])) break; if (sp > XB_SPIN_CAP) { atomicAdd(&bar[XB_TMO], 1u); break; } }
    }
    nloc = mine > 0u ? mine : 1u; nx = cnt > 0u ? cnt : 1u;
}

__device__ __forceinline__ void xcd_barrier(const XcdBarrier& b) {
    asm volatile("s_waitcnt vmcnt(0)" ::: "memory");
    __syncthreads();
    if (threadIdx.x == 0) {
        unsigned* bar = b.bar;
        __builtin_amdgcn_s_waitcnt(0);
        unsigned nloc = b.st[0], nx = b.st[1];
        if (nloc == 0u) { xcd_barrier_complete(bar, b.x, nloc, nx); b.st[0] = nloc; b.st[1] = nx; }
        const unsigned old = xb_add(&bar[XB_XSUB(b.x)], 1u);
        const unsigned gen = old / nloc;
        if (old + 1u == (gen + 1u) * nloc) {
            __builtin_amdgcn_fence(__ATOMIC_RELEASE, "agent");
            asm volatile("s_waitcnt vmcnt(0)" ::: "memory");
            const unsigned og = xb_add(&bar[XB_TOP], 1u);
            const unsigned tg = og / nx;
            if (og + 1u == (tg + 1u) * nx) xb_add(&bar[XB_TOPGEN], 1u);
            else XB_SPIN(xb_ld(&bar[XB_TOPGEN]) == tg, bar);
            __builtin_amdgcn_fence(__ATOMIC_ACQUIRE, "agent");
            xb_add(&bar[XB_XGEN(b.x)], 1u);
            asm volatile("s_waitcnt vmcnt(0)" ::: "memory");
        } else {
            XB_SPIN(xb_ld(&bar[XB_XGEN(b.x)]) == gen, bar);
            __builtin_amdgcn_fence(__ATOMIC_ACQUIRE, "agent");
            asm volatile("s_waitcnt vmcnt(0)" ::: "memory");
        }
    }
    __syncthreads();
}

struct Args {
    const float* in[25]; float* out; unsigned char* ws; int ph_lo, ph_hi, ph_rep, pad_;
};
enum { I_X = 0, I_N1G, I_WIN, I_MU, I_QG, I_KG, I_RELB, I_W0, I_WDEC, I_A0, I_WAAA, I_WGATE, I_KK, I_KA, I_RK, I_LNG, I_LNB, I_WOUT, I_N2G, I_WR, I_BR, I_WUP, I_BUP, I_WDN, I_BDN };
struct Frame {
    LAS unsigned char* lds;
    int tid, lane, wave, G, bid;
};


struct TrRegs { f32x4 v[8]; f32x4 s0, s1; bf16* dst; int ldo; };
DI void tr_load(TrRegs& t, const float* __restrict__ W, int ldw, int k0, int n0, bf16* WT, int ldo, long drow, int lane, const float* __restrict__ ksc8 = nullptr) {
    const int r8 = lane >> 3, c4 = lane & 7;
    t.s0 = (f32x4){1.f, 1.f, 1.f, 1.f}; t.s1 = t.s0; if (ksc8) { t.s0 = *(const f32x4*)ksc8; t.s1 = *(const f32x4*)(ksc8 + 4); }
    const float* src = W + (size_t)(k0 + 8 * r8) * ldw + n0 + 4 * c4;
#pragma unroll
    for (int i = 0; i < 8; ++i) t.v[i] = __builtin_nontemporal_load((const f32x4*)(src + (size_t)i * ldw));
    t.dst = WT + (size_t)(drow + 4 * c4) * ldo + k0 + 8 * r8; t.ldo = ldo;
}
DI void tr_store(const TrRegs& t, const float* __restrict__ = nullptr) {
    const f32x4 s0 = t.s0, s1 = t.s1;
#pragma unroll
    for (int j = 0; j < 4; ++j) { const v4u o = {pk2(t.v[0][j] * s0[0], t.v[1][j] * s0[1]), pk2(t.v[2][j] * s0[2], t.v[3][j] * s0[3]), pk2(t.v[4][j] * s1[0], t.v[5][j] * s1[1]), pk2(t.v[6][j] * s1[2], t.v[7][j] * s1[3])};
        __builtin_nontemporal_store(o, (v4u*)(t.dst + (size_t)j * t.ldo)); }
}
DI void tr_item(const float* __restrict__ W, int ldw, int k0, int n0, bf16* WT, int ldo, long drow, LAS float* scr, int lane, const float* __restrict__ ksc) {
    (void)scr; TrRegs t; tr_load(t, W, ldw, k0, n0, WT, ldo, drow, lane, ksc ? ksc + k0 + 8 * (lane >> 3) : nullptr); tr_store(t);
}
constexpr int MOE_TR_UP = NEXP * 16 * 64, MOE_TR_DN = NEXP * 16 * 32, MOE_TR_ALL = MOE_TR_UP + MOE_TR_DN;
DI const float* moe_tr_load(TrRegs& t, const Args& a, int r, int lane) {
    unsigned char* ws = a.ws;
    if (r < MOE_TR_UP) { const int e = r / 1024, kb = (r % 1024) / 64, nb = r % 64, n0 = 32 * nb; const int n1 = n0 & 1023;
        const long drow = (long)(n1 / 128) * 256 + (n0 >= 1024 ? 128 : 0) + (n1 % 128);
        tr_load(t, a.in[I_WUP] + (size_t)e * 1024 * 2048, 2048, 64 * kb, n0, (bf16*)(ws + WS_WUP) + (size_t)e * 2048 * 1024, 1024, drow, lane, a.in[I_N2G] + 64 * kb + 8 * (lane >> 3));
        return nullptr; }
    r -= MOE_TR_UP; const int e = r / 512, kb = (r % 512) / 32, nb = r % 32;
    tr_load(t, a.in[I_WDN] + (size_t)e * 1024 * 1024, 1024, 64 * kb, 32 * nb, (bf16*)(ws + WS_WDN) + (size_t)e * 1024 * 1024, 1024, 32 * nb, lane);
    return nullptr;
}
DI void moe_tr_item(const Args& a, int r, LAS float* scr, int lane) { (void)scr; TrRegs t; const float* s = moe_tr_load(t, a, r, lane); tr_store(t, s); }
DI unsigned q_pack4(float a, float b, float c, float d) {
    const unsigned ua = __builtin_bit_cast(unsigned, a), ub = __builtin_bit_cast(unsigned, b), uc = __builtin_bit_cast(unsigned, c), ud = __builtin_bit_cast(unsigned, d);
    return (ua & 0xffu) | ((ub & 0xffu) << 8) | ((uc & 0xffu) << 16) | (ud << 24); }
constexpr float Q_MAGIC = 12582912.0f;
template <bool DOWN>
DI void moe_q_batch(const Args& a, int batch, int wave, int lane, LAS float* exch) {
    unsigned char* ws = a.ws;
    constexpr int LDW = DOWN ? 1024 : 2048, SPE = LDW / 32;
    const int strip = batch * 4 + (wave >> 1), half = wave & 1, e = strip / SPE, nb = strip % SPE, n0 = 32 * nb, n1 = n0 & 1023;
    const int r8 = lane >> 3, c4 = lane & 7;
    const long drow = DOWN ? (long)n0 : (long)(n1 / 128) * 256 + (n0 >= 1024 ? 128 : 0) + (n1 % 128);
    const float* W = a.in[DOWN ? I_WDN : I_WUP] + (size_t)e * 1024 * LDW + (size_t)(512 * half + 8 * r8) * LDW + n0 + 4 * c4;
    const float* gk = a.in[I_N2G] + 512 * half + 8 * r8;
    const f32x4 one = {1.f, 1.f, 1.f, 1.f};
    f32x4 mx = {0.f, 0.f, 0.f, 0.f};
    for (int g = 0; g < 8; g += 4) {
        f32x4 v[4][8], s0[4], s1[4];
#pragma unroll
        for (int t = 0; t < 4; ++t) { s0[t] = DOWN ? one : *(const f32x4*)(gk + 64 * (g + t)); s1[t] = DOWN ? one : *(const f32x4*)(gk + 64 * (g + t) + 4);
#pragma unroll
            for (int i = 0; i < 8; ++i) v[t][i] = *(const f32x4*)(W + (size_t)(64 * (g + t) + i) * LDW); }
#pragma unroll
        for (int t = 0; t < 4; ++t)
#pragma unroll
            for (int i = 0; i < 8; ++i) { const float s = i < 4 ? s0[t][i] : s1[t][i - 4]; const f32x4 p = v[t][i] * s;
#pragma unroll
                for (int j = 0; j < 4; ++j) mx[j] = fmaxf(mx[j], fabsf(p[j])); }
    }
#pragma unroll
    for (int j = 0; j < 4; ++j) { float m = mx[j]; m = fmaxf(m, __shfl_xor(m, 8)); m = fmaxf(m, __shfl_xor(m, 16)); m = fmaxf(m, __shfl_xor(m, 32)); mx[j] = m; }
    if (r8 == 0) *(LAS f32x4*)(exch + (wave * 8 + c4) * 4) = mx;
    __syncthreads();
    { const f32x4 o = *(const LAS f32x4*)(exch + ((wave ^ 1) * 8 + c4) * 4);
#pragma unroll
      for (int j = 0; j < 4; ++j) mx[j] = fmaxf(mx[j], o[j]); }
    constexpr float QMAX = DOWN ? 256.0f : 127.0f;
    if (half == 0 && r8 == 0) *(f32x4*)((float*)(ws + (DOWN ? WS_COLSC2 : WS_COLSC)) + (size_t)e * LDW + n0 + 4 * c4) = mx * (1.0f / QMAX);
    f32x4 inv;
#pragma unroll
    for (int j = 0; j < 4; ++j) inv[j] = mx[j] > 0.f ? QMAX / mx[j] : 0.f;
    unsigned char* dst = ws + (DOWN ? WS_WDN : WS_WUP) + ((size_t)e * LDW + drow + 4 * c4) * 1024 + 512 * half + 8 * r8;
    for (int g = 0; g < 8; g += 2) {
        f32x4 v[2][8], s0[2], s1[2];
#pragma unroll
        for (int t = 0; t < 2; ++t) { s0[t] = DOWN ? one : *(const f32x4*)(gk + 64 * (g + t)); s1[t] = DOWN ? one : *(const f32x4*)(gk + 64 * (g + t) + 4);
#pragma unroll
            for (int i = 0; i < 8; ++i) v[t][i] = __builtin_nontemporal_load((const f32x4*)(W + (size_t)(64 * (g + t) + i) * LDW)); }
#pragma unroll
        for (int t = 0; t < 2; ++t) {
            f32x4 p[8];
#pragma unroll
            for (int i = 0; i < 8; ++i) { const float s = i < 4 ? s0[t][i] : s1[t][i - 4]; p[i] = DOWN ? v[t][i] * inv : (v[t][i] * s) * inv + Q_MAGIC; }
#pragma unroll
            for (int j = 0; j < 4; ++j) { v2u o;
                if (DOWN) { o.x = (unsigned)__builtin_amdgcn_cvt_pk_fp8_f32(p[2][j], p[3][j], __builtin_amdgcn_cvt_pk_fp8_f32(p[0][j], p[1][j], 0, false), true);
                            o.y = (unsigned)__builtin_amdgcn_cvt_pk_fp8_f32(p[6][j], p[7][j], __builtin_amdgcn_cvt_pk_fp8_f32(p[4][j], p[5][j], 0, false), true); }
                else { o.x = q_pack4(p[0][j], p[1][j], p[2][j], p[3][j]); o.y = q_pack4(p[4][j], p[5][j], p[6][j], p[7][j]); }
                __builtin_nontemporal_store(o, (v2u*)(dst + (size_t)j * 1024 + 64 * (g + t))); } }
    }
}
DI void moe_tr_batch(const Args& a, int batch, int wave, int lane, LAS float* exch) {
    if (batch < MOE_TR_UP / 64) moe_q_batch<false>(a, batch, wave, lane, exch); else moe_q_batch<true>(a, batch - MOE_TR_UP / 64, wave, lane, exch);
}
constexpr int MOE_TR_BATCHES = MOE_TR_ALL / 64, MOE_TR_EARLY = 256;

#if !NAIVE_ATT
constexpr int ATT_KS = 144;
constexpr int ATT_TILE = 64 * ATT_KS;
constexpr int ATT_BIAS_OFF = 4 * ATT_TILE;
constexpr int ATT_NSLOT = (NBATCH * 8 * (NCHUNK / 2) / 8) * 11;
static_assert(NBATCH * 8 * (NCHUNK / 2) == 2048 && MOE_TR_ALL == 256 * 3 * 64, "attention / conversion work queue");
DI int att_pos(int key) { return (key & 32) + 8 * ((key >> 2) & 3) + 4 * ((key >> 4) & 1) + (key & 3); }
DI void attn_phase(const Frame& F, const Args& a, const int qid = 0) {
    const bf16* proj = (const bf16*)(a.ws + WS_PROJ); bf16* mix = (bf16*)(a.ws + WS_MIX);
    LAS unsigned char* lds = F.lds; LAS float* sbias = (LAS float*)(lds + ATT_BIAS_OFF);
    const int l = F.lane, n16 = l & 15, q = l >> 4, w = F.wave;
    const float LOG2E = 1.4426950408889634f;
    const int srow = F.tid >> 3, spc = F.tid & 7;
    float kgv[8];
#pragma unroll
    for (int j = 0; j < 8; ++j) kgv[j] = a.in[I_KG][8 * spc + j];
    const int spos = att_pos(srow);
    LAS int* s_item = (LAS int*)(lds + ATT_BIAS_OFF + 1024);
    unsigned* qhead = (unsigned*)(a.ws + WS_CTL) + CW_ATT + 64 * qid;
    for (;;) {
        __syncthreads();
        if (F.tid == 0) *s_item = (int)__hip_atomic_fetch_add(qhead, 1u, __ATOMIC_RELAXED, __HIP_MEMORY_SCOPE_AGENT);
        __syncthreads();
        const int slot = *s_item;
        if (slot >= ATT_NSLOT) break;
        const int grp = slot / 11, sub = slot % 11;
        if (sub >= 8) { const int base = (grp * 3 + (sub - 8)) * 64 + w * 8;
            (void)base; moe_tr_batch(a, grp * 3 + (sub - 8), w, l, (LAS float*)(lds + ATT_BIAS_OFF + 2048));
            continue; }
        const int item = grp * 8 + sub;
        const int b = item / (8 * (NCHUNK / 2)), h = (item / (NCHUNK / 2)) & 7, n0 = 2 * (item % (NCHUNK / 2));
        if (F.tid < 192) sbias[F.tid] = a.in[I_RELB][h * 192 + F.tid] * LOG2E;
        const int nq = n0 + (w >> 2), qpos = 16 * (w & 3) + n16;
        const size_t qtok = (size_t)b * SEQ + nq * 64 + qpos;
        bf16x8 qf[2];
        { const v4u q0 = *(const v4u*)(proj + qtok * INC + h * 64 + 8 * q), q1 = *(const v4u*)(proj + qtok * INC + h * 64 + 32 + 8 * q);
          float f[16]; const unsigned ww[8] = {q0.x, q0.y, q0.z, q0.w, q1.x, q1.y, q1.z, q1.w};
          float ss = 0.f;
#pragma unroll
          for (int e = 0; e < 8; ++e) { f[2 * e] = bflo(ww[e]); f[2 * e + 1] = bfhi(ww[e]); ss += f[2 * e] * f[2 * e] + f[2 * e + 1] * f[2 * e + 1]; }
          ss = quad_sum(ss);
          const float rs = (1.0f / sqrtf(ss * (1.f / 64.f) + 1e-6f)) * 0.125f * LOG2E;
          unsigned pk[8];
#pragma unroll
          for (int e = 0; e < 8; ++e) { const int d = (e < 4 ? 0 : 32) + 8 * q + 2 * (e & 3); pk[e] = pk2(f[2 * e] * rs * a.in[I_QG][d], f[2 * e + 1] * rs * a.in[I_QG][d + 1]); }
          const v4u p0 = {pk[0], pk[1], pk[2], pk[3]}, p1 = {pk[4], pk[5], pk[6], pk[7]};
          qf[0] = __builtin_bit_cast(bf16x8, p0); qf[1] = __builtin_bit_cast(bf16x8, p1); }
        f32x4 o[4];
#pragma unroll
        for (int dt = 0; dt < 4; ++dt) o[dt] = (f32x4){0.f, 0.f, 0.f, 0.f};
        float m_run = -3.0e38f, l_run = 0.f;
        v4u kreg, vreg;
        auto gload = [&](int jc) { const int kc = n0 - 8 + jc; if (kc >= 0) { const size_t tok = (size_t)b * SEQ + kc * 64 + srow;
            kreg = *(const v4u*)(proj + tok * INC + 512 + h * 64 + 8 * spc); vreg = *(const v4u*)(proj + tok * INC + 1024 + h * 64 + 8 * spc); } };
        auto lstore = [&](int jc) { const int kc = n0 - 8 + jc; if (kc >= 0) { LAS unsigned char* kb = lds + (jc & 1) * 2 * ATT_TILE; LAS unsigned char* vb = kb + ATT_TILE;
            const unsigned ww[4] = {kreg.x, kreg.y, kreg.z, kreg.w}; float f[8]; float ss = 0.f;
#pragma unroll
            for (int e = 0; e < 4; ++e) { f[2 * e] = bflo(ww[e]); f[2 * e + 1] = bfhi(ww[e]); ss += f[2 * e] * f[2 * e] + f[2 * e + 1] * f[2 * e + 1]; }
            ss += __builtin_bit_cast(float, __builtin_amdgcn_update_dpp(0, __builtin_bit_cast(int, ss), 0xB1, 0xf, 0xf, true));
            ss += __builtin_bit_cast(float, __builtin_amdgcn_update_dpp(0, __builtin_bit_cast(int, ss), 0x4E, 0xf, 0xf, true));
            ss += __builtin_bit_cast(float, __builtin_amdgcn_update_dpp(0, __builtin_bit_cast(int, ss), 0x141, 0xf, 0xf, true));
            const float rs = 1.0f / sqrtf(ss * (1.f / 64.f) + 1e-6f);
            v4u kk; kk.x = pk2(f[0] * rs * kgv[0], f[1] * rs * kgv[1]); kk.y = pk2(f[2] * rs * kgv[2], f[3] * rs * kgv[3]); kk.z = pk2(f[4] * rs * kgv[4], f[5] * rs * kgv[5]); kk.w = pk2(f[6] * rs * kgv[6], f[7] * rs * kgv[7]);
            *(LAS v4u*)(kb + srow * ATT_KS + 16 * spc) = kk;
            const unsigned vv[4] = {vreg.x, vreg.y, vreg.z, vreg.w};
#pragma unroll
            for (int e = 0; e < 4; ++e) { *(LAS unsigned short*)(vb + (8 * spc + 2 * e) * ATT_KS + 2 * spos) = (unsigned short)(vv[e] & 0xffffu);
                                          *(LAS unsigned short*)(vb + (8 * spc + 2 * e + 1) * ATT_KS + 2 * spos) = (unsigned short)(vv[e] >> 16); } } };
        gload(0); lstore(0);
        __syncthreads();
        for (int jc = 0; jc < 10; ++jc) {
            if (jc + 1 < 10) gload(jc + 1);
            const int kc = n0 - 8 + jc, dj = jc - (w >> 2);
            if (kc >= 0 && dj >= 0 && dj <= 8) {
                const LAS unsigned char* kb = lds + (jc & 1) * 2 * ATT_TILE; const LAS unsigned char* vb = kb + ATT_TILE;
                f32x4 sc[4];
#pragma unroll
                for (int mt = 0; mt < 4; ++mt) { sc[mt] = (f32x4){0.f, 0.f, 0.f, 0.f};
#pragma unroll
                    for (int ks = 0; ks < 2; ++ks) { const bf16x8 kf = *(const LAS bf16x8*)(kb + (16 * mt + n16) * ATT_KS + 64 * ks + 16 * q);
                        sc[mt] = __builtin_amdgcn_mfma_f32_16x16x32_bf16(kf, qf[ks], sc[mt], 0, 0, 0); } }
                float boff = 0.f;
                if (dj <= 5) boff = sbias[0];
                else { const int base = (dj - 8) * 64 - qpos + 128;
#pragma unroll
                    for (int mt = 0; mt < 4; ++mt)
#pragma unroll
                        for (int i = 0; i < 4; ++i) { int idx = base + 16 * mt + 4 * q + i; idx = idx < 0 ? 0 : idx; const float bv_ = sbias[idx];
                            sc[mt][i] += bv_; } }
                float mx = sc[0][0];
#pragma unroll
                for (int mt = 0; mt < 4; ++mt)
#pragma unroll
                    for (int i = 0; i < 4; ++i) mx = fmaxf(mx, sc[mt][i]);
                mx = quad_max(mx);
                const float m_new = fmaxf(m_run, mx + boff), alpha = __builtin_amdgcn_exp2f(m_run - m_new), msub = m_new - boff;
                const bool moved = __builtin_amdgcn_ballot_w64(m_new != m_run) != 0ull;
                m_run = m_new; float ls = 0.f;
#pragma unroll
                for (int mt = 0; mt < 4; ++mt)
#pragma unroll
                    for (int i = 0; i < 4; ++i) { sc[mt][i] = __builtin_amdgcn_exp2f(sc[mt][i] - msub); ls += sc[mt][i]; }
                if (moved) { l_run *= alpha;
#pragma unroll
                    for (int dt = 0; dt < 4; ++dt) o[dt] = o[dt] * alpha; }
                l_run += ls;
#pragma unroll
                for (int s = 0; s < 2; ++s) {
                    const v4u pp = {pk2(sc[2 * s][0], sc[2 * s][1]), pk2(sc[2 * s][2], sc[2 * s][3]), pk2(sc[2 * s + 1][0], sc[2 * s + 1][1]), pk2(sc[2 * s + 1][2], sc[2 * s + 1][3])};
                    const bf16x8 pf = __builtin_bit_cast(bf16x8, pp);
#pragma unroll
                    for (int dt = 0; dt < 4; ++dt) { const bf16x8 vf = *(const LAS bf16x8*)(vb + (16 * dt + n16) * ATT_KS + 64 * s + 16 * q);
                        o[dt] = __builtin_amdgcn_mfma_f32_16x16x32_bf16(vf, pf, o[dt], 0, 0, 0); } }
            }
            if (jc + 1 < 10) lstore(jc + 1);
            __syncthreads();
        }
        l_run = quad_sum(l_run);
        const float inv = 1.0f / l_run;
#pragma unroll
        for (int dt = 0; dt < 4; ++dt) { v2u ov; ov.x = pk2(o[dt][0] * inv, o[dt][1] * inv); ov.y = pk2(o[dt][2] * inv, o[dt][3] * inv);
            *(v2u*)(mix + qtok * 1024 + h * 64 + 16 * dt + 4 * q) = ov; }
    }
}
#endif

#if !NAIVE_RWKV
constexpr int RA_HALF = 80896;
constexpr int RA_RT = 0, RA_KT = 9216, RA_BT = 18432, RA_AT = 27648;
constexpr int RA_VT = 36864, RA_KH = 46080, RA_BH = 55296;
constexpr int RA_AAB = 64512;
constexpr int RA_XWD = 0, RA_XAD = 9216, RA_XGD = 18432;
constexpr int RA_RHS2 = 0, RA_GEND = 17408;
constexpr int RA_W1T = 18432, RA_W2T = 27648;
constexpr int RA_WT = RA_AAB;
constexpr int RB_REC = 65536, RB_YLT = 0, RB_PCT = 8192, RB_G1T = 16384, RB_E2T = 24576, RB_MC = 32768, RB_CC = 40960, RB_SC = 57344;
static_assert(2 * RA_HALF <= MISC_OFF, "rwkv phase A LDS");

DI void ld8f(const bf16* p, float (&f)[8]) { const v4u w = *(const v4u*)p; f[0] = bflo(w.x); f[1] = bfhi(w.x); f[2] = bflo(w.y); f[3] = bfhi(w.y); f[4] = bflo(w.z); f[5] = bfhi(w.z); f[6] = bflo(w.w); f[7] = bfhi(w.w); }
DI void ld4f(const bf16* p, float (&f)[4]) { const v2u w = *(const v2u*)p; f[0] = bflo(w.x); f[1] = bfhi(w.x); f[2] = bflo(w.y); f[3] = bfhi(w.y); }
DI bf16x8 pack8(const f32x4& a, const f32x4& b) { const v4u p = {pk2(a[0], a[1]), pk2(a[2], a[3]), pk2(b[0], b[1]), pk2(b[2], b[3])}; return __builtin_bit_cast(bf16x8, p); }
DI float fast_sigmoid(float x) { return __builtin_amdgcn_rcpf(1.0f + __builtin_amdgcn_exp2f(-1.4426950408889634f * x)); }
DI float fast_tanh(float x) { return 1.0f - 2.0f * __builtin_amdgcn_rcpf(1.0f + __builtin_amdgcn_exp2f(2.8853900817779268f * x)); }
#define MFMA16(a, b, c) __builtin_amdgcn_mfma_f32_16x16x32_bf16((a), (b), (c), 0, 0, 0)

DI void rwkv_phase_a(const Frame& F, const Args& a) {
    unsigned char* ws = a.ws; unsigned char* rb = ws + WS_RW;
    const bf16* wdec = (const bf16*)(ws + WS_WDEC); const bf16* waaa = (const bf16*)(ws + WS_WAAA); const bf16* wgate = (const bf16*)(ws + WS_WGATE);
    const float* mu = a.in[I_MU]; const float* par = (const float*)(ws + WS_PAR);
    const int hb = F.wave >> 2, w4 = F.wave & 3;
    LAS unsigned char* hbase = F.lds + hb * RA_HALF;
    const float LOG2E = 1.4426950408889634f;
    v4u s0c[4];
#define RA_REQUEST(pair_) do { const int item_ = 2 * (pair_) + hb, c_ = (item_ >> 3) & 127, b_ = item_ >> 10; const size_t tok0_ = (size_t)b_ * SEQ + c_ * 64; \
        int lq_ = F.lane; asm volatile("" : "+v"(lq_)); size_t wsq_ = (size_t)ws; asm volatile("" : "+s"(wsq_)); const int t9q_ = (hb << 8) | (w4 << 6) | lq_; \
        const bf16* cur_ = (const bf16*)(wsq_ + WS_PROJ) + (tok0_ + (t9q_ >> 3)) * INC + PRW + 1536 + 32 * (t9q_ & 7); \
        _Pragma("unroll") for (int g8 = 0; g8 < 4; ++g8) s0c[g8] = *(const v4u*)(cur_ + 8 * g8); } while (0)
    if (F.bid < NITEM / 2) RA_REQUEST(F.bid);
    for (int pair = F.bid; pair < NITEM / 2; pair += F.G) {
        size_t wsb = (size_t)ws; asm volatile("" : "+s"(wsb)); const bf16* proj = (const bf16*)(wsb + WS_PROJ);
        int l = F.lane; asm volatile("" : "+v"(l));
        const int n16 = l & 15, q = l >> 4, t4 = (hb << 8 | (F.wave & 3) << 6 | l) & 255;
        const int tokl = 16 * w4 + n16;
        const int tslot = (tokl & 32) + 8 * ((tokl >> 2) & 3) + 4 * ((tokl >> 4) & 1) + (tokl & 3);
        const int item = 2 * pair + hb, h = item & 7, c = (item >> 3) & 127, b = item >> 10;
        const size_t tok0 = (size_t)b * SEQ + c * 64; unsigned char* rbi = rb + (size_t)item * RB_REC;
        const int t9 = (hb << 8) | t4, tk0 = t9 >> 3, part = t9 & 7;
        v4u s0p[4];
        { const bool first = (c == 0 && tk0 == 0); const bf16* prv = proj + (tok0 + tk0) * INC + PRW + 1536 + 32 * part - INC;
#pragma unroll
          for (int g8 = 0; g8 < 4; ++g8) { s0p[g8] = (v4u){0u, 0u, 0u, 0u}; if (!first) s0p[g8] = *(const v4u*)(prv + 8 * g8); } }
        v2u rawc[3][4], rawp[3][4];
        { const bool first = (c == 0 && tokl == 0); const bf16* cur = proj + (tok0 + tokl) * INC + PRW + h * 64 + 4 * q; const bf16* prv = cur - INC;
#pragma unroll
          for (int m = 0; m < 3; ++m)
#pragma unroll
              for (int ct = 0; ct < 4; ++ct) { rawc[m][ct] = *(const v2u*)(cur + 512 * m + 16 * ct); rawp[m][ct] = (v2u){0u, 0u}; if (!first) rawp[m][ct] = *(const v2u*)(prv + 512 * m + 16 * ct); } }
        bf16x8 wfr[2][8];
#define RA_WLOAD(dst, ctv) do { const int row_ = h * 64 + 16 * (ctv) + n16; \
            dst[0] = *(const bf16x8*)(wdec + row_ * 64 + 8 * q); dst[1] = *(const bf16x8*)(wdec + row_ * 64 + 32 + 8 * q); \
            dst[2] = *(const bf16x8*)(waaa + row_ * 64 + 8 * q); dst[3] = *(const bf16x8*)(waaa + row_ * 64 + 32 + 8 * q); \
            _Pragma("unroll") for (int ks_ = 0; ks_ < 4; ++ks_) dst[4 + ks_] = *(const bf16x8*)(wgate + row_ * 128 + 32 * ks_ + 8 * q); } while (0)
        RA_WLOAD(wfr[0], 0); RA_WLOAD(wfr[1], 1);
        __syncthreads();
        { const float esc = part < 2 ? 2.8853900817779268f : -1.4426950408889634f;
          LAS unsigned char* dst = F.lds + (part < 2 ? RA_XWD + tk0 * 144 + part * 64 : (part < 4 ? RA_XAD + tk0 * 144 + (part - 2) * 64 : RA_XGD + tk0 * 272 + (part - 4) * 64));
#pragma unroll
          for (int g8 = 0; g8 < 4; ++g8) {
              const unsigned xw[4] = {s0c[g8].x, s0c[g8].y, s0c[g8].z, s0c[g8].w}, pw[4] = {s0p[g8].x, s0p[g8].y, s0p[g8].z, s0p[g8].w};
              const f32x4 m0 = *(const f32x4*)(mu + 1536 + 32 * part + 8 * g8), m1 = *(const f32x4*)(mu + 1536 + 32 * part + 8 * g8 + 4);
              float y[8];
#pragma unroll
              for (int j = 0; j < 8; ++j) { const float x = (j & 1) ? bfhi(xw[j >> 1]) : bflo(xw[j >> 1]), p = (j & 1) ? bfhi(pw[j >> 1]) : bflo(pw[j >> 1]);
                  const float xs = x + (p - x) * (j < 4 ? m0[j & 3] : m1[j & 3]);
                  const float rc = __builtin_amdgcn_rcpf(1.0f + __builtin_amdgcn_exp2f(esc * xs));
                  y[j] = part < 2 ? 1.0f - 2.0f * rc : (part < 4 ? xs : rc); }
              const v4u o = {pk2(y[0], y[1]), pk2(y[2], y[3]), pk2(y[4], y[5]), pk2(y[6], y[7])};
              *(LAS v4u*)(dst + 16 * g8) = o; } }
        v2u shv[3][4];
#pragma unroll
        for (int m = 0; m < 3; ++m)
#pragma unroll
            for (int ct = 0; ct < 4; ++ct) { const v2u xw = rawc[m][ct], pw = rawp[m][ct];
                const f32x4 mm = *(const f32x4*)(mu + 512 * m + h * 64 + 16 * ct + 4 * q);
                const float x0 = bflo(xw.x), x1 = bfhi(xw.x), x2 = bflo(xw.y), x3 = bfhi(xw.y);
                shv[m][ct].x = pk2(x0 + (bflo(pw.x) - x0) * mm[0], x1 + (bfhi(pw.x) - x1) * mm[1]); shv[m][ct].y = pk2(x2 + (bflo(pw.y) - x2) * mm[2], x3 + (bfhi(pw.y) - x3) * mm[3]); }
        __syncthreads();
        f32x4 awl[4], aal[4], ag[4];
        { bf16x8 bwd[2], bad[2], bgd[4], wf2[2][8];
          RA_WLOAD(wf2[0], 2); RA_WLOAD(wf2[1], 3);
#pragma unroll
          for (int ks = 0; ks < 2; ++ks) { bwd[ks] = *(const LAS bf16x8*)(F.lds + RA_XWD + tokl * 144 + 64 * ks + 16 * q); bad[ks] = *(const LAS bf16x8*)(F.lds + RA_XAD + tokl * 144 + 64 * ks + 16 * q); }
#pragma unroll
          for (int ks = 0; ks < 4; ++ks) bgd[ks] = *(const LAS bf16x8*)(F.lds + RA_XGD + tokl * 272 + 64 * ks + 16 * q);
#pragma unroll
          for (int ct = 0; ct < 4; ++ct) { const bf16x8* wv = ct < 2 ? wfr[ct] : wf2[ct - 2];
              awl[ct] = (f32x4){0.f, 0.f, 0.f, 0.f}; aal[ct] = awl[ct]; ag[ct] = awl[ct];
#pragma unroll
              for (int ks = 0; ks < 2; ++ks) { awl[ct] = MFMA16(wv[ks], bwd[ks], awl[ct]); aal[ct] = MFMA16(wv[2 + ks], bad[ks], aal[ct]); }
#pragma unroll
              for (int ks = 0; ks < 4; ++ks) ag[ct] = MFMA16(wv[4 + ks], bgd[ks], ag[ct]); } }
#undef RA_WLOAD
        v2u rtp[4];
        {
#define RA_SHIFT(dst, pcol, ctv) do { const v2u w_ = shv[(pcol) / 512][ctv]; dst[0] = bflo(w_.x); dst[1] = bfhi(w_.x); dst[2] = bflo(w_.y); dst[3] = bfhi(w_.y); } while (0)
          float nrm = 0.f, bd = 0.f;
#pragma unroll
          for (int ct = 0; ct < 4; ++ct) { const int ch = h * 64 + 16 * ct + 4 * q;
              float r4[4], k4[4]; RA_SHIFT(r4, 0, ct); RA_SHIFT(k4, 512, ct);
              const f32x4 a0v = *(const f32x4*)(par + 512 + ch), kkv = *(const f32x4*)(par + 1024 + ch), kav = *(const f32x4*)(par + 1536 + ch), rkv = *(const f32x4*)(par + 2048 + ch);
#pragma unroll
              for (int i = 0; i < 4; ++i) { const float av = fast_sigmoid(a0v[i] + aal[ct][i]); const float kk = k4[i] * kkv[i]; nrm += kk * kk;
                  bd += r4[i] * (k4[i] * (1.0f + (av - 1.0f) * kav[i])) * rkv[i]; } }
          nrm = quad_sum(nrm); bd = quad_sum(bd);
          const float kinv = 1.0f / fmaxf(sqrtf(nrm), 1e-12f);
          float lw[4][4], lg[4][4], lgend[4][4];
#pragma unroll
          for (int ct = 0; ct < 4; ++ct) { const f32x4 w0v = *(const f32x4*)(par + h * 64 + 16 * ct + 4 * q);
#pragma unroll
              for (int i = 0; i < 4; ++i) { lw[ct][i] = (-0.6065306597126334f * LOG2E) * fast_sigmoid(w0v[i] + awl[ct][i]); float x = lw[ct][i];
                  x += __builtin_bit_cast(float, __builtin_amdgcn_update_dpp(0, __builtin_bit_cast(int, x), 0x111, 0xf, 0xf, false));
                  x += __builtin_bit_cast(float, __builtin_amdgcn_update_dpp(0, __builtin_bit_cast(int, x), 0x112, 0xf, 0xf, false));
                  x += __builtin_bit_cast(float, __builtin_amdgcn_update_dpp(0, __builtin_bit_cast(int, x), 0x114, 0xf, 0xf, false));
                  x += __builtin_bit_cast(float, __builtin_amdgcn_update_dpp(0, __builtin_bit_cast(int, x), 0x118, 0xf, 0xf, false));
                  lg[ct][i] = x; } }
          LAS float* wt = (LAS float*)(hbase + RA_WT);
          if (n16 == 15) {
#pragma unroll
              for (int ct = 0; ct < 4; ++ct) *(LAS f32x4*)(wt + w4 * 64 + 16 * ct + 4 * q) = (f32x4){lg[ct][0], lg[ct][1], lg[ct][2], lg[ct][3]}; }
          __syncthreads();
#pragma unroll
          for (int ct = 0; ct < 4; ++ct) { f32x4 off = {0.f, 0.f, 0.f, 0.f}, tot = {0.f, 0.f, 0.f, 0.f};
#pragma unroll
              for (int w = 0; w < 4; ++w) { const f32x4 t = *(const LAS f32x4*)(wt + w * 64 + 16 * ct + 4 * q); tot = tot + t; if (w < w4) off = off + t; }
#pragma unroll
              for (int i = 0; i < 4; ++i) { lg[ct][i] += off[i]; lgend[ct][i] = tot[i]; } }
#pragma unroll
          for (int ct = 0; ct < 4; ++ct) { const int ch = h * 64 + 16 * ct + 4 * q;
              float r4[4], k4[4], v4[4]; RA_SHIFT(r4, 0, ct); RA_SHIFT(k4, 512, ct); RA_SHIFT(v4, 1024, ct);
              const f32x4 a0v = *(const f32x4*)(par + 512 + ch), kkv = *(const f32x4*)(par + 1024 + ch), kav = *(const f32x4*)(par + 1536 + ch);
              const f32x4 lg_ = *(const f32x4*)(par + 2560 + ch), lb_ = *(const f32x4*)(par + 3072 + ch);
              float rtl[4], ktl[4], btl[4], atl[4], khh[4], bhh[4], g1[4], e2[4];
#pragma unroll
              for (int i = 0; i < 4; ++i) {
                  const float av = fast_sigmoid(a0v[i] + aal[ct][i]); const float k2 = k4[i] * (1.0f + (av - 1.0f) * kav[i]);
                  const float kkn = k4[i] * kkv[i] * kinv, bb = kkn * av;
                  const float gam = __builtin_amdgcn_exp2f(lg[ct][i]), gpv = __builtin_amdgcn_exp2f(lg[ct][i] - lw[ct][i]), gin = __builtin_amdgcn_exp2f(-lg[ct][i]), ger = __builtin_amdgcn_exp2f(lgend[ct][i] - lg[ct][i]);
                  rtl[i] = r4[i] * gam; ktl[i] = k2 * gin; btl[i] = bb * gin; atl[i] = -kkn * gpv; khh[i] = k2 * ger; bhh[i] = bb * ger;
                  const float g = ag[ct][i]; g1[i] = lg_[i] * g; e2[i] = (lb_[i] + bd * v4[i]) * g;
              }
              const int fo = ((w4 * 4 + ct) * 64 + l) * 8;
              v2u o; o.x = pk2(g1[0], g1[1]); o.y = pk2(g1[2], g1[3]); __builtin_nontemporal_store(o, (v2u*)(rbi + RB_G1T + fo));
              o.x = pk2(e2[0], e2[1]); o.y = pk2(e2[2], e2[3]); __builtin_nontemporal_store(o, (v2u*)(rbi + RB_E2T + fo));
              const int co = tokl * 144 + (16 * ct + 4 * q) * 2;
              o.x = pk2(rtl[0], rtl[1]); o.y = pk2(rtl[2], rtl[3]); *(LAS v2u*)(hbase + RA_RT + co) = o; rtp[ct] = o;
              o.x = pk2(ktl[0], ktl[1]); o.y = pk2(ktl[2], ktl[3]); *(LAS v2u*)(hbase + RA_KT + co) = o;
              o.x = pk2(btl[0], btl[1]); o.y = pk2(btl[2], btl[3]); *(LAS v2u*)(hbase + RA_BT + co) = o;
              o.x = pk2(atl[0], atl[1]); o.y = pk2(atl[2], atl[3]); *(LAS v2u*)(hbase + RA_AT + co) = o;
#pragma unroll
              for (int i = 0; i < 4; ++i) { const int ro = (16 * ct + 4 * q + i) * 144 + 2 * tslot;
                  if (tokl == 0) *(LAS float*)(hbase + RA_VT + (16 * ct + 4 * q + i) * 144 + 128) = __builtin_amdgcn_exp2f(lgend[ct][i]);
                  *(LAS unsigned short*)(hbase + RA_VT + ro) = (unsigned short)(pk2(v4[i], 0.f) & 0xffffu);
                  *(LAS unsigned short*)(hbase + RA_KH + ro) = (unsigned short)(pk2(khh[i], 0.f) & 0xffffu);
                  *(LAS unsigned short*)(hbase + RA_BH + ro) = (unsigned short)(pk2(bhh[i], 0.f) & 0xffffu); }
              asm volatile("" ::: "memory");
          }
#undef RA_SHIFT
        }
        __syncthreads();
        bf16x8 akp[2], rkp[2], rbp[2];
        { bf16x8 fa[2], fr[2];
#pragma unroll
          for (int ks = 0; ks < 2; ++ks) { fa[ks] = *(const LAS bf16x8*)(hbase + RA_AT + tokl * 144 + 64 * ks + 16 * q); fr[ks] = *(const LAS bf16x8*)(hbase + RA_RT + tokl * 144 + 64 * ks + 16 * q); }
          f32x4 aak[4], arkk[4], arb[4];
#pragma unroll
          for (int jt = 0; jt < 4; ++jt) {
              f32x4 tab = {0.f, 0.f, 0.f, 0.f}; aak[jt] = tab; arkk[jt] = tab; arb[jt] = tab;
              if (jt <= w4) {
#pragma unroll
                  for (int ks = 0; ks < 2; ++ks) { const bf16x8 fk = *(const LAS bf16x8*)(hbase + RA_KT + (16 * jt + n16) * 144 + 64 * ks + 16 * q), fb = *(const LAS bf16x8*)(hbase + RA_BT + (16 * jt + n16) * 144 + 64 * ks + 16 * q);
                      aak[jt] = MFMA16(fk, fa[ks], aak[jt]); tab = MFMA16(fb, fa[ks], tab); arkk[jt] = MFMA16(fk, fr[ks], arkk[jt]); arb[jt] = MFMA16(fb, fr[ks], arb[jt]); }
                  if (jt == w4) {
#pragma unroll
                      for (int i = 0; i < 4; ++i) { const int j = 4 * q + i; if (j >= n16) { aak[jt][i] = 0.f; tab[i] = 0.f; } if (j > n16) { arkk[jt][i] = 0.f; arb[jt][i] = 0.f; } } }
                  *(LAS f32x4*)(hbase + RA_AAB + tokl * 256 + (16 * jt + 4 * q) * 4) = tab;
              }
          }
#pragma unroll
          for (int s = 0; s < 2; ++s) { akp[s] = pack8(aak[2 * s], aak[2 * s + 1]); rkp[s] = pack8(arkk[2 * s], arkk[2 * s + 1]); rbp[s] = pack8(arb[2 * s], arb[2 * s + 1]); } }
        { f32x4 akv[4];
#pragma unroll
          for (int vt = 0; vt < 4; ++vt) { akv[vt] = (f32x4){0.f, 0.f, 0.f, 0.f};
#pragma unroll
              for (int s = 0; s < 2; ++s) { const bf16x8 fv = *(const LAS bf16x8*)(hbase + RA_VT + (16 * vt + n16) * 144 + 64 * s + 16 * q); akv[vt] = MFMA16(akp[s], fv, akv[vt]); } }
          __syncthreads();
#pragma unroll
          for (int vt = 0; vt < 4; ++vt) *(LAS f32x4*)(hbase + RA_RHS2 + (16 * vt + n16) * 272 + (16 * w4 + 4 * q) * 4) = akv[vt]; }
        if (pair + F.G < NITEM / 2) RA_REQUEST(pair + F.G);
        { const LAS unsigned char* aab = hbase + RA_AAB + (16 * w4) * 256 + (16 * w4) * 4;
          LAS unsigned char* ti = hbase + RA_BT;
          if (q == 0) { float t[16];
#pragma unroll
              for (int r_ = 0; r_ < 16; ++r_) { float acc = (r_ == n16) ? 1.0f : 0.0f;
#pragma unroll
                  for (int j4 = 0; j4 < (r_ + 3) / 4; ++j4) { const f32x4 av = *(const LAS f32x4*)(aab + r_ * 256 + j4 * 16);
#pragma unroll
                      for (int e = 0; e < 4; ++e) if (4 * j4 + e < r_) acc += av[e] * t[4 * j4 + e]; }
                  t[r_] = acc; *(LAS unsigned short*)(ti + w4 * 512 + r_ * 32 + 2 * n16) = (unsigned short)(pk2(acc, 0.f) & 0xffffu); } }
          __syncthreads();
          bf16x8 a10, a20, a30, a31, tf[4];
          { const LAS unsigned char* ab = hbase + RA_AAB + n16 * 256 + 16 * q; const f32x4 z4 = {0.f, 0.f, 0.f, 0.f};
            const f32x4 l10 = *(const LAS f32x4*)(ab + 16 * 256), l20 = *(const LAS f32x4*)(ab + 32 * 256), l21 = *(const LAS f32x4*)(ab + 32 * 256 + 64);
            const f32x4 l30 = *(const LAS f32x4*)(ab + 48 * 256), l31 = *(const LAS f32x4*)(ab + 48 * 256 + 64), l32 = *(const LAS f32x4*)(ab + 48 * 256 + 128);
            a10 = pack8(l10, z4); a20 = pack8(l20, l21); a30 = pack8(l30, l31); a31 = pack8(l32, z4);
#pragma unroll
            for (int I = 0; I < 4; ++I) { const v2u tw = *(const LAS v2u*)(ti + I * 512 + n16 * 32 + 8 * q); const v4u t4 = {tw.x, tw.y, 0u, 0u}; tf[I] = __builtin_bit_cast(bf16x8, t4); } }
          v4u xw[2][2];
#pragma unroll
          for (int m = 0; m < 2; ++m) {
              v4u x0 = {0u, 0u, 0u, 0u}, x1 = {0u, 0u, 0u, 0u};
#pragma unroll
              for (int I = 0; I < 4; ++I) {
                  f32x4 z;
                  if (m == 0) {
#pragma unroll
                      for (int i = 0; i < 4; ++i) z[i] = bf2f(*(const LAS unsigned short*)(hbase + RA_AT + (16 * I + 4 * q + i) * 144 + 2 * tokl)); }
                  else z = *(const LAS f32x4*)(hbase + RA_RHS2 + tokl * 272 + (16 * I + 4 * q) * 4);
                  if (I == 1) z = MFMA16(a10, __builtin_bit_cast(bf16x8, x0), z);
                  if (I == 2) z = MFMA16(a20, __builtin_bit_cast(bf16x8, x0), z);
                  if (I == 3) { z = MFMA16(a30, __builtin_bit_cast(bf16x8, x0), z); z = MFMA16(a31, __builtin_bit_cast(bf16x8, x1), z); }
                  const v4u zb = {pk2(z[0], z[1]), pk2(z[2], z[3]), 0u, 0u};
                  const f32x4 x = MFMA16(tf[I], __builtin_bit_cast(bf16x8, zb), ((f32x4){0.f, 0.f, 0.f, 0.f}));
                  const unsigned p0 = pk2(x[0], x[1]), p1 = pk2(x[2], x[3]);
                  if (I == 0) { x0.x = p0; x0.y = p1; } if (I == 1) { x0.z = p0; x0.w = p1; } if (I == 2) { x1.x = p0; x1.y = p1; } if (I == 3) { x1.z = p0; x1.w = p1; }
              }
              xw[m][0] = x0; xw[m][1] = x1;
          }
          __syncthreads();
#pragma unroll
          for (int s = 0; s < 2; ++s) { *(LAS v4u*)(hbase + RA_W1T + tokl * 144 + 64 * s + 16 * q) = xw[0][s]; *(LAS v4u*)(hbase + RA_W2T + tokl * 144 + 64 * s + 16 * q) = xw[1][s]; }
        }
        __syncthreads();
        {
          f32x4 pc[4], y0[4];
#pragma unroll
          for (int t = 0; t < 4; ++t) { pc[t] = (f32x4){bflo(rtp[t].x), bfhi(rtp[t].x), bflo(rtp[t].y), bfhi(rtp[t].y)}; y0[t] = (f32x4){0.f, 0.f, 0.f, 0.f};
#pragma unroll
              for (int s = 0; s < 2; ++s) { y0[t] = MFMA16(*(const LAS bf16x8*)(hbase + RA_VT + (16 * t + n16) * 144 + 64 * s + 16 * q), rkp[s], y0[t]);
                                            y0[t] = MFMA16(*(const LAS bf16x8*)(hbase + RA_W2T + (16 * t + n16) * 144 + 64 * s + 16 * q), rbp[s], y0[t]);
                                            pc[t] = MFMA16(*(const LAS bf16x8*)(hbase + RA_W1T + (16 * t + n16) * 144 + 64 * s + 16 * q), rbp[s], pc[t]); } }
#pragma unroll
          for (int vt = 0; vt < 4; ++vt) { v2u o; o.x = pk2(y0[vt][0], y0[vt][1]); o.y = pk2(y0[vt][2], y0[vt][3]); __builtin_nontemporal_store(o, (v2u*)(rbi + RB_YLT + ((w4 * 4 + vt) * 64 + l) * 8)); }
#pragma unroll
          for (int s = 0; s < 2; ++s) __builtin_nontemporal_store(pack8(pc[2 * s], pc[2 * s + 1]), (bf16x8*)(rbi + RB_PCT + ((w4 * 2 + s) * 64 + l) * 16));
          f32x4 mc[4]; bf16x8 fb[2], fvv[2];
#pragma unroll
          for (int s = 0; s < 2; ++s) { fb[s] = *(const LAS bf16x8*)(hbase + RA_BH + tokl * 144 + 64 * s + 16 * q); fvv[s] = *(const LAS bf16x8*)(hbase + RA_VT + tokl * 144 + 64 * s + 16 * q); }
          const float gend_k = *(const LAS float*)(hbase + RA_VT + tokl * 144 + 128);
#pragma unroll
          for (int t = 0; t < 4; ++t) { mc[t] = (f32x4){0.f, 0.f, 0.f, 0.f};
#pragma unroll
              for (int s = 0; s < 2; ++s) mc[t] = MFMA16(*(const LAS bf16x8*)(hbase + RA_W1T + (16 * t + n16) * 144 + 64 * s + 16 * q), fb[s], mc[t]);
              if (t == w4) {
#pragma unroll
                  for (int i = 0; i < 4; ++i) if (4 * q + i == n16) mc[t][i] += gend_k; } }
#pragma unroll
          for (int s = 0; s < 2; ++s) __builtin_nontemporal_store(pack8(mc[2 * s], mc[2 * s + 1]), (bf16x8*)(rbi + RB_MC + ((w4 * 2 + s) * 64 + l) * 16));
          bf16x8 fw2[2];
#pragma unroll
          for (int s = 0; s < 2; ++s) fw2[s] = *(const LAS bf16x8*)(hbase + RA_W2T + tokl * 144 + 64 * s + 16 * q);
#pragma unroll
          for (int kt = 0; kt < 4; ++kt) { f32x4 cc = {0.f, 0.f, 0.f, 0.f};
#pragma unroll
              for (int s = 0; s < 2; ++s) { cc = MFMA16(*(const LAS bf16x8*)(hbase + RA_KH + (16 * kt + n16) * 144 + 64 * s + 16 * q), fvv[s], cc);
                                            cc = MFMA16(*(const LAS bf16x8*)(hbase + RA_BH + (16 * kt + n16) * 144 + 64 * s + 16 * q), fw2[s], cc); }
              v2u cw; cw.x = pk2(cc[0], cc[1]); cw.y = pk2(cc[2], cc[3]); __builtin_nontemporal_store(cw, (v2u*)(rbi + RB_CC + ((w4 * 4 + kt) * 64 + l) * 8)); } }
    }
}

constexpr int RBK_NS = 9, RBK_D = 8, RBK_SLOT = 16384, RBK_BLOCKS = 32;
static_assert(RBK_NS * RBK_SLOT <= MISC_OFF && RBK_D == RBK_NS - 1, "phase B ring");
DI void rwkv_phase_b(const Frame& F, const Args& a) {
    if (F.bid >= RBK_BLOCKS) return;
    unsigned char* rb = a.ws + WS_RW; const int l = F.lane, w = F.wave;
    const int h = F.bid & 7, b = F.bid >> 3;
    LAS unsigned char* lds = F.lds;
    if (w >= 4) {
        const int j = w - 4;
#define RBK_ISSUE(cc_) do { const int c_ = (cc_) < NCHUNK ? (cc_) : NCHUNK - 1; const unsigned char* r_ = rb + (size_t)(((b * 128 + c_) << 3) + h) * RB_REC; \
            LAS unsigned char* slot_ = lds + ((cc_) % RBK_NS) * RBK_SLOT; \
            _Pragma("unroll") for (int k_ = 0; k_ < 4; ++k_) { const int blk_ = 4 * j + k_; \
                const unsigned char* src_ = blk_ < 8 ? r_ + RB_MC + blk_ * 1024 : r_ + RB_CC + (blk_ - 8) * 1024; \
                __builtin_amdgcn_global_load_lds((const unsigned*)(src_ + l * 16), (LAS unsigned*)(slot_ + blk_ * 1024), 16, 0, 0); } } while (0)
        for (int c = 0; c < RBK_D; ++c) RBK_ISSUE(c);
        for (int c = 0; c < NCHUNK; ++c) {
            asm volatile("s_waitcnt vmcnt(28)" ::: "memory");
            __builtin_amdgcn_s_barrier();
            RBK_ISSUE(c + RBK_D);
        }
        asm volatile("s_waitcnt vmcnt(0)" ::: "memory");
        __builtin_amdgcn_s_barrier();
#undef RBK_ISSUE
    } else {
        const int vs = w;
        f32x4 st[4];
#pragma unroll
        for (int kt = 0; kt < 4; ++kt) st[kt] = (f32x4){0.f, 0.f, 0.f, 0.f};
        for (int c = 0; c < NCHUNK; ++c) {
            unsigned char* rbi = rb + (size_t)(((b * 128 + c) << 3) + h) * RB_REC;
            bf16x8 sb[2];
#pragma unroll
            for (int s = 0; s < 2; ++s) { sb[s] = pack8(st[2 * s], st[2 * s + 1]); *(bf16x8*)(rbi + RB_SC + ((vs * 2 + s) * 64 + l) * 16) = sb[s]; }
            __builtin_amdgcn_s_barrier();
            const LAS unsigned char* slot = lds + (c % RBK_NS) * RBK_SLOT;
#pragma unroll
            for (int kt = 0; kt < 4; ++kt) { const v2u cw = *(const LAS v2u*)(slot + 8192 + ((vs * 4 + kt) * 64 + l) * 8);
                f32x4 n = {bflo(cw.x), bfhi(cw.x), bflo(cw.y), bfhi(cw.y)};
#pragma unroll
                for (int s = 0; s < 2; ++s) n = MFMA16(*(const LAS bf16x8*)(slot + ((kt * 2 + s) * 64 + l) * 16), sb[s], n);
                st[kt] = n; }
        }
        __builtin_amdgcn_s_barrier();
    }
}

struct RcOps { bf16x8 pc[2]; v2u yl[4]; bf16x8 sc[4][2]; v2u g1[4], e2[4]; };
DI void rc_load(RcOps& o, const unsigned char* rb, int task, int l) {
    const int item = task >> 2, it = task & 3; const unsigned char* rbi = rb + (size_t)item * RB_REC;
#pragma unroll
    for (int s = 0; s < 2; ++s) o.pc[s] = __builtin_nontemporal_load((const bf16x8*)(rbi + RB_PCT + ((it * 2 + s) * 64 + l) * 16));
#pragma unroll
    for (int vt = 0; vt < 4; ++vt) { const int fo = ((it * 4 + vt) * 64 + l) * 8;
        o.yl[vt] = __builtin_nontemporal_load((const v2u*)(rbi + RB_YLT + fo)); o.g1[vt] = __builtin_nontemporal_load((const v2u*)(rbi + RB_G1T + fo)); o.e2[vt] = __builtin_nontemporal_load((const v2u*)(rbi + RB_E2T + fo));
#pragma unroll
        for (int s = 0; s < 2; ++s) o.sc[vt][s] = __builtin_nontemporal_load((const bf16x8*)(rbi + RB_SC + ((vt * 2 + s) * 64 + l) * 16)); }
}
DI void rwkv_phase_c(const Frame& F, const Args& a) {
    const unsigned char* rb = a.ws + WS_RW; bf16* mix = (bf16*)(a.ws + WS_MIX);
    const int l = F.lane, n16 = l & 15, q = l >> 4;
    const int gw = F.bid * NWAVES + F.wave, NGW = F.G * NWAVES;
    RcOps cur, nxt;
    if (gw < NITEM * 4) rc_load(cur, rb, gw, l);
    for (int task = gw; task < NITEM * 4; task += NGW) {
        const int item = task >> 2, it = task & 3, h = item & 7, c = (item >> 3) & 127, b = item >> 10;
        if (task + NGW < NITEM * 4) rc_load(nxt, rb, task + NGW, l);
        f32x4 y[4]; float sum = 0.f;
#pragma unroll
        for (int vt = 0; vt < 4; ++vt) { y[vt] = (f32x4){bflo(cur.yl[vt].x), bfhi(cur.yl[vt].x), bflo(cur.yl[vt].y), bfhi(cur.yl[vt].y)};
#pragma unroll
            for (int s = 0; s < 2; ++s) y[vt] = MFMA16(cur.sc[vt][s], cur.pc[s], y[vt]);
            sum += (y[vt][0] + y[vt][1]) + (y[vt][2] + y[vt][3]); }
        sum = quad_sum(sum);
        const float mean = sum * (1.f / 64.f); float sq = 0.f;
#pragma unroll
        for (int vt = 0; vt < 4; ++vt) { y[vt] = y[vt] - mean; sq += (y[vt][0] * y[vt][0] + y[vt][1] * y[vt][1]) + (y[vt][2] * y[vt][2] + y[vt][3] * y[vt][3]); }
        sq = quad_sum(sq);
        const float rstd = 1.0f / sqrtf(sq * (1.f / 64.f) + 64e-5f);
        const size_t tok = (size_t)b * SEQ + c * 64 + 16 * it + n16;
#pragma unroll
        for (int vt = 0; vt < 4; ++vt) { const v2u g = cur.g1[vt], e = cur.e2[vt];
            v2u o; o.x = pk2(y[vt][0] * rstd * bflo(g.x) + bflo(e.x), y[vt][1] * rstd * bfhi(g.x) + bfhi(e.x)); o.y = pk2(y[vt][2] * rstd * bflo(g.y) + bflo(e.y), y[vt][3] * rstd * bfhi(g.y) + bfhi(e.y));
            *(v2u*)(mix + tok * 1024 + 512 + h * 64 + 16 * vt + 4 * q) = o; }
        cur = nxt;
    }
}
#endif

DI void p0_prologue(const Frame& F, const Args& a) {
    unsigned char* ws = a.ws;
    LAS float* scr = (LAS float*)(F.lds + F.wave * 16384);
    const int gw = F.bid * NWAVES + F.wave, NGW = F.G * NWAVES;
    constexpr int I_IN = 16 * 104, I_OUT = 16 * 32, I_DEC = 16, I_AAA = 16, I_GATE = 32;
    constexpr int NITEMS = I_IN + I_OUT + I_DEC + I_AAA + I_GATE;
    for (int it = gw; it < NITEMS; it += NGW) {
        int r = it;
        if (r < I_IN) { const int kb = r / 104, nb = r % 104; tr_item(a.in[I_WIN], INC, 64 * kb, 32 * nb, (bf16*)(ws + WS_WIN), 1024, 32 * nb, scr, F.lane, nullptr); continue; } r -= I_IN;
        if (r < I_OUT) { const int kb = r / 32, nb = r % 32; tr_item(a.in[I_WOUT], 1024, 64 * kb, 32 * nb, (bf16*)(ws + WS_WOUT), 1024, 32 * nb, scr, F.lane, nullptr); continue; } r -= I_OUT;
        if (r < I_DEC) { tr_item(a.in[I_WDEC], 512, 0, 32 * r, (bf16*)(ws + WS_WDEC), 64, 32 * r, scr, F.lane, nullptr); continue; } r -= I_DEC;
        if (r < I_AAA) { tr_item(a.in[I_WAAA], 512, 0, 32 * r, (bf16*)(ws + WS_WAAA), 64, 32 * r, scr, F.lane, nullptr); continue; } r -= I_AAA;
        { const int kb = r / 16, nb = r % 16; tr_item(a.in[I_WGATE], 512, 64 * kb, 32 * nb, (bf16*)(ws + WS_WGATE), 128, 32 * nb, scr, F.lane, nullptr); }
    }
    { float* wrt = (float*)(ws + WS_WRT); const float* wr = a.in[I_WR]; const float* g2 = a.in[I_N2G];
      for (int i = F.bid * 512 + F.tid; i < 32 * 1024; i += F.G * 512) { const int e = i >> 10, k = i & 1023; wrt[i] = g2[k] * wr[k * 32 + e]; } }
    { float* par = (float*)(ws + WS_PAR); const int srcs[7] = {I_W0, I_A0, I_KK, I_KA, I_RK, I_LNG, I_LNB};
      for (int i = F.bid * 512 + F.tid; i < 7 * 512; i += F.G * 512) { const int k = i >> 9; float v = 0.f;
#pragma unroll
          for (int j = 0; j < 7; ++j) if (k == j) v = a.in[srcs[j]][i & 511];
          par[i] = v; } }
    { const float* x = a.in[I_X]; const float* g1 = a.in[I_N1G]; bf16* xn = (bf16*)(ws + WS_XN);
      f32x4 gv[4];
#pragma unroll
      for (int j = 0; j < 4; ++j) gv[j] = *((const f32x4*)g1 + F.lane + 64 * j);
      for (int m0 = 2 * gw; m0 < T; m0 += 2 * NGW) {
          f32x4 v[2][4];
#pragma unroll
          for (int r = 0; r < 2; ++r) { const f32x4* xr = (const f32x4*)(x + (size_t)(m0 + r) * D) + F.lane;
#pragma unroll
              for (int j = 0; j < 4; ++j) v[r][j] = __builtin_nontemporal_load(xr + 64 * j); }
#pragma unroll
          for (int r = 0; r < 2; ++r) { float s = 0.f;
#pragma unroll
              for (int j = 0; j < 4; ++j) s += (v[r][j].x * v[r][j].x + v[r][j].y * v[r][j].y) + (v[r][j].z * v[r][j].z + v[r][j].w * v[r][j].w);
              const float rs = 1.0f / sqrtf(wave_sum(s) * (1.f / D) + 1e-6f);
              v2u* o8 = (v2u*)(xn + (size_t)(m0 + r) * D) + F.lane;
#pragma unroll
              for (int j = 0; j < 4; ++j) { v2u o; o.x = pk2(v[r][j].x * rs * gv[j].x, v[r][j].y * rs * gv[j].y); o.y = pk2(v[r][j].z * rs * gv[j].z, v[r][j].w * rs * gv[j].w); o8[64 * j] = o; } }
      } }
}

#if NAIVE_RWKV
DI void rwkv_naive_prep(const Frame& F, const Args& a) {
    const bf16* proj = (const bf16*)(a.ws + WS_PROJ); LAS float* sx = (LAS float*)F.lds;
    float* RW = (float*)(a.ws + WS_RW); float* GG = (float*)(a.ws + WS_XN);
    const float* mu = a.in[I_MU]; const int c = F.tid;
    for (int t = F.bid; t < T; t += F.G) {
        const bool first = (t % SEQ) == 0; const bf16* cur = proj + (size_t)t * INC + PRW; const bf16* prv = cur - INC;
#define SH_(col) ({ const float x_ = bf2f(cur[col]); const float p_ = first ? 0.f : bf2f(prv[col]); x_ + (p_ - x_) * mu[col]; })
        if (c < 256) { const float v = SH_(1536 + c); sx[c] = c < 64 ? tanhf(v) : (c < 128 ? v : sigmoidf_(v)); }
        __syncthreads();
        const float r = SH_(c), k = SH_(512 + c), v = SH_(1024 + c);
#undef SH_
        float wl = a.in[I_W0][c], al = a.in[I_A0][c], g = 0.f;
        const float* wdec = a.in[I_WDEC] + c; const float* waaa = a.in[I_WAAA] + c; const float* wgate = a.in[I_WGATE] + c;
#pragma unroll 4
        for (int j = 0; j < 64; ++j) { wl += sx[j] * wdec[j * 512]; al += sx[64 + j] * waaa[j * 512]; }
#pragma unroll 4
        for (int j = 0; j < 128; ++j) g += sx[128 + j] * wgate[j * 512];
        const float dec = __expf(-0.6065306597126334f * sigmoidf_(wl)), av = sigmoidf_(al);
        float kk = k * a.in[I_KK][c]; const float n2 = wave_sum(kk * kk); kk = kk / fmaxf(sqrtf(n2), 1e-12f);
        const float k2 = k * (1.0f + (av - 1.0f) * a.in[I_KA][c]);
        const size_t o = (size_t)t * 512 + c; const size_t S1 = (size_t)T * 512;
        RW[o] = r; RW[S1 + o] = dec; RW[2 * S1 + o] = k2; RW[3 * S1 + o] = v; RW[4 * S1 + o] = kk; RW[5 * S1 + o] = av; GG[o] = g;
        __syncthreads();
    }
}
DI void rwkv_naive_scan(const Frame& F, const Args& a) {
    if (F.bid >= 32 || F.wave != 0) return;
    const int b = F.bid >> 3, h = F.bid & 7, l = F.lane, c = h * 64 + l;
    const float* RW = (const float*)(a.ws + WS_RW); const float* GG = (const float*)(a.ws + WS_XN); bf16* mix = (bf16*)(a.ws + WS_MIX);
    const size_t S1 = (size_t)T * 512; LAS float* sh = (LAS float*)F.lds;
    LAS float* st = sh + 512 + l;
    for (int k = 0; k < 64; ++k) st[64 * k] = 0.f;
    const float rk = a.in[I_RK][c], lg = a.in[I_LNG][c], lb = a.in[I_LNB][c];
    for (int s = 0; s < SEQ; ++s) {
        const size_t o = (size_t)(b * SEQ + s) * 512 + c;
        const float r = RW[o], w = RW[S1 + o], k2 = RW[2 * S1 + o], v = RW[3 * S1 + o], kk = RW[4 * S1 + o], av = RW[5 * S1 + o], g = GG[o];
        sh[l] = r; sh[64 + l] = w; sh[128 + l] = k2; sh[192 + l] = kk; sh[256 + l] = kk * av;
        LDS_WAIT();
        float sa = 0.f;
#pragma unroll 8
        for (int k = 0; k < 64; ++k) sa -= st[64 * k] * sh[192 + k];
        float y = 0.f;
#pragma unroll 8
        for (int k = 0; k < 64; ++k) { const float nv = st[64 * k] * sh[64 + k] + sa * sh[256 + k] + v * sh[128 + k]; st[64 * k] = nv; y += nv * sh[k]; }
        LDS_WAIT();
        const float mean = wave_sum(y) * (1.f / 64.f); const float d = y - mean; const float var = wave_sum(d * d) * (1.f / 64.f);
        const float yn = d * (1.0f / sqrtf(var + 64e-5f));
        const float bonus = wave_sum(r * k2 * rk) * v;
        const float outv = (yn * lg + lb + bonus) * g;
        mix[(size_t)(b * SEQ + s) * 1024 + 512 + c] = (bf16)(pk2(outv, 0.f) & 0xffffu);
    }
}
#endif
#if NAIVE_ATT
DI void attn_naive(const Frame& F, const Args& a) {
    const bf16* proj = (const bf16*)(a.ws + WS_PROJ); bf16* mix = (bf16*)(a.ws + WS_MIX);
    LAS float* sq = (LAS float*)(F.lds + F.wave * 1024);
    const int gw = F.bid * NWAVES + F.wave, NGW = F.G * NWAVES, l = F.lane;
    const float qg = a.in[I_QG][l];
    for (int it = gw; it < T * 8; it += NGW) {
        const int t = it >> 3, h = it & 7, b = t / SEQ, s = t % SEQ, n = s >> 6;
        const float qd = bf2f(proj[(size_t)t * INC + h * 64 + l]);
        const float qn = qd * (1.0f / sqrtf(wave_sum(qd * qd) * (1.f / 64.f) + 1e-6f)) * qg * 0.125f;
        sq[l] = qn; LDS_WAIT();
        float sc[9]; float mx = -3.0e38f;
#pragma unroll
        for (int r = 0; r < 9; ++r) {
            const int kp = (n - 8) * 64 + 64 * r + l; float v = -3.0e38f;
            if (kp >= 0) {
                const v4u* kr = (const v4u*)(proj + (size_t)(b * SEQ + kp) * INC + 512 + h * 64);
                float ss = 0.f, dot = 0.f;
#pragma unroll
                for (int j = 0; j < 8; ++j) { const v4u w = kr[j]; const unsigned ww[4] = {w.x, w.y, w.z, w.w};
#pragma unroll
                    for (int e = 0; e < 4; ++e) { const float k0 = bflo(ww[e]), k1 = bfhi(ww[e]); const int d0 = 8 * j + 2 * e;
                        ss += k0 * k0 + k1 * k1; dot += sq[d0] * a.in[I_KG][d0] * k0 + sq[d0 + 1] * a.in[I_KG][d0 + 1] * k1; } }
                int rel = kp - s; rel = rel < -128 ? -128 : (rel > 63 ? 63 : rel);
                v = dot * (1.0f / sqrtf(ss * (1.f / 64.f) + 1e-6f)) + a.in[I_RELB][h * 192 + rel + 128];
            }
            sc[r] = v; mx = fmaxf(mx, v);
        }
        mx = wave_max(mx); float sum = 0.f;
#pragma unroll
        for (int r = 0; r < 9; ++r) { sc[r] = (sc[r] > -1.0e38f) ? __expf(sc[r] - mx) : 0.f; sum += sc[r]; }
        sum = wave_sum(sum);
        float o = 0.f;
#pragma unroll
        for (int r = 0; r < 9; ++r) {
            const int kp0 = (n - 8) * 64 + 64 * r;
            if (kp0 >= 0) {
                const bf16* vp = proj + (size_t)(b * SEQ + kp0) * INC + 1024 + h * 64 + l;
                for (int key = 0; key < 64; ++key) o += __shfl(sc[r], key) * bf2f(vp[(size_t)key * INC]);
            }
        }
        mix[(size_t)t * 1024 + h * 64 + l] = (bf16)(pk2(o / sum, 0.f) & 0xffffu);
        LDS_WAIT();
    }
}
#endif

DI void p6_router(const Frame& F, const Args& a) {
    unsigned char* ws = a.ws; const bf16* x1 = (const bf16*)(ws + WS_XN); const float* wrt = (const float*)(ws + WS_WRT); const float* br = a.in[I_BR];
    int* eidx = (int*)(ws + WS_EIDX); float* gate = (float*)(ws + WS_GATE); int* lrank = (int*)(ws + WS_LRANK); float* rstd = (float*)(ws + WS_RSTD); int* cnt = (int*)(ws + WS_CNT);
    constexpr int WROW = 2064, WIMG = 32 * WROW;
    LAS int* hist = (LAS int*)(F.lds + 2 * WIMG);
    const int n = F.lane & 15, q = F.lane >> 4;
    for (int i = F.tid; i < 32 * 256; i += NWAVES * 64) { const int e = i >> 8, c4 = i & 255; const f32x4 w = *((const f32x4*)(wrt + (size_t)e * D) + c4);
        v2u hi, lo; hi.x = pk2(w[0], w[1]); hi.y = pk2(w[2], w[3]);
        lo.x = pk2(w[0] - bflo(hi.x), w[1] - bfhi(hi.x)); lo.y = pk2(w[2] - bflo(hi.y), w[3] - bfhi(hi.y));
        *(LAS v2u*)(F.lds + e * WROW + c4 * 8) = hi; *(LAS v2u*)(F.lds + WIMG + e * WROW + c4 * 8) = lo; }
    __syncthreads();
    for (int tile = F.bid; tile < T / 128; tile += F.G) {
        if (F.tid < 32) hist[F.tid] = 0;
        __syncthreads();
        const int tok = tile * 128 + F.wave * 16 + n;
        const v4u* xr = (const v4u*)(x1 + (size_t)tok * D) + q; const LAS unsigned char* w0 = F.lds + n * WROW + 16 * q;
        f32x4 acc0 = {0.f, 0.f, 0.f, 0.f}, acc1 = {0.f, 0.f, 0.f, 0.f}; float ssq = 0.f, amax = 0.f;
        for (int S0 = 0; S0 < 32; S0 += 16) {
            v4u xw[16];
#pragma unroll
            for (int s = 0; s < 16; ++s) xw[s] = xr[4 * (S0 + s)];
#pragma unroll
            for (int s = 0; s < 16; ++s) { const bf16x8 xb8 = __builtin_bit_cast(bf16x8, xw[s]); const LAS unsigned char* wp = w0 + (S0 + s) * 64;
                const unsigned u[4] = {xw[s].x, xw[s].y, xw[s].z, xw[s].w};
#pragma unroll
                for (int j = 0; j < 4; ++j) { const float a = bflo(u[j]), b = bfhi(u[j]); ssq += a * a + b * b; amax = fmaxf(amax, fmaxf(fabsf(a), fabsf(b))); }
                acc0 = __builtin_amdgcn_mfma_f32_16x16x32_bf16(*(const LAS bf16x8*)(wp), xb8, acc0, 0, 0, 0);
                acc0 = __builtin_amdgcn_mfma_f32_16x16x32_bf16(*(const LAS bf16x8*)(wp + WIMG), xb8, acc0, 0, 0, 0);
                acc1 = __builtin_amdgcn_mfma_f32_16x16x32_bf16(*(const LAS bf16x8*)(wp + 16 * WROW), xb8, acc1, 0, 0, 0);
                acc1 = __builtin_amdgcn_mfma_f32_16x16x32_bf16(*(const LAS bf16x8*)(wp + WIMG + 16 * WROW), xb8, acc1, 0, 0, 0); }
        }
        ssq = quad_sum(ssq); amax = quad_max(amax);
        const float rs = 1.0f / sqrtf(ssq * (1.f / D) + 1e-6f);
        float lg[8];
#pragma unroll
        for (int i = 0; i < 4; ++i) { lg[i] = acc0[i] * rs + br[4 * q + i]; lg[4 + i] = acc1[i] * rs + br[16 + 4 * q + i]; }
        float tv[4]; int ti[4];
#pragma unroll
        for (int r = 0; r < 4; ++r) {
            float bv = -3.0e38f; int bi = 0;
#pragma unroll
            for (int j = 0; j < 8; ++j) { const int e = (j < 4 ? 0 : 16) + 4 * q + (j & 3); if (lg[j] > bv) { bv = lg[j]; bi = e; } }
#pragma unroll
            for (int o = 16; o <= 32; o <<= 1) { const float ov = __shfl_xor(bv, o); const int oi = __shfl_xor(bi, o); if (ov > bv || (ov == bv && oi < bi)) { bv = ov; bi = oi; } }
            tv[r] = bv; ti[r] = bi;
#pragma unroll
            for (int j = 0; j < 8; ++j) { const int e = (j < 4 ? 0 : 16) + 4 * q + (j & 3); if (e == bi) lg[j] = -3.0e38f; }
        }
        if (q == 0) {
            const float e1 = __expf(tv[1] - tv[0]), e2 = __expf(tv[2] - tv[0]), e3 = __expf(tv[3] - tv[0]); const float inv = 1.0f / (1.0f + e1 + e2 + e3);
            int lr[4];
#pragma unroll
            for (int r = 0; r < 4; ++r) lr[r] = atomicAdd((int*)&hist[ti[r]], 1);
            *(int4*)(eidx + (size_t)tok * 4) = make_int4(ti[0], ti[1], ti[2], ti[3]);
            *(float4*)(gate + (size_t)tok * 4) = make_float4(inv, e1 * inv, e2 * inv, e3 * inv);
            *(int4*)(lrank + (size_t)tok * 4) = make_int4(lr[0], lr[1], lr[2], lr[3]);
            rstd[tok] = rs * amax * (1.0f / 127.0f);
        }
        { const float qinv = amax > 0.f ? 127.0f / amax : 0.f; unsigned char* xq = ws + WS_XQ;
            for (int i0 = 0; i0 < 16; i0 += 4) { v4u xa[4], xb2[4];
#pragma unroll
                for (int i = 0; i < 4; ++i) { const v4u* p = (const v4u*)(x1 + (size_t)(tile * 128 + F.wave * 16 + i0 + i) * D) + 2 * F.lane; xa[i] = p[0]; xb2[i] = p[1]; }
#pragma unroll
                for (int i = 0; i < 4; ++i) { const float sc = __builtin_bit_cast(float, __builtin_amdgcn_readlane(__builtin_bit_cast(int, qinv), i0 + i));
                    const unsigned u[8] = {xa[i].x, xa[i].y, xa[i].z, xa[i].w, xb2[i].x, xb2[i].y, xb2[i].z, xb2[i].w}; v4u o;
#pragma unroll
                    for (int d = 0; d < 4; ++d) { const f32x2 lo = {bflo(u[2 * d]), bfhi(u[2 * d])}, hi = {bflo(u[2 * d + 1]), bfhi(u[2 * d + 1])};
                        const f32x2 ql = lo * sc + Q_MAGIC, qh = hi * sc + Q_MAGIC; o[d] = q_pack4(ql.x, ql.y, qh.x, qh.y); }
                    *((v4u*)(xq + (size_t)(tile * 128 + F.wave * 16 + i0 + i) * D) + F.lane) = o; } }
        }
        __syncthreads();
        if (F.tid < 32) cnt[tile * 32 + F.tid] = hist[F.tid];
        __syncthreads();
    }
}

DI void p7_permute(const Frame& F, const Args& a) {
    unsigned char* ws = a.ws; const int* cnt = (const int*)(ws + WS_CNT); int* meta = (int*)(ws + WS_META);
    const int* eidx = (const int*)(ws + WS_EIDX); const int* lrank = (const int*)(ws + WS_LRANK); int* inv = (int*)(ws + WS_INV);
    const float* rstd = (const float*)(ws + WS_RSTD); float* rowrstd = (float*)(ws + WS_ROWRSTD);
    bf16* xb = (bf16*)(ws + WS_XN); int* rowtok = (int*)(ws + WS_ROWTOK);
    LAS int* s_tot = (LAS int*)F.lds; LAS int* s_pst = s_tot + 32; LAS int* s_base = s_tot + 64; LAS int* s_part = s_tot + 128;
    { const int e = F.tid & 31, part = F.tid >> 5; int s = 0; for (int t = part * 16; t < part * 16 + 16; ++t) s += cnt[t * 32 + e]; s_part[part * 32 + e] = s; }
    __syncthreads();
    if (F.tid < 32) { int s = 0; for (int p = 0; p < 16; ++p) s += s_part[p * 32 + F.tid]; s_tot[F.tid] = s; }
    __syncthreads();
    if (F.tid < 32) { int ps = 0; for (int e = 0; e < F.tid; ++e) ps += (s_tot[e] + 255) / 256 * 256; s_pst[F.tid] = ps; }
    __syncthreads();
    if (F.bid == 0 && F.tid < 32) { const int e = F.tid, nb = (s_tot[e] + 255) / 256, rb0 = s_pst[e] / 256; for (int i = 0; i < nb; ++i) meta[16 + rb0 + i] = e; if (e == 31) meta[0] = rb0 + nb; }
    if (F.bid < 32) { const int e = F.bid, r0 = s_pst[e] + s_tot[e], r1 = s_pst[e] + (s_tot[e] + 255) / 256 * 256;
        for (int r = r0 + F.tid; r < r1; r += NWAVES * 64) { rowtok[r] = T; rowrstd[r] = 0.f; } }
    if (F.bid == 0 && F.tid < 64) { const v4u z = {0u, 0u, 0u, 0u}; *((v4u*)(ws + WS_XQ + (size_t)T * D) + F.tid) = z; }
    for (int tile = F.bid; tile < T / 128; tile += F.G) {
        __syncthreads();
        if (F.tid < 32) { int s = 0; for (int t = 0; t < tile; ++t) s += cnt[t * 32 + F.tid]; s_base[F.tid] = s_pst[F.tid] + s; }
        __syncthreads();
        { const int i = F.tid;
            const int tok = tile * 128 + (i >> 2), k = i & 3; const int e = eidx[tok * 4 + k]; const int dest = s_base[e] + lrank[tok * 4 + k];
            inv[tok * 4 + k] = dest; rowtok[dest] = tok; rowrstd[dest] = rstd[tok];
        }
    }
}

DI void p10_combine(const Frame& F, const Args& a) {
    unsigned char* ws = a.ws; const int* inv = (const int*)(ws + WS_INV); const float* gate = (const float*)(ws + WS_GATE); const bf16* yr = (const bf16*)(ws + WS_YR); const bf16* xb = (const bf16*)(ws + WS_XN); float* out = a.out;
    const int gw = F.bid * NWAVES + F.wave, NGW = F.G * NWAVES;
    for (int t = gw; t < T; t += NGW) {
        const int4 iv = *(const int4*)(inv + (size_t)t * 4); const float4 gv = *(const float4*)(gate + (size_t)t * 4);
        const int rows[4] = {iv.x, iv.y, iv.z, iv.w}; const float gs[4] = {gv.x, gv.y, gv.z, gv.w};
        f32x4* o = (f32x4*)(out + (size_t)t * D) + F.lane; const v2u* xr = (const v2u*)(xb + (size_t)t * D) + F.lane;
#pragma unroll
        for (int j = 0; j < 4; ++j) {
            const v2u xw = xr[64 * j]; f32x4 acc = {bflo(xw.x), bfhi(xw.x), bflo(xw.y), bfhi(xw.y)};
#pragma unroll
            for (int k = 0; k < 4; ++k) { const v2u w = __builtin_nontemporal_load((const v2u*)(yr + (size_t)rows[k] * D) + F.lane + 64 * j);
                acc.x += gs[k] * bflo(w.x); acc.y += gs[k] * bfhi(w.x); acc.z += gs[k] * bflo(w.y); acc.w += gs[k] * bfhi(w.y); }
            __builtin_nontemporal_store(acc, o + 64 * j);
        }
    }
}

constexpr int N_PHASES = 11;
__global__ void __launch_bounds__(NWAVES * 64, 2) fwd(Args args) {
    extern __shared__ __attribute__((aligned(16))) unsigned char lds[];
    Frame F;
    F.lds = (LAS unsigned char*)lds;
    F.tid = threadIdx.x; F.lane = F.tid & 63; F.wave = __builtin_amdgcn_readfirstlane(F.tid >> 6);
    F.G = gridDim.x; F.bid = blockIdx.x;
    volatile LAS unsigned* MISC = (volatile LAS unsigned*)(F.lds + MISC_OFF);
    if (F.tid < 64) MISC[F.tid] = 0u;
    __syncthreads();
    unsigned char* ws = args.ws;
    unsigned* ctl = (unsigned*)(ws + WS_CTL);
    XcdBarrier bar; bar.bar = ctl + CW_BAR; bar.x = 0; bar.st = nullptr;
    if (MK_N_LAUNCHES == 1) bar = xcd_barrier_post(ctl + CW_BAR, MISC + 8);
    const int lo = args.ph_lo, hi = args.ph_hi;
#ifndef PHASE_MASK
#define PHASE_MASK 0xffff
#endif
#define IN(k) (((PHASE_MASK >> (k)) & 1) && lo <= (k) && (k) < hi)
#ifndef DUP_PHASE
#define DUP_PHASE -1
#endif
#define REPS(k) ((DUP_PHASE >= 0 && (k) == DUP_PHASE) ? args.ph_rep : 1)
#define SEAM(k) do { if (IN(k) && IN((k) + 1)) xcd_barrier(bar); { int t_ = threadIdx.x; asm volatile("" : "+v"(t_)); F.tid = t_; F.lane = t_ & 63; } } while (0)

    for (int rep_ = 0; rep_ < REPS(0); ++rep_) { if (rep_) xcd_barrier(bar);
    if (IN(0)) { p0_prologue(F, args); } } SEAM(0);

    for (int rep_ = 0; rep_ < REPS(1); ++rep_) { if (rep_) xcd_barrier(bar);
    if (IN(1)) {
        pg8::Gemm g{(const bf16*)(ws + WS_XN), (const bf16*)(ws + WS_WIN), T, INC, D}; pg8::StaticOrder S; S.init(T, INC, F.G, F.bid);
        pg8::EpiBf16 E{(bf16*)(ws + WS_PROJ), INC};
        pg8::gemm_phase<pg8::EpiBf16, pg8::StaticOrder, true, true>(F.lds, g, S, E);
    } } SEAM(1);

    for (int rep_ = 0; rep_ < REPS(2); ++rep_) { if (rep_) xcd_barrier(bar);
    if (IN(2)) {
#if NAIVE_RWKV
        rwkv_naive_prep(F, args);
#else
        rwkv_phase_a(F, args);
#endif
    } } SEAM(2);

    for (int rep_ = 0; rep_ < REPS(3); ++rep_) { if (rep_) xcd_barrier(bar);
    if (IN(3)) {
#if NAIVE_RWKV
        rwkv_naive_scan(F, args);
#else
        rwkv_phase_b(F, args);
#endif
        __syncthreads();
#if NAIVE_ATT
        attn_naive(F, args);
#else
        attn_phase(F, args, rep_);
#endif
    } } SEAM(3);

    for (int rep_ = 0; rep_ < REPS(4); ++rep_) { if (rep_) xcd_barrier(bar);
    if (IN(4)) {
#if !NAIVE_RWKV
        rwkv_phase_c(F, args);
#endif
    } } SEAM(4);

    for (int rep_ = 0; rep_ < REPS(5); ++rep_) { if (rep_) xcd_barrier(bar);
    if (IN(5)) {
        pg8::Gemm g{(const bf16*)(ws + WS_MIX), (const bf16*)(ws + WS_WOUT), T, D, D}; pg8::StaticOrder S; S.init(T, D, F.G, F.bid);
        pg8::EpiResid E{args.in[I_X], nullptr, (bf16*)(ws + WS_XN), D};
        pg8::gemm_phase<pg8::EpiResid, pg8::StaticOrder, true, true>(F.lds, g, S, E);
    } } SEAM(5);

    for (int rep_ = 0; rep_ < REPS(6); ++rep_) { if (rep_) xcd_barrier(bar);
    if (IN(6)) { p6_router(F, args); } } SEAM(6);
    for (int rep_ = 0; rep_ < REPS(7); ++rep_) { if (rep_) xcd_barrier(bar);
    if (IN(7)) { p7_permute(F, args); } } SEAM(7);

    for (int rep_ = 0; rep_ < REPS(8); ++rep_) { if (rep_) xcd_barrier(bar);
    if (IN(8)) {
        pg8::Gemm g{(const bf16*)(ws + WS_XQ), (const bf16*)(ws + WS_WUP), NROWS_MAX, 2048, D / 2};
        pg8::MoeOrder<true> S{(const int*)(ws + WS_META), 8, F.G, F.bid, (const int*)(ws + WS_ROWTOK)};
        pg8::EpiSwiGLU E{(bf16*)(ws + WS_ACT), args.in[I_BUP], (const float*)(ws + WS_ROWRSTD), (const float*)(ws + WS_COLSC)};
        pg8::gemm_phase<pg8::EpiSwiGLU, pg8::MoeOrder<true>, true, true>(F.lds, g, S, E);
    } } SEAM(8);

    for (int rep_ = 0; rep_ < REPS(9); ++rep_) { if (rep_) xcd_barrier(bar);
    if (IN(9)) {
        pg8::Gemm g{(const bf16*)(ws + WS_ACT), (const bf16*)(ws + WS_WDN), NROWS_MAX, 1024, D / 2};
        pg8::MoeOrder<false> S{(const int*)(ws + WS_META), 4, F.G, F.bid, nullptr};
        pg8::EpiDown E{(bf16*)(ws + WS_YR), args.in[I_BDN], (const float*)(ws + WS_COLSC2)};
        pg8::gemm_phase<pg8::EpiDown, pg8::MoeOrder<false>, true, true>(F.lds, g, S, E);
    } } SEAM(9);

    if (IN(10)) { p10_combine(F, args); }
#undef IN
#undef SEAM
}

extern "C" void kernel_launch(void* const* d_in, const int* in_sizes, int n_in, void* d_out, int out_size, void* d_ws, size_t ws_size, hipStream_t stream) {
    static int grid = 0;
    if (grid == 0) {
        if (n_in != 25 || out_size != T * D || ws_size < WS_END) { fprintf(stderr, "kernel_launch: unexpected shapes (n_in %d out %d ws %zu)\n", n_in, out_size, ws_size); grid = -1; return; }
        int dev = 0, cus = 0, per_cu = 0;
        if (hipGetDevice(&dev) != hipSuccess || hipDeviceGetAttribute(&cus, hipDeviceAttributeMultiprocessorCount, dev) != hipSuccess) { grid = -1; return; }
        if (hipFuncSetAttribute((const void*)fwd, hipFuncAttributeMaxDynamicSharedMemorySize, LDS_BYTES) != hipSuccess) { fprintf(stderr, "kernel_launch: hipFuncSetAttribute failed\n"); grid = -1; return; }
        if (hipOccupancyMaxActiveBlocksPerMultiprocessor(&per_cu, (const void*)fwd, NWAVES * 64, LDS_BYTES) != hipSuccess || per_cu < 1) { fprintf(stderr, "kernel_launch: occupancy query says %d\n", per_cu); }
        (void)hipGetLastError();
        grid = cus;
    }
    if (grid < 0) return;
    (void)hipMemsetAsync((char*)d_ws + WS_CTL, 0, CTL_ZERO_BYTES, stream);
    Args a{};
    for (int i = 0; i < 25; ++i) a.in[i] = (const float*)d_in[i];
    a.out = (float*)d_out; a.ws = (unsigned char*)d_ws;
#if MK_N_LAUNCHES == 1
    a.ph_lo = 0; a.ph_hi = N_PHASES; a.ph_rep = 2;
    hipLaunchKernelGGL(fwd, dim3(grid), dim3(NWAVES * 64), LDS_BYTES, stream, a);
#else
    for (int p = 0; p < N_PHASES; ++p) { a.ph_lo = p; a.ph_hi = p + 1; hipLaunchKernelGGL(fwd, dim3(grid), dim3(NWAVES * 64), LDS_BYTES, stream, a); }
#endif
}
```

```cpp
#define NAIVE_RWKV 0
#define NAIVE_ATT 0
#define MK_N_LAUNCHES 1
#include <hip/hip_runtime.h>
#include <cstdio>
#include <cstdint>

#ifndef MK_N_LAUNCHES
#define MK_N_LAUNCHES 1
#endif
#ifndef NAIVE_RWKV
#define NAIVE_RWKV 0
#endif
#ifndef NAIVE_ATT
#define NAIVE_ATT 0
#endif

namespace pg8 {
#define PG8_LAS __attribute__((address_space(3)))
typedef unsigned short bf16_t;
typedef short bf16x8 __attribute__((ext_vector_type(8)));
typedef float f32x4 __attribute__((ext_vector_type(4)));
typedef unsigned u32x4 __attribute__((ext_vector_type(4)));
typedef unsigned u32x2 __attribute__((ext_vector_type(2)));
typedef float f32x2e __attribute__((ext_vector_type(2)));
typedef int i32x4 __attribute__((ext_vector_type(4)));
typedef int i32x8 __attribute__((ext_vector_type(8)));
template <bool F8> struct Frag { bf16x8 v[2]; __device__ __forceinline__ void set(bf16x8 a, bf16x8 b) { v[0] = a; v[1] = b; } };
template <> struct Frag<true> { i32x8 v; __device__ __forceinline__ void set(bf16x8 a, bf16x8 b) { v = __builtin_shufflevector(__builtin_bit_cast(i32x4, a), __builtin_bit_cast(i32x4, b), 0, 1, 2, 3, 4, 5, 6, 7); } };
__device__ __forceinline__ i32x8 cat8(bf16x8 a, bf16x8 b) { return __builtin_shufflevector(__builtin_bit_cast(i32x4, a), __builtin_bit_cast(i32x4, b), 0, 1, 2, 3, 4, 5, 6, 7); }
constexpr int BM = 256, BK = 64, HALF = 128, HTB = HALF * BK * 2  , STAGE_BYTES = 8 * HTB, NXCD = 8, WGM = 8;

__host__ __device__ __forceinline__ int lds_byte(int r, int c) { const int st = (r >> 4) * 2 + (c >> 5), rr = r & 15, cc = c & 31, ob = rr * 64 + cc * 2; return st * 1024 + (ob ^ (((ob >> 9) & 1) << 5)); }
__host__ __device__ __forceinline__ void stage_rc(int b, int& R, int& C) { const int st = b / 1024, sb = b % 1024, swz = sb ^ (((sb >> 9) & 1) << 5); R = (st >> 1) * 16 + swz / 64; C = (st & 1) * 32 + (swz % 64) / 2; }
__host__ __device__ __forceinline__ int perm32(int rho) { const int n = rho >> 4, i = rho & 15; return 8 * (i >> 2) + 4 * n + (i & 3); }

struct Unit { int pm, pn, e; };
struct Gemm { const bf16_t* A; const bf16_t* Bt; int M, N, K; };

__device__ __forceinline__ bool tile_of(int i, int G, int c, int nM, int nN, int& pm, int& pn) {
    const int nwg = nM * nN; const long L = (long)i * G + c; if (L >= nwg) return false;
    int wgid = (int)L; { const int q = nwg / NXCD, r = nwg % NXCD, xcd = wgid % NXCD, off = wgid / NXCD; wgid = (xcd < r ? xcd * (q + 1) : r * (q + 1) + (xcd - r) * q) + off; }
    const int nig = WGM * nN, gid = wgid / nig, fm = gid * WGM, gsz = (nM - fm) < WGM ? (nM - fm) : WGM;
    pm = fm + ((wgid % nig) % gsz); pn = (wgid % nig) / gsz; return true;
}
struct StaticOrder {
    int nM, nN, G, c;
    __device__ void init(int M, int N, int G_, int c_) { nM = M / BM; nN = N / BM; G = G_; c = c_; }
    __device__ __forceinline__ bool next(int i, Unit& u) const { u.e = 0; return tile_of(i, G, c, nM, nN, u.pm, u.pn); }
    __device__ __forceinline__ const char* a_base(const Gemm& g, const Unit& u) const { return (const char*)g.A + (size_t)u.pm * BM * g.K * 2; }
    __device__ __forceinline__ const char* b_base(const Gemm& g, const Unit& u) const { return (const char*)g.Bt + (size_t)u.pn * BM * g.K * 2; }
    __device__ __forceinline__ void a_off(const Gemm& g, const Unit&, const int (&R)[2], const int (&C)[2], unsigned (&vo)[2][2]) const {
#pragma unroll
        for (int h = 0; h < 2; ++h)
#pragma unroll
            for (int i = 0; i < 2; ++i) vo[h][i] = (unsigned)((h * HALF + R[i]) * g.K + C[i]) * 2u; }
    __device__ __forceinline__ void a_ready(const Unit&) const {}
    __device__ __forceinline__ void done(const Unit&) const {}
};
template <bool GATHER>
struct MoeOrder {
    const int* meta; int nN, G, c;
    __device__ __forceinline__ bool next(int i, Unit& u) const {
        const int nM = __builtin_amdgcn_readfirstlane(meta[0]);
        if (!tile_of(i, G, c, nM, nN, u.pm, u.pn)) return false;
        u.e = __builtin_amdgcn_readfirstlane(meta[16 + u.pm]); return true;
    }
    const int* rowtok;
    __device__ __forceinline__ const char* a_base(const Gemm& g, const Unit& u) const { return GATHER ? (const char*)g.A : (const char*)g.A + (size_t)u.pm * BM * g.K * 2; }
    __device__ __forceinline__ const char* b_base(const Gemm& g, const Unit& u) const { return (const char*)g.Bt + ((size_t)u.e * g.N + (size_t)u.pn * BM) * g.K * 2; }
    __device__ __forceinline__ void a_off(const Gemm& g, const Unit& u, const int (&R)[2], const int (&C)[2], unsigned (&vo)[2][2]) const {
#pragma unroll
        for (int h = 0; h < 2; ++h)
#pragma unroll
            for (int i = 0; i < 2; ++i) { const int r = h * HALF + R[i]; vo[h][i] = (unsigned)((GATHER ? rowtok[u.pm * BM + r] : r) * g.K + C[i]) * 2u; } }
    __device__ __forceinline__ void a_ready(const Unit&) const {}
    __device__ __forceinline__ void done(const Unit&) const {}
};

__device__ __forceinline__ unsigned cvt_pk_bf16(float lo, float hi) { unsigned r; asm volatile("v_cvt_pk_bf16_f32 %0, %1, %2" : "=v"(r) : "v"(lo), "v"(hi)); return r; }

__device__ __forceinline__ float acc_i2f(float bits) { return (float)__builtin_bit_cast(int, bits); }
struct EpiBf16Q {
    static constexpr bool PERM = true, AFTER_DRAIN = false, I8 = true, F8 = false;
    bf16_t* O; int ldc; const float* rowsc; const float* colsc;
    __device__ __forceinline__ void operator()(const f32x4 (&acc)[2][2][4][2], const Unit& u, int wr, int wc, int fr, int fq) const {
        const int row0 = u.pm * BM + wr * 64 + fr, col0 = u.pn * BM + wc * 32 + 8 * fq;
        f32x4 cv[2][2]; float rsv[2][4];
#pragma unroll
        for (int bj = 0; bj < 2; ++bj)
#pragma unroll
            for (int n = 0; n < 2; ++n) cv[bj][n] = *(const f32x4*)(colsc + col0 + bj * HALF + 4 * n);
#pragma unroll
        for (int ai = 0; ai < 2; ++ai)
#pragma unroll
            for (int m = 0; m < 4; ++m) rsv[ai][m] = rowsc[row0 + ai * HALF + m * 16];
#pragma unroll
        for (int ai = 0; ai < 2; ++ai)
#pragma unroll
            for (int m = 0; m < 4; ++m) { bf16_t* rowp = O + (size_t)(row0 + ai * HALF + m * 16) * ldc + col0; const float rs = rsv[ai][m];
#pragma unroll
                for (int bj = 0; bj < 2; ++bj) { f32x4 v0, v1;
#pragma unroll
                    for (int j = 0; j < 4; ++j) { v0[j] = acc_i2f(acc[ai][bj][m][0][j]); v1[j] = acc_i2f(acc[ai][bj][m][1][j]); }
                    v0 = (v0 * rs) * cv[bj][0]; v1 = (v1 * rs) * cv[bj][1];
                    u32x4 w; w.x = cvt_pk_bf16(v0[0], v0[1]); w.y = cvt_pk_bf16(v0[2], v0[3]); w.z = cvt_pk_bf16(v1[0], v1[1]); w.w = cvt_pk_bf16(v1[2], v1[3]);
                    *(u32x4*)(rowp + bj * HALF) = w; } }
    }
};
struct EpiBf16 {
    static constexpr bool PERM = true, AFTER_DRAIN = false, I8 = false, F8 = false;
    bf16_t* O; int ldc;
    __device__ __forceinline__ void operator()(const f32x4 (&acc)[2][2][4][2], const Unit& u, int wr, int wc, int fr, int fq) const {
        const int row0 = u.pm * BM + wr * 64 + fr, col0 = u.pn * BM + wc * 32 + 8 * fq;
#pragma unroll
        for (int ai = 0; ai < 2; ++ai)
#pragma unroll
            for (int m = 0; m < 4; ++m) { bf16_t* rowp = O + (size_t)(row0 + ai * HALF + m * 16) * ldc + col0;
#pragma unroll
                for (int bj = 0; bj < 2; ++bj) { const f32x4 v0 = acc[ai][bj][m][0], v1 = acc[ai][bj][m][1];
                    u32x4 w; w.x = cvt_pk_bf16(v0[0], v0[1]); w.y = cvt_pk_bf16(v0[2], v0[3]); w.z = cvt_pk_bf16(v1[0], v1[1]); w.w = cvt_pk_bf16(v1[2], v1[3]);
                    *(u32x4*)(rowp + bj * HALF) = w; } }
    }
};
struct EpiResid {
    static constexpr bool PERM = false, AFTER_DRAIN = false, I8 = false, F8 = false;
    const float* base; float* out; bf16_t* xb; int ldc;
    __device__ __forceinline__ void operator()(const f32x4 (&acc)[2][2][4][2], const Unit& u, int wr, int wc, int fr, int fq) const {
        const int row0 = u.pm * BM + wr * 64 + fr, col0 = u.pn * BM + wc * 32 + 4 * fq;
        f32x4 nb[4][2][2];
#define PG8_RES_LOAD(g_) do { const size_t off_ = (size_t)(row0 + ((g_) >> 2) * HALF + ((g_) & 3) * 16) * ldc + col0; _Pragma("unroll") for (int bj = 0; bj < 2; ++bj) _Pragma("unroll") for (int n = 0; n < 2; ++n) \
            nb[(g_) & 3][bj][n] = __builtin_nontemporal_load((const f32x4*)(base + off_ + bj * HALF + n * 16)); } while (0)
        PG8_RES_LOAD(0); PG8_RES_LOAD(1); PG8_RES_LOAD(2);
#pragma unroll
        for (int g = 0; g < 8; ++g) { const int ai = g >> 2, m = g & 3; const size_t off = (size_t)(row0 + ai * HALF + m * 16) * ldc + col0;
            if (g + 3 < 8) PG8_RES_LOAD(g + 3);
#pragma unroll
            for (int bj = 0; bj < 2; ++bj)
#pragma unroll
                for (int n = 0; n < 2; ++n) { const f32x4 o = nb[g & 3][bj][n] + acc[ai][bj][m][n];
                    if (out) *(f32x4*)(out + off + bj * HALF + n * 16) = o;
                    u32x2 w; w.x = cvt_pk_bf16(o[0], o[1]); w.y = cvt_pk_bf16(o[2], o[3]); *(u32x2*)(xb + off + bj * HALF + n * 16) = w; }
            asm volatile("" ::: "memory"); }
#undef PG8_RES_LOAD
    }
};
struct EpiSwiGLU {
    static constexpr bool PERM = true, AFTER_DRAIN = false, I8 = true, F8 = false;
    bf16_t* O; const float* b_up; const float* rowrstd; const float* colsc;
    __device__ __forceinline__ void operator()(const f32x4 (&acc)[2][2][4][2], const Unit& u, int wr, int wc, int fr, int fq) const {
        const int row0 = u.pm * BM + wr * 64 + fr, f0 = u.pn * HALF + wc * 32 + 8 * fq;
        const float* bg = b_up + (size_t)u.e * 2048 + f0; const float* bl = bg + 1024;
        const f32x4 bg0 = *(const f32x4*)bg, bg1 = *(const f32x4*)(bg + 4), bl0 = *(const f32x4*)bl, bl1 = *(const f32x4*)(bl + 4);
        const float* cg = colsc + (size_t)u.e * 2048 + f0; const float* cl = cg + 1024;
        const f32x4 cg0 = *(const f32x4*)cg, cg1 = *(const f32x4*)(cg + 4), cl0 = *(const f32x4*)cl, cl1 = *(const f32x4*)(cl + 4);
        float rsv[2][4];
#pragma unroll
        for (int ai = 0; ai < 2; ++ai)
#pragma unroll
            for (int m = 0; m < 4; ++m) rsv[ai][m] = rowrstd[row0 + ai * HALF + m * 16];
#pragma unroll
        for (int ai = 0; ai < 2; ++ai)
#pragma unroll
            for (int m = 0; m < 4; ++m) { const int row = row0 + ai * HALF + m * 16; const float rs = rsv[ai][m];
                float a[8];
#pragma unroll
                for (int n = 0; n < 2; ++n)
#pragma unroll
                    for (int j = 0; j < 4; j += 2) {
                        const f32x2e ag2 = {acc_i2f(acc[ai][0][m][n][j]), acc_i2f(acc[ai][0][m][n][j + 1])}, al2 = {acc_i2f(acc[ai][1][m][n][j]), acc_i2f(acc[ai][1][m][n][j + 1])};
                        const f32x2e cg2 = n ? (f32x2e){cg1[j], cg1[j + 1]} : (f32x2e){cg0[j], cg0[j + 1]}, cl2 = n ? (f32x2e){cl1[j], cl1[j + 1]} : (f32x2e){cl0[j], cl0[j + 1]};
                        const f32x2e bg2 = n ? (f32x2e){bg1[j], bg1[j + 1]} : (f32x2e){bg0[j], bg0[j + 1]}, bl2 = n ? (f32x2e){bl1[j], bl1[j + 1]} : (f32x2e){bl0[j], bl0[j + 1]};
                        f32x2e hg = (ag2 * rs) * cg2 + bg2, hl = (al2 * rs) * cl2 + bl2;
                        hg.x = fminf(hg.x, 7.0f); hg.y = fminf(hg.y, 7.0f); hl.x = fminf(fmaxf(hl.x, -7.0f), 7.0f); hl.y = fminf(fmaxf(hl.y, -7.0f), 7.0f);
                        const f32x2e t = hg * (-1.702f * 1.4426950408889634f);
                        f32x2e e; e.x = __builtin_amdgcn_exp2f(t.x); e.y = __builtin_amdgcn_exp2f(t.y);
                        const f32x2e d = e + 1.0f; f32x2e sg; sg.x = __builtin_amdgcn_rcpf(d.x); sg.y = __builtin_amdgcn_rcpf(d.y);
                        const f32x2e o = (hg * sg) * (hl + 1.0f);
                        a[n * 4 + j] = o.x; a[n * 4 + j + 1] = o.y; }
                u32x2 w;
                w.x = (unsigned)__builtin_amdgcn_cvt_pk_fp8_f32(a[2], a[3], __builtin_amdgcn_cvt_pk_fp8_f32(a[0], a[1], 0, false), true);
                w.y = (unsigned)__builtin_amdgcn_cvt_pk_fp8_f32(a[6], a[7], __builtin_amdgcn_cvt_pk_fp8_f32(a[4], a[5], 0, false), true);
                *(u32x2*)((unsigned char*)O + (size_t)row * 1024 + f0) = w; }
    }
};
struct EpiDown {
    static constexpr bool PERM = true, AFTER_DRAIN = false, I8 = false, F8 = true;
    bf16_t* O; const float* b_dn; const float* colsc;
    __device__ __forceinline__ void operator()(const f32x4 (&acc)[2][2][4][2], const Unit& u, int wr, int wc, int fr, int fq) const {
        const int row0 = u.pm * BM + wr * 64 + fr, col0 = u.pn * BM + wc * 32 + 8 * fq;
        const float* bp = b_dn + (size_t)u.e * 1024 + col0;
        const float* cp = colsc + (size_t)u.e * 1024 + col0;
        f32x4 bv[2][2], cv[2][2];
#pragma unroll
        for (int bj = 0; bj < 2; ++bj)
#pragma unroll
            for (int n = 0; n < 2; ++n) { bv[bj][n] = *(const f32x4*)(bp + bj * HALF + 4 * n); cv[bj][n] = *(const f32x4*)(cp + bj * HALF + 4 * n); }
#pragma unroll
        for (int ai = 0; ai < 2; ++ai)
#pragma unroll
            for (int m = 0; m < 4; ++m) { bf16_t* rowp = O + (size_t)(row0 + ai * HALF + m * 16) * 1024 + col0;
#pragma unroll
                for (int bj = 0; bj < 2; ++bj) { const f32x4 v0 = acc[ai][bj][m][0] * cv[bj][0] + bv[bj][0], v1 = acc[ai][bj][m][1] * cv[bj][1] + bv[bj][1];
                    u32x4 w; w.x = cvt_pk_bf16(v0[0], v0[1]); w.y = cvt_pk_bf16(v0[2], v0[3]); w.z = cvt_pk_bf16(v1[0], v1[1]); w.w = cvt_pk_bf16(v1[2], v1[3]);
                    *(u32x4*)(rowp + bj * HALF) = w; } }
    }
};

template <class Epi, class Sched, bool ALIGN_EPI = false, bool SP2 = false>
__device__ __forceinline__ void gemm_phase(PG8_LAS unsigned char* lds, const Gemm g, const Sched& S, const Epi& E) {
    int tid = threadIdx.x; asm volatile("" : "+v"(tid));
    const int wid = __builtin_amdgcn_readfirstlane(tid >> 6), lane = tid & 63, wr = wid >> 2, wc = wid & 3, fr = lane & 15, fq = lane >> 4;
    const int K = g.K, nt = K / BK;
    unsigned voffB[2]; int sR[2], sC[2];
#pragma unroll
    for (int i = 0; i < 2; ++i) { int R, C; stage_rc(tid * 16 + i * 8192, R, C); const int Rb = Epi::PERM ? ((R & ~31) + perm32(R & 31)) : R;
        sR[i] = R; sC[i] = C; voffB[i] = (unsigned)(Rb * K + C) * 2u; }
    const size_t kstep = (size_t)(BK * 2);
    const size_t hstep = (size_t)HALF * K * 2;
    const unsigned ldsw = (unsigned)wid * 1024u;
    const int aoff = lds_byte(wr * 64 + fr, fq * 8), boff = lds_byte(wc * 32 + fr, fq * 8);
#define PG8_SA(b, h) (((b) * 2 + (h)) * HTB)
#define PG8_SB(b, h) ((4 + (b) * 2 + (h)) * HTB)
#define PG8_STAGE(bufoff, gbase, voff) do { _Pragma("unroll") for (int _i = 0; _i < 2; ++_i) \
        __builtin_amdgcn_global_load_lds((const unsigned*)((const char*)(gbase) + (voff)[_i]), (PG8_LAS unsigned*)(lds + (bufoff) + ldsw + _i * 8192), 16, 0, 0); } while (0)
#define PG8_STAGE_A(bufoff, gbase, vo, h) do { _Pragma("unroll") for (int _i = 0; _i < 2; ++_i) \
        __builtin_amdgcn_global_load_lds((const unsigned*)((const char*)(gbase) + (vo)[h][_i]), (PG8_LAS unsigned*)(lds + (bufoff) + ldsw + _i * 8192), 16, 0, 0); } while (0)
#define PG8_LDA(dst, b, h) do { _Pragma("unroll") for (int m = 0; m < 4; ++m) dst[m].set(*(const PG8_LAS bf16x8*)(lds + PG8_SA(b, h) + aoff + m * 2048), *(const PG8_LAS bf16x8*)(lds + PG8_SA(b, h) + aoff + m * 2048 + 1024)); } while (0)
#define PG8_LDB(dst, b, h) do { _Pragma("unroll") for (int n = 0; n < 2; ++n) dst[n].set(*(const PG8_LAS bf16x8*)(lds + PG8_SB(b, h) + boff + n * 2048), *(const PG8_LAS bf16x8*)(lds + PG8_SB(b, h) + boff + n * 2048 + 1024)); } while (0)
#define PG8_MMA(ai, bj, At, Bt) do { __builtin_amdgcn_s_setprio(1); _Pragma("unroll") for (int m = 0; m < 4; ++m) _Pragma("unroll") for (int n = 0; n < 2; ++n) { \
        if constexpr (Epi::F8) asm volatile("v_mfma_scale_f32_16x16x128_f8f6f4 %0, %1, %2, %0, %3, %3 op_sel_hi:[0,0,0]" : "+v"(acc[ai][bj][m][n]) : "v"(Bt[n].v), "v"(At[m].v), "v"(f8scale)); \
        else { _Pragma("unroll") for (int k = 0; k < 2; ++k) { \
            if constexpr (Epi::I8) acc[ai][bj][m][n] = __builtin_bit_cast(f32x4, __builtin_amdgcn_mfma_i32_16x16x64_i8(__builtin_bit_cast(i32x4, Bt[n].v[k]), __builtin_bit_cast(i32x4, At[m].v[k]), __builtin_bit_cast(i32x4, acc[ai][bj][m][n]), 0, 0, 0)); \
            else acc[ai][bj][m][n] = __builtin_amdgcn_mfma_f32_16x16x32_bf16(Bt[n].v[k], At[m].v[k], acc[ai][bj][m][n], 0, 0, 0); } } } __builtin_amdgcn_s_setprio(0); } while (0)
#define PG8_WAIT_V(n) asm volatile("s_waitcnt vmcnt(" #n ")" ::: "memory")
#define PG8_WAIT_L(n) asm volatile("s_waitcnt lgkmcnt(" #n ")" ::: "memory")
#define PG8_BAR __builtin_amdgcn_s_barrier()
#define PG8_SCHED __builtin_amdgcn_sched_barrier(0)
    Unit cur, nxt; int ui = 0;
#ifdef GEMM_TIME
    long long gacc_ = 0;
#endif
    if (!S.next(0, cur)) return;
    f32x4 acc[2][2][4][2];
#pragma unroll
    for (int a = 0; a < 2; ++a)
#pragma unroll
        for (int b = 0; b < 2; ++b)
#pragma unroll
            for (int m = 0; m < 4; ++m)
#pragma unroll
                for (int n = 0; n < 2; ++n) acc[a][b][m][n] = (f32x4){0.f, 0.f, 0.f, 0.f};
    Frag<Epi::F8> At[4], B0[2], B1[2];
    const int f8scale = 0x7f7f7f7f;
    (void)f8scale;
    const char* cA = S.a_base(g, cur); const char* cB = S.b_base(g, cur);
    unsigned voC[2][2], voN[2][2];
    S.a_off(g, cur, sR, sC, voC);
    S.a_ready(cur);
    static_assert(SP2, "only the two-MFMA-blocks-per-barrier-pair loop is kept");
    PG8_STAGE(PG8_SB(0, 0), cB, voffB); PG8_STAGE(PG8_SB(0, 1), cB + hstep, voffB); PG8_STAGE_A(PG8_SA(0, 0), cA, voC, 0); PG8_STAGE_A(PG8_SA(0, 1), cA, voC, 1);
    if (wr == 1) PG8_BAR;
    PG8_WAIT_V(2); PG8_BAR;
    PG8_STAGE(PG8_SB(1, 0), cB + kstep, voffB); PG8_STAGE_A(PG8_SA(1, 0), cA + kstep, voC, 0); PG8_STAGE(PG8_SB(1, 1), cB + hstep + kstep, voffB);
    PG8_WAIT_V(6); PG8_BAR;
    for (;;) {
        const bool has_next = S.next(ui + 1, nxt);
        const char* nA = has_next ? S.a_base(g, nxt) : cA; const char* nB = has_next ? S.b_base(g, nxt) : cB;
        if (has_next) S.a_off(g, nxt, sR, sC, voN); else {
#pragma unroll
            for (int h_ = 0; h_ < 2; ++h_) { voN[h_][0] = voC[h_][0]; voN[h_][1] = voC[h_][1]; } }
#pragma unroll 1
        for (int t = 0; t < nt; t += 2) {
            const bool last = (t == nt - 2);
            const char* a1 = cA + (size_t)(t + 1) * kstep;
            const char* a2 = last ? nA : cA + (size_t)(t + 2) * kstep; const char* b2 = last ? nB : cB + (size_t)(t + 2) * kstep;
            const char* a3 = a2 + kstep; const char* b3 = b2 + kstep;
            if (last && has_next) S.a_ready(nxt);
            unsigned vo2[2][2];
#pragma unroll
            for (int h_ = 0; h_ < 2; ++h_) { vo2[h_][0] = last ? voN[h_][0] : voC[h_][0]; vo2[h_][1] = last ? voN[h_][1] : voC[h_][1]; }
            PG8_LDB(B0, 0, 0); PG8_LDB(B1, 0, 1); PG8_SCHED; PG8_LDA(At, 0, 0); PG8_STAGE_A(PG8_SA(1, 1), a1, voC, 1);
            PG8_WAIT_V(8); PG8_WAIT_L(0); PG8_BAR; PG8_MMA(0, 0, At, B0); PG8_MMA(0, 1, At, B1); PG8_BAR; PG8_SCHED;
            PG8_LDA(At, 0, 1); PG8_STAGE(PG8_SB(0, 0), b2, voffB); PG8_STAGE(PG8_SB(0, 1), b2 + hstep, voffB); PG8_STAGE_A(PG8_SA(0, 0), a2, vo2, 0);
            PG8_WAIT_V(8); PG8_WAIT_L(0); PG8_BAR; PG8_MMA(1, 0, At, B0); PG8_MMA(1, 1, At, B1); PG8_BAR; PG8_SCHED;
            PG8_LDB(B0, 1, 0); PG8_LDB(B1, 1, 1); PG8_SCHED; PG8_LDA(At, 1, 0); PG8_STAGE_A(PG8_SA(0, 1), a2, vo2, 1);
            PG8_WAIT_V(8); PG8_WAIT_L(0); PG8_BAR; PG8_MMA(0, 0, At, B0); PG8_MMA(0, 1, At, B1); PG8_BAR; PG8_SCHED;
            PG8_LDA(At, 1, 1); PG8_STAGE(PG8_SB(1, 0), b3, voffB); PG8_STAGE(PG8_SB(1, 1), b3 + hstep, voffB); PG8_STAGE_A(PG8_SA(1, 0), a3, vo2, 0);
            PG8_WAIT_V(8); PG8_WAIT_L(0); PG8_BAR; PG8_MMA(1, 0, At, B0); PG8_MMA(1, 1, At, B1); PG8_BAR; PG8_SCHED;
        }
        if constexpr (ALIGN_EPI) { if (wr == 0) PG8_BAR; }
#ifdef GEMM_TIME
        const long long gt0_ = clock64();
#endif
        if constexpr (!Epi::AFTER_DRAIN) { E(acc, cur, wr, wc, fr, fq); S.done(cur); }
#ifdef GEMM_TIME
        gacc_ += clock64() - gt0_;
#endif
        if (!has_next) break;
#pragma unroll
        for (int a = 0; a < 2; ++a)
#pragma unroll
            for (int b = 0; b < 2; ++b)
#pragma unroll
                for (int m = 0; m < 4; ++m)
#pragma unroll
                    for (int n = 0; n < 2; ++n) acc[a][b][m][n] = (f32x4){0.f, 0.f, 0.f, 0.f};
        cur = nxt; cA = nA; cB = nB; ++ui;
#pragma unroll
        for (int h_ = 0; h_ < 2; ++h_) { voC[h_][0] = voN[h_][0]; voC[h_][1] = voN[h_][1]; }
        if constexpr (ALIGN_EPI) { if (wr == 1) PG8_BAR; }
    }
    PG8_WAIT_V(0);
    if constexpr (!ALIGN_EPI) { if (wr == 0) PG8_BAR; }
    PG8_BAR;
#ifdef GEMM_TIME
    { const long long s0_ = clock64(); while (clock64() - s0_ < gacc_) __builtin_amdgcn_s_sleep(8); }
#endif
    if constexpr (Epi::AFTER_DRAIN) { E.fused(acc, cur, wr, wc, fr, fq, lds, wid, lane); S.done(cur); }
#undef PG8_SA
#undef PG8_SB
#undef PG8_STAGE
#undef PG8_STAGE_A
#undef PG8_LDA
#undef PG8_LDB
#undef PG8_MMA
#undef PG8_WAIT_V
#undef PG8_WAIT_L
#undef PG8_BAR
#undef PG8_SCHED
}
}

constexpr int NWAVES = 8;
constexpr int T = 32768, D = 1024, SEQ = 8192, NBATCH = 4, NCHUNK = SEQ / 64;
constexpr int INC = 3328;
constexpr int PRW = 1536;
constexpr int NEXP = 32, TOPK = 4;
constexpr int NRB_MAX = T * TOPK / 256 + NEXP;
constexpr int NROWS_MAX = NRB_MAX * 256;
constexpr int NITEM = NBATCH * NCHUNK * 8;

constexpr size_t MiB = 1u << 20, KiB = 1u << 10;
constexpr size_t WS_CTL = 0, CTL_ZERO_BYTES = 1 * MiB;
constexpr size_t WS_META = 1 * MiB;
constexpr size_t WS_CNT = 1 * MiB + 64 * KiB;
constexpr size_t WS_EIDX = 2 * MiB, WS_GATE = 2 * MiB + 512 * KiB, WS_LRANK = 3 * MiB, WS_INV = 3 * MiB + 512 * KiB;
constexpr size_t WS_RSTD = 4 * MiB, WS_ROWRSTD = 4 * MiB + 256 * KiB;
constexpr size_t WS_WRT = 5 * MiB;
constexpr size_t WS_PAR = 5 * MiB + 128 * KiB;
constexpr size_t WS_WDEC = 5 * MiB + 256 * KiB, WS_WAAA = WS_WDEC + 64 * KiB, WS_WGATE = WS_WAAA + 64 * KiB;
constexpr size_t WS_WIN = 6 * MiB, WS_WOUT = 13 * MiB;
constexpr size_t WS_ROWTOK = 15 * MiB;
constexpr size_t WS_WUP = 16 * MiB, WS_WDN = 144 * MiB;
constexpr size_t WS_XN = 208 * MiB;
constexpr size_t WS_PROJ = 272 * MiB;
constexpr size_t WS_MIX = 480 * MiB;
constexpr size_t WS_RW = 544 * MiB;
constexpr size_t WS_XG = 272 * MiB, WS_ACT = 544 * MiB, WS_YR = WS_XG;
constexpr size_t WS_COLSC = 15 * MiB + 640 * KiB;
constexpr size_t WS_COLSC1 = 5 * MiB + 192 * KiB;
constexpr size_t WS_XNSC = WS_RSTD;
constexpr size_t WS_COLSC2 = 15 * MiB + 896 * KiB;
constexpr size_t WS_XQ = WS_MIX;
constexpr size_t WS_END = 1000 * MiB;
constexpr int CW_ATT = 8192;
constexpr int CW_BAR = 4096;

constexpr int RING_BYTES = 131072;
constexpr int LDS_BYTES = 163840;
constexpr int MISC_OFF = LDS_BYTES - 256;

#define GAS __attribute__((address_space(1)))
#define LAS __attribute__((address_space(3)))
#define DI __device__ __forceinline__
typedef unsigned short bf16;
typedef unsigned v4u __attribute__((ext_vector_type(4)));
typedef unsigned v2u __attribute__((ext_vector_type(2)));
typedef float f32x4 __attribute__((ext_vector_type(4)));
typedef float f32x2 __attribute__((ext_vector_type(2)));
typedef short bf16x8 __attribute__((ext_vector_type(8)));
typedef __bf16 bf16x2_t __attribute__((ext_vector_type(2)));
#define LDS_WAIT() asm volatile("s_waitcnt lgkmcnt(0)" ::: "memory")
#define VM_WAIT() asm volatile("s_waitcnt vmcnt(0)" ::: "memory")
DI unsigned pk2(float lo, float hi) { const f32x2 v = {lo, hi}; const bf16x2_t b = __builtin_convertvector(v, bf16x2_t); return __builtin_bit_cast(unsigned, b); }
DI float bf2f(unsigned short b) { return __uint_as_float((unsigned)b << 16); }
DI float bflo(unsigned w) { return __uint_as_float(w << 16); }
DI float bfhi(unsigned w) { return __uint_as_float(w & 0xffff0000u); }
DI float wave_sum(float v) {
#pragma unroll
    for (int o = 1; o < 64; o <<= 1) v += __shfl_xor(v, o);
    return v;
}
DI float wave_max(float v) {
#pragma unroll
    for (int o = 1; o < 64; o <<= 1) v = fmaxf(v, __shfl_xor(v, o));
    return v;
}
DI float sigmoidf_(float x) { return 1.0f / (1.0f + __expf(-x)); }

DI float quad_sum(float x) {
    const unsigned a = __builtin_bit_cast(unsigned, x); const auto r = __builtin_amdgcn_permlane32_swap(a, a, false, false);
    const float y = __builtin_bit_cast(float, (unsigned)r[0]) + __builtin_bit_cast(float, (unsigned)r[1]);
    const unsigned b = __builtin_bit_cast(unsigned, y); const auto s = __builtin_amdgcn_permlane16_swap(b, b, false, false);
    return __builtin_bit_cast(float, (unsigned)s[0]) + __builtin_bit_cast(float, (unsigned)s[1]);
}
DI float quad_max(float x) {
    const unsigned a = __builtin_bit_cast(unsigned, x); const auto r = __builtin_amdgcn_permlane32_swap(a, a, false, false);
    const float y = fmaxf(__builtin_bit_cast(float, (unsigned)r[0]), __builtin_bit_cast(float, (unsigned)r[1]));
    const unsigned b = __builtin_bit_cast(unsigned, y); const auto s = __builtin_amdgcn_permlane16_swap(b, b, false, false);
    return fmaxf(__builtin_bit_cast(float, (unsigned)s[0]), __builtin_bit_cast(float, (unsigned)s[1]));
}
#define XB_TMO      128
#define XB_XCNT(j)  (256  + 64 * (j))
#define XB_XSUB(j)  (1280 + 64 * (j))
#define XB_XGEN(j)  (2304 + 64 * (j))
#define XB_TOP      3328
#define XB_TOPGEN   3392
#define XCD_BAR_WORDS 3456
#define XB_SPIN_CAP (NAIVE_RWKV ? (1u << 25) : (1u << 20))

__device__ __forceinline__ unsigned xb_ld(unsigned* p)              { return __hip_atomic_load(p, __ATOMIC_RELAXED, __HIP_MEMORY_SCOPE_AGENT); }
__device__ __forceinline__ unsigned xb_add(unsigned* p, unsigned v) { return __hip_atomic_fetch_add(p, v, __ATOMIC_RELAXED, __HIP_MEMORY_SCOPE_AGENT); }
__device__ __forceinline__ unsigned xb_xcc_id() { return (unsigned)__builtin_amdgcn_s_getreg((3 << 11) | 20) & 0xFu; }
#define XB_SPIN(cond, bar) do { unsigned _sp = 0; while (cond) { __builtin_amdgcn_s_sleep(1); \
    if ((++_sp & 255u) == 0u) { if (xb_ld(&(bar)[XB_TMO])) break; if (_sp > XB_SPIN_CAP) { atomicAdd(&(bar)[XB_TMO], 1u); break; } } } } while (0)

struct XcdBarrier {
    unsigned* bar; unsigned x;
    volatile LAS unsigned* st;
};

__device__ __forceinline__ XcdBarrier xcd_barrier_post(unsigned* bar, volatile LAS unsigned* st) {
    XcdBarrier b; b.bar = bar; b.x = xb_xcc_id(); b.st = st;
    if (threadIdx.x == 0) (void)xb_add(&bar[XB_XCNT(b.x)], 1u);
    return b;
}
__device__ __forceinline__ void xcd_barrier_complete(unsigned* bar, unsigned x, unsigned& nloc, unsigned& nx) {
    const unsigned G = gridDim.x * gridDim.y * gridDim.z;
    unsigned sum, cnt, mine, sp = 0u;
    for (;;) {
        sum = 0u; cnt = 0u; mine = 0u;
#pragma unroll
        for (unsigned j = 0; j < 16; ++j) { const unsigned c = xb_ld(&bar[XB_XCNT(j)]); sum += c; cnt += (c > 0u) ? 1u : 0u; mine = (j == x) ? c : mine; }
        if (sum == G) break;
        __builtin_amdgcn_s_sleep(1);
        if ((++sp & 255u) == 0u) { if (xb_ld(&bar[XB_TMO])) break; if (sp > XB_SPIN_CAP) { atomicAdd(&bar[XB_TMO], 1u); break; } }
    }
    nloc = mine > 0u ? mine : 1u; nx = cnt > 0u ? cnt : 1u;
}

__device__ __forceinline__ void xcd_barrier(const XcdBarrier& b) {
    asm volatile("s_waitcnt vmcnt(0)" ::: "memory");
    __syncthreads();
    if (threadIdx.x == 0) {
        unsigned* bar = b.bar;
        __builtin_amdgcn_s_waitcnt(0);
        unsigned nloc = b.st[0], nx = b.st[1];
        if (nloc == 0u) { xcd_barrier_complete(bar, b.x, nloc, nx); b.st[0] = nloc; b.st[1] = nx; }
        const unsigned old = xb_add(&bar[XB_XSUB(b.x)], 1u);
        const unsigned gen = old / nloc;
        if (old + 1u == (gen + 1u) * nloc) {
            __builtin_amdgcn_fence(__ATOMIC_RELEASE, "agent");
            asm volatile("s_waitcnt vmcnt(0)" ::: "memory");
            const unsigned og = xb_add(&bar[XB_TOP], 1u);
            const unsigned tg = og / nx;
            if (og + 1u == (tg + 1u) * nx) xb_add(&bar[XB_TOPGEN], 1u);
            else XB_SPIN(xb_ld(&bar[XB_TOPGEN]) == tg, bar);
            __builtin_amdgcn_fence(__ATOMIC_ACQUIRE, "agent");
            xb_add(&bar[XB_XGEN(b.x)], 1u);
            asm volatile("s_waitcnt vmcnt(0)" ::: "memory");
        } else {
            XB_SPIN(xb_ld(&bar[XB_XGEN(b.x)]) == gen, bar);
            __builtin_amdgcn_fence(__ATOMIC_ACQUIRE, "agent");
            asm volatile("s_waitcnt vmcnt(0)" ::: "memory");
        }
    }
    __syncthreads();
}

struct Args {
    const float* in[25]; float* out; unsigned char* ws; int ph_lo, ph_hi, ph_rep, pad_;
};
enum { I_X = 0, I_N1G, I_WIN, I_MU, I_QG, I_KG, I_RELB, I_W0, I_WDEC, I_A0, I_WAAA, I_WGATE, I_KK, I_KA, I_RK, I_LNG, I_LNB, I_WOUT, I_N2G, I_WR, I_BR, I_WUP, I_BUP, I_WDN, I_BDN };
struct Frame {
    LAS unsigned char* lds;
    int tid, lane, wave, G, bid;
};


struct TrRegs { f32x4 v[8]; f32x4 s0, s1; bf16* dst; int ldo; };
DI void tr_load(TrRegs& t, const float* __restrict__ W, int ldw, int k0, int n0, bf16* WT, int ldo, long drow, int lane, const float* __restrict__ ksc8 = nullptr) {
    const int r8 = lane >> 3, c4 = lane & 7;
    t.s0 = (f32x4){1.f, 1.f, 1.f, 1.f}; t.s1 = t.s0; if (ksc8) { t.s0 = *(const f32x4*)ksc8; t.s1 = *(const f32x4*)(ksc8 + 4); }
    const float* src = W + (size_t)(k0 + 8 * r8) * ldw + n0 + 4 * c4;
#pragma unroll
    for (int i = 0; i < 8; ++i) t.v[i] = __builtin_nontemporal_load((const f32x4*)(src + (size_t)i * ldw));
    t.dst = WT + (size_t)(drow + 4 * c4) * ldo + k0 + 8 * r8; t.ldo = ldo;
}
DI void tr_store(const TrRegs& t, const float* __restrict__ = nullptr) {
    const f32x4 s0 = t.s0, s1 = t.s1;
#pragma unroll
    for (int j = 0; j < 4; ++j) { const v4u o = {pk2(t.v[0][j] * s0[0], t.v[1][j] * s0[1]), pk2(t.v[2][j] * s0[2], t.v[3][j] * s0[3]), pk2(t.v[4][j] * s1[0], t.v[5][j] * s1[1]), pk2(t.v[6][j] * s1[2], t.v[7][j] * s1[3])};
        __builtin_nontemporal_store(o, (v4u*)(t.dst + (size_t)j * t.ldo)); }
}
DI void tr_item(const float* __restrict__ W, int ldw, int k0, int n0, bf16* WT, int ldo, long drow, LAS float* scr, int lane, const float* __restrict__ ksc) {
    (void)scr; TrRegs t; tr_load(t, W, ldw, k0, n0, WT, ldo, drow, lane, ksc ? ksc + k0 + 8 * (lane >> 3) : nullptr); tr_store(t);
}
constexpr int MOE_TR_UP = NEXP * 16 * 64, MOE_TR_DN = NEXP * 16 * 32, MOE_TR_ALL = MOE_TR_UP + MOE_TR_DN;
DI const float* moe_tr_load(TrRegs& t, const Args& a, int r, int lane) {
    unsigned char* ws = a.ws;
    if (r < MOE_TR_UP) { const int e = r / 1024, kb = (r % 1024) / 64, nb = r % 64, n0 = 32 * nb; const int n1 = n0 & 1023;
        const long drow = (long)(n1 / 128) * 256 + (n0 >= 1024 ? 128 : 0) + (n1 % 128);
        tr_load(t, a.in[I_WUP] + (size_t)e * 1024 * 2048, 2048, 64 * kb, n0, (bf16*)(ws + WS_WUP) + (size_t)e * 2048 * 1024, 1024, drow, lane, a.in[I_N2G] + 64 * kb + 8 * (lane >> 3));
        return nullptr; }
    r -= MOE_TR_UP; const int e = r / 512, kb = (r % 512) / 32, nb = r % 32;
    tr_load(t, a.in[I_WDN] + (size_t)e * 1024 * 1024, 1024, 64 * kb, 32 * nb, (bf16*)(ws + WS_WDN) + (size_t)e * 1024 * 1024, 1024, 32 * nb, lane);
    return nullptr;
}
DI void moe_tr_item(const Args& a, int r, LAS float* scr, int lane) { (void)scr; TrRegs t; const float* s = moe_tr_load(t, a, r, lane); tr_store(t, s); }
DI unsigned q_pack4(float a, float b, float c, float d) {
    const unsigned ua = __builtin_bit_cast(unsigned, a), ub = __builtin_bit_cast(unsigned, b), uc = __builtin_bit_cast(unsigned, c), ud = __builtin_bit_cast(unsigned, d);
    return (ua & 0xffu) | ((ub & 0xffu) << 8) | ((uc & 0xffu) << 16) | (ud << 24); }
constexpr float Q_MAGIC = 12582912.0f;
template <bool DOWN>
DI void moe_q_batch(const Args& a, int batch, int wave, int lane, LAS float* exch) {
    unsigned char* ws = a.ws;
    constexpr int LDW = DOWN ? 1024 : 2048, SPE = LDW / 32;
    const int strip = batch * 4 + (wave >> 1), half = wave & 1, e = strip / SPE, nb = strip % SPE, n0 = 32 * nb, n1 = n0 & 1023;
    const int r8 = lane >> 3, c4 = lane & 7;
    const long drow = DOWN ? (long)n0 : (long)(n1 / 128) * 256 + (n0 >= 1024 ? 128 : 0) + (n1 % 128);
    const float* W = a.in[DOWN ? I_WDN : I_WUP] + (size_t)e * 1024 * LDW + (size_t)(512 * half + 8 * r8) * LDW + n0 + 4 * c4;
    const float* gk = a.in[I_N2G] + 512 * half + 8 * r8;
    const f32x4 one = {1.f, 1.f, 1.f, 1.f};
    f32x4 mx = {0.f, 0.f, 0.f, 0.f};
    for (int g = 0; g < 8; g += 4) {
        f32x4 v[4][8], s0[4], s1[4];
#pragma unroll
        for (int t = 0; t < 4; ++t) { s0[t] = DOWN ? one : *(const f32x4*)(gk + 64 * (g + t)); s1[t] = DOWN ? one : *(const f32x4*)(gk + 64 * (g + t) + 4);
#pragma unroll
            for (int i = 0; i < 8; ++i) v[t][i] = *(const f32x4*)(W + (size_t)(64 * (g + t) + i) * LDW); }
#pragma unroll
        for (int t = 0; t < 4; ++t)
#pragma unroll
            for (int i = 0; i < 8; ++i) { const float s = i < 4 ? s0[t][i] : s1[t][i - 4]; const f32x4 p = v[t][i] * s;
#pragma unroll
                for (int j = 0; j < 4; ++j) mx[j] = fmaxf(mx[j], fabsf(p[j])); }
    }
#pragma unroll
    for (int j = 0; j < 4; ++j) { float m = mx[j]; m = fmaxf(m, __shfl_xor(m, 8)); m = fmaxf(m, __shfl_xor(m, 16)); m = fmaxf(m, __shfl_xor(m, 32)); mx[j] = m; }
    if (r8 == 0) *(LAS f32x4*)(exch + (wave * 8 + c4) * 4) = mx;
    __syncthreads();
    { const f32x4 o = *(const LAS f32x4*)(exch + ((wave ^ 1) * 8 + c4) * 4);
#pragma unroll
      for (int j = 0; j < 4; ++j) mx[j] = fmaxf(mx[j], o[j]); }
    constexpr float QMAX = DOWN ? 256.0f : 127.0f;
    if (half == 0 && r8 == 0) *(f32x4*)((float*)(ws + (DOWN ? WS_COLSC2 : WS_COLSC)) + (size_t)e * LDW + n0 + 4 * c4) = mx * (1.0f / QMAX);
    f32x4 inv;
#pragma unroll
    for (int j = 0; j < 4; ++j) inv[j] = mx[j] > 0.f ? QMAX / mx[j] : 0.f;
    unsigned char* dst = ws + (DOWN ? WS_WDN : WS_WUP) + ((size_t)e * LDW + drow + 4 * c4) * 1024 + 512 * half + 8 * r8;
    for (int g = 0; g < 8; g += 2) {
        f32x4 v[2][8], s0[2], s1[2];
#pragma unroll
        for (int t = 0; t < 2; ++t) { s0[t] = DOWN ? one : *(const f32x4*)(gk + 64 * (g + t)); s1[t] = DOWN ? one : *(const f32x4*)(gk + 64 * (g + t) + 4);
#pragma unroll
            for (int i = 0; i < 8; ++i) v[t][i] = __builtin_nontemporal_load((const f32x4*)(W + (size_t)(64 * (g + t) + i) * LDW)); }
#pragma unroll
        for (int t = 0; t < 2; ++t) {
            f32x4 p[8];
#pragma unroll
            for (int i = 0; i < 8; ++i) { const float s = i < 4 ? s0[t][i] : s1[t][i - 4]; p[i] = DOWN ? v[t][i] * inv : (v[t][i] * s) * inv + Q_MAGIC; }
#pragma unroll
            for (int j = 0; j < 4; ++j) { v2u o;
                if (DOWN) { o.x = (unsigned)__builtin_amdgcn_cvt_pk_fp8_f32(p[2][j], p[3][j], __builtin_amdgcn_cvt_pk_fp8_f32(p[0][j], p[1][j], 0, false), true);
                            o.y = (unsigned)__builtin_amdgcn_cvt_pk_fp8_f32(p[6][j], p[7][j], __builtin_amdgcn_cvt_pk_fp8_f32(p[4][j], p[5][j], 0, false), true); }
                else { o.x = q_pack4(p[0][j], p[1][j], p[2][j], p[3][j]); o.y = q_pack4(p[4][j], p[5][j], p[6][j], p[7][j]); }
                __builtin_nontemporal_store(o, (v2u*)(dst + (size_t)j * 1024 + 64 * (g + t))); } }
    }
}
DI void q_strip_i8_wg(const float* __restrict__ Wsrc, int ldw, int n0, unsigned char* WT, float* colsc, int wave, int lane, LAS float* exch) {
    const int r8 = lane >> 3, c4 = lane & 7;
    const float* W = Wsrc + (size_t)(128 * wave + 8 * r8) * ldw + n0 + 4 * c4;
    f32x4 v[2][8], mx = {0.f, 0.f, 0.f, 0.f};
#pragma unroll
    for (int t = 0; t < 2; ++t)
#pragma unroll
        for (int i = 0; i < 8; ++i) v[t][i] = *(const f32x4*)(W + (size_t)(64 * t + i) * ldw);
#pragma unroll
    for (int t = 0; t < 2; ++t)
#pragma unroll
        for (int i = 0; i < 8; ++i)
#pragma unroll
            for (int j = 0; j < 4; ++j) mx[j] = fmaxf(mx[j], fabsf(v[t][i][j]));
#pragma unroll
    for (int j = 0; j < 4; ++j) { float m = mx[j]; m = fmaxf(m, __shfl_xor(m, 8)); m = fmaxf(m, __shfl_xor(m, 16)); m = fmaxf(m, __shfl_xor(m, 32)); mx[j] = m; }
    if (r8 == 0) *(LAS f32x4*)(exch + (wave * 8 + c4) * 4) = mx;
    __syncthreads();
#pragma unroll
    for (int w2 = 0; w2 < 8; ++w2) { const f32x4 o = *(const LAS f32x4*)(exch + (w2 * 8 + c4) * 4);
#pragma unroll
        for (int j = 0; j < 4; ++j) mx[j] = fmaxf(mx[j], o[j]); }
    if (wave == 0 && r8 == 0) *(f32x4*)(colsc + n0 + 4 * c4) = mx * (1.0f / 127.0f);
    f32x4 inv;
#pragma unroll
    for (int j = 0; j < 4; ++j) inv[j] = mx[j] > 0.f ? 127.0f / mx[j] : 0.f;
    unsigned char* dst = WT + (size_t)(n0 + 4 * c4) * 1024 + 128 * wave + 8 * r8;
#pragma unroll
    for (int t = 0; t < 2; ++t) {
        f32x4 p[8];
#pragma unroll
        for (int i = 0; i < 8; ++i) p[i] = v[t][i] * inv + Q_MAGIC;
#pragma unroll
        for (int j = 0; j < 4; ++j) { const v2u o = {q_pack4(p[0][j], p[1][j], p[2][j], p[3][j]), q_pack4(p[4][j], p[5][j], p[6][j], p[7][j])};
            *(v2u*)(dst + (size_t)j * 1024 + 64 * t) = o; } }
}
DI void moe_tr_batch(const Args& a, int batch, int wave, int lane, LAS float* exch) {
    if (batch < MOE_TR_UP / 64) moe_q_batch<false>(a, batch, wave, lane, exch); else moe_q_batch<true>(a, batch - MOE_TR_UP / 64, wave, lane, exch);
}
constexpr int MOE_TR_BATCHES = MOE_TR_ALL / 64, MOE_TR_EARLY = 256;

#if !NAIVE_ATT
constexpr int ATT_KS = 144;
constexpr int ATT_TILE = 64 * ATT_KS;
constexpr int ATT_BIAS_OFF = 4 * ATT_TILE;
constexpr int ATT_NSLOT = (NBATCH * 8 * (NCHUNK / 2) / 8) * 11;
static_assert(NBATCH * 8 * (NCHUNK / 2) == 2048 && MOE_TR_ALL == 256 * 3 * 64, "attention / conversion work queue");
DI int att_pos(int key) { return (key & 32) + 8 * ((key >> 2) & 3) + 4 * ((key >> 4) & 1) + (key & 3); }
DI void attn_phase(const Frame& F, const Args& a, const int qid = 0) {
    const bf16* proj = (const bf16*)(a.ws + WS_PROJ); bf16* mix = (bf16*)(a.ws + WS_MIX);
    LAS unsigned char* lds = F.lds; LAS float* sbias = (LAS float*)(lds + ATT_BIAS_OFF);
    const int l = F.lane, n16 = l & 15, q = l >> 4, w = F.wave;
    const float LOG2E = 1.4426950408889634f;
    const int srow = F.tid >> 3, spc = F.tid & 7;
    float kgv[8];
#pragma unroll
    for (int j = 0; j < 8; ++j) kgv[j] = a.in[I_KG][8 * spc + j];
    const int spos = att_pos(srow);
    LAS int* s_item = (LAS int*)(lds + ATT_BIAS_OFF + 1024);
    unsigned* qhead = (unsigned*)(a.ws + WS_CTL) + CW_ATT + 64 * qid;
    for (;;) {
        __syncthreads();
        if (F.tid == 0) *s_item = (int)__hip_atomic_fetch_add(qhead, 1u, __ATOMIC_RELAXED, __HIP_MEMORY_SCOPE_AGENT);
        __syncthreads();
        const int slot = *s_item;
        if (slot >= ATT_NSLOT) break;
        const int grp = slot / 11, sub = slot % 11;
        if (sub >= 8) { const int base = (grp * 3 + (sub - 8)) * 64 + w * 8;
            (void)base; moe_tr_batch(a, grp * 3 + (sub - 8), w, l, (LAS float*)(lds + ATT_BIAS_OFF + 2048));
            continue; }
        const int item = grp * 8 + sub;
        const int b = item / (8 * (NCHUNK / 2)), h = (item / (NCHUNK / 2)) & 7, n0 = 2 * (item % (NCHUNK / 2));
        if (F.tid < 192) sbias[F.tid] = a.in[I_RELB][h * 192 + F.tid] * LOG2E;
        const int nq = n0 + (w >> 2), qpos = 16 * (w & 3) + n16;
        const size_t qtok = (size_t)b * SEQ + nq * 64 + qpos;
        bf16x8 qf[2];
        { const v4u q0 = *(const v4u*)(proj + qtok * INC + h * 64 + 8 * q), q1 = *(const v4u*)(proj + qtok * INC + h * 64 + 32 + 8 * q);
          float f[16]; const unsigned ww[8] = {q0.x, q0.y, q0.z, q0.w, q1.x, q1.y, q1.z, q1.w};
          float ss = 0.f;
#pragma unroll
          for (int e = 0; e < 8; ++e) { f[2 * e] = bflo(ww[e]); f[2 * e + 1] = bfhi(ww[e]); ss += f[2 * e] * f[2 * e] + f[2 * e + 1] * f[2 * e + 1]; }
          ss = quad_sum(ss);
          const float rs = (1.0f / sqrtf(ss * (1.f / 64.f) + 1e-6f)) * 0.125f * LOG2E;
          unsigned pk[8];
#pragma unroll
          for (int e = 0; e < 8; ++e) { const int d = (e < 4 ? 0 : 32) + 8 * q + 2 * (e & 3); pk[e] = pk2(f[2 * e] * rs * a.in[I_QG][d], f[2 * e + 1] * rs * a.in[I_QG][d + 1]); }
          const v4u p0 = {pk[0], pk[1], pk[2], pk[3]}, p1 = {pk[4], pk[5], pk[6], pk[7]};
          qf[0] = __builtin_bit_cast(bf16x8, p0); qf[1] = __builtin_bit_cast(bf16x8, p1); }
        f32x4 o[4];
#pragma unroll
        for (int dt = 0; dt < 4; ++dt) o[dt] = (f32x4){0.f, 0.f, 0.f, 0.f};
        float m_run = -3.0e38f, l_run = 0.f;
        v4u kreg, vreg;
        auto gload = [&](int jc) { const int kc = n0 - 8 + jc; if (kc >= 0) { const size_t tok = (size_t)b * SEQ + kc * 64 + srow;
            kreg = *(const v4u*)(proj + tok * INC + 512 + h * 64 + 8 * spc); vreg = *(const v4u*)(proj + tok * INC + 1024 + h * 64 + 8 * spc); } };
        auto lstore = [&](int jc) { const int kc = n0 - 8 + jc; if (kc >= 0) { LAS unsigned char* kb = lds + (jc & 1) * 2 * ATT_TILE; LAS unsigned char* vb = kb + ATT_TILE;
            const unsigned ww[4] = {kreg.x, kreg.y, kreg.z, kreg.w}; float f[8]; float ss = 0.f;
#pragma unroll
            for (int e = 0; e < 4; ++e) { f[2 * e] = bflo(ww[e]); f[2 * e + 1] = bfhi(ww[e]); ss += f[2 * e] * f[2 * e] + f[2 * e + 1] * f[2 * e + 1]; }
            ss += __builtin_bit_cast(float, __builtin_amdgcn_update_dpp(0, __builtin_bit_cast(int, ss), 0xB1, 0xf, 0xf, true));
            ss += __builtin_bit_cast(float, __builtin_amdgcn_update_dpp(0, __builtin_bit_cast(int, ss), 0x4E, 0xf, 0xf, true));
            ss += __builtin_bit_cast(float, __builtin_amdgcn_update_dpp(0, __builtin_bit_cast(int, ss), 0x141, 0xf, 0xf, true));
            const float rs = 1.0f / sqrtf(ss * (1.f / 64.f) + 1e-6f);
            v4u kk; kk.x = pk2(f[0] * rs * kgv[0], f[1] * rs * kgv[1]); kk.y = pk2(f[2] * rs * kgv[2], f[3] * rs * kgv[3]); kk.z = pk2(f[4] * rs * kgv[4], f[5] * rs * kgv[5]); kk.w = pk2(f[6] * rs * kgv[6], f[7] * rs * kgv[7]);
            *(LAS v4u*)(kb + srow * ATT_KS + 16 * spc) = kk;
            const unsigned vv[4] = {vreg.x, vreg.y, vreg.z, vreg.w};
#pragma unroll
            for (int e = 0; e < 4; ++e) { *(LAS unsigned short*)(vb + (8 * spc + 2 * e) * ATT_KS + 2 * spos) = (unsigned short)(vv[e] & 0xffffu);
                                          *(LAS unsigned short*)(vb + (8 * spc + 2 * e + 1) * ATT_KS + 2 * spos) = (unsigned short)(vv[e] >> 16); } } };
        gload(0); lstore(0);
        __syncthreads();
        for (int jc = 0; jc < 10; ++jc) {
            if (jc + 1 < 10) gload(jc + 1);
            const int kc = n0 - 8 + jc, dj = jc - (w >> 2);
            if (kc >= 0 && dj >= 0 && dj <= 8) {
                const LAS unsigned char* kb = lds + (jc & 1) * 2 * ATT_TILE; const LAS unsigned char* vb = kb + ATT_TILE;
                f32x4 sc[4];
#pragma unroll
                for (int mt = 0; mt < 4; ++mt) { sc[mt] = (f32x4){0.f, 0.f, 0.f, 0.f};
#pragma unroll
                    for (int ks = 0; ks < 2; ++ks) { const bf16x8 kf = *(const LAS bf16x8*)(kb + (16 * mt + n16) * ATT_KS + 64 * ks + 16 * q);
                        sc[mt] = __builtin_amdgcn_mfma_f32_16x16x32_bf16(kf, qf[ks], sc[mt], 0, 0, 0); } }
                float boff = 0.f;
                if (dj <= 5) boff = sbias[0];
                else { const int base = (dj - 8) * 64 - qpos + 128;
#pragma unroll
                    for (int mt = 0; mt < 4; ++mt)
#pragma unroll
                        for (int i = 0; i < 4; ++i) { int idx = base + 16 * mt + 4 * q + i; idx = idx < 0 ? 0 : idx; const float bv_ = sbias[idx];
                            sc[mt][i] += bv_; } }
                float mx = sc[0][0];
#pragma unroll
                for (int mt = 0; mt < 4; ++mt)
#pragma unroll
                    for (int i = 0; i < 4; ++i) mx = fmaxf(mx, sc[mt][i]);
                mx = quad_max(mx);
                const float m_new = fmaxf(m_run, mx + boff), alpha = __builtin_amdgcn_exp2f(m_run - m_new), msub = m_new - boff;
                const bool moved = __builtin_amdgcn_ballot_w64(m_new != m_run) != 0ull;
                m_run = m_new; float ls = 0.f;
#pragma unroll
                for (int mt = 0; mt < 4; ++mt)
#pragma unroll
                    for (int i = 0; i < 4; ++i) { sc[mt][i] = __builtin_amdgcn_exp2f(sc[mt][i] - msub); ls += sc[mt][i]; }
                if (moved) { l_run *= alpha;
#pragma unroll
                    for (int dt = 0; dt < 4; ++dt) o[dt] = o[dt] * alpha; }
                l_run += ls;
#pragma unroll
                for (int s = 0; s < 2; ++s) {
                    const v4u pp = {pk2(sc[2 * s][0], sc[2 * s][1]), pk2(sc[2 * s][2], sc[2 * s][3]), pk2(sc[2 * s + 1][0], sc[2 * s + 1][1]), pk2(sc[2 * s + 1][2], sc[2 * s + 1][3])};
                    const bf16x8 pf = __builtin_bit_cast(bf16x8, pp);
#pragma unroll
                    for (int dt = 0; dt < 4; ++dt) { const bf16x8 vf = *(const LAS bf16x8*)(vb + (16 * dt + n16) * ATT_KS + 64 * s + 16 * q);
                        o[dt] = __builtin_amdgcn_mfma_f32_16x16x32_bf16(vf, pf, o[dt], 0, 0, 0); } }
            }
            if (jc + 1 < 10) lstore(jc + 1);
            __syncthreads();
        }
        l_run = quad_sum(l_run);
        const float inv = 1.0f / l_run;
#pragma unroll
        for (int dt = 0; dt < 4; ++dt) { v2u ov; ov.x = pk2(o[dt][0] * inv, o[dt][1] * inv); ov.y = pk2(o[dt][2] * inv, o[dt][3] * inv);
            *(v2u*)(mix + qtok * 1024 + h * 64 + 16 * dt + 4 * q) = ov; }
    }
}
#endif

#if !NAIVE_RWKV
constexpr int RA_HALF = 80896;
constexpr int RA_RT = 0, RA_KT = 9216, RA_BT = 18432, RA_AT = 27648;
constexpr int RA_VT = 36864, RA_KH = 46080, RA_BH = 55296;
constexpr int RA_AAB = 64512;
constexpr int RA_XWD = 0, RA_XAD = 9216, RA_XGD = 18432;
constexpr int RA_RHS2 = 0, RA_GEND = 17408;
constexpr int RA_W1T = 18432, RA_W2T = 27648;
constexpr int RA_WT = RA_AAB;
constexpr int RB_REC = 65536, RB_YLT = 0, RB_PCT = 8192, RB_G1T = 16384, RB_E2T = 24576, RB_MC = 32768, RB_CC = 40960, RB_SC = 57344;
static_assert(2 * RA_HALF <= MISC_OFF, "rwkv phase A LDS");

DI void ld8f(const bf16* p, float (&f)[8]) { const v4u w = *(const v4u*)p; f[0] = bflo(w.x); f[1] = bfhi(w.x); f[2] = bflo(w.y); f[3] = bfhi(w.y); f[4] = bflo(w.z); f[5] = bfhi(w.z); f[6] = bflo(w.w); f[7] = bfhi(w.w); }
DI void ld4f(const bf16* p, float (&f)[4]) { const v2u w = *(const v2u*)p; f[0] = bflo(w.x); f[1] = bfhi(w.x); f[2] = bflo(w.y); f[3] = bfhi(w.y); }
DI bf16x8 pack8(const f32x4& a, const f32x4& b) { const v4u p = {pk2(a[0], a[1]), pk2(a[2], a[3]), pk2(b[0], b[1]), pk2(b[2], b[3])}; return __builtin_bit_cast(bf16x8, p); }
DI float fast_sigmoid(float x) { return __builtin_amdgcn_rcpf(1.0f + __builtin_amdgcn_exp2f(-1.4426950408889634f * x)); }
DI float fast_tanh(float x) { return 1.0f - 2.0f * __builtin_amdgcn_rcpf(1.0f + __builtin_amdgcn_exp2f(2.8853900817779268f * x)); }
#define MFMA16(a, b, c) __builtin_amdgcn_mfma_f32_16x16x32_bf16((a), (b), (c), 0, 0, 0)

DI void rwkv_phase_a(const Frame& F, const Args& a) {
    unsigned char* ws = a.ws; unsigned char* rb = ws + WS_RW;
    const bf16* wdec = (const bf16*)(ws + WS_WDEC); const bf16* waaa = (const bf16*)(ws + WS_WAAA); const bf16* wgate = (const bf16*)(ws + WS_WGATE);
    const float* mu = a.in[I_MU]; const float* par = (const float*)(ws + WS_PAR);
    const int hb = F.wave >> 2, w4 = F.wave & 3;
    LAS unsigned char* hbase = F.lds + hb * RA_HALF;
    const float LOG2E = 1.4426950408889634f;
    v4u s0c[4];
#define RA_REQUEST(pair_) do { const int item_ = 2 * (pair_) + hb, c_ = (item_ >> 3) & 127, b_ = item_ >> 10; const size_t tok0_ = (size_t)b_ * SEQ + c_ * 64; \
        int lq_ = F.lane; asm volatile("" : "+v"(lq_)); size_t wsq_ = (size_t)ws; asm volatile("" : "+s"(wsq_)); const int t9q_ = (hb << 8) | (w4 << 6) | lq_; \
        const bf16* cur_ = (const bf16*)(wsq_ + WS_PROJ) + (tok0_ + (t9q_ >> 3)) * INC + PRW + 1536 + 32 * (t9q_ & 7); \
        _Pragma("unroll") for (int g8 = 0; g8 < 4; ++g8) s0c[g8] = *(const v4u*)(cur_ + 8 * g8); } while (0)
    if (F.bid < NITEM / 2) RA_REQUEST(F.bid);
    for (int pair = F.bid; pair < NITEM / 2; pair += F.G) {
        size_t wsb = (size_t)ws; asm volatile("" : "+s"(wsb)); const bf16* proj = (const bf16*)(wsb + WS_PROJ);
        int l = F.lane; asm volatile("" : "+v"(l));
        const int n16 = l & 15, q = l >> 4, t4 = (hb << 8 | (F.wave & 3) << 6 | l) & 255;
        const int tokl = 16 * w4 + n16;
        const int tslot = (tokl & 32) + 8 * ((tokl >> 2) & 3) + 4 * ((tokl >> 4) & 1) + (tokl & 3);
        const int item = 2 * pair + hb, h = item & 7, c = (item >> 3) & 127, b = item >> 10;
        const size_t tok0 = (size_t)b * SEQ + c * 64; unsigned char* rbi = rb + (size_t)item * RB_REC;
        const int t9 = (hb << 8) | t4, tk0 = t9 >> 3, part = t9 & 7;
        v4u s0p[4];
        { const bool first = (c == 0 && tk0 == 0); const bf16* prv = proj + (tok0 + tk0) * INC + PRW + 1536 + 32 * part - INC;
#pragma unroll
          for (int g8 = 0; g8 < 4; ++g8) { s0p[g8] = (v4u){0u, 0u, 0u, 0u}; if (!first) s0p[g8] = *(const v4u*)(prv + 8 * g8); } }
        v2u rawc[3][4], rawp[3][4];
        { const bool first = (c == 0 && tokl == 0); const bf16* cur = proj + (tok0 + tokl) * INC + PRW + h * 64 + 4 * q; const bf16* prv = cur - INC;
#pragma unroll
          for (int m = 0; m < 3; ++m)
#pragma unroll
              for (int ct = 0; ct < 4; ++ct) { rawc[m][ct] = *(const v2u*)(cur + 512 * m + 16 * ct); rawp[m][ct] = (v2u){0u, 0u}; if (!first) rawp[m][ct] = *(const v2u*)(prv + 512 * m + 16 * ct); } }
        bf16x8 wfr[2][8];
#define RA_WLOAD(dst, ctv) do { const int row_ = h * 64 + 16 * (ctv) + n16; \
            dst[0] = *(const bf16x8*)(wdec + row_ * 64 + 8 * q); dst[1] = *(const bf16x8*)(wdec + row_ * 64 + 32 + 8 * q); \
            dst[2] = *(const bf16x8*)(waaa + row_ * 64 + 8 * q); dst[3] = *(const bf16x8*)(waaa + row_ * 64 + 32 + 8 * q); \
            _Pragma("unroll") for (int ks_ = 0; ks_ < 4; ++ks_) dst[4 + ks_] = *(const bf16x8*)(wgate + row_ * 128 + 32 * ks_ + 8 * q); } while (0)
        RA_WLOAD(wfr[0], 0); RA_WLOAD(wfr[1], 1);
        __syncthreads();
        { const float esc = part < 2 ? 2.8853900817779268f : -1.4426950408889634f;
          LAS unsigned char* dst = F.lds + (part < 2 ? RA_XWD + tk0 * 144 + part * 64 : (part < 4 ? RA_XAD + tk0 * 144 + (part - 2) * 64 : RA_XGD + tk0 * 272 + (part - 4) * 64));
#pragma unroll
          for (int g8 = 0; g8 < 4; ++g8) {
              const unsigned xw[4] = {s0c[g8].x, s0c[g8].y, s0c[g8].z, s0c[g8].w}, pw[4] = {s0p[g8].x, s0p[g8].y, s0p[g8].z, s0p[g8].w};
              const f32x4 m0 = *(const f32x4*)(mu + 1536 + 32 * part + 8 * g8), m1 = *(const f32x4*)(mu + 1536 + 32 * part + 8 * g8 + 4);
              float y[8];
#pragma unroll
              for (int j = 0; j < 8; ++j) { const float x = (j & 1) ? bfhi(xw[j >> 1]) : bflo(xw[j >> 1]), p = (j & 1) ? bfhi(pw[j >> 1]) : bflo(pw[j >> 1]);
                  const float xs = x + (p - x) * (j < 4 ? m0[j & 3] : m1[j & 3]);
                  const float rc = __builtin_amdgcn_rcpf(1.0f + __builtin_amdgcn_exp2f(esc * xs));
                  y[j] = part < 2 ? 1.0f - 2.0f * rc : (part < 4 ? xs : rc); }
              const v4u o = {pk2(y[0], y[1]), pk2(y[2], y[3]), pk2(y[4], y[5]), pk2(y[6], y[7])};
              *(LAS v4u*)(dst + 16 * g8) = o; } }
        v2u shv[3][4];
#pragma unroll
        for (int m = 0; m < 3; ++m)
#pragma unroll
            for (int ct = 0; ct < 4; ++ct) { const v2u xw = rawc[m][ct], pw = rawp[m][ct];
                const f32x4 mm = *(const f32x4*)(mu + 512 * m + h * 64 + 16 * ct + 4 * q);
                const float x0 = bflo(xw.x), x1 = bfhi(xw.x), x2 = bflo(xw.y), x3 = bfhi(xw.y);
                shv[m][ct].x = pk2(x0 + (bflo(pw.x) - x0) * mm[0], x1 + (bfhi(pw.x) - x1) * mm[1]); shv[m][ct].y = pk2(x2 + (bflo(pw.y) - x2) * mm[2], x3 + (bfhi(pw.y) - x3) * mm[3]); }
        __syncthreads();
        f32x4 awl[4], aal[4], ag[4];
        { bf16x8 bwd[2], bad[2], bgd[4], wf2[2][8];
          RA_WLOAD(wf2[0], 2); RA_WLOAD(wf2[1], 3);
#pragma unroll
          for (int ks = 0; ks < 2; ++ks) { bwd[ks] = *(const LAS bf16x8*)(F.lds + RA_XWD + tokl * 144 + 64 * ks + 16 * q); bad[ks] = *(const LAS bf16x8*)(F.lds + RA_XAD + tokl * 144 + 64 * ks + 16 * q); }
#pragma unroll
          for (int ks = 0; ks < 4; ++ks) bgd[ks] = *(const LAS bf16x8*)(F.lds + RA_XGD + tokl * 272 + 64 * ks + 16 * q);
#pragma unroll
          for (int ct = 0; ct < 4; ++ct) { const bf16x8* wv = ct < 2 ? wfr[ct] : wf2[ct - 2];
              awl[ct] = (f32x4){0.f, 0.f, 0.f, 0.f}; aal[ct] = awl[ct]; ag[ct] = awl[ct];
#pragma unroll
              for (int ks = 0; ks < 2; ++ks) { awl[ct] = MFMA16(wv[ks], bwd[ks], awl[ct]); aal[ct] = MFMA16(wv[2 + ks], bad[ks], aal[ct]); }
#pragma unroll
              for (int ks = 0; ks < 4; ++ks) ag[ct] = MFMA16(wv[4 + ks], bgd[ks], ag[ct]); } }
#undef RA_WLOAD
        v2u rtp[4];
        {
#define RA_SHIFT(dst, pcol, ctv) do { const v2u w_ = shv[(pcol) / 512][ctv]; dst[0] = bflo(w_.x); dst[1] = bfhi(w_.x); dst[2] = bflo(w_.y); dst[3] = bfhi(w_.y); } while (0)
          float nrm = 0.f, bd = 0.f;
#pragma unroll
          for (int ct = 0; ct < 4; ++ct) { const int ch = h * 64 + 16 * ct + 4 * q;
              float r4[4], k4[4]; RA_SHIFT(r4, 0, ct); RA_SHIFT(k4, 512, ct);
              const f32x4 a0v = *(const f32x4*)(par + 512 + ch), kkv = *(const f32x4*)(par + 1024 + ch), kav = *(const f32x4*)(par + 1536 + ch), rkv = *(const f32x4*)(par + 2048 + ch);
#pragma unroll
              for (int i = 0; i < 4; ++i) { const float av = fast_sigmoid(a0v[i] + aal[ct][i]); const float kk = k4[i] * kkv[i]; nrm += kk * kk;
                  bd += r4[i] * (k4[i] * (1.0f + (av - 1.0f) * kav[i])) * rkv[i]; } }
          nrm = quad_sum(nrm); bd = quad_sum(bd);
          const float kinv = 1.0f / fmaxf(sqrtf(nrm), 1e-12f);
          float lw[4][4], lg[4][4], lgend[4][4];
#pragma unroll
          for (int ct = 0; ct < 4; ++ct) { const f32x4 w0v = *(const f32x4*)(par + h * 64 + 16 * ct + 4 * q);
#pragma unroll
              for (int i = 0; i < 4; ++i) { lw[ct][i] = (-0.6065306597126334f * LOG2E) * fast_sigmoid(w0v[i] + awl[ct][i]); float x = lw[ct][i];
                  x += __builtin_bit_cast(float, __builtin_amdgcn_update_dpp(0, __builtin_bit_cast(int, x), 0x111, 0xf, 0xf, false));
                  x += __builtin_bit_cast(float, __builtin_amdgcn_update_dpp(0, __builtin_bit_cast(int, x), 0x112, 0xf, 0xf, false));
                  x += __builtin_bit_cast(float, __builtin_amdgcn_update_dpp(0, __builtin_bit_cast(int, x), 0x114, 0xf, 0xf, false));
                  x += __builtin_bit_cast(float, __builtin_amdgcn_update_dpp(0, __builtin_bit_cast(int, x), 0x118, 0xf, 0xf, false));
                  lg[ct][i] = x; } }
          LAS float* wt = (LAS float*)(hbase + RA_WT);
          if (n16 == 15) {
#pragma unroll
              for (int ct = 0; ct < 4; ++ct) *(LAS f32x4*)(wt + w4 * 64 + 16 * ct + 4 * q) = (f32x4){lg[ct][0], lg[ct][1], lg[ct][2], lg[ct][3]}; }
          __syncthreads();
#pragma unroll
          for (int ct = 0; ct < 4; ++ct) { f32x4 off = {0.f, 0.f, 0.f, 0.f}, tot = {0.f, 0.f, 0.f, 0.f};
#pragma unroll
              for (int w = 0; w < 4; ++w) { const f32x4 t = *(const LAS f32x4*)(wt + w * 64 + 16 * ct + 4 * q); tot = tot + t; if (w < w4) off = off + t; }
#pragma unroll
              for (int i = 0; i < 4; ++i) { lg[ct][i] += off[i]; lgend[ct][i] = tot[i]; } }
#pragma unroll
          for (int ct = 0; ct < 4; ++ct) { const int ch = h * 64 + 16 * ct + 4 * q;
              float r4[4], k4[4], v4[4]; RA_SHIFT(r4, 0, ct); RA_SHIFT(k4, 512, ct); RA_SHIFT(v4, 1024, ct);
              const f32x4 a0v = *(const f32x4*)(par + 512 + ch), kkv = *(const f32x4*)(par + 1024 + ch), kav = *(const f32x4*)(par + 1536 + ch);
              const f32x4 lg_ = *(const f32x4*)(par + 2560 + ch), lb_ = *(const f32x4*)(par + 3072 + ch);
              float rtl[4], ktl[4], btl[4], atl[4], khh[4], bhh[4], g1[4], e2[4];
#pragma unroll
              for (int i = 0; i < 4; ++i) {
                  const float av = fast_sigmoid(a0v[i] + aal[ct][i]); const float k2 = k4[i] * (1.0f + (av - 1.0f) * kav[i]);
                  const float kkn = k4[i] * kkv[i] * kinv, bb = kkn * av;
                  const float gam = __builtin_amdgcn_exp2f(lg[ct][i]), gpv = __builtin_amdgcn_exp2f(lg[ct][i] - lw[ct][i]), gin = __builtin_amdgcn_exp2f(-lg[ct][i]), ger = __builtin_amdgcn_exp2f(lgend[ct][i] - lg[ct][i]);
                  rtl[i] = r4[i] * gam; ktl[i] = k2 * gin; btl[i] = bb * gin; atl[i] = -kkn * gpv; khh[i] = k2 * ger; bhh[i] = bb * ger;
                  const float g = ag[ct][i]; g1[i] = lg_[i] * g; e2[i] = (lb_[i] + bd * v4[i]) * g;
              }
              const int fo = ((w4 * 4 + ct) * 64 + l) * 8;
              v2u o; o.x = pk2(g1[0], g1[1]); o.y = pk2(g1[2], g1[3]); __builtin_nontemporal_store(o, (v2u*)(rbi + RB_G1T + fo));
              o.x = pk2(e2[0], e2[1]); o.y = pk2(e2[2], e2[3]); __builtin_nontemporal_store(o, (v2u*)(rbi + RB_E2T + fo));
              const int co = tokl * 144 + (16 * ct + 4 * q) * 2;
              o.x = pk2(rtl[0], rtl[1]); o.y = pk2(rtl[2], rtl[3]); *(LAS v2u*)(hbase + RA_RT + co) = o; rtp[ct] = o;
              o.x = pk2(ktl[0], ktl[1]); o.y = pk2(ktl[2], ktl[3]); *(LAS v2u*)(hbase + RA_KT + co) = o;
              o.x = pk2(btl[0], btl[1]); o.y = pk2(btl[2], btl[3]); *(LAS v2u*)(hbase + RA_BT + co) = o;
              o.x = pk2(atl[0], atl[1]); o.y = pk2(atl[2], atl[3]); *(LAS v2u*)(hbase + RA_AT + co) = o;
#pragma unroll
              for (int i = 0; i < 4; ++i) { const int ro = (16 * ct + 4 * q + i) * 144 + 2 * tslot;
                  if (tokl == 0) *(LAS float*)(hbase + RA_VT + (16 * ct + 4 * q + i) * 144 + 128) = __builtin_amdgcn_exp2f(lgend[ct][i]);
                  *(LAS unsigned short*)(hbase + RA_VT + ro) = (unsigned short)(pk2(v4[i], 0.f) & 0xffffu);
                  *(LAS unsigned short*)(hbase + RA_KH + ro) = (unsigned short)(pk2(khh[i], 0.f) & 0xffffu);
                  *(LAS unsigned short*)(hbase + RA_BH + ro) = (unsigned short)(pk2(bhh[i], 0.f) & 0xffffu); }
              asm volatile("" ::: "memory");
          }
#undef RA_SHIFT
        }
        __syncthreads();
        bf16x8 akp[2], rkp[2], rbp[2];
        { bf16x8 fa[2], fr[2];
#pragma unroll
          for (int ks = 0; ks < 2; ++ks) { fa[ks] = *(const LAS bf16x8*)(hbase + RA_AT + tokl * 144 + 64 * ks + 16 * q); fr[ks] = *(const LAS bf16x8*)(hbase + RA_RT + tokl * 144 + 64 * ks + 16 * q); }
          f32x4 aak[4], arkk[4], arb[4];
#pragma unroll
          for (int jt = 0; jt < 4; ++jt) {
              f32x4 tab = {0.f, 0.f, 0.f, 0.f}; aak[jt] = tab; arkk[jt] = tab; arb[jt] = tab;
              if (jt <= w4) {
#pragma unroll
                  for (int ks = 0; ks < 2; ++ks) { const bf16x8 fk = *(const LAS bf16x8*)(hbase + RA_KT + (16 * jt + n16) * 144 + 64 * ks + 16 * q), fb = *(const LAS bf16x8*)(hbase + RA_BT + (16 * jt + n16) * 144 + 64 * ks + 16 * q);
                      aak[jt] = MFMA16(fk, fa[ks], aak[jt]); tab = MFMA16(fb, fa[ks], tab); arkk[jt] = MFMA16(fk, fr[ks], arkk[jt]); arb[jt] = MFMA16(fb, fr[ks], arb[jt]); }
                  if (jt == w4) {
#pragma unroll
                      for (int i = 0; i < 4; ++i) { const int j = 4 * q + i; if (j >= n16) { aak[jt][i] = 0.f; tab[i] = 0.f; } if (j > n16) { arkk[jt][i] = 0.f; arb[jt][i] = 0.f; } } }
                  *(LAS f32x4*)(hbase + RA_AAB + tokl * 256 + (16 * jt + 4 * q) * 4) = tab;
              }
          }
#pragma unroll
          for (int s = 0; s < 2; ++s) { akp[s] = pack8(aak[2 * s], aak[2 * s + 1]); rkp[s] = pack8(arkk[2 * s], arkk[2 * s + 1]); rbp[s] = pack8(arb[2 * s], arb[2 * s + 1]); } }
        { f32x4 akv[4];
#pragma unroll
          for (int vt = 0; vt < 4; ++vt) { akv[vt] = (f32x4){0.f, 0.f, 0.f, 0.f};
#pragma unroll
              for (int s = 0; s < 2; ++s) { const bf16x8 fv = *(const LAS bf16x8*)(hbase + RA_VT + (16 * vt + n16) * 144 + 64 * s + 16 * q); akv[vt] = MFMA16(akp[s], fv, akv[vt]); } }
          __syncthreads();
#pragma unroll
          for (int vt = 0; vt < 4; ++vt) *(LAS f32x4*)(hbase + RA_RHS2 + (16 * vt + n16) * 272 + (16 * w4 + 4 * q) * 4) = akv[vt]; }
        if (pair + F.G < NITEM / 2) RA_REQUEST(pair + F.G);
        { const LAS unsigned char* aab = hbase + RA_AAB + (16 * w4) * 256 + (16 * w4) * 4;
          LAS unsigned char* ti = hbase + RA_BT;
          if (q == 0) { float t[16];
#pragma unroll
              for (int r_ = 0; r_ < 16; ++r_) { float acc = (r_ == n16) ? 1.0f : 0.0f;
#pragma unroll
                  for (int j4 = 0; j4 < (r_ + 3) / 4; ++j4) { const f32x4 av = *(const LAS f32x4*)(aab + r_ * 256 + j4 * 16);
#pragma unroll
                      for (int e = 0; e < 4; ++e) if (4 * j4 + e < r_) acc += av[e] * t[4 * j4 + e]; }
                  t[r_] = acc; *(LAS unsigned short*)(ti + w4 * 512 + r_ * 32 + 2 * n16) = (unsigned short)(pk2(acc, 0.f) & 0xffffu); } }
          __syncthreads();
          bf16x8 a10, a20, a30, a31, tf[4];
          { const LAS unsigned char* ab = hbase + RA_AAB + n16 * 256 + 16 * q; const f32x4 z4 = {0.f, 0.f, 0.f, 0.f};
            const f32x4 l10 = *(const LAS f32x4*)(ab + 16 * 256), l20 = *(const LAS f32x4*)(ab + 32 * 256), l21 = *(const LAS f32x4*)(ab + 32 * 256 + 64);
            const f32x4 l30 = *(const LAS f32x4*)(ab + 48 * 256), l31 = *(const LAS f32x4*)(ab + 48 * 256 + 64), l32 = *(const LAS f32x4*)(ab + 48 * 256 + 128);
            a10 = pack8(l10, z4); a20 = pack8(l20, l21); a30 = pack8(l30, l31); a31 = pack8(l32, z4);
#pragma unroll
            for (int I = 0; I < 4; ++I) { const v2u tw = *(const LAS v2u*)(ti + I * 512 + n16 * 32 + 8 * q); const v4u t4 = {tw.x, tw.y, 0u, 0u}; tf[I] = __builtin_bit_cast(bf16x8, t4); } }
          v4u xw[2][2];
#pragma unroll
          for (int m = 0; m < 2; ++m) {
              v4u x0 = {0u, 0u, 0u, 0u}, x1 = {0u, 0u, 0u, 0u};
#pragma unroll
              for (int I = 0; I < 4; ++I) {
                  f32x4 z;
                  if (m == 0) {
#pragma unroll
                      for (int i = 0; i < 4; ++i) z[i] = bf2f(*(const LAS unsigned short*)(hbase + RA_AT + (16 * I + 4 * q + i) * 144 + 2 * tokl)); }
                  else z = *(const LAS f32x4*)(hbase + RA_RHS2 + tokl * 272 + (16 * I + 4 * q) * 4);
                  if (I == 1) z = MFMA16(a10, __builtin_bit_cast(bf16x8, x0), z);
                  if (I == 2) z = MFMA16(a20, __builtin_bit_cast(bf16x8, x0), z);
                  if (I == 3) { z = MFMA16(a30, __builtin_bit_cast(bf16x8, x0), z); z = MFMA16(a31, __builtin_bit_cast(bf16x8, x1), z); }
                  const v4u zb = {pk2(z[0], z[1]), pk2(z[2], z[3]), 0u, 0u};
                  const f32x4 x = MFMA16(tf[I], __builtin_bit_cast(bf16x8, zb), ((f32x4){0.f, 0.f, 0.f, 0.f}));
                  const unsigned p0 = pk2(x[0], x[1]), p1 = pk2(x[2], x[3]);
                  if (I == 0) { x0.x = p0; x0.y = p1; } if (I == 1) { x0.z = p0; x0.w = p1; } if (I == 2) { x1.x = p0; x1.y = p1; } if (I == 3) { x1.z = p0; x1.w = p1; }
              }
              xw[m][0] = x0; xw[m][1] = x1;
          }
          __syncthreads();
#pragma unroll
          for (int s = 0; s < 2; ++s) { *(LAS v4u*)(hbase + RA_W1T + tokl * 144 + 64 * s + 16 * q) = xw[0][s]; *(LAS v4u*)(hbase + RA_W2T + tokl * 144 + 64 * s + 16 * q) = xw[1][s]; }
        }
        __syncthreads();
        {
          f32x4 pc[4], y0[4];
#pragma unroll
          for (int t = 0; t < 4; ++t) { pc[t] = (f32x4){bflo(rtp[t].x), bfhi(rtp[t].x), bflo(rtp[t].y), bfhi(rtp[t].y)}; y0[t] = (f32x4){0.f, 0.f, 0.f, 0.f};
#pragma unroll
              for (int s = 0; s < 2; ++s) { y0[t] = MFMA16(*(const LAS bf16x8*)(hbase + RA_VT + (16 * t + n16) * 144 + 64 * s + 16 * q), rkp[s], y0[t]);
                                            y0[t] = MFMA16(*(const LAS bf16x8*)(hbase + RA_W2T + (16 * t + n16) * 144 + 64 * s + 16 * q), rbp[s], y0[t]);
                                            pc[t] = MFMA16(*(const LAS bf16x8*)(hbase + RA_W1T + (16 * t + n16) * 144 + 64 * s + 16 * q), rbp[s], pc[t]); } }
#pragma unroll
          for (int vt = 0; vt < 4; ++vt) { v2u o; o.x = pk2(y0[vt][0], y0[vt][1]); o.y = pk2(y0[vt][2], y0[vt][3]); __builtin_nontemporal_store(o, (v2u*)(rbi + RB_YLT + ((w4 * 4 + vt) * 64 + l) * 8)); }
#pragma unroll
          for (int s = 0; s < 2; ++s) __builtin_nontemporal_store(pack8(pc[2 * s], pc[2 * s + 1]), (bf16x8*)(rbi + RB_PCT + ((w4 * 2 + s) * 64 + l) * 16));
          f32x4 mc[4]; bf16x8 fb[2], fvv[2];
#pragma unroll
          for (int s = 0; s < 2; ++s) { fb[s] = *(const LAS bf16x8*)(hbase + RA_BH + tokl * 144 + 64 * s + 16 * q); fvv[s] = *(const LAS bf16x8*)(hbase + RA_VT + tokl * 144 + 64 * s + 16 * q); }
          const float gend_k = *(const LAS float*)(hbase + RA_VT + tokl * 144 + 128);
#pragma unroll
          for (int t = 0; t < 4; ++t) { mc[t] = (f32x4){0.f, 0.f, 0.f, 0.f};
#pragma unroll
              for (int s = 0; s < 2; ++s) mc[t] = MFMA16(*(const LAS bf16x8*)(hbase + RA_W1T + (16 * t + n16) * 144 + 64 * s + 16 * q), fb[s], mc[t]);
              if (t == w4) {
#pragma unroll
                  for (int i = 0; i < 4; ++i) if (4 * q + i == n16) mc[t][i] += gend_k; } }
#pragma unroll
          for (int s = 0; s < 2; ++s) __builtin_nontemporal_store(pack8(mc[2 * s], mc[2 * s + 1]), (bf16x8*)(rbi + RB_MC + ((w4 * 2 + s) * 64 + l) * 16));
          bf16x8 fw2[2];
#pragma unroll
          for (int s = 0; s < 2; ++s) fw2[s] = *(const LAS bf16x8*)(hbase + RA_W2T + tokl * 144 + 64 * s + 16 * q);
#pragma unroll
          for (int kt = 0; kt < 4; ++kt) { f32x4 cc = {0.f, 0.f, 0.f, 0.f};
#pragma unroll
              for (int s = 0; s < 2; ++s) { cc = MFMA16(*(const LAS bf16x8*)(hbase + RA_KH + (16 * kt + n16) * 144 + 64 * s + 16 * q), fvv[s], cc);
                                            cc = MFMA16(*(const LAS bf16x8*)(hbase + RA_BH + (16 * kt + n16) * 144 + 64 * s + 16 * q), fw2[s], cc); }
              v2u cw; cw.x = pk2(cc[0], cc[1]); cw.y = pk2(cc[2], cc[3]); __builtin_nontemporal_store(cw, (v2u*)(rbi + RB_CC + ((w4 * 4 + kt) * 64 + l) * 8)); } }
    }
}

constexpr int RBK_NS = 9, RBK_D = 8, RBK_SLOT = 16384, RBK_BLOCKS = 32;
static_assert(RBK_NS * RBK_SLOT <= MISC_OFF && RBK_D == RBK_NS - 1, "phase B ring");
DI void rwkv_phase_b(const Frame& F, const Args& a) {
    if (F.bid >= RBK_BLOCKS) return;
    unsigned char* rb = a.ws + WS_RW; const int l = F.lane, w = F.wave;
    const int h = F.bid & 7, b = F.bid >> 3;
    LAS unsigned char* lds = F.lds;
    if (w >= 4) {
        const int j = w - 4;
#define RBK_ISSUE(cc_) do { const int c_ = (cc_) < NCHUNK ? (cc_) : NCHUNK - 1; const unsigned char* r_ = rb + (size_t)(((b * 128 + c_) << 3) + h) * RB_REC; \
            LAS unsigned char* slot_ = lds + ((cc_) % RBK_NS) * RBK_SLOT; \
            _Pragma("unroll") for (int k_ = 0; k_ < 4; ++k_) { const int blk_ = 4 * j + k_; \
                const unsigned char* src_ = blk_ < 8 ? r_ + RB_MC + blk_ * 1024 : r_ + RB_CC + (blk_ - 8) * 1024; \
                __builtin_amdgcn_global_load_lds((const unsigned*)(src_ + l * 16), (LAS unsigned*)(slot_ + blk_ * 1024), 16, 0, 0); } } while (0)
        for (int c = 0; c < RBK_D; ++c) RBK_ISSUE(c);
        for (int c = 0; c < NCHUNK; ++c) {
            asm volatile("s_waitcnt vmcnt(28)" ::: "memory");
            __builtin_amdgcn_s_barrier();
            RBK_ISSUE(c + RBK_D);
        }
        asm volatile("s_waitcnt vmcnt(0)" ::: "memory");
        __builtin_amdgcn_s_barrier();
#undef RBK_ISSUE
    } else {
        const int vs = w;
        f32x4 st[4];
#pragma unroll
        for (int kt = 0; kt < 4; ++kt) st[kt] = (f32x4){0.f, 0.f, 0.f, 0.f};
        for (int c = 0; c < NCHUNK; ++c) {
            unsigned char* rbi = rb + (size_t)(((b * 128 + c) << 3) + h) * RB_REC;
            bf16x8 sb[2];
#pragma unroll
            for (int s = 0; s < 2; ++s) { sb[s] = pack8(st[2 * s], st[2 * s + 1]); *(bf16x8*)(rbi + RB_SC + ((vs * 2 + s) * 64 + l) * 16) = sb[s]; }
            __builtin_amdgcn_s_barrier();
            const LAS unsigned char* slot = lds + (c % RBK_NS) * RBK_SLOT;
#pragma unroll
            for (int kt = 0; kt < 4; ++kt) { const v2u cw = *(const LAS v2u*)(slot + 8192 + ((vs * 4 + kt) * 64 + l) * 8);
                f32x4 n = {bflo(cw.x), bfhi(cw.x), bflo(cw.y), bfhi(cw.y)};
#pragma unroll
                for (int s = 0; s < 2; ++s) n = MFMA16(*(const LAS bf16x8*)(slot + ((kt * 2 + s) * 64 + l) * 16), sb[s], n);
                st[kt] = n; }
        }
        __builtin_amdgcn_s_barrier();
    }
}

struct RcOps { bf16x8 pc[2]; v2u yl[4]; bf16x8 sc[4][2]; v2u g1[4], e2[4]; };
DI void rc_load(RcOps& o, const unsigned char* rb, int task, int l) {
    const int item = task >> 2, it = task & 3; const unsigned char* rbi = rb + (size_t)item * RB_REC;
#pragma unroll
    for (int s = 0; s < 2; ++s) o.pc[s] = __builtin_nontemporal_load((const bf16x8*)(rbi + RB_PCT + ((it * 2 + s) * 64 + l) * 16));
#pragma unroll
    for (int vt = 0; vt < 4; ++vt) { const int fo = ((it * 4 + vt) * 64 + l) * 8;
        o.yl[vt] = __builtin_nontemporal_load((const v2u*)(rbi + RB_YLT + fo)); o.g1[vt] = __builtin_nontemporal_load((const v2u*)(rbi + RB_G1T + fo)); o.e2[vt] = __builtin_nontemporal_load((const v2u*)(rbi + RB_E2T + fo));
#pragma unroll
        for (int s = 0; s < 2; ++s) o.sc[vt][s] = __builtin_nontemporal_load((const bf16x8*)(rbi + RB_SC + ((vt * 2 + s) * 64 + l) * 16)); }
}
DI void rwkv_phase_c(const Frame& F, const Args& a) {
    const unsigned char* rb = a.ws + WS_RW; bf16* mix = (bf16*)(a.ws + WS_MIX);
    const int l = F.lane, n16 = l & 15, q = l >> 4;
    const int gw = F.bid * NWAVES + F.wave, NGW = F.G * NWAVES;
    RcOps cur, nxt;
    if (gw < NITEM * 4) rc_load(cur, rb, gw, l);
    for (int task = gw; task < NITEM * 4; task += NGW) {
        const int item = task >> 2, it = task & 3, h = item & 7, c = (item >> 3) & 127, b = item >> 10;
        if (task + NGW < NITEM * 4) rc_load(nxt, rb, task + NGW, l);
        f32x4 y[4]; float sum = 0.f;
#pragma unroll
        for (int vt = 0; vt < 4; ++vt) { y[vt] = (f32x4){bflo(cur.yl[vt].x), bfhi(cur.yl[vt].x), bflo(cur.yl[vt].y), bfhi(cur.yl[vt].y)};
#pragma unroll
            for (int s = 0; s < 2; ++s) y[vt] = MFMA16(cur.sc[vt][s], cur.pc[s], y[vt]);
            sum += (y[vt][0] + y[vt][1]) + (y[vt][2] + y[vt][3]); }
        sum = quad_sum(sum);
        const float mean = sum * (1.f / 64.f); float sq = 0.f;
#pragma unroll
        for (int vt = 0; vt < 4; ++vt) { y[vt] = y[vt] - mean; sq += (y[vt][0] * y[vt][0] + y[vt][1] * y[vt][1]) + (y[vt][2] * y[vt][2] + y[vt][3] * y[vt][3]); }
        sq = quad_sum(sq);
        const float rstd = 1.0f / sqrtf(sq * (1.f / 64.f) + 64e-5f);
        const size_t tok = (size_t)b * SEQ + c * 64 + 16 * it + n16;
#pragma unroll
        for (int vt = 0; vt < 4; ++vt) { const v2u g = cur.g1[vt], e = cur.e2[vt];
            v2u o; o.x = pk2(y[vt][0] * rstd * bflo(g.x) + bflo(e.x), y[vt][1] * rstd * bfhi(g.x) + bfhi(e.x)); o.y = pk2(y[vt][2] * rstd * bflo(g.y) + bflo(e.y), y[vt][3] * rstd * bfhi(g.y) + bfhi(e.y));
            *(v2u*)(mix + tok * 1024 + 512 + h * 64 + 16 * vt + 4 * q) = o; }
        cur = nxt;
    }
}
#endif

DI void p0_prologue(const Frame& F, const Args& a) {
    unsigned char* ws = a.ws;
    LAS float* scr = (LAS float*)(F.lds + F.wave * 16384);
    const int gw = F.bid * NWAVES + F.wave, NGW = F.G * NWAVES;
    constexpr int I_IN = 0, I_OUT = 16 * 32, I_DEC = 16, I_AAA = 16, I_GATE = 32;
    constexpr int NITEMS = I_IN + I_OUT + I_DEC + I_AAA + I_GATE;
    for (int s = F.G - 1 - F.bid; s < INC / 32; s += F.G) { q_strip_i8_wg(a.in[I_WIN], INC, 32 * s, ws + WS_WIN, (float*)(ws + WS_COLSC1), F.wave, F.lane, (LAS float*)F.lds); __syncthreads(); }
    for (int it = gw; it < NITEMS; it += NGW) {
        int r = it;
        if (r < I_OUT) { const int kb = r / 32, nb = r % 32; tr_item(a.in[I_WOUT], 1024, 64 * kb, 32 * nb, (bf16*)(ws + WS_WOUT), 1024, 32 * nb, scr, F.lane, nullptr); continue; } r -= I_OUT;
        if (r < I_DEC) { tr_item(a.in[I_WDEC], 512, 0, 32 * r, (bf16*)(ws + WS_WDEC), 64, 32 * r, scr, F.lane, nullptr); continue; } r -= I_DEC;
        if (r < I_AAA) { tr_item(a.in[I_WAAA], 512, 0, 32 * r, (bf16*)(ws + WS_WAAA), 64, 32 * r, scr, F.lane, nullptr); continue; } r -= I_AAA;
        { const int kb = r / 16, nb = r % 16; tr_item(a.in[I_WGATE], 512, 64 * kb, 32 * nb, (bf16*)(ws + WS_WGATE), 128, 32 * nb, scr, F.lane, nullptr); }
    }
    { float* wrt = (float*)(ws + WS_WRT); const float* wr = a.in[I_WR]; const float* g2 = a.in[I_N2G];
      for (int i = F.bid * 512 + F.tid; i < 32 * 1024; i += F.G * 512) { const int e = i >> 10, k = i & 1023; wrt[i] = g2[k] * wr[k * 32 + e]; } }
    { float* par = (float*)(ws + WS_PAR); const int srcs[7] = {I_W0, I_A0, I_KK, I_KA, I_RK, I_LNG, I_LNB};
      for (int i = F.bid * 512 + F.tid; i < 7 * 512; i += F.G * 512) { const int k = i >> 9; float v = 0.f;
#pragma unroll
          for (int j = 0; j < 7; ++j) if (k == j) v = a.in[srcs[j]][i & 511];
          par[i] = v; } }
    { const float* x = a.in[I_X]; const float* g1 = a.in[I_N1G]; bf16* xn = (bf16*)(ws + WS_XN);
      f32x4 gv[4];
#pragma unroll
      for (int j = 0; j < 4; ++j) gv[j] = *((const f32x4*)g1 + F.lane + 64 * j);
      for (int m0 = 2 * gw; m0 < T; m0 += 2 * NGW) {
          f32x4 v[2][4];
#pragma unroll
          for (int r = 0; r < 2; ++r) { const f32x4* xr = (const f32x4*)(x + (size_t)(m0 + r) * D) + F.lane;
#pragma unroll
              for (int j = 0; j < 4; ++j) v[r][j] = __builtin_nontemporal_load(xr + 64 * j); }
#pragma unroll
          for (int r = 0; r < 2; ++r) { float s = 0.f;
#pragma unroll
              for (int j = 0; j < 4; ++j) s += (v[r][j].x * v[r][j].x + v[r][j].y * v[r][j].y) + (v[r][j].z * v[r][j].z + v[r][j].w * v[r][j].w);
              const float rs = 1.0f / sqrtf(wave_sum(s) * (1.f / D) + 1e-6f);
              f32x4 y[4]; float am = 0.f;
#pragma unroll
              for (int j = 0; j < 4; ++j) { y[j] = (v[r][j] * rs) * gv[j]; am = fmaxf(fmaxf(am, fmaxf(fabsf(y[j].x), fabsf(y[j].y))), fmaxf(fabsf(y[j].z), fabsf(y[j].w))); }
              am = wave_max(am); const float qi = am > 0.f ? 127.0f / am : 0.f;
              if (F.lane == 0) ((float*)(ws + WS_XNSC))[m0 + r] = am * (1.0f / 127.0f);
              unsigned* o4 = (unsigned*)((unsigned char*)xn + (size_t)(m0 + r) * D) + F.lane;
#pragma unroll
              for (int j = 0; j < 4; ++j) { const f32x4 qv = y[j] * qi + Q_MAGIC; o4[64 * j] = q_pack4(qv.x, qv.y, qv.z, qv.w); } }
      } }
}

#if NAIVE_RWKV
DI void rwkv_naive_prep(const Frame& F, const Args& a) {
    const bf16* proj = (const bf16*)(a.ws + WS_PROJ); LAS float* sx = (LAS float*)F.lds;
    float* RW = (float*)(a.ws + WS_RW); float* GG = (float*)(a.ws + WS_XN);
    const float* mu = a.in[I_MU]; const int c = F.tid;
    for (int t = F.bid; t < T; t += F.G) {
        const bool first = (t % SEQ) == 0; const bf16* cur = proj + (size_t)t * INC + PRW; const bf16* prv = cur - INC;
#define SH_(col) ({ const float x_ = bf2f(cur[col]); const float p_ = first ? 0.f : bf2f(prv[col]); x_ + (p_ - x_) * mu[col]; })
        if (c < 256) { const float v = SH_(1536 + c); sx[c] = c < 64 ? tanhf(v) : (c < 128 ? v : sigmoidf_(v)); }
        __syncthreads();
        const float r = SH_(c), k = SH_(512 + c), v = SH_(1024 + c);
#undef SH_
        float wl = a.in[I_W0][c], al = a.in[I_A0][c], g = 0.f;
        const float* wdec = a.in[I_WDEC] + c; const float* waaa = a.in[I_WAAA] + c; const float* wgate = a.in[I_WGATE] + c;
#pragma unroll 4
        for (int j = 0; j < 64; ++j) { wl += sx[j] * wdec[j * 512]; al += sx[64 + j] * waaa[j * 512]; }
#pragma unroll 4
        for (int j = 0; j < 128; ++j) g += sx[128 + j] * wgate[j * 512];
        const float dec = __expf(-0.6065306597126334f * sigmoidf_(wl)), av = sigmoidf_(al);
        float kk = k * a.in[I_KK][c]; const float n2 = wave_sum(kk * kk); kk = kk / fmaxf(sqrtf(n2), 1e-12f);
        const float k2 = k * (1.0f + (av - 1.0f) * a.in[I_KA][c]);
        const size_t o = (size_t)t * 512 + c; const size_t S1 = (size_t)T * 512;
        RW[o] = r; RW[S1 + o] = dec; RW[2 * S1 + o] = k2; RW[3 * S1 + o] = v; RW[4 * S1 + o] = kk; RW[5 * S1 + o] = av; GG[o] = g;
        __syncthreads();
    }
}
DI void rwkv_naive_scan(const Frame& F, const Args& a) {
    if (F.bid >= 32 || F.wave != 0) return;
    const int b = F.bid >> 3, h = F.bid & 7, l = F.lane, c = h * 64 + l;
    const float* RW = (const float*)(a.ws + WS_RW); const float* GG = (const float*)(a.ws + WS_XN); bf16* mix = (bf16*)(a.ws + WS_MIX);
    const size_t S1 = (size_t)T * 512; LAS float* sh = (LAS float*)F.lds;
    LAS float* st = sh + 512 + l;
    for (int k = 0; k < 64; ++k) st[64 * k] = 0.f;
    const float rk = a.in[I_RK][c], lg = a.in[I_LNG][c], lb = a.in[I_LNB][c];
    for (int s = 0; s < SEQ; ++s) {
        const size_t o = (size_t)(b * SEQ + s) * 512 + c;
        const float r = RW[o], w = RW[S1 + o], k2 = RW[2 * S1 + o], v = RW[3 * S1 + o], kk = RW[4 * S1 + o], av = RW[5 * S1 + o], g = GG[o];
        sh[l] = r; sh[64 + l] = w; sh[128 + l] = k2; sh[192 + l] = kk; sh[256 + l] = kk * av;
        LDS_WAIT();
        float sa = 0.f;
#pragma unroll 8
        for (int k = 0; k < 64; ++k) sa -= st[64 * k] * sh[192 + k];
        float y = 0.f;
#pragma unroll 8
        for (int k = 0; k < 64; ++k) { const float nv = st[64 * k] * sh[64 + k] + sa * sh[256 + k] + v * sh[128 + k]; st[64 * k] = nv; y += nv * sh[k]; }
        LDS_WAIT();
        const float mean = wave_sum(y) * (1.f / 64.f); const float d = y - mean; const float var = wave_sum(d * d) * (1.f / 64.f);
        const float yn = d * (1.0f / sqrtf(var + 64e-5f));
        const float bonus = wave_sum(r * k2 * rk) * v;
        const float outv = (yn * lg + lb + bonus) * g;
        mix[(size_t)(b * SEQ + s) * 1024 + 512 + c] = (bf16)(pk2(outv, 0.f) & 0xffffu);
    }
}
#endif
#if NAIVE_ATT
DI void attn_naive(const Frame& F, const Args& a) {
    const bf16* proj = (const bf16*)(a.ws + WS_PROJ); bf16* mix = (bf16*)(a.ws + WS_MIX);
    LAS float* sq = (LAS float*)(F.lds + F.wave * 1024);
    const int gw = F.bid * NWAVES + F.wave, NGW = F.G * NWAVES, l = F.lane;
    const float qg = a.in[I_QG][l];
    for (int it = gw; it < T * 8; it += NGW) {
        const int t = it >> 3, h = it & 7, b = t / SEQ, s = t % SEQ, n = s >> 6;
        const float qd = bf2f(proj[(size_t)t * INC + h * 64 + l]);
        const float qn = qd * (1.0f / sqrtf(wave_sum(qd * qd) * (1.f / 64.f) + 1e-6f)) * qg * 0.125f;
        sq[l] = qn; LDS_WAIT();
        float sc[9]; float mx = -3.0e38f;
#pragma unroll
        for (int r = 0; r < 9; ++r) {
            const int kp = (n - 8) * 64 + 64 * r + l; float v = -3.0e38f;
            if (kp >= 0) {
                const v4u* kr = (const v4u*)(proj + (size_t)(b * SEQ + kp) * INC + 512 + h * 64);
                float ss = 0.f, dot = 0.f;
#pragma unroll
                for (int j = 0; j < 8; ++j) { const v4u w = kr[j]; const unsigned ww[4] = {w.x, w.y, w.z, w.w};
#pragma unroll
                    for (int e = 0; e < 4; ++e) { const float k0 = bflo(ww[e]), k1 = bfhi(ww[e]); const int d0 = 8 * j + 2 * e;
                        ss += k0 * k0 + k1 * k1; dot += sq[d0] * a.in[I_KG][d0] * k0 + sq[d0 + 1] * a.in[I_KG][d0 + 1] * k1; } }
                int rel = kp - s; rel = rel < -128 ? -128 : (rel > 63 ? 63 : rel);
                v = dot * (1.0f / sqrtf(ss * (1.f / 64.f) + 1e-6f)) + a.in[I_RELB][h * 192 + rel + 128];
            }
            sc[r] = v; mx = fmaxf(mx, v);
        }
        mx = wave_max(mx); float sum = 0.f;
#pragma unroll
        for (int r = 0; r < 9; ++r) { sc[r] = (sc[r] > -1.0e38f) ? __expf(sc[r] - mx) : 0.f; sum += sc[r]; }
        sum = wave_sum(sum);
        float o = 0.f;
#pragma unroll
        for (int r = 0; r < 9; ++r) {
            const int kp0 = (n - 8) * 64 + 64 * r;
            if (kp0 >= 0) {
                const bf16* vp = proj + (size_t)(b * SEQ + kp0) * INC + 1024 + h * 64 + l;
                for (int key = 0; key < 64; ++key) o += __shfl(sc[r], key) * bf2f(vp[(size_t)key * INC]);
            }
        }
        mix[(size_t)t * 1024 + h * 64 + l] = (bf16)(pk2(o / sum, 0.f) & 0xffffu);
        LDS_WAIT();
    }
}
#endif

DI void p6_router(const Frame& F, const Args& a) {
    unsigned char* ws = a.ws; const bf16* x1 = (const bf16*)(ws + WS_XN); const float* wrt = (const float*)(ws + WS_WRT); const float* br = a.in[I_BR];
    int* eidx = (int*)(ws + WS_EIDX); float* gate = (float*)(ws + WS_GATE); int* lrank = (int*)(ws + WS_LRANK); float* rstd = (float*)(ws + WS_RSTD); int* cnt = (int*)(ws + WS_CNT);
    constexpr int WROW = 2064, WIMG = 32 * WROW;
    LAS int* hist = (LAS int*)(F.lds + 2 * WIMG);
    const int n = F.lane & 15, q = F.lane >> 4;
    for (int i = F.tid; i < 32 * 256; i += NWAVES * 64) { const int e = i >> 8, c4 = i & 255; const f32x4 w = *((const f32x4*)(wrt + (size_t)e * D) + c4);
        v2u hi, lo; hi.x = pk2(w[0], w[1]); hi.y = pk2(w[2], w[3]);
        lo.x = pk2(w[0] - bflo(hi.x), w[1] - bfhi(hi.x)); lo.y = pk2(w[2] - bflo(hi.y), w[3] - bfhi(hi.y));
        *(LAS v2u*)(F.lds + e * WROW + c4 * 8) = hi; *(LAS v2u*)(F.lds + WIMG + e * WROW + c4 * 8) = lo; }
    __syncthreads();
    for (int tile = F.bid; tile < T / 128; tile += F.G) {
        if (F.tid < 32) hist[F.tid] = 0;
        __syncthreads();
        const int tok = tile * 128 + F.wave * 16 + n;
        const v4u* xr = (const v4u*)(x1 + (size_t)tok * D) + q; const LAS unsigned char* w0 = F.lds + n * WROW + 16 * q;
        f32x4 acc0 = {0.f, 0.f, 0.f, 0.f}, acc1 = {0.f, 0.f, 0.f, 0.f}; float ssq = 0.f, amax = 0.f;
        for (int S0 = 0; S0 < 32; S0 += 16) {
            v4u xw[16];
#pragma unroll
            for (int s = 0; s < 16; ++s) xw[s] = xr[4 * (S0 + s)];
#pragma unroll
            for (int s = 0; s < 16; ++s) { const bf16x8 xb8 = __builtin_bit_cast(bf16x8, xw[s]); const LAS unsigned char* wp = w0 + (S0 + s) * 64;
                const unsigned u[4] = {xw[s].x, xw[s].y, xw[s].z, xw[s].w};
#pragma unroll
                for (int j = 0; j < 4; ++j) { const float a = bflo(u[j]), b = bfhi(u[j]); ssq += a * a + b * b; amax = fmaxf(amax, fmaxf(fabsf(a), fabsf(b))); }
                acc0 = __builtin_amdgcn_mfma_f32_16x16x32_bf16(*(const LAS bf16x8*)(wp), xb8, acc0, 0, 0, 0);
                acc0 = __builtin_amdgcn_mfma_f32_16x16x32_bf16(*(const LAS bf16x8*)(wp + WIMG), xb8, acc0, 0, 0, 0);
                acc1 = __builtin_amdgcn_mfma_f32_16x16x32_bf16(*(const LAS bf16x8*)(wp + 16 * WROW), xb8, acc1, 0, 0, 0);
                acc1 = __builtin_amdgcn_mfma_f32_16x16x32_bf16(*(const LAS bf16x8*)(wp + WIMG + 16 * WROW), xb8, acc1, 0, 0, 0); }
        }
        ssq = quad_sum(ssq); amax = quad_max(amax);
        const float rs = 1.0f / sqrtf(ssq * (1.f / D) + 1e-6f);
        float lg[8];
#pragma unroll
        for (int i = 0; i < 4; ++i) { lg[i] = acc0[i] * rs + br[4 * q + i]; lg[4 + i] = acc1[i] * rs + br[16 + 4 * q + i]; }
        float tv[4]; int ti[4];
#pragma unroll
        for (int r = 0; r < 4; ++r) {
            float bv = -3.0e38f; int bi = 0;
#pragma unroll
            for (int j = 0; j < 8; ++j) { const int e = (j < 4 ? 0 : 16) + 4 * q + (j & 3); if (lg[j] > bv) { bv = lg[j]; bi = e; } }
#pragma unroll
            for (int o = 16; o <= 32; o <<= 1) { const float ov = __shfl_xor(bv, o); const int oi = __shfl_xor(bi, o); if (ov > bv || (ov == bv && oi < bi)) { bv = ov; bi = oi; } }
            tv[r] = bv; ti[r] = bi;
#pragma unroll
            for (int j = 0; j < 8; ++j) { const int e = (j < 4 ? 0 : 16) + 4 * q + (j & 3); if (e == bi) lg[j] = -3.0e38f; }
        }
        if (q == 0) {
            const float e1 = __expf(tv[1] - tv[0]), e2 = __expf(tv[2] - tv[0]), e3 = __expf(tv[3] - tv[0]); const float inv = 1.0f / (1.0f + e1 + e2 + e3);
            int lr[4];
#pragma unroll
            for (int r = 0; r < 4; ++r) lr[r] = atomicAdd((int*)&hist[ti[r]], 1);
            *(int4*)(eidx + (size_t)tok * 4) = make_int4(ti[0], ti[1], ti[2], ti[3]);
            *(float4*)(gate + (size_t)tok * 4) = make_float4(inv, e1 * inv, e2 * inv, e3 * inv);
            *(int4*)(lrank + (size_t)tok * 4) = make_int4(lr[0], lr[1], lr[2], lr[3]);
            rstd[tok] = rs * amax * (1.0f / 127.0f);
        }
        { const float qinv = amax > 0.f ? 127.0f / amax : 0.f; unsigned char* xq = ws + WS_XQ;
            for (int i0 = 0; i0 < 16; i0 += 4) { v4u xa[4], xb2[4];
#pragma unroll
                for (int i = 0; i < 4; ++i) { const v4u* p = (const v4u*)(x1 + (size_t)(tile * 128 + F.wave * 16 + i0 + i) * D) + 2 * F.lane; xa[i] = p[0]; xb2[i] = p[1]; }
#pragma unroll
                for (int i = 0; i < 4; ++i) { const float sc = __builtin_bit_cast(float, __builtin_amdgcn_readlane(__builtin_bit_cast(int, qinv), i0 + i));
                    const unsigned u[8] = {xa[i].x, xa[i].y, xa[i].z, xa[i].w, xb2[i].x, xb2[i].y, xb2[i].z, xb2[i].w}; v4u o;
#pragma unroll
                    for (int d = 0; d < 4; ++d) { const f32x2 lo = {bflo(u[2 * d]), bfhi(u[2 * d])}, hi = {bflo(u[2 * d + 1]), bfhi(u[2 * d + 1])};
                        const f32x2 ql = lo * sc + Q_MAGIC, qh = hi * sc + Q_MAGIC; o[d] = q_pack4(ql.x, ql.y, qh.x, qh.y); }
                    *((v4u*)(xq + (size_t)(tile * 128 + F.wave * 16 + i0 + i) * D) + F.lane) = o; } }
        }
        __syncthreads();
        if (F.tid < 32) cnt[tile * 32 + F.tid] = hist[F.tid];
        __syncthreads();
    }
}

DI void p7_permute(const Frame& F, const Args& a) {
    unsigned char* ws = a.ws; const int* cnt = (const int*)(ws + WS_CNT); int* meta = (int*)(ws + WS_META);
    const int* eidx = (const int*)(ws + WS_EIDX); const int* lrank = (const int*)(ws + WS_LRANK); int* inv = (int*)(ws + WS_INV);
    const float* rstd = (const float*)(ws + WS_RSTD); float* rowrstd = (float*)(ws + WS_ROWRSTD);
    bf16* xb = (bf16*)(ws + WS_XN); int* rowtok = (int*)(ws + WS_ROWTOK);
    LAS int* s_tot = (LAS int*)F.lds; LAS int* s_pst = s_tot + 32; LAS int* s_base = s_tot + 64; LAS int* s_part = s_tot + 128;
    { const int e = F.tid & 31, part = F.tid >> 5; int s = 0; for (int t = part * 16; t < part * 16 + 16; ++t) s += cnt[t * 32 + e]; s_part[part * 32 + e] = s; }
    __syncthreads();
    if (F.tid < 32) { int s = 0; for (int p = 0; p < 16; ++p) s += s_part[p * 32 + F.tid]; s_tot[F.tid] = s; }
    __syncthreads();
    if (F.tid < 32) { int ps = 0; for (int e = 0; e < F.tid; ++e) ps += (s_tot[e] + 255) / 256 * 256; s_pst[F.tid] = ps; }
    __syncthreads();
    if (F.bid == 0 && F.tid < 32) { const int e = F.tid, nb = (s_tot[e] + 255) / 256, rb0 = s_pst[e] / 256; for (int i = 0; i < nb; ++i) meta[16 + rb0 + i] = e; if (e == 31) meta[0] = rb0 + nb; }
    if (F.bid < 32) { const int e = F.bid, r0 = s_pst[e] + s_tot[e], r1 = s_pst[e] + (s_tot[e] + 255) / 256 * 256;
        for (int r = r0 + F.tid; r < r1; r += NWAVES * 64) { rowtok[r] = T; rowrstd[r] = 0.f; } }
    if (F.bid == 0 && F.tid < 64) { const v4u z = {0u, 0u, 0u, 0u}; *((v4u*)(ws + WS_XQ + (size_t)T * D) + F.tid) = z; }
    for (int tile = F.bid; tile < T / 128; tile += F.G) {
        __syncthreads();
        if (F.tid < 32) { int s = 0; for (int t = 0; t < tile; ++t) s += cnt[t * 32 + F.tid]; s_base[F.tid] = s_pst[F.tid] + s; }
        __syncthreads();
        { const int i = F.tid;
            const int tok = tile * 128 + (i >> 2), k = i & 3; const int e = eidx[tok * 4 + k]; const int dest = s_base[e] + lrank[tok * 4 + k];
            inv[tok * 4 + k] = dest; rowtok[dest] = tok; rowrstd[dest] = rstd[tok];
        }
    }
}

DI void p10_combine(const Frame& F, const Args& a) {
    unsigned char* ws = a.ws; const int* inv = (const int*)(ws + WS_INV); const float* gate = (const float*)(ws + WS_GATE); const bf16* yr = (const bf16*)(ws + WS_YR); const bf16* xb = (const bf16*)(ws + WS_XN); float* out = a.out;
    const int gw = F.bid * NWAVES + F.wave, NGW = F.G * NWAVES;
    for (int t = gw; t < T; t += NGW) {
        const int4 iv = *(const int4*)(inv + (size_t)t * 4); const float4 gv = *(const float4*)(gate + (size_t)t * 4);
        const int rows[4] = {iv.x, iv.y, iv.z, iv.w}; const float gs[4] = {gv.x, gv.y, gv.z, gv.w};
        f32x4* o = (f32x4*)(out + (size_t)t * D) + F.lane; const v2u* xr = (const v2u*)(xb + (size_t)t * D) + F.lane;
#pragma unroll
        for (int j = 0; j < 4; ++j) {
            const v2u xw = xr[64 * j]; f32x4 acc = {bflo(xw.x), bfhi(xw.x), bflo(xw.y), bfhi(xw.y)};
#pragma unroll
            for (int k = 0; k < 4; ++k) { const v2u w = __builtin_nontemporal_load((const v2u*)(yr + (size_t)rows[k] * D) + F.lane + 64 * j);
                acc.x += gs[k] * bflo(w.x); acc.y += gs[k] * bfhi(w.x); acc.z += gs[k] * bflo(w.y); acc.w += gs[k] * bfhi(w.y); }
            __builtin_nontemporal_store(acc, o + 64 * j);
        }
    }
}

constexpr int N_PHASES = 11;
__global__ void __launch_bounds__(NWAVES * 64, 2) fwd(Args args) {
    extern __shared__ __attribute__((aligned(16))) unsigned char lds[];
    Frame F;
    F.lds = (LAS unsigned char*)lds;
    F.tid = threadIdx.x; F.lane = F.tid & 63; F.wave = __builtin_amdgcn_readfirstlane(F.tid >> 6);
    F.G = gridDim.x; F.bid = blockIdx.x;
    volatile LAS unsigned* MISC = (volatile LAS unsigned*)(F.lds + MISC_OFF);
    if (F.tid < 64) MISC[F.tid] = 0u;
    __syncthreads();
    unsigned char* ws = args.ws;
    unsigned* ctl = (unsigned*)(ws + WS_CTL);
    XcdBarrier bar; bar.bar = ctl + CW_BAR; bar.x = 0; bar.st = nullptr;
    if (MK_N_LAUNCHES == 1) bar = xcd_barrier_post(ctl + CW_BAR, MISC + 8);
    const int lo = args.ph_lo, hi = args.ph_hi;
#ifndef PHASE_MASK
#define PHASE_MASK 0xffff
#endif
#define IN(k) (((PHASE_MASK >> (k)) & 1) && lo <= (k) && (k) < hi)
#ifndef DUP_PHASE
#define DUP_PHASE -1
#endif
#define REPS(k) ((DUP_PHASE >= 0 && (k) == DUP_PHASE) ? args.ph_rep : 1)
#define SEAM(k) do { if (IN(k) && IN((k) + 1)) xcd_barrier(bar); { int t_ = threadIdx.x; asm volatile("" : "+v"(t_)); F.tid = t_; F.lane = t_ & 63; } } while (0)

    for (int rep_ = 0; rep_ < REPS(0); ++rep_) { if (rep_) xcd_barrier(bar);
    if (IN(0)) { p0_prologue(F, args); } } SEAM(0);

    for (int rep_ = 0; rep_ < REPS(1); ++rep_) { if (rep_) xcd_barrier(bar);
    if (IN(1)) {
        pg8::Gemm g{(const bf16*)(ws + WS_XN), (const bf16*)(ws + WS_WIN), T, INC, D / 2}; pg8::StaticOrder S; S.init(T, INC, F.G, F.bid);
        pg8::EpiBf16Q E{(bf16*)(ws + WS_PROJ), INC, (const float*)(ws + WS_XNSC), (const float*)(ws + WS_COLSC1)};
        pg8::gemm_phase<pg8::EpiBf16Q, pg8::StaticOrder, true, true>(F.lds, g, S, E);
    } } SEAM(1);

    for (int rep_ = 0; rep_ < REPS(2); ++rep_) { if (rep_) xcd_barrier(bar);
    if (IN(2)) {
#if NAIVE_RWKV
        rwkv_naive_prep(F, args);
#else
        rwkv_phase_a(F, args);
#endif
    } } SEAM(2);

    for (int rep_ = 0; rep_ < REPS(3); ++rep_) { if (rep_) xcd_barrier(bar);
    if (IN(3)) {
#if NAIVE_RWKV
        rwkv_naive_scan(F, args);
#else
        rwkv_phase_b(F, args);
#endif
        __syncthreads();
#if NAIVE_ATT
        attn_naive(F, args);
#else
        attn_phase(F, args, rep_);
#endif
    } } SEAM(3);

    for (int rep_ = 0; rep_ < REPS(4); ++rep_) { if (rep_) xcd_barrier(bar);
    if (IN(4)) {
#if !NAIVE_RWKV
        rwkv_phase_c(F, args);
#endif
    } } SEAM(4);

    for (int rep_ = 0; rep_ < REPS(5); ++rep_) { if (rep_) xcd_barrier(bar);
    if (IN(5)) {
        pg8::Gemm g{(const bf16*)(ws + WS_MIX), (const bf16*)(ws + WS_WOUT), T, D, D}; pg8::StaticOrder S; S.init(T, D, F.G, F.bid);
        pg8::EpiResid E{args.in[I_X], nullptr, (bf16*)(ws + WS_XN), D};
        pg8::gemm_phase<pg8::EpiResid, pg8::StaticOrder, true, true>(F.lds, g, S, E);
    } } SEAM(5);

    for (int rep_ = 0; rep_ < REPS(6); ++rep_) { if (rep_) xcd_barrier(bar);
    if (IN(6)) { p6_router(F, args); } } SEAM(6);
    for (int rep_ = 0; rep_ < REPS(7); ++rep_) { if (rep_) xcd_barrier(bar);
    if (IN(7)) { p7_permute(F, args); } } SEAM(7);

    for (int rep_ = 0; rep_ < REPS(8); ++rep_) { if (rep_) xcd_barrier(bar);
    if (IN(8)) {
        pg8::Gemm g{(const bf16*)(ws + WS_XQ), (const bf16*)(ws + WS_WUP), NROWS_MAX, 2048, D / 2};
        pg8::MoeOrder<true> S{(const int*)(ws + WS_META), 8, F.G, F.bid, (const int*)(ws + WS_ROWTOK)};
        pg8::EpiSwiGLU E{(bf16*)(ws + WS_ACT), args.in[I_BUP], (const float*)(ws + WS_ROWRSTD), (const float*)(ws + WS_COLSC)};
        pg8::gemm_phase<pg8::EpiSwiGLU, pg8::MoeOrder<true>, true, true>(F.lds, g, S, E);
    } } SEAM(8);

    for (int rep_ = 0; rep_ < REPS(9); ++rep_) { if (rep_) xcd_barrier(bar);
    if (IN(9)) {
        pg8::Gemm g{(const bf16*)(ws + WS_ACT), (const bf16*)(ws + WS_WDN), NROWS_MAX, 1024, D / 2};
        pg8::MoeOrder<false> S{(const int*)(ws + WS_META), 4, F.G, F.bid, nullptr};
        pg8::EpiDown E{(bf16*)(ws + WS_YR), args.in[I_BDN], (const float*)(ws + WS_COLSC2)};
        pg8::gemm_phase<pg8::EpiDown, pg8::MoeOrder<false>, true, true>(F.lds, g, S, E);
    } } SEAM(9);

    if (IN(10)) { p10_combine(F, args); }
#undef IN
#undef SEAM
}

extern "C" void kernel_launch(void* const* d_in, const int* in_sizes, int n_in, void* d_out, int out_size, void* d_ws, size_t ws_size, hipStream_t stream) {
    static int grid = 0;
    if (grid == 0) {
        if (n_in != 25 || out_size != T * D || ws_size < WS_END) { fprintf(stderr, "kernel_launch: unexpected shapes (n_in %d out %d ws %zu)\n", n_in, out_size, ws_size); grid = -1; return; }
        int dev = 0, cus = 0, per_cu = 0;
        if (hipGetDevice(&dev) != hipSuccess || hipDeviceGetAttribute(&cus, hipDeviceAttributeMultiprocessorCount, dev) != hipSuccess) { grid = -1; return; }
        if (hipFuncSetAttribute((const void*)fwd, hipFuncAttributeMaxDynamicSharedMemorySize, LDS_BYTES) != hipSuccess) { fprintf(stderr, "kernel_launch: hipFuncSetAttribute failed\n"); grid = -1; return; }
        if (hipOccupancyMaxActiveBlocksPerMultiprocessor(&per_cu, (const void*)fwd, NWAVES * 64, LDS_BYTES) != hipSuccess || per_cu < 1) { fprintf(stderr, "kernel_launch: occupancy query says %d\n", per_cu); }
        (void)hipGetLastError();
        grid = cus;
    }
    if (grid < 0) return;
    (void)hipMemsetAsync((char*)d_ws + WS_CTL, 0, CTL_ZERO_BYTES, stream);
    Args a{};
    for (int i = 0; i < 25; ++i) a.in[i] = (const float*)d_in[i];
    a.out = (float*)d_out; a.ws = (unsigned char*)d_ws;
#if MK_N_LAUNCHES == 1
    a.ph_lo = 0; a.ph_hi = N_PHASES; a.ph_rep = 2;
    hipLaunchKernelGGL(fwd, dim3(grid), dim3(NWAVES * 64), LDS_BYTES, stream, a);
#else
    for (int p = 0; p < N_PHASES; ++p) { a.ph_lo = p; a.ph_hi = p + 1; hipLaunchKernelGGL(fwd, dim3(grid), dim3(NWAVES * 64), LDS_BYTES, stream, a); }
#endif
}
```

```cpp
#define NAIVE_RWKV 0
#define NAIVE_ATT 0
#define MK_N_LAUNCHES 1
#include <hip/hip_runtime.h>
#include <cstdio>
#include <cstdint>

#ifndef MK_N_LAUNCHES
#define MK_N_LAUNCHES 1
#endif
#ifndef NAIVE_RWKV
#define NAIVE_RWKV 0
#endif
#ifndef NAIVE_ATT
#define NAIVE_ATT 0
#endif

namespace pg8 {
#define PG8_LAS __attribute__((address_space(3)))
typedef unsigned short bf16_t;
typedef short bf16x8 __attribute__((ext_vector_type(8)));
typedef float f32x4 __attribute__((ext_vector_type(4)));
typedef unsigned u32x4 __attribute__((ext_vector_type(4)));
typedef unsigned u32x2 __attribute__((ext_vector_type(2)));
typedef float f32x2e __attribute__((ext_vector_type(2)));
typedef int i32x4 __attribute__((ext_vector_type(4)));
typedef int i32x8 __attribute__((ext_vector_type(8)));
template <bool F8> struct Frag { bf16x8 v[2]; __device__ __forceinline__ void set(bf16x8 a, bf16x8 b) { v[0] = a; v[1] = b; } };
template <> struct Frag<true> { i32x8 v; __device__ __forceinline__ void set(bf16x8 a, bf16x8 b) { v = __builtin_shufflevector(__builtin_bit_cast(i32x4, a), __builtin_bit_cast(i32x4, b), 0, 1, 2, 3, 4, 5, 6, 7); } };
__device__ __forceinline__ i32x8 cat8(bf16x8 a, bf16x8 b) { return __builtin_shufflevector(__builtin_bit_cast(i32x4, a), __builtin_bit_cast(i32x4, b), 0, 1, 2, 3, 4, 5, 6, 7); }
constexpr int BM = 256, BK = 64, HALF = 128, HTB = HALF * BK * 2  , STAGE_BYTES = 8 * HTB, NXCD = 8, WGM = 8;

__host__ __device__ __forceinline__ int lds_byte(int r, int c) { const int st = (r >> 4) * 2 + (c >> 5), rr = r & 15, cc = c & 31, ob = rr * 64 + cc * 2; return st * 1024 + (ob ^ (((ob >> 9) & 1) << 5)); }
__host__ __device__ __forceinline__ void stage_rc(int b, int& R, int& C) { const int st = b / 1024, sb = b % 1024, swz = sb ^ (((sb >> 9) & 1) << 5); R = (st >> 1) * 16 + swz / 64; C = (st & 1) * 32 + (swz % 64) / 2; }
__host__ __device__ __forceinline__ int perm32(int rho) { const int n = rho >> 4, i = rho & 15; return 8 * (i >> 2) + 4 * n + (i & 3); }

struct Unit { int pm, pn, e; };
struct Gemm { const bf16_t* A; const bf16_t* Bt; int M, N, K; };

__device__ __forceinline__ bool tile_of(int i, int G, int c, int nM, int nN, int& pm, int& pn) {
    const int nwg = nM * nN; const long L = (long)i * G + c; if (L >= nwg) return false;
    int wgid = (int)L; { const int q = nwg / NXCD, r = nwg % NXCD, xcd = wgid % NXCD, off = wgid / NXCD; wgid = (xcd < r ? xcd * (q + 1) : r * (q + 1) + (xcd - r) * q) + off; }
    const int nig = WGM * nN, gid = wgid / nig, fm = gid * WGM, gsz = (nM - fm) < WGM ? (nM - fm) : WGM;
    pm = fm + ((wgid % nig) % gsz); pn = (wgid % nig) / gsz; return true;
}
struct StaticOrder {
    int nM, nN, G, c;
    __device__ void init(int M, int N, int G_, int c_) { nM = M / BM; nN = N / BM; G = G_; c = c_; }
    __device__ __forceinline__ bool next(int i, Unit& u) const { u.e = 0; return tile_of(i, G, c, nM, nN, u.pm, u.pn); }
    __device__ __forceinline__ const char* a_base(const Gemm& g, const Unit& u) const { return (const char*)g.A + (size_t)u.pm * BM * g.K * 2; }
    __device__ __forceinline__ const char* b_base(const Gemm& g, const Unit& u) const { return (const char*)g.Bt + (size_t)u.pn * BM * g.K * 2; }
    __device__ __forceinline__ void a_off(const Gemm& g, const Unit&, const int (&R)[2], const int (&C)[2], unsigned (&vo)[2][2]) const {
#pragma unroll
        for (int h = 0; h < 2; ++h)
#pragma unroll
            for (int i = 0; i < 2; ++i) vo[h][i] = (unsigned)((h * HALF + R[i]) * g.K + C[i]) * 2u; }
    __device__ __forceinline__ void a_ready(const Unit&) const {}
    __device__ __forceinline__ void done(const Unit&) const {}
};
template <bool GATHER>
struct MoeOrder {
    const int* meta; int nN, G, c;
    __device__ __forceinline__ bool next(int i, Unit& u) const {
        const int nM = __builtin_amdgcn_readfirstlane(meta[0]);
        if (!tile_of(i, G, c, nM, nN, u.pm, u.pn)) return false;
        u.e = __builtin_amdgcn_readfirstlane(meta[16 + u.pm]); return true;
    }
    const int* rowtok;
    __device__ __forceinline__ const char* a_base(const Gemm& g, const Unit& u) const { return GATHER ? (const char*)g.A : (const char*)g.A + (size_t)u.pm * BM * g.K * 2; }
    __device__ __forceinline__ const char* b_base(const Gemm& g, const Unit& u) const { return (const char*)g.Bt + ((size_t)u.e * g.N + (size_t)u.pn * BM) * g.K * 2; }
    __device__ __forceinline__ void a_off(const Gemm& g, const Unit& u, const int (&R)[2], const int (&C)[2], unsigned (&vo)[2][2]) const {
#pragma unroll
        for (int h = 0; h < 2; ++h)
#pragma unroll
            for (int i = 0; i < 2; ++i) { const int r = h * HALF + R[i]; vo[h][i] = (unsigned)((GATHER ? rowtok[u.pm * BM + r] : r) * g.K + C[i]) * 2u; } }
    __device__ __forceinline__ void a_ready(const Unit&) const {}
    __device__ __forceinline__ void done(const Unit&) const {}
};

__device__ __forceinline__ unsigned cvt_pk_bf16(float lo, float hi) { unsigned r; asm volatile("v_cvt_pk_bf16_f32 %0, %1, %2" : "=v"(r) : "v"(lo), "v"(hi)); return r; }

__device__ __forceinline__ float acc_i2f(float bits) { return (float)__builtin_bit_cast(int, bits); }
struct EpiBf16Q {
    static constexpr bool PERM = true, AFTER_DRAIN = false, I8 = true, F8 = false;
    bf16_t* O; int ldc; const float* rowsc; const float* colsc;
    __device__ __forceinline__ void operator()(const f32x4 (&acc)[2][2][4][2], const Unit& u, int wr, int wc, int fr, int fq) const {
        const int row0 = u.pm * BM + wr * 64 + fr, col0 = u.pn * BM + wc * 32 + 8 * fq;
        f32x4 cv[2][2]; float rsv[2][4];
#pragma unroll
        for (int bj = 0; bj < 2; ++bj)
#pragma unroll
            for (int n = 0; n < 2; ++n) cv[bj][n] = *(const f32x4*)(colsc + col0 + bj * HALF + 4 * n);
#pragma unroll
        for (int ai = 0; ai < 2; ++ai)
#pragma unroll
            for (int m = 0; m < 4; ++m) rsv[ai][m] = rowsc[row0 + ai * HALF + m * 16];
#pragma unroll
        for (int ai = 0; ai < 2; ++ai)
#pragma unroll
            for (int m = 0; m < 4; ++m) { bf16_t* rowp = O + (size_t)(row0 + ai * HALF + m * 16) * ldc + col0; const float rs = rsv[ai][m];
#pragma unroll
                for (int bj = 0; bj < 2; ++bj) { f32x4 v0, v1;
#pragma unroll
                    for (int j = 0; j < 4; ++j) { v0[j] = acc_i2f(acc[ai][bj][m][0][j]); v1[j] = acc_i2f(acc[ai][bj][m][1][j]); }
                    v0 = (v0 * rs) * cv[bj][0]; v1 = (v1 * rs) * cv[bj][1];
                    u32x4 w; w.x = cvt_pk_bf16(v0[0], v0[1]); w.y = cvt_pk_bf16(v0[2], v0[3]); w.z = cvt_pk_bf16(v1[0], v1[1]); w.w = cvt_pk_bf16(v1[2], v1[3]);
                    *(u32x4*)(rowp + bj * HALF) = w; } }
    }
};
struct EpiBf16 {
    static constexpr bool PERM = true, AFTER_DRAIN = false, I8 = false, F8 = false;
    bf16_t* O; int ldc;
    __device__ __forceinline__ void operator()(const f32x4 (&acc)[2][2][4][2], const Unit& u, int wr, int wc, int fr, int fq) const {
        const int row0 = u.pm * BM + wr * 64 + fr, col0 = u.pn * BM + wc * 32 + 8 * fq;
#pragma unroll
        for (int ai = 0; ai < 2; ++ai)
#pragma unroll
            for (int m = 0; m < 4; ++m) { bf16_t* rowp = O + (size_t)(row0 + ai * HALF + m * 16) * ldc + col0;
#pragma unroll
                for (int bj = 0; bj < 2; ++bj) { const f32x4 v0 = acc[ai][bj][m][0], v1 = acc[ai][bj][m][1];
                    u32x4 w; w.x = cvt_pk_bf16(v0[0], v0[1]); w.y = cvt_pk_bf16(v0[2], v0[3]); w.z = cvt_pk_bf16(v1[0], v1[1]); w.w = cvt_pk_bf16(v1[2], v1[3]);
                    *(u32x4*)(rowp + bj * HALF) = w; } }
    }
};
struct EpiResid {
    static constexpr bool PERM = false, AFTER_DRAIN = false, I8 = false, F8 = false;
    const float* base; float* out; bf16_t* xb; int ldc;
    __device__ __forceinline__ void operator()(const f32x4 (&acc)[2][2][4][2], const Unit& u, int wr, int wc, int fr, int fq) const {
        const int row0 = u.pm * BM + wr * 64 + fr, col0 = u.pn * BM + wc * 32 + 4 * fq;
        f32x4 nb[4][2][2];
#define PG8_RES_LOAD(g_) do { const size_t off_ = (size_t)(row0 + ((g_) >> 2) * HALF + ((g_) & 3) * 16) * ldc + col0; _Pragma("unroll") for (int bj = 0; bj < 2; ++bj) _Pragma("unroll") for (int n = 0; n < 2; ++n) \
            nb[(g_) & 3][bj][n] = __builtin_nontemporal_load((const f32x4*)(base + off_ + bj * HALF + n * 16)); } while (0)
        PG8_RES_LOAD(0); PG8_RES_LOAD(1); PG8_RES_LOAD(2);
#pragma unroll
        for (int g = 0; g < 8; ++g) { const int ai = g >> 2, m = g & 3; const size_t off = (size_t)(row0 + ai * HALF + m * 16) * ldc + col0;
            if (g + 3 < 8) PG8_RES_LOAD(g + 3);
#pragma unroll
            for (int bj = 0; bj < 2; ++bj)
#pragma unroll
                for (int n = 0; n < 2; ++n) { const f32x4 o = nb[g & 3][bj][n] + acc[ai][bj][m][n];
                    if (out) *(f32x4*)(out + off + bj * HALF + n * 16) = o;
                    u32x2 w; w.x = cvt_pk_bf16(o[0], o[1]); w.y = cvt_pk_bf16(o[2], o[3]); *(u32x2*)(xb + off + bj * HALF + n * 16) = w; }
            asm volatile("" ::: "memory"); }
#undef PG8_RES_LOAD
    }
};
struct EpiSwiGLU {
    static constexpr bool PERM = true, AFTER_DRAIN = false, I8 = true, F8 = false;
    bf16_t* O; const float* b_up; const float* rowrstd; const float* colsc;
    __device__ __forceinline__ void operator()(const f32x4 (&acc)[2][2][4][2], const Unit& u, int wr, int wc, int fr, int fq) const {
        const int row0 = u.pm * BM + wr * 64 + fr, f0 = u.pn * HALF + wc * 32 + 8 * fq;
        const float* bg = b_up + (size_t)u.e * 2048 + f0; const float* bl = bg + 1024;
        const f32x4 bg0 = *(const f32x4*)bg, bg1 = *(const f32x4*)(bg + 4), bl0 = *(const f32x4*)bl, bl1 = *(const f32x4*)(bl + 4);
        const float* cg = colsc + (size_t)u.e * 2048 + f0; const float* cl = cg + 1024;
        const f32x4 cg0 = *(const f32x4*)cg, cg1 = *(const f32x4*)(cg + 4), cl0 = *(const f32x4*)cl, cl1 = *(const f32x4*)(cl + 4);
        float rsv[2][4];
#pragma unroll
        for (int ai = 0; ai < 2; ++ai)
#pragma unroll
            for (int m = 0; m < 4; ++m) rsv[ai][m] = rowrstd[row0 + ai * HALF + m * 16];
#pragma unroll
        for (int ai = 0; ai < 2; ++ai)
#pragma unroll
            for (int m = 0; m < 4; ++m) { const int row = row0 + ai * HALF + m * 16; const float rs = rsv[ai][m];
                float a[8];
#pragma unroll
                for (int n = 0; n < 2; ++n)
#pragma unroll
                    for (int j = 0; j < 4; j += 2) {
                        const f32x2e ag2 = {acc_i2f(acc[ai][0][m][n][j]), acc_i2f(acc[ai][0][m][n][j + 1])}, al2 = {acc_i2f(acc[ai][1][m][n][j]), acc_i2f(acc[ai][1][m][n][j + 1])};
                        const f32x2e cg2 = n ? (f32x2e){cg1[j], cg1[j + 1]} : (f32x2e){cg0[j], cg0[j + 1]}, cl2 = n ? (f32x2e){cl1[j], cl1[j + 1]} : (f32x2e){cl0[j], cl0[j + 1]};
                        const f32x2e bg2 = n ? (f32x2e){bg1[j], bg1[j + 1]} : (f32x2e){bg0[j], bg0[j + 1]}, bl2 = n ? (f32x2e){bl1[j], bl1[j + 1]} : (f32x2e){bl0[j], bl0[j + 1]};
                        f32x2e hg = (ag2 * rs) * cg2 + bg2, hl = (al2 * rs) * cl2 + bl2;
                        hg.x = fminf(hg.x, 7.0f); hg.y = fminf(hg.y, 7.0f); hl.x = fminf(fmaxf(hl.x, -7.0f), 7.0f); hl.y = fminf(fmaxf(hl.y, -7.0f), 7.0f);
                        const f32x2e t = hg * (-1.702f * 1.4426950408889634f);
                        f32x2e e; e.x = __builtin_amdgcn_exp2f(t.x); e.y = __builtin_amdgcn_exp2f(t.y);
                        const f32x2e d = e + 1.0f; f32x2e sg; sg.x = __builtin_amdgcn_rcpf(d.x); sg.y = __builtin_amdgcn_rcpf(d.y);
                        const f32x2e o = (hg * sg) * (hl + 1.0f);
                        a[n * 4 + j] = o.x; a[n * 4 + j + 1] = o.y; }
                u32x2 w;
                w.x = (unsigned)__builtin_amdgcn_cvt_pk_fp8_f32(a[2], a[3], __builtin_amdgcn_cvt_pk_fp8_f32(a[0], a[1], 0, false), true);
                w.y = (unsigned)__builtin_amdgcn_cvt_pk_fp8_f32(a[6], a[7], __builtin_amdgcn_cvt_pk_fp8_f32(a[4], a[5], 0, false), true);
                *(u32x2*)((unsigned char*)O + (size_t)row * 1024 + f0) = w; }
    }
};
struct EpiDown {
    static constexpr bool PERM = true, AFTER_DRAIN = false, I8 = false, F8 = true;
    bf16_t* O; const float* b_dn; const float* colsc;
    __device__ __forceinline__ void operator()(const f32x4 (&acc)[2][2][4][2], const Unit& u, int wr, int wc, int fr, int fq) const {
        const int row0 = u.pm * BM + wr * 64 + fr, col0 = u.pn * BM + wc * 32 + 8 * fq;
        const float* bp = b_dn + (size_t)u.e * 1024 + col0;
        const float* cp = colsc + (size_t)u.e * 1024 + col0;
        f32x4 bv[2][2], cv[2][2];
#pragma unroll
        for (int bj = 0; bj < 2; ++bj)
#pragma unroll
            for (int n = 0; n < 2; ++n) { bv[bj][n] = *(const f32x4*)(bp + bj * HALF + 4 * n); cv[bj][n] = *(const f32x4*)(cp + bj * HALF + 4 * n); }
#pragma unroll
        for (int ai = 0; ai < 2; ++ai)
#pragma unroll
            for (int m = 0; m < 4; ++m) { unsigned char* rowp = (unsigned char*)O + (size_t)(row0 + ai * HALF + m * 16) * 1024 + col0;
#pragma unroll
                for (int bj = 0; bj < 2; ++bj) { const f32x4 v0 = acc[ai][bj][m][0] * cv[bj][0] + bv[bj][0], v1 = acc[ai][bj][m][1] * cv[bj][1] + bv[bj][1];
                    u32x2 w; w.x = (unsigned)__builtin_amdgcn_cvt_pk_fp8_f32(v0[2], v0[3], __builtin_amdgcn_cvt_pk_fp8_f32(v0[0], v0[1], 0, false), true);
                    w.y = (unsigned)__builtin_amdgcn_cvt_pk_fp8_f32(v1[2], v1[3], __builtin_amdgcn_cvt_pk_fp8_f32(v1[0], v1[1], 0, false), true);
                    *(u32x2*)(rowp + bj * HALF) = w; } }
    }
};

template <class Epi, class Sched, bool ALIGN_EPI = false, bool SP2 = false>
__device__ __forceinline__ void gemm_phase(PG8_LAS unsigned char* lds, const Gemm g, const Sched& S, const Epi& E) {
    int tid = threadIdx.x; asm volatile("" : "+v"(tid));
    const int wid = __builtin_amdgcn_readfirstlane(tid >> 6), lane = tid & 63, wr = wid >> 2, wc = wid & 3, fr = lane & 15, fq = lane >> 4;
    const int K = g.K, nt = K / BK;
    unsigned voffB[2]; int sR[2], sC[2];
#pragma unroll
    for (int i = 0; i < 2; ++i) { int R, C; stage_rc(tid * 16 + i * 8192, R, C); const int Rb = Epi::PERM ? ((R & ~31) + perm32(R & 31)) : R;
        sR[i] = R; sC[i] = C; voffB[i] = (unsigned)(Rb * K + C) * 2u; }
    const size_t kstep = (size_t)(BK * 2);
    const size_t hstep = (size_t)HALF * K * 2;
    const unsigned ldsw = (unsigned)wid * 1024u;
    const int aoff = lds_byte(wr * 64 + fr, fq * 8), boff = lds_byte(wc * 32 + fr, fq * 8);
#define PG8_SA(b, h) (((b) * 2 + (h)) * HTB)
#define PG8_SB(b, h) ((4 + (b) * 2 + (h)) * HTB)
#define PG8_STAGE(bufoff, gbase, voff) do { _Pragma("unroll") for (int _i = 0; _i < 2; ++_i) \
        __builtin_amdgcn_global_load_lds((const unsigned*)((const char*)(gbase) + (voff)[_i]), (PG8_LAS unsigned*)(lds + (bufoff) + ldsw + _i * 8192), 16, 0, 0); } while (0)
#define PG8_STAGE_A(bufoff, gbase, vo, h) do { _Pragma("unroll") for (int _i = 0; _i < 2; ++_i) \
        __builtin_amdgcn_global_load_lds((const unsigned*)((const char*)(gbase) + (vo)[h][_i]), (PG8_LAS unsigned*)(lds + (bufoff) + ldsw + _i * 8192), 16, 0, 0); } while (0)
#define PG8_LDA(dst, b, h) do { _Pragma("unroll") for (int m = 0; m < 4; ++m) dst[m].set(*(const PG8_LAS bf16x8*)(lds + PG8_SA(b, h) + aoff + m * 2048), *(const PG8_LAS bf16x8*)(lds + PG8_SA(b, h) + aoff + m * 2048 + 1024)); } while (0)
#define PG8_LDB(dst, b, h) do { _Pragma("unroll") for (int n = 0; n < 2; ++n) dst[n].set(*(const PG8_LAS bf16x8*)(lds + PG8_SB(b, h) + boff + n * 2048), *(const PG8_LAS bf16x8*)(lds + PG8_SB(b, h) + boff + n * 2048 + 1024)); } while (0)
#define PG8_MMA(ai, bj, At, Bt) do { __builtin_amdgcn_s_setprio(1); _Pragma("unroll") for (int m = 0; m < 4; ++m) _Pragma("unroll") for (int n = 0; n < 2; ++n) { \
        if constexpr (Epi::F8) asm volatile("v_mfma_scale_f32_16x16x128_f8f6f4 %0, %1, %2, %0, %3, %3 op_sel_hi:[0,0,0]" : "+v"(acc[ai][bj][m][n]) : "v"(Bt[n].v), "v"(At[m].v), "v"(f8scale)); \
        else { _Pragma("unroll") for (int k = 0; k < 2; ++k) { \
            if constexpr (Epi::I8) acc[ai][bj][m][n] = __builtin_bit_cast(f32x4, __builtin_amdgcn_mfma_i32_16x16x64_i8(__builtin_bit_cast(i32x4, Bt[n].v[k]), __builtin_bit_cast(i32x4, At[m].v[k]), __builtin_bit_cast(i32x4, acc[ai][bj][m][n]), 0, 0, 0)); \
            else acc[ai][bj][m][n] = __builtin_amdgcn_mfma_f32_16x16x32_bf16(Bt[n].v[k], At[m].v[k], acc[ai][bj][m][n], 0, 0, 0); } } } __builtin_amdgcn_s_setprio(0); } while (0)
#define PG8_WAIT_V(n) asm volatile("s_waitcnt vmcnt(" #n ")" ::: "memory")
#define PG8_WAIT_L(n) asm volatile("s_waitcnt lgkmcnt(" #n ")" ::: "memory")
#define PG8_BAR __builtin_amdgcn_s_barrier()
#define PG8_SCHED __builtin_amdgcn_sched_barrier(0)
    Unit cur, nxt; int ui = 0;
#ifdef GEMM_TIME
    long long gacc_ = 0;
#endif
    if (!S.next(0, cur)) return;
    f32x4 acc[2][2][4][2];
#pragma unroll
    for (int a = 0; a < 2; ++a)
#pragma unroll
        for (int b = 0; b < 2; ++b)
#pragma unroll
            for (int m = 0; m < 4; ++m)
#pragma unroll
                for (int n = 0; n < 2; ++n) acc[a][b][m][n] = (f32x4){0.f, 0.f, 0.f, 0.f};
    Frag<Epi::F8> At[4], B0[2], B1[2];
    const int f8scale = 0x7f7f7f7f;
    (void)f8scale;
    const char* cA = S.a_base(g, cur); const char* cB = S.b_base(g, cur);
    unsigned voC[2][2], voN[2][2];
    S.a_off(g, cur, sR, sC, voC);
    S.a_ready(cur);
    static_assert(SP2, "only the two-MFMA-blocks-per-barrier-pair loop is kept");
    PG8_STAGE(PG8_SB(0, 0), cB, voffB); PG8_STAGE(PG8_SB(0, 1), cB + hstep, voffB); PG8_STAGE_A(PG8_SA(0, 0), cA, voC, 0); PG8_STAGE_A(PG8_SA(0, 1), cA, voC, 1);
    if (wr == 1) PG8_BAR;
    PG8_WAIT_V(2); PG8_BAR;
    PG8_STAGE(PG8_SB(1, 0), cB + kstep, voffB); PG8_STAGE_A(PG8_SA(1, 0), cA + kstep, voC, 0); PG8_STAGE(PG8_SB(1, 1), cB + hstep + kstep, voffB);
    PG8_WAIT_V(6); PG8_BAR;
    for (;;) {
        const bool has_next = S.next(ui + 1, nxt);
        const char* nA = has_next ? S.a_base(g, nxt) : cA; const char* nB = has_next ? S.b_base(g, nxt) : cB;
        if (has_next) S.a_off(g, nxt, sR, sC, voN); else {
#pragma unroll
            for (int h_ = 0; h_ < 2; ++h_) { voN[h_][0] = voC[h_][0]; voN[h_][1] = voC[h_][1]; } }
#pragma unroll 1
        for (int t = 0; t < nt; t += 2) {
            const bool last = (t == nt - 2);
            const char* a1 = cA + (size_t)(t + 1) * kstep;
            const char* a2 = last ? nA : cA + (size_t)(t + 2) * kstep; const char* b2 = last ? nB : cB + (size_t)(t + 2) * kstep;
            const char* a3 = a2 + kstep; const char* b3 = b2 + kstep;
            if (last && has_next) S.a_ready(nxt);
            unsigned vo2[2][2];
#pragma unroll
            for (int h_ = 0; h_ < 2; ++h_) { vo2[h_][0] = last ? voN[h_][0] : voC[h_][0]; vo2[h_][1] = last ? voN[h_][1] : voC[h_][1]; }
            PG8_LDB(B0, 0, 0); PG8_LDB(B1, 0, 1); PG8_SCHED; PG8_LDA(At, 0, 0); PG8_STAGE_A(PG8_SA(1, 1), a1, voC, 1);
            PG8_WAIT_V(8); PG8_WAIT_L(0); PG8_BAR; PG8_MMA(0, 0, At, B0); PG8_MMA(0, 1, At, B1); PG8_BAR; PG8_SCHED;
            PG8_LDA(At, 0, 1); PG8_STAGE(PG8_SB(0, 0), b2, voffB); PG8_STAGE(PG8_SB(0, 1), b2 + hstep, voffB); PG8_STAGE_A(PG8_SA(0, 0), a2, vo2, 0);
            PG8_WAIT_V(8); PG8_WAIT_L(0); PG8_BAR; PG8_MMA(1, 0, At, B0); PG8_MMA(1, 1, At, B1); PG8_BAR; PG8_SCHED;
            PG8_LDB(B0, 1, 0); PG8_LDB(B1, 1, 1); PG8_SCHED; PG8_LDA(At, 1, 0); PG8_STAGE_A(PG8_SA(0, 1), a2, vo2, 1);
            PG8_WAIT_V(8); PG8_WAIT_L(0); PG8_BAR; PG8_MMA(0, 0, At, B0); PG8_MMA(0, 1, At, B1); PG8_BAR; PG8_SCHED;
            PG8_LDA(At, 1, 1); PG8_STAGE(PG8_SB(1, 0), b3, voffB); PG8_STAGE(PG8_SB(1, 1), b3 + hstep, voffB); PG8_STAGE_A(PG8_SA(1, 0), a3, vo2, 0);
            PG8_WAIT_V(8); PG8_WAIT_L(0); PG8_BAR; PG8_MMA(1, 0, At, B0); PG8_MMA(1, 1, At, B1); PG8_BAR; PG8_SCHED;
        }
        if constexpr (ALIGN_EPI) { if (wr == 0) PG8_BAR; }
#ifdef GEMM_TIME
        const long long gt0_ = clock64();
#endif
        if constexpr (!Epi::AFTER_DRAIN) { E(acc, cur, wr, wc, fr, fq); S.done(cur); }
#ifdef GEMM_TIME
        gacc_ += clock64() - gt0_;
#endif
        if (!has_next) break;
#pragma unroll
        for (int a = 0; a < 2; ++a)
#pragma unroll
            for (int b = 0; b < 2; ++b)
#pragma unroll
                for (int m = 0; m < 4; ++m)
#pragma unroll
                    for (int n = 0; n < 2; ++n) acc[a][b][m][n] = (f32x4){0.f, 0.f, 0.f, 0.f};
        cur = nxt; cA = nA; cB = nB; ++ui;
#pragma unroll
        for (int h_ = 0; h_ < 2; ++h_) { voC[h_][0] = voN[h_][0]; voC[h_][1] = voN[h_][1]; }
        if constexpr (ALIGN_EPI) { if (wr == 1) PG8_BAR; }
    }
    PG8_WAIT_V(0);
    if constexpr (!ALIGN_EPI) { if (wr == 0) PG8_BAR; }
    PG8_BAR;
#ifdef GEMM_TIME
    { const long long s0_ = clock64(); while (clock64() - s0_ < gacc_) __builtin_amdgcn_s_sleep(8); }
#endif
    if constexpr (Epi::AFTER_DRAIN) { E.fused(acc, cur, wr, wc, fr, fq, lds, wid, lane); S.done(cur); }
#undef PG8_SA
#undef PG8_SB
#undef PG8_STAGE
#undef PG8_STAGE_A
#undef PG8_LDA
#undef PG8_LDB
#undef PG8_MMA
#undef PG8_WAIT_V
#undef PG8_WAIT_L
#undef PG8_BAR
#undef PG8_SCHED
}
}

constexpr int NWAVES = 8;
constexpr int T = 32768, D = 1024, SEQ = 8192, NBATCH = 4, NCHUNK = SEQ / 64;
constexpr int INC = 3328;
constexpr int PRW = 1536;
constexpr int NEXP = 32, TOPK = 4;
constexpr int NRB_MAX = T * TOPK / 256 + NEXP;
constexpr int NROWS_MAX = NRB_MAX * 256;
constexpr int NITEM = NBATCH * NCHUNK * 8;

constexpr size_t MiB = 1u << 20, KiB = 1u << 10;
constexpr size_t WS_CTL = 0, CTL_ZERO_BYTES = 1 * MiB;
constexpr size_t WS_META = 1 * MiB;
constexpr size_t WS_CNT = 1 * MiB + 64 * KiB;
constexpr size_t WS_EIDX = 2 * MiB, WS_GATE = 2 * MiB + 512 * KiB, WS_LRANK = 3 * MiB, WS_INV = 3 * MiB + 512 * KiB;
constexpr size_t WS_RSTD = 4 * MiB, WS_ROWRSTD = 4 * MiB + 256 * KiB;
constexpr size_t WS_WRT = 5 * MiB;
constexpr size_t WS_PAR = 5 * MiB + 128 * KiB;
constexpr size_t WS_WDEC = 5 * MiB + 256 * KiB, WS_WAAA = WS_WDEC + 64 * KiB, WS_WGATE = WS_WAAA + 64 * KiB;
constexpr size_t WS_WIN = 6 * MiB, WS_WOUT = 13 * MiB;
constexpr size_t WS_ROWTOK = 15 * MiB;
constexpr size_t WS_WUP = 16 * MiB, WS_WDN = 144 * MiB;
constexpr size_t WS_XN = 208 * MiB;
constexpr size_t WS_PROJ = 272 * MiB;
constexpr size_t WS_MIX = 480 * MiB;
constexpr size_t WS_RW = 544 * MiB;
constexpr size_t WS_XG = 272 * MiB, WS_ACT = 544 * MiB, WS_YR = WS_XG;
constexpr size_t WS_COLSC = 15 * MiB + 640 * KiB;
constexpr size_t WS_COLSC1 = 5 * MiB + 192 * KiB;
constexpr size_t WS_XNSC = WS_RSTD;
constexpr size_t WS_COLSC2 = 15 * MiB + 896 * KiB;
constexpr size_t WS_XQ = WS_MIX;
constexpr size_t WS_END = 1000 * MiB;
constexpr int CW_ATT = 8192;
constexpr int CW_BAR = 4096;

constexpr int RING_BYTES = 131072;
constexpr int LDS_BYTES = 163840;
constexpr int MISC_OFF = LDS_BYTES - 256;

#define GAS __attribute__((address_space(1)))
#define LAS __attribute__((address_space(3)))
#define DI __device__ __forceinline__
typedef unsigned short bf16;
typedef unsigned v4u __attribute__((ext_vector_type(4)));
typedef unsigned v2u __attribute__((ext_vector_type(2)));
typedef float f32x4 __attribute__((ext_vector_type(4)));
typedef float f32x2 __attribute__((ext_vector_type(2)));
typedef short bf16x8 __attribute__((ext_vector_type(8)));
typedef __bf16 bf16x2_t __attribute__((ext_vector_type(2)));
#define LDS_WAIT() asm volatile("s_waitcnt lgkmcnt(0)" ::: "memory")
#define VM_WAIT() asm volatile("s_waitcnt vmcnt(0)" ::: "memory")
DI unsigned pk2(float lo, float hi) { const f32x2 v = {lo, hi}; const bf16x2_t b = __builtin_convertvector(v, bf16x2_t); return __builtin_bit_cast(unsigned, b); }
DI float bf2f(unsigned short b) { return __uint_as_float((unsigned)b << 16); }
DI float bflo(unsigned w) { return __uint_as_float(w << 16); }
DI float bfhi(unsigned w) { return __uint_as_float(w & 0xffff0000u); }
DI float wave_sum(float v) {
#pragma unroll
    for (int o = 1; o < 64; o <<= 1) v += __shfl_xor(v, o);
    return v;
}
DI float wave_max(float v) {
#pragma unroll
    for (int o = 1; o < 64; o <<= 1) v = fmaxf(v, __shfl_xor(v, o));
    return v;
}
DI float sigmoidf_(float x) { return 1.0f / (1.0f + __expf(-x)); }

DI float quad_sum(float x) {
    const unsigned a = __builtin_bit_cast(unsigned, x); const auto r = __builtin_amdgcn_permlane32_swap(a, a, false, false);
    const float y = __builtin_bit_cast(float, (unsigned)r[0]) + __builtin_bit_cast(float, (unsigned)r[1]);
    const unsigned b = __builtin_bit_cast(unsigned, y); const auto s = __builtin_amdgcn_permlane16_swap(b, b, false, false);
    return __builtin_bit_cast(float, (unsigned)s[0]) + __builtin_bit_cast(float, (unsigned)s[1]);
}
DI float quad_max(float x) {
    const unsigned a = __builtin_bit_cast(unsigned, x); const auto r = __builtin_amdgcn_permlane32_swap(a, a, false, false);
    const float y = fmaxf(__builtin_bit_cast(float, (unsigned)r[0]), __builtin_bit_cast(float, (unsigned)r[1]));
    const unsigned b = __builtin_bit_cast(unsigned, y); const auto s = __builtin_amdgcn_permlane16_swap(b, b, false, false);
    return fmaxf(__builtin_bit_cast(float, (unsigned)s[0]), __builtin_bit_cast(float, (unsigned)s[1]));
}
#define XB_TMO      128
#define XB_XCNT(j)  (256  + 64 * (j))
#define XB_XSUB(j)  (1280 + 64 * (j))
#define XB_XGEN(j)  (2304 + 64 * (j))
#define XB_TOP      3328
#define XB_TOPGEN   3392
#define XCD_BAR_WORDS 3456
#define XB_SPIN_CAP (NAIVE_RWKV ? (1u << 25) : (1u << 20))

__device__ __forceinline__ unsigned xb_ld(unsigned* p)              { return __hip_atomic_load(p, __ATOMIC_RELAXED, __HIP_MEMORY_SCOPE_AGENT); }
__device__ __forceinline__ unsigned xb_add(unsigned* p, unsigned v) { return __hip_atomic_fetch_add(p, v, __ATOMIC_RELAXED, __HIP_MEMORY_SCOPE_AGENT); }
__device__ __forceinline__ unsigned xb_xcc_id() { return (unsigned)__builtin_amdgcn_s_getreg((3 << 11) | 20) & 0xFu; }
#define XB_SPIN(cond, bar) do { unsigned _sp = 0; while (cond) { __builtin_amdgcn_s_sleep(1); \
    if ((++_sp & 255u) == 0u) { if (xb_ld(&(bar)[XB_TMO])) break; if (_sp > XB_SPIN_CAP) { atomicAdd(&(bar)[XB_TMO], 1u); break; } } } } while (0)

struct XcdBarrier {
    unsigned* bar; unsigned x;
    volatile LAS unsigned* st;
};

__device__ __forceinline__ XcdBarrier xcd_barrier_post(unsigned* bar, volatile LAS unsigned* st) {
    XcdBarrier b; b.bar = bar; b.x = xb_xcc_id(); b.st = st;
    if (threadIdx.x == 0) (void)xb_add(&bar[XB_XCNT(b.x)], 1u);
    return b;
}
__device__ __forceinline__ void xcd_barrier_complete(unsigned* bar, unsigned x, unsigned& nloc, unsigned& nx) {
    const unsigned G = gridDim.x * gridDim.y * gridDim.z;
    unsigned sum, cnt, mine, sp = 0u;
    for (;;) {
        sum = 0u; cnt = 0u; mine = 0u;
#pragma unroll
        for (unsigned j = 0; j < 16; ++j) { const unsigned c = xb_ld(&bar[XB_XCNT(j)]); sum += c; cnt += (c > 0u) ? 1u : 0u; mine = (j == x) ? c : mine; }
        if (sum == G) break;
        __builtin_amdgcn_s_sleep(1);
        if ((++sp & 255u) == 0u) { if (xb_ld(&bar[XB_TMO])) break; if (sp > XB_SPIN_CAP) { atomicAdd(&bar[XB_TMO], 1u); break; } }
    }
    nloc = mine > 0u ? mine : 1u; nx = cnt > 0u ? cnt : 1u;
}

__device__ __forceinline__ void xcd_barrier(const XcdBarrier& b) {
    asm volatile("s_waitcnt vmcnt(0)" ::: "memory");
    __syncthreads();
    if (threadIdx.x == 0) {
        unsigned* bar = b.bar;
        __builtin_amdgcn_s_waitcnt(0);
        unsigned nloc = b.st[0], nx = b.st[1];
        if (nloc == 0u) { xcd_barrier_complete(bar, b.x, nloc, nx); b.st[0] = nloc; b.st[1] = nx; }
        const unsigned old = xb_add(&bar[XB_XSUB(b.x)], 1u);
        const unsigned gen = old / nloc;
        if (old + 1u == (gen + 1u) * nloc) {
            __builtin_amdgcn_fence(__ATOMIC_RELEASE, "agent");
            asm volatile("s_waitcnt vmcnt(0)" ::: "memory");
            const unsigned og = xb_add(&bar[XB_TOP], 1u);
            const unsigned tg = og / nx;
            if (og + 1u == (tg + 1u) * nx) xb_add(&bar[XB_TOPGEN], 1u);
            else XB_SPIN(xb_ld(&bar[XB_TOPGEN]) == tg, bar);
            __builtin_amdgcn_fence(__ATOMIC_ACQUIRE, "agent");
            xb_add(&bar[XB_XGEN(b.x)], 1u);
            asm volatile("s_waitcnt vmcnt(0)" ::: "memory");
        } else {
            XB_SPIN(xb_ld(&bar[XB_XGEN(b.x)]) == gen, bar);
            __builtin_amdgcn_fence(__ATOMIC_ACQUIRE, "agent");
            asm volatile("s_waitcnt vmcnt(0)" ::: "memory");
        }
    }
    __syncthreads();
}

struct Args {
    const float* in[25]; float* out; unsigned char* ws; int ph_lo, ph_hi, ph_rep, pad_;
};
enum { I_X = 0, I_N1G, I_WIN, I_MU, I_QG, I_KG, I_RELB, I_W0, I_WDEC, I_A0, I_WAAA, I_WGATE, I_KK, I_KA, I_RK, I_LNG, I_LNB, I_WOUT, I_N2G, I_WR, I_BR, I_WUP, I_BUP, I_WDN, I_BDN };
struct Frame {
    LAS unsigned char* lds;
    int tid, lane, wave, G, bid;
};


struct TrRegs { f32x4 v[8]; f32x4 s0, s1; bf16* dst; int ldo; };
DI void tr_load(TrRegs& t, const float* __restrict__ W, int ldw, int k0, int n0, bf16* WT, int ldo, long drow, int lane, const float* __restrict__ ksc8 = nullptr) {
    const int r8 = lane >> 3, c4 = lane & 7;
    t.s0 = (f32x4){1.f, 1.f, 1.f, 1.f}; t.s1 = t.s0; if (ksc8) { t.s0 = *(const f32x4*)ksc8; t.s1 = *(const f32x4*)(ksc8 + 4); }
    const float* src = W + (size_t)(k0 + 8 * r8) * ldw + n0 + 4 * c4;
#pragma unroll
    for (int i = 0; i < 8; ++i) t.v[i] = __builtin_nontemporal_load((const f32x4*)(src + (size_t)i * ldw));
    t.dst = WT + (size_t)(drow + 4 * c4) * ldo + k0 + 8 * r8; t.ldo = ldo;
}
DI void tr_store(const TrRegs& t, const float* __restrict__ = nullptr) {
    const f32x4 s0 = t.s0, s1 = t.s1;
#pragma unroll
    for (int j = 0; j < 4; ++j) { const v4u o = {pk2(t.v[0][j] * s0[0], t.v[1][j] * s0[1]), pk2(t.v[2][j] * s0[2], t.v[3][j] * s0[3]), pk2(t.v[4][j] * s1[0], t.v[5][j] * s1[1]), pk2(t.v[6][j] * s1[2], t.v[7][j] * s1[3])};
        __builtin_nontemporal_store(o, (v4u*)(t.dst + (size_t)j * t.ldo)); }
}
DI void tr_item(const float* __restrict__ W, int ldw, int k0, int n0, bf16* WT, int ldo, long drow, LAS float* scr, int lane, const float* __restrict__ ksc) {
    (void)scr; TrRegs t; tr_load(t, W, ldw, k0, n0, WT, ldo, drow, lane, ksc ? ksc + k0 + 8 * (lane >> 3) : nullptr); tr_store(t);
}
constexpr int MOE_TR_UP = NEXP * 16 * 64, MOE_TR_DN = NEXP * 16 * 32, MOE_TR_ALL = MOE_TR_UP + MOE_TR_DN;
DI const float* moe_tr_load(TrRegs& t, const Args& a, int r, int lane) {
    unsigned char* ws = a.ws;
    if (r < MOE_TR_UP) { const int e = r / 1024, kb = (r % 1024) / 64, nb = r % 64, n0 = 32 * nb; const int n1 = n0 & 1023;
        const long drow = (long)(n1 / 128) * 256 + (n0 >= 1024 ? 128 : 0) + (n1 % 128);
        tr_load(t, a.in[I_WUP] + (size_t)e * 1024 * 2048, 2048, 64 * kb, n0, (bf16*)(ws + WS_WUP) + (size_t)e * 2048 * 1024, 1024, drow, lane, a.in[I_N2G] + 64 * kb + 8 * (lane >> 3));
        return nullptr; }
    r -= MOE_TR_UP; const int e = r / 512, kb = (r % 512) / 32, nb = r % 32;
    tr_load(t, a.in[I_WDN] + (size_t)e * 1024 * 1024, 1024, 64 * kb, 32 * nb, (bf16*)(ws + WS_WDN) + (size_t)e * 1024 * 1024, 1024, 32 * nb, lane);
    return nullptr;
}
DI void moe_tr_item(const Args& a, int r, LAS float* scr, int lane) { (void)scr; TrRegs t; const float* s = moe_tr_load(t, a, r, lane); tr_store(t, s); }
DI unsigned q_pack4(float a, float b, float c, float d) {
    const unsigned ua = __builtin_bit_cast(unsigned, a), ub = __builtin_bit_cast(unsigned, b), uc = __builtin_bit_cast(unsigned, c), ud = __builtin_bit_cast(unsigned, d);
    return (ua & 0xffu) | ((ub & 0xffu) << 8) | ((uc & 0xffu) << 16) | (ud << 24); }
constexpr float Q_MAGIC = 12582912.0f;
template <bool DOWN>
DI void moe_q_batch(const Args& a, int batch, int wave, int lane, LAS float* exch) {
    unsigned char* ws = a.ws;
    constexpr int LDW = DOWN ? 1024 : 2048, SPE = LDW / 32;
    const int strip = batch * 4 + (wave >> 1), half = wave & 1, e = strip / SPE, nb = strip % SPE, n0 = 32 * nb, n1 = n0 & 1023;
    const int r8 = lane >> 3, c4 = lane & 7;
    const long drow = DOWN ? (long)n0 : (long)(n1 / 128) * 256 + (n0 >= 1024 ? 128 : 0) + (n1 % 128);
    const float* W = a.in[DOWN ? I_WDN : I_WUP] + (size_t)e * 1024 * LDW + (size_t)(512 * half + 8 * r8) * LDW + n0 + 4 * c4;
    const float* gk = a.in[I_N2G] + 512 * half + 8 * r8;
    const f32x4 one = {1.f, 1.f, 1.f, 1.f};
    f32x4 mx = {0.f, 0.f, 0.f, 0.f};
    for (int g = 0; g < 8; g += 4) {
        f32x4 v[4][8], s0[4], s1[4];
#pragma unroll
        for (int t = 0; t < 4; ++t) { s0[t] = DOWN ? one : *(const f32x4*)(gk + 64 * (g + t)); s1[t] = DOWN ? one : *(const f32x4*)(gk + 64 * (g + t) + 4);
#pragma unroll
            for (int i = 0; i < 8; ++i) v[t][i] = *(const f32x4*)(W + (size_t)(64 * (g + t) + i) * LDW); }
#pragma unroll
        for (int t = 0; t < 4; ++t)
#pragma unroll
            for (int i = 0; i < 8; ++i) { const float s = i < 4 ? s0[t][i] : s1[t][i - 4]; const f32x4 p = v[t][i] * s;
#pragma unroll
                for (int j = 0; j < 4; ++j) mx[j] = fmaxf(mx[j], fabsf(p[j])); }
    }
#pragma unroll
    for (int j = 0; j < 4; ++j) { float m = mx[j]; m = fmaxf(m, __shfl_xor(m, 8)); m = fmaxf(m, __shfl_xor(m, 16)); m = fmaxf(m, __shfl_xor(m, 32)); mx[j] = m; }
    if (r8 == 0) *(LAS f32x4*)(exch + (wave * 8 + c4) * 4) = mx;
    __syncthreads();
    { const f32x4 o = *(const LAS f32x4*)(exch + ((wave ^ 1) * 8 + c4) * 4);
#pragma unroll
      for (int j = 0; j < 4; ++j) mx[j] = fmaxf(mx[j], o[j]); }
    constexpr float QMAX = DOWN ? 256.0f : 127.0f;
    if (half == 0 && r8 == 0) *(f32x4*)((float*)(ws + (DOWN ? WS_COLSC2 : WS_COLSC)) + (size_t)e * LDW + n0 + 4 * c4) = mx * (1.0f / QMAX);
    f32x4 inv;
#pragma unroll
    for (int j = 0; j < 4; ++j) inv[j] = mx[j] > 0.f ? QMAX / mx[j] : 0.f;
    unsigned char* dst = ws + (DOWN ? WS_WDN : WS_WUP) + ((size_t)e * LDW + drow + 4 * c4) * 1024 + 512 * half + 8 * r8;
    for (int g = 0; g < 8; g += 2) {
        f32x4 v[2][8], s0[2], s1[2];
#pragma unroll
        for (int t = 0; t < 2; ++t) { s0[t] = DOWN ? one : *(const f32x4*)(gk + 64 * (g + t)); s1[t] = DOWN ? one : *(const f32x4*)(gk + 64 * (g + t) + 4);
#pragma unroll
            for (int i = 0; i < 8; ++i) v[t][i] = __builtin_nontemporal_load((const f32x4*)(W + (size_t)(64 * (g + t) + i) * LDW)); }
#pragma unroll
        for (int t = 0; t < 2; ++t) {
            f32x4 p[8];
#pragma unroll
            for (int i = 0; i < 8; ++i) { const float s = i < 4 ? s0[t][i] : s1[t][i - 4]; p[i] = DOWN ? v[t][i] * inv : (v[t][i] * s) * inv + Q_MAGIC; }
#pragma unroll
            for (int j = 0; j < 4; ++j) { v2u o;
                if (DOWN) { o.x = (unsigned)__builtin_amdgcn_cvt_pk_fp8_f32(p[2][j], p[3][j], __builtin_amdgcn_cvt_pk_fp8_f32(p[0][j], p[1][j], 0, false), true);
                            o.y = (unsigned)__builtin_amdgcn_cvt_pk_fp8_f32(p[6][j], p[7][j], __builtin_amdgcn_cvt_pk_fp8_f32(p[4][j], p[5][j], 0, false), true); }
                else { o.x = q_pack4(p[0][j], p[1][j], p[2][j], p[3][j]); o.y = q_pack4(p[4][j], p[5][j], p[6][j], p[7][j]); }
                __builtin_nontemporal_store(o, (v2u*)(dst + (size_t)j * 1024 + 64 * (g + t))); } }
    }
}
DI void q_strip_i8_wg(const float* __restrict__ Wsrc, int ldw, int n0, unsigned char* WT, float* colsc, int wave, int lane, LAS float* exch) {
    const int r8 = lane >> 3, c4 = lane & 7;
    const float* W = Wsrc + (size_t)(128 * wave + 8 * r8) * ldw + n0 + 4 * c4;
    f32x4 v[2][8], mx = {0.f, 0.f, 0.f, 0.f};
#pragma unroll
    for (int t = 0; t < 2; ++t)
#pragma unroll
        for (int i = 0; i < 8; ++i) v[t][i] = *(const f32x4*)(W + (size_t)(64 * t + i) * ldw);
#pragma unroll
    for (int t = 0; t < 2; ++t)
#pragma unroll
        for (int i = 0; i < 8; ++i)
#pragma unroll
            for (int j = 0; j < 4; ++j) mx[j] = fmaxf(mx[j], fabsf(v[t][i][j]));
#pragma unroll
    for (int j = 0; j < 4; ++j) { float m = mx[j]; m = fmaxf(m, __shfl_xor(m, 8)); m = fmaxf(m, __shfl_xor(m, 16)); m = fmaxf(m, __shfl_xor(m, 32)); mx[j] = m; }
    if (r8 == 0) *(LAS f32x4*)(exch + (wave * 8 + c4) * 4) = mx;
    __syncthreads();
#pragma unroll
    for (int w2 = 0; w2 < 8; ++w2) { const f32x4 o = *(const LAS f32x4*)(exch + (w2 * 8 + c4) * 4);
#pragma unroll
        for (int j = 0; j < 4; ++j) mx[j] = fmaxf(mx[j], o[j]); }
    if (wave == 0 && r8 == 0) *(f32x4*)(colsc + n0 + 4 * c4) = mx * (1.0f / 127.0f);
    f32x4 inv;
#pragma unroll
    for (int j = 0; j < 4; ++j) inv[j] = mx[j] > 0.f ? 127.0f / mx[j] : 0.f;
    unsigned char* dst = WT + (size_t)(n0 + 4 * c4) * 1024 + 128 * wave + 8 * r8;
#pragma unroll
    for (int t = 0; t < 2; ++t) {
        f32x4 p[8];
#pragma unroll
        for (int i = 0; i < 8; ++i) p[i] = v[t][i] * inv + Q_MAGIC;
#pragma unroll
        for (int j = 0; j < 4; ++j) { const v2u o = {q_pack4(p[0][j], p[1][j], p[2][j], p[3][j]), q_pack4(p[4][j], p[5][j], p[6][j], p[7][j])};
            *(v2u*)(dst + (size_t)j * 1024 + 64 * t) = o; } }
}
DI void moe_tr_batch(const Args& a, int batch, int wave, int lane, LAS float* exch) {
    if (batch < MOE_TR_UP / 64) moe_q_batch<false>(a, batch, wave, lane, exch); else moe_q_batch<true>(a, batch - MOE_TR_UP / 64, wave, lane, exch);
}
constexpr int MOE_TR_BATCHES = MOE_TR_ALL / 64, MOE_TR_EARLY = 256;

#if !NAIVE_ATT
constexpr int ATT_KS = 144;
constexpr int ATT_TILE = 64 * ATT_KS;
constexpr int ATT_BIAS_OFF = 4 * ATT_TILE;
constexpr int ATT_NSLOT = (NBATCH * 8 * (NCHUNK / 2) / 8) * 11;
static_assert(NBATCH * 8 * (NCHUNK / 2) == 2048 && MOE_TR_ALL == 256 * 3 * 64, "attention / conversion work queue");
DI int att_pos(int key) { return (key & 32) + 8 * ((key >> 2) & 3) + 4 * ((key >> 4) & 1) + (key & 3); }
DI void attn_phase(const Frame& F, const Args& a, const int qid = 0) {
    const bf16* proj = (const bf16*)(a.ws + WS_PROJ); bf16* mix = (bf16*)(a.ws + WS_MIX);
    LAS unsigned char* lds = F.lds; LAS float* sbias = (LAS float*)(lds + ATT_BIAS_OFF);
    const int l = F.lane, n16 = l & 15, q = l >> 4, w = F.wave;
    const float LOG2E = 1.4426950408889634f;
    const int srow = F.tid >> 3, spc = F.tid & 7;
    float kgv[8];
#pragma unroll
    for (int j = 0; j < 8; ++j) kgv[j] = a.in[I_KG][8 * spc + j];
    const int spos = att_pos(srow);
    LAS int* s_item = (LAS int*)(lds + ATT_BIAS_OFF + 1024);
    unsigned* qhead = (unsigned*)(a.ws + WS_CTL) + CW_ATT + 64 * qid;
    for (;;) {
        __syncthreads();
        if (F.tid == 0) *s_item = (int)__hip_atomic_fetch_add(qhead, 1u, __ATOMIC_RELAXED, __HIP_MEMORY_SCOPE_AGENT);
        __syncthreads();
        const int slot = *s_item;
        if (slot >= ATT_NSLOT) break;
        const int grp = slot / 11, sub = slot % 11;
        if (sub >= 8) { const int base = (grp * 3 + (sub - 8)) * 64 + w * 8;
            (void)base; moe_tr_batch(a, grp * 3 + (sub - 8), w, l, (LAS float*)(lds + ATT_BIAS_OFF + 2048));
            continue; }
        const int item = grp * 8 + sub;
        const int b = item / (8 * (NCHUNK / 2)), h = (item / (NCHUNK / 2)) & 7, n0 = 2 * (item % (NCHUNK / 2));
        if (F.tid < 192) sbias[F.tid] = a.in[I_RELB][h * 192 + F.tid] * LOG2E;
        const int nq = n0 + (w >> 2), qpos = 16 * (w & 3) + n16;
        const size_t qtok = (size_t)b * SEQ + nq * 64 + qpos;
        bf16x8 qf[2];
        { const v4u q0 = *(const v4u*)(proj + qtok * INC + h * 64 + 8 * q), q1 = *(const v4u*)(proj + qtok * INC + h * 64 + 32 + 8 * q);
          float f[16]; const unsigned ww[8] = {q0.x, q0.y, q0.z, q0.w, q1.x, q1.y, q1.z, q1.w};
          float ss = 0.f;
#pragma unroll
          for (int e = 0; e < 8; ++e) { f[2 * e] = bflo(ww[e]); f[2 * e + 1] = bfhi(ww[e]); ss += f[2 * e] * f[2 * e] + f[2 * e + 1] * f[2 * e + 1]; }
          ss = quad_sum(ss);
          const float rs = (1.0f / sqrtf(ss * (1.f / 64.f) + 1e-6f)) * 0.125f * LOG2E;
          unsigned pk[8];
#pragma unroll
          for (int e = 0; e < 8; ++e) { const int d = (e < 4 ? 0 : 32) + 8 * q + 2 * (e & 3); pk[e] = pk2(f[2 * e] * rs * a.in[I_QG][d], f[2 * e + 1] * rs * a.in[I_QG][d + 1]); }
          const v4u p0 = {pk[0], pk[1], pk[2], pk[3]}, p1 = {pk[4], pk[5], pk[6], pk[7]};
          qf[0] = __builtin_bit_cast(bf16x8, p0); qf[1] = __builtin_bit_cast(bf16x8, p1); }
        f32x4 o[4];
#pragma unroll
        for (int dt = 0; dt < 4; ++dt) o[dt] = (f32x4){0.f, 0.f, 0.f, 0.f};
        float m_run = -3.0e38f, l_run = 0.f;
        v4u kreg, vreg;
        auto gload = [&](int jc) { const int kc = n0 - 8 + jc; if (kc >= 0) { const size_t tok = (size_t)b * SEQ + kc * 64 + srow;
            kreg = *(const v4u*)(proj + tok * INC + 512 + h * 64 + 8 * spc); vreg = *(const v4u*)(proj + tok * INC + 1024 + h * 64 + 8 * spc); } };
        auto lstore = [&](int jc) { const int kc = n0 - 8 + jc; if (kc >= 0) { LAS unsigned char* kb = lds + (jc & 1) * 2 * ATT_TILE; LAS unsigned char* vb = kb + ATT_TILE;
            const unsigned ww[4] = {kreg.x, kreg.y, kreg.z, kreg.w}; float f[8]; float ss = 0.f;
#pragma unroll
            for (int e = 0; e < 4; ++e) { f[2 * e] = bflo(ww[e]); f[2 * e + 1] = bfhi(ww[e]); ss += f[2 * e] * f[2 * e] + f[2 * e + 1] * f[2 * e + 1]; }
            ss += __builtin_bit_cast(float, __builtin_amdgcn_update_dpp(0, __builtin_bit_cast(int, ss), 0xB1, 0xf, 0xf, true));
            ss += __builtin_bit_cast(float, __builtin_amdgcn_update_dpp(0, __builtin_bit_cast(int, ss), 0x4E, 0xf, 0xf, true));
            ss += __builtin_bit_cast(float, __builtin_amdgcn_update_dpp(0, __builtin_bit_cast(int, ss), 0x141, 0xf, 0xf, true));
            const float rs = 1.0f / sqrtf(ss * (1.f / 64.f) + 1e-6f);
            v4u kk; kk.x = pk2(f[0] * rs * kgv[0], f[1] * rs * kgv[1]); kk.y = pk2(f[2] * rs * kgv[2], f[3] * rs * kgv[3]); kk.z = pk2(f[4] * rs * kgv[4], f[5] * rs * kgv[5]); kk.w = pk2(f[6] * rs * kgv[6], f[7] * rs * kgv[7]);
            *(LAS v4u*)(kb + srow * ATT_KS + 16 * spc) = kk;
            const unsigned vv[4] = {vreg.x, vreg.y, vreg.z, vreg.w};
#pragma unroll
            for (int e = 0; e < 4; ++e) { *(LAS unsigned short*)(vb + (8 * spc + 2 * e) * ATT_KS + 2 * spos) = (unsigned short)(vv[e] & 0xffffu);
                                          *(LAS unsigned short*)(vb + (8 * spc + 2 * e + 1) * ATT_KS + 2 * spos) = (unsigned short)(vv[e] >> 16); } } };
        gload(0); lstore(0);
        __syncthreads();
        for (int jc = 0; jc < 10; ++jc) {
            if (jc + 1 < 10) gload(jc + 1);
            const int kc = n0 - 8 + jc, dj = jc - (w >> 2);
            if (kc >= 0 && dj >= 0 && dj <= 8) {
                const LAS unsigned char* kb = lds + (jc & 1) * 2 * ATT_TILE; const LAS unsigned char* vb = kb + ATT_TILE;
                f32x4 sc[4];
#pragma unroll
                for (int mt = 0; mt < 4; ++mt) { sc[mt] = (f32x4){0.f, 0.f, 0.f, 0.f};
#pragma unroll
                    for (int ks = 0; ks < 2; ++ks) { const bf16x8 kf = *(const LAS bf16x8*)(kb + (16 * mt + n16) * ATT_KS + 64 * ks + 16 * q);
                        sc[mt] = __builtin_amdgcn_mfma_f32_16x16x32_bf16(kf, qf[ks], sc[mt], 0, 0, 0); } }
                float boff = 0.f;
                if (dj <= 5) boff = sbias[0];
                else { const int base = (dj - 8) * 64 - qpos + 128;
#pragma unroll
                    for (int mt = 0; mt < 4; ++mt)
#pragma unroll
                        for (int i = 0; i < 4; ++i) { int idx = base + 16 * mt + 4 * q + i; idx = idx < 0 ? 0 : idx; const float bv_ = sbias[idx];
                            sc[mt][i] += bv_; } }
                float mx = sc[0][0];
#pragma unroll
                for (int mt = 0; mt < 4; ++mt)
#pragma unroll
                    for (int i = 0; i < 4; ++i) mx = fmaxf(mx, sc[mt][i]);
                mx = quad_max(mx);
                const float m_new = fmaxf(m_run, mx + boff), alpha = __builtin_amdgcn_exp2f(m_run - m_new), msub = m_new - boff;
                const bool moved = __builtin_amdgcn_ballot_w64(m_new != m_run) != 0ull;
                m_run = m_new; float ls = 0.f;
#pragma unroll
                for (int mt = 0; mt < 4; ++mt)
#pragma unroll
                    for (int i = 0; i < 4; ++i) { sc[mt][i] = __builtin_amdgcn_exp2f(sc[mt][i] - msub); ls += sc[mt][i]; }
                if (moved) { l_run *= alpha;
#pragma unroll
                    for (int dt = 0; dt < 4; ++dt) o[dt] = o[dt] * alpha; }
                l_run += ls;
#pragma unroll
                for (int s = 0; s < 2; ++s) {
                    const v4u pp = {pk2(sc[2 * s][0], sc[2 * s][1]), pk2(sc[2 * s][2], sc[2 * s][3]), pk2(sc[2 * s + 1][0], sc[2 * s + 1][1]), pk2(sc[2 * s + 1][2], sc[2 * s + 1][3])};
                    const bf16x8 pf = __builtin_bit_cast(bf16x8, pp);
#pragma unroll
                    for (int dt = 0; dt < 4; ++dt) { const bf16x8 vf = *(const LAS bf16x8*)(vb + (16 * dt + n16) * ATT_KS + 64 * s + 16 * q);
                        o[dt] = __builtin_amdgcn_mfma_f32_16x16x32_bf16(vf, pf, o[dt], 0, 0, 0); } }
            }
            if (jc + 1 < 10) lstore(jc + 1);
            __syncthreads();
        }
        l_run = quad_sum(l_run);
        const float inv = 1.0f / l_run;
#pragma unroll
        for (int dt = 0; dt < 4; ++dt) { v2u ov; ov.x = pk2(o[dt][0] * inv, o[dt][1] * inv); ov.y = pk2(o[dt][2] * inv, o[dt][3] * inv);
            *(v2u*)(mix + qtok * 1024 + h * 64 + 16 * dt + 4 * q) = ov; }
    }
}
#endif

#if !NAIVE_RWKV
constexpr int RA_HALF = 80896;
constexpr int RA_RT = 0, RA_KT = 9216, RA_BT = 18432, RA_AT = 27648;
constexpr int RA_VT = 36864, RA_KH = 46080, RA_BH = 55296;
constexpr int RA_AAB = 64512;
constexpr int RA_XWD = 0, RA_XAD = 9216, RA_XGD = 18432;
constexpr int RA_RHS2 = 0, RA_GEND = 17408;
constexpr int RA_W1T = 18432, RA_W2T = 27648;
constexpr int RA_WT = RA_AAB;
constexpr int RB_REC = 65536, RB_YLT = 0, RB_PCT = 8192, RB_G1T = 16384, RB_E2T = 24576, RB_MC = 32768, RB_CC = 40960, RB_SC = 57344;
static_assert(2 * RA_HALF <= MISC_OFF, "rwkv phase A LDS");

DI void ld8f(const bf16* p, float (&f)[8]) { const v4u w = *(const v4u*)p; f[0] = bflo(w.x); f[1] = bfhi(w.x); f[2] = bflo(w.y); f[3] = bfhi(w.y); f[4] = bflo(w.z); f[5] = bfhi(w.z); f[6] = bflo(w.w); f[7] = bfhi(w.w); }
DI void ld4f(const bf16* p, float (&f)[4]) { const v2u w = *(const v2u*)p; f[0] = bflo(w.x); f[1] = bfhi(w.x); f[2] = bflo(w.y); f[3] = bfhi(w.y); }
DI bf16x8 pack8(const f32x4& a, const f32x4& b) { const v4u p = {pk2(a[0], a[1]), pk2(a[2], a[3]), pk2(b[0], b[1]), pk2(b[2], b[3])}; return __builtin_bit_cast(bf16x8, p); }
DI float fast_sigmoid(float x) { return __builtin_amdgcn_rcpf(1.0f + __builtin_amdgcn_exp2f(-1.4426950408889634f * x)); }
DI float fast_tanh(float x) { return 1.0f - 2.0f * __builtin_amdgcn_rcpf(1.0f + __builtin_amdgcn_exp2f(2.8853900817779268f * x)); }
#define MFMA16(a, b, c) __builtin_amdgcn_mfma_f32_16x16x32_bf16((a), (b), (c), 0, 0, 0)

DI void rwkv_phase_a(const Frame& F, const Args& a) {
    unsigned char* ws = a.ws; unsigned char* rb = ws + WS_RW;
    const bf16* wdec = (const bf16*)(ws + WS_WDEC); const bf16* waaa = (const bf16*)(ws + WS_WAAA); const bf16* wgate = (const bf16*)(ws + WS_WGATE);
    const float* mu = a.in[I_MU]; const float* par = (const float*)(ws + WS_PAR);
    const int hb = F.wave >> 2, w4 = F.wave & 3;
    LAS unsigned char* hbase = F.lds + hb * RA_HALF;
    const float LOG2E = 1.4426950408889634f;
    v4u s0c[4];
#define RA_REQUEST(pair_) do { const int item_ = 2 * (pair_) + hb, c_ = (item_ >> 3) & 127, b_ = item_ >> 10; const size_t tok0_ = (size_t)b_ * SEQ + c_ * 64; \
        int lq_ = F.lane; asm volatile("" : "+v"(lq_)); size_t wsq_ = (size_t)ws; asm volatile("" : "+s"(wsq_)); const int t9q_ = (hb << 8) | (w4 << 6) | lq_; \
        const bf16* cur_ = (const bf16*)(wsq_ + WS_PROJ) + (tok0_ + (t9q_ >> 3)) * INC + PRW + 1536 + 32 * (t9q_ & 7); \
        _Pragma("unroll") for (int g8 = 0; g8 < 4; ++g8) s0c[g8] = *(const v4u*)(cur_ + 8 * g8); } while (0)
    if (F.bid < NITEM / 2) RA_REQUEST(F.bid);
    for (int pair = F.bid; pair < NITEM / 2; pair += F.G) {
        size_t wsb = (size_t)ws; asm volatile("" : "+s"(wsb)); const bf16* proj = (const bf16*)(wsb + WS_PROJ);
        int l = F.lane; asm volatile("" : "+v"(l));
        const int n16 = l & 15, q = l >> 4, t4 = (hb << 8 | (F.wave & 3) << 6 | l) & 255;
        const int tokl = 16 * w4 + n16;
        const int tslot = (tokl & 32) + 8 * ((tokl >> 2) & 3) + 4 * ((tokl >> 4) & 1) + (tokl & 3);
        const int item = 2 * pair + hb, h = item & 7, c = (item >> 3) & 127, b = item >> 10;
        const size_t tok0 = (size_t)b * SEQ + c * 64; unsigned char* rbi = rb + (size_t)item * RB_REC;
        const int t9 = (hb << 8) | t4, tk0 = t9 >> 3, part = t9 & 7;
        v4u s0p[4];
        { const bool first = (c == 0 && tk0 == 0); const bf16* prv = proj + (tok0 + tk0) * INC + PRW + 1536 + 32 * part - INC;
#pragma unroll
          for (int g8 = 0; g8 < 4; ++g8) { s0p[g8] = (v4u){0u, 0u, 0u, 0u}; if (!first) s0p[g8] = *(const v4u*)(prv + 8 * g8); } }
        v2u rawc[3][4], rawp[3][4];
        { const bool first = (c == 0 && tokl == 0); const bf16* cur = proj + (tok0 + tokl) * INC + PRW + h * 64 + 4 * q; const bf16* prv = cur - INC;
#pragma unroll
          for (int m = 0; m < 3; ++m)
#pragma unroll
              for (int ct = 0; ct < 4; ++ct) { rawc[m][ct] = *(const v2u*)(cur + 512 * m + 16 * ct); rawp[m][ct] = (v2u){0u, 0u}; if (!first) rawp[m][ct] = *(const v2u*)(prv + 512 * m + 16 * ct); } }
        bf16x8 wfr[2][8];
#define RA_WLOAD(dst, ctv) do { const int row_ = h * 64 + 16 * (ctv) + n16; \
            dst[0] = *(const bf16x8*)(wdec + row_ * 64 + 8 * q); dst[1] = *(const bf16x8*)(wdec + row_ * 64 + 32 + 8 * q); \
            dst[2] = *(const bf16x8*)(waaa + row_ * 64 + 8 * q); dst[3] = *(const bf16x8*)(waaa + row_ * 64 + 32 + 8 * q); \
            _Pragma("unroll") for (int ks_ = 0; ks_ < 4; ++ks_) dst[4 + ks_] = *(const bf16x8*)(wgate + row_ * 128 + 32 * ks_ + 8 * q); } while (0)
        RA_WLOAD(wfr[0], 0); RA_WLOAD(wfr[1], 1);
        __syncthreads();
        { const float esc = part < 2 ? 2.8853900817779268f : -1.4426950408889634f;
          LAS unsigned char* dst = F.lds + (part < 2 ? RA_XWD + tk0 * 144 + part * 64 : (part < 4 ? RA_XAD + tk0 * 144 + (part - 2) * 64 : RA_XGD + tk0 * 272 + (part - 4) * 64));
#pragma unroll
          for (int g8 = 0; g8 < 4; ++g8) {
              const unsigned xw[4] = {s0c[g8].x, s0c[g8].y, s0c[g8].z, s0c[g8].w}, pw[4] = {s0p[g8].x, s0p[g8].y, s0p[g8].z, s0p[g8].w};
              const f32x4 m0 = *(const f32x4*)(mu + 1536 + 32 * part + 8 * g8), m1 = *(const f32x4*)(mu + 1536 + 32 * part + 8 * g8 + 4);
              float y[8];
#pragma unroll
              for (int j = 0; j < 8; ++j) { const float x = (j & 1) ? bfhi(xw[j >> 1]) : bflo(xw[j >> 1]), p = (j & 1) ? bfhi(pw[j >> 1]) : bflo(pw[j >> 1]);
                  const float xs = x + (p - x) * (j < 4 ? m0[j & 3] : m1[j & 3]);
                  const float rc = __builtin_amdgcn_rcpf(1.0f + __builtin_amdgcn_exp2f(esc * xs));
                  y[j] = part < 2 ? 1.0f - 2.0f * rc : (part < 4 ? xs : rc); }
              const v4u o = {pk2(y[0], y[1]), pk2(y[2], y[3]), pk2(y[4], y[5]), pk2(y[6], y[7])};
              *(LAS v4u*)(dst + 16 * g8) = o; } }
        v2u shv[3][4];
#pragma unroll
        for (int m = 0; m < 3; ++m)
#pragma unroll
            for (int ct = 0; ct < 4; ++ct) { const v2u xw = rawc[m][ct], pw = rawp[m][ct];
                const f32x4 mm = *(const f32x4*)(mu + 512 * m + h * 64 + 16 * ct + 4 * q);
                const float x0 = bflo(xw.x), x1 = bfhi(xw.x), x2 = bflo(xw.y), x3 = bfhi(xw.y);
                shv[m][ct].x = pk2(x0 + (bflo(pw.x) - x0) * mm[0], x1 + (bfhi(pw.x) - x1) * mm[1]); shv[m][ct].y = pk2(x2 + (bflo(pw.y) - x2) * mm[2], x3 + (bfhi(pw.y) - x3) * mm[3]); }
        __syncthreads();
        f32x4 awl[4], aal[4], ag[4];
        { bf16x8 bwd[2], bad[2], bgd[4], wf2[2][8];
          RA_WLOAD(wf2[0], 2); RA_WLOAD(wf2[1], 3);
#pragma unroll
          for (int ks = 0; ks < 2; ++ks) { bwd[ks] = *(const LAS bf16x8*)(F.lds + RA_XWD + tokl * 144 + 64 * ks + 16 * q); bad[ks] = *(const LAS bf16x8*)(F.lds + RA_XAD + tokl * 144 + 64 * ks + 16 * q); }
#pragma unroll
          for (int ks = 0; ks < 4; ++ks) bgd[ks] = *(const LAS bf16x8*)(F.lds + RA_XGD + tokl * 272 + 64 * ks + 16 * q);
#pragma unroll
          for (int ct = 0; ct < 4; ++ct) { const bf16x8* wv = ct < 2 ? wfr[ct] : wf2[ct - 2];
              awl[ct] = (f32x4){0.f, 0.f, 0.f, 0.f}; aal[ct] = awl[ct]; ag[ct] = awl[ct];
#pragma unroll
              for (int ks = 0; ks < 2; ++ks) { awl[ct] = MFMA16(wv[ks], bwd[ks], awl[ct]); aal[ct] = MFMA16(wv[2 + ks], bad[ks], aal[ct]); }
#pragma unroll
              for (int ks = 0; ks < 4; ++ks) ag[ct] = MFMA16(wv[4 + ks], bgd[ks], ag[ct]); } }
#undef RA_WLOAD
        v2u rtp[4];
        {
#define RA_SHIFT(dst, pcol, ctv) do { const v2u w_ = shv[(pcol) / 512][ctv]; dst[0] = bflo(w_.x); dst[1] = bfhi(w_.x); dst[2] = bflo(w_.y); dst[3] = bfhi(w_.y); } while (0)
          float nrm = 0.f, bd = 0.f;
#pragma unroll
          for (int ct = 0; ct < 4; ++ct) { const int ch = h * 64 + 16 * ct + 4 * q;
              float r4[4], k4[4]; RA_SHIFT(r4, 0, ct); RA_SHIFT(k4, 512, ct);
              const f32x4 a0v = *(const f32x4*)(par + 512 + ch), kkv = *(const f32x4*)(par + 1024 + ch), kav = *(const f32x4*)(par + 1536 + ch), rkv = *(const f32x4*)(par + 2048 + ch);
#pragma unroll
              for (int i = 0; i < 4; ++i) { const float av = fast_sigmoid(a0v[i] + aal[ct][i]); const float kk = k4[i] * kkv[i]; nrm += kk * kk;
                  bd += r4[i] * (k4[i] * (1.0f + (av - 1.0f) * kav[i])) * rkv[i]; } }
          nrm = quad_sum(nrm); bd = quad_sum(bd);
          const float kinv = 1.0f / fmaxf(sqrtf(nrm), 1e-12f);
          float lw[4][4], lg[4][4], lgend[4][4];
#pragma unroll
          for (int ct = 0; ct < 4; ++ct) { const f32x4 w0v = *(const f32x4*)(par + h * 64 + 16 * ct + 4 * q);
#pragma unroll
              for (int i = 0; i < 4; ++i) { lw[ct][i] = (-0.6065306597126334f * LOG2E) * fast_sigmoid(w0v[i] + awl[ct][i]); float x = lw[ct][i];
                  x += __builtin_bit_cast(float, __builtin_amdgcn_update_dpp(0, __builtin_bit_cast(int, x), 0x111, 0xf, 0xf, false));
                  x += __builtin_bit_cast(float, __builtin_amdgcn_update_dpp(0, __builtin_bit_cast(int, x), 0x112, 0xf, 0xf, false));
                  x += __builtin_bit_cast(float, __builtin_amdgcn_update_dpp(0, __builtin_bit_cast(int, x), 0x114, 0xf, 0xf, false));
                  x += __builtin_bit_cast(float, __builtin_amdgcn_update_dpp(0, __builtin_bit_cast(int, x), 0x118, 0xf, 0xf, false));
                  lg[ct][i] = x; } }
          LAS float* wt = (LAS float*)(hbase + RA_WT);
          if (n16 == 15) {
#pragma unroll
              for (int ct = 0; ct < 4; ++ct) *(LAS f32x4*)(wt + w4 * 64 + 16 * ct + 4 * q) = (f32x4){lg[ct][0], lg[ct][1], lg[ct][2], lg[ct][3]}; }
          __syncthreads();
#pragma unroll
          for (int ct = 0; ct < 4; ++ct) { f32x4 off = {0.f, 0.f, 0.f, 0.f}, tot = {0.f, 0.f, 0.f, 0.f};
#pragma unroll
              for (int w = 0; w < 4; ++w) { const f32x4 t = *(const LAS f32x4*)(wt + w * 64 + 16 * ct + 4 * q); tot = tot + t; if (w < w4) off = off + t; }
#pragma unroll
              for (int i = 0; i < 4; ++i) { lg[ct][i] += off[i]; lgend[ct][i] = tot[i]; } }
#pragma unroll
          for (int ct = 0; ct < 4; ++ct) { const int ch = h * 64 + 16 * ct + 4 * q;
              float r4[4], k4[4], v4[4]; RA_SHIFT(r4, 0, ct); RA_SHIFT(k4, 512, ct); RA_SHIFT(v4, 1024, ct);
              const f32x4 a0v = *(const f32x4*)(par + 512 + ch), kkv = *(const f32x4*)(par + 1024 + ch), kav = *(const f32x4*)(par + 1536 + ch);
              const f32x4 lg_ = *(const f32x4*)(par + 2560 + ch), lb_ = *(const f32x4*)(par + 3072 + ch);
              float rtl[4], ktl[4], btl[4], atl[4], khh[4], bhh[4], g1[4], e2[4];
#pragma unroll
              for (int i = 0; i < 4; ++i) {
                  const float av = fast_sigmoid(a0v[i] + aal[ct][i]); const float k2 = k4[i] * (1.0f + (av - 1.0f) * kav[i]);
                  const float kkn = k4[i] * kkv[i] * kinv, bb = kkn * av;
                  const float gam = __builtin_amdgcn_exp2f(lg[ct][i]), gpv = __builtin_amdgcn_exp2f(lg[ct][i] - lw[ct][i]), gin = __builtin_amdgcn_exp2f(-lg[ct][i]), ger = __builtin_amdgcn_exp2f(lgend[ct][i] - lg[ct][i]);
                  rtl[i] = r4[i] * gam; ktl[i] = k2 * gin; btl[i] = bb * gin; atl[i] = -kkn * gpv; khh[i] = k2 * ger; bhh[i] = bb * ger;
                  const float g = ag[ct][i]; g1[i] = lg_[i] * g; e2[i] = (lb_[i] + bd * v4[i]) * g;
              }
              const int fo = ((w4 * 4 + ct) * 64 + l) * 8;
              v2u o; o.x = pk2(g1[0], g1[1]); o.y = pk2(g1[2], g1[3]); __builtin_nontemporal_store(o, (v2u*)(rbi + RB_G1T + fo));
              o.x = pk2(e2[0], e2[1]); o.y = pk2(e2[2], e2[3]); __builtin_nontemporal_store(o, (v2u*)(rbi + RB_E2T + fo));
              const int co = tokl * 144 + (16 * ct + 4 * q) * 2;
              o.x = pk2(rtl[0], rtl[1]); o.y = pk2(rtl[2], rtl[3]); *(LAS v2u*)(hbase + RA_RT + co) = o; rtp[ct] = o;
              o.x = pk2(ktl[0], ktl[1]); o.y = pk2(ktl[2], ktl[3]); *(LAS v2u*)(hbase + RA_KT + co) = o;
              o.x = pk2(btl[0], btl[1]); o.y = pk2(btl[2], btl[3]); *(LAS v2u*)(hbase + RA_BT + co) = o;
              o.x = pk2(atl[0], atl[1]); o.y = pk2(atl[2], atl[3]); *(LAS v2u*)(hbase + RA_AT + co) = o;
#pragma unroll
              for (int i = 0; i < 4; ++i) { const int ro = (16 * ct + 4 * q + i) * 144 + 2 * tslot;
                  if (tokl == 0) *(LAS float*)(hbase + RA_VT + (16 * ct + 4 * q + i) * 144 + 128) = __builtin_amdgcn_exp2f(lgend[ct][i]);
                  *(LAS unsigned short*)(hbase + RA_VT + ro) = (unsigned short)(pk2(v4[i], 0.f) & 0xffffu);
                  *(LAS unsigned short*)(hbase + RA_KH + ro) = (unsigned short)(pk2(khh[i], 0.f) & 0xffffu);
                  *(LAS unsigned short*)(hbase + RA_BH + ro) = (unsigned short)(pk2(bhh[i], 0.f) & 0xffffu); }
              asm volatile("" ::: "memory");
          }
#undef RA_SHIFT
        }
        __syncthreads();
        bf16x8 akp[2], rkp[2], rbp[2];
        { bf16x8 fa[2], fr[2];
#pragma unroll
          for (int ks = 0; ks < 2; ++ks) { fa[ks] = *(const LAS bf16x8*)(hbase + RA_AT + tokl * 144 + 64 * ks + 16 * q); fr[ks] = *(const LAS bf16x8*)(hbase + RA_RT + tokl * 144 + 64 * ks + 16 * q); }
          f32x4 aak[4], arkk[4], arb[4];
#pragma unroll
          for (int jt = 0; jt < 4; ++jt) {
              f32x4 tab = {0.f, 0.f, 0.f, 0.f}; aak[jt] = tab; arkk[jt] = tab; arb[jt] = tab;
              if (jt <= w4) {
#pragma unroll
                  for (int ks = 0; ks < 2; ++ks) { const bf16x8 fk = *(const LAS bf16x8*)(hbase + RA_KT + (16 * jt + n16) * 144 + 64 * ks + 16 * q), fb = *(const LAS bf16x8*)(hbase + RA_BT + (16 * jt + n16) * 144 + 64 * ks + 16 * q);
                      aak[jt] = MFMA16(fk, fa[ks], aak[jt]); tab = MFMA16(fb, fa[ks], tab); arkk[jt] = MFMA16(fk, fr[ks], arkk[jt]); arb[jt] = MFMA16(fb, fr[ks], arb[jt]); }
                  if (jt == w4) {
#pragma unroll
                      for (int i = 0; i < 4; ++i) { const int j = 4 * q + i; if (j >= n16) { aak[jt][i] = 0.f; tab[i] = 0.f; } if (j > n16) { arkk[jt][i] = 0.f; arb[jt][i] = 0.f; } } }
                  *(LAS f32x4*)(hbase + RA_AAB + tokl * 256 + (16 * jt + 4 * q) * 4) = tab;
              }
          }
#pragma unroll
          for (int s = 0; s < 2; ++s) { akp[s] = pack8(aak[2 * s], aak[2 * s + 1]); rkp[s] = pack8(arkk[2 * s], arkk[2 * s + 1]); rbp[s] = pack8(arb[2 * s], arb[2 * s + 1]); } }
        { f32x4 akv[4];
#pragma unroll
          for (int vt = 0; vt < 4; ++vt) { akv[vt] = (f32x4){0.f, 0.f, 0.f, 0.f};
#pragma unroll
              for (int s = 0; s < 2; ++s) { const bf16x8 fv = *(const LAS bf16x8*)(hbase + RA_VT + (16 * vt + n16) * 144 + 64 * s + 16 * q); akv[vt] = MFMA16(akp[s], fv, akv[vt]); } }
          __syncthreads();
#pragma unroll
          for (int vt = 0; vt < 4; ++vt) *(LAS f32x4*)(hbase + RA_RHS2 + (16 * vt + n16) * 272 + (16 * w4 + 4 * q) * 4) = akv[vt]; }
        if (pair + F.G < NITEM / 2) RA_REQUEST(pair + F.G);
        { const LAS unsigned char* aab = hbase + RA_AAB + (16 * w4) * 256 + (16 * w4) * 4;
          LAS unsigned char* ti = hbase + RA_BT;
          if (q == 0) { float t[16];
#pragma unroll
              for (int r_ = 0; r_ < 16; ++r_) { float acc = (r_ == n16) ? 1.0f : 0.0f;
#pragma unroll
                  for (int j4 = 0; j4 < (r_ + 3) / 4; ++j4) { const f32x4 av = *(const LAS f32x4*)(aab + r_ * 256 + j4 * 16);
#pragma unroll
                      for (int e = 0; e < 4; ++e) if (4 * j4 + e < r_) acc += av[e] * t[4 * j4 + e]; }
                  t[r_] = acc; *(LAS unsigned short*)(ti + w4 * 512 + r_ * 32 + 2 * n16) = (unsigned short)(pk2(acc, 0.f) & 0xffffu); } }
          __syncthreads();
          bf16x8 a10, a20, a30, a31, tf[4];
          { const LAS unsigned char* ab = hbase + RA_AAB + n16 * 256 + 16 * q; const f32x4 z4 = {0.f, 0.f, 0.f, 0.f};
            const f32x4 l10 = *(const LAS f32x4*)(ab + 16 * 256), l20 = *(const LAS f32x4*)(ab + 32 * 256), l21 = *(const LAS f32x4*)(ab + 32 * 256 + 64);
            const f32x4 l30 = *(const LAS f32x4*)(ab + 48 * 256), l31 = *(const LAS f32x4*)(ab + 48 * 256 + 64), l32 = *(const LAS f32x4*)(ab + 48 * 256 + 128);
            a10 = pack8(l10, z4); a20 = pack8(l20, l21); a30 = pack8(l30, l31); a31 = pack8(l32, z4);
#pragma unroll
            for (int I = 0; I < 4; ++I) { const v2u tw = *(const LAS v2u*)(ti + I * 512 + n16 * 32 + 8 * q); const v4u t4 = {tw.x, tw.y, 0u, 0u}; tf[I] = __builtin_bit_cast(bf16x8, t4); } }
          v4u xw[2][2];
#pragma unroll
          for (int m = 0; m < 2; ++m) {
              v4u x0 = {0u, 0u, 0u, 0u}, x1 = {0u, 0u, 0u, 0u};
#pragma unroll
              for (int I = 0; I < 4; ++I) {
                  f32x4 z;
                  if (m == 0) {
#pragma unroll
                      for (int i = 0; i < 4; ++i) z[i] = bf2f(*(const LAS unsigned short*)(hbase + RA_AT + (16 * I + 4 * q + i) * 144 + 2 * tokl)); }
                  else z = *(const LAS f32x4*)(hbase + RA_RHS2 + tokl * 272 + (16 * I + 4 * q) * 4);
                  if (I == 1) z = MFMA16(a10, __builtin_bit_cast(bf16x8, x0), z);
                  if (I == 2) z = MFMA16(a20, __builtin_bit_cast(bf16x8, x0), z);
                  if (I == 3) { z = MFMA16(a30, __builtin_bit_cast(bf16x8, x0), z); z = MFMA16(a31, __builtin_bit_cast(bf16x8, x1), z); }
                  const v4u zb = {pk2(z[0], z[1]), pk2(z[2], z[3]), 0u, 0u};
                  const f32x4 x = MFMA16(tf[I], __builtin_bit_cast(bf16x8, zb), ((f32x4){0.f, 0.f, 0.f, 0.f}));
                  const unsigned p0 = pk2(x[0], x[1]), p1 = pk2(x[2], x[3]);
                  if (I == 0) { x0.x = p0; x0.y = p1; } if (I == 1) { x0.z = p0; x0.w = p1; } if (I == 2) { x1.x = p0; x1.y = p1; } if (I == 3) { x1.z = p0; x1.w = p1; }
              }
              xw[m][0] = x0; xw[m][1] = x1;
          }
          __syncthreads();
#pragma unroll
          for (int s = 0; s < 2; ++s) { *(LAS v4u*)(hbase + RA_W1T + tokl * 144 + 64 * s + 16 * q) = xw[0][s]; *(LAS v4u*)(hbase + RA_W2T + tokl * 144 + 64 * s + 16 * q) = xw[1][s]; }
        }
        __syncthreads();
        {
          f32x4 pc[4], y0[4];
#pragma unroll
          for (int t = 0; t < 4; ++t) { pc[t] = (f32x4){bflo(rtp[t].x), bfhi(rtp[t].x), bflo(rtp[t].y), bfhi(rtp[t].y)}; y0[t] = (f32x4){0.f, 0.f, 0.f, 0.f};
#pragma unroll
              for (int s = 0; s < 2; ++s) { y0[t] = MFMA16(*(const LAS bf16x8*)(hbase + RA_VT + (16 * t + n16) * 144 + 64 * s + 16 * q), rkp[s], y0[t]);
                                            y0[t] = MFMA16(*(const LAS bf16x8*)(hbase + RA_W2T + (16 * t + n16) * 144 + 64 * s + 16 * q), rbp[s], y0[t]);
                                            pc[t] = MFMA16(*(const LAS bf16x8*)(hbase + RA_W1T + (16 * t + n16) * 144 + 64 * s + 16 * q), rbp[s], pc[t]); } }
#pragma unroll
          for (int vt = 0; vt < 4; ++vt) { v2u o; o.x = pk2(y0[vt][0], y0[vt][1]); o.y = pk2(y0[vt][2], y0[vt][3]); __builtin_nontemporal_store(o, (v2u*)(rbi + RB_YLT + ((w4 * 4 + vt) * 64 + l) * 8)); }
#pragma unroll
          for (int s = 0; s < 2; ++s) __builtin_nontemporal_store(pack8(pc[2 * s], pc[2 * s + 1]), (bf16x8*)(rbi + RB_PCT + ((w4 * 2 + s) * 64 + l) * 16));
          f32x4 mc[4]; bf16x8 fb[2], fvv[2];
#pragma unroll
          for (int s = 0; s < 2; ++s) { fb[s] = *(const LAS bf16x8*)(hbase + RA_BH + tokl * 144 + 64 * s + 16 * q); fvv[s] = *(const LAS bf16x8*)(hbase + RA_VT + tokl * 144 + 64 * s + 16 * q); }
          const float gend_k = *(const LAS float*)(hbase + RA_VT + tokl * 144 + 128);
#pragma unroll
          for (int t = 0; t < 4; ++t) { mc[t] = (f32x4){0.f, 0.f, 0.f, 0.f};
#pragma unroll
              for (int s = 0; s < 2; ++s) mc[t] = MFMA16(*(const LAS bf16x8*)(hbase + RA_W1T + (16 * t + n16) * 144 + 64 * s + 16 * q), fb[s], mc[t]);
              if (t == w4) {
#pragma unroll
                  for (int i = 0; i < 4; ++i) if (4 * q + i == n16) mc[t][i] += gend_k; } }
#pragma unroll
          for (int s = 0; s < 2; ++s) __builtin_nontemporal_store(pack8(mc[2 * s], mc[2 * s + 1]), (bf16x8*)(rbi + RB_MC + ((w4 * 2 + s) * 64 + l) * 16));
          bf16x8 fw2[2];
#pragma unroll
          for (int s = 0; s < 2; ++s) fw2[s] = *(const LAS bf16x8*)(hbase + RA_W2T + tokl * 144 + 64 * s + 16 * q);
#pragma unroll
          for (int kt = 0; kt < 4; ++kt) { f32x4 cc = {0.f, 0.f, 0.f, 0.f};
#pragma unroll
              for (int s = 0; s < 2; ++s) { cc = MFMA16(*(const LAS bf16x8*)(hbase + RA_KH + (16 * kt + n16) * 144 + 64 * s + 16 * q), fvv[s], cc);
                                            cc = MFMA16(*(const LAS bf16x8*)(hbase + RA_BH + (16 * kt + n16) * 144 + 64 * s + 16 * q), fw2[s], cc); }
              v2u cw; cw.x = pk2(cc[0], cc[1]); cw.y = pk2(cc[2], cc[3]); __builtin_nontemporal_store(cw, (v2u*)(rbi + RB_CC + ((w4 * 4 + kt) * 64 + l) * 8)); } }
    }
}

constexpr int RBK_NS = 9, RBK_D = 8, RBK_SLOT = 16384, RBK_BLOCKS = 32;
static_assert(RBK_NS * RBK_SLOT <= MISC_OFF && RBK_D == RBK_NS - 1, "phase B ring");
DI void rwkv_phase_b(const Frame& F, const Args& a) {
    if (F.bid >= RBK_BLOCKS) return;
    unsigned char* rb = a.ws + WS_RW; const int l = F.lane, w = F.wave;
    const int h = F.bid & 7, b = F.bid >> 3;
    LAS unsigned char* lds = F.lds;
    if (w >= 4) {
        const int j = w - 4;
#define RBK_ISSUE(cc_) do { const int c_ = (cc_) < NCHUNK ? (cc_) : NCHUNK - 1; const unsigned char* r_ = rb + (size_t)(((b * 128 + c_) << 3) + h) * RB_REC; \
            LAS unsigned char* slot_ = lds + ((cc_) % RBK_NS) * RBK_SLOT; \
            _Pragma("unroll") for (int k_ = 0; k_ < 4; ++k_) { const int blk_ = 4 * j + k_; \
                const unsigned char* src_ = blk_ < 8 ? r_ + RB_MC + blk_ * 1024 : r_ + RB_CC + (blk_ - 8) * 1024; \
                __builtin_amdgcn_global_load_lds((const unsigned*)(src_ + l * 16), (LAS unsigned*)(slot_ + blk_ * 1024), 16, 0, 0); } } while (0)
        for (int c = 0; c < RBK_D; ++c) RBK_ISSUE(c);
        for (int c = 0; c < NCHUNK; ++c) {
            asm volatile("s_waitcnt vmcnt(28)" ::: "memory");
            __builtin_amdgcn_s_barrier();
            RBK_ISSUE(c + RBK_D);
        }
        asm volatile("s_waitcnt vmcnt(0)" ::: "memory");
        __builtin_amdgcn_s_barrier();
#undef RBK_ISSUE
    } else {
        const int vs = w;
        f32x4 st[4];
#pragma unroll
        for (int kt = 0; kt < 4; ++kt) st[kt] = (f32x4){0.f, 0.f, 0.f, 0.f};
        for (int c = 0; c < NCHUNK; ++c) {
            unsigned char* rbi = rb + (size_t)(((b * 128 + c) << 3) + h) * RB_REC;
            bf16x8 sb[2];
#pragma unroll
            for (int s = 0; s < 2; ++s) { sb[s] = pack8(st[2 * s], st[2 * s + 1]); *(bf16x8*)(rbi + RB_SC + ((vs * 2 + s) * 64 + l) * 16) = sb[s]; }
            __builtin_amdgcn_s_barrier();
            const LAS unsigned char* slot = lds + (c % RBK_NS) * RBK_SLOT;
#pragma unroll
            for (int kt = 0; kt < 4; ++kt) { const v2u cw = *(const LAS v2u*)(slot + 8192 + ((vs * 4 + kt) * 64 + l) * 8);
                f32x4 n = {bflo(cw.x), bfhi(cw.x), bflo(cw.y), bfhi(cw.y)};
#pragma unroll
                for (int s = 0; s < 2; ++s) n = MFMA16(*(const LAS bf16x8*)(slot + ((kt * 2 + s) * 64 + l) * 16), sb[s], n);
                st[kt] = n; }
        }
        __builtin_amdgcn_s_barrier();
    }
}

struct RcOps { bf16x8 pc[2]; v2u yl[4]; bf16x8 sc[4][2]; v2u g1[4], e2[4]; };
DI void rc_load(RcOps& o, const unsigned char* rb, int task, int l) {
    const int item = task >> 2, it = task & 3; const unsigned char* rbi = rb + (size_t)item * RB_REC;
#pragma unroll
    for (int s = 0; s < 2; ++s) o.pc[s] = __builtin_nontemporal_load((const bf16x8*)(rbi + RB_PCT + ((it * 2 + s) * 64 + l) * 16));
#pragma unroll
    for (int vt = 0; vt < 4; ++vt) { const int fo = ((it * 4 + vt) * 64 + l) * 8;
        o.yl[vt] = __builtin_nontemporal_load((const v2u*)(rbi + RB_YLT + fo)); o.g1[vt] = __builtin_nontemporal_load((const v2u*)(rbi + RB_G1T + fo)); o.e2[vt] = __builtin_nontemporal_load((const v2u*)(rbi + RB_E2T + fo));
#pragma unroll
        for (int s = 0; s < 2; ++s) o.sc[vt][s] = __builtin_nontemporal_load((const bf16x8*)(rbi + RB_SC + ((vt * 2 + s) * 64 + l) * 16)); }
}
DI void rwkv_phase_c(const Frame& F, const Args& a) {
    const unsigned char* rb = a.ws + WS_RW; bf16* mix = (bf16*)(a.ws + WS_MIX);
    const int l = F.lane, n16 = l & 15, q = l >> 4;
    const int gw = F.bid * NWAVES + F.wave, NGW = F.G * NWAVES;
    RcOps cur, nxt;
    if (gw < NITEM * 4) rc_load(cur, rb, gw, l);
    for (int task = gw; task < NITEM * 4; task += NGW) {
        const int item = task >> 2, it = task & 3, h = item & 7, c = (item >> 3) & 127, b = item >> 10;
        if (task + NGW < NITEM * 4) rc_load(nxt, rb, task + NGW, l);
        f32x4 y[4]; float sum = 0.f;
#pragma unroll
        for (int vt = 0; vt < 4; ++vt) { y[vt] = (f32x4){bflo(cur.yl[vt].x), bfhi(cur.yl[vt].x), bflo(cur.yl[vt].y), bfhi(cur.yl[vt].y)};
#pragma unroll
            for (int s = 0; s < 2; ++s) y[vt] = MFMA16(cur.sc[vt][s], cur.pc[s], y[vt]);
            sum += (y[vt][0] + y[vt][1]) + (y[vt][2] + y[vt][3]); }
        sum = quad_sum(sum);
        const float mean = sum * (1.f / 64.f); float sq = 0.f;
#pragma unroll
        for (int vt = 0; vt < 4; ++vt) { y[vt] = y[vt] - mean; sq += (y[vt][0] * y[vt][0] + y[vt][1] * y[vt][1]) + (y[vt][2] * y[vt][2] + y[vt][3] * y[vt][3]); }
        sq = quad_sum(sq);
        const float rstd = 1.0f / sqrtf(sq * (1.f / 64.f) + 64e-5f);
        const size_t tok = (size_t)b * SEQ + c * 64 + 16 * it + n16;
#pragma unroll
        for (int vt = 0; vt < 4; ++vt) { const v2u g = cur.g1[vt], e = cur.e2[vt];
            v2u o; o.x = pk2(y[vt][0] * rstd * bflo(g.x) + bflo(e.x), y[vt][1] * rstd * bfhi(g.x) + bfhi(e.x)); o.y = pk2(y[vt][2] * rstd * bflo(g.y) + bflo(e.y), y[vt][3] * rstd * bfhi(g.y) + bfhi(e.y));
            *(v2u*)(mix + tok * 1024 + 512 + h * 64 + 16 * vt + 4 * q) = o; }
        cur = nxt;
    }
}
#endif

DI void p0_prologue(const Frame& F, const Args& a) {
    unsigned char* ws = a.ws;
    LAS float* scr = (LAS float*)(F.lds + F.wave * 16384);
    const int gw = F.bid * NWAVES + F.wave, NGW = F.G * NWAVES;
    constexpr int I_IN = 0, I_OUT = 16 * 32, I_DEC = 16, I_AAA = 16, I_GATE = 32;
    constexpr int NITEMS = I_IN + I_OUT + I_DEC + I_AAA + I_GATE;
    for (int s = F.G - 1 - F.bid; s < INC / 32; s += F.G) { q_strip_i8_wg(a.in[I_WIN], INC, 32 * s, ws + WS_WIN, (float*)(ws + WS_COLSC1), F.wave, F.lane, (LAS float*)F.lds); __syncthreads(); }
    for (int it = gw; it < NITEMS; it += NGW) {
        int r = it;
        if (r < I_OUT) { const int kb = r / 32, nb = r % 32; tr_item(a.in[I_WOUT], 1024, 64 * kb, 32 * nb, (bf16*)(ws + WS_WOUT), 1024, 32 * nb, scr, F.lane, nullptr); continue; } r -= I_OUT;
        if (r < I_DEC) { tr_item(a.in[I_WDEC], 512, 0, 32 * r, (bf16*)(ws + WS_WDEC), 64, 32 * r, scr, F.lane, nullptr); continue; } r -= I_DEC;
        if (r < I_AAA) { tr_item(a.in[I_WAAA], 512, 0, 32 * r, (bf16*)(ws + WS_WAAA), 64, 32 * r, scr, F.lane, nullptr); continue; } r -= I_AAA;
        { const int kb = r / 16, nb = r % 16; tr_item(a.in[I_WGATE], 512, 64 * kb, 32 * nb, (bf16*)(ws + WS_WGATE), 128, 32 * nb, scr, F.lane, nullptr); }
    }
    { float* wrt = (float*)(ws + WS_WRT); const float* wr = a.in[I_WR]; const float* g2 = a.in[I_N2G];
      for (int i = F.bid * 512 + F.tid; i < 32 * 1024; i += F.G * 512) { const int e = i >> 10, k = i & 1023; wrt[i] = g2[k] * wr[k * 32 + e]; } }
    { float* par = (float*)(ws + WS_PAR); const int srcs[7] = {I_W0, I_A0, I_KK, I_KA, I_RK, I_LNG, I_LNB};
      for (int i = F.bid * 512 + F.tid; i < 7 * 512; i += F.G * 512) { const int k = i >> 9; float v = 0.f;
#pragma unroll
          for (int j = 0; j < 7; ++j) if (k == j) v = a.in[srcs[j]][i & 511];
          par[i] = v; } }
    { const float* x = a.in[I_X]; const float* g1 = a.in[I_N1G]; bf16* xn = (bf16*)(ws + WS_XN);
      f32x4 gv[4];
#pragma unroll
      for (int j = 0; j < 4; ++j) gv[j] = *((const f32x4*)g1 + F.lane + 64 * j);
      for (int m0 = 2 * gw; m0 < T; m0 += 2 * NGW) {
          f32x4 v[2][4];
#pragma unroll
          for (int r = 0; r < 2; ++r) { const f32x4* xr = (const f32x4*)(x + (size_t)(m0 + r) * D) + F.lane;
#pragma unroll
              for (int j = 0; j < 4; ++j) v[r][j] = __builtin_nontemporal_load(xr + 64 * j); }
#pragma unroll
          for (int r = 0; r < 2; ++r) { float s = 0.f;
#pragma unroll
              for (int j = 0; j < 4; ++j) s += (v[r][j].x * v[r][j].x + v[r][j].y * v[r][j].y) + (v[r][j].z * v[r][j].z + v[r][j].w * v[r][j].w);
              const float rs = 1.0f / sqrtf(wave_sum(s) * (1.f / D) + 1e-6f);
              f32x4 y[4]; float am = 0.f;
#pragma unroll
              for (int j = 0; j < 4; ++j) { y[j] = (v[r][j] * rs) * gv[j]; am = fmaxf(fmaxf(am, fmaxf(fabsf(y[j].x), fabsf(y[j].y))), fmaxf(fabsf(y[j].z), fabsf(y[j].w))); }
              am = wave_max(am); const float qi = am > 0.f ? 127.0f / am : 0.f;
              if (F.lane == 0) ((float*)(ws + WS_XNSC))[m0 + r] = am * (1.0f / 127.0f);
              unsigned* o4 = (unsigned*)((unsigned char*)xn + (size_t)(m0 + r) * D) + F.lane;
#pragma unroll
              for (int j = 0; j < 4; ++j) { const f32x4 qv = y[j] * qi + Q_MAGIC; o4[64 * j] = q_pack4(qv.x, qv.y, qv.z, qv.w); } }
      } }
}

#if NAIVE_RWKV
DI void rwkv_naive_prep(const Frame& F, const Args& a) {
    const bf16* proj = (const bf16*)(a.ws + WS_PROJ); LAS float* sx = (LAS float*)F.lds;
    float* RW = (float*)(a.ws + WS_RW); float* GG = (float*)(a.ws + WS_XN);
    const float* mu = a.in[I_MU]; const int c = F.tid;
    for (int t = F.bid; t < T; t += F.G) {
        const bool first = (t % SEQ) == 0; const bf16* cur = proj + (size_t)t * INC + PRW; const bf16* prv = cur - INC;
#define SH_(col) ({ const float x_ = bf2f(cur[col]); const float p_ = first ? 0.f : bf2f(prv[col]); x_ + (p_ - x_) * mu[col]; })
        if (c < 256) { const float v = SH_(1536 + c); sx[c] = c < 64 ? tanhf(v) : (c < 128 ? v : sigmoidf_(v)); }
        __syncthreads();
        const float r = SH_(c), k = SH_(512 + c), v = SH_(1024 + c);
#undef SH_
        float wl = a.in[I_W0][c], al = a.in[I_A0][c], g = 0.f;
        const float* wdec = a.in[I_WDEC] + c; const float* waaa = a.in[I_WAAA] + c; const float* wgate = a.in[I_WGATE] + c;
#pragma unroll 4
        for (int j = 0; j < 64; ++j) { wl += sx[j] * wdec[j * 512]; al += sx[64 + j] * waaa[j * 512]; }
#pragma unroll 4
        for (int j = 0; j < 128; ++j) g += sx[128 + j] * wgate[j * 512];
        const float dec = __expf(-0.6065306597126334f * sigmoidf_(wl)), av = sigmoidf_(al);
        float kk = k * a.in[I_KK][c]; const float n2 = wave_sum(kk * kk); kk = kk / fmaxf(sqrtf(n2), 1e-12f);
        const float k2 = k * (1.0f + (av - 1.0f) * a.in[I_KA][c]);
        const size_t o = (size_t)t * 512 + c; const size_t S1 = (size_t)T * 512;
        RW[o] = r; RW[S1 + o] = dec; RW[2 * S1 + o] = k2; RW[3 * S1 + o] = v; RW[4 * S1 + o] = kk; RW[5 * S1 + o] = av; GG[o] = g;
        __syncthreads();
    }
}
DI void rwkv_naive_scan(const Frame& F, const Args& a) {
    if (F.bid >= 32 || F.wave != 0) return;
    const int b = F.bid >> 3, h = F.bid & 7, l = F.lane, c = h * 64 + l;
    const float* RW = (const float*)(a.ws + WS_RW); const float* GG = (const float*)(a.ws + WS_XN); bf16* mix = (bf16*)(a.ws + WS_MIX);
    const size_t S1 = (size_t)T * 512; LAS float* sh = (LAS float*)F.lds;
    LAS float* st = sh + 512 + l;
    for (int k = 0; k < 64; ++k) st[64 * k] = 0.f;
    const float rk = a.in[I_RK][c], lg = a.in[I_LNG][c], lb = a.in[I_LNB][c];
    for (int s = 0; s < SEQ; ++s) {
        const size_t o = (size_t)(b * SEQ + s) * 512 + c;
        const float r = RW[o], w = RW[S1 + o], k2 = RW[2 * S1 + o], v = RW[3 * S1 + o], kk = RW[4 * S1 + o], av = RW[5 * S1 + o], g = GG[o];
        sh[l] = r; sh[64 + l] = w; sh[128 + l] = k2; sh[192 + l] = kk; sh[256 + l] = kk * av;
        LDS_WAIT();
        float sa = 0.f;
#pragma unroll 8
        for (int k = 0; k < 64; ++k) sa -= st[64 * k] * sh[192 + k];
        float y = 0.f;
#pragma unroll 8
        for (int k = 0; k < 64; ++k) { const float nv = st[64 * k] * sh[64 + k] + sa * sh[256 + k] + v * sh[128 + k]; st[64 * k] = nv; y += nv * sh[k]; }
        LDS_WAIT();
        const float mean = wave_sum(y) * (1.f / 64.f); const float d = y - mean; const float var = wave_sum(d * d) * (1.f / 64.f);
        const float yn = d * (1.0f / sqrtf(var + 64e-5f));
        const float bonus = wave_sum(r * k2 * rk) * v;
        const float outv = (yn * lg + lb + bonus) * g;
        mix[(size_t)(b * SEQ + s) * 1024 + 512 + c] = (bf16)(pk2(outv, 0.f) & 0xffffu);
    }
}
#endif
#if NAIVE_ATT
DI void attn_naive(const Frame& F, const Args& a) {
    const bf16* proj = (const bf16*)(a.ws + WS_PROJ); bf16* mix = (bf16*)(a.ws + WS_MIX);
    LAS float* sq = (LAS float*)(F.lds + F.wave * 1024);
    const int gw = F.bid * NWAVES + F.wave, NGW = F.G * NWAVES, l = F.lane;
    const float qg = a.in[I_QG][l];
    for (int it = gw; it < T * 8; it += NGW) {
        const int t = it >> 3, h = it & 7, b = t / SEQ, s = t % SEQ, n = s >> 6;
        const float qd = bf2f(proj[(size_t)t * INC + h * 64 + l]);
        const float qn = qd * (1.0f / sqrtf(wave_sum(qd * qd) * (1.f / 64.f) + 1e-6f)) * qg * 0.125f;
        sq[l] = qn; LDS_WAIT();
        float sc[9]; float mx = -3.0e38f;
#pragma unroll
        for (int r = 0; r < 9; ++r) {
            const int kp = (n - 8) * 64 + 64 * r + l; float v = -3.0e38f;
            if (kp >= 0) {
                const v4u* kr = (const v4u*)(proj + (size_t)(b * SEQ + kp) * INC + 512 + h * 64);
                float ss = 0.f, dot = 0.f;
#pragma unroll
                for (int j = 0; j < 8; ++j) { const v4u w = kr[j]; const unsigned ww[4] = {w.x, w.y, w.z, w.w};
#pragma unroll
                    for (int e = 0; e < 4; ++e) { const float k0 = bflo(ww[e]), k1 = bfhi(ww[e]); const int d0 = 8 * j + 2 * e;
                        ss += k0 * k0 + k1 * k1; dot += sq[d0] * a.in[I_KG][d0] * k0 + sq[d0 + 1] * a.in[I_KG][d0 + 1] * k1; } }
                int rel = kp - s; rel = rel < -128 ? -128 : (rel > 63 ? 63 : rel);
                v = dot * (1.0f / sqrtf(ss * (1.f / 64.f) + 1e-6f)) + a.in[I_RELB][h * 192 + rel + 128];
            }
            sc[r] = v; mx = fmaxf(mx, v);
        }
        mx = wave_max(mx); float sum = 0.f;
#pragma unroll
        for (int r = 0; r < 9; ++r) { sc[r] = (sc[r] > -1.0e38f) ? __expf(sc[r] - mx) : 0.f; sum += sc[r]; }
        sum = wave_sum(sum);
        float o = 0.f;
#pragma unroll
        for (int r = 0; r < 9; ++r) {
            const int kp0 = (n - 8) * 64 + 64 * r;
            if (kp0 >= 0) {
                const bf16* vp = proj + (size_t)(b * SEQ + kp0) * INC + 1024 + h * 64 + l;
                for (int key = 0; key < 64; ++key) o += __shfl(sc[r], key) * bf2f(vp[(size_t)key * INC]);
            }
        }
        mix[(size_t)t * 1024 + h * 64 + l] = (bf16)(pk2(o / sum, 0.f) & 0xffffu);
        LDS_WAIT();
    }
}
#endif

DI void p6_router(const Frame& F, const Args& a) {
    unsigned char* ws = a.ws; const bf16* x1 = (const bf16*)(ws + WS_XN); const float* wrt = (const float*)(ws + WS_WRT); const float* br = a.in[I_BR];
    int* eidx = (int*)(ws + WS_EIDX); float* gate = (float*)(ws + WS_GATE); int* lrank = (int*)(ws + WS_LRANK); float* rstd = (float*)(ws + WS_RSTD); int* cnt = (int*)(ws + WS_CNT);
    constexpr int WROW = 2064, WIMG = 32 * WROW;
    LAS int* hist = (LAS int*)(F.lds + 2 * WIMG);
    const int n = F.lane & 15, q = F.lane >> 4;
    for (int i = F.tid; i < 32 * 256; i += NWAVES * 64) { const int e = i >> 8, c4 = i & 255; const f32x4 w = *((const f32x4*)(wrt + (size_t)e * D) + c4);
        v2u hi, lo; hi.x = pk2(w[0], w[1]); hi.y = pk2(w[2], w[3]);
        lo.x = pk2(w[0] - bflo(hi.x), w[1] - bfhi(hi.x)); lo.y = pk2(w[2] - bflo(hi.y), w[3] - bfhi(hi.y));
        *(LAS v2u*)(F.lds + e * WROW + c4 * 8) = hi; *(LAS v2u*)(F.lds + WIMG + e * WROW + c4 * 8) = lo; }
    __syncthreads();
    for (int tile = F.bid; tile < T / 128; tile += F.G) {
        if (F.tid < 32) hist[F.tid] = 0;
        __syncthreads();
        const int tok = tile * 128 + F.wave * 16 + n;
        const v4u* xr = (const v4u*)(x1 + (size_t)tok * D) + q; const LAS unsigned char* w0 = F.lds + n * WROW + 16 * q;
        f32x4 acc0 = {0.f, 0.f, 0.f, 0.f}, acc1 = {0.f, 0.f, 0.f, 0.f}; float ssq = 0.f, amax = 0.f;
        for (int S0 = 0; S0 < 32; S0 += 16) {
            v4u xw[16];
#pragma unroll
            for (int s = 0; s < 16; ++s) xw[s] = xr[4 * (S0 + s)];
#pragma unroll
            for (int s = 0; s < 16; ++s) { const bf16x8 xb8 = __builtin_bit_cast(bf16x8, xw[s]); const LAS unsigned char* wp = w0 + (S0 + s) * 64;
                const unsigned u[4] = {xw[s].x, xw[s].y, xw[s].z, xw[s].w};
#pragma unroll
                for (int j = 0; j < 4; ++j) { const float a = bflo(u[j]), b = bfhi(u[j]); ssq += a * a + b * b; amax = fmaxf(amax, fmaxf(fabsf(a), fabsf(b))); }
                acc0 = __builtin_amdgcn_mfma_f32_16x16x32_bf16(*(const LAS bf16x8*)(wp), xb8, acc0, 0, 0, 0);
                acc0 = __builtin_amdgcn_mfma_f32_16x16x32_bf16(*(const LAS bf16x8*)(wp + WIMG), xb8, acc0, 0, 0, 0);
                acc1 = __builtin_amdgcn_mfma_f32_16x16x32_bf16(*(const LAS bf16x8*)(wp + 16 * WROW), xb8, acc1, 0, 0, 0);
                acc1 = __builtin_amdgcn_mfma_f32_16x16x32_bf16(*(const LAS bf16x8*)(wp + WIMG + 16 * WROW), xb8, acc1, 0, 0, 0); }
        }
        ssq = quad_sum(ssq); amax = quad_max(amax);
        const float rs = 1.0f / sqrtf(ssq * (1.f / D) + 1e-6f);
        float lg[8];
#pragma unroll
        for (int i = 0; i < 4; ++i) { lg[i] = acc0[i] * rs + br[4 * q + i]; lg[4 + i] = acc1[i] * rs + br[16 + 4 * q + i]; }
        float tv[4]; int ti[4];
#pragma unroll
        for (int r = 0; r < 4; ++r) {
            float bv = -3.0e38f; int bi = 0;
#pragma unroll
            for (int j = 0; j < 8; ++j) { const int e = (j < 4 ? 0 : 16) + 4 * q + (j & 3); if (lg[j] > bv) { bv = lg[j]; bi = e; } }
#pragma unroll
            for (int o = 16; o <= 32; o <<= 1) { const float ov = __shfl_xor(bv, o); const int oi = __shfl_xor(bi, o); if (ov > bv || (ov == bv && oi < bi)) { bv = ov; bi = oi; } }
            tv[r] = bv; ti[r] = bi;
#pragma unroll
            for (int j = 0; j < 8; ++j) { const int e = (j < 4 ? 0 : 16) + 4 * q + (j & 3); if (e == bi) lg[j] = -3.0e38f; }
        }
        if (q == 0) {
            const float e1 = __expf(tv[1] - tv[0]), e2 = __expf(tv[2] - tv[0]), e3 = __expf(tv[3] - tv[0]); const float inv = 1.0f / (1.0f + e1 + e2 + e3);
            int lr[4];
#pragma unroll
            for (int r = 0; r < 4; ++r) lr[r] = atomicAdd((int*)&hist[ti[r]], 1);
            *(int4*)(eidx + (size_t)tok * 4) = make_int4(ti[0], ti[1], ti[2], ti[3]);
            *(float4*)(gate + (size_t)tok * 4) = make_float4(inv, e1 * inv, e2 * inv, e3 * inv);
            *(int4*)(lrank + (size_t)tok * 4) = make_int4(lr[0], lr[1], lr[2], lr[3]);
            rstd[tok] = rs * amax * (1.0f / 127.0f);
        }
        { const float qinv = amax > 0.f ? 127.0f / amax : 0.f; unsigned char* xq = ws + WS_XQ;
            for (int i0 = 0; i0 < 16; i0 += 4) { v4u xa[4], xb2[4];
#pragma unroll
                for (int i = 0; i < 4; ++i) { const v4u* p = (const v4u*)(x1 + (size_t)(tile * 128 + F.wave * 16 + i0 + i) * D) + 2 * F.lane; xa[i] = p[0]; xb2[i] = p[1]; }
#pragma unroll
                for (int i = 0; i < 4; ++i) { const float sc = __builtin_bit_cast(float, __builtin_amdgcn_readlane(__builtin_bit_cast(int, qinv), i0 + i));
                    const unsigned u[8] = {xa[i].x, xa[i].y, xa[i].z, xa[i].w, xb2[i].x, xb2[i].y, xb2[i].z, xb2[i].w}; v4u o;
#pragma unroll
                    for (int d = 0; d < 4; ++d) { const f32x2 lo = {bflo(u[2 * d]), bfhi(u[2 * d])}, hi = {bflo(u[2 * d + 1]), bfhi(u[2 * d + 1])};
                        const f32x2 ql = lo * sc + Q_MAGIC, qh = hi * sc + Q_MAGIC; o[d] = q_pack4(ql.x, ql.y, qh.x, qh.y); }
                    *((v4u*)(xq + (size_t)(tile * 128 + F.wave * 16 + i0 + i) * D) + F.lane) = o; } }
        }
        __syncthreads();
        if (F.tid < 32) cnt[tile * 32 + F.tid] = hist[F.tid];
        __syncthreads();
    }
}

DI void p7_permute(const Frame& F, const Args& a) {
    unsigned char* ws = a.ws; const int* cnt = (const int*)(ws + WS_CNT); int* meta = (int*)(ws + WS_META);
    const int* eidx = (const int*)(ws + WS_EIDX); const int* lrank = (const int*)(ws + WS_LRANK); int* inv = (int*)(ws + WS_INV);
    const float* rstd = (const float*)(ws + WS_RSTD); float* rowrstd = (float*)(ws + WS_ROWRSTD);
    bf16* xb = (bf16*)(ws + WS_XN); int* rowtok = (int*)(ws + WS_ROWTOK);
    LAS int* s_tot = (LAS int*)F.lds; LAS int* s_pst = s_tot + 32; LAS int* s_base = s_tot + 64; LAS int* s_part = s_tot + 128;
    { const int e = F.tid & 31, part = F.tid >> 5; int s = 0; for (int t = part * 16; t < part * 16 + 16; ++t) s += cnt[t * 32 + e]; s_part[part * 32 + e] = s; }
    __syncthreads();
    if (F.tid < 32) { int s = 0; for (int p = 0; p < 16; ++p) s += s_part[p * 32 + F.tid]; s_tot[F.tid] = s; }
    __syncthreads();
    if (F.tid < 32) { int ps = 0; for (int e = 0; e < F.tid; ++e) ps += (s_tot[e] + 255) / 256 * 256; s_pst[F.tid] = ps; }
    __syncthreads();
    if (F.bid == 0 && F.tid < 32) { const int e = F.tid, nb = (s_tot[e] + 255) / 256, rb0 = s_pst[e] / 256; for (int i = 0; i < nb; ++i) meta[16 + rb0 + i] = e; if (e == 31) meta[0] = rb0 + nb; }
    if (F.bid < 32) { const int e = F.bid, r0 = s_pst[e] + s_tot[e], r1 = s_pst[e] + (s_tot[e] + 255) / 256 * 256;
        for (int r = r0 + F.tid; r < r1; r += NWAVES * 64) { rowtok[r] = T; rowrstd[r] = 0.f; } }
    if (F.bid == 0 && F.tid < 64) { const v4u z = {0u, 0u, 0u, 0u}; *((v4u*)(ws + WS_XQ + (size_t)T * D) + F.tid) = z; }
    for (int tile = F.bid; tile < T / 128; tile += F.G) {
        __syncthreads();
        if (F.tid < 32) { int s = 0; for (int t = 0; t < tile; ++t) s += cnt[t * 32 + F.tid]; s_base[F.tid] = s_pst[F.tid] + s; }
        __syncthreads();
        { const int i = F.tid;
            const int tok = tile * 128 + (i >> 2), k = i & 3; const int e = eidx[tok * 4 + k]; const int dest = s_base[e] + lrank[tok * 4 + k];
            inv[tok * 4 + k] = dest; rowtok[dest] = tok; rowrstd[dest] = rstd[tok];
        }
    }
}

DI void p10_combine(const Frame& F, const Args& a) {
    unsigned char* ws = a.ws; const int* inv = (const int*)(ws + WS_INV); const float* gate = (const float*)(ws + WS_GATE); const bf16* yr = (const bf16*)(ws + WS_YR); const bf16* xb = (const bf16*)(ws + WS_XN); float* out = a.out;
    const int gw = F.bid * NWAVES + F.wave, NGW = F.G * NWAVES;
    for (int t = gw; t < T; t += NGW) {
        const int4 iv = *(const int4*)(inv + (size_t)t * 4); const float4 gv = *(const float4*)(gate + (size_t)t * 4);
        const int rows[4] = {iv.x, iv.y, iv.z, iv.w}; const float gs[4] = {gv.x, gv.y, gv.z, gv.w};
        f32x4* o = (f32x4*)(out + (size_t)t * D) + F.lane; const v2u* xr = (const v2u*)(xb + (size_t)t * D) + F.lane;
#pragma unroll
        for (int j = 0; j < 4; ++j) {
            const v2u xw = xr[64 * j]; f32x4 acc = {bflo(xw.x), bfhi(xw.x), bflo(xw.y), bfhi(xw.y)};
#pragma unroll
            for (int k = 0; k < 4; ++k) { const int w = (int)__builtin_nontemporal_load((const unsigned*)((const unsigned char*)yr + (size_t)rows[k] * D) + F.lane + 64 * j);
                const auto lo = __builtin_amdgcn_cvt_pk_f32_fp8(w, false), hi = __builtin_amdgcn_cvt_pk_f32_fp8(w, true);
                acc.x += gs[k] * lo[0]; acc.y += gs[k] * lo[1]; acc.z += gs[k] * hi[0]; acc.w += gs[k] * hi[1]; }
            __builtin_nontemporal_store(acc, o + 64 * j);
        }
    }
}

constexpr int N_PHASES = 11;
__global__ void __launch_bounds__(NWAVES * 64, 2) fwd(Args args) {
    extern __shared__ __attribute__((aligned(16))) unsigned char lds[];
    Frame F;
    F.lds = (LAS unsigned char*)lds;
    F.tid = threadIdx.x; F.lane = F.tid & 63; F.wave = __builtin_amdgcn_readfirstlane(F.tid >> 6);
    F.G = gridDim.x; F.bid = blockIdx.x;
    volatile LAS unsigned* MISC = (volatile LAS unsigned*)(F.lds + MISC_OFF);
    if (F.tid < 64) MISC[F.tid] = 0u;
    __syncthreads();
    unsigned char* ws = args.ws;
    unsigned* ctl = (unsigned*)(ws + WS_CTL);
    XcdBarrier bar; bar.bar = ctl + CW_BAR; bar.x = 0; bar.st = nullptr;
    if (MK_N_LAUNCHES == 1) bar = xcd_barrier_post(ctl + CW_BAR, MISC + 8);
    const int lo = args.ph_lo, hi = args.ph_hi;
#ifndef PHASE_MASK
#define PHASE_MASK 0xffff
#endif
#define IN(k) (((PHASE_MASK >> (k)) & 1) && lo <= (k) && (k) < hi)
#ifndef DUP_PHASE
#define DUP_PHASE -1
#endif
#define REPS(k) ((DUP_PHASE >= 0 && (k) == DUP_PHASE) ? args.ph_rep : 1)
#define SEAM(k) do { if (IN(k) && IN((k) + 1)) xcd_barrier(bar); { int t_ = threadIdx.x; asm volatile("" : "+v"(t_)); F.tid = t_; F.lane = t_ & 63; } } while (0)

    for (int rep_ = 0; rep_ < REPS(0); ++rep_) { if (rep_) xcd_barrier(bar);
    if (IN(0)) { p0_prologue(F, args); } } SEAM(0);

    for (int rep_ = 0; rep_ < REPS(1); ++rep_) { if (rep_) xcd_barrier(bar);
    if (IN(1)) {
        pg8::Gemm g{(const bf16*)(ws + WS_XN), (const bf16*)(ws + WS_WIN), T, INC, D / 2}; pg8::StaticOrder S; S.init(T, INC, F.G, F.bid);
        pg8::EpiBf16Q E{(bf16*)(ws + WS_PROJ), INC, (const float*)(ws + WS_XNSC), (const float*)(ws + WS_COLSC1)};
        pg8::gemm_phase<pg8::EpiBf16Q, pg8::StaticOrder, true, true>(F.lds, g, S, E);
    } } SEAM(1);

    for (int rep_ = 0; rep_ < REPS(2); ++rep_) { if (rep_) xcd_barrier(bar);
    if (IN(2)) {
#if NAIVE_RWKV
        rwkv_naive_prep(F, args);
#else
        rwkv_phase_a(F, args);
#endif
    } } SEAM(2);

    for (int rep_ = 0; rep_ < REPS(3); ++rep_) { if (rep_) xcd_barrier(bar);
    if (IN(3)) {
#if NAIVE_RWKV
        rwkv_naive_scan(F, args);
#else
        rwkv_phase_b(F, args);
#endif
        __syncthreads();
#if NAIVE_ATT
        attn_naive(F, args);
#else
        attn_phase(F, args, rep_);
#endif
    } } SEAM(3);

    for (int rep_ = 0; rep_ < REPS(4); ++rep_) { if (rep_) xcd_barrier(bar);
    if (IN(4)) {
#if !NAIVE_RWKV
        rwkv_phase_c(F, args);
#endif
    } } SEAM(4);

    for (int rep_ = 0; rep_ < REPS(5); ++rep_) { if (rep_) xcd_barrier(bar);
    if (IN(5)) {
        pg8::Gemm g{(const bf16*)(ws + WS_MIX), (const bf16*)(ws + WS_WOUT), T, D, D}; pg8::StaticOrder S; S.init(T, D, F.G, F.bid);
        pg8::EpiResid E{args.in[I_X], nullptr, (bf16*)(ws + WS_XN), D};
        pg8::gemm_phase<pg8::EpiResid, pg8::StaticOrder, true, true>(F.lds, g, S, E);
    } } SEAM(5);

    for (int rep_ = 0; rep_ < REPS(6); ++rep_) { if (rep_) xcd_barrier(bar);
    if (IN(6)) { p6_router(F, args); } } SEAM(6);
    for (int rep_ = 0; rep_ < REPS(7); ++rep_) { if (rep_) xcd_barrier(bar);
    if (IN(7)) { p7_permute(F, args); } } SEAM(7);

    for (int rep_ = 0; rep_ < REPS(8); ++rep_) { if (rep_) xcd_barrier(bar);
    if (IN(8)) {
        pg8::Gemm g{(const bf16*)(ws + WS_XQ), (const bf16*)(ws + WS_WUP), NROWS_MAX, 2048, D / 2};
        pg8::MoeOrder<true> S{(const int*)(ws + WS_META), 8, F.G, F.bid, (const int*)(ws + WS_ROWTOK)};
        pg8::EpiSwiGLU E{(bf16*)(ws + WS_ACT), args.in[I_BUP], (const float*)(ws + WS_ROWRSTD), (const float*)(ws + WS_COLSC)};
        pg8::gemm_phase<pg8::EpiSwiGLU, pg8::MoeOrder<true>, true, true>(F.lds, g, S, E);
    } } SEAM(8);

    for (int rep_ = 0; rep_ < REPS(9); ++rep_) { if (rep_) xcd_barrier(bar);
    if (IN(9)) {
        pg8::Gemm g{(const bf16*)(ws + WS_ACT), (const bf16*)(ws + WS_WDN), NROWS_MAX, 1024, D / 2};
        pg8::MoeOrder<false> S{(const int*)(ws + WS_META), 4, F.G, F.bid, nullptr};
        pg8::EpiDown E{(bf16*)(ws + WS_YR), args.in[I_BDN], (const float*)(ws + WS_COLSC2)};
        pg8::gemm_phase<pg8::EpiDown, pg8::MoeOrder<false>, true, true>(F.lds, g, S, E);
    } } SEAM(9);

    if (IN(10)) { p10_combine(F, args); }
#undef IN
#undef SEAM
}

extern "C" void kernel_launch(void* const* d_in, const int* in_sizes, int n_in, void* d_out, int out_size, void* d_ws, size_t ws_size, hipStream_t stream) {
    static int grid = 0;
    if (grid == 0) {
        if (n_in != 25 || out_size != T * D || ws_size < WS_END) { fprintf(stderr, "kernel_launch: unexpected shapes (n_in %d out %d ws %zu)\n", n_in, out_size, ws_size); grid = -1; return; }
        int dev = 0, cus = 0, per_cu = 0;
        if (hipGetDevice(&dev) != hipSuccess || hipDeviceGetAttribute(&cus, hipDeviceAttributeMultiprocessorCount, dev) != hipSuccess) { grid = -1; return; }
        if (hipFuncSetAttribute((const void*)fwd, hipFuncAttributeMaxDynamicSharedMemorySize, LDS_BYTES) != hipSuccess) { fprintf(stderr, "kernel_launch: hipFuncSetAttribute failed\n"); grid = -1; return; }
        if (hipOccupancyMaxActiveBlocksPerMultiprocessor(&per_cu, (const void*)fwd, NWAVES * 64, LDS_BYTES) != hipSuccess || per_cu < 1) { fprintf(stderr, "kernel_launch: occupancy query says %d\n", per_cu); }
        (void)hipGetLastError();
        grid = cus;
    }
    if (grid < 0) return;
    (void)hipMemsetAsync((char*)d_ws + WS_CTL, 0, CTL_ZERO_BYTES, stream);
    Args a{};
    for (int i = 0; i < 25; ++i) a.in[i] = (const float*)d_in[i];
    a.out = (float*)d_out; a.ws = (unsigned char*)d_ws;
#if MK_N_LAUNCHES == 1
    a.ph_lo = 0; a.ph_hi = N_PHASES; a.ph_rep = 2;
    hipLaunchKernelGGL(fwd, dim3(grid), dim3(NWAVES * 64), LDS_BYTES, stream, a);
#else
    for (int p = 0; p < N_PHASES; ++p) { a.ph_lo = p; a.ph_hi = p + 1; hipLaunchKernelGGL(fwd, dim3(grid), dim3(NWAVES * 64), LDS_BYTES, stream, a); }
#endif
}
```

```cpp
#define NAIVE_RWKV 0
#define NAIVE_ATT 0
#define MK_N_LAUNCHES 1
#include <hip/hip_runtime.h>
#include <cstdio>
#include <cstdint>

#ifndef MK_N_LAUNCHES
#define MK_N_LAUNCHES 1
#endif
#ifndef NAIVE_RWKV
#define NAIVE_RWKV 0
#endif
#ifndef NAIVE_ATT
#define NAIVE_ATT 0
#endif

namespace pg8 {
#define PG8_LAS __attribute__((address_space(3)))
typedef unsigned short bf16_t;
typedef short bf16x8 __attribute__((ext_vector_type(8)));
typedef float f32x4 __attribute__((ext_vector_type(4)));
typedef unsigned u32x4 __attribute__((ext_vector_type(4)));
typedef unsigned u32x2 __attribute__((ext_vector_type(2)));
typedef float f32x2e __attribute__((ext_vector_type(2)));
typedef int i32x4 __attribute__((ext_vector_type(4)));
typedef int i32x8 __attribute__((ext_vector_type(8)));
template <bool F8> struct Frag { bf16x8 v[2]; __device__ __forceinline__ void set(bf16x8 a, bf16x8 b) { v[0] = a; v[1] = b; } };
template <> struct Frag<true> { i32x8 v; __device__ __forceinline__ void set(bf16x8 a, bf16x8 b) { v = __builtin_shufflevector(__builtin_bit_cast(i32x4, a), __builtin_bit_cast(i32x4, b), 0, 1, 2, 3, 4, 5, 6, 7); } };
__device__ __forceinline__ i32x8 cat8(bf16x8 a, bf16x8 b) { return __builtin_shufflevector(__builtin_bit_cast(i32x4, a), __builtin_bit_cast(i32x4, b), 0, 1, 2, 3, 4, 5, 6, 7); }
constexpr int BM = 256, BK = 64, HALF = 128, HTB = HALF * BK * 2  , STAGE_BYTES = 8 * HTB, NXCD = 8, WGM = 8, EPF_OFF = STAGE_BYTES  ;

__host__ __device__ __forceinline__ int lds_byte(int r, int c) { const int st = (r >> 4) * 2 + (c >> 5), rr = r & 15, cc = c & 31, ob = rr * 64 + cc * 2; return st * 1024 + (ob ^ (((ob >> 9) & 1) << 5)); }
__host__ __device__ __forceinline__ void stage_rc(int b, int& R, int& C) { const int st = b / 1024, sb = b % 1024, swz = sb ^ (((sb >> 9) & 1) << 5); R = (st >> 1) * 16 + swz / 64; C = (st & 1) * 32 + (swz % 64) / 2; }
__host__ __device__ __forceinline__ int perm32(int rho) { const int n = rho >> 4, i = rho & 15; return 8 * (i >> 2) + 4 * n + (i & 3); }

struct Unit { int pm, pn, e; };
struct Gemm { const bf16_t* A; const bf16_t* Bt; int M, N, K; };

__device__ __forceinline__ bool tile_of(int i, int G, int c, int nM, int nN, int& pm, int& pn) {
    const int nwg = nM * nN; const long L = (long)i * G + c; if (L >= nwg) return false;
    int wgid = (int)L; { const int q = nwg / NXCD, r = nwg % NXCD, xcd = wgid % NXCD, off = wgid / NXCD; wgid = (xcd < r ? xcd * (q + 1) : r * (q + 1) + (xcd - r) * q) + off; }
    const int nig = WGM * nN, gid = wgid / nig, fm = gid * WGM, gsz = (nM - fm) < WGM ? (nM - fm) : WGM;
    pm = fm + ((wgid % nig) % gsz); pn = (wgid % nig) / gsz; return true;
}
struct StaticOrder {
    int nM, nN, G, c;
    __device__ void init(int M, int N, int G_, int c_) { nM = M / BM; nN = N / BM; G = G_; c = c_; }
    __device__ __forceinline__ bool next(int i, Unit& u) const { u.e = 0; return tile_of(i, G, c, nM, nN, u.pm, u.pn); }
    __device__ __forceinline__ const char* a_base(const Gemm& g, const Unit& u) const { return (const char*)g.A + (size_t)u.pm * BM * g.K * 2; }
    __device__ __forceinline__ const char* b_base(const Gemm& g, const Unit& u) const { return (const char*)g.Bt + (size_t)u.pn * BM * g.K * 2; }
    __device__ __forceinline__ void a_off(const Gemm& g, const Unit&, const int (&R)[2], const int (&C)[2], unsigned (&vo)[2][2]) const {
#pragma unroll
        for (int h = 0; h < 2; ++h)
#pragma unroll
            for (int i = 0; i < 2; ++i) vo[h][i] = (unsigned)((h * HALF + R[i]) * g.K + C[i]) * 2u; }
    __device__ __forceinline__ void a_ready(const Unit&) const {}
    __device__ __forceinline__ void done(const Unit&) const {}
};
template <bool GATHER>
struct MoeOrder {
    const int* meta; int nN, G, c;
    __device__ __forceinline__ bool next(int i, Unit& u) const {
        const int nM = __builtin_amdgcn_readfirstlane(meta[0]);
        if (!tile_of(i, G, c, nM, nN, u.pm, u.pn)) return false;
        u.e = __builtin_amdgcn_readfirstlane(meta[16 + u.pm]); return true;
    }
    const int* rowtok;
    __device__ __forceinline__ const char* a_base(const Gemm& g, const Unit& u) const { return GATHER ? (const char*)g.A : (const char*)g.A + (size_t)u.pm * BM * g.K * 2; }
    __device__ __forceinline__ const char* b_base(const Gemm& g, const Unit& u) const { return (const char*)g.Bt + ((size_t)u.e * g.N + (size_t)u.pn * BM) * g.K * 2; }
    __device__ __forceinline__ void a_off(const Gemm& g, const Unit& u, const int (&R)[2], const int (&C)[2], unsigned (&vo)[2][2]) const {
#pragma unroll
        for (int h = 0; h < 2; ++h)
#pragma unroll
            for (int i = 0; i < 2; ++i) { const int r = h * HALF + R[i]; vo[h][i] = (unsigned)((GATHER ? rowtok[u.pm * BM + r] : r) * g.K + C[i]) * 2u; } }
    __device__ __forceinline__ void a_ready(const Unit&) const {}
    __device__ __forceinline__ void done(const Unit&) const {}
};

__device__ __forceinline__ unsigned cvt_pk_bf16(float lo, float hi) { unsigned r; asm volatile("v_cvt_pk_bf16_f32 %0, %1, %2" : "=v"(r) : "v"(lo), "v"(hi)); return r; }

__device__ __forceinline__ float acc_i2f(float bits) { return (float)__builtin_bit_cast(int, bits); }
__device__ __forceinline__ void epf_dma(const float* src_lane, PG8_LAS unsigned char* dst) { __builtin_amdgcn_global_load_lds((const unsigned*)src_lane, (PG8_LAS unsigned*)dst, 16, 0, 0); }
struct EpiBf16Q {
    static constexpr bool PERM = true, AFTER_DRAIN = false, I8 = true, F8 = false, EPF = true;
    bf16_t* O; int ldc; const float* rowsc; const float* colsc;
    __device__ __forceinline__ void prefetch(const Unit& u, PG8_LAS unsigned char* ev, int lane) const {
        epf_dma(colsc + u.pn * BM + 4 * lane, ev); epf_dma(rowsc + u.pm * BM + 4 * lane, ev + 1024); }
    __device__ __forceinline__ void operator()(const f32x4 (&acc)[2][2][4][2], const Unit& u, int wr, int wc, int fr, int fq, const PG8_LAS float* ev) const {
        const int row0 = u.pm * BM + wr * 64 + fr, col0 = u.pn * BM + wc * 32 + 8 * fq;
        f32x4 cv[2][2]; float rsv[2][4];
#pragma unroll
        for (int bj = 0; bj < 2; ++bj)
#pragma unroll
            for (int n = 0; n < 2; ++n) cv[bj][n] = *(const PG8_LAS f32x4*)(ev + wc * 32 + 8 * fq + bj * HALF + 4 * n);
#pragma unroll
        for (int ai = 0; ai < 2; ++ai)
#pragma unroll
            for (int m = 0; m < 4; ++m) rsv[ai][m] = ev[256 + wr * 64 + fr + ai * HALF + m * 16];
#pragma unroll
        for (int ai = 0; ai < 2; ++ai)
#pragma unroll
            for (int m = 0; m < 4; ++m) { bf16_t* rowp = O + (size_t)(row0 + ai * HALF + m * 16) * ldc + col0; const float rs = rsv[ai][m];
#pragma unroll
                for (int bj = 0; bj < 2; ++bj) { f32x4 v0, v1;
#pragma unroll
                    for (int j = 0; j < 4; ++j) { v0[j] = acc_i2f(acc[ai][bj][m][0][j]); v1[j] = acc_i2f(acc[ai][bj][m][1][j]); }
                    v0 = (v0 * rs) * cv[bj][0]; v1 = (v1 * rs) * cv[bj][1];
                    u32x4 w; w.x = cvt_pk_bf16(v0[0], v0[1]); w.y = cvt_pk_bf16(v0[2], v0[3]); w.z = cvt_pk_bf16(v1[0], v1[1]); w.w = cvt_pk_bf16(v1[2], v1[3]);
                    *(u32x4*)(rowp + bj * HALF) = w; } }
    }
};
struct EpiBf16 {
    static constexpr bool PERM = true, AFTER_DRAIN = false, I8 = false, F8 = false, EPF = false;
    bf16_t* O; int ldc;
    __device__ __forceinline__ void operator()(const f32x4 (&acc)[2][2][4][2], const Unit& u, int wr, int wc, int fr, int fq) const {
        const int row0 = u.pm * BM + wr * 64 + fr, col0 = u.pn * BM + wc * 32 + 8 * fq;
#pragma unroll
        for (int ai = 0; ai < 2; ++ai)
#pragma unroll
            for (int m = 0; m < 4; ++m) { bf16_t* rowp = O + (size_t)(row0 + ai * HALF + m * 16) * ldc + col0;
#pragma unroll
                for (int bj = 0; bj < 2; ++bj) { const f32x4 v0 = acc[ai][bj][m][0], v1 = acc[ai][bj][m][1];
                    u32x4 w; w.x = cvt_pk_bf16(v0[0], v0[1]); w.y = cvt_pk_bf16(v0[2], v0[3]); w.z = cvt_pk_bf16(v1[0], v1[1]); w.w = cvt_pk_bf16(v1[2], v1[3]);
                    *(u32x4*)(rowp + bj * HALF) = w; } }
    }
};
struct EpiResid {
    static constexpr bool PERM = false, AFTER_DRAIN = false, I8 = false, F8 = false, EPF = false;
    const float* base; float* out; bf16_t* xb; int ldc;
    __device__ __forceinline__ void operator()(const f32x4 (&acc)[2][2][4][2], const Unit& u, int wr, int wc, int fr, int fq) const {
        const int row0 = u.pm * BM + wr * 64 + fr, col0 = u.pn * BM + wc * 32 + 4 * fq;
        f32x4 nb[4][2][2];
#define PG8_RES_LOAD(g_) do { const size_t off_ = (size_t)(row0 + ((g_) >> 2) * HALF + ((g_) & 3) * 16) * ldc + col0; _Pragma("unroll") for (int bj = 0; bj < 2; ++bj) _Pragma("unroll") for (int n = 0; n < 2; ++n) \
            nb[(g_) & 3][bj][n] = __builtin_nontemporal_load((const f32x4*)(base + off_ + bj * HALF + n * 16)); } while (0)
        PG8_RES_LOAD(0); PG8_RES_LOAD(1); PG8_RES_LOAD(2);
#pragma unroll
        for (int g = 0; g < 8; ++g) { const int ai = g >> 2, m = g & 3; const size_t off = (size_t)(row0 + ai * HALF + m * 16) * ldc + col0;
            if (g + 3 < 8) PG8_RES_LOAD(g + 3);
#pragma unroll
            for (int bj = 0; bj < 2; ++bj)
#pragma unroll
                for (int n = 0; n < 2; ++n) { const f32x4 o = nb[g & 3][bj][n] + acc[ai][bj][m][n];
                    if (out) *(f32x4*)(out + off + bj * HALF + n * 16) = o;
                    u32x2 w; w.x = cvt_pk_bf16(o[0], o[1]); w.y = cvt_pk_bf16(o[2], o[3]); *(u32x2*)(xb + off + bj * HALF + n * 16) = w; }
            asm volatile("" ::: "memory"); }
#undef PG8_RES_LOAD
    }
};
struct EpiSwiGLU {
    static constexpr bool PERM = true, AFTER_DRAIN = false, I8 = true, F8 = false, EPF = true;
    bf16_t* O; const float* b_up; const float* rowrstd; const float* colsc;
    __device__ __forceinline__ void prefetch(const Unit& u, PG8_LAS unsigned char* ev, int lane) const {
        const int off = (size_t)u.e * 2048 + u.pn * HALF + (lane >> 5) * 1024 + 4 * (lane & 31);
        epf_dma(b_up + off, ev); epf_dma(colsc + off, ev + 1024); epf_dma(rowrstd + u.pm * BM + 4 * lane, ev + 2048); }
    __device__ __forceinline__ void operator()(const f32x4 (&acc)[2][2][4][2], const Unit& u, int wr, int wc, int fr, int fq, const PG8_LAS float* ev) const {
        const int row0 = u.pm * BM + wr * 64 + fr, f0 = u.pn * HALF + wc * 32 + 8 * fq;
        const PG8_LAS float* ep = ev + wc * 32 + 8 * fq;
        const f32x4 bg0 = *(const PG8_LAS f32x4*)ep, bg1 = *(const PG8_LAS f32x4*)(ep + 4), bl0 = *(const PG8_LAS f32x4*)(ep + 128), bl1 = *(const PG8_LAS f32x4*)(ep + 132);
        const f32x4 cg0 = *(const PG8_LAS f32x4*)(ep + 256), cg1 = *(const PG8_LAS f32x4*)(ep + 260), cl0 = *(const PG8_LAS f32x4*)(ep + 384), cl1 = *(const PG8_LAS f32x4*)(ep + 388);
        float rsv[2][4];
#pragma unroll
        for (int ai = 0; ai < 2; ++ai)
#pragma unroll
            for (int m = 0; m < 4; ++m) rsv[ai][m] = ev[512 + wr * 64 + fr + ai * HALF + m * 16];
#pragma unroll
        for (int ai = 0; ai < 2; ++ai)
#pragma unroll
            for (int m = 0; m < 4; ++m) { const int row = row0 + ai * HALF + m * 16; const float rs = rsv[ai][m];
                float a[8];
#pragma unroll
                for (int n = 0; n < 2; ++n)
#pragma unroll
                    for (int j = 0; j < 4; j += 2) {
                        const f32x2e ag2 = {acc_i2f(acc[ai][0][m][n][j]), acc_i2f(acc[ai][0][m][n][j + 1])}, al2 = {acc_i2f(acc[ai][1][m][n][j]), acc_i2f(acc[ai][1][m][n][j + 1])};
                        const f32x2e cg2 = n ? (f32x2e){cg1[j], cg1[j + 1]} : (f32x2e){cg0[j], cg0[j + 1]}, cl2 = n ? (f32x2e){cl1[j], cl1[j + 1]} : (f32x2e){cl0[j], cl0[j + 1]};
                        const f32x2e bg2 = n ? (f32x2e){bg1[j], bg1[j + 1]} : (f32x2e){bg0[j], bg0[j + 1]}, bl2 = n ? (f32x2e){bl1[j], bl1[j + 1]} : (f32x2e){bl0[j], bl0[j + 1]};
                        f32x2e hg = (ag2 * rs) * cg2 + bg2, hl = (al2 * rs) * cl2 + bl2;
                        hg.x = fminf(hg.x, 7.0f); hg.y = fminf(hg.y, 7.0f); hl.x = fminf(fmaxf(hl.x, -7.0f), 7.0f); hl.y = fminf(fmaxf(hl.y, -7.0f), 7.0f);
                        const f32x2e t = hg * (-1.702f * 1.4426950408889634f);
                        f32x2e e; e.x = __builtin_amdgcn_exp2f(t.x); e.y = __builtin_amdgcn_exp2f(t.y);
                        const f32x2e d = e + 1.0f; f32x2e sg; sg.x = __builtin_amdgcn_rcpf(d.x); sg.y = __builtin_amdgcn_rcpf(d.y);
                        const f32x2e o = (hg * sg) * (hl + 1.0f);
                        a[n * 4 + j] = o.x; a[n * 4 + j + 1] = o.y; }
                u32x2 w;
                w.x = (unsigned)__builtin_amdgcn_cvt_pk_fp8_f32(a[2], a[3], __builtin_amdgcn_cvt_pk_fp8_f32(a[0], a[1], 0, false), true);
                w.y = (unsigned)__builtin_amdgcn_cvt_pk_fp8_f32(a[6], a[7], __builtin_amdgcn_cvt_pk_fp8_f32(a[4], a[5], 0, false), true);
                *(u32x2*)((unsigned char*)O + (size_t)row * 1024 + f0) = w; }
    }
};
struct EpiDown {
    static constexpr bool PERM = true, AFTER_DRAIN = false, I8 = false, F8 = true, EPF = true;
    bf16_t* O; const float* b_dn; const float* colsc;
    __device__ __forceinline__ void prefetch(const Unit& u, PG8_LAS unsigned char* ev, int lane) const {
        const int off = (size_t)u.e * 1024 + u.pn * BM + 4 * lane;
        epf_dma(b_dn + off, ev); epf_dma(colsc + off, ev + 1024); }
    __device__ __forceinline__ void operator()(const f32x4 (&acc)[2][2][4][2], const Unit& u, int wr, int wc, int fr, int fq, const PG8_LAS float* ev) const {
        const int row0 = u.pm * BM + wr * 64 + fr, col0 = u.pn * BM + wc * 32 + 8 * fq;
        f32x4 bv[2][2], cv[2][2];
#pragma unroll
        for (int bj = 0; bj < 2; ++bj)
#pragma unroll
            for (int n = 0; n < 2; ++n) { bv[bj][n] = *(const PG8_LAS f32x4*)(ev + wc * 32 + 8 * fq + bj * HALF + 4 * n); cv[bj][n] = *(const PG8_LAS f32x4*)(ev + 256 + wc * 32 + 8 * fq + bj * HALF + 4 * n); }
#pragma unroll
        for (int ai = 0; ai < 2; ++ai)
#pragma unroll
            for (int m = 0; m < 4; ++m) { unsigned char* rowp = (unsigned char*)O + (size_t)(row0 + ai * HALF + m * 16) * 1024 + col0;
#pragma unroll
                for (int bj = 0; bj < 2; ++bj) { const f32x4 v0 = acc[ai][bj][m][0] * cv[bj][0] + bv[bj][0], v1 = acc[ai][bj][m][1] * cv[bj][1] + bv[bj][1];
                    u32x2 w; w.x = (unsigned)__builtin_amdgcn_cvt_pk_fp8_f32(v0[2], v0[3], __builtin_amdgcn_cvt_pk_fp8_f32(v0[0], v0[1], 0, false), true);
                    w.y = (unsigned)__builtin_amdgcn_cvt_pk_fp8_f32(v1[2], v1[3], __builtin_amdgcn_cvt_pk_fp8_f32(v1[0], v1[1], 0, false), true);
                    *(u32x2*)(rowp + bj * HALF) = w; } }
    }
};

template <class Epi, class Sched, bool ALIGN_EPI = false, bool SP2 = false>
__device__ __forceinline__ void gemm_phase(PG8_LAS unsigned char* lds, const Gemm g, const Sched& S, const Epi& E) {
    int tid = threadIdx.x; asm volatile("" : "+v"(tid));
    const int wid = __builtin_amdgcn_readfirstlane(tid >> 6), lane = tid & 63, wr = wid >> 2, wc = wid & 3, fr = lane & 15, fq = lane >> 4;
    const int K = g.K, nt = K / BK;
    unsigned voffB[2]; int sR[2], sC[2];
#pragma unroll
    for (int i = 0; i < 2; ++i) { int R, C; stage_rc(tid * 16 + i * 8192, R, C); const int Rb = Epi::PERM ? ((R & ~31) + perm32(R & 31)) : R;
        sR[i] = R; sC[i] = C; voffB[i] = (unsigned)(Rb * K + C) * 2u; }
    const size_t kstep = (size_t)(BK * 2);
    const size_t hstep = (size_t)HALF * K * 2;
    const unsigned ldsw = (unsigned)wid * 1024u;
    const int aoff = lds_byte(wr * 64 + fr, fq * 8), boff = lds_byte(wc * 32 + fr, fq * 8);
#define PG8_SA(b, h) (((b) * 2 + (h)) * HTB)
#define PG8_SB(b, h) ((4 + (b) * 2 + (h)) * HTB)
#define PG8_STAGE(bufoff, gbase, voff) do { _Pragma("unroll") for (int _i = 0; _i < 2; ++_i) \
        __builtin_amdgcn_global_load_lds((const unsigned*)((const char*)(gbase) + (voff)[_i]), (PG8_LAS unsigned*)(lds + (bufoff) + ldsw + _i * 8192), 16, 0, 0); } while (0)
#define PG8_STAGE_A(bufoff, gbase, vo, h) do { _Pragma("unroll") for (int _i = 0; _i < 2; ++_i) \
        __builtin_amdgcn_global_load_lds((const unsigned*)((const char*)(gbase) + (vo)[h][_i]), (PG8_LAS unsigned*)(lds + (bufoff) + ldsw + _i * 8192), 16, 0, 0); } while (0)
#define PG8_LDA(dst, b, h) do { _Pragma("unroll") for (int m = 0; m < 4; ++m) dst[m].set(*(const PG8_LAS bf16x8*)(lds + PG8_SA(b, h) + aoff + m * 2048), *(const PG8_LAS bf16x8*)(lds + PG8_SA(b, h) + aoff + m * 2048 + 1024)); } while (0)
#define PG8_LDB(dst, b, h) do { _Pragma("unroll") for (int n = 0; n < 2; ++n) dst[n].set(*(const PG8_LAS bf16x8*)(lds + PG8_SB(b, h) + boff + n * 2048), *(const PG8_LAS bf16x8*)(lds + PG8_SB(b, h) + boff + n * 2048 + 1024)); } while (0)
#define PG8_MMA(ai, bj, At, Bt) do { __builtin_amdgcn_s_setprio(1); _Pragma("unroll") for (int m = 0; m < 4; ++m) _Pragma("unroll") for (int n = 0; n < 2; ++n) { \
        if constexpr (Epi::F8) asm volatile("v_mfma_scale_f32_16x16x128_f8f6f4 %0, %1, %2, %0, %3, %3 op_sel_hi:[0,0,0]" : "+v"(acc[ai][bj][m][n]) : "v"(Bt[n].v), "v"(At[m].v), "v"(f8scale)); \
        else { _Pragma("unroll") for (int k = 0; k < 2; ++k) { \
            if constexpr (Epi::I8) acc[ai][bj][m][n] = __builtin_bit_cast(f32x4, __builtin_amdgcn_mfma_i32_16x16x64_i8(__builtin_bit_cast(i32x4, Bt[n].v[k]), __builtin_bit_cast(i32x4, At[m].v[k]), __builtin_bit_cast(i32x4, acc[ai][bj][m][n]), 0, 0, 0)); \
            else acc[ai][bj][m][n] = __builtin_amdgcn_mfma_f32_16x16x32_bf16(Bt[n].v[k], At[m].v[k], acc[ai][bj][m][n], 0, 0, 0); } } } __builtin_amdgcn_s_setprio(0); } while (0)
#define PG8_WAIT_V(n) asm volatile("s_waitcnt vmcnt(" #n ")" ::: "memory")
#define PG8_WAIT_L(n) asm volatile("s_waitcnt lgkmcnt(" #n ")" ::: "memory")
#define PG8_BAR __builtin_amdgcn_s_barrier()
#define PG8_SCHED __builtin_amdgcn_sched_barrier(0)
    Unit cur, nxt; int ui = 0;
#ifdef GEMM_TIME
    long long gacc_ = 0;
#endif
    if (!S.next(0, cur)) return;
    f32x4 acc[2][2][4][2];
#pragma unroll
    for (int a = 0; a < 2; ++a)
#pragma unroll
        for (int b = 0; b < 2; ++b)
#pragma unroll
            for (int m = 0; m < 4; ++m)
#pragma unroll
                for (int n = 0; n < 2; ++n) acc[a][b][m][n] = (f32x4){0.f, 0.f, 0.f, 0.f};
    Frag<Epi::F8> At[4], B0[2], B1[2];
    const int f8scale = 0x7f7f7f7f;
    (void)f8scale;
    const char* cA = S.a_base(g, cur); const char* cB = S.b_base(g, cur);
    unsigned voC[2][2], voN[2][2];
    S.a_off(g, cur, sR, sC, voC);
    S.a_ready(cur);
    static_assert(SP2, "only the two-MFMA-blocks-per-barrier-pair loop is kept");
    PG8_STAGE(PG8_SB(0, 0), cB, voffB); PG8_STAGE(PG8_SB(0, 1), cB + hstep, voffB); PG8_STAGE_A(PG8_SA(0, 0), cA, voC, 0); PG8_STAGE_A(PG8_SA(0, 1), cA, voC, 1);
    if (wr == 1) PG8_BAR;
    PG8_WAIT_V(2); PG8_BAR;
    PG8_STAGE(PG8_SB(1, 0), cB + kstep, voffB); PG8_STAGE_A(PG8_SA(1, 0), cA + kstep, voC, 0); PG8_STAGE(PG8_SB(1, 1), cB + hstep + kstep, voffB);
    PG8_WAIT_V(6); PG8_BAR;
    for (;;) {
        const bool has_next = S.next(ui + 1, nxt);
        const char* nA = has_next ? S.a_base(g, nxt) : cA; const char* nB = has_next ? S.b_base(g, nxt) : cB;
        if (has_next) S.a_off(g, nxt, sR, sC, voN); else {
#pragma unroll
            for (int h_ = 0; h_ < 2; ++h_) { voN[h_][0] = voC[h_][0]; voN[h_][1] = voC[h_][1]; } }
#pragma unroll 1
        for (int t = 0; t < nt; t += 2) {
            const bool last = (t == nt - 2);
            const char* a1 = cA + (size_t)(t + 1) * kstep;
            const char* a2 = last ? nA : cA + (size_t)(t + 2) * kstep; const char* b2 = last ? nB : cB + (size_t)(t + 2) * kstep;
            const char* a3 = a2 + kstep; const char* b3 = b2 + kstep;
            if (last && has_next) S.a_ready(nxt);
            if constexpr (Epi::EPF) { if (last && wid == 0) E.prefetch(cur, lds + EPF_OFF, lane); }
            unsigned vo2[2][2];
#pragma unroll
            for (int h_ = 0; h_ < 2; ++h_) { vo2[h_][0] = last ? voN[h_][0] : voC[h_][0]; vo2[h_][1] = last ? voN[h_][1] : voC[h_][1]; }
            PG8_LDB(B0, 0, 0); PG8_LDB(B1, 0, 1); PG8_SCHED; PG8_LDA(At, 0, 0); PG8_STAGE_A(PG8_SA(1, 1), a1, voC, 1);
            PG8_WAIT_V(8); PG8_WAIT_L(0); PG8_BAR; PG8_MMA(0, 0, At, B0); PG8_MMA(0, 1, At, B1); PG8_BAR; PG8_SCHED;
            PG8_LDA(At, 0, 1); PG8_STAGE(PG8_SB(0, 0), b2, voffB); PG8_STAGE(PG8_SB(0, 1), b2 + hstep, voffB); PG8_STAGE_A(PG8_SA(0, 0), a2, vo2, 0);
            PG8_WAIT_V(8); PG8_WAIT_L(0); PG8_BAR; PG8_MMA(1, 0, At, B0); PG8_MMA(1, 1, At, B1); PG8_BAR; PG8_SCHED;
            PG8_LDB(B0, 1, 0); PG8_LDB(B1, 1, 1); PG8_SCHED; PG8_LDA(At, 1, 0); PG8_STAGE_A(PG8_SA(0, 1), a2, vo2, 1);
            PG8_WAIT_V(8); PG8_WAIT_L(0); PG8_BAR; PG8_MMA(0, 0, At, B0); PG8_MMA(0, 1, At, B1); PG8_BAR; PG8_SCHED;
            PG8_LDA(At, 1, 1); PG8_STAGE(PG8_SB(1, 0), b3, voffB); PG8_STAGE(PG8_SB(1, 1), b3 + hstep, voffB); PG8_STAGE_A(PG8_SA(1, 0), a3, vo2, 0);
            PG8_WAIT_V(8); PG8_WAIT_L(0); PG8_BAR; PG8_MMA(1, 0, At, B0); PG8_MMA(1, 1, At, B1); PG8_BAR; PG8_SCHED;
        }
        if constexpr (ALIGN_EPI) { if (wr == 0) PG8_BAR; }
#ifdef GEMM_TIME
        const long long gt0_ = clock64();
#endif
        if constexpr (!Epi::AFTER_DRAIN) { if constexpr (Epi::EPF) E(acc, cur, wr, wc, fr, fq, (const PG8_LAS float*)(lds + EPF_OFF)); else E(acc, cur, wr, wc, fr, fq); S.done(cur); }
#ifdef GEMM_TIME
        gacc_ += clock64() - gt0_;
#endif
        if (!has_next) break;
#pragma unroll
        for (int a = 0; a < 2; ++a)
#pragma unroll
            for (int b = 0; b < 2; ++b)
#pragma unroll
                for (int m = 0; m < 4; ++m)
#pragma unroll
                    for (int n = 0; n < 2; ++n) acc[a][b][m][n] = (f32x4){0.f, 0.f, 0.f, 0.f};
        cur = nxt; cA = nA; cB = nB; ++ui;
#pragma unroll
        for (int h_ = 0; h_ < 2; ++h_) { voC[h_][0] = voN[h_][0]; voC[h_][1] = voN[h_][1]; }
        if constexpr (ALIGN_EPI) { if (wr == 1) PG8_BAR; }
    }
    PG8_WAIT_V(0);
    if constexpr (!ALIGN_EPI) { if (wr == 0) PG8_BAR; }
    PG8_BAR;
#ifdef GEMM_TIME
    { const long long s0_ = clock64(); while (clock64() - s0_ < gacc_) __builtin_amdgcn_s_sleep(8); }
#endif
    if constexpr (Epi::AFTER_DRAIN) { E.fused(acc, cur, wr, wc, fr, fq, lds, wid, lane); S.done(cur); }
#undef PG8_SA
#undef PG8_SB
#undef PG8_STAGE
#undef PG8_STAGE_A
#undef PG8_LDA
#undef PG8_LDB
#undef PG8_MMA
#undef PG8_WAIT_V
#undef PG8_WAIT_L
#undef PG8_BAR
#undef PG8_SCHED
}
}

constexpr int NWAVES = 8;
constexpr int T = 32768, D = 1024, SEQ = 8192, NBATCH = 4, NCHUNK = SEQ / 64;
constexpr int INC = 3328;
constexpr int PRW = 1536;
constexpr int NEXP = 32, TOPK = 4;
constexpr int NRB_MAX = T * TOPK / 256 + NEXP;
constexpr int NROWS_MAX = NRB_MAX * 256;
constexpr int NITEM = NBATCH * NCHUNK * 8;

constexpr size_t MiB = 1u << 20, KiB = 1u << 10;
constexpr size_t WS_CTL = 0, CTL_ZERO_BYTES = 1 * MiB;
constexpr size_t WS_META = 1 * MiB;
constexpr size_t WS_CNT = 1 * MiB + 64 * KiB;
constexpr size_t WS_EIDX = 2 * MiB, WS_GATE = 2 * MiB + 512 * KiB, WS_LRANK = 3 * MiB, WS_INV = 3 * MiB + 512 * KiB;
constexpr size_t WS_RSTD = 4 * MiB, WS_ROWRSTD = 4 * MiB + 256 * KiB;
constexpr size_t WS_WRT = 5 * MiB;
constexpr size_t WS_PAR = 5 * MiB + 128 * KiB;
constexpr size_t WS_WDEC = 5 * MiB + 256 * KiB, WS_WAAA = WS_WDEC + 64 * KiB, WS_WGATE = WS_WAAA + 64 * KiB;
constexpr size_t WS_WIN = 6 * MiB, WS_WOUT = 13 * MiB;
constexpr size_t WS_ROWTOK = 15 * MiB;
constexpr size_t WS_WUP = 16 * MiB, WS_WDN = 144 * MiB;
constexpr size_t WS_XN = 208 * MiB;
constexpr size_t WS_PROJ = 272 * MiB;
constexpr size_t WS_MIX = 480 * MiB;
constexpr size_t WS_RW = 544 * MiB;
constexpr size_t WS_XG = 272 * MiB, WS_ACT = 544 * MiB, WS_YR = WS_XG;
constexpr size_t WS_COLSC = 15 * MiB + 640 * KiB;
constexpr size_t WS_COLSC1 = 5 * MiB + 192 * KiB;
constexpr size_t WS_XNSC = WS_RSTD;
constexpr size_t WS_COLSC2 = 15 * MiB + 896 * KiB;
constexpr size_t WS_XQ = WS_MIX;
constexpr size_t WS_END = 1000 * MiB;
constexpr int CW_ATT = 8192;
constexpr int CW_BAR = 4096;

constexpr int RING_BYTES = 131072;
constexpr int LDS_BYTES = 163840;
constexpr int MISC_OFF = LDS_BYTES - 256;

#define GAS __attribute__((address_space(1)))
#define LAS __attribute__((address_space(3)))
#define DI __device__ __forceinline__
typedef unsigned short bf16;
typedef unsigned v4u __attribute__((ext_vector_type(4)));
typedef unsigned v2u __attribute__((ext_vector_type(2)));
typedef float f32x4 __attribute__((ext_vector_type(4)));
typedef float f32x2 __attribute__((ext_vector_type(2)));
typedef short bf16x8 __attribute__((ext_vector_type(8)));
typedef __bf16 bf16x2_t __attribute__((ext_vector_type(2)));
#define LDS_WAIT() asm volatile("s_waitcnt lgkmcnt(0)" ::: "memory")
#define VM_WAIT() asm volatile("s_waitcnt vmcnt(0)" ::: "memory")
DI unsigned pk2(float lo, float hi) { const f32x2 v = {lo, hi}; const bf16x2_t b = __builtin_convertvector(v, bf16x2_t); return __builtin_bit_cast(unsigned, b); }
DI float bf2f(unsigned short b) { return __uint_as_float((unsigned)b << 16); }
DI float bflo(unsigned w) { return __uint_as_float(w << 16); }
DI float bfhi(unsigned w) { return __uint_as_float(w & 0xffff0000u); }
DI float wave_sum(float v) {
#pragma unroll
    for (int o = 1; o < 64; o <<= 1) v += __shfl_xor(v, o);
    return v;
}
DI float wave_max(float v) {
#pragma unroll
    for (int o = 1; o < 64; o <<= 1) v = fmaxf(v, __shfl_xor(v, o));
    return v;
}
DI float sigmoidf_(float x) { return 1.0f / (1.0f + __expf(-x)); }

DI float quad_sum(float x) {
    const unsigned a = __builtin_bit_cast(unsigned, x); const auto r = __builtin_amdgcn_permlane32_swap(a, a, false, false);
    const float y = __builtin_bit_cast(float, (unsigned)r[0]) + __builtin_bit_cast(float, (unsigned)r[1]);
    const unsigned b = __builtin_bit_cast(unsigned, y); const auto s = __builtin_amdgcn_permlane16_swap(b, b, false, false);
    return __builtin_bit_cast(float, (unsigned)s[0]) + __builtin_bit_cast(float, (unsigned)s[1]);
}
DI float quad_max(float x) {
    const unsigned a = __builtin_bit_cast(unsigned, x); const auto r = __builtin_amdgcn_permlane32_swap(a, a, false, false);
    const float y = fmaxf(__builtin_bit_cast(float, (unsigned)r[0]), __builtin_bit_cast(float, (unsigned)r[1]));
    const unsigned b = __builtin_bit_cast(unsigned, y); const auto s = __builtin_amdgcn_permlane16_swap(b, b, false, false);
    return fmaxf(__builtin_bit_cast(float, (unsigned)s[0]), __builtin_bit_cast(float, (unsigned)s[1]));
}
#define XB_TMO      128
#define XB_XCNT(j)  (256  + 64 * (j))
#define XB_XSUB(j)  (1280 + 64 * (j))
#define XB_XGEN(j)  (2304 + 64 * (j))
#define XB_TOP      3328
#define XB_TOPGEN   3392
#define XCD_BAR_WORDS 3456
#define XB_SPIN_CAP (NAIVE_RWKV ? (1u << 25) : (1u << 20))

__device__ __forceinline__ unsigned xb_ld(unsigned* p)              { return __hip_atomic_load(p, __ATOMIC_RELAXED, __HIP_MEMORY_SCOPE_AGENT); }
__device__ __forceinline__ unsigned xb_add(unsigned* p, unsigned v) { return __hip_atomic_fetch_add(p, v, __ATOMIC_RELAXED, __HIP_MEMORY_SCOPE_AGENT); }
__device__ __forceinline__ unsigned xb_xcc_id() { return (unsigned)__builtin_amdgcn_s_getreg((3 << 11) | 20) & 0xFu; }
#define XB_SPIN(cond, bar) do { unsigned _sp = 0; while (cond) { __builtin_amdgcn_s_sleep(1); \
    if ((++_sp & 255u) == 0u) { if (xb_ld(&(bar)[XB_TMO])) break; if (_sp > XB_SPIN_CAP) { atomicAdd(&(bar)[XB_TMO], 1u); break; } } } } while (0)

struct XcdBarrier {
    unsigned* bar; unsigned x;
    volatile LAS unsigned* st;
};

__device__ __forceinline__ XcdBarrier xcd_barrier_post(unsigned* bar, volatile LAS unsigned* st) {
    XcdBarrier b; b.bar = bar; b.x = xb_xcc_id(); b.st = st;
    if (threadIdx.x == 0) (void)xb_add(&bar[XB_XCNT(b.x)], 1u);
    return b;
}
__device__ __forceinline__ void xcd_barrier_complete(unsigned* bar, unsigned x, unsigned& nloc, unsigned& nx) {
    const unsigned G = gridDim.x * gridDim.y * gridDim.z;
    unsigned sum, cnt, mine, sp = 0u;
    for (;;) {
        sum = 0u; cnt = 0u; mine = 0u;
#pragma unroll
        for (unsigned j = 0; j < 16; ++j) { const unsigned c = xb_ld(&bar[XB_XCNT(j)]); sum += c; cnt += (c > 0u) ? 1u : 0u; mine = (j == x) ? c : mine; }
        if (sum == G) break;
        __builtin_amdgcn_s_sleep(1);
        if ((++sp & 255u) == 0u) { if (xb_ld(&bar[XB_TMO])) break; if (sp > XB_SPIN_CAP) { atomicAdd(&bar[XB_TMO], 1u); break; } }
    }
    nloc = mine > 0u ? mine : 1u; nx = cnt > 0u ? cnt : 1u;
}

__device__ __forceinline__ void xcd_barrier(const XcdBarrier& b) {
    asm volatile("s_waitcnt vmcnt(0)" ::: "memory");
    __syncthreads();
    if (threadIdx.x == 0) {
        unsigned* bar = b.bar;
        __builtin_amdgcn_s_waitcnt(0);
        unsigned nloc = b.st[0], nx = b.st[1];
        if (nloc == 0u) { xcd_barrier_complete(bar, b.x, nloc, nx); b.st[0] = nloc; b.st[1] = nx; }
        const unsigned old = xb_add(&bar[XB_XSUB(b.x)], 1u);
        const unsigned gen = old / nloc;
        if (old + 1u == (gen + 1u) * nloc) {
            __builtin_amdgcn_fence(__ATOMIC_RELEASE, "agent");
            asm volatile("s_waitcnt vmcnt(0)" ::: "memory");
            const unsigned og = xb_add(&bar[XB_TOP], 1u);
            const unsigned tg = og / nx;
            if (og + 1u == (tg + 1u) * nx) xb_add(&bar[XB_TOPGEN], 1u);
            else XB_SPIN(xb_ld(&bar[XB_TOPGEN]) == tg, bar);
            __builtin_amdgcn_fence(__ATOMIC_ACQUIRE, "agent");
            xb_add(&bar[XB_XGEN(b.x)], 1u);
            asm volatile("s_waitcnt vmcnt(0)" ::: "memory");
        } else {
            XB_SPIN(xb_ld(&bar[XB_XGEN(b.x)]) == gen, bar);
            __builtin_amdgcn_fence(__ATOMIC_ACQUIRE, "agent");
            asm volatile("s_waitcnt vmcnt(0)" ::: "memory");
        }
    }
    __syncthreads();
}

struct Args {
    const float* in[25]; float* out; unsigned char* ws; int ph_lo, ph_hi, ph_rep, pad_;
};
enum { I_X = 0, I_N1G, I_WIN, I_MU, I_QG, I_KG, I_RELB, I_W0, I_WDEC, I_A0, I_WAAA, I_WGATE, I_KK, I_KA, I_RK, I_LNG, I_LNB, I_WOUT, I_N2G, I_WR, I_BR, I_WUP, I_BUP, I_WDN, I_BDN };
struct Frame {
    LAS unsigned char* lds;
    int tid, lane, wave, G, bid;
};


struct TrRegs { f32x4 v[8]; f32x4 s0, s1; bf16* dst; int ldo; };
DI void tr_load(TrRegs& t, const float* __restrict__ W, int ldw, int k0, int n0, bf16* WT, int ldo, long drow, int lane, const float* __restrict__ ksc8 = nullptr) {
    const int r8 = lane >> 3, c4 = lane & 7;
    t.s0 = (f32x4){1.f, 1.f, 1.f, 1.f}; t.s1 = t.s0; if (ksc8) { t.s0 = *(const f32x4*)ksc8; t.s1 = *(const f32x4*)(ksc8 + 4); }
    const float* src = W + (size_t)(k0 + 8 * r8) * ldw + n0 + 4 * c4;
#pragma unroll
    for (int i = 0; i < 8; ++i) t.v[i] = __builtin_nontemporal_load((const f32x4*)(src + (size_t)i * ldw));
    t.dst = WT + (size_t)(drow + 4 * c4) * ldo + k0 + 8 * r8; t.ldo = ldo;
}
DI void tr_store(const TrRegs& t, const float* __restrict__ = nullptr) {
    const f32x4 s0 = t.s0, s1 = t.s1;
#pragma unroll
    for (int j = 0; j < 4; ++j) { const v4u o = {pk2(t.v[0][j] * s0[0], t.v[1][j] * s0[1]), pk2(t.v[2][j] * s0[2], t.v[3][j] * s0[3]), pk2(t.v[4][j] * s1[0], t.v[5][j] * s1[1]), pk2(t.v[6][j] * s1[2], t.v[7][j] * s1[3])};
        __builtin_nontemporal_store(o, (v4u*)(t.dst + (size_t)j * t.ldo)); }
}
DI void tr_item(const float* __restrict__ W, int ldw, int k0, int n0, bf16* WT, int ldo, long drow, LAS float* scr, int lane, const float* __restrict__ ksc) {
    (void)scr; TrRegs t; tr_load(t, W, ldw, k0, n0, WT, ldo, drow, lane, ksc ? ksc + k0 + 8 * (lane >> 3) : nullptr); tr_store(t);
}
constexpr int MOE_TR_UP = NEXP * 16 * 64, MOE_TR_DN = NEXP * 16 * 32, MOE_TR_ALL = MOE_TR_UP + MOE_TR_DN;
DI const float* moe_tr_load(TrRegs& t, const Args& a, int r, int lane) {
    unsigned char* ws = a.ws;
    if (r < MOE_TR_UP) { const int e = r / 1024, kb = (r % 1024) / 64, nb = r % 64, n0 = 32 * nb; const int n1 = n0 & 1023;
        const long drow = (long)(n1 / 128) * 256 + (n0 >= 1024 ? 128 : 0) + (n1 % 128);
        tr_load(t, a.in[I_WUP] + (size_t)e * 1024 * 2048, 2048, 64 * kb, n0, (bf16*)(ws + WS_WUP) + (size_t)e * 2048 * 1024, 1024, drow, lane, a.in[I_N2G] + 64 * kb + 8 * (lane >> 3));
        return nullptr; }
    r -= MOE_TR_UP; const int e = r / 512, kb = (r % 512) / 32, nb = r % 32;
    tr_load(t, a.in[I_WDN] + (size_t)e * 1024 * 1024, 1024, 64 * kb, 32 * nb, (bf16*)(ws + WS_WDN) + (size_t)e * 1024 * 1024, 1024, 32 * nb, lane);
    return nullptr;
}
DI void moe_tr_item(const Args& a, int r, LAS float* scr, int lane) { (void)scr; TrRegs t; const float* s = moe_tr_load(t, a, r, lane); tr_store(t, s); }
DI unsigned q_pack4(float a, float b, float c, float d) {
    const unsigned ua = __builtin_bit_cast(unsigned, a), ub = __builtin_bit_cast(unsigned, b), uc = __builtin_bit_cast(unsigned, c), ud = __builtin_bit_cast(unsigned, d);
    return (ua & 0xffu) | ((ub & 0xffu) << 8) | ((uc & 0xffu) << 16) | (ud << 24); }
constexpr float Q_MAGIC = 12582912.0f;
template <bool DOWN>
DI void moe_q_batch(const Args& a, int batch, int wave, int lane, LAS float* exch) {
    unsigned char* ws = a.ws;
    constexpr int LDW = DOWN ? 1024 : 2048, SPE = LDW / 32;
    const int strip = batch * 4 + (wave >> 1), half = wave & 1, e = strip / SPE, nb = strip % SPE, n0 = 32 * nb, n1 = n0 & 1023;
    const int r8 = lane >> 3, c4 = lane & 7;
    const long drow = DOWN ? (long)n0 : (long)(n1 / 128) * 256 + (n0 >= 1024 ? 128 : 0) + (n1 % 128);
    const float* W = a.in[DOWN ? I_WDN : I_WUP] + (size_t)e * 1024 * LDW + (size_t)(512 * half + 8 * r8) * LDW + n0 + 4 * c4;
    const float* gk = a.in[I_N2G] + 512 * half + 8 * r8;
    const f32x4 one = {1.f, 1.f, 1.f, 1.f};
    f32x4 mx = {0.f, 0.f, 0.f, 0.f};
    for (int g = 0; g < 8; g += 4) {
        f32x4 v[4][8], s0[4], s1[4];
#pragma unroll
        for (int t = 0; t < 4; ++t) { s0[t] = DOWN ? one : *(const f32x4*)(gk + 64 * (g + t)); s1[t] = DOWN ? one : *(const f32x4*)(gk + 64 * (g + t) + 4);
#pragma unroll
            for (int i = 0; i < 8; ++i) v[t][i] = *(const f32x4*)(W + (size_t)(64 * (g + t) + i) * LDW); }
#pragma unroll
        for (int t = 0; t < 4; ++t)
#pragma unroll
            for (int i = 0; i < 8; ++i) { const float s = i < 4 ? s0[t][i] : s1[t][i - 4]; const f32x4 p = v[t][i] * s;
#pragma unroll
                for (int j = 0; j < 4; ++j) mx[j] = fmaxf(mx[j], fabsf(p[j])); }
    }
#pragma unroll
    for (int j = 0; j < 4; ++j) { float m = mx[j]; m = fmaxf(m, __shfl_xor(m, 8)); m = fmaxf(m, __shfl_xor(m, 16)); m = fmaxf(m, __shfl_xor(m, 32)); mx[j] = m; }
    if (r8 == 0) *(LAS f32x4*)(exch + (wave * 8 + c4) * 4) = mx;
    __syncthreads();
    { const f32x4 o = *(const LAS f32x4*)(exch + ((wave ^ 1) * 8 + c4) * 4);
#pragma unroll
      for (int j = 0; j < 4; ++j) mx[j] = fmaxf(mx[j], o[j]); }
    constexpr float QMAX = DOWN ? 256.0f : 127.0f;
    if (half == 0 && r8 == 0) *(f32x4*)((float*)(ws + (DOWN ? WS_COLSC2 : WS_COLSC)) + (size_t)e * LDW + n0 + 4 * c4) = mx * (1.0f / QMAX);
    f32x4 inv;
#pragma unroll
    for (int j = 0; j < 4; ++j) inv[j] = mx[j] > 0.f ? QMAX / mx[j] : 0.f;
    unsigned char* dst = ws + (DOWN ? WS_WDN : WS_WUP) + ((size_t)e * LDW + drow + 4 * c4) * 1024 + 512 * half + 8 * r8;
    for (int g = 0; g < 8; g += 2) {
        f32x4 v[2][8], s0[2], s1[2];
#pragma unroll
        for (int t = 0; t < 2; ++t) { s0[t] = DOWN ? one : *(const f32x4*)(gk + 64 * (g + t)); s1[t] = DOWN ? one : *(const f32x4*)(gk + 64 * (g + t) + 4);
#pragma unroll
            for (int i = 0; i < 8; ++i) v[t][i] = __builtin_nontemporal_load((const f32x4*)(W + (size_t)(64 * (g + t) + i) * LDW)); }
#pragma unroll
        for (int t = 0; t < 2; ++t) {
            f32x4 p[8];
#pragma unroll
            for (int i = 0; i < 8; ++i) { const float s = i < 4 ? s0[t][i] : s1[t][i - 4]; p[i] = DOWN ? v[t][i] * inv : (v[t][i] * s) * inv + Q_MAGIC; }
#pragma unroll
            for (int j = 0; j < 4; ++j) { v2u o;
                if (DOWN) { o.x = (unsigned)__builtin_amdgcn_cvt_pk_fp8_f32(p[2][j], p[3][j], __builtin_amdgcn_cvt_pk_fp8_f32(p[0][j], p[1][j], 0, false), true);
                            o.y = (unsigned)__builtin_amdgcn_cvt_pk_fp8_f32(p[6][j], p[7][j], __builtin_amdgcn_cvt_pk_fp8_f32(p[4][j], p[5][j], 0, false), true); }
                else { o.x = q_pack4(p[0][j], p[1][j], p[2][j], p[3][j]); o.y = q_pack4(p[4][j], p[5][j], p[6][j], p[7][j]); }
                __builtin_nontemporal_store(o, (v2u*)(dst + (size_t)j * 1024 + 64 * (g + t))); } }
    }
}
DI void q_strip_i8_wg(const float* __restrict__ Wsrc, int ldw, int n0, unsigned char* WT, float* colsc, int wave, int lane, LAS float* exch) {
    const int r8 = lane >> 3, c4 = lane & 7;
    const float* W = Wsrc + (size_t)(128 * wave + 8 * r8) * ldw + n0 + 4 * c4;
    f32x4 v[2][8], mx = {0.f, 0.f, 0.f, 0.f};
#pragma unroll
    for (int t = 0; t < 2; ++t)
#pragma unroll
        for (int i = 0; i < 8; ++i) v[t][i] = *(const f32x4*)(W + (size_t)(64 * t + i) * ldw);
#pragma unroll
    for (int t = 0; t < 2; ++t)
#pragma unroll
        for (int i = 0; i < 8; ++i)
#pragma unroll
            for (int j = 0; j < 4; ++j) mx[j] = fmaxf(mx[j], fabsf(v[t][i][j]));
#pragma unroll
    for (int j = 0; j < 4; ++j) { float m = mx[j]; m = fmaxf(m, __shfl_xor(m, 8)); m = fmaxf(m, __shfl_xor(m, 16)); m = fmaxf(m, __shfl_xor(m, 32)); mx[j] = m; }
    if (r8 == 0) *(LAS f32x4*)(exch + (wave * 8 + c4) * 4) = mx;
    __syncthreads();
#pragma unroll
    for (int w2 = 0; w2 < 8; ++w2) { const f32x4 o = *(const LAS f32x4*)(exch + (w2 * 8 + c4) * 4);
#pragma unroll
        for (int j = 0; j < 4; ++j) mx[j] = fmaxf(mx[j], o[j]); }
    if (wave == 0 && r8 == 0) *(f32x4*)(colsc + n0 + 4 * c4) = mx * (1.0f / 127.0f);
    f32x4 inv;
#pragma unroll
    for (int j = 0; j < 4; ++j) inv[j] = mx[j] > 0.f ? 127.0f / mx[j] : 0.f;
    unsigned char* dst = WT + (size_t)(n0 + 4 * c4) * 1024 + 128 * wave + 8 * r8;
#pragma unroll
    for (int t = 0; t < 2; ++t) {
        f32x4 p[8];
#pragma unroll
        for (int i = 0; i < 8; ++i) p[i] = v[t][i] * inv + Q_MAGIC;
#pragma unroll
        for (int j = 0; j < 4; ++j) { const v2u o = {q_pack4(p[0][j], p[1][j], p[2][j], p[3][j]), q_pack4(p[4][j], p[5][j], p[6][j], p[7][j])};
            *(v2u*)(dst + (size_t)j * 1024 + 64 * t) = o; } }
}
DI void moe_tr_batch(const Args& a, int batch, int wave, int lane, LAS float* exch) {
    if (batch < MOE_TR_UP / 64) moe_q_batch<false>(a, batch, wave, lane, exch); else moe_q_batch<true>(a, batch - MOE_TR_UP / 64, wave, lane, exch);
}
constexpr int MOE_TR_BATCHES = MOE_TR_ALL / 64, MOE_TR_EARLY = 256;

#if !NAIVE_ATT
constexpr int ATT_KS = 144;
constexpr int ATT_TILE = 64 * ATT_KS;
constexpr int ATT_BIAS_OFF = 4 * ATT_TILE;
constexpr int ATT_NSLOT = (NBATCH * 8 * (NCHUNK / 2) / 8) * 11;
static_assert(NBATCH * 8 * (NCHUNK / 2) == 2048 && MOE_TR_ALL == 256 * 3 * 64, "attention / conversion work queue");
DI int att_pos(int key) { return (key & 32) + 8 * ((key >> 2) & 3) + 4 * ((key >> 4) & 1) + (key & 3); }
DI void attn_phase(const Frame& F, const Args& a, const int qid = 0) {
    const bf16* proj = (const bf16*)(a.ws + WS_PROJ); bf16* mix = (bf16*)(a.ws + WS_MIX);
    LAS unsigned char* lds = F.lds; LAS float* sbias = (LAS float*)(lds + ATT_BIAS_OFF);
    const int l = F.lane, n16 = l & 15, q = l >> 4, w = F.wave;
    const float LOG2E = 1.4426950408889634f;
    const int srow = F.tid >> 3, spc = F.tid & 7;
    float kgv[8];
#pragma unroll
    for (int j = 0; j < 8; ++j) kgv[j] = a.in[I_KG][8 * spc + j];
    const int spos = att_pos(srow);
    LAS int* s_item = (LAS int*)(lds + ATT_BIAS_OFF + 1024);
    unsigned* qhead = (unsigned*)(a.ws + WS_CTL) + CW_ATT + 64 * qid;
    for (;;) {
        __syncthreads();
        if (F.tid == 0) *s_item = (int)__hip_atomic_fetch_add(qhead, 1u, __ATOMIC_RELAXED, __HIP_MEMORY_SCOPE_AGENT);
        __syncthreads();
        const int slot = *s_item;
        if (slot >= ATT_NSLOT) break;
        const int grp = slot / 11, sub = slot % 11;
        if (sub >= 8) { const int base = (grp * 3 + (sub - 8)) * 64 + w * 8;
            (void)base; moe_tr_batch(a, grp * 3 + (sub - 8), w, l, (LAS float*)(lds + ATT_BIAS_OFF + 2048));
            continue; }
        const int item = grp * 8 + sub;
        const int b = item / (8 * (NCHUNK / 2)), h = (item / (NCHUNK / 2)) & 7, n0 = 2 * (item % (NCHUNK / 2));
        if (F.tid < 192) sbias[F.tid] = a.in[I_RELB][h * 192 + F.tid] * LOG2E;
        const int nq = n0 + (w >> 2), qpos = 16 * (w & 3) + n16;
        const size_t qtok = (size_t)b * SEQ + nq * 64 + qpos;
        bf16x8 qf[2];
        { const v4u q0 = *(const v4u*)(proj + qtok * INC + h * 64 + 8 * q), q1 = *(const v4u*)(proj + qtok * INC + h * 64 + 32 + 8 * q);
          float f[16]; const unsigned ww[8] = {q0.x, q0.y, q0.z, q0.w, q1.x, q1.y, q1.z, q1.w};
          float ss = 0.f;
#pragma unroll
          for (int e = 0; e < 8; ++e) { f[2 * e] = bflo(ww[e]); f[2 * e + 1] = bfhi(ww[e]); ss += f[2 * e] * f[2 * e] + f[2 * e + 1] * f[2 * e + 1]; }
          ss = quad_sum(ss);
          const float rs = (1.0f / sqrtf(ss * (1.f / 64.f) + 1e-6f)) * 0.125f * LOG2E;
          unsigned pk[8];
#pragma unroll
          for (int e = 0; e < 8; ++e) { const int d = (e < 4 ? 0 : 32) + 8 * q + 2 * (e & 3); pk[e] = pk2(f[2 * e] * rs * a.in[I_QG][d], f[2 * e + 1] * rs * a.in[I_QG][d + 1]); }
          const v4u p0 = {pk[0], pk[1], pk[2], pk[3]}, p1 = {pk[4], pk[5], pk[6], pk[7]};
          qf[0] = __builtin_bit_cast(bf16x8, p0); qf[1] = __builtin_bit_cast(bf16x8, p1); }
        f32x4 o[4];
#pragma unroll
        for (int dt = 0; dt < 4; ++dt) o[dt] = (f32x4){0.f, 0.f, 0.f, 0.f};
        float m_run = -3.0e38f, l_run = 0.f;
        v4u kreg, vreg;
        auto gload = [&](int jc) { const int kc = n0 - 8 + jc; if (kc >= 0) { const size_t tok = (size_t)b * SEQ + kc * 64 + srow;
            kreg = *(const v4u*)(proj + tok * INC + 512 + h * 64 + 8 * spc); vreg = *(const v4u*)(proj + tok * INC + 1024 + h * 64 + 8 * spc); } };
        auto lstore = [&](int jc) { const int kc = n0 - 8 + jc; if (kc >= 0) { LAS unsigned char* kb = lds + (jc & 1) * 2 * ATT_TILE; LAS unsigned char* vb = kb + ATT_TILE;
            const unsigned ww[4] = {kreg.x, kreg.y, kreg.z, kreg.w}; float f[8]; float ss = 0.f;
#pragma unroll
            for (int e = 0; e < 4; ++e) { f[2 * e] = bflo(ww[e]); f[2 * e + 1] = bfhi(ww[e]); ss += f[2 * e] * f[2 * e] + f[2 * e + 1] * f[2 * e + 1]; }
            ss += __builtin_bit_cast(float, __builtin_amdgcn_update_dpp(0, __builtin_bit_cast(int, ss), 0xB1, 0xf, 0xf, true));
            ss += __builtin_bit_cast(float, __builtin_amdgcn_update_dpp(0, __builtin_bit_cast(int, ss), 0x4E, 0xf, 0xf, true));
            ss += __builtin_bit_cast(float, __builtin_amdgcn_update_dpp(0, __builtin_bit_cast(int, ss), 0x141, 0xf, 0xf, true));
            const float rs = 1.0f / sqrtf(ss * (1.f / 64.f) + 1e-6f);
            v4u kk; kk.x = pk2(f[0] * rs * kgv[0], f[1] * rs * kgv[1]); kk.y = pk2(f[2] * rs * kgv[2], f[3] * rs * kgv[3]); kk.z = pk2(f[4] * rs * kgv[4], f[5] * rs * kgv[5]); kk.w = pk2(f[6] * rs * kgv[6], f[7] * rs * kgv[7]);
            *(LAS v4u*)(kb + srow * ATT_KS + 16 * spc) = kk;
            const unsigned vv[4] = {vreg.x, vreg.y, vreg.z, vreg.w};
#pragma unroll
            for (int e = 0; e < 4; ++e) { *(LAS unsigned short*)(vb + (8 * spc + 2 * e) * ATT_KS + 2 * spos) = (unsigned short)(vv[e] & 0xffffu);
                                          *(LAS unsigned short*)(vb + (8 * spc + 2 * e + 1) * ATT_KS + 2 * spos) = (unsigned short)(vv[e] >> 16); } } };
        gload(0); lstore(0);
        __syncthreads();
        for (int jc = 0; jc < 10; ++jc) {
            if (jc + 1 < 10) gload(jc + 1);
            const int kc = n0 - 8 + jc, dj = jc - (w >> 2);
            if (kc >= 0 && dj >= 0 && dj <= 8) {
                const LAS unsigned char* kb = lds + (jc & 1) * 2 * ATT_TILE; const LAS unsigned char* vb = kb + ATT_TILE;
                f32x4 sc[4];
#pragma unroll
                for (int mt = 0; mt < 4; ++mt) { sc[mt] = (f32x4){0.f, 0.f, 0.f, 0.f};
#pragma unroll
                    for (int ks = 0; ks < 2; ++ks) { const bf16x8 kf = *(const LAS bf16x8*)(kb + (16 * mt + n16) * ATT_KS + 64 * ks + 16 * q);
                        sc[mt] = __builtin_amdgcn_mfma_f32_16x16x32_bf16(kf, qf[ks], sc[mt], 0, 0, 0); } }
                float boff = 0.f;
                if (dj <= 5) boff = sbias[0];
                else { const int base = (dj - 8) * 64 - qpos + 128;
#pragma unroll
                    for (int mt = 0; mt < 4; ++mt)
#pragma unroll
                        for (int i = 0; i < 4; ++i) { int idx = base + 16 * mt + 4 * q + i; idx = idx < 0 ? 0 : idx; const float bv_ = sbias[idx];
                            sc[mt][i] += bv_; } }
                float mx = sc[0][0];
#pragma unroll
                for (int mt = 0; mt < 4; ++mt)
#pragma unroll
                    for (int i = 0; i < 4; ++i) mx = fmaxf(mx, sc[mt][i]);
                mx = quad_max(mx);
                const float m_new = fmaxf(m_run, mx + boff), alpha = __builtin_amdgcn_exp2f(m_run - m_new), msub = m_new - boff;
                const bool moved = __builtin_amdgcn_ballot_w64(m_new != m_run) != 0ull;
                m_run = m_new; float ls = 0.f;
#pragma unroll
                for (int mt = 0; mt < 4; ++mt)
#pragma unroll
                    for (int i = 0; i < 4; ++i) { sc[mt][i] = __builtin_amdgcn_exp2f(sc[mt][i] - msub); ls += sc[mt][i]; }
                if (moved) { l_run *= alpha;
#pragma unroll
                    for (int dt = 0; dt < 4; ++dt) o[dt] = o[dt] * alpha; }
                l_run += ls;
#pragma unroll
                for (int s = 0; s < 2; ++s) {
                    const v4u pp = {pk2(sc[2 * s][0], sc[2 * s][1]), pk2(sc[2 * s][2], sc[2 * s][3]), pk2(sc[2 * s + 1][0], sc[2 * s + 1][1]), pk2(sc[2 * s + 1][2], sc[2 * s + 1][3])};
                    const bf16x8 pf = __builtin_bit_cast(bf16x8, pp);
#pragma unroll
                    for (int dt = 0; dt < 4; ++dt) { const bf16x8 vf = *(const LAS bf16x8*)(vb + (16 * dt + n16) * ATT_KS + 64 * s + 16 * q);
                        o[dt] = __builtin_amdgcn_mfma_f32_16x16x32_bf16(vf, pf, o[dt], 0, 0, 0); } }
            }
            if (jc + 1 < 10) lstore(jc + 1);
            __syncthreads();
        }
        l_run = quad_sum(l_run);
        const float inv = 1.0f / l_run;
#pragma unroll
        for (int dt = 0; dt < 4; ++dt) { v2u ov; ov.x = pk2(o[dt][0] * inv, o[dt][1] * inv); ov.y = pk2(o[dt][2] * inv, o[dt][3] * inv);
            *(v2u*)(mix + qtok * 1024 + h * 64 + 16 * dt + 4 * q) = ov; }
    }
}
#endif

#if !NAIVE_RWKV
constexpr int RA_HALF = 80896;
constexpr int RA_RT = 0, RA_KT = 9216, RA_BT = 18432, RA_AT = 27648;
constexpr int RA_VT = 36864, RA_KH = 46080, RA_BH = 55296;
constexpr int RA_AAB = 64512;
constexpr int RA_XWD = 0, RA_XAD = 9216, RA_XGD = 18432;
constexpr int RA_RHS2 = 0, RA_GEND = 17408;
constexpr int RA_W1T = 18432, RA_W2T = 27648;
constexpr int RA_WT = RA_AAB;
constexpr int RB_REC = 65536, RB_YLT = 0, RB_PCT = 8192, RB_G1T = 16384, RB_E2T = 24576, RB_MC = 32768, RB_CC = 40960, RB_SC = 57344;
static_assert(2 * RA_HALF <= MISC_OFF, "rwkv phase A LDS");

DI void ld8f(const bf16* p, float (&f)[8]) { const v4u w = *(const v4u*)p; f[0] = bflo(w.x); f[1] = bfhi(w.x); f[2] = bflo(w.y); f[3] = bfhi(w.y); f[4] = bflo(w.z); f[5] = bfhi(w.z); f[6] = bflo(w.w); f[7] = bfhi(w.w); }
DI void ld4f(const bf16* p, float (&f)[4]) { const v2u w = *(const v2u*)p; f[0] = bflo(w.x); f[1] = bfhi(w.x); f[2] = bflo(w.y); f[3] = bfhi(w.y); }
DI bf16x8 pack8(const f32x4& a, const f32x4& b) { const v4u p = {pk2(a[0], a[1]), pk2(a[2], a[3]), pk2(b[0], b[1]), pk2(b[2], b[3])}; return __builtin_bit_cast(bf16x8, p); }
DI float fast_sigmoid(float x) { return __builtin_amdgcn_rcpf(1.0f + __builtin_amdgcn_exp2f(-1.4426950408889634f * x)); }
DI float fast_tanh(float x) { return 1.0f - 2.0f * __builtin_amdgcn_rcpf(1.0f + __builtin_amdgcn_exp2f(2.8853900817779268f * x)); }
#define MFMA16(a, b, c) __builtin_amdgcn_mfma_f32_16x16x32_bf16((a), (b), (c), 0, 0, 0)

DI void rwkv_phase_a(const Frame& F, const Args& a) {
    unsigned char* ws = a.ws; unsigned char* rb = ws + WS_RW;
    const bf16* wdec = (const bf16*)(ws + WS_WDEC); const bf16* waaa = (const bf16*)(ws + WS_WAAA); const bf16* wgate = (const bf16*)(ws + WS_WGATE);
    const float* mu = a.in[I_MU]; const float* par = (const float*)(ws + WS_PAR);
    const int hb = F.wave >> 2, w4 = F.wave & 3;
    LAS unsigned char* hbase = F.lds + hb * RA_HALF;
    const float LOG2E = 1.4426950408889634f;
    v4u s0c[4];
#define RA_REQUEST(pair_) do { const int item_ = 2 * (pair_) + hb, c_ = (item_ >> 3) & 127, b_ = item_ >> 10; const size_t tok0_ = (size_t)b_ * SEQ + c_ * 64; \
        int lq_ = F.lane; asm volatile("" : "+v"(lq_)); size_t wsq_ = (size_t)ws; asm volatile("" : "+s"(wsq_)); const int t9q_ = (hb << 8) | (w4 << 6) | lq_; \
        const bf16* cur_ = (const bf16*)(wsq_ + WS_PROJ) + (tok0_ + (t9q_ >> 3)) * INC + PRW + 1536 + 32 * (t9q_ & 7); \
        _Pragma("unroll") for (int g8 = 0; g8 < 4; ++g8) s0c[g8] = *(const v4u*)(cur_ + 8 * g8); } while (0)
    if (F.bid < NITEM / 2) RA_REQUEST(F.bid);
    for (int pair = F.bid; pair < NITEM / 2; pair += F.G) {
        size_t wsb = (size_t)ws; asm volatile("" : "+s"(wsb)); const bf16* proj = (const bf16*)(wsb + WS_PROJ);
        int l = F.lane; asm volatile("" : "+v"(l));
        const int n16 = l & 15, q = l >> 4, t4 = (hb << 8 | (F.wave & 3) << 6 | l) & 255;
        const int tokl = 16 * w4 + n16;
        const int tslot = (tokl & 32) + 8 * ((tokl >> 2) & 3) + 4 * ((tokl >> 4) & 1) + (tokl & 3);
        const int item = 2 * pair + hb, h = item & 7, c = (item >> 3) & 127, b = item >> 10;
        const size_t tok0 = (size_t)b * SEQ + c * 64; unsigned char* rbi = rb + (size_t)item * RB_REC;
        const int t9 = (hb << 8) | t4, tk0 = t9 >> 3, part = t9 & 7;
        v4u s0p[4];
        { const bool first = (c == 0 && tk0 == 0); const bf16* prv = proj + (tok0 + tk0) * INC + PRW + 1536 + 32 * part - INC;
#pragma unroll
          for (int g8 = 0; g8 < 4; ++g8) { s0p[g8] = (v4u){0u, 0u, 0u, 0u}; if (!first) s0p[g8] = *(const v4u*)(prv + 8 * g8); } }
        v2u rawc[3][4], rawp[3][4];
        { const bool first = (c == 0 && tokl == 0); const bf16* cur = proj + (tok0 + tokl) * INC + PRW + h * 64 + 4 * q; const bf16* prv = cur - INC;
#pragma unroll
          for (int m = 0; m < 3; ++m)
#pragma unroll
              for (int ct = 0; ct < 4; ++ct) { rawc[m][ct] = *(const v2u*)(cur + 512 * m + 16 * ct); rawp[m][ct] = (v2u){0u, 0u}; if (!first) rawp[m][ct] = *(const v2u*)(prv + 512 * m + 16 * ct); } }
        bf16x8 wfr[2][8];
#define RA_WLOAD(dst, ctv) do { const int row_ = h * 64 + 16 * (ctv) + n16; \
            dst[0] = *(const bf16x8*)(wdec + row_ * 64 + 8 * q); dst[1] = *(const bf16x8*)(wdec + row_ * 64 + 32 + 8 * q); \
            dst[2] = *(const bf16x8*)(waaa + row_ * 64 + 8 * q); dst[3] = *(const bf16x8*)(waaa + row_ * 64 + 32 + 8 * q); \
            _Pragma("unroll") for (int ks_ = 0; ks_ < 4; ++ks_) dst[4 + ks_] = *(const bf16x8*)(wgate + row_ * 128 + 32 * ks_ + 8 * q); } while (0)
        RA_WLOAD(wfr[0], 0); RA_WLOAD(wfr[1], 1);
        __syncthreads();
        { const float esc = part < 2 ? 2.8853900817779268f : -1.4426950408889634f;
          LAS unsigned char* dst = F.lds + (part < 2 ? RA_XWD + tk0 * 144 + part * 64 : (part < 4 ? RA_XAD + tk0 * 144 + (part - 2) * 64 : RA_XGD + tk0 * 272 + (part - 4) * 64));
#pragma unroll
          for (int g8 = 0; g8 < 4; ++g8) {
              const unsigned xw[4] = {s0c[g8].x, s0c[g8].y, s0c[g8].z, s0c[g8].w}, pw[4] = {s0p[g8].x, s0p[g8].y, s0p[g8].z, s0p[g8].w};
              const f32x4 m0 = *(const f32x4*)(mu + 1536 + 32 * part + 8 * g8), m1 = *(const f32x4*)(mu + 1536 + 32 * part + 8 * g8 + 4);
              float y[8];
#pragma unroll
              for (int j = 0; j < 8; ++j) { const float x = (j & 1) ? bfhi(xw[j >> 1]) : bflo(xw[j >> 1]), p = (j & 1) ? bfhi(pw[j >> 1]) : bflo(pw[j >> 1]);
                  const float xs = x + (p - x) * (j < 4 ? m0[j & 3] : m1[j & 3]);
                  const float rc = __builtin_amdgcn_rcpf(1.0f + __builtin_amdgcn_exp2f(esc * xs));
                  y[j] = part < 2 ? 1.0f - 2.0f * rc : (part < 4 ? xs : rc); }
              const v4u o = {pk2(y[0], y[1]), pk2(y[2], y[3]), pk2(y[4], y[5]), pk2(y[6], y[7])};
              *(LAS v4u*)(dst + 16 * g8) = o; } }
        v2u shv[3][4];
#pragma unroll
        for (int m = 0; m < 3; ++m)
#pragma unroll
            for (int ct = 0; ct < 4; ++ct) { const v2u xw = rawc[m][ct], pw = rawp[m][ct];
                const f32x4 mm = *(const f32x4*)(mu + 512 * m + h * 64 + 16 * ct + 4 * q);
                const float x0 = bflo(xw.x), x1 = bfhi(xw.x), x2 = bflo(xw.y), x3 = bfhi(xw.y);
                shv[m][ct].x = pk2(x0 + (bflo(pw.x) - x0) * mm[0], x1 + (bfhi(pw.x) - x1) * mm[1]); shv[m][ct].y = pk2(x2 + (bflo(pw.y) - x2) * mm[2], x3 + (bfhi(pw.y) - x3) * mm[3]); }
        __syncthreads();
        f32x4 awl[4], aal[4], ag[4];
        { bf16x8 bwd[2], bad[2], bgd[4], wf2[2][8];
          RA_WLOAD(wf2[0], 2); RA_WLOAD(wf2[1], 3);
#pragma unroll
          for (int ks = 0; ks < 2; ++ks) { bwd[ks] = *(const LAS bf16x8*)(F.lds + RA_XWD + tokl * 144 + 64 * ks + 16 * q); bad[ks] = *(const LAS bf16x8*)(F.lds + RA_XAD + tokl * 144 + 64 * ks + 16 * q); }
#pragma unroll
          for (int ks = 0; ks < 4; ++ks) bgd[ks] = *(const LAS bf16x8*)(F.lds + RA_XGD + tokl * 272 + 64 * ks + 16 * q);
#pragma unroll
          for (int ct = 0; ct < 4; ++ct) { const bf16x8* wv = ct < 2 ? wfr[ct] : wf2[ct - 2];
              awl[ct] = (f32x4){0.f, 0.f, 0.f, 0.f}; aal[ct] = awl[ct]; ag[ct] = awl[ct];
#pragma unroll
              for (int ks = 0; ks < 2; ++ks) { awl[ct] = MFMA16(wv[ks], bwd[ks], awl[ct]); aal[ct] = MFMA16(wv[2 + ks], bad[ks], aal[ct]); }
#pragma unroll
              for (int ks = 0; ks < 4; ++ks) ag[ct] = MFMA16(wv[4 + ks], bgd[ks], ag[ct]); } }
#undef RA_WLOAD
        v2u rtp[4];
        {
#define RA_SHIFT(dst, pcol, ctv) do { const v2u w_ = shv[(pcol) / 512][ctv]; dst[0] = bflo(w_.x); dst[1] = bfhi(w_.x); dst[2] = bflo(w_.y); dst[3] = bfhi(w_.y); } while (0)
          float nrm = 0.f, bd = 0.f;
#pragma unroll
          for (int ct = 0; ct < 4; ++ct) { const int ch = h * 64 + 16 * ct + 4 * q;
              float r4[4], k4[4]; RA_SHIFT(r4, 0, ct); RA_SHIFT(k4, 512, ct);
              const f32x4 a0v = *(const f32x4*)(par + 512 + ch), kkv = *(const f32x4*)(par + 1024 + ch), kav = *(const f32x4*)(par + 1536 + ch), rkv = *(const f32x4*)(par + 2048 + ch);
#pragma unroll
              for (int i = 0; i < 4; ++i) { const float av = fast_sigmoid(a0v[i] + aal[ct][i]); const float kk = k4[i] * kkv[i]; nrm += kk * kk;
                  bd += r4[i] * (k4[i] * (1.0f + (av - 1.0f) * kav[i])) * rkv[i]; } }
          nrm = quad_sum(nrm); bd = quad_sum(bd);
          const float kinv = 1.0f / fmaxf(sqrtf(nrm), 1e-12f);
          float lw[4][4], lg[4][4], lgend[4][4];
#pragma unroll
          for (int ct = 0; ct < 4; ++ct) { const f32x4 w0v = *(const f32x4*)(par + h * 64 + 16 * ct + 4 * q);
#pragma unroll
              for (int i = 0; i < 4; ++i) { lw[ct][i] = (-0.6065306597126334f * LOG2E) * fast_sigmoid(w0v[i] + awl[ct][i]); float x = lw[ct][i];
                  x += __builtin_bit_cast(float, __builtin_amdgcn_update_dpp(0, __builtin_bit_cast(int, x), 0x111, 0xf, 0xf, false));
                  x += __builtin_bit_cast(float, __builtin_amdgcn_update_dpp(0, __builtin_bit_cast(int, x), 0x112, 0xf, 0xf, false));
                  x += __builtin_bit_cast(float, __builtin_amdgcn_update_dpp(0, __builtin_bit_cast(int, x), 0x114, 0xf, 0xf, false));
                  x += __builtin_bit_cast(float, __builtin_amdgcn_update_dpp(0, __builtin_bit_cast(int, x), 0x118, 0xf, 0xf, false));
                  lg[ct][i] = x; } }
          LAS float* wt = (LAS float*)(hbase + RA_WT);
          if (n16 == 15) {
#pragma unroll
              for (int ct = 0; ct < 4; ++ct) *(LAS f32x4*)(wt + w4 * 64 + 16 * ct + 4 * q) = (f32x4){lg[ct][0], lg[ct][1], lg[ct][2], lg[ct][3]}; }
          __syncthreads();
#pragma unroll
          for (int ct = 0; ct < 4; ++ct) { f32x4 off = {0.f, 0.f, 0.f, 0.f}, tot = {0.f, 0.f, 0.f, 0.f};
#pragma unroll
              for (int w = 0; w < 4; ++w) { const f32x4 t = *(const LAS f32x4*)(wt + w * 64 + 16 * ct + 4 * q); tot = tot + t; if (w < w4) off = off + t; }
#pragma unroll
              for (int i = 0; i < 4; ++i) { lg[ct][i] += off[i]; lgend[ct][i] = tot[i]; } }
#pragma unroll
          for (int ct = 0; ct < 4; ++ct) { const int ch = h * 64 + 16 * ct + 4 * q;
              float r4[4], k4[4], v4[4]; RA_SHIFT(r4, 0, ct); RA_SHIFT(k4, 512, ct); RA_SHIFT(v4, 1024, ct);
              const f32x4 a0v = *(const f32x4*)(par + 512 + ch), kkv = *(const f32x4*)(par + 1024 + ch), kav = *(const f32x4*)(par + 1536 + ch);
              const f32x4 lg_ = *(const f32x4*)(par + 2560 + ch), lb_ = *(const f32x4*)(par + 3072 + ch);
              float rtl[4], ktl[4], btl[4], atl[4], khh[4], bhh[4], g1[4], e2[4];
#pragma unroll
              for (int i = 0; i < 4; ++i) {
                  const float av = fast_sigmoid(a0v[i] + aal[ct][i]); const float k2 = k4[i] * (1.0f + (av - 1.0f) * kav[i]);
                  const float kkn = k4[i] * kkv[i] * kinv, bb = kkn * av;
                  const float gam = __builtin_amdgcn_exp2f(lg[ct][i]), gpv = __builtin_amdgcn_exp2f(lg[ct][i] - lw[ct][i]), gin = __builtin_amdgcn_exp2f(-lg[ct][i]), ger = __builtin_amdgcn_exp2f(lgend[ct][i] - lg[ct][i]);
                  rtl[i] = r4[i] * gam; ktl[i] = k2 * gin; btl[i] = bb * gin; atl[i] = -kkn * gpv; khh[i] = k2 * ger; bhh[i] = bb * ger;
                  const float g = ag[ct][i]; g1[i] = lg_[i] * g; e2[i] = (lb_[i] + bd * v4[i]) * g;
              }
              const int fo = ((w4 * 4 + ct) * 64 + l) * 8;
              v2u o; o.x = pk2(g1[0], g1[1]); o.y = pk2(g1[2], g1[3]); __builtin_nontemporal_store(o, (v2u*)(rbi + RB_G1T + fo));
              o.x = pk2(e2[0], e2[1]); o.y = pk2(e2[2], e2[3]); __builtin_nontemporal_store(o, (v2u*)(rbi + RB_E2T + fo));
              const int co = tokl * 144 + (16 * ct + 4 * q) * 2;
              o.x = pk2(rtl[0], rtl[1]); o.y = pk2(rtl[2], rtl[3]); *(LAS v2u*)(hbase + RA_RT + co) = o; rtp[ct] = o;
              o.x = pk2(ktl[0], ktl[1]); o.y = pk2(ktl[2], ktl[3]); *(LAS v2u*)(hbase + RA_KT + co) = o;
              o.x = pk2(btl[0], btl[1]); o.y = pk2(btl[2], btl[3]); *(LAS v2u*)(hbase + RA_BT + co) = o;
              o.x = pk2(atl[0], atl[1]); o.y = pk2(atl[2], atl[3]); *(LAS v2u*)(hbase + RA_AT + co) = o;
#pragma unroll
              for (int i = 0; i < 4; ++i) { const int ro = (16 * ct + 4 * q + i) * 144 + 2 * tslot;
                  if (tokl == 0) *(LAS float*)(hbase + RA_VT + (16 * ct + 4 * q + i) * 144 + 128) = __builtin_amdgcn_exp2f(lgend[ct][i]);
                  *(LAS unsigned short*)(hbase + RA_VT + ro) = (unsigned short)(pk2(v4[i], 0.f) & 0xffffu);
                  *(LAS unsigned short*)(hbase + RA_KH + ro) = (unsigned short)(pk2(khh[i], 0.f) & 0xffffu);
                  *(LAS unsigned short*)(hbase + RA_BH + ro) = (unsigned short)(pk2(bhh[i], 0.f) & 0xffffu); }
              asm volatile("" ::: "memory");
          }
#undef RA_SHIFT
        }
        __syncthreads();
        bf16x8 akp[2], rkp[2], rbp[2];
        { bf16x8 fa[2], fr[2];
#pragma unroll
          for (int ks = 0; ks < 2; ++ks) { fa[ks] = *(const LAS bf16x8*)(hbase + RA_AT + tokl * 144 + 64 * ks + 16 * q); fr[ks] = *(const LAS bf16x8*)(hbase + RA_RT + tokl * 144 + 64 * ks + 16 * q); }
          f32x4 aak[4], arkk[4], arb[4];
#pragma unroll
          for (int jt = 0; jt < 4; ++jt) {
              f32x4 tab = {0.f, 0.f, 0.f, 0.f}; aak[jt] = tab; arkk[jt] = tab; arb[jt] = tab;
              if (jt <= w4) {
#pragma unroll
                  for (int ks = 0; ks < 2; ++ks) { const bf16x8 fk = *(const LAS bf16x8*)(hbase + RA_KT + (16 * jt + n16) * 144 + 64 * ks + 16 * q), fb = *(const LAS bf16x8*)(hbase + RA_BT + (16 * jt + n16) * 144 + 64 * ks + 16 * q);
                      aak[jt] = MFMA16(fk, fa[ks], aak[jt]); tab = MFMA16(fb, fa[ks], tab); arkk[jt] = MFMA16(fk, fr[ks], arkk[jt]); arb[jt] = MFMA16(fb, fr[ks], arb[jt]); }
                  if (jt == w4) {
#pragma unroll
                      for (int i = 0; i < 4; ++i) { const int j = 4 * q + i; if (j >= n16) { aak[jt][i] = 0.f; tab[i] = 0.f; } if (j > n16) { arkk[jt][i] = 0.f; arb[jt][i] = 0.f; } } }
                  *(LAS f32x4*)(hbase + RA_AAB + tokl * 256 + (16 * jt + 4 * q) * 4) = tab;
              }
          }
#pragma unroll
          for (int s = 0; s < 2; ++s) { akp[s] = pack8(aak[2 * s], aak[2 * s + 1]); rkp[s] = pack8(arkk[2 * s], arkk[2 * s + 1]); rbp[s] = pack8(arb[2 * s], arb[2 * s + 1]); } }
        { f32x4 akv[4];
#pragma unroll
          for (int vt = 0; vt < 4; ++vt) { akv[vt] = (f32x4){0.f, 0.f, 0.f, 0.f};
#pragma unroll
              for (int s = 0; s < 2; ++s) { const bf16x8 fv = *(const LAS bf16x8*)(hbase + RA_VT + (16 * vt + n16) * 144 + 64 * s + 16 * q); akv[vt] = MFMA16(akp[s], fv, akv[vt]); } }
          __syncthreads();
#pragma unroll
          for (int vt = 0; vt < 4; ++vt) *(LAS f32x4*)(hbase + RA_RHS2 + (16 * vt + n16) * 272 + (16 * w4 + 4 * q) * 4) = akv[vt]; }
        if (pair + F.G < NITEM / 2) RA_REQUEST(pair + F.G);
        { const LAS unsigned char* aab = hbase + RA_AAB + (16 * w4) * 256 + (16 * w4) * 4;
          LAS unsigned char* ti = hbase + RA_BT;
          if (q == 0) { float t[16];
#pragma unroll
              for (int r_ = 0; r_ < 16; ++r_) { float acc = (r_ == n16) ? 1.0f : 0.0f;
#pragma unroll
                  for (int j4 = 0; j4 < (r_ + 3) / 4; ++j4) { const f32x4 av = *(const LAS f32x4*)(aab + r_ * 256 + j4 * 16);
#pragma unroll
                      for (int e = 0; e < 4; ++e) if (4 * j4 + e < r_) acc += av[e] * t[4 * j4 + e]; }
                  t[r_] = acc; *(LAS unsigned short*)(ti + w4 * 512 + r_ * 32 + 2 * n16) = (unsigned short)(pk2(acc, 0.f) & 0xffffu); } }
          __syncthreads();
          bf16x8 a10, a20, a30, a31, tf[4];
          { const LAS unsigned char* ab = hbase + RA_AAB + n16 * 256 + 16 * q; const f32x4 z4 = {0.f, 0.f, 0.f, 0.f};
            const f32x4 l10 = *(const LAS f32x4*)(ab + 16 * 256), l20 = *(const LAS f32x4*)(ab + 32 * 256), l21 = *(const LAS f32x4*)(ab + 32 * 256 + 64);
            const f32x4 l30 = *(const LAS f32x4*)(ab + 48 * 256), l31 = *(const LAS f32x4*)(ab + 48 * 256 + 64), l32 = *(const LAS f32x4*)(ab + 48 * 256 + 128);
            a10 = pack8(l10, z4); a20 = pack8(l20, l21); a30 = pack8(l30, l31); a31 = pack8(l32, z4);
#pragma unroll
            for (int I = 0; I < 4; ++I) { const v2u tw = *(const LAS v2u*)(ti + I * 512 + n16 * 32 + 8 * q); const v4u t4 = {tw.x, tw.y, 0u, 0u}; tf[I] = __builtin_bit_cast(bf16x8, t4); } }
          v4u xw[2][2];
#pragma unroll
          for (int m = 0; m < 2; ++m) {
              v4u x0 = {0u, 0u, 0u, 0u}, x1 = {0u, 0u, 0u, 0u};
#pragma unroll
              for (int I = 0; I < 4; ++I) {
                  f32x4 z;
                  if (m == 0) {
#pragma unroll
                      for (int i = 0; i < 4; ++i) z[i] = bf2f(*(const LAS unsigned short*)(hbase + RA_AT + (16 * I + 4 * q + i) * 144 + 2 * tokl)); }
                  else z = *(const LAS f32x4*)(hbase + RA_RHS2 + tokl * 272 + (16 * I + 4 * q) * 4);
                  if (I == 1) z = MFMA16(a10, __builtin_bit_cast(bf16x8, x0), z);
                  if (I == 2) z = MFMA16(a20, __builtin_bit_cast(bf16x8, x0), z);
                  if (I == 3) { z = MFMA16(a30, __builtin_bit_cast(bf16x8, x0), z); z = MFMA16(a31, __builtin_bit_cast(bf16x8, x1), z); }
                  const v4u zb = {pk2(z[0], z[1]), pk2(z[2], z[3]), 0u, 0u};
                  const f32x4 x = MFMA16(tf[I], __builtin_bit_cast(bf16x8, zb), ((f32x4){0.f, 0.f, 0.f, 0.f}));
                  const unsigned p0 = pk2(x[0], x[1]), p1 = pk2(x[2], x[3]);
                  if (I == 0) { x0.x = p0; x0.y = p1; } if (I == 1) { x0.z = p0; x0.w = p1; } if (I == 2) { x1.x = p0; x1.y = p1; } if (I == 3) { x1.z = p0; x1.w = p1; }
              }
              xw[m][0] = x0; xw[m][1] = x1;
          }
          __syncthreads();
#pragma unroll
          for (int s = 0; s < 2; ++s) { *(LAS v4u*)(hbase + RA_W1T + tokl * 144 + 64 * s + 16 * q) = xw[0][s]; *(LAS v4u*)(hbase + RA_W2T + tokl * 144 + 64 * s + 16 * q) = xw[1][s]; }
        }
        __syncthreads();
        {
          f32x4 pc[4], y0[4];
#pragma unroll
          for (int t = 0; t < 4; ++t) { pc[t] = (f32x4){bflo(rtp[t].x), bfhi(rtp[t].x), bflo(rtp[t].y), bfhi(rtp[t].y)}; y0[t] = (f32x4){0.f, 0.f, 0.f, 0.f};
#pragma unroll
              for (int s = 0; s < 2; ++s) { y0[t] = MFMA16(*(const LAS bf16x8*)(hbase + RA_VT + (16 * t + n16) * 144 + 64 * s + 16 * q), rkp[s], y0[t]);
                                            y0[t] = MFMA16(*(const LAS bf16x8*)(hbase + RA_W2T + (16 * t + n16) * 144 + 64 * s + 16 * q), rbp[s], y0[t]);
                                            pc[t] = MFMA16(*(const LAS bf16x8*)(hbase + RA_W1T + (16 * t + n16) * 144 + 64 * s + 16 * q), rbp[s], pc[t]); } }
#pragma unroll
          for (int vt = 0; vt < 4; ++vt) { v2u o; o.x = pk2(y0[vt][0], y0[vt][1]); o.y = pk2(y0[vt][2], y0[vt][3]); __builtin_nontemporal_store(o, (v2u*)(rbi + RB_YLT + ((w4 * 4 + vt) * 64 + l) * 8)); }
#pragma unroll
          for (int s = 0; s < 2; ++s) __builtin_nontemporal_store(pack8(pc[2 * s], pc[2 * s + 1]), (bf16x8*)(rbi + RB_PCT + ((w4 * 2 + s) * 64 + l) * 16));
          f32x4 mc[4]; bf16x8 fb[2], fvv[2];
#pragma unroll
          for (int s = 0; s < 2; ++s) { fb[s] = *(const LAS bf16x8*)(hbase + RA_BH + tokl * 144 + 64 * s + 16 * q); fvv[s] = *(const LAS bf16x8*)(hbase + RA_VT + tokl * 144 + 64 * s + 16 * q); }
          const float gend_k = *(const LAS float*)(hbase + RA_VT + tokl * 144 + 128);
#pragma unroll
          for (int t = 0; t < 4; ++t) { mc[t] = (f32x4){0.f, 0.f, 0.f, 0.f};
#pragma unroll
              for (int s = 0; s < 2; ++s) mc[t] = MFMA16(*(const LAS bf16x8*)(hbase + RA_W1T + (16 * t + n16) * 144 + 64 * s + 16 * q), fb[s], mc[t]);
              if (t == w4) {
#pragma unroll
                  for (int i = 0; i < 4; ++i) if (4 * q + i == n16) mc[t][i] += gend_k; } }
#pragma unroll
          for (int s = 0; s < 2; ++s) __builtin_nontemporal_store(pack8(mc[2 * s], mc[2 * s + 1]), (bf16x8*)(rbi + RB_MC + ((w4 * 2 + s) * 64 + l) * 16));
          bf16x8 fw2[2];
#pragma unroll
          for (int s = 0; s < 2; ++s) fw2[s] = *(const LAS bf16x8*)(hbase + RA_W2T + tokl * 144 + 64 * s + 16 * q);
#pragma unroll
          for (int kt = 0; kt < 4; ++kt) { f32x4 cc = {0.f, 0.f, 0.f, 0.f};
#pragma unroll
              for (int s = 0; s < 2; ++s) { cc = MFMA16(*(const LAS bf16x8*)(hbase + RA_KH + (16 * kt + n16) * 144 + 64 * s + 16 * q), fvv[s], cc);
                                            cc = MFMA16(*(const LAS bf16x8*)(hbase + RA_BH + (16 * kt + n16) * 144 + 64 * s + 16 * q), fw2[s], cc); }
              v2u cw; cw.x = pk2(cc[0], cc[1]); cw.y = pk2(cc[2], cc[3]); __builtin_nontemporal_store(cw, (v2u*)(rbi + RB_CC + ((w4 * 4 + kt) * 64 + l) * 8)); } }
    }
}

constexpr int RBK_NS = 9, RBK_D = 8, RBK_SLOT = 16384, RBK_BLOCKS = 32;
static_assert(RBK_NS * RBK_SLOT <= MISC_OFF && RBK_D == RBK_NS - 1, "phase B ring");
DI void rwkv_phase_b(const Frame& F, const Args& a) {
    if (F.bid >= RBK_BLOCKS) return;
    unsigned char* rb = a.ws + WS_RW; const int l = F.lane, w = F.wave;
    const int h = F.bid & 7, b = F.bid >> 3;
    LAS unsigned char* lds = F.lds;
    if (w >= 4) {
        const int j = w - 4;
#define RBK_ISSUE(cc_) do { const int c_ = (cc_) < NCHUNK ? (cc_) : NCHUNK - 1; const unsigned char* r_ = rb + (size_t)(((b * 128 + c_) << 3) + h) * RB_REC; \
            LAS unsigned char* slot_ = lds + ((cc_) % RBK_NS) * RBK_SLOT; \
            _Pragma("unroll") for (int k_ = 0; k_ < 4; ++k_) { const int blk_ = 4 * j + k_; \
                const unsigned char* src_ = blk_ < 8 ? r_ + RB_MC + blk_ * 1024 : r_ + RB_CC + (blk_ - 8) * 1024; \
                __builtin_amdgcn_global_load_lds((const unsigned*)(src_ + l * 16), (LAS unsigned*)(slot_ + blk_ * 1024), 16, 0, 0); } } while (0)
        for (int c = 0; c < RBK_D; ++c) RBK_ISSUE(c);
        for (int c = 0; c < NCHUNK; ++c) {
            asm volatile("s_waitcnt vmcnt(28)" ::: "memory");
            __builtin_amdgcn_s_barrier();
            RBK_ISSUE(c + RBK_D);
        }
        asm volatile("s_waitcnt vmcnt(0)" ::: "memory");
        __builtin_amdgcn_s_barrier();
#undef RBK_ISSUE
    } else {
        const int vs = w;
        f32x4 st[4];
#pragma unroll
        for (int kt = 0; kt < 4; ++kt) st[kt] = (f32x4){0.f, 0.f, 0.f, 0.f};
        for (int c = 0; c < NCHUNK; ++c) {
            unsigned char* rbi = rb + (size_t)(((b * 128 + c) << 3) + h) * RB_REC;
            bf16x8 sb[2];
#pragma unroll
            for (int s = 0; s < 2; ++s) { sb[s] = pack8(st[2 * s], st[2 * s + 1]); *(bf16x8*)(rbi + RB_SC + ((vs * 2 + s) * 64 + l) * 16) = sb[s]; }
            __builtin_amdgcn_s_barrier();
            const LAS unsigned char* slot = lds + (c % RBK_NS) * RBK_SLOT;
#pragma unroll
            for (int kt = 0; kt < 4; ++kt) { const v2u cw = *(const LAS v2u*)(slot + 8192 + ((vs * 4 + kt) * 64 + l) * 8);
                f32x4 n = {bflo(cw.x), bfhi(cw.x), bflo(cw.y), bfhi(cw.y)};
#pragma unroll
                for (int s = 0; s < 2; ++s) n = MFMA16(*(const LAS bf16x8*)(slot + ((kt * 2 + s) * 64 + l) * 16), sb[s], n);
                st[kt] = n; }
        }
        __builtin_amdgcn_s_barrier();
    }
}

struct RcOps { bf16x8 pc[2]; v2u yl[4]; bf16x8 sc[4][2]; v2u g1[4], e2[4]; };
DI void rc_load(RcOps& o, const unsigned char* rb, int task, int l) {
    const int item = task >> 2, it = task & 3; const unsigned char* rbi = rb + (size_t)item * RB_REC;
#pragma unroll
    for (int s = 0; s < 2; ++s) o.pc[s] = __builtin_nontemporal_load((const bf16x8*)(rbi + RB_PCT + ((it * 2 + s) * 64 + l) * 16));
#pragma unroll
    for (int vt = 0; vt < 4; ++vt) { const int fo = ((it * 4 + vt) * 64 + l) * 8;
        o.yl[vt] = __builtin_nontemporal_load((const v2u*)(rbi + RB_YLT + fo)); o.g1[vt] = __builtin_nontemporal_load((const v2u*)(rbi + RB_G1T + fo)); o.e2[vt] = __builtin_nontemporal_load((const v2u*)(rbi + RB_E2T + fo));
#pragma unroll
        for (int s = 0; s < 2; ++s) o.sc[vt][s] = __builtin_nontemporal_load((const bf16x8*)(rbi + RB_SC + ((vt * 2 + s) * 64 + l) * 16)); }
}
DI void rwkv_phase_c(const Frame& F, const Args& a) {
    const unsigned char* rb = a.ws + WS_RW; bf16* mix = (bf16*)(a.ws + WS_MIX);
    const int l = F.lane, n16 = l & 15, q = l >> 4;
    const int gw = F.bid * NWAVES + F.wave, NGW = F.G * NWAVES;
    RcOps cur, nxt;
    if (gw < NITEM * 4) rc_load(cur, rb, gw, l);
    for (int task = gw; task < NITEM * 4; task += NGW) {
        const int item = task >> 2, it = task & 3, h = item & 7, c = (item >> 3) & 127, b = item >> 10;
        if (task + NGW < NITEM * 4) rc_load(nxt, rb, task + NGW, l);
        f32x4 y[4]; float sum = 0.f;
#pragma unroll
        for (int vt = 0; vt < 4; ++vt) { y[vt] = (f32x4){bflo(cur.yl[vt].x), bfhi(cur.yl[vt].x), bflo(cur.yl[vt].y), bfhi(cur.yl[vt].y)};
#pragma unroll
            for (int s = 0; s < 2; ++s) y[vt] = MFMA16(cur.sc[vt][s], cur.pc[s], y[vt]);
            sum += (y[vt][0] + y[vt][1]) + (y[vt][2] + y[vt][3]); }
        sum = quad_sum(sum);
        const float mean = sum * (1.f / 64.f); float sq = 0.f;
#pragma unroll
        for (int vt = 0; vt < 4; ++vt) { y[vt] = y[vt] - mean; sq += (y[vt][0] * y[vt][0] + y[vt][1] * y[vt][1]) + (y[vt][2] * y[vt][2] + y[vt][3] * y[vt][3]); }
        sq = quad_sum(sq);
        const float rstd = 1.0f / sqrtf(sq * (1.f / 64.f) + 64e-5f);
        const size_t tok = (size_t)b * SEQ + c * 64 + 16 * it + n16;
#pragma unroll
        for (int vt = 0; vt < 4; ++vt) { const v2u g = cur.g1[vt], e = cur.e2[vt];
            v2u o; o.x = pk2(y[vt][0] * rstd * bflo(g.x) + bflo(e.x), y[vt][1] * rstd * bfhi(g.x) + bfhi(e.x)); o.y = pk2(y[vt][2] * rstd * bflo(g.y) + bflo(e.y), y[vt][3] * rstd * bfhi(g.y) + bfhi(e.y));
            *(v2u*)(mix + tok * 1024 + 512 + h * 64 + 16 * vt + 4 * q) = o; }
        cur = nxt;
    }
}
#endif

DI void p0_prologue(const Frame& F, const Args& a) {
    unsigned char* ws = a.ws;
    LAS float* scr = (LAS float*)(F.lds + F.wave * 16384);
    const int gw = F.bid * NWAVES + F.wave, NGW = F.G * NWAVES;
    constexpr int I_IN = 0, I_OUT = 16 * 32, I_DEC = 16, I_AAA = 16, I_GATE = 32;
    constexpr int NITEMS = I_IN + I_OUT + I_DEC + I_AAA + I_GATE;
    for (int s = F.G - 1 - F.bid; s < INC / 32; s += F.G) { q_strip_i8_wg(a.in[I_WIN], INC, 32 * s, ws + WS_WIN, (float*)(ws + WS_COLSC1), F.wave, F.lane, (LAS float*)F.lds); __syncthreads(); }
    for (int it = gw; it < NITEMS; it += NGW) {
        int r = it;
        if (r < I_OUT) { const int kb = r / 32, nb = r % 32; tr_item(a.in[I_WOUT], 1024, 64 * kb, 32 * nb, (bf16*)(ws + WS_WOUT), 1024, 32 * nb, scr, F.lane, nullptr); continue; } r -= I_OUT;
        if (r < I_DEC) { tr_item(a.in[I_WDEC], 512, 0, 32 * r, (bf16*)(ws + WS_WDEC), 64, 32 * r, scr, F.lane, nullptr); continue; } r -= I_DEC;
        if (r < I_AAA) { tr_item(a.in[I_WAAA], 512, 0, 32 * r, (bf16*)(ws + WS_WAAA), 64, 32 * r, scr, F.lane, nullptr); continue; } r -= I_AAA;
        { const int kb = r / 16, nb = r % 16; tr_item(a.in[I_WGATE], 512, 64 * kb, 32 * nb, (bf16*)(ws + WS_WGATE), 128, 32 * nb, scr, F.lane, nullptr); }
    }
    { float* wrt = (float*)(ws + WS_WRT); const float* wr = a.in[I_WR]; const float* g2 = a.in[I_N2G];
      for (int i = F.bid * 512 + F.tid; i < 32 * 1024; i += F.G * 512) { const int e = i >> 10, k = i & 1023; wrt[i] = g2[k] * wr[k * 32 + e]; } }
    { float* par = (float*)(ws + WS_PAR); const int srcs[7] = {I_W0, I_A0, I_KK, I_KA, I_RK, I_LNG, I_LNB};
      for (int i = F.bid * 512 + F.tid; i < 7 * 512; i += F.G * 512) { const int k = i >> 9; float v = 0.f;
#pragma unroll
          for (int j = 0; j < 7; ++j) if (k == j) v = a.in[srcs[j]][i & 511];
          par[i] = v; } }
    { const float* x = a.in[I_X]; const float* g1 = a.in[I_N1G]; bf16* xn = (bf16*)(ws + WS_XN);
      f32x4 gv[4];
#pragma unroll
      for (int j = 0; j < 4; ++j) gv[j] = *((const f32x4*)g1 + F.lane + 64 * j);
      for (int m0 = 2 * gw; m0 < T; m0 += 2 * NGW) {
          f32x4 v[2][4];
#pragma unroll
          for (int r = 0; r < 2; ++r) { const f32x4* xr = (const f32x4*)(x + (size_t)(m0 + r) * D) + F.lane;
#pragma unroll
              for (int j = 0; j < 4; ++j) v[r][j] = __builtin_nontemporal_load(xr + 64 * j); }
#pragma unroll
          for (int r = 0; r < 2; ++r) { float s = 0.f;
#pragma unroll
              for (int j = 0; j < 4; ++j) s += (v[r][j].x * v[r][j].x + v[r][j].y * v[r][j].y) + (v[r][j].z * v[r][j].z + v[r][j].w * v[r][j].w);
              const float rs = 1.0f / sqrtf(wave_sum(s) * (1.f / D) + 1e-6f);
              f32x4 y[4]; float am = 0.f;
#pragma unroll
              for (int j = 0; j < 4; ++j) { y[j] = (v[r][j] * rs) * gv[j]; am = fmaxf(fmaxf(am, fmaxf(fabsf(y[j].x), fabsf(y[j].y))), fmaxf(fabsf(y[j].z), fabsf(y[j].w))); }
              am = wave_max(am); const float qi = am > 0.f ? 127.0f / am : 0.f;
              if (F.lane == 0) ((float*)(ws + WS_XNSC))[m0 + r] = am * (1.0f / 127.0f);
              unsigned* o4 = (unsigned*)((unsigned char*)xn + (size_t)(m0 + r) * D) + F.lane;
#pragma unroll
              for (int j = 0; j < 4; ++j) { const f32x4 qv = y[j] * qi + Q_MAGIC; o4[64 * j] = q_pack4(qv.x, qv.y, qv.z, qv.w); } }
      } }
}

#if NAIVE_RWKV
DI void rwkv_naive_prep(const Frame& F, const Args& a) {
    const bf16* proj = (const bf16*)(a.ws + WS_PROJ); LAS float* sx = (LAS float*)F.lds;
    float* RW = (float*)(a.ws + WS_RW); float* GG = (float*)(a.ws + WS_XN);
    const float* mu = a.in[I_MU]; const int c = F.tid;
    for (int t = F.bid; t < T; t += F.G) {
        const bool first = (t % SEQ) == 0; const bf16* cur = proj + (size_t)t * INC + PRW; const bf16* prv = cur - INC;
#define SH_(col) ({ const float x_ = bf2f(cur[col]); const float p_ = first ? 0.f : bf2f(prv[col]); x_ + (p_ - x_) * mu[col]; })
        if (c < 256) { const float v = SH_(1536 + c); sx[c] = c < 64 ? tanhf(v) : (c < 128 ? v : sigmoidf_(v)); }
        __syncthreads();
        const float r = SH_(c), k = SH_(512 + c), v = SH_(1024 + c);
#undef SH_
        float wl = a.in[I_W0][c], al = a.in[I_A0][c], g = 0.f;
        const float* wdec = a.in[I_WDEC] + c; const float* waaa = a.in[I_WAAA] + c; const float* wgate = a.in[I_WGATE] + c;
#pragma unroll 4
        for (int j = 0; j < 64; ++j) { wl += sx[j] * wdec[j * 512]; al += sx[64 + j] * waaa[j * 512]; }
#pragma unroll 4
        for (int j = 0; j < 128; ++j) g += sx[128 + j] * wgate[j * 512];
        const float dec = __expf(-0.6065306597126334f * sigmoidf_(wl)), av = sigmoidf_(al);
        float kk = k * a.in[I_KK][c]; const float n2 = wave_sum(kk * kk); kk = kk / fmaxf(sqrtf(n2), 1e-12f);
        const float k2 = k * (1.0f + (av - 1.0f) * a.in[I_KA][c]);
        const size_t o = (size_t)t * 512 + c; const size_t S1 = (size_t)T * 512;
        RW[o] = r; RW[S1 + o] = dec; RW[2 * S1 + o] = k2; RW[3 * S1 + o] = v; RW[4 * S1 + o] = kk; RW[5 * S1 + o] = av; GG[o] = g;
        __syncthreads();
    }
}
DI void rwkv_naive_scan(const Frame& F, const Args& a) {
    if (F.bid >= 32 || F.wave != 0) return;
    const int b = F.bid >> 3, h = F.bid & 7, l = F.lane, c = h * 64 + l;
    const float* RW = (const float*)(a.ws + WS_RW); const float* GG = (const float*)(a.ws + WS_XN); bf16* mix = (bf16*)(a.ws + WS_MIX);
    const size_t S1 = (size_t)T * 512; LAS float* sh = (LAS float*)F.lds;
    LAS float* st = sh + 512 + l;
    for (int k = 0; k < 64; ++k) st[64 * k] = 0.f;
    const float rk = a.in[I_RK][c], lg = a.in[I_LNG][c], lb = a.in[I_LNB][c];
    for (int s = 0; s < SEQ; ++s) {
        const size_t o = (size_t)(b * SEQ + s) * 512 + c;
        const float r = RW[o], w = RW[S1 + o], k2 = RW[2 * S1 + o], v = RW[3 * S1 + o], kk = RW[4 * S1 + o], av = RW[5 * S1 + o], g = GG[o];
        sh[l] = r; sh[64 + l] = w; sh[128 + l] = k2; sh[192 + l] = kk; sh[256 + l] = kk * av;
        LDS_WAIT();
        float sa = 0.f;
#pragma unroll 8
        for (int k = 0; k < 64; ++k) sa -= st[64 * k] * sh[192 + k];
        float y = 0.f;
#pragma unroll 8
        for (int k = 0; k < 64; ++k) { const float nv = st[64 * k] * sh[64 + k] + sa * sh[256 + k] + v * sh[128 + k]; st[64 * k] = nv; y += nv * sh[k]; }
        LDS_WAIT();
        const float mean = wave_sum(y) * (1.f / 64.f); const float d = y - mean; const float var = wave_sum(d * d) * (1.f / 64.f);
        const float yn = d * (1.0f / sqrtf(var + 64e-5f));
        const float bonus = wave_sum(r * k2 * rk) * v;
        const float outv = (yn * lg + lb + bonus) * g;
        mix[(size_t)(b * SEQ + s) * 1024 + 512 + c] = (bf16)(pk2(outv, 0.f) & 0xffffu);
    }
}
#endif
#if NAIVE_ATT
DI void attn_naive(const Frame& F, const Args& a) {
    const bf16* proj = (const bf16*)(a.ws + WS_PROJ); bf16* mix = (bf16*)(a.ws + WS_MIX);
    LAS float* sq = (LAS float*)(F.lds + F.wave * 1024);
    const int gw = F.bid * NWAVES + F.wave, NGW = F.G * NWAVES, l = F.lane;
    const float qg = a.in[I_QG][l];
    for (int it = gw; it < T * 8; it += NGW) {
        const int t = it >> 3, h = it & 7, b = t / SEQ, s = t % SEQ, n = s >> 6;
        const float qd = bf2f(proj[(size_t)t * INC + h * 64 + l]);
        const float qn = qd * (1.0f / sqrtf(wave_sum(qd * qd) * (1.f / 64.f) + 1e-6f)) * qg * 0.125f;
        sq[l] = qn; LDS_WAIT();
        float sc[9]; float mx = -3.0e38f;
#pragma unroll
        for (int r = 0; r < 9; ++r) {
            const int kp = (n - 8) * 64 + 64 * r + l; float v = -3.0e38f;
            if (kp >= 0) {
                const v4u* kr = (const v4u*)(proj + (size_t)(b * SEQ + kp) * INC + 512 + h * 64);
                float ss = 0.f, dot = 0.f;
#pragma unroll
                for (int j = 0; j < 8; ++j) { const v4u w = kr[j]; const unsigned ww[4] = {w.x, w.y, w.z, w.w};
#pragma unroll
                    for (int e = 0; e < 4; ++e) { const float k0 = bflo(ww[e]), k1 = bfhi(ww[e]); const int d0 = 8 * j + 2 * e;
                        ss += k0 * k0 + k1 * k1; dot += sq[d0] * a.in[I_KG][d0] * k0 + sq[d0 + 1] * a.in[I_KG][d0 + 1] * k1; } }
                int rel = kp - s; rel = rel < -128 ? -128 : (rel > 63 ? 63 : rel);
                v = dot * (1.0f / sqrtf(ss * (1.f / 64.f) + 1e-6f)) + a.in[I_RELB][h * 192 + rel + 128];
            }
            sc[r] = v; mx = fmaxf(mx, v);
        }
        mx = wave_max(mx); float sum = 0.f;
#pragma unroll
        for (int r = 0; r < 9; ++r) { sc[r] = (sc[r] > -1.0e38f) ? __expf(sc[r] - mx) : 0.f; sum += sc[r]; }
        sum = wave_sum(sum);
        float o = 0.f;
#pragma unroll
        for (int r = 0; r < 9; ++r) {
            const int kp0 = (n - 8) * 64 + 64 * r;
            if (kp0 >= 0) {
                const bf16* vp = proj + (size_t)(b * SEQ + kp0) * INC + 1024 + h * 64 + l;
                for (int key = 0; key < 64; ++key) o += __shfl(sc[r], key) * bf2f(vp[(size_t)key * INC]);
            }
        }
        mix[(size_t)t * 1024 + h * 64 + l] = (bf16)(pk2(o / sum, 0.f) & 0xffffu);
        LDS_WAIT();
    }
}
#endif

DI void p6_router(const Frame& F, const Args& a) {
    unsigned char* ws = a.ws; const bf16* x1 = (const bf16*)(ws + WS_XN); const float* wrt = (const float*)(ws + WS_WRT); const float* br = a.in[I_BR];
    int* eidx = (int*)(ws + WS_EIDX); float* gate = (float*)(ws + WS_GATE); int* lrank = (int*)(ws + WS_LRANK); float* rstd = (float*)(ws + WS_RSTD); int* cnt = (int*)(ws + WS_CNT);
    constexpr int WROW = 2064, WIMG = 32 * WROW;
    LAS int* hist = (LAS int*)(F.lds + 2 * WIMG);
    const int n = F.lane & 15, q = F.lane >> 4;
    for (int i = F.tid; i < 32 * 256; i += NWAVES * 64) { const int e = i >> 8, c4 = i & 255; const f32x4 w = *((const f32x4*)(wrt + (size_t)e * D) + c4);
        v2u hi, lo; hi.x = pk2(w[0], w[1]); hi.y = pk2(w[2], w[3]);
        lo.x = pk2(w[0] - bflo(hi.x), w[1] - bfhi(hi.x)); lo.y = pk2(w[2] - bflo(hi.y), w[3] - bfhi(hi.y));
        *(LAS v2u*)(F.lds + e * WROW + c4 * 8) = hi; *(LAS v2u*)(F.lds + WIMG + e * WROW + c4 * 8) = lo; }
    __syncthreads();
    for (int tile = F.bid; tile < T / 128; tile += F.G) {
        if (F.tid < 32) hist[F.tid] = 0;
        __syncthreads();
        const int tok = tile * 128 + F.wave * 16 + n;
        const v4u* xr = (const v4u*)(x1 + (size_t)tok * D) + q; const LAS unsigned char* w0 = F.lds + n * WROW + 16 * q;
        f32x4 acc0 = {0.f, 0.f, 0.f, 0.f}, acc1 = {0.f, 0.f, 0.f, 0.f}; float ssq = 0.f, amax = 0.f;
        for (int S0 = 0; S0 < 32; S0 += 16) {
            v4u xw[16];
#pragma unroll
            for (int s = 0; s < 16; ++s) xw[s] = xr[4 * (S0 + s)];
#pragma unroll
            for (int s = 0; s < 16; ++s) { const bf16x8 xb8 = __builtin_bit_cast(bf16x8, xw[s]); const LAS unsigned char* wp = w0 + (S0 + s) * 64;
                const unsigned u[4] = {xw[s].x, xw[s].y, xw[s].z, xw[s].w};
#pragma unroll
                for (int j = 0; j < 4; ++j) { const float a = bflo(u[j]), b = bfhi(u[j]); ssq += a * a + b * b; amax = fmaxf(amax, fmaxf(fabsf(a), fabsf(b))); }
                acc0 = __builtin_amdgcn_mfma_f32_16x16x32_bf16(*(const LAS bf16x8*)(wp), xb8, acc0, 0, 0, 0);
                acc0 = __builtin_amdgcn_mfma_f32_16x16x32_bf16(*(const LAS bf16x8*)(wp + WIMG), xb8, acc0, 0, 0, 0);
                acc1 = __builtin_amdgcn_mfma_f32_16x16x32_bf16(*(const LAS bf16x8*)(wp + 16 * WROW), xb8, acc1, 0, 0, 0);
                acc1 = __builtin_amdgcn_mfma_f32_16x16x32_bf16(*(const LAS bf16x8*)(wp + WIMG + 16 * WROW), xb8, acc1, 0, 0, 0); }
        }
        ssq = quad_sum(ssq); amax = quad_max(amax);
        const float rs = 1.0f / sqrtf(ssq * (1.f / D) + 1e-6f);
        float lg[8];
#pragma unroll
        for (int i = 0; i < 4; ++i) { lg[i] = acc0[i] * rs + br[4 * q + i]; lg[4 + i] = acc1[i] * rs + br[16 + 4 * q + i]; }
        float tv[4]; int ti[4];
#pragma unroll
        for (int r = 0; r < 4; ++r) {
            float bv = -3.0e38f; int bi = 0;
#pragma unroll
            for (int j = 0; j < 8; ++j) { const int e = (j < 4 ? 0 : 16) + 4 * q + (j & 3); if (lg[j] > bv) { bv = lg[j]; bi = e; } }
#pragma unroll
            for (int o = 16; o <= 32; o <<= 1) { const float ov = __shfl_xor(bv, o); const int oi = __shfl_xor(bi, o); if (ov > bv || (ov == bv && oi < bi)) { bv = ov; bi = oi; } }
            tv[r] = bv; ti[r] = bi;
#pragma unroll
            for (int j = 0; j < 8; ++j) { const int e = (j < 4 ? 0 : 16) + 4 * q + (j & 3); if (e == bi) lg[j] = -3.0e38f; }
        }
        if (q == 0) {
            const float e1 = __expf(tv[1] - tv[0]), e2 = __expf(tv[2] - tv[0]), e3 = __expf(tv[3] - tv[0]); const float inv = 1.0f / (1.0f + e1 + e2 + e3);
            int lr[4];
#pragma unroll
            for (int r = 0; r < 4; ++r) lr[r] = atomicAdd((int*)&hist[ti[r]], 1);
            *(int4*)(eidx + (size_t)tok * 4) = make_int4(ti[0], ti[1], ti[2], ti[3]);
            *(float4*)(gate + (size_t)tok * 4) = make_float4(inv, e1 * inv, e2 * inv, e3 * inv);
            *(int4*)(lrank + (size_t)tok * 4) = make_int4(lr[0], lr[1], lr[2], lr[3]);
            rstd[tok] = rs * amax * (1.0f / 127.0f);
        }
        { const float qinv = amax > 0.f ? 127.0f / amax : 0.f; unsigned char* xq = ws + WS_XQ;
            for (int i0 = 0; i0 < 16; i0 += 4) { v4u xa[4], xb2[4];
#pragma unroll
                for (int i = 0; i < 4; ++i) { const v4u* p = (const v4u*)(x1 + (size_t)(tile * 128 + F.wave * 16 + i0 + i) * D) + 2 * F.lane; xa[i] = p[0]; xb2[i] = p[1]; }
#pragma unroll
                for (int i = 0; i < 4; ++i) { const float sc = __builtin_bit_cast(float, __builtin_amdgcn_readlane(__builtin_bit_cast(int, qinv), i0 + i));
                    const unsigned u[8] = {xa[i].x, xa[i].y, xa[i].z, xa[i].w, xb2[i].x, xb2[i].y, xb2[i].z, xb2[i].w}; v4u o;
#pragma unroll
                    for (int d = 0; d < 4; ++d) { const f32x2 lo = {bflo(u[2 * d]), bfhi(u[2 * d])}, hi = {bflo(u[2 * d + 1]), bfhi(u[2 * d + 1])};
                        const f32x2 ql = lo * sc + Q_MAGIC, qh = hi * sc + Q_MAGIC; o[d] = q_pack4(ql.x, ql.y, qh.x, qh.y); }
                    *((v4u*)(xq + (size_t)(tile * 128 + F.wave * 16 + i0 + i) * D) + F.lane) = o; } }
        }
        __syncthreads();
        if (F.tid < 32) cnt[tile * 32 + F.tid] = hist[F.tid];
        __syncthreads();
    }
}

DI void p7_permute(const Frame& F, const Args& a) {
    unsigned char* ws = a.ws; const int* cnt = (const int*)(ws + WS_CNT); int* meta = (int*)(ws + WS_META);
    const int* eidx = (const int*)(ws + WS_EIDX); const int* lrank = (const int*)(ws + WS_LRANK); int* inv = (int*)(ws + WS_INV);
    const float* rstd = (const float*)(ws + WS_RSTD); float* rowrstd = (float*)(ws + WS_ROWRSTD);
    bf16* xb = (bf16*)(ws + WS_XN); int* rowtok = (int*)(ws + WS_ROWTOK);
    LAS int* s_tot = (LAS int*)F.lds; LAS int* s_pst = s_tot + 32; LAS int* s_base = s_tot + 64; LAS int* s_part = s_tot + 128;
    { const int e = F.tid & 31, part = F.tid >> 5; int s = 0; for (int t = part * 16; t < part * 16 + 16; ++t) s += cnt[t * 32 + e]; s_part[part * 32 + e] = s; }
    __syncthreads();
    if (F.tid < 32) { int s = 0; for (int p = 0; p < 16; ++p) s += s_part[p * 32 + F.tid]; s_tot[F.tid] = s; }
    __syncthreads();
    if (F.tid < 32) { int ps = 0; for (int e = 0; e < F.tid; ++e) ps += (s_tot[e] + 255) / 256 * 256; s_pst[F.tid] = ps; }
    __syncthreads();
    if (F.bid == 0 && F.tid < 32) { const int e = F.tid, nb = (s_tot[e] + 255) / 256, rb0 = s_pst[e] / 256; for (int i = 0; i < nb; ++i) meta[16 + rb0 + i] = e; if (e == 31) meta[0] = rb0 + nb; }
    if (F.bid < 32) { const int e = F.bid, r0 = s_pst[e] + s_tot[e], r1 = s_pst[e] + (s_tot[e] + 255) / 256 * 256;
        for (int r = r0 + F.tid; r < r1; r += NWAVES * 64) { rowtok[r] = T; rowrstd[r] = 0.f; } }
    if (F.bid == 0 && F.tid < 64) { const v4u z = {0u, 0u, 0u, 0u}; *((v4u*)(ws + WS_XQ + (size_t)T * D) + F.tid) = z; }
    for (int tile = F.bid; tile < T / 128; tile += F.G) {
        __syncthreads();
        if (F.tid < 32) { int s = 0; for (int t = 0; t < tile; ++t) s += cnt[t * 32 + F.tid]; s_base[F.tid] = s_pst[F.tid] + s; }
        __syncthreads();
        { const int i = F.tid;
            const int tok = tile * 128 + (i >> 2), k = i & 3; const int e = eidx[tok * 4 + k]; const int dest = s_base[e] + lrank[tok * 4 + k];
            inv[tok * 4 + k] = dest; rowtok[dest] = tok; rowrstd[dest] = rstd[tok];
        }
    }
}

DI void p10_combine(const Frame& F, const Args& a) {
    unsigned char* ws = a.ws; const int* inv = (const int*)(ws + WS_INV); const float* gate = (const float*)(ws + WS_GATE); const bf16* yr = (const bf16*)(ws + WS_YR); const bf16* xb = (const bf16*)(ws + WS_XN); float* out = a.out;
    const int gw = F.bid * NWAVES + F.wave, NGW = F.G * NWAVES;
    for (int t = gw; t < T; t += NGW) {
        const int4 iv = *(const int4*)(inv + (size_t)t * 4); const float4 gv = *(const float4*)(gate + (size_t)t * 4);
        const int rows[4] = {iv.x, iv.y, iv.z, iv.w}; const float gs[4] = {gv.x, gv.y, gv.z, gv.w};
        f32x4* o = (f32x4*)(out + (size_t)t * D) + F.lane; const v2u* xr = (const v2u*)(xb + (size_t)t * D) + F.lane;
#pragma unroll
        for (int j = 0; j < 4; ++j) {
            const v2u xw = xr[64 * j]; f32x4 acc = {bflo(xw.x), bfhi(xw.x), bflo(xw.y), bfhi(xw.y)};
#pragma unroll
            for (int k = 0; k < 4; ++k) { const int w = (int)__builtin_nontemporal_load((const unsigned*)((const unsigned char*)yr + (size_t)rows[k] * D) + F.lane + 64 * j);
                const auto lo = __builtin_amdgcn_cvt_pk_f32_fp8(w, false), hi = __builtin_amdgcn_cvt_pk_f32_fp8(w, true);
                acc.x += gs[k] * lo[0]; acc.y += gs[k] * lo[1]; acc.z += gs[k] * hi[0]; acc.w += gs[k] * hi[1]; }
            __builtin_nontemporal_store(acc, o + 64 * j);
        }
    }
}

constexpr int N_PHASES = 11;
__global__ void __launch_bounds__(NWAVES * 64, 2) fwd(Args args) {
    extern __shared__ __attribute__((aligned(16))) unsigned char lds[];
    Frame F;
    F.lds = (LAS unsigned char*)lds;
    F.tid = threadIdx.x; F.lane = F.tid & 63; F.wave = __builtin_amdgcn_readfirstlane(F.tid >> 6);
    F.G = gridDim.x; F.bid = blockIdx.x;
    volatile LAS unsigned* MISC = (volatile LAS unsigned*)(F.lds + MISC_OFF);
    if (F.tid < 64) MISC[F.tid] = 0u;
    __syncthreads();
    unsigned char* ws = args.ws;
    unsigned* ctl = (unsigned*)(ws + WS_CTL);
    XcdBarrier bar; bar.bar = ctl + CW_BAR; bar.x = 0; bar.st = nullptr;
    if (MK_N_LAUNCHES == 1) bar = xcd_barrier_post(ctl + CW_BAR, MISC + 8);
    const int lo = args.ph_lo, hi = args.ph_hi;
#ifndef PHASE_MASK
#define PHASE_MASK 0xffff
#endif
#define IN(k) (((PHASE_MASK >> (k)) & 1) && lo <= (k) && (k) < hi)
#ifndef DUP_PHASE
#define DUP_PHASE -1
#endif
#define REPS(k) ((DUP_PHASE >= 0 && (k) == DUP_PHASE) ? args.ph_rep : 1)
#define SEAM(k) do { if (IN(k) && IN((k) + 1)) xcd_barrier(bar); { int t_ = threadIdx.x; asm volatile("" : "+v"(t_)); F.tid = t_; F.lane = t_ & 63; } } while (0)

    for (int rep_ = 0; rep_ < REPS(0); ++rep_) { if (rep_) xcd_barrier(bar);
    if (IN(0)) { p0_prologue(F, args); } } SEAM(0);

    for (int rep_ = 0; rep_ < REPS(1); ++rep_) { if (rep_) xcd_barrier(bar);
    if (IN(1)) {
        pg8::Gemm g{(const bf16*)(ws + WS_XN), (const bf16*)(ws + WS_WIN), T, INC, D / 2}; pg8::StaticOrder S; S.init(T, INC, F.G, F.bid);
        pg8::EpiBf16Q E{(bf16*)(ws + WS_PROJ), INC, (const float*)(ws + WS_XNSC), (const float*)(ws + WS_COLSC1)};
        pg8::gemm_phase<pg8::EpiBf16Q, pg8::StaticOrder, true, true>(F.lds, g, S, E);
    } } SEAM(1);

    for (int rep_ = 0; rep_ < REPS(2); ++rep_) { if (rep_) xcd_barrier(bar);
    if (IN(2)) {
#if NAIVE_RWKV
        rwkv_naive_prep(F, args);
#else
        rwkv_phase_a(F, args);
#endif
    } } SEAM(2);

    for (int rep_ = 0; rep_ < REPS(3); ++rep_) { if (rep_) xcd_barrier(bar);
    if (IN(3)) {
#if NAIVE_RWKV
        rwkv_naive_scan(F, args);
#else
        rwkv_phase_b(F, args);
#endif
        __syncthreads();
#if NAIVE_ATT
        attn_naive(F, args);
#else
        attn_phase(F, args, rep_);
#endif
    } } SEAM(3);

    for (int rep_ = 0; rep_ < REPS(4); ++rep_) { if (rep_) xcd_barrier(bar);
    if (IN(4)) {
#if !NAIVE_RWKV
        rwkv_phase_c(F, args);
#endif
    } } SEAM(4);

    for (int rep_ = 0; rep_ < REPS(5); ++rep_) { if (rep_) xcd_barrier(bar);
    if (IN(5)) {
        pg8::Gemm g{(const bf16*)(ws + WS_MIX), (const bf16*)(ws + WS_WOUT), T, D, D}; pg8::StaticOrder S; S.init(T, D, F.G, F.bid);
        pg8::EpiResid E{args.in[I_X], nullptr, (bf16*)(ws + WS_XN), D};
        pg8::gemm_phase<pg8::EpiResid, pg8::StaticOrder, true, true>(F.lds, g, S, E);
    } } SEAM(5);

    for (int rep_ = 0; rep_ < REPS(6); ++rep_) { if (rep_) xcd_barrier(bar);
    if (IN(6)) { p6_router(F, args); } } SEAM(6);
    for (int rep_ = 0; rep_ < REPS(7); ++rep_) { if (rep_) xcd_barrier(bar);
    if (IN(7)) { p7_permute(F, args); } } SEAM(7);

    for (int rep_ = 0; rep_ < REPS(8); ++rep_) { if (rep_) xcd_barrier(bar);
    if (IN(8)) {
        pg8::Gemm g{(const bf16*)(ws + WS_XQ), (const bf16*)(ws + WS_WUP), NROWS_MAX, 2048, D / 2};
        pg8::MoeOrder<true> S{(const int*)(ws + WS_META), 8, F.G, F.bid, (const int*)(ws + WS_ROWTOK)};
        pg8::EpiSwiGLU E{(bf16*)(ws + WS_ACT), args.in[I_BUP], (const float*)(ws + WS_ROWRSTD), (const float*)(ws + WS_COLSC)};
        pg8::gemm_phase<pg8::EpiSwiGLU, pg8::MoeOrder<true>, true, true>(F.lds, g, S, E);
    } } SEAM(8);

    for (int rep_ = 0; rep_ < REPS(9); ++rep_) { if (rep_) xcd_barrier(bar);
    if (IN(9)) {
        pg8::Gemm g{(const bf16*)(ws + WS_ACT), (const bf16*)(ws + WS_WDN), NROWS_MAX, 1024, D / 2};
        pg8::MoeOrder<false> S{(const int*)(ws + WS_META), 4, F.G, F.bid, nullptr};
        pg8::EpiDown E{(bf16*)(ws + WS_YR), args.in[I_BDN], (const float*)(ws + WS_COLSC2)};
        pg8::gemm_phase<pg8::EpiDown, pg8::MoeOrder<false>, true, true>(F.lds, g, S, E);
    } } SEAM(9);

    if (IN(10)) { p10_combine(F, args); }
#undef IN
#undef SEAM
}

extern "C" void kernel_launch(void* const* d_in, const int* in_sizes, int n_in, void* d_out, int out_size, void* d_ws, size_t ws_size, hipStream_t stream) {
    static int grid = 0;
    if (grid == 0) {
        if (n_in != 25 || out_size != T * D || ws_size < WS_END) { fprintf(stderr, "kernel_launch: unexpected shapes (n_in %d out %d ws %zu)\n", n_in, out_size, ws_size); grid = -1; return; }
        int dev = 0, cus = 0, per_cu = 0;
        if (hipGetDevice(&dev) != hipSuccess || hipDeviceGetAttribute(&cus, hipDeviceAttributeMultiprocessorCount, dev) != hipSuccess) { grid = -1; return; }
        if (hipFuncSetAttribute((const void*)fwd, hipFuncAttributeMaxDynamicSharedMemorySize, LDS_BYTES) != hipSuccess) { fprintf(stderr, "kernel_launch: hipFuncSetAttribute failed\n"); grid = -1; return; }
        if (hipOccupancyMaxActiveBlocksPerMultiprocessor(&per_cu, (const void*)fwd, NWAVES * 64, LDS_BYTES) != hipSuccess || per_cu < 1) { fprintf(stderr, "kernel_launch: occupancy query says %d\n", per_cu); }
        (void)hipGetLastError();
        grid = cus;
    }
    if (grid < 0) return;
    (void)hipMemsetAsync((char*)d_ws + WS_CTL, 0, CTL_ZERO_BYTES, stream);
    Args a{};
    for (int i = 0; i < 25; ++i) a.in[i] = (const float*)d_in[i];
    a.out = (float*)d_out; a.ws = (unsigned char*)d_ws;
#if MK_N_LAUNCHES == 1
    a.ph_lo = 0; a.ph_hi = N_PHASES; a.ph_rep = 2;
    hipLaunchKernelGGL(fwd, dim3(grid), dim3(NWAVES * 64), LDS_BYTES, stream, a);
#else
    for (int p = 0; p < N_PHASES; ++p) { a.ph_lo = p; a.ph_hi = p + 1; hipLaunchKernelGGL(fwd, dim3(grid), dim3(NWAVES * 64), LDS_BYTES, stream, a); }
#endif
}
```

```cpp
#define NAIVE_RWKV 0
#define NAIVE_ATT 0
#define MK_N_LAUNCHES 1
#include <hip/hip_runtime.h>
#include <cstdio>
#include <cstdint>

#ifndef MK_N_LAUNCHES
#define MK_N_LAUNCHES 1
#endif
#ifndef NAIVE_RWKV
#define NAIVE_RWKV 0
#endif
#ifndef NAIVE_ATT
#define NAIVE_ATT 0
#endif

namespace pg8 {
#define PG8_LAS __attribute__((address_space(3)))
typedef unsigned short bf16_t;
typedef short bf16x8 __attribute__((ext_vector_type(8)));
typedef float f32x4 __attribute__((ext_vector_type(4)));
typedef unsigned u32x4 __attribute__((ext_vector_type(4)));
typedef unsigned u32x2 __attribute__((ext_vector_type(2)));
typedef float f32x2e __attribute__((ext_vector_type(2)));
typedef int i32x4 __attribute__((ext_vector_type(4)));
typedef int i32x8 __attribute__((ext_vector_type(8)));
template <bool F8> struct Frag { bf16x8 v[2]; __device__ __forceinline__ void set(bf16x8 a, bf16x8 b) { v[0] = a; v[1] = b; } };
template <> struct Frag<true> { i32x8 v; __device__ __forceinline__ void set(bf16x8 a, bf16x8 b) { v = __builtin_shufflevector(__builtin_bit_cast(i32x4, a), __builtin_bit_cast(i32x4, b), 0, 1, 2, 3, 4, 5, 6, 7); } };
__device__ __forceinline__ i32x8 cat8(bf16x8 a, bf16x8 b) { return __builtin_shufflevector(__builtin_bit_cast(i32x4, a), __builtin_bit_cast(i32x4, b), 0, 1, 2, 3, 4, 5, 6, 7); }
constexpr int BM = 256, BK = 64, HALF = 128, HTB = HALF * BK * 2  , STAGE_BYTES = 8 * HTB, NXCD = 8, WGM = 8, EPF_OFF = STAGE_BYTES  ;

__host__ __device__ __forceinline__ int lds_byte(int r, int c) { const int st = (r >> 4) * 2 + (c >> 5), rr = r & 15, cc = c & 31, ob = rr * 64 + cc * 2; return st * 1024 + (ob ^ (((ob >> 9) & 1) << 5)); }
__host__ __device__ __forceinline__ void stage_rc(int b, int& R, int& C) { const int st = b / 1024, sb = b % 1024, swz = sb ^ (((sb >> 9) & 1) << 5); R = (st >> 1) * 16 + swz / 64; C = (st & 1) * 32 + (swz % 64) / 2; }
__host__ __device__ __forceinline__ int perm32(int rho) { const int n = rho >> 4, i = rho & 15; return 8 * (i >> 2) + 4 * n + (i & 3); }

struct Unit { int pm, pn, e; };
struct Gemm { const bf16_t* A; const bf16_t* Bt; int M, N, K; };

__device__ __forceinline__ bool tile_of(int i, int G, int c, int nM, int nN, int& pm, int& pn) {
    const int nwg = nM * nN; const long L = (long)i * G + c; if (L >= nwg) return false;
    int wgid = (int)L; { const int q = nwg / NXCD, r = nwg % NXCD, xcd = wgid % NXCD, off = wgid / NXCD; wgid = (xcd < r ? xcd * (q + 1) : r * (q + 1) + (xcd - r) * q) + off; }
    const int nig = WGM * nN, gid = wgid / nig, fm = gid * WGM, gsz = (nM - fm) < WGM ? (nM - fm) : WGM;
    pm = fm + ((wgid % nig) % gsz); pn = (wgid % nig) / gsz; return true;
}
struct StaticOrder {
    int nM, nN, G, c;
    __device__ void init(int M, int N, int G_, int c_) { nM = M / BM; nN = N / BM; G = G_; c = c_; }
    __device__ __forceinline__ bool next(int i, Unit& u) const { u.e = 0; return tile_of(i, G, c, nM, nN, u.pm, u.pn); }
    __device__ __forceinline__ const char* a_base(const Gemm& g, const Unit& u) const { return (const char*)g.A + (size_t)u.pm * BM * g.K * 2; }
    __device__ __forceinline__ const char* b_base(const Gemm& g, const Unit& u) const { return (const char*)g.Bt + (size_t)u.pn * BM * g.K * 2; }
    __device__ __forceinline__ void a_off(const Gemm& g, const Unit&, const int (&R)[2], const int (&C)[2], unsigned (&vo)[2][2]) const {
#pragma unroll
        for (int h = 0; h < 2; ++h)
#pragma unroll
            for (int i = 0; i < 2; ++i) vo[h][i] = (unsigned)((h * HALF + R[i]) * g.K + C[i]) * 2u; }
    __device__ __forceinline__ void a_ready(const Unit&) const {}
    __device__ __forceinline__ void done(const Unit&) const {}
};
template <bool GATHER>
struct MoeOrder {
    const int* meta; int nN, G, c;
    __device__ __forceinline__ bool next(int i, Unit& u) const {
        const int nM = __builtin_amdgcn_readfirstlane(meta[0]);
        if (!tile_of(i, G, c, nM, nN, u.pm, u.pn)) return false;
        u.e = __builtin_amdgcn_readfirstlane(meta[16 + u.pm]); return true;
    }
    const int* rowtok;
    __device__ __forceinline__ const char* a_base(const Gemm& g, const Unit& u) const { return GATHER ? (const char*)g.A : (const char*)g.A + (size_t)u.pm * BM * g.K * 2; }
    __device__ __forceinline__ const char* b_base(const Gemm& g, const Unit& u) const { return (const char*)g.Bt + ((size_t)u.e * g.N + (size_t)u.pn * BM) * g.K * 2; }
    __device__ __forceinline__ void a_off(const Gemm& g, const Unit& u, const int (&R)[2], const int (&C)[2], unsigned (&vo)[2][2]) const {
#pragma unroll
        for (int h = 0; h < 2; ++h)
#pragma unroll
            for (int i = 0; i < 2; ++i) { const int r = h * HALF + R[i]; vo[h][i] = (unsigned)((GATHER ? rowtok[u.pm * BM + r] : r) * g.K + C[i]) * 2u; } }
    __device__ __forceinline__ void a_ready(const Unit&) const {}
    __device__ __forceinline__ void done(const Unit&) const {}
};

__device__ __forceinline__ unsigned cvt_pk_bf16(float lo, float hi) { unsigned r; asm volatile("v_cvt_pk_bf16_f32 %0, %1, %2" : "=v"(r) : "v"(lo), "v"(hi)); return r; }

__device__ __forceinline__ float acc_i2f(float bits) { return (float)__builtin_bit_cast(int, bits); }
__device__ __forceinline__ void epf_dma(const float* src_lane, PG8_LAS unsigned char* dst) { __builtin_amdgcn_global_load_lds((const unsigned*)src_lane, (PG8_LAS unsigned*)dst, 16, 0, 0); }
struct EpiBf16Q {
    static constexpr bool PERM = true, AFTER_DRAIN = false, I8 = true, F8 = false, EPF = true;
    bf16_t* O; int ldc; const float* rowsc; const float* colsc;
    __device__ __forceinline__ void prefetch(const Unit& u, PG8_LAS unsigned char* ev, int lane) const {
        epf_dma(colsc + u.pn * BM + 4 * lane, ev); epf_dma(rowsc + u.pm * BM + 4 * lane, ev + 1024); }
    __device__ __forceinline__ void operator()(const f32x4 (&acc)[2][2][4][2], const Unit& u, int wr, int wc, int fr, int fq, const PG8_LAS float* ev) const {
        const int row0 = u.pm * BM + wr * 64 + fr, col0 = u.pn * BM + wc * 32 + 8 * fq;
        f32x4 cv[2][2]; float rsv[2][4];
#pragma unroll
        for (int bj = 0; bj < 2; ++bj)
#pragma unroll
            for (int n = 0; n < 2; ++n) cv[bj][n] = *(const PG8_LAS f32x4*)(ev + wc * 32 + 8 * fq + bj * HALF + 4 * n);
#pragma unroll
        for (int ai = 0; ai < 2; ++ai)
#pragma unroll
            for (int m = 0; m < 4; ++m) rsv[ai][m] = ev[256 + wr * 64 + fr + ai * HALF + m * 16];
#pragma unroll
        for (int ai = 0; ai < 2; ++ai)
#pragma unroll
            for (int m = 0; m < 4; ++m) { bf16_t* rowp = O + (size_t)(row0 + ai * HALF + m * 16) * ldc + col0; const float rs = rsv[ai][m];
#pragma unroll
                for (int bj = 0; bj < 2; ++bj) { f32x4 v0, v1;
#pragma unroll
                    for (int j = 0; j < 4; ++j) { v0[j] = acc_i2f(acc[ai][bj][m][0][j]); v1[j] = acc_i2f(acc[ai][bj][m][1][j]); }
                    v0 = (v0 * rs) * cv[bj][0]; v1 = (v1 * rs) * cv[bj][1];
                    u32x4 w; w.x = cvt_pk_bf16(v0[0], v0[1]); w.y = cvt_pk_bf16(v0[2], v0[3]); w.z = cvt_pk_bf16(v1[0], v1[1]); w.w = cvt_pk_bf16(v1[2], v1[3]);
                    *(u32x4*)(rowp + bj * HALF) = w; } }
    }
};
struct EpiBf16 {
    static constexpr bool PERM = true, AFTER_DRAIN = false, I8 = false, F8 = false, EPF = false;
    bf16_t* O; int ldc;
    __device__ __forceinline__ void operator()(const f32x4 (&acc)[2][2][4][2], const Unit& u, int wr, int wc, int fr, int fq) const {
        const int row0 = u.pm * BM + wr * 64 + fr, col0 = u.pn * BM + wc * 32 + 8 * fq;
#pragma unroll
        for (int ai = 0; ai < 2; ++ai)
#pragma unroll
            for (int m = 0; m < 4; ++m) { bf16_t* rowp = O + (size_t)(row0 + ai * HALF + m * 16) * ldc + col0;
#pragma unroll
                for (int bj = 0; bj < 2; ++bj) { const f32x4 v0 = acc[ai][bj][m][0], v1 = acc[ai][bj][m][1];
                    u32x4 w; w.x = cvt_pk_bf16(v0[0], v0[1]); w.y = cvt_pk_bf16(v0[2], v0[3]); w.z = cvt_pk_bf16(v1[0], v1[1]); w.w = cvt_pk_bf16(v1[2], v1[3]);
                    *(u32x4*)(rowp + bj * HALF) = w; } }
    }
};
struct EpiResid {
    static constexpr bool PERM = false, AFTER_DRAIN = false, I8 = false, F8 = false, EPF = false;
    const float* base; float* out; bf16_t* xb; int ldc;
    __device__ __forceinline__ void operator()(const f32x4 (&acc)[2][2][4][2], const Unit& u, int wr, int wc, int fr, int fq) const {
        const int row0 = u.pm * BM + wr * 64 + fr, col0 = u.pn * BM + wc * 32 + 4 * fq;
        f32x4 nb[4][2][2];
#define PG8_RES_LOAD(g_) do { const size_t off_ = (size_t)(row0 + ((g_) >> 2) * HALF + ((g_) & 3) * 16) * ldc + col0; _Pragma("unroll") for (int bj = 0; bj < 2; ++bj) _Pragma("unroll") for (int n = 0; n < 2; ++n) \
            nb[(g_) & 3][bj][n] = __builtin_nontemporal_load((const f32x4*)(base + off_ + bj * HALF + n * 16)); } while (0)
        PG8_RES_LOAD(0); PG8_RES_LOAD(1); PG8_RES_LOAD(2);
#pragma unroll
        for (int g = 0; g < 8; ++g) { const int ai = g >> 2, m = g & 3; const size_t off = (size_t)(row0 + ai * HALF + m * 16) * ldc + col0;
            if (g + 3 < 8) PG8_RES_LOAD(g + 3);
#pragma unroll
            for (int bj = 0; bj < 2; ++bj)
#pragma unroll
                for (int n = 0; n < 2; ++n) { const f32x4 o = nb[g & 3][bj][n] + acc[ai][bj][m][n];
                    if (out) *(f32x4*)(out + off + bj * HALF + n * 16) = o;
                    u32x2 w; w.x = cvt_pk_bf16(o[0], o[1]); w.y = cvt_pk_bf16(o[2], o[3]); *(u32x2*)(xb + off + bj * HALF + n * 16) = w; }
            asm volatile("" ::: "memory"); }
#undef PG8_RES_LOAD
    }
};
struct EpiSwiGLU {
    static constexpr bool PERM = true, AFTER_DRAIN = false, I8 = true, F8 = false, EPF = true;
    bf16_t* O; const float* b_up; const float* rowrstd; const float* colsc;
    __device__ __forceinline__ void prefetch(const Unit& u, PG8_LAS unsigned char* ev, int lane) const {
        const int off = (size_t)u.e * 2048 + u.pn * HALF + (lane >> 5) * 1024 + 4 * (lane & 31);
        epf_dma(b_up + off, ev); epf_dma(colsc + off, ev + 1024); epf_dma(rowrstd + u.pm * BM + 4 * lane, ev + 2048); }
    __device__ __forceinline__ void operator()(const f32x4 (&acc)[2][2][4][2], const Unit& u, int wr, int wc, int fr, int fq, const PG8_LAS float* ev) const {
        const int row0 = u.pm * BM + wr * 64 + fr, f0 = u.pn * HALF + wc * 32 + 8 * fq;
        const PG8_LAS float* ep = ev + wc * 32 + 8 * fq;
        const f32x4 bg0 = *(const PG8_LAS f32x4*)ep, bg1 = *(const PG8_LAS f32x4*)(ep + 4), bl0 = *(const PG8_LAS f32x4*)(ep + 128), bl1 = *(const PG8_LAS f32x4*)(ep + 132);
        const f32x4 cg0 = *(const PG8_LAS f32x4*)(ep + 256), cg1 = *(const PG8_LAS f32x4*)(ep + 260), cl0 = *(const PG8_LAS f32x4*)(ep + 384), cl1 = *(const PG8_LAS f32x4*)(ep + 388);
        float rsv[2][4];
#pragma unroll
        for (int ai = 0; ai < 2; ++ai)
#pragma unroll
            for (int m = 0; m < 4; ++m) rsv[ai][m] = ev[512 + wr * 64 + fr + ai * HALF + m * 16];
#pragma unroll
        for (int ai = 0; ai < 2; ++ai)
#pragma unroll
            for (int m = 0; m < 4; ++m) { const int row = row0 + ai * HALF + m * 16; const float rs = rsv[ai][m];
                float a[8];
#pragma unroll
                for (int n = 0; n < 2; ++n)
#pragma unroll
                    for (int j = 0; j < 4; j += 2) {
                        const f32x2e ag2 = {acc_i2f(acc[ai][0][m][n][j]), acc_i2f(acc[ai][0][m][n][j + 1])}, al2 = {acc_i2f(acc[ai][1][m][n][j]), acc_i2f(acc[ai][1][m][n][j + 1])};
                        const f32x2e cg2 = n ? (f32x2e){cg1[j], cg1[j + 1]} : (f32x2e){cg0[j], cg0[j + 1]}, cl2 = n ? (f32x2e){cl1[j], cl1[j + 1]} : (f32x2e){cl0[j], cl0[j + 1]};
                        const f32x2e bg2 = n ? (f32x2e){bg1[j], bg1[j + 1]} : (f32x2e){bg0[j], bg0[j + 1]}, bl2 = n ? (f32x2e){bl1[j], bl1[j + 1]} : (f32x2e){bl0[j], bl0[j + 1]};
                        f32x2e hg = (ag2 * rs) * cg2 + bg2, hl = (al2 * rs) * cl2 + bl2;
                        hg.x = fminf(hg.x, 7.0f); hg.y = fminf(hg.y, 7.0f); hl.x = fminf(fmaxf(hl.x, -7.0f), 7.0f); hl.y = fminf(fmaxf(hl.y, -7.0f), 7.0f);
                        const f32x2e t = hg * (-1.702f * 1.4426950408889634f);
                        f32x2e e; e.x = __builtin_amdgcn_exp2f(t.x); e.y = __builtin_amdgcn_exp2f(t.y);
                        const f32x2e d = e + 1.0f; f32x2e sg; sg.x = __builtin_amdgcn_rcpf(d.x); sg.y = __builtin_amdgcn_rcpf(d.y);
                        const f32x2e o = (hg * sg) * (hl + 1.0f);
                        a[n * 4 + j] = o.x; a[n * 4 + j + 1] = o.y; }
                u32x2 w;
                w.x = (unsigned)__builtin_amdgcn_cvt_pk_fp8_f32(a[2], a[3], __builtin_amdgcn_cvt_pk_fp8_f32(a[0], a[1], 0, false), true);
                w.y = (unsigned)__builtin_amdgcn_cvt_pk_fp8_f32(a[6], a[7], __builtin_amdgcn_cvt_pk_fp8_f32(a[4], a[5], 0, false), true);
                *(u32x2*)((unsigned char*)O + (size_t)row * 1024 + f0) = w; }
    }
};
struct EpiDown {
    static constexpr bool PERM = true, AFTER_DRAIN = false, I8 = false, F8 = true, EPF = true;
    bf16_t* O; const float* b_dn; const float* colsc;
    __device__ __forceinline__ void prefetch(const Unit& u, PG8_LAS unsigned char* ev, int lane) const {
        const int off = (size_t)u.e * 1024 + u.pn * BM + 4 * lane;
        epf_dma(b_dn + off, ev); epf_dma(colsc + off, ev + 1024); }
    __device__ __forceinline__ void operator()(const f32x4 (&acc)[2][2][4][2], const Unit& u, int wr, int wc, int fr, int fq, const PG8_LAS float* ev) const {
        const int row0 = u.pm * BM + wr * 64 + fr, col0 = u.pn * BM + wc * 32 + 8 * fq;
        f32x4 bv[2][2], cv[2][2];
#pragma unroll
        for (int bj = 0; bj < 2; ++bj)
#pragma unroll
            for (int n = 0; n < 2; ++n) { bv[bj][n] = *(const PG8_LAS f32x4*)(ev + wc * 32 + 8 * fq + bj * HALF + 4 * n); cv[bj][n] = *(const PG8_LAS f32x4*)(ev + 256 + wc * 32 + 8 * fq + bj * HALF + 4 * n); }
#pragma unroll
        for (int ai = 0; ai < 2; ++ai)
#pragma unroll
            for (int m = 0; m < 4; ++m) { unsigned char* rowp = (unsigned char*)O + (size_t)(row0 + ai * HALF + m * 16) * 1024 + col0;
#pragma unroll
                for (int bj = 0; bj < 2; ++bj) { const f32x4 v0 = acc[ai][bj][m][0] * cv[bj][0] + bv[bj][0], v1 = acc[ai][bj][m][1] * cv[bj][1] + bv[bj][1];
                    u32x2 w; w.x = (unsigned)__builtin_amdgcn_cvt_pk_fp8_f32(v0[2], v0[3], __builtin_amdgcn_cvt_pk_fp8_f32(v0[0], v0[1], 0, false), true);
                    w.y = (unsigned)__builtin_amdgcn_cvt_pk_fp8_f32(v1[2], v1[3], __builtin_amdgcn_cvt_pk_fp8_f32(v1[0], v1[1], 0, false), true);
                    *(u32x2*)(rowp + bj * HALF) = w; } }
    }
};

template <class Epi, class Sched, bool ALIGN_EPI = false, bool SP2 = false>
__device__ __forceinline__ void gemm_phase(PG8_LAS unsigned char* lds, const Gemm g, const Sched& S, const Epi& E) {
    int tid = threadIdx.x; asm volatile("" : "+v"(tid));
    const int wid = __builtin_amdgcn_readfirstlane(tid >> 6), lane = tid & 63, wr = wid >> 2, wc = wid & 3, fr = lane & 15, fq = lane >> 4;
    const int K = g.K, nt = K / BK;
    unsigned voffB[2]; int sR[2], sC[2];
#pragma unroll
    for (int i = 0; i < 2; ++i) { int R, C; stage_rc(tid * 16 + i * 8192, R, C); const int Rb = Epi::PERM ? ((R & ~31) + perm32(R & 31)) : R;
        sR[i] = R; sC[i] = C; voffB[i] = (unsigned)(Rb * K + C) * 2u; }
    const size_t kstep = (size_t)(BK * 2);
    const size_t hstep = (size_t)HALF * K * 2;
    const unsigned ldsw = (unsigned)wid * 1024u;
    const int aoff = lds_byte(wr * 64 + fr, fq * 8), boff = lds_byte(wc * 32 + fr, fq * 8);
#define PG8_SA(b, h) (((b) * 2 + (h)) * HTB)
#define PG8_SB(b, h) ((4 + (b) * 2 + (h)) * HTB)
#define PG8_STAGE(bufoff, gbase, voff) do { _Pragma("unroll") for (int _i = 0; _i < 2; ++_i) \
        __builtin_amdgcn_global_load_lds((const unsigned*)((const char*)(gbase) + (voff)[_i]), (PG8_LAS unsigned*)(lds + (bufoff) + ldsw + _i * 8192), 16, 0, 0); } while (0)
#define PG8_STAGE_A(bufoff, gbase, vo, h) do { _Pragma("unroll") for (int _i = 0; _i < 2; ++_i) \
        __builtin_amdgcn_global_load_lds((const unsigned*)((const char*)(gbase) + (vo)[h][_i]), (PG8_LAS unsigned*)(lds + (bufoff) + ldsw + _i * 8192), 16, 0, 0); } while (0)
#define PG8_LDA(dst, b, h) do { _Pragma("unroll") for (int m = 0; m < 4; ++m) dst[m].set(*(const PG8_LAS bf16x8*)(lds + PG8_SA(b, h) + aoff + m * 2048), *(const PG8_LAS bf16x8*)(lds + PG8_SA(b, h) + aoff + m * 2048 + 1024)); } while (0)
#define PG8_LDB(dst, b, h) do { _Pragma("unroll") for (int n = 0; n < 2; ++n) dst[n].set(*(const PG8_LAS bf16x8*)(lds + PG8_SB(b, h) + boff + n * 2048), *(const PG8_LAS bf16x8*)(lds + PG8_SB(b, h) + boff + n * 2048 + 1024)); } while (0)
#define PG8_MMA(ai, bj, At, Bt) do { __builtin_amdgcn_s_setprio(1); _Pragma("unroll") for (int m = 0; m < 4; ++m) _Pragma("unroll") for (int n = 0; n < 2; ++n) { \
        if constexpr (Epi::F8) asm volatile("v_mfma_scale_f32_16x16x128_f8f6f4 %0, %1, %2, %0, %3, %3 op_sel_hi:[0,0,0]" : "+v"(acc[ai][bj][m][n]) : "v"(Bt[n].v), "v"(At[m].v), "v"(f8scale)); \
        else { _Pragma("unroll") for (int k = 0; k < 2; ++k) { \
            if constexpr (Epi::I8) acc[ai][bj][m][n] = __builtin_bit_cast(f32x4, __builtin_amdgcn_mfma_i32_16x16x64_i8(__builtin_bit_cast(i32x4, Bt[n].v[k]), __builtin_bit_cast(i32x4, At[m].v[k]), __builtin_bit_cast(i32x4, acc[ai][bj][m][n]), 0, 0, 0)); \
            else acc[ai][bj][m][n] = __builtin_amdgcn_mfma_f32_16x16x32_bf16(Bt[n].v[k], At[m].v[k], acc[ai][bj][m][n], 0, 0, 0); } } } __builtin_amdgcn_s_setprio(0); } while (0)
#define PG8_WAIT_V(n) asm volatile("s_waitcnt vmcnt(" #n ")" ::: "memory")
#define PG8_WAIT_L(n) asm volatile("s_waitcnt lgkmcnt(" #n ")" ::: "memory")
#define PG8_BAR __builtin_amdgcn_s_barrier()
#define PG8_SCHED __builtin_amdgcn_sched_barrier(0)
    Unit cur, nxt; int ui = 0;
#ifdef GEMM_TIME
    long long gacc_ = 0;
#endif
    if (!S.next(0, cur)) return;
    f32x4 acc[2][2][4][2];
#pragma unroll
    for (int a = 0; a < 2; ++a)
#pragma unroll
        for (int b = 0; b < 2; ++b)
#pragma unroll
            for (int m = 0; m < 4; ++m)
#pragma unroll
                for (int n = 0; n < 2; ++n) acc[a][b][m][n] = (f32x4){0.f, 0.f, 0.f, 0.f};
    Frag<Epi::F8> At[4], B0[2], B1[2];
    const int f8scale = 0x7f7f7f7f;
    (void)f8scale;
    const char* cA = S.a_base(g, cur); const char* cB = S.b_base(g, cur);
    unsigned voC[2][2], voN[2][2];
    S.a_off(g, cur, sR, sC, voC);
    S.a_ready(cur);
    static_assert(SP2, "only the two-MFMA-blocks-per-barrier-pair loop is kept");
    PG8_STAGE(PG8_SB(0, 0), cB, voffB); PG8_STAGE(PG8_SB(0, 1), cB + hstep, voffB); PG8_STAGE_A(PG8_SA(0, 0), cA, voC, 0); PG8_STAGE_A(PG8_SA(0, 1), cA, voC, 1);
    if (wr == 1) PG8_BAR;
    PG8_WAIT_V(2); PG8_BAR;
    PG8_STAGE(PG8_SB(1, 0), cB + kstep, voffB); PG8_STAGE_A(PG8_SA(1, 0), cA + kstep, voC, 0); PG8_STAGE(PG8_SB(1, 1), cB + hstep + kstep, voffB);
    PG8_WAIT_V(6); PG8_BAR;
    for (;;) {
        const bool has_next = S.next(ui + 1, nxt);
        const char* nA = has_next ? S.a_base(g, nxt) : cA; const char* nB = has_next ? S.b_base(g, nxt) : cB;
        if (has_next) S.a_off(g, nxt, sR, sC, voN); else {
#pragma unroll
            for (int h_ = 0; h_ < 2; ++h_) { voN[h_][0] = voC[h_][0]; voN[h_][1] = voC[h_][1]; } }
#pragma unroll 1
        for (int t = 0; t < nt; t += 2) {
            const bool last = (t == nt - 2);
            const char* a1 = cA + (size_t)(t + 1) * kstep;
            const char* a2 = last ? nA : cA + (size_t)(t + 2) * kstep; const char* b2 = last ? nB : cB + (size_t)(t + 2) * kstep;
            const char* a3 = a2 + kstep; const char* b3 = b2 + kstep;
            if (last && has_next) S.a_ready(nxt);
            if constexpr (Epi::EPF) { if (last && wid == 0) E.prefetch(cur, lds + EPF_OFF, lane); }
            unsigned vo2[2][2];
#pragma unroll
            for (int h_ = 0; h_ < 2; ++h_) { vo2[h_][0] = last ? voN[h_][0] : voC[h_][0]; vo2[h_][1] = last ? voN[h_][1] : voC[h_][1]; }
            PG8_LDB(B0, 0, 0); PG8_LDB(B1, 0, 1); PG8_SCHED; PG8_LDA(At, 0, 0); PG8_STAGE_A(PG8_SA(1, 1), a1, voC, 1);
            PG8_WAIT_V(8); PG8_WAIT_L(0); PG8_BAR; PG8_MMA(0, 0, At, B0); PG8_MMA(0, 1, At, B1); PG8_BAR; PG8_SCHED;
            PG8_LDA(At, 0, 1); PG8_STAGE(PG8_SB(0, 0), b2, voffB); PG8_STAGE(PG8_SB(0, 1), b2 + hstep, voffB); PG8_STAGE_A(PG8_SA(0, 0), a2, vo2, 0);
            PG8_WAIT_V(8); PG8_WAIT_L(0); PG8_BAR; PG8_MMA(1, 0, At, B0); PG8_MMA(1, 1, At, B1); PG8_BAR; PG8_SCHED;
            PG8_LDB(B0, 1, 0); PG8_LDB(B1, 1, 1); PG8_SCHED; PG8_LDA(At, 1, 0); PG8_STAGE_A(PG8_SA(0, 1), a2, vo2, 1);
            PG8_WAIT_V(8); PG8_WAIT_L(0); PG8_BAR; PG8_MMA(0, 0, At, B0); PG8_MMA(0, 1, At, B1); PG8_BAR; PG8_SCHED;
            PG8_LDA(At, 1, 1); PG8_STAGE(PG8_SB(1, 0), b3, voffB); PG8_STAGE(PG8_SB(1, 1), b3 + hstep, voffB); PG8_STAGE_A(PG8_SA(1, 0), a3, vo2, 0);
            PG8_WAIT_V(8); PG8_WAIT_L(0); PG8_BAR; PG8_MMA(1, 0, At, B0); PG8_MMA(1, 1, At, B1); PG8_BAR; PG8_SCHED;
        }
        if constexpr (ALIGN_EPI) { if (wr == 0) PG8_BAR; }
#ifdef GEMM_TIME
        const long long gt0_ = clock64();
#endif
        if constexpr (!Epi::AFTER_DRAIN) { if constexpr (Epi::EPF) E(acc, cur, wr, wc, fr, fq, (const PG8_LAS float*)(lds + EPF_OFF)); else E(acc, cur, wr, wc, fr, fq); S.done(cur); }
#ifdef GEMM_TIME
        gacc_ += clock64() - gt0_;
#endif
        if (!has_next) break;
#pragma unroll
        for (int a = 0; a < 2; ++a)
#pragma unroll
            for (int b = 0; b < 2; ++b)
#pragma unroll
                for (int m = 0; m < 4; ++m)
#pragma unroll
                    for (int n = 0; n < 2; ++n) acc[a][b][m][n] = (f32x4){0.f, 0.f, 0.f, 0.f};
        cur = nxt; cA = nA; cB = nB; ++ui;
#pragma unroll
        for (int h_ = 0; h_ < 2; ++h_) { voC[h_][0] = voN[h_][0]; voC[h_][1] = voN[h_][1]; }
        if constexpr (ALIGN_EPI) { if (wr == 1) PG8_BAR; }
    }
    PG8_WAIT_V(0);
    if constexpr (!ALIGN_EPI) { if (wr == 0) PG8_BAR; }
    PG8_BAR;
#ifdef GEMM_TIME
    { const long long s0_ = clock64(); while (clock64() - s0_ < gacc_) __builtin_amdgcn_s_sleep(8); }
#endif
    if constexpr (Epi::AFTER_DRAIN) { E.fused(acc, cur, wr, wc, fr, fq, lds, wid, lane); S.done(cur); }
#undef PG8_SA
#undef PG8_SB
#undef PG8_STAGE
#undef PG8_STAGE_A
#undef PG8_LDA
#undef PG8_LDB
#undef PG8_MMA
#undef PG8_WAIT_V
#undef PG8_WAIT_L
#undef PG8_BAR
#undef PG8_SCHED
}
}

constexpr int NWAVES = 8;
constexpr int T = 32768, D = 1024, SEQ = 8192, NBATCH = 4, NCHUNK = SEQ / 64;
constexpr int INC = 3328;
constexpr int PRW = 1536;
constexpr int NEXP = 32, TOPK = 4;
constexpr int NRB_MAX = T * TOPK / 256 + NEXP;
constexpr int NROWS_MAX = NRB_MAX * 256;
constexpr int NITEM = NBATCH * NCHUNK * 8;

constexpr size_t MiB = 1u << 20, KiB = 1u << 10;
constexpr size_t WS_CTL = 0, CTL_ZERO_BYTES = 1 * MiB;
constexpr size_t WS_META = 1 * MiB;
constexpr size_t WS_CNT = 1 * MiB + 64 * KiB;
constexpr size_t WS_EIDX = 2 * MiB, WS_GATE = 2 * MiB + 512 * KiB, WS_LRANK = 3 * MiB, WS_INV = 3 * MiB + 512 * KiB;
constexpr size_t WS_RSTD = 4 * MiB, WS_ROWRSTD = 4 * MiB + 256 * KiB;
constexpr size_t WS_WRT = 5 * MiB;
constexpr size_t WS_PAR = 5 * MiB + 128 * KiB;
constexpr size_t WS_WDEC = 5 * MiB + 256 * KiB, WS_WAAA = WS_WDEC + 64 * KiB, WS_WGATE = WS_WAAA + 64 * KiB;
constexpr size_t WS_WIN = 6 * MiB, WS_WOUT = 13 * MiB;
constexpr size_t WS_ROWTOK = 15 * MiB;
constexpr size_t WS_WUP = 16 * MiB, WS_WDN = 144 * MiB;
constexpr size_t WS_XN = 208 * MiB;
constexpr size_t WS_PROJ = 272 * MiB;
constexpr size_t WS_MIX = 480 * MiB;
constexpr size_t WS_RW = 544 * MiB;
constexpr size_t WS_XG = 272 * MiB, WS_ACT = 544 * MiB, WS_YR = WS_XG;
constexpr size_t WS_COLSC = 15 * MiB + 640 * KiB;
constexpr size_t WS_COLSC1 = 5 * MiB + 192 * KiB;
constexpr size_t WS_XNSC = WS_RSTD;
constexpr size_t WS_COLSC2 = 15 * MiB + 896 * KiB;
constexpr size_t WS_XQ = WS_MIX;
constexpr size_t WS_END = 1000 * MiB;
constexpr int CW_ATT = 8192;
constexpr int CW_BAR = 4096;

constexpr int RING_BYTES = 131072;
constexpr int LDS_BYTES = 163840;
constexpr int MISC_OFF = LDS_BYTES - 256;

#define GAS __attribute__((address_space(1)))
#define LAS __attribute__((address_space(3)))
#define DI __device__ __forceinline__
typedef unsigned short bf16;
typedef unsigned v4u __attribute__((ext_vector_type(4)));
typedef unsigned v2u __attribute__((ext_vector_type(2)));
typedef float f32x4 __attribute__((ext_vector_type(4)));
typedef float f32x2 __attribute__((ext_vector_type(2)));
typedef short bf16x8 __attribute__((ext_vector_type(8)));
typedef __bf16 bf16x2_t __attribute__((ext_vector_type(2)));
#define LDS_WAIT() asm volatile("s_waitcnt lgkmcnt(0)" ::: "memory")
#define VM_WAIT() asm volatile("s_waitcnt vmcnt(0)" ::: "memory")
DI unsigned pk2(float lo, float hi) { const f32x2 v = {lo, hi}; const bf16x2_t b = __builtin_convertvector(v, bf16x2_t); return __builtin_bit_cast(unsigned, b); }
DI float bf2f(unsigned short b) { return __uint_as_float((unsigned)b << 16); }
DI float bflo(unsigned w) { return __uint_as_float(w << 16); }
DI float bfhi(unsigned w) { return __uint_as_float(w & 0xffff0000u); }
DI float wave_sum(float v) {
#pragma unroll
    for (int o = 1; o < 64; o <<= 1) v += __shfl_xor(v, o);
    return v;
}
DI float wave_max(float v) {
#pragma unroll
    for (int o = 1; o < 64; o <<= 1) v = fmaxf(v, __shfl_xor(v, o));
    return v;
}
DI float sigmoidf_(float x) { return 1.0f / (1.0f + __expf(-x)); }

DI float quad_sum(float x) {
    const unsigned a = __builtin_bit_cast(unsigned, x); const auto r = __builtin_amdgcn_permlane32_swap(a, a, false, false);
    const float y = __builtin_bit_cast(float, (unsigned)r[0]) + __builtin_bit_cast(float, (unsigned)r[1]);
    const unsigned b = __builtin_bit_cast(unsigned, y); const auto s = __builtin_amdgcn_permlane16_swap(b, b, false, false);
    return __builtin_bit_cast(float, (unsigned)s[0]) + __builtin_bit_cast(float, (unsigned)s[1]);
}
DI float quad_max(float x) {
    const unsigned a = __builtin_bit_cast(unsigned, x); const auto r = __builtin_amdgcn_permlane32_swap(a, a, false, false);
    const float y = fmaxf(__builtin_bit_cast(float, (unsigned)r[0]), __builtin_bit_cast(float, (unsigned)r[1]));
    const unsigned b = __builtin_bit_cast(unsigned, y); const auto s = __builtin_amdgcn_permlane16_swap(b, b, false, false);
    return fmaxf(__builtin_bit_cast(float, (unsigned)s[0]), __builtin_bit_cast(float, (unsigned)s[1]));
}
#define XB_TMO      128
#define XB_XCNT(j)  (256  + 64 * (j))
#define XB_XSUB(j)  (1280 + 64 * (j))
#define XB_XGEN(j)  (2304 + 64 * (j))
#define XB_TOP      3328
#define XB_TOPGEN   3392
#define XCD_BAR_WORDS 3456
#define XB_SPIN_CAP (NAIVE_RWKV ? (1u << 25) : (1u << 20))

__device__ __forceinline__ unsigned xb_ld(unsigned* p)              { return __hip_atomic_load(p, __ATOMIC_RELAXED, __HIP_MEMORY_SCOPE_AGENT); }
__device__ __forceinline__ unsigned xb_add(unsigned* p, unsigned v) { return __hip_atomic_fetch_add(p, v, __ATOMIC_RELAXED, __HIP_MEMORY_SCOPE_AGENT); }
__device__ __forceinline__ unsigned xb_xcc_id() { return (unsigned)__builtin_amdgcn_s_getreg((3 << 11) | 20) & 0xFu; }
#define XB_SPIN(cond, bar) do { unsigned _sp = 0; while (cond) { __builtin_amdgcn_s_sleep(1); \
    if ((++_sp & 255u) == 0u) { if (xb_ld(&(bar)[XB_TMO])) break; if (_sp > XB_SPIN_CAP) { atomicAdd(&(bar)[XB_TMO], 1u); break; } } } } while (0)

struct XcdBarrier {
    unsigned* bar; unsigned x;
    volatile LAS unsigned* st;
};

__device__ __forceinline__ XcdBarrier xcd_barrier_post(unsigned* bar, volatile LAS unsigned* st) {
    XcdBarrier b; b.bar = bar; b.x = xb_xcc_id(); b.st = st;
    if (threadIdx.x == 0) (void)xb_add(&bar[XB_XCNT(b.x)], 1u);
    return b;
}
__device__ __forceinline__ void xcd_barrier_complete(unsigned* bar, unsigned x, unsigned& nloc, unsigned& nx) {
    const unsigned G = gridDim.x * gridDim.y * gridDim.z;
    unsigned sum, cnt, mine, sp = 0u;
    for (;;) {
        sum = 0u; cnt = 0u; mine = 0u;
#pragma unroll
        for (unsigned j = 0; j < 16; ++j) { const unsigned c = xb_ld(&bar[XB_XCNT(j)]); sum += c; cnt += (c > 0u) ? 1u : 0u; mine = (j == x) ? c : mine; }
        if (sum == G) break;
        __builtin_amdgcn_s_sleep(1);
        if ((++sp & 255u) == 0u) { if (xb_ld(&bar[XB_TMO])) break; if (sp > XB_SPIN_CAP) { atomicAdd(&bar[XB_TMO], 1u); break; } }
    }
    nloc = mine > 0u ? mine : 1u; nx = cnt > 0u ? cnt : 1u;
}

__device__ __forceinline__ void xcd_barrier(const XcdBarrier& b) {
    asm volatile("s_waitcnt vmcnt(0)" ::: "memory");
    __syncthreads();
    if (threadIdx.x == 0) {
        unsigned* bar = b.bar;
        __builtin_amdgcn_s_waitcnt(0);
        unsigned nloc = b.st[0], nx = b.st[1];
        if (nloc == 0u) { xcd_barrier_complete(bar, b.x, nloc, nx); b.st[0] = nloc; b.st[1] = nx; }
        const unsigned old = xb_add(&bar[XB_XSUB(b.x)], 1u);
        const unsigned gen = old / nloc;
        if (old + 1u == (gen + 1u) * nloc) {
            __builtin_amdgcn_fence(__ATOMIC_RELEASE, "agent");
            asm volatile("s_waitcnt vmcnt(0)" ::: "memory");
            const unsigned og = xb_add(&bar[XB_TOP], 1u);
            const unsigned tg = og / nx;
            if (og + 1u == (tg + 1u) * nx) xb_add(&bar[XB_TOPGEN], 1u);
            else XB_SPIN(xb_ld(&bar[XB_TOPGEN]) == tg, bar);
            __builtin_amdgcn_fence(__ATOMIC_ACQUIRE, "agent");
            xb_add(&bar[XB_XGEN(b.x)], 1u);
            asm volatile("s_waitcnt vmcnt(0)" ::: "memory");
        } else {
            XB_SPIN(xb_ld(&bar[XB_XGEN(b.x)]) == gen, bar);
            __builtin_amdgcn_fence(__ATOMIC_ACQUIRE, "agent");
            asm volatile("s_waitcnt vmcnt(0)" ::: "memory");
        }
    }
    __syncthreads();
}

struct Args {
    const float* in[25]; float* out; unsigned char* ws; int ph_lo, ph_hi, ph_rep, pad_;
};
enum { I_X = 0, I_N1G, I_WIN, I_MU, I_QG, I_KG, I_RELB, I_W0, I_WDEC, I_A0, I_WAAA, I_WGATE, I_KK, I_KA, I_RK, I_LNG, I_LNB, I_WOUT, I_N2G, I_WR, I_BR, I_WUP, I_BUP, I_WDN, I_BDN };
struct Frame {
    LAS unsigned char* lds;
    int tid, lane, wave, G, bid;
};


struct TrRegs { f32x4 v[8]; f32x4 s0, s1; bf16* dst; int ldo; };
DI void tr_load(TrRegs& t, const float* __restrict__ W, int ldw, int k0, int n0, bf16* WT, int ldo, long drow, int lane, const float* __restrict__ ksc8 = nullptr) {
    const int r8 = lane >> 3, c4 = lane & 7;
    t.s0 = (f32x4){1.f, 1.f, 1.f, 1.f}; t.s1 = t.s0; if (ksc8) { t.s0 = *(const f32x4*)ksc8; t.s1 = *(const f32x4*)(ksc8 + 4); }
    const float* src = W + (size_t)(k0 + 8 * r8) * ldw + n0 + 4 * c4;
#pragma unroll
    for (int i = 0; i < 8; ++i) t.v[i] = __builtin_nontemporal_load((const f32x4*)(src + (size_t)i * ldw));
    t.dst = WT + (size_t)(drow + 4 * c4) * ldo + k0 + 8 * r8; t.ldo = ldo;
}
DI void tr_store(const TrRegs& t, const float* __restrict__ = nullptr) {
    const f32x4 s0 = t.s0, s1 = t.s1;
#pragma unroll
    for (int j = 0; j < 4; ++j) { const v4u o = {pk2(t.v[0][j] * s0[0], t.v[1][j] * s0[1]), pk2(t.v[2][j] * s0[2], t.v[3][j] * s0[3]), pk2(t.v[4][j] * s1[0], t.v[5][j] * s1[1]), pk2(t.v[6][j] * s1[2], t.v[7][j] * s1[3])};
        __builtin_nontemporal_store(o, (v4u*)(t.dst + (size_t)j * t.ldo)); }
}
DI void tr_item(const float* __restrict__ W, int ldw, int k0, int n0, bf16* WT, int ldo, long drow, LAS float* scr, int lane, const float* __restrict__ ksc) {
    (void)scr; TrRegs t; tr_load(t, W, ldw, k0, n0, WT, ldo, drow, lane, ksc ? ksc + k0 + 8 * (lane >> 3) : nullptr); tr_store(t);
}
constexpr int MOE_TR_UP = NEXP * 16 * 64, MOE_TR_DN = NEXP * 16 * 32, MOE_TR_ALL = MOE_TR_UP + MOE_TR_DN;
DI const float* moe_tr_load(TrRegs& t, const Args& a, int r, int lane) {
    unsigned char* ws = a.ws;
    if (r < MOE_TR_UP) { const int e = r / 1024, kb = (r % 1024) / 64, nb = r % 64, n0 = 32 * nb; const int n1 = n0 & 1023;
        const long drow = (long)(n1 / 128) * 256 + (n0 >= 1024 ? 128 : 0) + (n1 % 128);
        tr_load(t, a.in[I_WUP] + (size_t)e * 1024 * 2048, 2048, 64 * kb, n0, (bf16*)(ws + WS_WUP) + (size_t)e * 2048 * 1024, 1024, drow, lane, a.in[I_N2G] + 64 * kb + 8 * (lane >> 3));
        return nullptr; }
    r -= MOE_TR_UP; const int e = r / 512, kb = (r % 512) / 32, nb = r % 32;
    tr_load(t, a.in[I_WDN] + (size_t)e * 1024 * 1024, 1024, 64 * kb, 32 * nb, (bf16*)(ws + WS_WDN) + (size_t)e * 1024 * 1024, 1024, 32 * nb, lane);
    return nullptr;
}
DI void moe_tr_item(const Args& a, int r, LAS float* scr, int lane) { (void)scr; TrRegs t; const float* s = moe_tr_load(t, a, r, lane); tr_store(t, s); }
DI unsigned q_pack4(float a, float b, float c, float d) {
    const unsigned ua = __builtin_bit_cast(unsigned, a), ub = __builtin_bit_cast(unsigned, b), uc = __builtin_bit_cast(unsigned, c), ud = __builtin_bit_cast(unsigned, d);
    return (ua & 0xffu) | ((ub & 0xffu) << 8) | ((uc & 0xffu) << 16) | (ud << 24); }
constexpr float Q_MAGIC = 12582912.0f;
template <bool DOWN>
DI void moe_q_batch(const Args& a, int batch, int wave, int lane, LAS float* exch) {
    unsigned char* ws = a.ws;
    constexpr int LDW = DOWN ? 1024 : 2048, SPE = LDW / 32;
    constexpr float QMAX = DOWN ? 256.0f : 127.0f;
    asm volatile("" : "+v"(lane));
    const int r8 = lane >> 3, c4 = lane & 7;
    const float* gk = a.in[I_N2G] + 128 * wave + 8 * r8;
    const f32x4 one = {1.f, 1.f, 1.f, 1.f};
    f32x4 s0[2], s1[2];
#pragma unroll
    for (int t = 0; t < 2; ++t) { s0[t] = DOWN ? one : *(const f32x4*)(gk + 64 * t); s1[t] = DOWN ? one : *(const f32x4*)(gk + 64 * t + 4); }
    f32x4 v[2][2][8]; const int loff = 8 * r8 * LDW + 4 * c4;
#define MQ_LOAD(buf, s_) do { const int strip_ = batch * 4 + (s_), e_ = strip_ / SPE, n0_ = 32 * (strip_ % SPE); \
        const float* W_ = a.in[DOWN ? I_WDN : I_WUP] + (size_t)e_ * 1024 * LDW + (size_t)(128 * wave) * LDW + n0_;     \
        _Pragma("unroll") for (int t = 0; t < 2; ++t) _Pragma("unroll") for (int i = 0; i < 8; ++i) v[buf][t][i] = __builtin_nontemporal_load((const f32x4*)(W_ + (size_t)(64 * t + i) * LDW + loff)); } while (0)
    MQ_LOAD(0, 0);
#pragma unroll
    for (int s = 0; s < 4; ++s) {
        if (s < 3) MQ_LOAD((s + 1) & 1, s + 1);
        const int strip = batch * 4 + s, e = strip / SPE, n0 = 32 * (strip % SPE), n1 = n0 & 1023;
        const long drow = DOWN ? (long)n0 : (long)(n1 / 128) * 256 + (n0 >= 1024 ? 128 : 0) + (n1 % 128);
        f32x4 mx = {0.f, 0.f, 0.f, 0.f};
#pragma unroll
        for (int t = 0; t < 2; ++t)
#pragma unroll
            for (int i = 0; i < 8; ++i) { const float sc = i < 4 ? s0[t][i] : s1[t][i - 4]; const f32x4 p = v[s & 1][t][i] * sc; v[s & 1][t][i] = p;
#pragma unroll
                for (int j = 0; j < 4; ++j) mx[j] = fmaxf(mx[j], fabsf(p[j])); }
#pragma unroll
        for (int j = 0; j < 4; ++j) { float m = mx[j]; m = fmaxf(m, __shfl_xor(m, 8)); m = fmaxf(m, __shfl_xor(m, 16)); m = fmaxf(m, __shfl_xor(m, 32)); mx[j] = m; }
        LAS float* ex = exch + (s & 1) * 256;
        if (r8 == 0) *(LAS f32x4*)(ex + (wave * 8 + c4) * 4) = mx;
        __syncthreads();
#pragma unroll
        for (int w2 = 0; w2 < 8; ++w2) { const f32x4 o = *(const LAS f32x4*)(ex + (w2 * 8 + c4) * 4);
#pragma unroll
            for (int j = 0; j < 4; ++j) mx[j] = fmaxf(mx[j], o[j]); }
        if (wave == 0 && r8 == 0) *(f32x4*)((float*)(ws + (DOWN ? WS_COLSC2 : WS_COLSC)) + (size_t)e * LDW + n0 + 4 * c4) = mx * (1.0f / QMAX);
        f32x4 inv;
#pragma unroll
        for (int j = 0; j < 4; ++j) inv[j] = mx[j] > 0.f ? QMAX / mx[j] : 0.f;
        unsigned char* dst = ws + (DOWN ? WS_WDN : WS_WUP) + ((size_t)e * LDW + drow + 4 * c4) * 1024 + 128 * wave + 8 * r8;
#pragma unroll
        for (int t = 0; t < 2; ++t) {
            f32x4 (&p)[8] = v[s & 1][t];
#pragma unroll
            for (int i = 0; i < 8; ++i) p[i] = DOWN ? p[i] * inv : p[i] * inv + Q_MAGIC;
#pragma unroll
            for (int j = 0; j < 4; ++j) { v2u o;
                if (DOWN) { o.x = (unsigned)__builtin_amdgcn_cvt_pk_fp8_f32(p[2][j], p[3][j], __builtin_amdgcn_cvt_pk_fp8_f32(p[0][j], p[1][j], 0, false), true);
                            o.y = (unsigned)__builtin_amdgcn_cvt_pk_fp8_f32(p[6][j], p[7][j], __builtin_amdgcn_cvt_pk_fp8_f32(p[4][j], p[5][j], 0, false), true); }
                else { o.x = q_pack4(p[0][j], p[1][j], p[2][j], p[3][j]); o.y = q_pack4(p[4][j], p[5][j], p[6][j], p[7][j]); }
                __builtin_nontemporal_store(o, (v2u*)(dst + (size_t)j * 1024 + 64 * t)); } }
    }
#undef MQ_LOAD
}
DI void q_strip_i8_wg(const float* __restrict__ Wsrc, int ldw, int n0, unsigned char* WT, float* colsc, int wave, int lane, LAS float* exch) {
    const int r8 = lane >> 3, c4 = lane & 7;
    const float* W = Wsrc + (size_t)(128 * wave + 8 * r8) * ldw + n0 + 4 * c4;
    f32x4 v[2][8], mx = {0.f, 0.f, 0.f, 0.f};
#pragma unroll
    for (int t = 0; t < 2; ++t)
#pragma unroll
        for (int i = 0; i < 8; ++i) v[t][i] = *(const f32x4*)(W + (size_t)(64 * t + i) * ldw);
#pragma unroll
    for (int t = 0; t < 2; ++t)
#pragma unroll
        for (int i = 0; i < 8; ++i)
#pragma unroll
            for (int j = 0; j < 4; ++j) mx[j] = fmaxf(mx[j], fabsf(v[t][i][j]));
#pragma unroll
    for (int j = 0; j < 4; ++j) { float m = mx[j]; m = fmaxf(m, __shfl_xor(m, 8)); m = fmaxf(m, __shfl_xor(m, 16)); m = fmaxf(m, __shfl_xor(m, 32)); mx[j] = m; }
    if (r8 == 0) *(LAS f32x4*)(exch + (wave * 8 + c4) * 4) = mx;
    __syncthreads();
#pragma unroll
    for (int w2 = 0; w2 < 8; ++w2) { const f32x4 o = *(const LAS f32x4*)(exch + (w2 * 8 + c4) * 4);
#pragma unroll
        for (int j = 0; j < 4; ++j) mx[j] = fmaxf(mx[j], o[j]); }
    if (wave == 0 && r8 == 0) *(f32x4*)(colsc + n0 + 4 * c4) = mx * (1.0f / 127.0f);
    f32x4 inv;
#pragma unroll
    for (int j = 0; j < 4; ++j) inv[j] = mx[j] > 0.f ? 127.0f / mx[j] : 0.f;
    unsigned char* dst = WT + (size_t)(n0 + 4 * c4) * 1024 + 128 * wave + 8 * r8;
#pragma unroll
    for (int t = 0; t < 2; ++t) {
        f32x4 p[8];
#pragma unroll
        for (int i = 0; i < 8; ++i) p[i] = v[t][i] * inv + Q_MAGIC;
#pragma unroll
        for (int j = 0; j < 4; ++j) { const v2u o = {q_pack4(p[0][j], p[1][j], p[2][j], p[3][j]), q_pack4(p[4][j], p[5][j], p[6][j], p[7][j])};
            *(v2u*)(dst + (size_t)j * 1024 + 64 * t) = o; } }
}
DI void moe_tr_batch(const Args& a, int batch, int wave, int lane, LAS float* exch) {
    if (batch < MOE_TR_UP / 64) moe_q_batch<false>(a, batch, wave, lane, exch); else moe_q_batch<true>(a, batch - MOE_TR_UP / 64, wave, lane, exch);
}
constexpr int MOE_TR_BATCHES = MOE_TR_ALL / 64, MOE_TR_EARLY = 256;

#if !NAIVE_ATT
constexpr int ATT_KS = 144;
constexpr int ATT_TILE = 64 * ATT_KS;
constexpr int ATT_BIAS_OFF = 4 * ATT_TILE;
constexpr int ATT_NSLOT = (NBATCH * 8 * (NCHUNK / 2) / 8) * 11;
static_assert(NBATCH * 8 * (NCHUNK / 2) == 2048 && MOE_TR_ALL == 256 * 3 * 64, "attention / conversion work queue");
DI int att_pos(int key) { return (key & 32) + 8 * ((key >> 2) & 3) + 4 * ((key >> 4) & 1) + (key & 3); }
DI void attn_phase(const Frame& F, const Args& a, const int qid = 0) {
    const bf16* proj = (const bf16*)(a.ws + WS_PROJ); bf16* mix = (bf16*)(a.ws + WS_MIX);
    LAS unsigned char* lds = F.lds; LAS float* sbias = (LAS float*)(lds + ATT_BIAS_OFF);
    const int w = F.wave;
    const float LOG2E = 1.4426950408889634f;
    const int srow = F.tid >> 3, spc = F.tid & 7;
    float kgv[8];
#pragma unroll
    for (int j = 0; j < 8; ++j) kgv[j] = a.in[I_KG][8 * spc + j];
    const int spos = att_pos(srow);
    LAS int* s_item = (LAS int*)(lds + ATT_BIAS_OFF + 1024);
    unsigned* qhead = (unsigned*)(a.ws + WS_CTL) + CW_ATT + 64 * qid;
    for (;;) {
        __syncthreads();
        if (F.tid == 0) *s_item = (int)__hip_atomic_fetch_add(qhead, 1u, __ATOMIC_RELAXED, __HIP_MEMORY_SCOPE_AGENT);
        __syncthreads();
        const int slot = *s_item;
        if (slot >= ATT_NSLOT) break;
        const int grp = slot / 11, sub = slot % 11;
        if (sub >= 8) { const int base = (grp * 3 + (sub - 8)) * 64 + w * 8;
            (void)base; moe_tr_batch(a, grp * 3 + (sub - 8), w, F.lane, (LAS float*)(lds + ATT_BIAS_OFF + 2048));
            continue; }
        int l = F.lane; asm volatile("" : "+v"(l));
        const int n16 = l & 15, q = l >> 4;
        const int item = grp * 8 + sub;
        const int b = item / (8 * (NCHUNK / 2)), h = (item / (NCHUNK / 2)) & 7, n0 = 2 * (item % (NCHUNK / 2));
        if (F.tid < 192) sbias[F.tid] = a.in[I_RELB][h * 192 + F.tid] * LOG2E;
        const int nq = n0 + (w >> 2), qpos = 16 * (w & 3) + n16;
        const size_t qtok = (size_t)b * SEQ + nq * 64 + qpos;
        bf16x8 qf[2];
        { const v4u q0 = *(const v4u*)(proj + qtok * INC + h * 64 + 8 * q), q1 = *(const v4u*)(proj + qtok * INC + h * 64 + 32 + 8 * q);
          float f[16]; const unsigned ww[8] = {q0.x, q0.y, q0.z, q0.w, q1.x, q1.y, q1.z, q1.w};
          float ss = 0.f;
#pragma unroll
          for (int e = 0; e < 8; ++e) { f[2 * e] = bflo(ww[e]); f[2 * e + 1] = bfhi(ww[e]); ss += f[2 * e] * f[2 * e] + f[2 * e + 1] * f[2 * e + 1]; }
          ss = quad_sum(ss);
          const float rs = (1.0f / sqrtf(ss * (1.f / 64.f) + 1e-6f)) * 0.125f * LOG2E;
          unsigned pk[8];
#pragma unroll
          for (int e = 0; e < 8; ++e) { const int d = (e < 4 ? 0 : 32) + 8 * q + 2 * (e & 3); pk[e] = pk2(f[2 * e] * rs * a.in[I_QG][d], f[2 * e + 1] * rs * a.in[I_QG][d + 1]); }
          const v4u p0 = {pk[0], pk[1], pk[2], pk[3]}, p1 = {pk[4], pk[5], pk[6], pk[7]};
          qf[0] = __builtin_bit_cast(bf16x8, p0); qf[1] = __builtin_bit_cast(bf16x8, p1); }
        f32x4 o[4];
#pragma unroll
        for (int dt = 0; dt < 4; ++dt) o[dt] = (f32x4){0.f, 0.f, 0.f, 0.f};
        float m_run = -3.0e38f, l_run = 0.f;
        v4u kreg, vreg;
        auto gload = [&](int jc) { const int kc = n0 - 8 + jc; if (kc >= 0) { const size_t tok = (size_t)b * SEQ + kc * 64 + srow;
            kreg = *(const v4u*)(proj + tok * INC + 512 + h * 64 + 8 * spc); vreg = *(const v4u*)(proj + tok * INC + 1024 + h * 64 + 8 * spc); } };
        auto lstore = [&](int jc) { const int kc = n0 - 8 + jc; if (kc >= 0) { LAS unsigned char* kb = lds + (jc & 1) * 2 * ATT_TILE; LAS unsigned char* vb = kb + ATT_TILE;
            const unsigned ww[4] = {kreg.x, kreg.y, kreg.z, kreg.w}; float f[8]; float ss = 0.f;
#pragma unroll
            for (int e = 0; e < 4; ++e) { f[2 * e] = bflo(ww[e]); f[2 * e + 1] = bfhi(ww[e]); ss += f[2 * e] * f[2 * e] + f[2 * e + 1] * f[2 * e + 1]; }
            ss += __builtin_bit_cast(float, __builtin_amdgcn_update_dpp(0, __builtin_bit_cast(int, ss), 0xB1, 0xf, 0xf, true));
            ss += __builtin_bit_cast(float, __builtin_amdgcn_update_dpp(0, __builtin_bit_cast(int, ss), 0x4E, 0xf, 0xf, true));
            ss += __builtin_bit_cast(float, __builtin_amdgcn_update_dpp(0, __builtin_bit_cast(int, ss), 0x141, 0xf, 0xf, true));
            const float rs = 1.0f / sqrtf(ss * (1.f / 64.f) + 1e-6f);
            v4u kk; kk.x = pk2(f[0] * rs * kgv[0], f[1] * rs * kgv[1]); kk.y = pk2(f[2] * rs * kgv[2], f[3] * rs * kgv[3]); kk.z = pk2(f[4] * rs * kgv[4], f[5] * rs * kgv[5]); kk.w = pk2(f[6] * rs * kgv[6], f[7] * rs * kgv[7]);
            *(LAS v4u*)(kb + srow * ATT_KS + 16 * spc) = kk;
            const unsigned vv[4] = {vreg.x, vreg.y, vreg.z, vreg.w};
#pragma unroll
            for (int e = 0; e < 4; ++e) { *(LAS unsigned short*)(vb + (8 * spc + 2 * e) * ATT_KS + 2 * spos) = (unsigned short)(vv[e] & 0xffffu);
                                          *(LAS unsigned short*)(vb + (8 * spc + 2 * e + 1) * ATT_KS + 2 * spos) = (unsigned short)(vv[e] >> 16); } } };
        gload(0); lstore(0);
        __syncthreads();
        for (int jc = 0; jc < 10; ++jc) {
            if (jc + 1 < 10) gload(jc + 1);
            const int kc = n0 - 8 + jc, dj = jc - (w >> 2);
            if (kc >= 0 && dj >= 0 && dj <= 8) {
                const LAS unsigned char* kb = lds + (jc & 1) * 2 * ATT_TILE; const LAS unsigned char* vb = kb + ATT_TILE;
                f32x4 sc[4];
#pragma unroll
                for (int mt = 0; mt < 4; ++mt) { sc[mt] = (f32x4){0.f, 0.f, 0.f, 0.f};
#pragma unroll
                    for (int ks = 0; ks < 2; ++ks) { const bf16x8 kf = *(const LAS bf16x8*)(kb + (16 * mt + n16) * ATT_KS + 64 * ks + 16 * q);
                        sc[mt] = __builtin_amdgcn_mfma_f32_16x16x32_bf16(kf, qf[ks], sc[mt], 0, 0, 0); } }
                float boff = 0.f;
                if (dj <= 5) boff = sbias[0];
                else { const int base = (dj - 8) * 64 - qpos + 128;
#pragma unroll
                    for (int mt = 0; mt < 4; ++mt)
#pragma unroll
                        for (int i = 0; i < 4; ++i) { int idx = base + 16 * mt + 4 * q + i; idx = idx < 0 ? 0 : idx; const float bv_ = sbias[idx];
                            sc[mt][i] += bv_; } }
                float mx = sc[0][0];
#pragma unroll
                for (int mt = 0; mt < 4; ++mt)
#pragma unroll
                    for (int i = 0; i < 4; ++i) mx = fmaxf(mx, sc[mt][i]);
                mx = quad_max(mx);
                const float m_new = fmaxf(m_run, mx + boff), alpha = __builtin_amdgcn_exp2f(m_run - m_new), msub = m_new - boff;
                const bool moved = __builtin_amdgcn_ballot_w64(m_new != m_run) != 0ull;
                m_run = m_new; float ls = 0.f;
#pragma unroll
                for (int mt = 0; mt < 4; ++mt)
#pragma unroll
                    for (int i = 0; i < 4; ++i) { sc[mt][i] = __builtin_amdgcn_exp2f(sc[mt][i] - msub); ls += sc[mt][i]; }
                if (moved) { l_run *= alpha;
#pragma unroll
                    for (int dt = 0; dt < 4; ++dt) o[dt] = o[dt] * alpha; }
                l_run += ls;
#pragma unroll
                for (int s = 0; s < 2; ++s) {
                    const v4u pp = {pk2(sc[2 * s][0], sc[2 * s][1]), pk2(sc[2 * s][2], sc[2 * s][3]), pk2(sc[2 * s + 1][0], sc[2 * s + 1][1]), pk2(sc[2 * s + 1][2], sc[2 * s + 1][3])};
                    const bf16x8 pf = __builtin_bit_cast(bf16x8, pp);
#pragma unroll
                    for (int dt = 0; dt < 4; ++dt) { const bf16x8 vf = *(const LAS bf16x8*)(vb + (16 * dt + n16) * ATT_KS + 64 * s + 16 * q);
                        o[dt] = __builtin_amdgcn_mfma_f32_16x16x32_bf16(vf, pf, o[dt], 0, 0, 0); } }
            }
            if (jc + 1 < 10) lstore(jc + 1);
            __syncthreads();
        }
        l_run = quad_sum(l_run);
        const float inv = 1.0f / l_run;
#pragma unroll
        for (int dt = 0; dt < 4; ++dt) { v2u ov; ov.x = pk2(o[dt][0] * inv, o[dt][1] * inv); ov.y = pk2(o[dt][2] * inv, o[dt][3] * inv);
            *(v2u*)(mix + qtok * 1024 + h * 64 + 16 * dt + 4 * q) = ov; }
    }
}
#endif

#if !NAIVE_RWKV
constexpr int RA_HALF = 80896;
constexpr int RA_RT = 0, RA_KT = 9216, RA_BT = 18432, RA_AT = 27648;
constexpr int RA_VT = 36864, RA_KH = 46080, RA_BH = 55296;
constexpr int RA_AAB = 64512;
constexpr int RA_XWD = 0, RA_XAD = 9216, RA_XGD = 18432;
constexpr int RA_RHS2 = 0, RA_GEND = 17408;
constexpr int RA_W1T = 18432, RA_W2T = 27648;
constexpr int RA_WT = RA_AAB;
constexpr int RB_REC = 65536, RB_YLT = 0, RB_PCT = 8192, RB_G1T = 16384, RB_E2T = 24576, RB_MC = 32768, RB_CC = 40960, RB_SC = 57344;
static_assert(2 * RA_HALF <= MISC_OFF, "rwkv phase A LDS");

DI void ld8f(const bf16* p, float (&f)[8]) { const v4u w = *(const v4u*)p; f[0] = bflo(w.x); f[1] = bfhi(w.x); f[2] = bflo(w.y); f[3] = bfhi(w.y); f[4] = bflo(w.z); f[5] = bfhi(w.z); f[6] = bflo(w.w); f[7] = bfhi(w.w); }
DI void ld4f(const bf16* p, float (&f)[4]) { const v2u w = *(const v2u*)p; f[0] = bflo(w.x); f[1] = bfhi(w.x); f[2] = bflo(w.y); f[3] = bfhi(w.y); }
DI bf16x8 pack8(const f32x4& a, const f32x4& b) { const v4u p = {pk2(a[0], a[1]), pk2(a[2], a[3]), pk2(b[0], b[1]), pk2(b[2], b[3])}; return __builtin_bit_cast(bf16x8, p); }
DI float fast_sigmoid(float x) { return __builtin_amdgcn_rcpf(1.0f + __builtin_amdgcn_exp2f(-1.4426950408889634f * x)); }
DI float fast_tanh(float x) { return 1.0f - 2.0f * __builtin_amdgcn_rcpf(1.0f + __builtin_amdgcn_exp2f(2.8853900817779268f * x)); }
#define MFMA16(a, b, c) __builtin_amdgcn_mfma_f32_16x16x32_bf16((a), (b), (c), 0, 0, 0)

DI void rwkv_phase_a(const Frame& F, const Args& a) {
    unsigned char* ws = a.ws; unsigned char* rb = ws + WS_RW;
    const bf16* wdec = (const bf16*)(ws + WS_WDEC); const bf16* waaa = (const bf16*)(ws + WS_WAAA); const bf16* wgate = (const bf16*)(ws + WS_WGATE);
    const float* mu = a.in[I_MU]; const float* par = (const float*)(ws + WS_PAR);
    const int hb = F.wave >> 2, w4 = F.wave & 3;
    LAS unsigned char* hbase = F.lds + hb * RA_HALF;
    const float LOG2E = 1.4426950408889634f;
    v4u s0c[4];
#define RA_REQUEST(pair_) do { const int item_ = 2 * (pair_) + hb, c_ = (item_ >> 3) & 127, b_ = item_ >> 10; const size_t tok0_ = (size_t)b_ * SEQ + c_ * 64; \
        int lq_ = F.lane; asm volatile("" : "+v"(lq_)); size_t wsq_ = (size_t)ws; asm volatile("" : "+s"(wsq_)); const int t9q_ = (hb << 8) | (w4 << 6) | lq_; \
        const bf16* cur_ = (const bf16*)(wsq_ + WS_PROJ) + (tok0_ + (t9q_ >> 3)) * INC + PRW + 1536 + 32 * (t9q_ & 7); \
        _Pragma("unroll") for (int g8 = 0; g8 < 4; ++g8) s0c[g8] = *(const v4u*)(cur_ + 8 * g8); } while (0)
    if (F.bid < NITEM / 2) RA_REQUEST(F.bid);
    for (int pair = F.bid; pair < NITEM / 2; pair += F.G) {
        size_t wsb = (size_t)ws; asm volatile("" : "+s"(wsb)); const bf16* proj = (const bf16*)(wsb + WS_PROJ);
        int l = F.lane; asm volatile("" : "+v"(l));
        const int n16 = l & 15, q = l >> 4, t4 = (hb << 8 | (F.wave & 3) << 6 | l) & 255;
        const int tokl = 16 * w4 + n16;
        const int tslot = (tokl & 32) + 8 * ((tokl >> 2) & 3) + 4 * ((tokl >> 4) & 1) + (tokl & 3);
        const int item = 2 * pair + hb, h = item & 7, c = (item >> 3) & 127, b = item >> 10;
        const size_t tok0 = (size_t)b * SEQ + c * 64; unsigned char* rbi = rb + (size_t)item * RB_REC;
        const int t9 = (hb << 8) | t4, tk0 = t9 >> 3, part = t9 & 7;
        v4u s0p[4];
        { const bool first = (c == 0 && tk0 == 0); const bf16* prv = proj + (tok0 + tk0) * INC + PRW + 1536 + 32 * part - INC;
#pragma unroll
          for (int g8 = 0; g8 < 4; ++g8) { s0p[g8] = (v4u){0u, 0u, 0u, 0u}; if (!first) s0p[g8] = *(const v4u*)(prv + 8 * g8); } }
        v2u rawc[3][4], rawp[3][4];
        { const bool first = (c == 0 && tokl == 0); const bf16* cur = proj + (tok0 + tokl) * INC + PRW + h * 64 + 4 * q; const bf16* prv = cur - INC;
#pragma unroll
          for (int m = 0; m < 3; ++m)
#pragma unroll
              for (int ct = 0; ct < 4; ++ct) { rawc[m][ct] = *(const v2u*)(cur + 512 * m + 16 * ct); rawp[m][ct] = (v2u){0u, 0u}; if (!first) rawp[m][ct] = *(const v2u*)(prv + 512 * m + 16 * ct); } }
        bf16x8 wfr[2][8];
#define RA_WLOAD(dst, ctv) do { const int row_ = h * 64 + 16 * (ctv) + n16; \
            dst[0] = *(const bf16x8*)(wdec + row_ * 64 + 8 * q); dst[1] = *(const bf16x8*)(wdec + row_ * 64 + 32 + 8 * q); \
            dst[2] = *(const bf16x8*)(waaa + row_ * 64 + 8 * q); dst[3] = *(const bf16x8*)(waaa + row_ * 64 + 32 + 8 * q); \
            _Pragma("unroll") for (int ks_ = 0; ks_ < 4; ++ks_) dst[4 + ks_] = *(const bf16x8*)(wgate + row_ * 128 + 32 * ks_ + 8 * q); } while (0)
        RA_WLOAD(wfr[0], 0); RA_WLOAD(wfr[1], 1);
        __syncthreads();
        { const float esc = part < 2 ? 2.8853900817779268f : -1.4426950408889634f;
          LAS unsigned char* dst = F.lds + (part < 2 ? RA_XWD + tk0 * 144 + part * 64 : (part < 4 ? RA_XAD + tk0 * 144 + (part - 2) * 64 : RA_XGD + tk0 * 272 + (part - 4) * 64));
#pragma unroll
          for (int g8 = 0; g8 < 4; ++g8) {
              const unsigned xw[4] = {s0c[g8].x, s0c[g8].y, s0c[g8].z, s0c[g8].w}, pw[4] = {s0p[g8].x, s0p[g8].y, s0p[g8].z, s0p[g8].w};
              const f32x4 m0 = *(const f32x4*)(mu + 1536 + 32 * part + 8 * g8), m1 = *(const f32x4*)(mu + 1536 + 32 * part + 8 * g8 + 4);
              float y[8];
#pragma unroll
              for (int j = 0; j < 8; ++j) { const float x = (j & 1) ? bfhi(xw[j >> 1]) : bflo(xw[j >> 1]), p = (j & 1) ? bfhi(pw[j >> 1]) : bflo(pw[j >> 1]);
                  const float xs = x + (p - x) * (j < 4 ? m0[j & 3] : m1[j & 3]);
                  const float rc = __builtin_amdgcn_rcpf(1.0f + __builtin_amdgcn_exp2f(esc * xs));
                  y[j] = part < 2 ? 1.0f - 2.0f * rc : (part < 4 ? xs : rc); }
              const v4u o = {pk2(y[0], y[1]), pk2(y[2], y[3]), pk2(y[4], y[5]), pk2(y[6], y[7])};
              *(LAS v4u*)(dst + 16 * g8) = o; } }
        v2u shv[3][4];
#pragma unroll
        for (int m = 0; m < 3; ++m)
#pragma unroll
            for (int ct = 0; ct < 4; ++ct) { const v2u xw = rawc[m][ct], pw = rawp[m][ct];
                const f32x4 mm = *(const f32x4*)(mu + 512 * m + h * 64 + 16 * ct + 4 * q);
                const float x0 = bflo(xw.x), x1 = bfhi(xw.x), x2 = bflo(xw.y), x3 = bfhi(xw.y);
                shv[m][ct].x = pk2(x0 + (bflo(pw.x) - x0) * mm[0], x1 + (bfhi(pw.x) - x1) * mm[1]); shv[m][ct].y = pk2(x2 + (bflo(pw.y) - x2) * mm[2], x3 + (bfhi(pw.y) - x3) * mm[3]); }
        __syncthreads();
        f32x4 awl[4], aal[4], ag[4];
        { bf16x8 bwd[2], bad[2], bgd[4], wf2[2][8];
          RA_WLOAD(wf2[0], 2); RA_WLOAD(wf2[1], 3);
#pragma unroll
          for (int ks = 0; ks < 2; ++ks) { bwd[ks] = *(const LAS bf16x8*)(F.lds + RA_XWD + tokl * 144 + 64 * ks + 16 * q); bad[ks] = *(const LAS bf16x8*)(F.lds + RA_XAD + tokl * 144 + 64 * ks + 16 * q); }
#pragma unroll
          for (int ks = 0; ks < 4; ++ks) bgd[ks] = *(const LAS bf16x8*)(F.lds + RA_XGD + tokl * 272 + 64 * ks + 16 * q);
#pragma unroll
          for (int ct = 0; ct < 4; ++ct) { const bf16x8* wv = ct < 2 ? wfr[ct] : wf2[ct - 2];
              awl[ct] = (f32x4){0.f, 0.f, 0.f, 0.f}; aal[ct] = awl[ct]; ag[ct] = awl[ct];
#pragma unroll
              for (int ks = 0; ks < 2; ++ks) { awl[ct] = MFMA16(wv[ks], bwd[ks], awl[ct]); aal[ct] = MFMA16(wv[2 + ks], bad[ks], aal[ct]); }
#pragma unroll
              for (int ks = 0; ks < 4; ++ks) ag[ct] = MFMA16(wv[4 + ks], bgd[ks], ag[ct]); } }
#undef RA_WLOAD
        v2u rtp[4];
        {
#define RA_SHIFT(dst, pcol, ctv) do { const v2u w_ = shv[(pcol) / 512][ctv]; dst[0] = bflo(w_.x); dst[1] = bfhi(w_.x); dst[2] = bflo(w_.y); dst[3] = bfhi(w_.y); } while (0)
          float nrm = 0.f, bd = 0.f;
#pragma unroll
          for (int ct = 0; ct < 4; ++ct) { const int ch = h * 64 + 16 * ct + 4 * q;
              float r4[4], k4[4]; RA_SHIFT(r4, 0, ct); RA_SHIFT(k4, 512, ct);
              const f32x4 a0v = *(const f32x4*)(par + 512 + ch), kkv = *(const f32x4*)(par + 1024 + ch), kav = *(const f32x4*)(par + 1536 + ch), rkv = *(const f32x4*)(par + 2048 + ch);
#pragma unroll
              for (int i = 0; i < 4; ++i) { const float av = fast_sigmoid(a0v[i] + aal[ct][i]); const float kk = k4[i] * kkv[i]; nrm += kk * kk;
                  bd += r4[i] * (k4[i] * (1.0f + (av - 1.0f) * kav[i])) * rkv[i]; } }
          nrm = quad_sum(nrm); bd = quad_sum(bd);
          const float kinv = 1.0f / fmaxf(sqrtf(nrm), 1e-12f);
          float lw[4][4], lg[4][4], lgend[4][4];
#pragma unroll
          for (int ct = 0; ct < 4; ++ct) { const f32x4 w0v = *(const f32x4*)(par + h * 64 + 16 * ct + 4 * q);
#pragma unroll
              for (int i = 0; i < 4; ++i) { lw[ct][i] = (-0.6065306597126334f * LOG2E) * fast_sigmoid(w0v[i] + awl[ct][i]); float x = lw[ct][i];
                  x += __builtin_bit_cast(float, __builtin_amdgcn_update_dpp(0, __builtin_bit_cast(int, x), 0x111, 0xf, 0xf, false));
                  x += __builtin_bit_cast(float, __builtin_amdgcn_update_dpp(0, __builtin_bit_cast(int, x), 0x112, 0xf, 0xf, false));
                  x += __builtin_bit_cast(float, __builtin_amdgcn_update_dpp(0, __builtin_bit_cast(int, x), 0x114, 0xf, 0xf, false));
                  x += __builtin_bit_cast(float, __builtin_amdgcn_update_dpp(0, __builtin_bit_cast(int, x), 0x118, 0xf, 0xf, false));
                  lg[ct][i] = x; } }
          LAS float* wt = (LAS float*)(hbase + RA_WT);
          if (n16 == 15) {
#pragma unroll
              for (int ct = 0; ct < 4; ++ct) *(LAS f32x4*)(wt + w4 * 64 + 16 * ct + 4 * q) = (f32x4){lg[ct][0], lg[ct][1], lg[ct][2], lg[ct][3]}; }
          __syncthreads();
#pragma unroll
          for (int ct = 0; ct < 4; ++ct) { f32x4 off = {0.f, 0.f, 0.f, 0.f}, tot = {0.f, 0.f, 0.f, 0.f};
#pragma unroll
              for (int w = 0; w < 4; ++w) { const f32x4 t = *(const LAS f32x4*)(wt + w * 64 + 16 * ct + 4 * q); tot = tot + t; if (w < w4) off = off + t; }
#pragma unroll
              for (int i = 0; i < 4; ++i) { lg[ct][i] += off[i]; lgend[ct][i] = tot[i]; } }
#pragma unroll
          for (int ct = 0; ct < 4; ++ct) { const int ch = h * 64 + 16 * ct + 4 * q;
              float r4[4], k4[4], v4[4]; RA_SHIFT(r4, 0, ct); RA_SHIFT(k4, 512, ct); RA_SHIFT(v4, 1024, ct);
              const f32x4 a0v = *(const f32x4*)(par + 512 + ch), kkv = *(const f32x4*)(par + 1024 + ch), kav = *(const f32x4*)(par + 1536 + ch);
              const f32x4 lg_ = *(const f32x4*)(par + 2560 + ch), lb_ = *(const f32x4*)(par + 3072 + ch);
              float rtl[4], ktl[4], btl[4], atl[4], khh[4], bhh[4], g1[4], e2[4];
#pragma unroll
              for (int i = 0; i < 4; ++i) {
                  const float av = fast_sigmoid(a0v[i] + aal[ct][i]); const float k2 = k4[i] * (1.0f + (av - 1.0f) * kav[i]);
                  const float kkn = k4[i] * kkv[i] * kinv, bb = kkn * av;
                  const float gam = __builtin_amdgcn_exp2f(lg[ct][i]), gpv = __builtin_amdgcn_exp2f(lg[ct][i] - lw[ct][i]), gin = __builtin_amdgcn_exp2f(-lg[ct][i]), ger = __builtin_amdgcn_exp2f(lgend[ct][i] - lg[ct][i]);
                  rtl[i] = r4[i] * gam; ktl[i] = k2 * gin; btl[i] = bb * gin; atl[i] = -kkn * gpv; khh[i] = k2 * ger; bhh[i] = bb * ger;
                  const float g = ag[ct][i]; g1[i] = lg_[i] * g; e2[i] = (lb_[i] + bd * v4[i]) * g;
              }
              const int fo = ((w4 * 4 + ct) * 64 + l) * 8;
              v2u o; o.x = pk2(g1[0], g1[1]); o.y = pk2(g1[2], g1[3]); __builtin_nontemporal_store(o, (v2u*)(rbi + RB_G1T + fo));
              o.x = pk2(e2[0], e2[1]); o.y = pk2(e2[2], e2[3]); __builtin_nontemporal_store(o, (v2u*)(rbi + RB_E2T + fo));
              const int co = tokl * 144 + (16 * ct + 4 * q) * 2;
              o.x = pk2(rtl[0], rtl[1]); o.y = pk2(rtl[2], rtl[3]); *(LAS v2u*)(hbase + RA_RT + co) = o; rtp[ct] = o;
              o.x = pk2(ktl[0], ktl[1]); o.y = pk2(ktl[2], ktl[3]); *(LAS v2u*)(hbase + RA_KT + co) = o;
              o.x = pk2(btl[0], btl[1]); o.y = pk2(btl[2], btl[3]); *(LAS v2u*)(hbase + RA_BT + co) = o;
              o.x = pk2(atl[0], atl[1]); o.y = pk2(atl[2], atl[3]); *(LAS v2u*)(hbase + RA_AT + co) = o;
#pragma unroll
              for (int i = 0; i < 4; ++i) { const int ro = (16 * ct + 4 * q + i) * 144 + 2 * tslot;
                  if (tokl == 0) *(LAS float*)(hbase + RA_VT + (16 * ct + 4 * q + i) * 144 + 128) = __builtin_amdgcn_exp2f(lgend[ct][i]);
                  *(LAS unsigned short*)(hbase + RA_VT + ro) = (unsigned short)(pk2(v4[i], 0.f) & 0xffffu);
                  *(LAS unsigned short*)(hbase + RA_KH + ro) = (unsigned short)(pk2(khh[i], 0.f) & 0xffffu);
                  *(LAS unsigned short*)(hbase + RA_BH + ro) = (unsigned short)(pk2(bhh[i], 0.f) & 0xffffu); }
              asm volatile("" ::: "memory");
          }
#undef RA_SHIFT
        }
        __syncthreads();
        bf16x8 akp[2], rkp[2], rbp[2];
        { bf16x8 fa[2], fr[2];
#pragma unroll
          for (int ks = 0; ks < 2; ++ks) { fa[ks] = *(const LAS bf16x8*)(hbase + RA_AT + tokl * 144 + 64 * ks + 16 * q); fr[ks] = *(const LAS bf16x8*)(hbase + RA_RT + tokl * 144 + 64 * ks + 16 * q); }
          f32x4 aak[4], arkk[4], arb[4];
#pragma unroll
          for (int jt = 0; jt < 4; ++jt) {
              f32x4 tab = {0.f, 0.f, 0.f, 0.f}; aak[jt] = tab; arkk[jt] = tab; arb[jt] = tab;
              if (jt <= w4) {
#pragma unroll
                  for (int ks = 0; ks < 2; ++ks) { const bf16x8 fk = *(const LAS bf16x8*)(hbase + RA_KT + (16 * jt + n16) * 144 + 64 * ks + 16 * q), fb = *(const LAS bf16x8*)(hbase + RA_BT + (16 * jt + n16) * 144 + 64 * ks + 16 * q);
                      aak[jt] = MFMA16(fk, fa[ks], aak[jt]); tab = MFMA16(fb, fa[ks], tab); arkk[jt] = MFMA16(fk, fr[ks], arkk[jt]); arb[jt] = MFMA16(fb, fr[ks], arb[jt]); }
                  if (jt == w4) {
#pragma unroll
                      for (int i = 0; i < 4; ++i) { const int j = 4 * q + i; if (j >= n16) { aak[jt][i] = 0.f; tab[i] = 0.f; } if (j > n16) { arkk[jt][i] = 0.f; arb[jt][i] = 0.f; } } }
                  *(LAS f32x4*)(hbase + RA_AAB + tokl * 256 + (16 * jt + 4 * q) * 4) = tab;
              }
          }
#pragma unroll
          for (int s = 0; s < 2; ++s) { akp[s] = pack8(aak[2 * s], aak[2 * s + 1]); rkp[s] = pack8(arkk[2 * s], arkk[2 * s + 1]); rbp[s] = pack8(arb[2 * s], arb[2 * s + 1]); } }
        { f32x4 akv[4];
#pragma unroll
          for (int vt = 0; vt < 4; ++vt) { akv[vt] = (f32x4){0.f, 0.f, 0.f, 0.f};
#pragma unroll
              for (int s = 0; s < 2; ++s) { const bf16x8 fv = *(const LAS bf16x8*)(hbase + RA_VT + (16 * vt + n16) * 144 + 64 * s + 16 * q); akv[vt] = MFMA16(akp[s], fv, akv[vt]); } }
          __syncthreads();
#pragma unroll
          for (int vt = 0; vt < 4; ++vt) *(LAS f32x4*)(hbase + RA_RHS2 + (16 * vt + n16) * 272 + (16 * w4 + 4 * q) * 4) = akv[vt]; }
        if (pair + F.G < NITEM / 2) RA_REQUEST(pair + F.G);
        { const LAS unsigned char* aab = hbase + RA_AAB + (16 * w4) * 256 + (16 * w4) * 4;
          LAS unsigned char* ti = hbase + RA_BT;
          if (q == 0) { float t[16];
#pragma unroll
              for (int r_ = 0; r_ < 16; ++r_) { float acc = (r_ == n16) ? 1.0f : 0.0f;
#pragma unroll
                  for (int j4 = 0; j4 < (r_ + 3) / 4; ++j4) { const f32x4 av = *(const LAS f32x4*)(aab + r_ * 256 + j4 * 16);
#pragma unroll
                      for (int e = 0; e < 4; ++e) if (4 * j4 + e < r_) acc += av[e] * t[4 * j4 + e]; }
                  t[r_] = acc; *(LAS unsigned short*)(ti + w4 * 512 + r_ * 32 + 2 * n16) = (unsigned short)(pk2(acc, 0.f) & 0xffffu); } }
          __syncthreads();
          bf16x8 a10, a20, a30, a31, tf[4];
          { const LAS unsigned char* ab = hbase + RA_AAB + n16 * 256 + 16 * q; const f32x4 z4 = {0.f, 0.f, 0.f, 0.f};
            const f32x4 l10 = *(const LAS f32x4*)(ab + 16 * 256), l20 = *(const LAS f32x4*)(ab + 32 * 256), l21 = *(const LAS f32x4*)(ab + 32 * 256 + 64);
            const f32x4 l30 = *(const LAS f32x4*)(ab + 48 * 256), l31 = *(const LAS f32x4*)(ab + 48 * 256 + 64), l32 = *(const LAS f32x4*)(ab + 48 * 256 + 128);
            a10 = pack8(l10, z4); a20 = pack8(l20, l21); a30 = pack8(l30, l31); a31 = pack8(l32, z4);
#pragma unroll
            for (int I = 0; I < 4; ++I) { const v2u tw = *(const LAS v2u*)(ti + I * 512 + n16 * 32 + 8 * q); const v4u t4 = {tw.x, tw.y, 0u, 0u}; tf[I] = __builtin_bit_cast(bf16x8, t4); } }
          v4u xw[2][2];
#pragma unroll
          for (int m = 0; m < 2; ++m) {
              v4u x0 = {0u, 0u, 0u, 0u}, x1 = {0u, 0u, 0u, 0u};
#pragma unroll
              for (int I = 0; I < 4; ++I) {
                  f32x4 z;
                  if (m == 0) {
#pragma unroll
                      for (int i = 0; i < 4; ++i) z[i] = bf2f(*(const LAS unsigned short*)(hbase + RA_AT + (16 * I + 4 * q + i) * 144 + 2 * tokl)); }
                  else z = *(const LAS f32x4*)(hbase + RA_RHS2 + tokl * 272 + (16 * I + 4 * q) * 4);
                  if (I == 1) z = MFMA16(a10, __builtin_bit_cast(bf16x8, x0), z);
                  if (I == 2) z = MFMA16(a20, __builtin_bit_cast(bf16x8, x0), z);
                  if (I == 3) { z = MFMA16(a30, __builtin_bit_cast(bf16x8, x0), z); z = MFMA16(a31, __builtin_bit_cast(bf16x8, x1), z); }
                  const v4u zb = {pk2(z[0], z[1]), pk2(z[2], z[3]), 0u, 0u};
                  const f32x4 x = MFMA16(tf[I], __builtin_bit_cast(bf16x8, zb), ((f32x4){0.f, 0.f, 0.f, 0.f}));
                  const unsigned p0 = pk2(x[0], x[1]), p1 = pk2(x[2], x[3]);
                  if (I == 0) { x0.x = p0; x0.y = p1; } if (I == 1) { x0.z = p0; x0.w = p1; } if (I == 2) { x1.x = p0; x1.y = p1; } if (I == 3) { x1.z = p0; x1.w = p1; }
              }
              xw[m][0] = x0; xw[m][1] = x1;
          }
          __syncthreads();
#pragma unroll
          for (int s = 0; s < 2; ++s) { *(LAS v4u*)(hbase + RA_W1T + tokl * 144 + 64 * s + 16 * q) = xw[0][s]; *(LAS v4u*)(hbase + RA_W2T + tokl * 144 + 64 * s + 16 * q) = xw[1][s]; }
        }
        __syncthreads();
        {
          f32x4 pc[4], y0[4];
#pragma unroll
          for (int t = 0; t < 4; ++t) { pc[t] = (f32x4){bflo(rtp[t].x), bfhi(rtp[t].x), bflo(rtp[t].y), bfhi(rtp[t].y)}; y0[t] = (f32x4){0.f, 0.f, 0.f, 0.f};
#pragma unroll
              for (int s = 0; s < 2; ++s) { y0[t] = MFMA16(*(const LAS bf16x8*)(hbase + RA_VT + (16 * t + n16) * 144 + 64 * s + 16 * q), rkp[s], y0[t]);
                                            y0[t] = MFMA16(*(const LAS bf16x8*)(hbase + RA_W2T + (16 * t + n16) * 144 + 64 * s + 16 * q), rbp[s], y0[t]);
                                            pc[t] = MFMA16(*(const LAS bf16x8*)(hbase + RA_W1T + (16 * t + n16) * 144 + 64 * s + 16 * q), rbp[s], pc[t]); } }
#pragma unroll
          for (int vt = 0; vt < 4; ++vt) { v2u o; o.x = pk2(y0[vt][0], y0[vt][1]); o.y = pk2(y0[vt][2], y0[vt][3]); __builtin_nontemporal_store(o, (v2u*)(rbi + RB_YLT + ((w4 * 4 + vt) * 64 + l) * 8)); }
#pragma unroll
          for (int s = 0; s < 2; ++s) __builtin_nontemporal_store(pack8(pc[2 * s], pc[2 * s + 1]), (bf16x8*)(rbi + RB_PCT + ((w4 * 2 + s) * 64 + l) * 16));
          f32x4 mc[4]; bf16x8 fb[2], fvv[2];
#pragma unroll
          for (int s = 0; s < 2; ++s) { fb[s] = *(const LAS bf16x8*)(hbase + RA_BH + tokl * 144 + 64 * s + 16 * q); fvv[s] = *(const LAS bf16x8*)(hbase + RA_VT + tokl * 144 + 64 * s + 16 * q); }
          const float gend_k = *(const LAS float*)(hbase + RA_VT + tokl * 144 + 128);
#pragma unroll
          for (int t = 0; t < 4; ++t) { mc[t] = (f32x4){0.f, 0.f, 0.f, 0.f};
#pragma unroll
              for (int s = 0; s < 2; ++s) mc[t] = MFMA16(*(const LAS bf16x8*)(hbase + RA_W1T + (16 * t + n16) * 144 + 64 * s + 16 * q), fb[s], mc[t]);
              if (t == w4) {
#pragma unroll
                  for (int i = 0; i < 4; ++i) if (4 * q + i == n16) mc[t][i] += gend_k; } }
#pragma unroll
          for (int s = 0; s < 2; ++s) __builtin_nontemporal_store(pack8(mc[2 * s], mc[2 * s + 1]), (bf16x8*)(rbi + RB_MC + ((w4 * 2 + s) * 64 + l) * 16));
          bf16x8 fw2[2];
#pragma unroll
          for (int s = 0; s < 2; ++s) fw2[s] = *(const LAS bf16x8*)(hbase + RA_W2T + tokl * 144 + 64 * s + 16 * q);
#pragma unroll
          for (int kt = 0; kt < 4; ++kt) { f32x4 cc = {0.f, 0.f, 0.f, 0.f};
#pragma unroll
              for (int s = 0; s < 2; ++s) { cc = MFMA16(*(const LAS bf16x8*)(hbase + RA_KH + (16 * kt + n16) * 144 + 64 * s + 16 * q), fvv[s], cc);
                                            cc = MFMA16(*(const LAS bf16x8*)(hbase + RA_BH + (16 * kt + n16) * 144 + 64 * s + 16 * q), fw2[s], cc); }
              v2u cw; cw.x = pk2(cc[0], cc[1]); cw.y = pk2(cc[2], cc[3]); __builtin_nontemporal_store(cw, (v2u*)(rbi + RB_CC + ((w4 * 4 + kt) * 64 + l) * 8)); } }
    }
}

constexpr int RBK_NS = 9, RBK_D = 8, RBK_SLOT = 16384, RBK_BLOCKS = 32;
static_assert(RBK_NS * RBK_SLOT <= MISC_OFF && RBK_D == RBK_NS - 1, "phase B ring");
DI void rwkv_phase_b(const Frame& F, const Args& a) {
    if (F.bid >= RBK_BLOCKS) return;
    unsigned char* rb = a.ws + WS_RW; const int l = F.lane, w = F.wave;
    const int h = F.bid & 7, b = F.bid >> 3;
    LAS unsigned char* lds = F.lds;
    if (w >= 4) {
        const int j = w - 4;
#define RBK_ISSUE(cc_) do { const int c_ = (cc_) < NCHUNK ? (cc_) : NCHUNK - 1; const unsigned char* r_ = rb + (size_t)(((b * 128 + c_) << 3) + h) * RB_REC; \
            LAS unsigned char* slot_ = lds + ((cc_) % RBK_NS) * RBK_SLOT; \
            _Pragma("unroll") for (int k_ = 0; k_ < 4; ++k_) { const int blk_ = 4 * j + k_; \
                const unsigned char* src_ = blk_ < 8 ? r_ + RB_MC + blk_ * 1024 : r_ + RB_CC + (blk_ - 8) * 1024; \
                __builtin_amdgcn_global_load_lds((const unsigned*)(src_ + l * 16), (LAS unsigned*)(slot_ + blk_ * 1024), 16, 0, 0); } } while (0)
        for (int c = 0; c < RBK_D; ++c) RBK_ISSUE(c);
        for (int c = 0; c < NCHUNK; ++c) {
            asm volatile("s_waitcnt vmcnt(28)" ::: "memory");
            __builtin_amdgcn_s_barrier();
            RBK_ISSUE(c + RBK_D);
        }
        asm volatile("s_waitcnt vmcnt(0)" ::: "memory");
        __builtin_amdgcn_s_barrier();
#undef RBK_ISSUE
    } else {
        const int vs = w;
        f32x4 st[4];
#pragma unroll
        for (int kt = 0; kt < 4; ++kt) st[kt] = (f32x4){0.f, 0.f, 0.f, 0.f};
        for (int c = 0; c < NCHUNK; ++c) {
            unsigned char* rbi = rb + (size_t)(((b * 128 + c) << 3) + h) * RB_REC;
            bf16x8 sb[2];
#pragma unroll
            for (int s = 0; s < 2; ++s) { sb[s] = pack8(st[2 * s], st[2 * s + 1]); *(bf16x8*)(rbi + RB_SC + ((vs * 2 + s) * 64 + l) * 16) = sb[s]; }
            __builtin_amdgcn_s_barrier();
            const LAS unsigned char* slot = lds + (c % RBK_NS) * RBK_SLOT;
#pragma unroll
            for (int kt = 0; kt < 4; ++kt) { const v2u cw = *(const LAS v2u*)(slot + 8192 + ((vs * 4 + kt) * 64 + l) * 8);
                f32x4 n = {bflo(cw.x), bfhi(cw.x), bflo(cw.y), bfhi(cw.y)};
#pragma unroll
                for (int s = 0; s < 2; ++s) n = MFMA16(*(const LAS bf16x8*)(slot + ((kt * 2 + s) * 64 + l) * 16), sb[s], n);
                st[kt] = n; }
        }
        __builtin_amdgcn_s_barrier();
    }
}

struct RcOps { bf16x8 pc[2]; v2u yl[4]; bf16x8 sc[4][2]; v2u g1[4], e2[4]; };
DI void rc_load(RcOps& o, const unsigned char* rb, int task, int l) {
    const int item = task >> 2, it = task & 3; const unsigned char* rbi = rb + (size_t)item * RB_REC;
#pragma unroll
    for (int s = 0; s < 2; ++s) o.pc[s] = __builtin_nontemporal_load((const bf16x8*)(rbi + RB_PCT + ((it * 2 + s) * 64 + l) * 16));
#pragma unroll
    for (int vt = 0; vt < 4; ++vt) { const int fo = ((it * 4 + vt) * 64 + l) * 8;
        o.yl[vt] = __builtin_nontemporal_load((const v2u*)(rbi + RB_YLT + fo)); o.g1[vt] = __builtin_nontemporal_load((const v2u*)(rbi + RB_G1T + fo)); o.e2[vt] = __builtin_nontemporal_load((const v2u*)(rbi + RB_E2T + fo));
#pragma unroll
        for (int s = 0; s < 2; ++s) o.sc[vt][s] = __builtin_nontemporal_load((const bf16x8*)(rbi + RB_SC + ((vt * 2 + s) * 64 + l) * 16)); }
}
DI void rwkv_phase_c(const Frame& F, const Args& a) {
    const unsigned char* rb = a.ws + WS_RW; bf16* mix = (bf16*)(a.ws + WS_MIX);
    const int l = F.lane, n16 = l & 15, q = l >> 4;
    const int gw = F.bid * NWAVES + F.wave, NGW = F.G * NWAVES;
    RcOps cur, nxt;
    if (gw < NITEM * 4) rc_load(cur, rb, gw, l);
    for (int task = gw; task < NITEM * 4; task += NGW) {
        const int item = task >> 2, it = task & 3, h = item & 7, c = (item >> 3) & 127, b = item >> 10;
        if (task + NGW < NITEM * 4) rc_load(nxt, rb, task + NGW, l);
        f32x4 y[4]; float sum = 0.f;
#pragma unroll
        for (int vt = 0; vt < 4; ++vt) { y[vt] = (f32x4){bflo(cur.yl[vt].x), bfhi(cur.yl[vt].x), bflo(cur.yl[vt].y), bfhi(cur.yl[vt].y)};
#pragma unroll
            for (int s = 0; s < 2; ++s) y[vt] = MFMA16(cur.sc[vt][s], cur.pc[s], y[vt]);
            sum += (y[vt][0] + y[vt][1]) + (y[vt][2] + y[vt][3]); }
        sum = quad_sum(sum);
        const float mean = sum * (1.f / 64.f); float sq = 0.f;
#pragma unroll
        for (int vt = 0; vt < 4; ++vt) { y[vt] = y[vt] - mean; sq += (y[vt][0] * y[vt][0] + y[vt][1] * y[vt][1]) + (y[vt][2] * y[vt][2] + y[vt][3] * y[vt][3]); }
        sq = quad_sum(sq);
        const float rstd = 1.0f / sqrtf(sq * (1.f / 64.f) + 64e-5f);
        const size_t tok = (size_t)b * SEQ + c * 64 + 16 * it + n16;
#pragma unroll
        for (int vt = 0; vt < 4; ++vt) { const v2u g = cur.g1[vt], e = cur.e2[vt];
            v2u o; o.x = pk2(y[vt][0] * rstd * bflo(g.x) + bflo(e.x), y[vt][1] * rstd * bfhi(g.x) + bfhi(e.x)); o.y = pk2(y[vt][2] * rstd * bflo(g.y) + bflo(e.y), y[vt][3] * rstd * bfhi(g.y) + bfhi(e.y));
            *(v2u*)(mix + tok * 1024 + 512 + h * 64 + 16 * vt + 4 * q) = o; }
        cur = nxt;
    }
}
#endif

DI void p0_prologue(const Frame& F, const Args& a) {
    unsigned char* ws = a.ws;
    LAS float* scr = (LAS float*)(F.lds + F.wave * 16384);
    const int gw = F.bid * NWAVES + F.wave, NGW = F.G * NWAVES;
    constexpr int I_IN = 0, I_OUT = 16 * 32, I_DEC = 16, I_AAA = 16, I_GATE = 32;
    constexpr int NITEMS = I_IN + I_OUT + I_DEC + I_AAA + I_GATE;
    for (int s = F.G - 1 - F.bid; s < INC / 32; s += F.G) { q_strip_i8_wg(a.in[I_WIN], INC, 32 * s, ws + WS_WIN, (float*)(ws + WS_COLSC1), F.wave, F.lane, (LAS float*)F.lds); __syncthreads(); }
    for (int it = gw; it < NITEMS; it += NGW) {
        int r = it;
        if (r < I_OUT) { const int kb = r / 32, nb = r % 32; tr_item(a.in[I_WOUT], 1024, 64 * kb, 32 * nb, (bf16*)(ws + WS_WOUT), 1024, 32 * nb, scr, F.lane, nullptr); continue; } r -= I_OUT;
        if (r < I_DEC) { tr_item(a.in[I_WDEC], 512, 0, 32 * r, (bf16*)(ws + WS_WDEC), 64, 32 * r, scr, F.lane, nullptr); continue; } r -= I_DEC;
        if (r < I_AAA) { tr_item(a.in[I_WAAA], 512, 0, 32 * r, (bf16*)(ws + WS_WAAA), 64, 32 * r, scr, F.lane, nullptr); continue; } r -= I_AAA;
        { const int kb = r / 16, nb = r % 16; tr_item(a.in[I_WGATE], 512, 64 * kb, 32 * nb, (bf16*)(ws + WS_WGATE), 128, 32 * nb, scr, F.lane, nullptr); }
    }
    { float* wrt = (float*)(ws + WS_WRT); const float* wr = a.in[I_WR]; const float* g2 = a.in[I_N2G];
      for (int i = F.bid * 512 + F.tid; i < 32 * 1024; i += F.G * 512) { const int e = i >> 10, k = i & 1023; wrt[i] = g2[k] * wr[k * 32 + e]; } }
    { float* par = (float*)(ws + WS_PAR); const int srcs[7] = {I_W0, I_A0, I_KK, I_KA, I_RK, I_LNG, I_LNB};
      for (int i = F.bid * 512 + F.tid; i < 7 * 512; i += F.G * 512) { const int k = i >> 9; float v = 0.f;
#pragma unroll
          for (int j = 0; j < 7; ++j) if (k == j) v = a.in[srcs[j]][i & 511];
          par[i] = v; } }
    { const float* x = a.in[I_X]; const float* g1 = a.in[I_N1G]; bf16* xn = (bf16*)(ws + WS_XN);
      f32x4 gv[4];
#pragma unroll
      for (int j = 0; j < 4; ++j) gv[j] = *((const f32x4*)g1 + F.lane + 64 * j);
      for (int m0 = 2 * gw; m0 < T; m0 += 2 * NGW) {
          f32x4 v[2][4];
#pragma unroll
          for (int r = 0; r < 2; ++r) { const f32x4* xr = (const f32x4*)(x + (size_t)(m0 + r) * D) + F.lane;
#pragma unroll
              for (int j = 0; j < 4; ++j) v[r][j] = __builtin_nontemporal_load(xr + 64 * j); }
#pragma unroll
          for (int r = 0; r < 2; ++r) { float s = 0.f;
#pragma unroll
              for (int j = 0; j < 4; ++j) s += (v[r][j].x * v[r][j].x + v[r][j].y * v[r][j].y) + (v[r][j].z * v[r][j].z + v[r][j].w * v[r][j].w);
              const float rs = 1.0f / sqrtf(wave_sum(s) * (1.f / D) + 1e-6f);
              f32x4 y[4]; float am = 0.f;
#pragma unroll
              for (int j = 0; j < 4; ++j) { y[j] = (v[r][j] * rs) * gv[j]; am = fmaxf(fmaxf(am, fmaxf(fabsf(y[j].x), fabsf(y[j].y))), fmaxf(fabsf(y[j].z), fabsf(y[j].w))); }
              am = wave_max(am); const float qi = am > 0.f ? 127.0f / am : 0.f;
              if (F.lane == 0) ((float*)(ws + WS_XNSC))[m0 + r] = am * (1.0f / 127.0f);
              unsigned* o4 = (unsigned*)((unsigned char*)xn + (size_t)(m0 + r) * D) + F.lane;
#pragma unroll
              for (int j = 0; j < 4; ++j) { const f32x4 qv = y[j] * qi + Q_MAGIC; o4[64 * j] = q_pack4(qv.x, qv.y, qv.z, qv.w); } }
      } }
}

#if NAIVE_RWKV
DI void rwkv_naive_prep(const Frame& F, const Args& a) {
    const bf16* proj = (const bf16*)(a.ws + WS_PROJ); LAS float* sx = (LAS float*)F.lds;
    float* RW = (float*)(a.ws + WS_RW); float* GG = (float*)(a.ws + WS_XN);
    const float* mu = a.in[I_MU]; const int c = F.tid;
    for (int t = F.bid; t < T; t += F.G) {
        const bool first = (t % SEQ) == 0; const bf16* cur = proj + (size_t)t * INC + PRW; const bf16* prv = cur - INC;
#define SH_(col) ({ const float x_ = bf2f(cur[col]); const float p_ = first ? 0.f : bf2f(prv[col]); x_ + (p_ - x_) * mu[col]; })
        if (c < 256) { const float v = SH_(1536 + c); sx[c] = c < 64 ? tanhf(v) : (c < 128 ? v : sigmoidf_(v)); }
        __syncthreads();
        const float r = SH_(c), k = SH_(512 + c), v = SH_(1024 + c);
#undef SH_
        float wl = a.in[I_W0][c], al = a.in[I_A0][c], g = 0.f;
        const float* wdec = a.in[I_WDEC] + c; const float* waaa = a.in[I_WAAA] + c; const float* wgate = a.in[I_WGATE] + c;
#pragma unroll 4
        for (int j = 0; j < 64; ++j) { wl += sx[j] * wdec[j * 512]; al += sx[64 + j] * waaa[j * 512]; }
#pragma unroll 4
        for (int j = 0; j < 128; ++j) g += sx[128 + j] * wgate[j * 512];
        const float dec = __expf(-0.6065306597126334f * sigmoidf_(wl)), av = sigmoidf_(al);
        float kk = k * a.in[I_KK][c]; const float n2 = wave_sum(kk * kk); kk = kk / fmaxf(sqrtf(n2), 1e-12f);
        const float k2 = k * (1.0f + (av - 1.0f) * a.in[I_KA][c]);
        const size_t o = (size_t)t * 512 + c; const size_t S1 = (size_t)T * 512;
        RW[o] = r; RW[S1 + o] = dec; RW[2 * S1 + o] = k2; RW[3 * S1 + o] = v; RW[4 * S1 + o] = kk; RW[5 * S1 + o] = av; GG[o] = g;
        __syncthreads();
    }
}
DI void rwkv_naive_scan(const Frame& F, const Args& a) {
    if (F.bid >= 32 || F.wave != 0) return;
    const int b = F.bid >> 3, h = F.bid & 7, l = F.lane, c = h * 64 + l;
    const float* RW = (const float*)(a.ws + WS_RW); const float* GG = (const float*)(a.ws + WS_XN); bf16* mix = (bf16*)(a.ws + WS_MIX);
    const size_t S1 = (size_t)T * 512; LAS float* sh = (LAS float*)F.lds;
    LAS float* st = sh + 512 + l;
    for (int k = 0; k < 64; ++k) st[64 * k] = 0.f;
    const float rk = a.in[I_RK][c], lg = a.in[I_LNG][c], lb = a.in[I_LNB][c];
    for (int s = 0; s < SEQ; ++s) {
        const size_t o = (size_t)(b * SEQ + s) * 512 + c;
        const float r = RW[o], w = RW[S1 + o], k2 = RW[2 * S1 + o], v = RW[3 * S1 + o], kk = RW[4 * S1 + o], av = RW[5 * S1 + o], g = GG[o];
        sh[l] = r; sh[64 + l] = w; sh[128 + l] = k2; sh[192 + l] = kk; sh[256 + l] = kk * av;
        LDS_WAIT();
        float sa = 0.f;
#pragma unroll 8
        for (int k = 0; k < 64; ++k) sa -= st[64 * k] * sh[192 + k];
        float y = 0.f;
#pragma unroll 8
        for (int k = 0; k < 64; ++k) { const float nv = st[64 * k] * sh[64 + k] + sa * sh[256 + k] + v * sh[128 + k]; st[64 * k] = nv; y += nv * sh[k]; }
        LDS_WAIT();
        const float mean = wave_sum(y) * (1.f / 64.f); const float d = y - mean; const float var = wave_sum(d * d) * (1.f / 64.f);
        const float yn = d * (1.0f / sqrtf(var + 64e-5f));
        const float bonus = wave_sum(r * k2 * rk) * v;
        const float outv = (yn * lg + lb + bonus) * g;
        mix[(size_t)(b * SEQ + s) * 1024 + 512 + c] = (bf16)(pk2(outv, 0.f) & 0xffffu);
    }
}
#endif
#if NAIVE_ATT
DI void attn_naive(const Frame& F, const Args& a) {
    const bf16* proj = (const bf16*)(a.ws + WS_PROJ); bf16* mix = (bf16*)(a.ws + WS_MIX);
    LAS float* sq = (LAS float*)(F.lds + F.wave * 1024);
    const int gw = F.bid * NWAVES + F.wave, NGW = F.G * NWAVES, l = F.lane;
    const float qg = a.in[I_QG][l];
    for (int it = gw; it < T * 8; it += NGW) {
        const int t = it >> 3, h = it & 7, b = t / SEQ, s = t % SEQ, n = s >> 6;
        const float qd = bf2f(proj[(size_t)t * INC + h * 64 + l]);
        const float qn = qd * (1.0f / sqrtf(wave_sum(qd * qd) * (1.f / 64.f) + 1e-6f)) * qg * 0.125f;
        sq[l] = qn; LDS_WAIT();
        float sc[9]; float mx = -3.0e38f;
#pragma unroll
        for (int r = 0; r < 9; ++r) {
            const int kp = (n - 8) * 64 + 64 * r + l; float v = -3.0e38f;
            if (kp >= 0) {
                const v4u* kr = (const v4u*)(proj + (size_t)(b * SEQ + kp) * INC + 512 + h * 64);
                float ss = 0.f, dot = 0.f;
#pragma unroll
                for (int j = 0; j < 8; ++j) { const v4u w = kr[j]; const unsigned ww[4] = {w.x, w.y, w.z, w.w};
#pragma unroll
                    for (int e = 0; e < 4; ++e) { const float k0 = bflo(ww[e]), k1 = bfhi(ww[e]); const int d0 = 8 * j + 2 * e;
                        ss += k0 * k0 + k1 * k1; dot += sq[d0] * a.in[I_KG][d0] * k0 + sq[d0 + 1] * a.in[I_KG][d0 + 1] * k1; } }
                int rel = kp - s; rel = rel < -128 ? -128 : (rel > 63 ? 63 : rel);
                v = dot * (1.0f / sqrtf(ss * (1.f / 64.f) + 1e-6f)) + a.in[I_RELB][h * 192 + rel + 128];
            }
            sc[r] = v; mx = fmaxf(mx, v);
        }
        mx = wave_max(mx); float sum = 0.f;
#pragma unroll
        for (int r = 0; r < 9; ++r) { sc[r] = (sc[r] > -1.0e38f) ? __expf(sc[r] - mx) : 0.f; sum += sc[r]; }
        sum = wave_sum(sum);
        float o = 0.f;
#pragma unroll
        for (int r = 0; r < 9; ++r) {
            const int kp0 = (n - 8) * 64 + 64 * r;
            if (kp0 >= 0) {
                const bf16* vp = proj + (size_t)(b * SEQ + kp0) * INC + 1024 + h * 64 + l;
                for (int key = 0; key < 64; ++key) o += __shfl(sc[r], key) * bf2f(vp[(size_t)key * INC]);
            }
        }
        mix[(size_t)t * 1024 + h * 64 + l] = (bf16)(pk2(o / sum, 0.f) & 0xffffu);
        LDS_WAIT();
    }
}
#endif

DI void p6_router(const Frame& F, const Args& a) {
    unsigned char* ws = a.ws; const bf16* x1 = (const bf16*)(ws + WS_XN); const float* wrt = (const float*)(ws + WS_WRT); const float* br = a.in[I_BR];
    int* eidx = (int*)(ws + WS_EIDX); float* gate = (float*)(ws + WS_GATE); int* lrank = (int*)(ws + WS_LRANK); float* rstd = (float*)(ws + WS_RSTD); int* cnt = (int*)(ws + WS_CNT);
    constexpr int WROW = 2064, WIMG = 32 * WROW;
    LAS int* hist = (LAS int*)(F.lds + 2 * WIMG);
    const int n = F.lane & 15, q = F.lane >> 4;
    for (int i = F.tid; i < 32 * 256; i += NWAVES * 64) { const int e = i >> 8, c4 = i & 255; const f32x4 w = *((const f32x4*)(wrt + (size_t)e * D) + c4);
        v2u hi, lo; hi.x = pk2(w[0], w[1]); hi.y = pk2(w[2], w[3]);
        lo.x = pk2(w[0] - bflo(hi.x), w[1] - bfhi(hi.x)); lo.y = pk2(w[2] - bflo(hi.y), w[3] - bfhi(hi.y));
        *(LAS v2u*)(F.lds + e * WROW + c4 * 8) = hi; *(LAS v2u*)(F.lds + WIMG + e * WROW + c4 * 8) = lo; }
    __syncthreads();
    for (int tile = F.bid; tile < T / 128; tile += F.G) {
        if (F.tid < 32) hist[F.tid] = 0;
        __syncthreads();
        const int tok = tile * 128 + F.wave * 16 + n;
        const v4u* xr = (const v4u*)(x1 + (size_t)tok * D) + q; const LAS unsigned char* w0 = F.lds + n * WROW + 16 * q;
        f32x4 acc0 = {0.f, 0.f, 0.f, 0.f}, acc1 = {0.f, 0.f, 0.f, 0.f}; float ssq = 0.f, amax = 0.f;
        for (int S0 = 0; S0 < 32; S0 += 16) {
            v4u xw[16];
#pragma unroll
            for (int s = 0; s < 16; ++s) xw[s] = xr[4 * (S0 + s)];
#pragma unroll
            for (int s = 0; s < 16; ++s) { const bf16x8 xb8 = __builtin_bit_cast(bf16x8, xw[s]); const LAS unsigned char* wp = w0 + (S0 + s) * 64;
                const unsigned u[4] = {xw[s].x, xw[s].y, xw[s].z, xw[s].w};
#pragma unroll
                for (int j = 0; j < 4; ++j) { const float a = bflo(u[j]), b = bfhi(u[j]); ssq += a * a + b * b; amax = fmaxf(amax, fmaxf(fabsf(a), fabsf(b))); }
                acc0 = __builtin_amdgcn_mfma_f32_16x16x32_bf16(*(const LAS bf16x8*)(wp), xb8, acc0, 0, 0, 0);
                acc0 = __builtin_amdgcn_mfma_f32_16x16x32_bf16(*(const LAS bf16x8*)(wp + WIMG), xb8, acc0, 0, 0, 0);
                acc1 = __builtin_amdgcn_mfma_f32_16x16x32_bf16(*(const LAS bf16x8*)(wp + 16 * WROW), xb8, acc1, 0, 0, 0);
                acc1 = __builtin_amdgcn_mfma_f32_16x16x32_bf16(*(const LAS bf16x8*)(wp + WIMG + 16 * WROW), xb8, acc1, 0, 0, 0); }
        }
        ssq = quad_sum(ssq); amax = quad_max(amax);
        const float rs = 1.0f / sqrtf(ssq * (1.f / D) + 1e-6f);
        float lg[8];
#pragma unroll
        for (int i = 0; i < 4; ++i) { lg[i] = acc0[i] * rs + br[4 * q + i]; lg[4 + i] = acc1[i] * rs + br[16 + 4 * q + i]; }
        float tv[4]; int ti[4];
#pragma unroll
        for (int r = 0; r < 4; ++r) {
            float bv = -3.0e38f; int bi = 0;
#pragma unroll
            for (int j = 0; j < 8; ++j) { const int e = (j < 4 ? 0 : 16) + 4 * q + (j & 3); if (lg[j] > bv) { bv = lg[j]; bi = e; } }
#pragma unroll
            for (int o = 16; o <= 32; o <<= 1) { const float ov = __shfl_xor(bv, o); const int oi = __shfl_xor(bi, o); if (ov > bv || (ov == bv && oi < bi)) { bv = ov; bi = oi; } }
            tv[r] = bv; ti[r] = bi;
#pragma unroll
            for (int j = 0; j < 8; ++j) { const int e = (j < 4 ? 0 : 16) + 4 * q + (j & 3); if (e == bi) lg[j] = -3.0e38f; }
        }
        if (q == 0) {
            const float e1 = __expf(tv[1] - tv[0]), e2 = __expf(tv[2] - tv[0]), e3 = __expf(tv[3] - tv[0]); const float inv = 1.0f / (1.0f + e1 + e2 + e3);
            int lr[4];
#pragma unroll
            for (int r = 0; r < 4; ++r) lr[r] = atomicAdd((int*)&hist[ti[r]], 1);
            *(int4*)(eidx + (size_t)tok * 4) = make_int4(ti[0], ti[1], ti[2], ti[3]);
            *(float4*)(gate + (size_t)tok * 4) = make_float4(inv, e1 * inv, e2 * inv, e3 * inv);
            *(int4*)(lrank + (size_t)tok * 4) = make_int4(lr[0], lr[1], lr[2], lr[3]);
            rstd[tok] = rs * amax * (1.0f / 127.0f);
        }
        { const float qinv = amax > 0.f ? 127.0f / amax : 0.f; unsigned char* xq = ws + WS_XQ;
            for (int i0 = 0; i0 < 16; i0 += 4) { v4u xa[4], xb2[4];
#pragma unroll
                for (int i = 0; i < 4; ++i) { const v4u* p = (const v4u*)(x1 + (size_t)(tile * 128 + F.wave * 16 + i0 + i) * D) + 2 * F.lane; xa[i] = p[0]; xb2[i] = p[1]; }
#pragma unroll
                for (int i = 0; i < 4; ++i) { const float sc = __builtin_bit_cast(float, __builtin_amdgcn_readlane(__builtin_bit_cast(int, qinv), i0 + i));
                    const unsigned u[8] = {xa[i].x, xa[i].y, xa[i].z, xa[i].w, xb2[i].x, xb2[i].y, xb2[i].z, xb2[i].w}; v4u o;
#pragma unroll
                    for (int d = 0; d < 4; ++d) { const f32x2 lo = {bflo(u[2 * d]), bfhi(u[2 * d])}, hi = {bflo(u[2 * d + 1]), bfhi(u[2 * d + 1])};
                        const f32x2 ql = lo * sc + Q_MAGIC, qh = hi * sc + Q_MAGIC; o[d] = q_pack4(ql.x, ql.y, qh.x, qh.y); }
                    *((v4u*)(xq + (size_t)(tile * 128 + F.wave * 16 + i0 + i) * D) + F.lane) = o; } }
        }
        __syncthreads();
        if (F.tid < 32) cnt[tile * 32 + F.tid] = hist[F.tid];
        __syncthreads();
    }
}

DI void p7_permute(const Frame& F, const Args& a) {
    unsigned char* ws = a.ws; const int* cnt = (const int*)(ws + WS_CNT); int* meta = (int*)(ws + WS_META);
    const int* eidx = (const int*)(ws + WS_EIDX); const int* lrank = (const int*)(ws + WS_LRANK); int* inv = (int*)(ws + WS_INV);
    const float* rstd = (const float*)(ws + WS_RSTD); float* rowrstd = (float*)(ws + WS_ROWRSTD);
    bf16* xb = (bf16*)(ws + WS_XN); int* rowtok = (int*)(ws + WS_ROWTOK);
    LAS int* s_tot = (LAS int*)F.lds; LAS int* s_pst = s_tot + 32; LAS int* s_base = s_tot + 64; LAS int* s_part = s_tot + 128;
    { const int e = F.tid & 31, part = F.tid >> 5; int s = 0; for (int t = part * 16; t < part * 16 + 16; ++t) s += cnt[t * 32 + e]; s_part[part * 32 + e] = s; }
    __syncthreads();
    if (F.tid < 32) { int s = 0; for (int p = 0; p < 16; ++p) s += s_part[p * 32 + F.tid]; s_tot[F.tid] = s; }
    __syncthreads();
    if (F.tid < 32) { int ps = 0; for (int e = 0; e < F.tid; ++e) ps += (s_tot[e] + 255) / 256 * 256; s_pst[F.tid] = ps; }
    __syncthreads();
    if (F.bid == 0 && F.tid < 32) { const int e = F.tid, nb = (s_tot[e] + 255) / 256, rb0 = s_pst[e] / 256; for (int i = 0; i < nb; ++i) meta[16 + rb0 + i] = e; if (e == 31) meta[0] = rb0 + nb; }
    if (F.bid < 32) { const int e = F.bid, r0 = s_pst[e] + s_tot[e], r1 = s_pst[e] + (s_tot[e] + 255) / 256 * 256;
        for (int r = r0 + F.tid; r < r1; r += NWAVES * 64) { rowtok[r] = T; rowrstd[r] = 0.f; } }
    if (F.bid == 0 && F.tid < 64) { const v4u z = {0u, 0u, 0u, 0u}; *((v4u*)(ws + WS_XQ + (size_t)T * D) + F.tid) = z; }
    for (int tile = F.bid; tile < T / 128; tile += F.G) {
        __syncthreads();
        if (F.tid < 32) { int s = 0; for (int t = 0; t < tile; ++t) s += cnt[t * 32 + F.tid]; s_base[F.tid] = s_pst[F.tid] + s; }
        __syncthreads();
        { const int i = F.tid;
            const int tok = tile * 128 + (i >> 2), k = i & 3; const int e = eidx[tok * 4 + k]; const int dest = s_base[e] + lrank[tok * 4 + k];
            inv[tok * 4 + k] = dest; rowtok[dest] = tok; rowrstd[dest] = rstd[tok];
        }
    }
}

DI void p10_combine(const Frame& F, const Args& a) {
    unsigned char* ws = a.ws; const int* inv = (const int*)(ws + WS_INV); const float* gate = (const float*)(ws + WS_GATE); const bf16* yr = (const bf16*)(ws + WS_YR); const bf16* xb = (const bf16*)(ws + WS_XN); float* out = a.out;
    const int gw = F.bid * NWAVES + F.wave, NGW = F.G * NWAVES;
    for (int t = gw; t < T; t += NGW) {
        const int4 iv = *(const int4*)(inv + (size_t)t * 4); const float4 gv = *(const float4*)(gate + (size_t)t * 4);
        const int rows[4] = {iv.x, iv.y, iv.z, iv.w}; const float gs[4] = {gv.x, gv.y, gv.z, gv.w};
        f32x4* o = (f32x4*)(out + (size_t)t * D) + F.lane; const v2u* xr = (const v2u*)(xb + (size_t)t * D) + F.lane;
#pragma unroll
        for (int j = 0; j < 4; ++j) {
            const v2u xw = xr[64 * j]; f32x4 acc = {bflo(xw.x), bfhi(xw.x), bflo(xw.y), bfhi(xw.y)};
#pragma unroll
            for (int k = 0; k < 4; ++k) { const int w = (int)__builtin_nontemporal_load((const unsigned*)((const unsigned char*)yr + (size_t)rows[k] * D) + F.lane + 64 * j);
                const auto lo = __builtin_amdgcn_cvt_pk_f32_fp8(w, false), hi = __builtin_amdgcn_cvt_pk_f32_fp8(w, true);
                acc.x += gs[k] * lo[0]; acc.y += gs[k] * lo[1]; acc.z += gs[k] * hi[0]; acc.w += gs[k] * hi[1]; }
            __builtin_nontemporal_store(acc, o + 64 * j);
        }
    }
}

constexpr int N_PHASES = 11;
__global__ void __launch_bounds__(NWAVES * 64, 2) fwd(Args args) {
    extern __shared__ __attribute__((aligned(16))) unsigned char lds[];
    Frame F;
    F.lds = (LAS unsigned char*)lds;
    F.tid = threadIdx.x; F.lane = F.tid & 63; F.wave = __builtin_amdgcn_readfirstlane(F.tid >> 6);
    F.G = gridDim.x; F.bid = blockIdx.x;
    volatile LAS unsigned* MISC = (volatile LAS unsigned*)(F.lds + MISC_OFF);
    if (F.tid < 64) MISC[F.tid] = 0u;
    __syncthreads();
    unsigned char* ws = args.ws;
    unsigned* ctl = (unsigned*)(ws + WS_CTL);
    XcdBarrier bar; bar.bar = ctl + CW_BAR; bar.x = 0; bar.st = nullptr;
    if (MK_N_LAUNCHES == 1) bar = xcd_barrier_post(ctl + CW_BAR, MISC + 8);
    const int lo = args.ph_lo, hi = args.ph_hi;
#ifndef PHASE_MASK
#define PHASE_MASK 0xffff
#endif
#define IN(k) (((PHASE_MASK >> (k)) & 1) && lo <= (k) && (k) < hi)
#ifndef DUP_PHASE
#define DUP_PHASE -1
#endif
#define REPS(k) ((DUP_PHASE >= 0 && (k) == DUP_PHASE) ? args.ph_rep : 1)
#define SEAM(k) do { if (IN(k) && IN((k) + 1)) xcd_barrier(bar); { int t_ = threadIdx.x; asm volatile("" : "+v"(t_)); F.tid = t_; F.lane = t_ & 63; } } while (0)

    for (int rep_ = 0; rep_ < REPS(0); ++rep_) { if (rep_) xcd_barrier(bar);
    if (IN(0)) { p0_prologue(F, args); } } SEAM(0);

    for (int rep_ = 0; rep_ < REPS(1); ++rep_) { if (rep_) xcd_barrier(bar);
    if (IN(1)) {
        pg8::Gemm g{(const bf16*)(ws + WS_XN), (const bf16*)(ws + WS_WIN), T, INC, D / 2}; pg8::StaticOrder S; S.init(T, INC, F.G, F.bid);
        pg8::EpiBf16Q E{(bf16*)(ws + WS_PROJ), INC, (const float*)(ws + WS_XNSC), (const float*)(ws + WS_COLSC1)};
        pg8::gemm_phase<pg8::EpiBf16Q, pg8::StaticOrder, true, true>(F.lds, g, S, E);
    } } SEAM(1);

    for (int rep_ = 0; rep_ < REPS(2); ++rep_) { if (rep_) xcd_barrier(bar);
    if (IN(2)) {
#if NAIVE_RWKV
        rwkv_naive_prep(F, args);
#else
        rwkv_phase_a(F, args);
#endif
    } } SEAM(2);

    for (int rep_ = 0; rep_ < REPS(3); ++rep_) { if (rep_) xcd_barrier(bar);
    if (IN(3)) {
#if NAIVE_RWKV
        rwkv_naive_scan(F, args);
#else
        rwkv_phase_b(F, args);
#endif
        __syncthreads();
#if NAIVE_ATT
        attn_naive(F, args);
#else
        attn_phase(F, args, rep_);
#endif
    } } SEAM(3);

    for (int rep_ = 0; rep_ < REPS(4); ++rep_) { if (rep_) xcd_barrier(bar);
    if (IN(4)) {
#if !NAIVE_RWKV
        rwkv_phase_c(F, args);
#endif
    } } SEAM(4);

    for (int rep_ = 0; rep_ < REPS(5); ++rep_) { if (rep_) xcd_barrier(bar);
    if (IN(5)) {
        pg8::Gemm g{(const bf16*)(ws + WS_MIX), (const bf16*)(ws + WS_WOUT), T, D, D}; pg8::StaticOrder S; S.init(T, D, F.G, F.bid);
        pg8::EpiResid E{args.in[I_X], nullptr, (bf16*)(ws + WS_XN), D};
        pg8::gemm_phase<pg8::EpiResid, pg8::StaticOrder, true, true>(F.lds, g, S, E);
    } } SEAM(5);

    for (int rep_ = 0; rep_ < REPS(6); ++rep_) { if (rep_) xcd_barrier(bar);
    if (IN(6)) { p6_router(F, args); } } SEAM(6);
    for (int rep_ = 0; rep_ < REPS(7); ++rep_) { if (rep_) xcd_barrier(bar);
    if (IN(7)) { p7_permute(F, args); } } SEAM(7);

    for (int rep_ = 0; rep_ < REPS(8); ++rep_) { if (rep_) xcd_barrier(bar);
    if (IN(8)) {
        pg8::Gemm g{(const bf16*)(ws + WS_XQ), (const bf16*)(ws + WS_WUP), NROWS_MAX, 2048, D / 2};
        pg8::MoeOrder<true> S{(const int*)(ws + WS_META), 8, F.G, F.bid, (const int*)(ws + WS_ROWTOK)};
        pg8::EpiSwiGLU E{(bf16*)(ws + WS_ACT), args.in[I_BUP], (const float*)(ws + WS_ROWRSTD), (const float*)(ws + WS_COLSC)};
        pg8::gemm_phase<pg8::EpiSwiGLU, pg8::MoeOrder<true>, true, true>(F.lds, g, S, E);
    } } SEAM(8);

    for (int rep_ = 0; rep_ < REPS(9); ++rep_) { if (rep_) xcd_barrier(bar);
    if (IN(9)) {
        pg8::Gemm g{(const bf16*)(ws + WS_ACT), (const bf16*)(ws + WS_WDN), NROWS_MAX, 1024, D / 2};
        pg8::MoeOrder<false> S{(const int*)(ws + WS_META), 4, F.G, F.bid, nullptr};
        pg8::EpiDown E{(bf16*)(ws + WS_YR), args.in[I_BDN], (const float*)(ws + WS_COLSC2)};
        pg8::gemm_phase<pg8::EpiDown, pg8::MoeOrder<false>, true, true>(F.lds, g, S, E);
    } } SEAM(9);

    if (IN(10)) { p10_combine(F, args); }
#undef IN
#undef SEAM
}

extern "C" void kernel_launch(void* const* d_in, const int* in_sizes, int n_in, void* d_out, int out_size, void* d_ws, size_t ws_size, hipStream_t stream) {
    static int grid = 0;
    if (grid == 0) {
        if (n_in != 25 || out_size != T * D || ws_size < WS_END) { fprintf(stderr, "kernel_launch: unexpected shapes (n_in %d out %d ws %zu)\n", n_in, out_size, ws_size); grid = -1; return; }
        int dev = 0, cus = 0, per_cu = 0;
        if (hipGetDevice(&dev) != hipSuccess || hipDeviceGetAttribute(&cus, hipDeviceAttributeMultiprocessorCount, dev) != hipSuccess) { grid = -1; return; }
        if (hipFuncSetAttribute((const void*)fwd, hipFuncAttributeMaxDynamicSharedMemorySize, LDS_BYTES) != hipSuccess) { fprintf(stderr, "kernel_launch: hipFuncSetAttribute failed\n"); grid = -1; return; }
        if (hipOccupancyMaxActiveBlocksPerMultiprocessor(&per_cu, (const void*)fwd, NWAVES * 64, LDS_BYTES) != hipSuccess || per_cu < 1) { fprintf(stderr, "kernel_launch: occupancy query says %d\n", per_cu); }
        (void)hipGetLastError();
        grid = cus;
    }
    if (grid < 0) return;
    (void)hipMemsetAsync((char*)d_ws + WS_CTL, 0, CTL_ZERO_BYTES, stream);
    Args a{};
    for (int i = 0; i < 25; ++i) a.in[i] = (const float*)d_in[i];
    a.out = (float*)d_out; a.ws = (unsigned char*)d_ws;
#if MK_N_LAUNCHES == 1
    a.ph_lo = 0; a.ph_hi = N_PHASES; a.ph_rep = 2;
    hipLaunchKernelGGL(fwd, dim3(grid), dim3(NWAVES * 64), LDS_BYTES, stream, a);
#else
    for (int p = 0; p < N_PHASES; ++p) { a.ph_lo = p; a.ph_hi = p + 1; hipLaunchKernelGGL(fwd, dim3(grid), dim3(NWAVES * 64), LDS_BYTES, stream, a); }
#endif
}
```

```cpp
#define NAIVE_RWKV 0
#define NAIVE_ATT 0
#define MK_N_LAUNCHES 1
#include <hip/hip_runtime.h>
#include <cstdio>
#include <cstdint>

#ifndef MK_N_LAUNCHES
#define MK_N_LAUNCHES 1
#endif
#ifndef NAIVE_RWKV
#define NAIVE_RWKV 0
#endif
#ifndef NAIVE_ATT
#define NAIVE_ATT 0
#endif

namespace pg8 {
#define PG8_LAS __attribute__((address_space(3)))
typedef unsigned short bf16_t;
typedef short bf16x8 __attribute__((ext_vector_type(8)));
typedef float f32x4 __attribute__((ext_vector_type(4)));
typedef unsigned u32x4 __attribute__((ext_vector_type(4)));
typedef unsigned u32x2 __attribute__((ext_vector_type(2)));
typedef float f32x2e __attribute__((ext_vector_type(2)));
typedef int i32x4 __attribute__((ext_vector_type(4)));
typedef int i32x8 __attribute__((ext_vector_type(8)));
template <bool F8> struct Frag { bf16x8 v[2]; __device__ __forceinline__ void set(bf16x8 a, bf16x8 b) { v[0] = a; v[1] = b; } };
template <> struct Frag<true> { i32x8 v; __device__ __forceinline__ void set(bf16x8 a, bf16x8 b) { v = __builtin_shufflevector(__builtin_bit_cast(i32x4, a), __builtin_bit_cast(i32x4, b), 0, 1, 2, 3, 4, 5, 6, 7); } };
__device__ __forceinline__ i32x8 cat8(bf16x8 a, bf16x8 b) { return __builtin_shufflevector(__builtin_bit_cast(i32x4, a), __builtin_bit_cast(i32x4, b), 0, 1, 2, 3, 4, 5, 6, 7); }
constexpr int BM = 256, BK = 64, HALF = 128, HTB = HALF * BK * 2  , STAGE_BYTES = 8 * HTB, NXCD = 8, WGM = 8, EPF_OFF = STAGE_BYTES  ;

__host__ __device__ __forceinline__ int lds_byte(int r, int c) { const int st = (r >> 4) * 2 + (c >> 5), rr = r & 15, cc = c & 31, ob = rr * 64 + cc * 2; return st * 1024 + (ob ^ (((ob >> 9) & 1) << 5)); }
__host__ __device__ __forceinline__ void stage_rc(int b, int& R, int& C) { const int st = b / 1024, sb = b % 1024, swz = sb ^ (((sb >> 9) & 1) << 5); R = (st >> 1) * 16 + swz / 64; C = (st & 1) * 32 + (swz % 64) / 2; }
__host__ __device__ __forceinline__ int perm32(int rho) { const int n = rho >> 4, i = rho & 15; return 8 * (i >> 2) + 4 * n + (i & 3); }

struct Unit { int pm, pn, e; };
struct Gemm { const bf16_t* A; const bf16_t* Bt; int M, N, K; };

__device__ __forceinline__ bool tile_of(int i, int G, int c, int nM, int nN, int& pm, int& pn) {
    const int nwg = nM * nN; const long L = (long)i * G + c; if (L >= nwg) return false;
    int wgid = (int)L; { const int q = nwg / NXCD, r = nwg % NXCD, xcd = wgid % NXCD, off = wgid / NXCD; wgid = (xcd < r ? xcd * (q + 1) : r * (q + 1) + (xcd - r) * q) + off; }
    const int nig = WGM * nN, gid = wgid / nig, fm = gid * WGM, gsz = (nM - fm) < WGM ? (nM - fm) : WGM;
    pm = fm + ((wgid % nig) % gsz); pn = (wgid % nig) / gsz; return true;
}
struct StaticOrder {
    int nM, nN, G, c;
    __device__ void init(int M, int N, int G_, int c_) { nM = M / BM; nN = N / BM; G = G_; c = c_; }
    __device__ __forceinline__ bool next(int i, Unit& u) const { u.e = 0; return tile_of(i, G, c, nM, nN, u.pm, u.pn); }
    __device__ __forceinline__ const char* a_base(const Gemm& g, const Unit& u) const { return (const char*)g.A + (size_t)u.pm * BM * g.K * 2; }
    __device__ __forceinline__ const char* b_base(const Gemm& g, const Unit& u) const { return (const char*)g.Bt + (size_t)u.pn * BM * g.K * 2; }
    __device__ __forceinline__ void a_off(const Gemm& g, const Unit&, const int (&R)[2], const int (&C)[2], unsigned (&vo)[2][2]) const {
#pragma unroll
        for (int h = 0; h < 2; ++h)
#pragma unroll
            for (int i = 0; i < 2; ++i) vo[h][i] = (unsigned)((h * HALF + R[i]) * g.K + C[i]) * 2u; }
    __device__ __forceinline__ void a_ready(const Unit&) const {}
    __device__ __forceinline__ void done(const Unit&) const {}
    static constexpr bool LATE = false;
    __device__ __forceinline__ void prologue(PG8_LAS unsigned char*, int) const {}
    __device__ __forceinline__ void a_req(const Unit&, PG8_LAS unsigned char*, int, int, int) const {}
    __device__ __forceinline__ void a_off_lds(const Gemm&, const PG8_LAS unsigned char*, int, const int (&)[2], const int (&)[2], unsigned (&)[2][2]) const {}
};
constexpr int SCH_META_OFF = EPF_OFF + 4096, SCH_ROW_OFF = EPF_OFF + 8192;
template <bool GATHER>
struct MoeOrder {
    const int* meta; int nN, G, c;
    const int* rowtok;
    const PG8_LAS int* lmeta;
    static constexpr bool LATE = GATHER;
    __device__ __forceinline__ void prologue(PG8_LAS unsigned char* lds, int tid) { PG8_LAS int* lm = (PG8_LAS int*)(lds + SCH_META_OFF);
        for (int i = tid; i < 16 + 544; i += 512) lm[i] = meta[i];
        __syncthreads(); lmeta = lm; }
    __device__ __forceinline__ bool next(int i, Unit& u) const {
        const int nM = __builtin_amdgcn_readfirstlane(lmeta[0]);
        if (!tile_of(i, G, c, nM, nN, u.pm, u.pn)) return false;
        u.e = __builtin_amdgcn_readfirstlane(lmeta[16 + u.pm]); return true;
    }
    __device__ __forceinline__ const char* a_base(const Gemm& g, const Unit& u) const { return GATHER ? (const char*)g.A : (const char*)g.A + (size_t)u.pm * BM * g.K * 2; }
    __device__ __forceinline__ const char* b_base(const Gemm& g, const Unit& u) const { return (const char*)g.Bt + ((size_t)u.e * g.N + (size_t)u.pn * BM) * g.K * 2; }
    __device__ __forceinline__ void a_off(const Gemm& g, const Unit& u, const int (&R)[2], const int (&C)[2], unsigned (&vo)[2][2]) const {
#pragma unroll
        for (int h = 0; h < 2; ++h)
#pragma unroll
            for (int i = 0; i < 2; ++i) { const int r = h * HALF + R[i]; vo[h][i] = (unsigned)((GATHER ? rowtok[u.pm * BM + r] : r) * g.K + C[i]) * 2u; } }
    __device__ __forceinline__ void a_req(const Unit& nxt, PG8_LAS unsigned char* lds, int wid, int lane, int slot) const {
        if (GATHER && wid == 0) __builtin_amdgcn_global_load_lds((const unsigned*)(rowtok + nxt.pm * BM + 4 * lane), (PG8_LAS unsigned*)(lds + SCH_ROW_OFF + (slot & 1) * 1024), 16, 0, 0); }
    __device__ __forceinline__ void a_off_lds(const Gemm& g, const PG8_LAS unsigned char* lds, int slot, const int (&R)[2], const int (&C)[2], unsigned (&vo)[2][2]) const {
        const PG8_LAS int* lr = (const PG8_LAS int*)(lds + SCH_ROW_OFF + (slot & 1) * 1024);
#pragma unroll
        for (int h = 0; h < 2; ++h)
#pragma unroll
            for (int i = 0; i < 2; ++i) vo[h][i] = (unsigned)(lr[h * HALF + R[i]] * g.K + C[i]) * 2u; }
    __device__ __forceinline__ void a_ready(const Unit&) const {}
    __device__ __forceinline__ void done(const Unit&) const {}
};

__device__ __forceinline__ unsigned cvt_pk_bf16(float lo, float hi) { unsigned r; asm volatile("v_cvt_pk_bf16_f32 %0, %1, %2" : "=v"(r) : "v"(lo), "v"(hi)); return r; }

__device__ __forceinline__ float acc_i2f(float bits) { return (float)__builtin_bit_cast(int, bits); }
__device__ __forceinline__ void epf_dma(const float* src_lane, PG8_LAS unsigned char* dst) { __builtin_amdgcn_global_load_lds((const unsigned*)src_lane, (PG8_LAS unsigned*)dst, 16, 0, 0); }
struct EpiBf16Q {
    static constexpr int ID = 1; static constexpr bool PERM = true, AFTER_DRAIN = false, I8 = true, F8 = false, EPF = true;
    bf16_t* O; int ldc; const float* rowsc; const float* colsc;
    __device__ __forceinline__ void prefetch(const Unit& u, PG8_LAS unsigned char* ev, int lane) const {
        epf_dma(colsc + u.pn * BM + 4 * lane, ev); epf_dma(rowsc + u.pm * BM + 4 * lane, ev + 1024); }
    __device__ __forceinline__ void operator()(const f32x4 (&acc)[2][2][4][2], const Unit& u, int wr, int wc, int fr, int fq, const PG8_LAS float* ev) const {
        const int row0 = u.pm * BM + wr * 64 + fr, col0 = u.pn * BM + wc * 32 + 8 * fq;
        f32x4 cv[2][2]; float rsv[2][4];
#pragma unroll
        for (int bj = 0; bj < 2; ++bj)
#pragma unroll
            for (int n = 0; n < 2; ++n) cv[bj][n] = *(const PG8_LAS f32x4*)(ev + wc * 32 + 8 * fq + bj * HALF + 4 * n);
#pragma unroll
        for (int ai = 0; ai < 2; ++ai)
#pragma unroll
            for (int m = 0; m < 4; ++m) rsv[ai][m] = ev[256 + wr * 64 + fr + ai * HALF + m * 16];
#pragma unroll
        for (int ai = 0; ai < 2; ++ai)
#pragma unroll
            for (int m = 0; m < 4; ++m) { bf16_t* rowp = O + (size_t)(row0 + ai * HALF + m * 16) * ldc + col0; const float rs = rsv[ai][m];
#pragma unroll
                for (int bj = 0; bj < 2; ++bj) { f32x4 v0, v1;
#pragma unroll
                    for (int j = 0; j < 4; ++j) { v0[j] = acc_i2f(acc[ai][bj][m][0][j]); v1[j] = acc_i2f(acc[ai][bj][m][1][j]); }
                    v0 = (v0 * rs) * cv[bj][0]; v1 = (v1 * rs) * cv[bj][1];
                    u32x4 w; w.x = cvt_pk_bf16(v0[0], v0[1]); w.y = cvt_pk_bf16(v0[2], v0[3]); w.z = cvt_pk_bf16(v1[0], v1[1]); w.w = cvt_pk_bf16(v1[2], v1[3]);
                    *(u32x4*)(rowp + bj * HALF) = w; } }
    }
};
struct EpiBf16 {
    static constexpr int ID = 0; static constexpr bool PERM = true, AFTER_DRAIN = false, I8 = false, F8 = false, EPF = false;
    bf16_t* O; int ldc;
    __device__ __forceinline__ void operator()(const f32x4 (&acc)[2][2][4][2], const Unit& u, int wr, int wc, int fr, int fq) const {
        const int row0 = u.pm * BM + wr * 64 + fr, col0 = u.pn * BM + wc * 32 + 8 * fq;
#pragma unroll
        for (int ai = 0; ai < 2; ++ai)
#pragma unroll
            for (int m = 0; m < 4; ++m) { bf16_t* rowp = O + (size_t)(row0 + ai * HALF + m * 16) * ldc + col0;
#pragma unroll
                for (int bj = 0; bj < 2; ++bj) { const f32x4 v0 = acc[ai][bj][m][0], v1 = acc[ai][bj][m][1];
                    u32x4 w; w.x = cvt_pk_bf16(v0[0], v0[1]); w.y = cvt_pk_bf16(v0[2], v0[3]); w.z = cvt_pk_bf16(v1[0], v1[1]); w.w = cvt_pk_bf16(v1[2], v1[3]);
                    *(u32x4*)(rowp + bj * HALF) = w; } }
    }
};
struct EpiResid {
    static constexpr int ID = 5; static constexpr bool PERM = false, AFTER_DRAIN = false, I8 = false, F8 = false, EPF = false;
    const float* base; float* out; bf16_t* xb; int ldc;
    __device__ __forceinline__ void operator()(const f32x4 (&acc)[2][2][4][2], const Unit& u, int wr, int wc, int fr, int fq) const {
        const int row0 = u.pm * BM + wr * 64 + fr, col0 = u.pn * BM + wc * 32 + 4 * fq;
        f32x4 nb[4][2][2];
#define PG8_RES_LOAD(g_) do { const size_t off_ = (size_t)(row0 + ((g_) >> 2) * HALF + ((g_) & 3) * 16) * ldc + col0; _Pragma("unroll") for (int bj = 0; bj < 2; ++bj) _Pragma("unroll") for (int n = 0; n < 2; ++n) \
            nb[(g_) & 3][bj][n] = __builtin_nontemporal_load((const f32x4*)(base + off_ + bj * HALF + n * 16)); } while (0)
        PG8_RES_LOAD(0); PG8_RES_LOAD(1); PG8_RES_LOAD(2);
#pragma unroll
        for (int g = 0; g < 8; ++g) { const int ai = g >> 2, m = g & 3; const size_t off = (size_t)(row0 + ai * HALF + m * 16) * ldc + col0;
            if (g + 3 < 8) PG8_RES_LOAD(g + 3);
#pragma unroll
            for (int bj = 0; bj < 2; ++bj)
#pragma unroll
                for (int n = 0; n < 2; ++n) { const f32x4 o = nb[g & 3][bj][n] + acc[ai][bj][m][n];
                    if (out) *(f32x4*)(out + off + bj * HALF + n * 16) = o;
                    u32x2 w; w.x = cvt_pk_bf16(o[0], o[1]); w.y = cvt_pk_bf16(o[2], o[3]); *(u32x2*)(xb + off + bj * HALF + n * 16) = w; }
            asm volatile("" ::: "memory"); }
#undef PG8_RES_LOAD
    }
};
struct EpiSwiGLU {
    static constexpr int ID = 8; static constexpr bool PERM = true, AFTER_DRAIN = false, I8 = true, F8 = false, EPF = true;
    bf16_t* O; const float* b_up; const float* rowrstd; const float* colsc;
    __device__ __forceinline__ void prefetch(const Unit& u, PG8_LAS unsigned char* ev, int lane) const {
        const int off = (size_t)u.e * 2048 + u.pn * HALF + (lane >> 5) * 1024 + 4 * (lane & 31);
        epf_dma(b_up + off, ev); epf_dma(colsc + off, ev + 1024); epf_dma(rowrstd + u.pm * BM + 4 * lane, ev + 2048); }
    __device__ __forceinline__ void operator()(const f32x4 (&acc)[2][2][4][2], const Unit& u, int wr, int wc, int fr, int fq, const PG8_LAS float* ev) const {
        const int row0 = u.pm * BM + wr * 64 + fr, f0 = u.pn * HALF + wc * 32 + 8 * fq;
        const PG8_LAS float* ep = ev + wc * 32 + 8 * fq;
        const f32x4 bg0 = *(const PG8_LAS f32x4*)ep, bg1 = *(const PG8_LAS f32x4*)(ep + 4), bl0 = *(const PG8_LAS f32x4*)(ep + 128), bl1 = *(const PG8_LAS f32x4*)(ep + 132);
        const f32x4 cg0 = *(const PG8_LAS f32x4*)(ep + 256), cg1 = *(const PG8_LAS f32x4*)(ep + 260), cl0 = *(const PG8_LAS f32x4*)(ep + 384), cl1 = *(const PG8_LAS f32x4*)(ep + 388);
        float rsv[2][4];
#pragma unroll
        for (int ai = 0; ai < 2; ++ai)
#pragma unroll
            for (int m = 0; m < 4; ++m) rsv[ai][m] = ev[512 + wr * 64 + fr + ai * HALF + m * 16];
#pragma unroll
        for (int ai = 0; ai < 2; ++ai)
#pragma unroll
            for (int m = 0; m < 4; ++m) { const int row = row0 + ai * HALF + m * 16; const float rs = rsv[ai][m];
                float a[8];
#pragma unroll
                for (int n = 0; n < 2; ++n)
#pragma unroll
                    for (int j = 0; j < 4; j += 2) {
                        const f32x2e ag2 = {acc_i2f(acc[ai][0][m][n][j]), acc_i2f(acc[ai][0][m][n][j + 1])}, al2 = {acc_i2f(acc[ai][1][m][n][j]), acc_i2f(acc[ai][1][m][n][j + 1])};
                        const f32x2e cg2 = n ? (f32x2e){cg1[j], cg1[j + 1]} : (f32x2e){cg0[j], cg0[j + 1]}, cl2 = n ? (f32x2e){cl1[j], cl1[j + 1]} : (f32x2e){cl0[j], cl0[j + 1]};
                        const f32x2e bg2 = n ? (f32x2e){bg1[j], bg1[j + 1]} : (f32x2e){bg0[j], bg0[j + 1]}, bl2 = n ? (f32x2e){bl1[j], bl1[j + 1]} : (f32x2e){bl0[j], bl0[j + 1]};
                        f32x2e hg = (ag2 * rs) * cg2 + bg2, hl = (al2 * rs) * cl2 + bl2;
                        hg.x = fminf(hg.x, 7.0f); hg.y = fminf(hg.y, 7.0f); hl.x = fminf(fmaxf(hl.x, -7.0f), 7.0f); hl.y = fminf(fmaxf(hl.y, -7.0f), 7.0f);
                        const f32x2e t = hg * (-1.702f * 1.4426950408889634f);
                        f32x2e e; e.x = __builtin_amdgcn_exp2f(t.x); e.y = __builtin_amdgcn_exp2f(t.y);
                        const f32x2e d = e + 1.0f; f32x2e sg; sg.x = __builtin_amdgcn_rcpf(d.x); sg.y = __builtin_amdgcn_rcpf(d.y);
                        const f32x2e o = (hg * sg) * (hl + 1.0f);
                        a[n * 4 + j] = o.x; a[n * 4 + j + 1] = o.y; }
                u32x2 w;
                w.x = (unsigned)__builtin_amdgcn_cvt_pk_fp8_f32(a[2], a[3], __builtin_amdgcn_cvt_pk_fp8_f32(a[0], a[1], 0, false), true);
                w.y = (unsigned)__builtin_amdgcn_cvt_pk_fp8_f32(a[6], a[7], __builtin_amdgcn_cvt_pk_fp8_f32(a[4], a[5], 0, false), true);
                *(u32x2*)((unsigned char*)O + (size_t)row * 1024 + f0) = w; }
    }
};
struct EpiDown {
    static constexpr int ID = 9; static constexpr bool PERM = true, AFTER_DRAIN = false, I8 = false, F8 = true, EPF = true;
    bf16_t* O; const float* b_dn; const float* colsc;
    __device__ __forceinline__ void prefetch(const Unit& u, PG8_LAS unsigned char* ev, int lane) const {
        const int off = (size_t)u.e * 1024 + u.pn * BM + 4 * lane;
        epf_dma(b_dn + off, ev); epf_dma(colsc + off, ev + 1024); }
    __device__ __forceinline__ void operator()(const f32x4 (&acc)[2][2][4][2], const Unit& u, int wr, int wc, int fr, int fq, const PG8_LAS float* ev) const {
        const int row0 = u.pm * BM + wr * 64 + fr, col0 = u.pn * BM + wc * 32 + 8 * fq;
        f32x4 bv[2][2], cv[2][2];
#pragma unroll
        for (int bj = 0; bj < 2; ++bj)
#pragma unroll
            for (int n = 0; n < 2; ++n) { bv[bj][n] = *(const PG8_LAS f32x4*)(ev + wc * 32 + 8 * fq + bj * HALF + 4 * n); cv[bj][n] = *(const PG8_LAS f32x4*)(ev + 256 + wc * 32 + 8 * fq + bj * HALF + 4 * n); }
#pragma unroll
        for (int ai = 0; ai < 2; ++ai)
#pragma unroll
            for (int m = 0; m < 4; ++m) { unsigned char* rowp = (unsigned char*)O + (size_t)(row0 + ai * HALF + m * 16) * 1024 + col0;
#pragma unroll
                for (int bj = 0; bj < 2; ++bj) { const f32x4 v0 = acc[ai][bj][m][0] * cv[bj][0] + bv[bj][0], v1 = acc[ai][bj][m][1] * cv[bj][1] + bv[bj][1];
                    u32x2 w; w.x = (unsigned)__builtin_amdgcn_cvt_pk_fp8_f32(v0[2], v0[3], __builtin_amdgcn_cvt_pk_fp8_f32(v0[0], v0[1], 0, false), true);
                    w.y = (unsigned)__builtin_amdgcn_cvt_pk_fp8_f32(v1[2], v1[3], __builtin_amdgcn_cvt_pk_fp8_f32(v1[0], v1[1], 0, false), true);
                    *(u32x2*)(rowp + bj * HALF) = w; } }
    }
};

template <class Epi, class Sched, bool ALIGN_EPI = false, bool SP2 = false>
__device__ __forceinline__ void gemm_phase(PG8_LAS unsigned char* lds, const Gemm g, Sched S, const Epi& E) {
    int tid = threadIdx.x; asm volatile("" : "+v"(tid));
    const int wid = __builtin_amdgcn_readfirstlane(tid >> 6), lane = tid & 63, wr = wid >> 2, wc = wid & 3, fr = lane & 15, fq = lane >> 4;
    const int K = g.K, nt = K / BK;
    unsigned voffB[2]; int sR[2], sC[2];
#pragma unroll
    for (int i = 0; i < 2; ++i) { int R, C; stage_rc(tid * 16 + i * 8192, R, C); const int Rb = Epi::PERM ? ((R & ~31) + perm32(R & 31)) : R;
        sR[i] = R; sC[i] = C; voffB[i] = (unsigned)(Rb * K + C) * 2u; }
    const size_t kstep = (size_t)(BK * 2);
    const size_t hstep = (size_t)HALF * K * 2;
    const unsigned ldsw = (unsigned)wid * 1024u;
    const int aoff = lds_byte(wr * 64 + fr, fq * 8), boff = lds_byte(wc * 32 + fr, fq * 8);
#define PG8_SA(b, h) (((b) * 2 + (h)) * HTB)
#define PG8_SB(b, h) ((4 + (b) * 2 + (h)) * HTB)
#define PG8_STAGE(bufoff, gbase, voff) do { _Pragma("unroll") for (int _i = 0; _i < 2; ++_i) \
        __builtin_amdgcn_global_load_lds((const unsigned*)((const char*)(gbase) + (voff)[_i]), (PG8_LAS unsigned*)(lds + (bufoff) + ldsw + _i * 8192), 16, 0, 0); } while (0)
#define PG8_STAGE_A(bufoff, gbase, vo, h) do { _Pragma("unroll") for (int _i = 0; _i < 2; ++_i) \
        __builtin_amdgcn_global_load_lds((const unsigned*)((const char*)(gbase) + (vo)[h][_i]), (PG8_LAS unsigned*)(lds + (bufoff) + ldsw + _i * 8192), 16, 0, 0); } while (0)
#define PG8_LDA(dst, b, h) do { _Pragma("unroll") for (int m = 0; m < 4; ++m) dst[m].set(*(const PG8_LAS bf16x8*)(lds + PG8_SA(b, h) + aoff + m * 2048), *(const PG8_LAS bf16x8*)(lds + PG8_SA(b, h) + aoff + m * 2048 + 1024)); } while (0)
#define PG8_LDB(dst, b, h) do { _Pragma("unroll") for (int n = 0; n < 2; ++n) dst[n].set(*(const PG8_LAS bf16x8*)(lds + PG8_SB(b, h) + boff + n * 2048), *(const PG8_LAS bf16x8*)(lds + PG8_SB(b, h) + boff + n * 2048 + 1024)); } while (0)
#define PG8_MMA(ai, bj, At, Bt) do { __builtin_amdgcn_s_setprio(1); _Pragma("unroll") for (int m = 0; m < 4; ++m) _Pragma("unroll") for (int n = 0; n < 2; ++n) { \
        if constexpr (Epi::F8) asm volatile("v_mfma_scale_f32_16x16x128_f8f6f4 %0, %1, %2, %0, %3, %3 op_sel_hi:[0,0,0]" : "+v"(acc[ai][bj][m][n]) : "v"(Bt[n].v), "v"(At[m].v), "v"(f8scale)); \
        else { _Pragma("unroll") for (int k = 0; k < 2; ++k) { \
            if constexpr (Epi::I8) acc[ai][bj][m][n] = __builtin_bit_cast(f32x4, __builtin_amdgcn_mfma_i32_16x16x64_i8(__builtin_bit_cast(i32x4, Bt[n].v[k]), __builtin_bit_cast(i32x4, At[m].v[k]), __builtin_bit_cast(i32x4, acc[ai][bj][m][n]), 0, 0, 0)); \
            else acc[ai][bj][m][n] = __builtin_amdgcn_mfma_f32_16x16x32_bf16(Bt[n].v[k], At[m].v[k], acc[ai][bj][m][n], 0, 0, 0); } } } __builtin_amdgcn_s_setprio(0); } while (0)
#define PG8_WAIT_V(n) asm volatile("s_waitcnt vmcnt(" #n ")" ::: "memory")
#define PG8_WAIT_L(n) asm volatile("s_waitcnt lgkmcnt(" #n ")" ::: "memory")
#define PG8_BAR __builtin_amdgcn_s_barrier()
#define PG8_SCHED __builtin_amdgcn_sched_barrier(0)
    Unit cur, nxt; int ui = 0;
#ifdef GEMM_TIME
    long long gacc_ = 0;
#endif
    S.prologue(lds, tid);
    if (!S.next(0, cur)) return;
    f32x4 acc[2][2][4][2];
#pragma unroll
    for (int a = 0; a < 2; ++a)
#pragma unroll
        for (int b = 0; b < 2; ++b)
#pragma unroll
            for (int m = 0; m < 4; ++m)
#pragma unroll
                for (int n = 0; n < 2; ++n) acc[a][b][m][n] = (f32x4){0.f, 0.f, 0.f, 0.f};
    Frag<Epi::F8> At[4], B0[2], B1[2];
    const int f8scale = 0x7f7f7f7f;
    (void)f8scale;
    const char* cA = S.a_base(g, cur); const char* cB = S.b_base(g, cur);
    unsigned voC[2][2], voN[2][2];
    S.a_off(g, cur, sR, sC, voC);
    S.a_ready(cur);
    static_assert(SP2, "only the two-MFMA-blocks-per-barrier-pair loop is kept");
    PG8_STAGE(PG8_SB(0, 0), cB, voffB); PG8_STAGE(PG8_SB(0, 1), cB + hstep, voffB); PG8_STAGE_A(PG8_SA(0, 0), cA, voC, 0); PG8_STAGE_A(PG8_SA(0, 1), cA, voC, 1);
    if (wr == 1) PG8_BAR;
    PG8_WAIT_V(2); PG8_BAR;
    PG8_STAGE(PG8_SB(1, 0), cB + kstep, voffB); PG8_STAGE_A(PG8_SA(1, 0), cA + kstep, voC, 0); PG8_STAGE(PG8_SB(1, 1), cB + hstep + kstep, voffB);
    PG8_WAIT_V(6); PG8_BAR;
    for (;;) {
        const bool has_next = S.next(ui + 1, nxt);
        const char* nA = has_next ? S.a_base(g, nxt) : cA; const char* nB = has_next ? S.b_base(g, nxt) : cB;
        if (has_next && !Sched::LATE) S.a_off(g, nxt, sR, sC, voN); else {
#pragma unroll
            for (int h_ = 0; h_ < 2; ++h_) { voN[h_][0] = voC[h_][0]; voN[h_][1] = voC[h_][1]; } }
        if constexpr (Sched::LATE) { if (has_next) S.a_req(nxt, lds, wid, lane, ui + 1); }
#pragma unroll 1
        for (int t = 0; t < nt; t += 2) {
            const bool last = (t == nt - 2);
            const char* a1 = cA + (size_t)(t + 1) * kstep;
            const char* a2 = last ? nA : cA + (size_t)(t + 2) * kstep; const char* b2 = last ? nB : cB + (size_t)(t + 2) * kstep;
            const char* a3 = a2 + kstep; const char* b3 = b2 + kstep;
            if (last && has_next) S.a_ready(nxt);
            if constexpr (Sched::LATE) { if (last && has_next) S.a_off_lds(g, lds, ui + 1, sR, sC, voN); }
            if constexpr (Epi::EPF) { if (last && wid == 0) E.prefetch(cur, lds + EPF_OFF, lane); }
            unsigned vo2[2][2];
#pragma unroll
            for (int h_ = 0; h_ < 2; ++h_) { vo2[h_][0] = last ? voN[h_][0] : voC[h_][0]; vo2[h_][1] = last ? voN[h_][1] : voC[h_][1]; }
            PG8_LDB(B0, 0, 0); PG8_LDB(B1, 0, 1); PG8_SCHED; PG8_LDA(At, 0, 0); PG8_STAGE_A(PG8_SA(1, 1), a1, voC, 1);
            PG8_WAIT_V(8); PG8_WAIT_L(0); PG8_BAR; PG8_MMA(0, 0, At, B0); PG8_MMA(0, 1, At, B1); PG8_BAR; PG8_SCHED;
            PG8_LDA(At, 0, 1); PG8_STAGE(PG8_SB(0, 0), b2, voffB); PG8_STAGE(PG8_SB(0, 1), b2 + hstep, voffB); PG8_STAGE_A(PG8_SA(0, 0), a2, vo2, 0);
            PG8_WAIT_V(8); PG8_WAIT_L(0); PG8_BAR; PG8_MMA(1, 0, At, B0); PG8_MMA(1, 1, At, B1); PG8_BAR; PG8_SCHED;
            PG8_LDB(B0, 1, 0); PG8_LDB(B1, 1, 1); PG8_SCHED; PG8_LDA(At, 1, 0); PG8_STAGE_A(PG8_SA(0, 1), a2, vo2, 1);
            PG8_WAIT_V(8); PG8_WAIT_L(0); PG8_BAR; PG8_MMA(0, 0, At, B0); PG8_MMA(0, 1, At, B1); PG8_BAR; PG8_SCHED;
            PG8_LDA(At, 1, 1); PG8_STAGE(PG8_SB(1, 0), b3, voffB); PG8_STAGE(PG8_SB(1, 1), b3 + hstep, voffB); PG8_STAGE_A(PG8_SA(1, 0), a3, vo2, 0);
            PG8_WAIT_V(8); PG8_WAIT_L(0); PG8_BAR; PG8_MMA(1, 0, At, B0); PG8_MMA(1, 1, At, B1); PG8_BAR; PG8_SCHED;
        }
        if constexpr (ALIGN_EPI) { if (wr == 0) PG8_BAR; }
#ifdef GEMM_TIME
        const long long gt0_ = clock64();
#endif
        if constexpr (!Epi::AFTER_DRAIN) { if constexpr (Epi::EPF) E(acc, cur, wr, wc, fr, fq, (const PG8_LAS float*)(lds + EPF_OFF)); else E(acc, cur, wr, wc, fr, fq); S.done(cur); }
#ifdef GEMM_TIME
        if (GEMM_TIME == 100 || GEMM_TIME == Epi::ID) gacc_ += clock64() - gt0_;
#endif
        if (!has_next) break;
#pragma unroll
        for (int a = 0; a < 2; ++a)
#pragma unroll
            for (int b = 0; b < 2; ++b)
#pragma unroll
                for (int m = 0; m < 4; ++m)
#pragma unroll
                    for (int n = 0; n < 2; ++n) acc[a][b][m][n] = (f32x4){0.f, 0.f, 0.f, 0.f};
        cur = nxt; cA = nA; cB = nB; ++ui;
#pragma unroll
        for (int h_ = 0; h_ < 2; ++h_) { voC[h_][0] = voN[h_][0]; voC[h_][1] = voN[h_][1]; }
        if constexpr (ALIGN_EPI) { if (wr == 1) PG8_BAR; }
    }
    PG8_WAIT_V(0);
    if constexpr (!ALIGN_EPI) { if (wr == 0) PG8_BAR; }
    PG8_BAR;
#ifdef GEMM_TIME
    { const long long s0_ = clock64(); while (clock64() - s0_ < gacc_) __builtin_amdgcn_s_sleep(8); }
#endif
    if constexpr (Epi::AFTER_DRAIN) { E.fused(acc, cur, wr, wc, fr, fq, lds, wid, lane); S.done(cur); }
#undef PG8_SA
#undef PG8_SB
#undef PG8_STAGE
#undef PG8_STAGE_A
#undef PG8_LDA
#undef PG8_LDB
#undef PG8_MMA
#undef PG8_WAIT_V
#undef PG8_WAIT_L
#undef PG8_BAR
#undef PG8_SCHED
}
}

constexpr int NWAVES = 8;
constexpr int T = 32768, D = 1024, SEQ = 8192, NBATCH = 4, NCHUNK = SEQ / 64;
constexpr int INC = 3328;
constexpr int PRW = 1536;
constexpr int NEXP = 32, TOPK = 4;
constexpr int NRB_MAX = T * TOPK / 256 + NEXP;
constexpr int NROWS_MAX = NRB_MAX * 256;
constexpr int NITEM = NBATCH * NCHUNK * 8;

constexpr size_t MiB = 1u << 20, KiB = 1u << 10;
constexpr size_t WS_CTL = 0, CTL_ZERO_BYTES = 1 * MiB;
constexpr size_t WS_META = 1 * MiB;
constexpr size_t WS_CNT = 1 * MiB + 64 * KiB;
constexpr size_t WS_EIDX = 2 * MiB, WS_GATE = 2 * MiB + 512 * KiB, WS_LRANK = 3 * MiB, WS_INV = 3 * MiB + 512 * KiB;
constexpr size_t WS_RSTD = 4 * MiB, WS_ROWRSTD = 4 * MiB + 256 * KiB;
constexpr size_t WS_WRT = 5 * MiB;
constexpr size_t WS_PAR = 5 * MiB + 128 * KiB;
constexpr size_t WS_WDEC = 5 * MiB + 256 * KiB, WS_WAAA = WS_WDEC + 64 * KiB, WS_WGATE = WS_WAAA + 64 * KiB;
constexpr size_t WS_WIN = 6 * MiB, WS_WOUT = 13 * MiB;
constexpr size_t WS_ROWTOK = 15 * MiB;
constexpr size_t WS_WUP = 16 * MiB, WS_WDN = 144 * MiB;
constexpr size_t WS_XN = 208 * MiB;
constexpr size_t WS_PROJ = 272 * MiB;
constexpr size_t WS_MIX = 480 * MiB;
constexpr size_t WS_RW = 544 * MiB;
constexpr size_t WS_XG = 272 * MiB, WS_ACT = 544 * MiB, WS_YR = WS_XG;
constexpr size_t WS_COLSC = 15 * MiB + 640 * KiB;
constexpr size_t WS_COLSC1 = 5 * MiB + 192 * KiB;
constexpr size_t WS_XNSC = WS_RSTD;
constexpr size_t WS_COLSC2 = 15 * MiB + 896 * KiB;
constexpr size_t WS_XQ = WS_MIX;
constexpr size_t WS_END = 1000 * MiB;
constexpr int CW_ATT = 8192;
constexpr int CW_BAR = 4096;

constexpr int RING_BYTES = 131072;
constexpr int LDS_BYTES = 163840;
constexpr int MISC_OFF = LDS_BYTES - 256;

#define GAS __attribute__((address_space(1)))
#define LAS __attribute__((address_space(3)))
#define DI __device__ __forceinline__
typedef unsigned short bf16;
typedef unsigned v4u __attribute__((ext_vector_type(4)));
typedef unsigned v2u __attribute__((ext_vector_type(2)));
typedef float f32x4 __attribute__((ext_vector_type(4)));
typedef float f32x2 __attribute__((ext_vector_type(2)));
typedef short bf16x8 __attribute__((ext_vector_type(8)));
typedef __bf16 bf16x2_t __attribute__((ext_vector_type(2)));
#define LDS_WAIT() asm volatile("s_waitcnt lgkmcnt(0)" ::: "memory")
#define VM_WAIT() asm volatile("s_waitcnt vmcnt(0)" ::: "memory")
DI unsigned pk2(float lo, float hi) { const f32x2 v = {lo, hi}; const bf16x2_t b = __builtin_convertvector(v, bf16x2_t); return __builtin_bit_cast(unsigned, b); }
DI float bf2f(unsigned short b) { return __uint_as_float((unsigned)b << 16); }
DI float bflo(unsigned w) { return __uint_as_float(w << 16); }
DI float bfhi(unsigned w) { return __uint_as_float(w & 0xffff0000u); }
DI float wave_sum(float v) {
#pragma unroll
    for (int o = 1; o < 64; o <<= 1) v += __shfl_xor(v, o);
    return v;
}
DI float wave_max(float v) {
#pragma unroll
    for (int o = 1; o < 64; o <<= 1) v = fmaxf(v, __shfl_xor(v, o));
    return v;
}
DI float sigmoidf_(float x) { return 1.0f / (1.0f + __expf(-x)); }

DI float quad_sum(float x) {
    const unsigned a = __builtin_bit_cast(unsigned, x); const auto r = __builtin_amdgcn_permlane32_swap(a, a, false, false);
    const float y = __builtin_bit_cast(float, (unsigned)r[0]) + __builtin_bit_cast(float, (unsigned)r[1]);
    const unsigned b = __builtin_bit_cast(unsigned, y); const auto s = __builtin_amdgcn_permlane16_swap(b, b, false, false);
    return __builtin_bit_cast(float, (unsigned)s[0]) + __builtin_bit_cast(float, (unsigned)s[1]);
}
DI float quad_max(float x) {
    const unsigned a = __builtin_bit_cast(unsigned, x); const auto r = __builtin_amdgcn_permlane32_swap(a, a, false, false);
    const float y = fmaxf(__builtin_bit_cast(float, (unsigned)r[0]), __builtin_bit_cast(float, (unsigned)r[1]));
    const unsigned b = __builtin_bit_cast(unsigned, y); const auto s = __builtin_amdgcn_permlane16_swap(b, b, false, false);
    return fmaxf(__builtin_bit_cast(float, (unsigned)s[0]), __builtin_bit_cast(float, (unsigned)s[1]));
}
#define XB_TMO      128
#define XB_XCNT(j)  (256  + 64 * (j))
#define XB_XSUB(j)  (1280 + 64 * (j))
#define XB_XGEN(j)  (2304 + 64 * (j))
#define XB_TOP      3328
#define XB_TOPGEN   3392
#define XCD_BAR_WORDS 3456
#define XB_SPIN_CAP (NAIVE_RWKV ? (1u << 25) : (1u << 20))

__device__ __forceinline__ unsigned xb_ld(unsigned* p)              { return __hip_atomic_load(p, __ATOMIC_RELAXED, __HIP_MEMORY_SCOPE_AGENT); }
__device__ __forceinline__ unsigned xb_add(unsigned* p, unsigned v) { return __hip_atomic_fetch_add(p, v, __ATOMIC_RELAXED, __HIP_MEMORY_SCOPE_AGENT); }
__device__ __forceinline__ unsigned xb_xcc_id() { return (unsigned)__builtin_amdgcn_s_getreg((3 << 11) | 20) & 0xFu; }
#define XB_SPIN(cond, bar) do { unsigned _sp = 0; while (cond) { __builtin_amdgcn_s_sleep(1); \
    if ((++_sp & 255u) == 0u) { if (xb_ld(&(bar)[XB_TMO])) break; if (_sp > XB_SPIN_CAP) { atomicAdd(&(bar)[XB_TMO], 1u); break; } } } } while (0)

struct XcdBarrier {
    unsigned* bar; unsigned x;
    volatile LAS unsigned* st;
};

__device__ __forceinline__ XcdBarrier xcd_barrier_post(unsigned* bar, volatile LAS unsigned* st) {
    XcdBarrier b; b.bar = bar; b.x = xb_xcc_id(); b.st = st;
    if (threadIdx.x == 0) (void)xb_add(&bar[XB_XCNT(b.x)], 1u);
    return b;
}
__device__ __forceinline__ void xcd_barrier_complete(unsigned* bar, unsigned x, unsigned& nloc, unsigned& nx) {
    const unsigned G = gridDim.x * gridDim.y * gridDim.z;
    unsigned sum, cnt, mine, sp = 0u;
    for (;;) {
        sum = 0u; cnt = 0u; mine = 0u;
#pragma unroll
        for (unsigned j = 0; j < 16; ++j) { const unsigned c = xb_ld(&bar[XB_XCNT(j)]); sum += c; cnt += (c > 0u) ? 1u : 0u; mine = (j == x) ? c : mine; }
        if (sum == G) break;
        __builtin_amdgcn_s_sleep(1);
        if ((++sp & 255u) == 0u) { if (xb_ld(&bar[XB_TMO])) break; if (sp > XB_SPIN_CAP) { atomicAdd(&bar[XB_TMO], 1u); break; } }
    }
    nloc = mine > 0u ? mine : 1u; nx = cnt > 0u ? cnt : 1u;
}

__device__ __forceinline__ void xcd_barrier(const XcdBarrier& b) {
    asm volatile("s_waitcnt vmcnt(0)" ::: "memory");
    __syncthreads();
    if (threadIdx.x == 0) {
        unsigned* bar = b.bar;
        __builtin_amdgcn_s_waitcnt(0);
        unsigned nloc = b.st[0], nx = b.st[1];
        if (nloc == 0u) { xcd_barrier_complete(bar, b.x, nloc, nx); b.st[0] = nloc; b.st[1] = nx; }
        const unsigned old = xb_add(&bar[XB_XSUB(b.x)], 1u);
        const unsigned gen = old / nloc;
        if (old + 1u == (gen + 1u) * nloc) {
            __builtin_amdgcn_fence(__ATOMIC_RELEASE, "agent");
            asm volatile("s_waitcnt vmcnt(0)" ::: "memory");
            const unsigned og = xb_add(&bar[XB_TOP], 1u);
            const unsigned tg = og / nx;
            if (og + 1u == (tg + 1u) * nx) xb_add(&bar[XB_TOPGEN], 1u);
            else XB_SPIN(xb_ld(&bar[XB_TOPGEN]) == tg, bar);
            __builtin_amdgcn_fence(__ATOMIC_ACQUIRE, "agent");
            xb_add(&bar[XB_XGEN(b.x)], 1u);
            asm volatile("s_waitcnt vmcnt(0)" ::: "memory");
        } else {
            XB_SPIN(xb_ld(&bar[XB_XGEN(b.x)]) == gen, bar);
            __builtin_amdgcn_fence(__ATOMIC_ACQUIRE, "agent");
            asm volatile("s_waitcnt vmcnt(0)" ::: "memory");
        }
    }
    __syncthreads();
}

struct Args {
    const float* in[25]; float* out; unsigned char* ws; int ph_lo, ph_hi, ph_rep, pad_;
};
enum { I_X = 0, I_N1G, I_WIN, I_MU, I_QG, I_KG, I_RELB, I_W0, I_WDEC, I_A0, I_WAAA, I_WGATE, I_KK, I_KA, I_RK, I_LNG, I_LNB, I_WOUT, I_N2G, I_WR, I_BR, I_WUP, I_BUP, I_WDN, I_BDN };
struct Frame {
    LAS unsigned char* lds;
    int tid, lane, wave, G, bid;
};


struct TrRegs { f32x4 v[8]; f32x4 s0, s1; bf16* dst; int ldo; };
DI void tr_load(TrRegs& t, const float* __restrict__ W, int ldw, int k0, int n0, bf16* WT, int ldo, long drow, int lane, const float* __restrict__ ksc8 = nullptr) {
    const int r8 = lane >> 3, c4 = lane & 7;
    t.s0 = (f32x4){1.f, 1.f, 1.f, 1.f}; t.s1 = t.s0; if (ksc8) { t.s0 = *(const f32x4*)ksc8; t.s1 = *(const f32x4*)(ksc8 + 4); }
    const float* src = W + (size_t)(k0 + 8 * r8) * ldw + n0 + 4 * c4;
#pragma unroll
    for (int i = 0; i < 8; ++i) t.v[i] = __builtin_nontemporal_load((const f32x4*)(src + (size_t)i * ldw));
    t.dst = WT + (size_t)(drow + 4 * c4) * ldo + k0 + 8 * r8; t.ldo = ldo;
}
DI void tr_store(const TrRegs& t, const float* __restrict__ = nullptr) {
    const f32x4 s0 = t.s0, s1 = t.s1;
#pragma unroll
    for (int j = 0; j < 4; ++j) { const v4u o = {pk2(t.v[0][j] * s0[0], t.v[1][j] * s0[1]), pk2(t.v[2][j] * s0[2], t.v[3][j] * s0[3]), pk2(t.v[4][j] * s1[0], t.v[5][j] * s1[1]), pk2(t.v[6][j] * s1[2], t.v[7][j] * s1[3])};
        __builtin_nontemporal_store(o, (v4u*)(t.dst + (size_t)j * t.ldo)); }
}
DI void tr_item(const float* __restrict__ W, int ldw, int k0, int n0, bf16* WT, int ldo, long drow, LAS float* scr, int lane, const float* __restrict__ ksc) {
    (void)scr; TrRegs t; tr_load(t, W, ldw, k0, n0, WT, ldo, drow, lane, ksc ? ksc + k0 + 8 * (lane >> 3) : nullptr); tr_store(t);
}
constexpr int MOE_TR_UP = NEXP * 16 * 64, MOE_TR_DN = NEXP * 16 * 32, MOE_TR_ALL = MOE_TR_UP + MOE_TR_DN;
DI const float* moe_tr_load(TrRegs& t, const Args& a, int r, int lane) {
    unsigned char* ws = a.ws;
    if (r < MOE_TR_UP) { const int e = r / 1024, kb = (r % 1024) / 64, nb = r % 64, n0 = 32 * nb; const int n1 = n0 & 1023;
        const long drow = (long)(n1 / 128) * 256 + (n0 >= 1024 ? 128 : 0) + (n1 % 128);
        tr_load(t, a.in[I_WUP] + (size_t)e * 1024 * 2048, 2048, 64 * kb, n0, (bf16*)(ws + WS_WUP) + (size_t)e * 2048 * 1024, 1024, drow, lane, a.in[I_N2G] + 64 * kb + 8 * (lane >> 3));
        return nullptr; }
    r -= MOE_TR_UP; const int e = r / 512, kb = (r % 512) / 32, nb = r % 32;
    tr_load(t, a.in[I_WDN] + (size_t)e * 1024 * 1024, 1024, 64 * kb, 32 * nb, (bf16*)(ws + WS_WDN) + (size_t)e * 1024 * 1024, 1024, 32 * nb, lane);
    return nullptr;
}
DI void moe_tr_item(const Args& a, int r, LAS float* scr, int lane) { (void)scr; TrRegs t; const float* s = moe_tr_load(t, a, r, lane); tr_store(t, s); }
DI unsigned q_pack4(float a, float b, float c, float d) {
    const unsigned ua = __builtin_bit_cast(unsigned, a), ub = __builtin_bit_cast(unsigned, b), uc = __builtin_bit_cast(unsigned, c), ud = __builtin_bit_cast(unsigned, d);
    return (ua & 0xffu) | ((ub & 0xffu) << 8) | ((uc & 0xffu) << 16) | (ud << 24); }
constexpr float Q_MAGIC = 12582912.0f;
template <bool DOWN>
DI void moe_q_batch(const Args& a, int batch, int wave, int lane, LAS float* exch) {
    unsigned char* ws = a.ws;
    constexpr int LDW = DOWN ? 1024 : 2048, SPE = LDW / 32;
    constexpr float QMAX = DOWN ? 256.0f : 127.0f;
    asm volatile("" : "+v"(lane));
    const int r8 = lane >> 3, c4 = lane & 7;
    const float* gk = a.in[I_N2G] + 128 * wave + 8 * r8;
    const f32x4 one = {1.f, 1.f, 1.f, 1.f};
    f32x4 s0[2], s1[2];
#pragma unroll
    for (int t = 0; t < 2; ++t) { s0[t] = DOWN ? one : *(const f32x4*)(gk + 64 * t); s1[t] = DOWN ? one : *(const f32x4*)(gk + 64 * t + 4); }
    f32x4 v[2][2][8]; const int loff = 8 * r8 * LDW + 4 * c4;
#define MQ_LOAD(buf, s_) do { const int strip_ = batch * 4 + (s_), e_ = strip_ / SPE, n0_ = 32 * (strip_ % SPE); \
        const float* W_ = a.in[DOWN ? I_WDN : I_WUP] + (size_t)e_ * 1024 * LDW + (size_t)(128 * wave) * LDW + n0_;     \
        _Pragma("unroll") for (int t = 0; t < 2; ++t) _Pragma("unroll") for (int i = 0; i < 8; ++i) v[buf][t][i] = __builtin_nontemporal_load((const f32x4*)(W_ + (size_t)(64 * t + i) * LDW + loff)); } while (0)
    MQ_LOAD(0, 0);
#pragma unroll
    for (int s = 0; s < 4; ++s) {
        if (s < 3) MQ_LOAD((s + 1) & 1, s + 1);
        const int strip = batch * 4 + s, e = strip / SPE, n0 = 32 * (strip % SPE), n1 = n0 & 1023;
        const long drow = DOWN ? (long)n0 : (long)(n1 / 128) * 256 + (n0 >= 1024 ? 128 : 0) + (n1 % 128);
        f32x4 mx = {0.f, 0.f, 0.f, 0.f};
#pragma unroll
        for (int t = 0; t < 2; ++t)
#pragma unroll
            for (int i = 0; i < 8; ++i) { const float sc = i < 4 ? s0[t][i] : s1[t][i - 4]; const f32x4 p = v[s & 1][t][i] * sc; v[s & 1][t][i] = p;
#pragma unroll
                for (int j = 0; j < 4; ++j) mx[j] = fmaxf(mx[j], fabsf(p[j])); }
#pragma unroll
        for (int j = 0; j < 4; ++j) { float m = mx[j]; m = fmaxf(m, __shfl_xor(m, 8)); m = fmaxf(m, __shfl_xor(m, 16)); m = fmaxf(m, __shfl_xor(m, 32)); mx[j] = m; }
        LAS float* ex = exch + (s & 1) * 256;
        if (r8 == 0) *(LAS f32x4*)(ex + (wave * 8 + c4) * 4) = mx;
        __syncthreads();
#pragma unroll
        for (int w2 = 0; w2 < 8; ++w2) { const f32x4 o = *(const LAS f32x4*)(ex + (w2 * 8 + c4) * 4);
#pragma unroll
            for (int j = 0; j < 4; ++j) mx[j] = fmaxf(mx[j], o[j]); }
        if (wave == 0 && r8 == 0) *(f32x4*)((float*)(ws + (DOWN ? WS_COLSC2 : WS_COLSC)) + (size_t)e * LDW + n0 + 4 * c4) = mx * (1.0f / QMAX);
        f32x4 inv;
#pragma unroll
        for (int j = 0; j < 4; ++j) inv[j] = mx[j] > 0.f ? QMAX / mx[j] : 0.f;
        unsigned char* dst = ws + (DOWN ? WS_WDN : WS_WUP) + ((size_t)e * LDW + drow + 4 * c4) * 1024 + 128 * wave + 8 * r8;
#pragma unroll
        for (int t = 0; t < 2; ++t) {
            f32x4 (&p)[8] = v[s & 1][t];
#pragma unroll
            for (int i = 0; i < 8; ++i) p[i] = DOWN ? p[i] * inv : p[i] * inv + Q_MAGIC;
#pragma unroll
            for (int j = 0; j < 4; ++j) { v2u o;
                if (DOWN) { o.x = (unsigned)__builtin_amdgcn_cvt_pk_fp8_f32(p[2][j], p[3][j], __builtin_amdgcn_cvt_pk_fp8_f32(p[0][j], p[1][j], 0, false), true);
                            o.y = (unsigned)__builtin_amdgcn_cvt_pk_fp8_f32(p[6][j], p[7][j], __builtin_amdgcn_cvt_pk_fp8_f32(p[4][j], p[5][j], 0, false), true); }
                else { o.x = q_pack4(p[0][j], p[1][j], p[2][j], p[3][j]); o.y = q_pack4(p[4][j], p[5][j], p[6][j], p[7][j]); }
                __builtin_nontemporal_store(o, (v2u*)(dst + (size_t)j * 1024 + 64 * t)); } }
    }
#undef MQ_LOAD
}
DI void q_strip_i8_wg(const float* __restrict__ Wsrc, int ldw, int n0, unsigned char* WT, float* colsc, int wave, int lane, LAS float* exch) {
    const int r8 = lane >> 3, c4 = lane & 7;
    const float* W = Wsrc + (size_t)(128 * wave + 8 * r8) * ldw + n0 + 4 * c4;
    f32x4 v[2][8], mx = {0.f, 0.f, 0.f, 0.f};
#pragma unroll
    for (int t = 0; t < 2; ++t)
#pragma unroll
        for (int i = 0; i < 8; ++i) v[t][i] = *(const f32x4*)(W + (size_t)(64 * t + i) * ldw);
#pragma unroll
    for (int t = 0; t < 2; ++t)
#pragma unroll
        for (int i = 0; i < 8; ++i)
#pragma unroll
            for (int j = 0; j < 4; ++j) mx[j] = fmaxf(mx[j], fabsf(v[t][i][j]));
#pragma unroll
    for (int j = 0; j < 4; ++j) { float m = mx[j]; m = fmaxf(m, __shfl_xor(m, 8)); m = fmaxf(m, __shfl_xor(m, 16)); m = fmaxf(m, __shfl_xor(m, 32)); mx[j] = m; }
    if (r8 == 0) *(LAS f32x4*)(exch + (wave * 8 + c4) * 4) = mx;
    __syncthreads();
#pragma unroll
    for (int w2 = 0; w2 < 8; ++w2) { const f32x4 o = *(const LAS f32x4*)(exch + (w2 * 8 + c4) * 4);
#pragma unroll
        for (int j = 0; j < 4; ++j) mx[j] = fmaxf(mx[j], o[j]); }
    if (wave == 0 && r8 == 0) *(f32x4*)(colsc + n0 + 4 * c4) = mx * (1.0f / 127.0f);
    f32x4 inv;
#pragma unroll
    for (int j = 0; j < 4; ++j) inv[j] = mx[j] > 0.f ? 127.0f / mx[j] : 0.f;
    unsigned char* dst = WT + (size_t)(n0 + 4 * c4) * 1024 + 128 * wave + 8 * r8;
#pragma unroll
    for (int t = 0; t < 2; ++t) {
        f32x4 p[8];
#pragma unroll
        for (int i = 0; i < 8; ++i) p[i] = v[t][i] * inv + Q_MAGIC;
#pragma unroll
        for (int j = 0; j < 4; ++j) { const v2u o = {q_pack4(p[0][j], p[1][j], p[2][j], p[3][j]), q_pack4(p[4][j], p[5][j], p[6][j], p[7][j])};
            *(v2u*)(dst + (size_t)j * 1024 + 64 * t) = o; } }
}
DI void moe_tr_batch(const Args& a, int batch, int wave, int lane, LAS float* exch) {
    if (batch < MOE_TR_UP / 64) moe_q_batch<false>(a, batch, wave, lane, exch); else moe_q_batch<true>(a, batch - MOE_TR_UP / 64, wave, lane, exch);
}
constexpr int MOE_TR_BATCHES = MOE_TR_ALL / 64, MOE_TR_EARLY = 256;

#if !NAIVE_ATT
constexpr int ATT_KS = 144;
constexpr int ATT_TILE = 64 * ATT_KS;
constexpr int ATT_BIAS_OFF = 4 * ATT_TILE;
constexpr int ATT_NSLOT = (NBATCH * 8 * (NCHUNK / 2) / 8) * 11;
static_assert(NBATCH * 8 * (NCHUNK / 2) == 2048 && MOE_TR_ALL == 256 * 3 * 64, "attention / conversion work queue");
DI int att_pos(int key) { return (key & 32) + 8 * ((key >> 2) & 3) + 4 * ((key >> 4) & 1) + (key & 3); }
DI void attn_phase(const Frame& F, const Args& a, const int qid = 0) {
    const bf16* proj = (const bf16*)(a.ws + WS_PROJ); bf16* mix = (bf16*)(a.ws + WS_MIX);
    LAS unsigned char* lds = F.lds; LAS float* sbias = (LAS float*)(lds + ATT_BIAS_OFF);
    const int w = F.wave;
    const float LOG2E = 1.4426950408889634f;
    const int srow = F.tid >> 3, spc = F.tid & 7;
    float kgv[8];
#pragma unroll
    for (int j = 0; j < 8; ++j) kgv[j] = a.in[I_KG][8 * spc + j];
    const int spos = att_pos(srow);
    LAS int* s_item = (LAS int*)(lds + ATT_BIAS_OFF + 1024);
    unsigned* qhead = (unsigned*)(a.ws + WS_CTL) + CW_ATT + 64 * qid;
    for (;;) {
        __syncthreads();
        if (F.tid == 0) *s_item = (int)__hip_atomic_fetch_add(qhead, 1u, __ATOMIC_RELAXED, __HIP_MEMORY_SCOPE_AGENT);
        __syncthreads();
        const int slot = *s_item;
        if (slot >= ATT_NSLOT) break;
        const int grp = slot / 11, sub = slot % 11;
        if (sub >= 8) { const int base = (grp * 3 + (sub - 8)) * 64 + w * 8;
            (void)base; moe_tr_batch(a, grp * 3 + (sub - 8), w, F.lane, (LAS float*)(lds + ATT_BIAS_OFF + 2048));
            continue; }
        int l = F.lane; asm volatile("" : "+v"(l));
        const int n16 = l & 15, q = l >> 4;
        const int item = grp * 8 + sub;
        const int b = item / (8 * (NCHUNK / 2)), h = (item / (NCHUNK / 2)) & 7, n0 = 2 * (item % (NCHUNK / 2));
        if (F.tid < 192) sbias[F.tid] = a.in[I_RELB][h * 192 + F.tid] * LOG2E;
        const int nq = n0 + (w >> 2), qpos = 16 * (w & 3) + n16;
        const size_t qtok = (size_t)b * SEQ + nq * 64 + qpos;
        bf16x8 qf[2];
        { const v4u q0 = *(const v4u*)(proj + qtok * INC + h * 64 + 8 * q), q1 = *(const v4u*)(proj + qtok * INC + h * 64 + 32 + 8 * q);
          float f[16]; const unsigned ww[8] = {q0.x, q0.y, q0.z, q0.w, q1.x, q1.y, q1.z, q1.w};
          float ss = 0.f;
#pragma unroll
          for (int e = 0; e < 8; ++e) { f[2 * e] = bflo(ww[e]); f[2 * e + 1] = bfhi(ww[e]); ss += f[2 * e] * f[2 * e] + f[2 * e + 1] * f[2 * e + 1]; }
          ss = quad_sum(ss);
          const float rs = (1.0f / sqrtf(ss * (1.f / 64.f) + 1e-6f)) * 0.125f * LOG2E;
          unsigned pk[8];
#pragma unroll
          for (int e = 0; e < 8; ++e) { const int d = (e < 4 ? 0 : 32) + 8 * q + 2 * (e & 3); pk[e] = pk2(f[2 * e] * rs * a.in[I_QG][d], f[2 * e + 1] * rs * a.in[I_QG][d + 1]); }
          const v4u p0 = {pk[0], pk[1], pk[2], pk[3]}, p1 = {pk[4], pk[5], pk[6], pk[7]};
          qf[0] = __builtin_bit_cast(bf16x8, p0); qf[1] = __builtin_bit_cast(bf16x8, p1); }
        f32x4 o[4];
#pragma unroll
        for (int dt = 0; dt < 4; ++dt) o[dt] = (f32x4){0.f, 0.f, 0.f, 0.f};
        float m_run = -3.0e38f, l_run = 0.f;
        v4u kreg, vreg;
        auto gload = [&](int jc) { const int kc = n0 - 8 + jc; if (kc >= 0) { const size_t tok = (size_t)b * SEQ + kc * 64 + srow;
            kreg = *(const v4u*)(proj + tok * INC + 512 + h * 64 + 8 * spc); vreg = *(const v4u*)(proj + tok * INC + 1024 + h * 64 + 8 * spc); } };
        auto lstore = [&](int jc) { const int kc = n0 - 8 + jc; if (kc >= 0) { LAS unsigned char* kb = lds + (jc & 1) * 2 * ATT_TILE; LAS unsigned char* vb = kb + ATT_TILE;
            const unsigned ww[4] = {kreg.x, kreg.y, kreg.z, kreg.w}; float f[8]; float ss = 0.f;
#pragma unroll
            for (int e = 0; e < 4; ++e) { f[2 * e] = bflo(ww[e]); f[2 * e + 1] = bfhi(ww[e]); ss += f[2 * e] * f[2 * e] + f[2 * e + 1] * f[2 * e + 1]; }
            ss += __builtin_bit_cast(float, __builtin_amdgcn_update_dpp(0, __builtin_bit_cast(int, ss), 0xB1, 0xf, 0xf, true));
            ss += __builtin_bit_cast(float, __builtin_amdgcn_update_dpp(0, __builtin_bit_cast(int, ss), 0x4E, 0xf, 0xf, true));
            ss += __builtin_bit_cast(float, __builtin_amdgcn_update_dpp(0, __builtin_bit_cast(int, ss), 0x141, 0xf, 0xf, true));
            const float rs = 1.0f / sqrtf(ss * (1.f / 64.f) + 1e-6f);
            v4u kk; kk.x = pk2(f[0] * rs * kgv[0], f[1] * rs * kgv[1]); kk.y = pk2(f[2] * rs * kgv[2], f[3] * rs * kgv[3]); kk.z = pk2(f[4] * rs * kgv[4], f[5] * rs * kgv[5]); kk.w = pk2(f[6] * rs * kgv[6], f[7] * rs * kgv[7]);
            *(LAS v4u*)(kb + srow * ATT_KS + 16 * spc) = kk;
            const unsigned vv[4] = {vreg.x, vreg.y, vreg.z, vreg.w};
#pragma unroll
            for (int e = 0; e < 4; ++e) { *(LAS unsigned short*)(vb + (8 * spc + 2 * e) * ATT_KS + 2 * spos) = (unsigned short)(vv[e] & 0xffffu);
                                          *(LAS unsigned short*)(vb + (8 * spc + 2 * e + 1) * ATT_KS + 2 * spos) = (unsigned short)(vv[e] >> 16); } } };
        gload(0); lstore(0);
        __syncthreads();
        for (int jc = 0; jc < 10; ++jc) {
            if (jc + 1 < 10) gload(jc + 1);
            const int kc = n0 - 8 + jc, dj = jc - (w >> 2);
            if (kc >= 0 && dj >= 0 && dj <= 8) {
                const LAS unsigned char* kb = lds + (jc & 1) * 2 * ATT_TILE; const LAS unsigned char* vb = kb + ATT_TILE;
                f32x4 sc[4];
#pragma unroll
                for (int mt = 0; mt < 4; ++mt) { sc[mt] = (f32x4){0.f, 0.f, 0.f, 0.f};
#pragma unroll
                    for (int ks = 0; ks < 2; ++ks) { const bf16x8 kf = *(const LAS bf16x8*)(kb + (16 * mt + n16) * ATT_KS + 64 * ks + 16 * q);
                        sc[mt] = __builtin_amdgcn_mfma_f32_16x16x32_bf16(kf, qf[ks], sc[mt], 0, 0, 0); } }
                float boff = 0.f;
                if (dj <= 5) boff = sbias[0];
                else { const int base = (dj - 8) * 64 - qpos + 128;
#pragma unroll
                    for (int mt = 0; mt < 4; ++mt)
#pragma unroll
                        for (int i = 0; i < 4; ++i) { int idx = base + 16 * mt + 4 * q + i; idx = idx < 0 ? 0 : idx; const float bv_ = sbias[idx];
                            sc[mt][i] += bv_; } }
                float mx = sc[0][0];
#pragma unroll
                for (int mt = 0; mt < 4; ++mt)
#pragma unroll
                    for (int i = 0; i < 4; ++i) mx = fmaxf(mx, sc[mt][i]);
                mx = quad_max(mx);
                const float m_new = fmaxf(m_run, mx + boff), alpha = __builtin_amdgcn_exp2f(m_run - m_new), msub = m_new - boff;
                const bool moved = __builtin_amdgcn_ballot_w64(m_new != m_run) != 0ull;
                m_run = m_new; float ls = 0.f;
#pragma unroll
                for (int mt = 0; mt < 4; ++mt)
#pragma unroll
                    for (int i = 0; i < 4; ++i) { sc[mt][i] = __builtin_amdgcn_exp2f(sc[mt][i] - msub); ls += sc[mt][i]; }
                if (moved) { l_run *= alpha;
#pragma unroll
                    for (int dt = 0; dt < 4; ++dt) o[dt] = o[dt] * alpha; }
                l_run += ls;
#pragma unroll
                for (int s = 0; s < 2; ++s) {
                    const v4u pp = {pk2(sc[2 * s][0], sc[2 * s][1]), pk2(sc[2 * s][2], sc[2 * s][3]), pk2(sc[2 * s + 1][0], sc[2 * s + 1][1]), pk2(sc[2 * s + 1][2], sc[2 * s + 1][3])};
                    const bf16x8 pf = __builtin_bit_cast(bf16x8, pp);
#pragma unroll
                    for (int dt = 0; dt < 4; ++dt) { const bf16x8 vf = *(const LAS bf16x8*)(vb + (16 * dt + n16) * ATT_KS + 64 * s + 16 * q);
                        o[dt] = __builtin_amdgcn_mfma_f32_16x16x32_bf16(vf, pf, o[dt], 0, 0, 0); } }
            }
            if (jc + 1 < 10) lstore(jc + 1);
            __syncthreads();
        }
        l_run = quad_sum(l_run);
        const float inv = 1.0f / l_run;
#pragma unroll
        for (int dt = 0; dt < 4; ++dt) { v2u ov; ov.x = pk2(o[dt][0] * inv, o[dt][1] * inv); ov.y = pk2(o[dt][2] * inv, o[dt][3] * inv);
            *(v2u*)(mix + qtok * 1024 + h * 64 + 16 * dt + 4 * q) = ov; }
    }
}
#endif

#if !NAIVE_RWKV
constexpr int RA_HALF = 80896;
constexpr int RA_RT = 0, RA_KT = 9216, RA_BT = 18432, RA_AT = 27648;
constexpr int RA_VT = 36864, RA_KH = 46080, RA_BH = 55296;
constexpr int RA_AAB = 64512;
constexpr int RA_XWD = 0, RA_XAD = 9216, RA_XGD = 18432;
constexpr int RA_RHS2 = 0, RA_GEND = 17408;
constexpr int RA_W1T = 18432, RA_W2T = 27648;
constexpr int RA_WT = RA_AAB;
constexpr int RB_REC = 65536, RB_YLT = 0, RB_PCT = 8192, RB_G1T = 16384, RB_E2T = 24576, RB_MC = 32768, RB_CC = 40960, RB_SC = 57344;
static_assert(2 * RA_HALF <= MISC_OFF, "rwkv phase A LDS");

DI void ld8f(const bf16* p, float (&f)[8]) { const v4u w = *(const v4u*)p; f[0] = bflo(w.x); f[1] = bfhi(w.x); f[2] = bflo(w.y); f[3] = bfhi(w.y); f[4] = bflo(w.z); f[5] = bfhi(w.z); f[6] = bflo(w.w); f[7] = bfhi(w.w); }
DI void ld4f(const bf16* p, float (&f)[4]) { const v2u w = *(const v2u*)p; f[0] = bflo(w.x); f[1] = bfhi(w.x); f[2] = bflo(w.y); f[3] = bfhi(w.y); }
DI bf16x8 pack8(const f32x4& a, const f32x4& b) { const v4u p = {pk2(a[0], a[1]), pk2(a[2], a[3]), pk2(b[0], b[1]), pk2(b[2], b[3])}; return __builtin_bit_cast(bf16x8, p); }
DI float fast_sigmoid(float x) { return __builtin_amdgcn_rcpf(1.0f + __builtin_amdgcn_exp2f(-1.4426950408889634f * x)); }
DI float fast_tanh(float x) { return 1.0f - 2.0f * __builtin_amdgcn_rcpf(1.0f + __builtin_amdgcn_exp2f(2.8853900817779268f * x)); }
#define MFMA16(a, b, c) __builtin_amdgcn_mfma_f32_16x16x32_bf16((a), (b), (c), 0, 0, 0)

DI void rwkv_phase_a(const Frame& F, const Args& a) {
    unsigned char* ws = a.ws; unsigned char* rb = ws + WS_RW;
    const bf16* wdec = (const bf16*)(ws + WS_WDEC); const bf16* waaa = (const bf16*)(ws + WS_WAAA); const bf16* wgate = (const bf16*)(ws + WS_WGATE);
    const float* mu = a.in[I_MU]; const float* par = (const float*)(ws + WS_PAR);
    const int hb = F.wave >> 2, w4 = F.wave & 3;
    LAS unsigned char* hbase = F.lds + hb * RA_HALF;
    const float LOG2E = 1.4426950408889634f;
    v4u s0c[4];
#define RA_REQUEST(pair_) do { const int item_ = 2 * (pair_) + hb, c_ = (item_ >> 3) & 127, b_ = item_ >> 10; const size_t tok0_ = (size_t)b_ * SEQ + c_ * 64; \
        int lq_ = F.lane; asm volatile("" : "+v"(lq_)); size_t wsq_ = (size_t)ws; asm volatile("" : "+s"(wsq_)); const int t9q_ = (hb << 8) | (w4 << 6) | lq_; \
        const bf16* cur_ = (const bf16*)(wsq_ + WS_PROJ) + (tok0_ + (t9q_ >> 3)) * INC + PRW + 1536 + 32 * (t9q_ & 7); \
        _Pragma("unroll") for (int g8 = 0; g8 < 4; ++g8) s0c[g8] = *(const v4u*)(cur_ + 8 * g8); } while (0)
    if (F.bid < NITEM / 2) RA_REQUEST(F.bid);
    for (int pair = F.bid; pair < NITEM / 2; pair += F.G) {
        size_t wsb = (size_t)ws; asm volatile("" : "+s"(wsb)); const bf16* proj = (const bf16*)(wsb + WS_PROJ);
        int l = F.lane; asm volatile("" : "+v"(l));
        const int n16 = l & 15, q = l >> 4, t4 = (hb << 8 | (F.wave & 3) << 6 | l) & 255;
        const int tokl = 16 * w4 + n16;
        const int tslot = (tokl & 32) + 8 * ((tokl >> 2) & 3) + 4 * ((tokl >> 4) & 1) + (tokl & 3);
        const int item = 2 * pair + hb, h = item & 7, c = (item >> 3) & 127, b = item >> 10;
        const size_t tok0 = (size_t)b * SEQ + c * 64; unsigned char* rbi = rb + (size_t)item * RB_REC;
        const int t9 = (hb << 8) | t4, tk0 = t9 >> 3, part = t9 & 7;
        v4u s0p[4];
        { const bool first = (c == 0 && tk0 == 0); const bf16* prv = proj + (tok0 + tk0) * INC + PRW + 1536 + 32 * part - INC;
#pragma unroll
          for (int g8 = 0; g8 < 4; ++g8) { s0p[g8] = (v4u){0u, 0u, 0u, 0u}; if (!first) s0p[g8] = *(const v4u*)(prv + 8 * g8); } }
        v2u rawc[3][4], rawp[3][4];
        { const bool first = (c == 0 && tokl == 0); const bf16* cur = proj + (tok0 + tokl) * INC + PRW + h * 64 + 4 * q; const bf16* prv = cur - INC;
#pragma unroll
          for (int m = 0; m < 3; ++m)
#pragma unroll
              for (int ct = 0; ct < 4; ++ct) { rawc[m][ct] = *(const v2u*)(cur + 512 * m + 16 * ct); rawp[m][ct] = (v2u){0u, 0u}; if (!first) rawp[m][ct] = *(const v2u*)(prv + 512 * m + 16 * ct); } }
        bf16x8 wfr[2][8];
#define RA_WLOAD(dst, ctv) do { const int row_ = h * 64 + 16 * (ctv) + n16; \
            dst[0] = *(const bf16x8*)(wdec + row_ * 64 + 8 * q); dst[1] = *(const bf16x8*)(wdec + row_ * 64 + 32 + 8 * q); \
            dst[2] = *(const bf16x8*)(waaa + row_ * 64 + 8 * q); dst[3] = *(const bf16x8*)(waaa + row_ * 64 + 32 + 8 * q); \
            _Pragma("unroll") for (int ks_ = 0; ks_ < 4; ++ks_) dst[4 + ks_] = *(const bf16x8*)(wgate + row_ * 128 + 32 * ks_ + 8 * q); } while (0)
        RA_WLOAD(wfr[0], 0); RA_WLOAD(wfr[1], 1);
        __syncthreads();
        { const float esc = part < 2 ? 2.8853900817779268f : -1.4426950408889634f;
          LAS unsigned char* dst = F.lds + (part < 2 ? RA_XWD + tk0 * 144 + part * 64 : (part < 4 ? RA_XAD + tk0 * 144 + (part - 2) * 64 : RA_XGD + tk0 * 272 + (part - 4) * 64));
#pragma unroll
          for (int g8 = 0; g8 < 4; ++g8) {
              const unsigned xw[4] = {s0c[g8].x, s0c[g8].y, s0c[g8].z, s0c[g8].w}, pw[4] = {s0p[g8].x, s0p[g8].y, s0p[g8].z, s0p[g8].w};
              const f32x4 m0 = *(const f32x4*)(mu + 1536 + 32 * part + 8 * g8), m1 = *(const f32x4*)(mu + 1536 + 32 * part + 8 * g8 + 4);
              float y[8];
#pragma unroll
              for (int j = 0; j < 8; ++j) { const float x = (j & 1) ? bfhi(xw[j >> 1]) : bflo(xw[j >> 1]), p = (j & 1) ? bfhi(pw[j >> 1]) : bflo(pw[j >> 1]);
                  const float xs = x + (p - x) * (j < 4 ? m0[j & 3] : m1[j & 3]);
                  const float rc = __builtin_amdgcn_rcpf(1.0f + __builtin_amdgcn_exp2f(esc * xs));
                  y[j] = part < 2 ? 1.0f - 2.0f * rc : (part < 4 ? xs : rc); }
              const v4u o = {pk2(y[0], y[1]), pk2(y[2], y[3]), pk2(y[4], y[5]), pk2(y[6], y[7])};
              *(LAS v4u*)(dst + 16 * g8) = o; } }
        v2u shv[3][4];
#pragma unroll
        for (int m = 0; m < 3; ++m)
#pragma unroll
            for (int ct = 0; ct < 4; ++ct) { const v2u xw = rawc[m][ct], pw = rawp[m][ct];
                const f32x4 mm = *(const f32x4*)(mu + 512 * m + h * 64 + 16 * ct + 4 * q);
                const float x0 = bflo(xw.x), x1 = bfhi(xw.x), x2 = bflo(xw.y), x3 = bfhi(xw.y);
                shv[m][ct].x = pk2(x0 + (bflo(pw.x) - x0) * mm[0], x1 + (bfhi(pw.x) - x1) * mm[1]); shv[m][ct].y = pk2(x2 + (bflo(pw.y) - x2) * mm[2], x3 + (bfhi(pw.y) - x3) * mm[3]); }
        __syncthreads();
        f32x4 awl[4], aal[4], ag[4];
        { bf16x8 bwd[2], bad[2], bgd[4], wf2[2][8];
          RA_WLOAD(wf2[0], 2); RA_WLOAD(wf2[1], 3);
#pragma unroll
          for (int ks = 0; ks < 2; ++ks) { bwd[ks] = *(const LAS bf16x8*)(F.lds + RA_XWD + tokl * 144 + 64 * ks + 16 * q); bad[ks] = *(const LAS bf16x8*)(F.lds + RA_XAD + tokl * 144 + 64 * ks + 16 * q); }
#pragma unroll
          for (int ks = 0; ks < 4; ++ks) bgd[ks] = *(const LAS bf16x8*)(F.lds + RA_XGD + tokl * 272 + 64 * ks + 16 * q);
#pragma unroll
          for (int ct = 0; ct < 4; ++ct) { const bf16x8* wv = ct < 2 ? wfr[ct] : wf2[ct - 2];
              awl[ct] = (f32x4){0.f, 0.f, 0.f, 0.f}; aal[ct] = awl[ct]; ag[ct] = awl[ct];
#pragma unroll
              for (int ks = 0; ks < 2; ++ks) { awl[ct] = MFMA16(wv[ks], bwd[ks], awl[ct]); aal[ct] = MFMA16(wv[2 + ks], bad[ks], aal[ct]); }
#pragma unroll
              for (int ks = 0; ks < 4; ++ks) ag[ct] = MFMA16(wv[4 + ks], bgd[ks], ag[ct]); } }
#undef RA_WLOAD
        v2u rtp[4];
        {
#define RA_SHIFT(dst, pcol, ctv) do { const v2u w_ = shv[(pcol) / 512][ctv]; dst[0] = bflo(w_.x); dst[1] = bfhi(w_.x); dst[2] = bflo(w_.y); dst[3] = bfhi(w_.y); } while (0)
          float nrm = 0.f, bd = 0.f;
#pragma unroll
          for (int ct = 0; ct < 4; ++ct) { const int ch = h * 64 + 16 * ct + 4 * q;
              float r4[4], k4[4]; RA_SHIFT(r4, 0, ct); RA_SHIFT(k4, 512, ct);
              const f32x4 a0v = *(const f32x4*)(par + 512 + ch), kkv = *(const f32x4*)(par + 1024 + ch), kav = *(const f32x4*)(par + 1536 + ch), rkv = *(const f32x4*)(par + 2048 + ch);
#pragma unroll
              for (int i = 0; i < 4; ++i) { const float av = fast_sigmoid(a0v[i] + aal[ct][i]); const float kk = k4[i] * kkv[i]; nrm += kk * kk;
                  bd += r4[i] * (k4[i] * (1.0f + (av - 1.0f) * kav[i])) * rkv[i]; } }
          nrm = quad_sum(nrm); bd = quad_sum(bd);
          const float kinv = 1.0f / fmaxf(sqrtf(nrm), 1e-12f);
          float lw[4][4], lg[4][4], lgend[4][4];
#pragma unroll
          for (int ct = 0; ct < 4; ++ct) { const f32x4 w0v = *(const f32x4*)(par + h * 64 + 16 * ct + 4 * q);
#pragma unroll
              for (int i = 0; i < 4; ++i) { lw[ct][i] = (-0.6065306597126334f * LOG2E) * fast_sigmoid(w0v[i] + awl[ct][i]); float x = lw[ct][i];
                  x += __builtin_bit_cast(float, __builtin_amdgcn_update_dpp(0, __builtin_bit_cast(int, x), 0x111, 0xf, 0xf, false));
                  x += __builtin_bit_cast(float, __builtin_amdgcn_update_dpp(0, __builtin_bit_cast(int, x), 0x112, 0xf, 0xf, false));
                  x += __builtin_bit_cast(float, __builtin_amdgcn_update_dpp(0, __builtin_bit_cast(int, x), 0x114, 0xf, 0xf, false));
                  x += __builtin_bit_cast(float, __builtin_amdgcn_update_dpp(0, __builtin_bit_cast(int, x), 0x118, 0xf, 0xf, false));
                  lg[ct][i] = x; } }
          LAS float* wt = (LAS float*)(hbase + RA_WT);
          if (n16 == 15) {
#pragma unroll
              for (int ct = 0; ct < 4; ++ct) *(LAS f32x4*)(wt + w4 * 64 + 16 * ct + 4 * q) = (f32x4){lg[ct][0], lg[ct][1], lg[ct][2], lg[ct][3]}; }
          __syncthreads();
#pragma unroll
          for (int ct = 0; ct < 4; ++ct) { f32x4 off = {0.f, 0.f, 0.f, 0.f}, tot = {0.f, 0.f, 0.f, 0.f};
#pragma unroll
              for (int w = 0; w < 4; ++w) { const f32x4 t = *(const LAS f32x4*)(wt + w * 64 + 16 * ct + 4 * q); tot = tot + t; if (w < w4) off = off + t; }
#pragma unroll
              for (int i = 0; i < 4; ++i) { lg[ct][i] += off[i]; lgend[ct][i] = tot[i]; } }
#pragma unroll
          for (int ct = 0; ct < 4; ++ct) { const int ch = h * 64 + 16 * ct + 4 * q;
              float r4[4], k4[4], v4[4]; RA_SHIFT(r4, 0, ct); RA_SHIFT(k4, 512, ct); RA_SHIFT(v4, 1024, ct);
              const f32x4 a0v = *(const f32x4*)(par + 512 + ch), kkv = *(const f32x4*)(par + 1024 + ch), kav = *(const f32x4*)(par + 1536 + ch);
              const f32x4 lg_ = *(const f32x4*)(par + 2560 + ch), lb_ = *(const f32x4*)(par + 3072 + ch);
              float rtl[4], ktl[4], btl[4], atl[4], khh[4], bhh[4], g1[4], e2[4];
#pragma unroll
              for (int i = 0; i < 4; ++i) {
                  const float av = fast_sigmoid(a0v[i] + aal[ct][i]); const float k2 = k4[i] * (1.0f + (av - 1.0f) * kav[i]);
                  const float kkn = k4[i] * kkv[i] * kinv, bb = kkn * av;
                  const float gam = __builtin_amdgcn_exp2f(lg[ct][i]), gpv = __builtin_amdgcn_exp2f(lg[ct][i] - lw[ct][i]), gin = __builtin_amdgcn_exp2f(-lg[ct][i]), ger = __builtin_amdgcn_exp2f(lgend[ct][i] - lg[ct][i]);
                  rtl[i] = r4[i] * gam; ktl[i] = k2 * gin; btl[i] = bb * gin; atl[i] = -kkn * gpv; khh[i] = k2 * ger; bhh[i] = bb * ger;
                  const float g = ag[ct][i]; g1[i] = lg_[i] * g; e2[i] = (lb_[i] + bd * v4[i]) * g;
              }
              const int fo = ((w4 * 4 + ct) * 64 + l) * 8;
              v2u o; o.x = pk2(g1[0], g1[1]); o.y = pk2(g1[2], g1[3]); __builtin_nontemporal_store(o, (v2u*)(rbi + RB_G1T + fo));
              o.x = pk2(e2[0], e2[1]); o.y = pk2(e2[2], e2[3]); __builtin_nontemporal_store(o, (v2u*)(rbi + RB_E2T + fo));
              const int co = tokl * 144 + (16 * ct + 4 * q) * 2;
              o.x = pk2(rtl[0], rtl[1]); o.y = pk2(rtl[2], rtl[3]); *(LAS v2u*)(hbase + RA_RT + co) = o; rtp[ct] = o;
              o.x = pk2(ktl[0], ktl[1]); o.y = pk2(ktl[2], ktl[3]); *(LAS v2u*)(hbase + RA_KT + co) = o;
              o.x = pk2(btl[0], btl[1]); o.y = pk2(btl[2], btl[3]); *(LAS v2u*)(hbase + RA_BT + co) = o;
              o.x = pk2(atl[0], atl[1]); o.y = pk2(atl[2], atl[3]); *(LAS v2u*)(hbase + RA_AT + co) = o;
#pragma unroll
              for (int i = 0; i < 4; ++i) { const int ro = (16 * ct + 4 * q + i) * 144 + 2 * tslot;
                  if (tokl == 0) *(LAS float*)(hbase + RA_VT + (16 * ct + 4 * q + i) * 144 + 128) = __builtin_amdgcn_exp2f(lgend[ct][i]);
                  *(LAS unsigned short*)(hbase + RA_VT + ro) = (unsigned short)(pk2(v4[i], 0.f) & 0xffffu);
                  *(LAS unsigned short*)(hbase + RA_KH + ro) = (unsigned short)(pk2(khh[i], 0.f) & 0xffffu);
                  *(LAS unsigned short*)(hbase + RA_BH + ro) = (unsigned short)(pk2(bhh[i], 0.f) & 0xffffu); }
              asm volatile("" ::: "memory");
          }
#undef RA_SHIFT
        }
        __syncthreads();
        bf16x8 akp[2], rkp[2], rbp[2];
        { bf16x8 fa[2], fr[2];
#pragma unroll
          for (int ks = 0; ks < 2; ++ks) { fa[ks] = *(const LAS bf16x8*)(hbase + RA_AT + tokl * 144 + 64 * ks + 16 * q); fr[ks] = *(const LAS bf16x8*)(hbase + RA_RT + tokl * 144 + 64 * ks + 16 * q); }
          f32x4 aak[4], arkk[4], arb[4];
#pragma unroll
          for (int jt = 0; jt < 4; ++jt) {
              f32x4 tab = {0.f, 0.f, 0.f, 0.f}; aak[jt] = tab; arkk[jt] = tab; arb[jt] = tab;
              if (jt <= w4) {
#pragma unroll
                  for (int ks = 0; ks < 2; ++ks) { const bf16x8 fk = *(const LAS bf16x8*)(hbase + RA_KT + (16 * jt + n16) * 144 + 64 * ks + 16 * q), fb = *(const LAS bf16x8*)(hbase + RA_BT + (16 * jt + n16) * 144 + 64 * ks + 16 * q);
                      aak[jt] = MFMA16(fk, fa[ks], aak[jt]); tab = MFMA16(fb, fa[ks], tab); arkk[jt] = MFMA16(fk, fr[ks], arkk[jt]); arb[jt] = MFMA16(fb, fr[ks], arb[jt]); }
                  if (jt == w4) {
#pragma unroll
                      for (int i = 0; i < 4; ++i) { const int j = 4 * q + i; if (j >= n16) { aak[jt][i] = 0.f; tab[i] = 0.f; } if (j > n16) { arkk[jt][i] = 0.f; arb[jt][i] = 0.f; } } }
                  *(LAS f32x4*)(hbase + RA_AAB + tokl * 256 + (16 * jt + 4 * q) * 4) = tab;
              }
          }
#pragma unroll
          for (int s = 0; s < 2; ++s) { akp[s] = pack8(aak[2 * s], aak[2 * s + 1]); rkp[s] = pack8(arkk[2 * s], arkk[2 * s + 1]); rbp[s] = pack8(arb[2 * s], arb[2 * s + 1]); } }
        { f32x4 akv[4];
#pragma unroll
          for (int vt = 0; vt < 4; ++vt) { akv[vt] = (f32x4){0.f, 0.f, 0.f, 0.f};
#pragma unroll
              for (int s = 0; s < 2; ++s) { const bf16x8 fv = *(const LAS bf16x8*)(hbase + RA_VT + (16 * vt + n16) * 144 + 64 * s + 16 * q); akv[vt] = MFMA16(akp[s], fv, akv[vt]); } }
          __syncthreads();
#pragma unroll
          for (int vt = 0; vt < 4; ++vt) *(LAS f32x4*)(hbase + RA_RHS2 + (16 * vt + n16) * 272 + (16 * w4 + 4 * q) * 4) = akv[vt]; }
        if (pair + F.G < NITEM / 2) RA_REQUEST(pair + F.G);
        { const LAS unsigned char* aab = hbase + RA_AAB + (16 * w4) * 256 + (16 * w4) * 4;
          LAS unsigned char* ti = hbase + RA_BT;
          if (q == 0) { float t[16];
#pragma unroll
              for (int r_ = 0; r_ < 16; ++r_) { float acc = (r_ == n16) ? 1.0f : 0.0f;
#pragma unroll
                  for (int j4 = 0; j4 < (r_ + 3) / 4; ++j4) { const f32x4 av = *(const LAS f32x4*)(aab + r_ * 256 + j4 * 16);
#pragma unroll
                      for (int e = 0; e < 4; ++e) if (4 * j4 + e < r_) acc += av[e] * t[4 * j4 + e]; }
                  t[r_] = acc; *(LAS unsigned short*)(ti + w4 * 512 + r_ * 32 + 2 * n16) = (unsigned short)(pk2(acc, 0.f) & 0xffffu); } }
          __syncthreads();
          bf16x8 a10, a20, a30, a31, tf[4];
          { const LAS unsigned char* ab = hbase + RA_AAB + n16 * 256 + 16 * q; const f32x4 z4 = {0.f, 0.f, 0.f, 0.f};
            const f32x4 l10 = *(const LAS f32x4*)(ab + 16 * 256), l20 = *(const LAS f32x4*)(ab + 32 * 256), l21 = *(const LAS f32x4*)(ab + 32 * 256 + 64);
            const f32x4 l30 = *(const LAS f32x4*)(ab + 48 * 256), l31 = *(const LAS f32x4*)(ab + 48 * 256 + 64), l32 = *(const LAS f32x4*)(ab + 48 * 256 + 128);
            a10 = pack8(l10, z4); a20 = pack8(l20, l21); a30 = pack8(l30, l31); a31 = pack8(l32, z4);
#pragma unroll
            for (int I = 0; I < 4; ++I) { const v2u tw = *(const LAS v2u*)(ti + I * 512 + n16 * 32 + 8 * q); const v4u t4 = {tw.x, tw.y, 0u, 0u}; tf[I] = __builtin_bit_cast(bf16x8, t4); } }
          v4u xw[2][2];
#pragma unroll
          for (int m = 0; m < 2; ++m) {
              v4u x0 = {0u, 0u, 0u, 0u}, x1 = {0u, 0u, 0u, 0u};
#pragma unroll
              for (int I = 0; I < 4; ++I) {
                  f32x4 z;
                  if (m == 0) {
#pragma unroll
                      for (int i = 0; i < 4; ++i) z[i] = bf2f(*(const LAS unsigned short*)(hbase + RA_AT + (16 * I + 4 * q + i) * 144 + 2 * tokl)); }
                  else z = *(const LAS f32x4*)(hbase + RA_RHS2 + tokl * 272 + (16 * I + 4 * q) * 4);
                  if (I == 1) z = MFMA16(a10, __builtin_bit_cast(bf16x8, x0), z);
                  if (I == 2) z = MFMA16(a20, __builtin_bit_cast(bf16x8, x0), z);
                  if (I == 3) { z = MFMA16(a30, __builtin_bit_cast(bf16x8, x0), z); z = MFMA16(a31, __builtin_bit_cast(bf16x8, x1), z); }
                  const v4u zb = {pk2(z[0], z[1]), pk2(z[2], z[3]), 0u, 0u};
                  const f32x4 x = MFMA16(tf[I], __builtin_bit_cast(bf16x8, zb), ((f32x4){0.f, 0.f, 0.f, 0.f}));
                  const unsigned p0 = pk2(x[0], x[1]), p1 = pk2(x[2], x[3]);
                  if (I == 0) { x0.x = p0; x0.y = p1; } if (I == 1) { x0.z = p0; x0.w = p1; } if (I == 2) { x1.x = p0; x1.y = p1; } if (I == 3) { x1.z = p0; x1.w = p1; }
              }
              xw[m][0] = x0; xw[m][1] = x1;
          }
          __syncthreads();
#pragma unroll
          for (int s = 0; s < 2; ++s) { *(LAS v4u*)(hbase + RA_W1T + tokl * 144 + 64 * s + 16 * q) = xw[0][s]; *(LAS v4u*)(hbase + RA_W2T + tokl * 144 + 64 * s + 16 * q) = xw[1][s]; }
        }
        __syncthreads();
        {
          f32x4 pc[4], y0[4];
#pragma unroll
          for (int t = 0; t < 4; ++t) { pc[t] = (f32x4){bflo(rtp[t].x), bfhi(rtp[t].x), bflo(rtp[t].y), bfhi(rtp[t].y)}; y0[t] = (f32x4){0.f, 0.f, 0.f, 0.f};
#pragma unroll
              for (int s = 0; s < 2; ++s) { y0[t] = MFMA16(*(const LAS bf16x8*)(hbase + RA_VT + (16 * t + n16) * 144 + 64 * s + 16 * q), rkp[s], y0[t]);
                                            y0[t] = MFMA16(*(const LAS bf16x8*)(hbase + RA_W2T + (16 * t + n16) * 144 + 64 * s + 16 * q), rbp[s], y0[t]);
                                            pc[t] = MFMA16(*(const LAS bf16x8*)(hbase + RA_W1T + (16 * t + n16) * 144 + 64 * s + 16 * q), rbp[s], pc[t]); } }
#pragma unroll
          for (int vt = 0; vt < 4; ++vt) { v2u o; o.x = pk2(y0[vt][0], y0[vt][1]); o.y = pk2(y0[vt][2], y0[vt][3]); __builtin_nontemporal_store(o, (v2u*)(rbi + RB_YLT + ((w4 * 4 + vt) * 64 + l) * 8)); }
#pragma unroll
          for (int s = 0; s < 2; ++s) __builtin_nontemporal_store(pack8(pc[2 * s], pc[2 * s + 1]), (bf16x8*)(rbi + RB_PCT + ((w4 * 2 + s) * 64 + l) * 16));
          f32x4 mc[4]; bf16x8 fb[2], fvv[2];
#pragma unroll
          for (int s = 0; s < 2; ++s) { fb[s] = *(const LAS bf16x8*)(hbase + RA_BH + tokl * 144 + 64 * s + 16 * q); fvv[s] = *(const LAS bf16x8*)(hbase + RA_VT + tokl * 144 + 64 * s + 16 * q); }
          const float gend_k = *(const LAS float*)(hbase + RA_VT + tokl * 144 + 128);
#pragma unroll
          for (int t = 0; t < 4; ++t) { mc[t] = (f32x4){0.f, 0.f, 0.f, 0.f};
#pragma unroll
              for (int s = 0; s < 2; ++s) mc[t] = MFMA16(*(const LAS bf16x8*)(hbase + RA_W1T + (16 * t + n16) * 144 + 64 * s + 16 * q), fb[s], mc[t]);
              if (t == w4) {
#pragma unroll
                  for (int i = 0; i < 4; ++i) if (4 * q + i == n16) mc[t][i] += gend_k; } }
#pragma unroll
          for (int s = 0; s < 2; ++s) __builtin_nontemporal_store(pack8(mc[2 * s], mc[2 * s + 1]), (bf16x8*)(rbi + RB_MC + ((w4 * 2 + s) * 64 + l) * 16));
          bf16x8 fw2[2];
#pragma unroll
          for (int s = 0; s < 2; ++s) fw2[s] = *(const LAS bf16x8*)(hbase + RA_W2T + tokl * 144 + 64 * s + 16 * q);
#pragma unroll
          for (int kt = 0; kt < 4; ++kt) { f32x4 cc = {0.f, 0.f, 0.f, 0.f};
#pragma unroll
              for (int s = 0; s < 2; ++s) { cc = MFMA16(*(const LAS bf16x8*)(hbase + RA_KH + (16 * kt + n16) * 144 + 64 * s + 16 * q), fvv[s], cc);
                                            cc = MFMA16(*(const LAS bf16x8*)(hbase + RA_BH + (16 * kt + n16) * 144 + 64 * s + 16 * q), fw2[s], cc); }
              v2u cw; cw.x = pk2(cc[0], cc[1]); cw.y = pk2(cc[2], cc[3]); __builtin_nontemporal_store(cw, (v2u*)(rbi + RB_CC + ((w4 * 4 + kt) * 64 + l) * 8)); } }
    }
}

constexpr int RBK_NS = 9, RBK_D = 8, RBK_SLOT = 16384, RBK_BLOCKS = 32;
static_assert(RBK_NS * RBK_SLOT <= MISC_OFF && RBK_D == RBK_NS - 1, "phase B ring");
DI void rwkv_phase_b(const Frame& F, const Args& a) {
    if (F.bid >= RBK_BLOCKS) return;
    unsigned char* rb = a.ws + WS_RW; const int l = F.lane, w = F.wave;
    const int h = F.bid & 7, b = F.bid >> 3;
    LAS unsigned char* lds = F.lds;
    if (w >= 4) {
        const int j = w - 4;
#define RBK_ISSUE(cc_) do { const int c_ = (cc_) < NCHUNK ? (cc_) : NCHUNK - 1; const unsigned char* r_ = rb + (size_t)(((b * 128 + c_) << 3) + h) * RB_REC; \
            LAS unsigned char* slot_ = lds + ((cc_) % RBK_NS) * RBK_SLOT; \
            _Pragma("unroll") for (int k_ = 0; k_ < 4; ++k_) { const int blk_ = 4 * j + k_; \
                const unsigned char* src_ = blk_ < 8 ? r_ + RB_MC + blk_ * 1024 : r_ + RB_CC + (blk_ - 8) * 1024; \
                __builtin_amdgcn_global_load_lds((const unsigned*)(src_ + l * 16), (LAS unsigned*)(slot_ + blk_ * 1024), 16, 0, 0); } } while (0)
        for (int c = 0; c < RBK_D; ++c) RBK_ISSUE(c);
        for (int c = 0; c < NCHUNK; ++c) {
            asm volatile("s_waitcnt vmcnt(28)" ::: "memory");
            __builtin_amdgcn_s_barrier();
            RBK_ISSUE(c + RBK_D);
        }
        asm volatile("s_waitcnt vmcnt(0)" ::: "memory");
        __builtin_amdgcn_s_barrier();
#undef RBK_ISSUE
    } else {
        const int vs = w;
        f32x4 st[4];
#pragma unroll
        for (int kt = 0; kt < 4; ++kt) st[kt] = (f32x4){0.f, 0.f, 0.f, 0.f};
        for (int c = 0; c < NCHUNK; ++c) {
            unsigned char* rbi = rb + (size_t)(((b * 128 + c) << 3) + h) * RB_REC;
            bf16x8 sb[2];
#pragma unroll
            for (int s = 0; s < 2; ++s) { sb[s] = pack8(st[2 * s], st[2 * s + 1]); *(bf16x8*)(rbi + RB_SC + ((vs * 2 + s) * 64 + l) * 16) = sb[s]; }
            __builtin_amdgcn_s_barrier();
            const LAS unsigned char* slot = lds + (c % RBK_NS) * RBK_SLOT;
#pragma unroll
            for (int kt = 0; kt < 4; ++kt) { const v2u cw = *(const LAS v2u*)(slot + 8192 + ((vs * 4 + kt) * 64 + l) * 8);
                f32x4 n = {bflo(cw.x), bfhi(cw.x), bflo(cw.y), bfhi(cw.y)};
#pragma unroll
                for (int s = 0; s < 2; ++s) n = MFMA16(*(const LAS bf16x8*)(slot + ((kt * 2 + s) * 64 + l) * 16), sb[s], n);
                st[kt] = n; }
        }
        __builtin_amdgcn_s_barrier();
    }
}

struct RcOps { bf16x8 pc[2]; v2u yl[4]; bf16x8 sc[4][2]; v2u g1[4], e2[4]; };
DI void rc_load(RcOps& o, const unsigned char* rb, int task, int l) {
    const int item = task >> 2, it = task & 3; const unsigned char* rbi = rb + (size_t)item * RB_REC;
#pragma unroll
    for (int s = 0; s < 2; ++s) o.pc[s] = __builtin_nontemporal_load((const bf16x8*)(rbi + RB_PCT + ((it * 2 + s) * 64 + l) * 16));
#pragma unroll
    for (int vt = 0; vt < 4; ++vt) { const int fo = ((it * 4 + vt) * 64 + l) * 8;
        o.yl[vt] = __builtin_nontemporal_load((const v2u*)(rbi + RB_YLT + fo)); o.g1[vt] = __builtin_nontemporal_load((const v2u*)(rbi + RB_G1T + fo)); o.e2[vt] = __builtin_nontemporal_load((const v2u*)(rbi + RB_E2T + fo));
#pragma unroll
        for (int s = 0; s < 2; ++s) o.sc[vt][s] = __builtin_nontemporal_load((const bf16x8*)(rbi + RB_SC + ((vt * 2 + s) * 64 + l) * 16)); }
}
DI void rwkv_phase_c(const Frame& F, const Args& a) {
    const unsigned char* rb = a.ws + WS_RW; bf16* mix = (bf16*)(a.ws + WS_MIX);
    const int l = F.lane, n16 = l & 15, q = l >> 4;
    const int gw = F.bid * NWAVES + F.wave, NGW = F.G * NWAVES;
    RcOps cur, nxt;
    if (gw < NITEM * 4) rc_load(cur, rb, gw, l);
    for (int task = gw; task < NITEM * 4; task += NGW) {
        const int item = task >> 2, it = task & 3, h = item & 7, c = (item >> 3) & 127, b = item >> 10;
        if (task + NGW < NITEM * 4) rc_load(nxt, rb, task + NGW, l);
        f32x4 y[4]; float sum = 0.f;
#pragma unroll
        for (int vt = 0; vt < 4; ++vt) { y[vt] = (f32x4){bflo(cur.yl[vt].x), bfhi(cur.yl[vt].x), bflo(cur.yl[vt].y), bfhi(cur.yl[vt].y)};
#pragma unroll
            for (int s = 0; s < 2; ++s) y[vt] = MFMA16(cur.sc[vt][s], cur.pc[s], y[vt]);
            sum += (y[vt][0] + y[vt][1]) + (y[vt][2] + y[vt][3]); }
        sum = quad_sum(sum);
        const float mean = sum * (1.f / 64.f); float sq = 0.f;
#pragma unroll
        for (int vt = 0; vt < 4; ++vt) { y[vt] = y[vt] - mean; sq += (y[vt][0] * y[vt][0] + y[vt][1] * y[vt][1]) + (y[vt][2] * y[vt][2] + y[vt][3] * y[vt][3]); }
        sq = quad_sum(sq);
        const float rstd = 1.0f / sqrtf(sq * (1.f / 64.f) + 64e-5f);
        const size_t tok = (size_t)b * SEQ + c * 64 + 16 * it + n16;
#pragma unroll
        for (int vt = 0; vt < 4; ++vt) { const v2u g = cur.g1[vt], e = cur.e2[vt];
            v2u o; o.x = pk2(y[vt][0] * rstd * bflo(g.x) + bflo(e.x), y[vt][1] * rstd * bfhi(g.x) + bfhi(e.x)); o.y = pk2(y[vt][2] * rstd * bflo(g.y) + bflo(e.y), y[vt][3] * rstd * bfhi(g.y) + bfhi(e.y));
            *(v2u*)(mix + tok * 1024 + 512 + h * 64 + 16 * vt + 4 * q) = o; }
        cur = nxt;
    }
}
#endif

DI void p0_prologue(const Frame& F, const Args& a) {
    unsigned char* ws = a.ws;
    LAS float* scr = (LAS float*)(F.lds + F.wave * 16384);
    const int gw = F.bid * NWAVES + F.wave, NGW = F.G * NWAVES;
    constexpr int I_IN = 0, I_OUT = 16 * 32, I_DEC = 16, I_AAA = 16, I_GATE = 32;
    constexpr int NITEMS = I_IN + I_OUT + I_DEC + I_AAA + I_GATE;
    for (int s = F.G - 1 - F.bid; s < INC / 32; s += F.G) { q_strip_i8_wg(a.in[I_WIN], INC, 32 * s, ws + WS_WIN, (float*)(ws + WS_COLSC1), F.wave, F.lane, (LAS float*)F.lds); __syncthreads(); }
    for (int it = gw; it < NITEMS; it += NGW) {
        int r = it;
        if (r < I_OUT) { const int kb = r / 32, nb = r % 32; tr_item(a.in[I_WOUT], 1024, 64 * kb, 32 * nb, (bf16*)(ws + WS_WOUT), 1024, 32 * nb, scr, F.lane, nullptr); continue; } r -= I_OUT;
        if (r < I_DEC) { tr_item(a.in[I_WDEC], 512, 0, 32 * r, (bf16*)(ws + WS_WDEC), 64, 32 * r, scr, F.lane, nullptr); continue; } r -= I_DEC;
        if (r < I_AAA) { tr_item(a.in[I_WAAA], 512, 0, 32 * r, (bf16*)(ws + WS_WAAA), 64, 32 * r, scr, F.lane, nullptr); continue; } r -= I_AAA;
        { const int kb = r / 16, nb = r % 16; tr_item(a.in[I_WGATE], 512, 64 * kb, 32 * nb, (bf16*)(ws + WS_WGATE), 128, 32 * nb, scr, F.lane, nullptr); }
    }
    { float* wrt = (float*)(ws + WS_WRT); const float* wr = a.in[I_WR]; const float* g2 = a.in[I_N2G];
      for (int i = F.bid * 512 + F.tid; i < 32 * 1024; i += F.G * 512) { const int e = i >> 10, k = i & 1023; wrt[i] = g2[k] * wr[k * 32 + e]; } }
    { float* par = (float*)(ws + WS_PAR); const int srcs[7] = {I_W0, I_A0, I_KK, I_KA, I_RK, I_LNG, I_LNB};
      for (int i = F.bid * 512 + F.tid; i < 7 * 512; i += F.G * 512) { const int k = i >> 9; float v = 0.f;
#pragma unroll
          for (int j = 0; j < 7; ++j) if (k == j) v = a.in[srcs[j]][i & 511];
          par[i] = v; } }
    { const float* x = a.in[I_X]; const float* g1 = a.in[I_N1G]; bf16* xn = (bf16*)(ws + WS_XN);
      f32x4 gv[4];
#pragma unroll
      for (int j = 0; j < 4; ++j) gv[j] = *((const f32x4*)g1 + F.lane + 64 * j);
      for (int m0 = 2 * gw; m0 < T; m0 += 2 * NGW) {
          f32x4 v[2][4];
#pragma unroll
          for (int r = 0; r < 2; ++r) { const f32x4* xr = (const f32x4*)(x + (size_t)(m0 + r) * D) + F.lane;
#pragma unroll
              for (int j = 0; j < 4; ++j) v[r][j] = __builtin_nontemporal_load(xr + 64 * j); }
#pragma unroll
          for (int r = 0; r < 2; ++r) { float s = 0.f;
#pragma unroll
              for (int j = 0; j < 4; ++j) s += (v[r][j].x * v[r][j].x + v[r][j].y * v[r][j].y) + (v[r][j].z * v[r][j].z + v[r][j].w * v[r][j].w);
              const float rs = 1.0f / sqrtf(wave_sum(s) * (1.f / D) + 1e-6f);
              f32x4 y[4]; float am = 0.f;
#pragma unroll
              for (int j = 0; j < 4; ++j) { y[j] = (v[r][j] * rs) * gv[j]; am = fmaxf(fmaxf(am, fmaxf(fabsf(y[j].x), fabsf(y[j].y))), fmaxf(fabsf(y[j].z), fabsf(y[j].w))); }
              am = wave_max(am); const float qi = am > 0.f ? 127.0f / am : 0.f;
              if (F.lane == 0) ((float*)(ws + WS_XNSC))[m0 + r] = am * (1.0f / 127.0f);
              unsigned* o4 = (unsigned*)((unsigned char*)xn + (size_t)(m0 + r) * D) + F.lane;
#pragma unroll
              for (int j = 0; j < 4; ++j) { const f32x4 qv = y[j] * qi + Q_MAGIC; o4[64 * j] = q_pack4(qv.x, qv.y, qv.z, qv.w); } }
      } }
}

#if NAIVE_RWKV
DI void rwkv_naive_prep(const Frame& F, const Args& a) {
    const bf16* proj = (const bf16*)(a.ws + WS_PROJ); LAS float* sx = (LAS float*)F.lds;
    float* RW = (float*)(a.ws + WS_RW); float* GG = (float*)(a.ws + WS_XN);
    const float* mu = a.in[I_MU]; const int c = F.tid;
    for (int t = F.bid; t < T; t += F.G) {
        const bool first = (t % SEQ) == 0; const bf16* cur = proj + (size_t)t * INC + PRW; const bf16* prv = cur - INC;
#define SH_(col) ({ const float x_ = bf2f(cur[col]); const float p_ = first ? 0.f : bf2f(prv[col]); x_ + (p_ - x_) * mu[col]; })
        if (c < 256) { const float v = SH_(1536 + c); sx[c] = c < 64 ? tanhf(v) : (c < 128 ? v : sigmoidf_(v)); }
        __syncthreads();
        const float r = SH_(c), k = SH_(512 + c), v = SH_(1024 + c);
#undef SH_
        float wl = a.in[I_W0][c], al = a.in[I_A0][c], g = 0.f;
        const float* wdec = a.in[I_WDEC] + c; const float* waaa = a.in[I_WAAA] + c; const float* wgate = a.in[I_WGATE] + c;
#pragma unroll 4
        for (int j = 0; j < 64; ++j) { wl += sx[j] * wdec[j * 512]; al += sx[64 + j] * waaa[j * 512]; }
#pragma unroll 4
        for (int j = 0; j < 128; ++j) g += sx[128 + j] * wgate[j * 512];
        const float dec = __expf(-0.6065306597126334f * sigmoidf_(wl)), av = sigmoidf_(al);
        float kk = k * a.in[I_KK][c]; const float n2 = wave_sum(kk * kk); kk = kk / fmaxf(sqrtf(n2), 1e-12f);
        const float k2 = k * (1.0f + (av - 1.0f) * a.in[I_KA][c]);
        const size_t o = (size_t)t * 512 + c; const size_t S1 = (size_t)T * 512;
        RW[o] = r; RW[S1 + o] = dec; RW[2 * S1 + o] = k2; RW[3 * S1 + o] = v; RW[4 * S1 + o] = kk; RW[5 * S1 + o] = av; GG[o] = g;
        __syncthreads();
    }
}
DI void rwkv_naive_scan(const Frame& F, const Args& a) {
    if (F.bid >= 32 || F.wave != 0) return;
    const int b = F.bid >> 3, h = F.bid & 7, l = F.lane, c = h * 64 + l;
    const float* RW = (const float*)(a.ws + WS_RW); const float* GG = (const float*)(a.ws + WS_XN); bf16* mix = (bf16*)(a.ws + WS_MIX);
    const size_t S1 = (size_t)T * 512; LAS float* sh = (LAS float*)F.lds;
    LAS float* st = sh + 512 + l;
    for (int k = 0; k < 64; ++k) st[64 * k] = 0.f;
    const float rk = a.in[I_RK][c], lg = a.in[I_LNG][c], lb = a.in[I_LNB][c];
    for (int s = 0; s < SEQ; ++s) {
        const size_t o = (size_t)(b * SEQ + s) * 512 + c;
        const float r = RW[o], w = RW[S1 + o], k2 = RW[2 * S1 + o], v = RW[3 * S1 + o], kk = RW[4 * S1 + o], av = RW[5 * S1 + o], g = GG[o];
        sh[l] = r; sh[64 + l] = w; sh[128 + l] = k2; sh[192 + l] = kk; sh[256 + l] = kk * av;
        LDS_WAIT();
        float sa = 0.f;
#pragma unroll 8
        for (int k = 0; k < 64; ++k) sa -= st[64 * k] * sh[192 + k];
        float y = 0.f;
#pragma unroll 8
        for (int k = 0; k < 64; ++k) { const float nv = st[64 * k] * sh[64 + k] + sa * sh[256 + k] + v * sh[128 + k]; st[64 * k] = nv; y += nv * sh[k]; }
        LDS_WAIT();
        const float mean = wave_sum(y) * (1.f / 64.f); const float d = y - mean; const float var = wave_sum(d * d) * (1.f / 64.f);
        const float yn = d * (1.0f / sqrtf(var + 64e-5f));
        const float bonus = wave_sum(r * k2 * rk) * v;
        const float outv = (yn * lg + lb + bonus) * g;
        mix[(size_t)(b * SEQ + s) * 1024 + 512 + c] = (bf16)(pk2(outv, 0.f) & 0xffffu);
    }
}
#endif
#if NAIVE_ATT
DI void attn_naive(const Frame& F, const Args& a) {
    const bf16* proj = (const bf16*)(a.ws + WS_PROJ); bf16* mix = (bf16*)(a.ws + WS_MIX);
    LAS float* sq = (LAS float*)(F.lds + F.wave * 1024);
    const int gw = F.bid * NWAVES + F.wave, NGW = F.G * NWAVES, l = F.lane;
    const float qg = a.in[I_QG][l];
    for (int it = gw; it < T * 8; it += NGW) {
        const int t = it >> 3, h = it & 7, b = t / SEQ, s = t % SEQ, n = s >> 6;
        const float qd = bf2f(proj[(size_t)t * INC + h * 64 + l]);
        const float qn = qd * (1.0f / sqrtf(wave_sum(qd * qd) * (1.f / 64.f) + 1e-6f)) * qg * 0.125f;
        sq[l] = qn; LDS_WAIT();
        float sc[9]; float mx = -3.0e38f;
#pragma unroll
        for (int r = 0; r < 9; ++r) {
            const int kp = (n - 8) * 64 + 64 * r + l; float v = -3.0e38f;
            if (kp >= 0) {
                const v4u* kr = (const v4u*)(proj + (size_t)(b * SEQ + kp) * INC + 512 + h * 64);
                float ss = 0.f, dot = 0.f;
#pragma unroll
                for (int j = 0; j < 8; ++j) { const v4u w = kr[j]; const unsigned ww[4] = {w.x, w.y, w.z, w.w};
#pragma unroll
                    for (int e = 0; e < 4; ++e) { const float k0 = bflo(ww[e]), k1 = bfhi(ww[e]); const int d0 = 8 * j + 2 * e;
                        ss += k0 * k0 + k1 * k1; dot += sq[d0] * a.in[I_KG][d0] * k0 + sq[d0 + 1] * a.in[I_KG][d0 + 1] * k1; } }
                int rel = kp - s; rel = rel < -128 ? -128 : (rel > 63 ? 63 : rel);
                v = dot * (1.0f / sqrtf(ss * (1.f / 64.f) + 1e-6f)) + a.in[I_RELB][h * 192 + rel + 128];
            }
            sc[r] = v; mx = fmaxf(mx, v);
        }
        mx = wave_max(mx); float sum = 0.f;
#pragma unroll
        for (int r = 0; r < 9; ++r) { sc[r] = (sc[r] > -1.0e38f) ? __expf(sc[r] - mx) : 0.f; sum += sc[r]; }
        sum = wave_sum(sum);
        float o = 0.f;
#pragma unroll
        for (int r = 0; r < 9; ++r) {
            const int kp0 = (n - 8) * 64 + 64 * r;
            if (kp0 >= 0) {
                const bf16* vp = proj + (size_t)(b * SEQ + kp0) * INC + 1024 + h * 64 + l;
                for (int key = 0; key < 64; ++key) o += __shfl(sc[r], key) * bf2f(vp[(size_t)key * INC]);
            }
        }
        mix[(size_t)t * 1024 + h * 64 + l] = (bf16)(pk2(o / sum, 0.f) & 0xffffu);
        LDS_WAIT();
    }
}
#endif

DI void p6_router(const Frame& F, const Args& a) {
    unsigned char* ws = a.ws; const bf16* x1 = (const bf16*)(ws + WS_XN); const float* wrt = (const float*)(ws + WS_WRT); const float* br = a.in[I_BR];
    int* eidx = (int*)(ws + WS_EIDX); float* gate = (float*)(ws + WS_GATE); int* lrank = (int*)(ws + WS_LRANK); float* rstd = (float*)(ws + WS_RSTD); int* cnt = (int*)(ws + WS_CNT);
    constexpr int WROW = 2064, WIMG = 32 * WROW;
    LAS int* hist = (LAS int*)(F.lds + 2 * WIMG);
    const int n = F.lane & 15, q = F.lane >> 4;
    for (int i = F.tid; i < 32 * 256; i += NWAVES * 64) { const int e = i >> 8, c4 = i & 255; const f32x4 w = *((const f32x4*)(wrt + (size_t)e * D) + c4);
        v2u hi, lo; hi.x = pk2(w[0], w[1]); hi.y = pk2(w[2], w[3]);
        lo.x = pk2(w[0] - bflo(hi.x), w[1] - bfhi(hi.x)); lo.y = pk2(w[2] - bflo(hi.y), w[3] - bfhi(hi.y));
        *(LAS v2u*)(F.lds + e * WROW + c4 * 8) = hi; *(LAS v2u*)(F.lds + WIMG + e * WROW + c4 * 8) = lo; }
    __syncthreads();
    for (int tile = F.bid; tile < T / 128; tile += F.G) {
        if (F.tid < 32) hist[F.tid] = 0;
        __syncthreads();
        const int tok = tile * 128 + F.wave * 16 + n;
        const v4u* xr = (const v4u*)(x1 + (size_t)tok * D) + q; const LAS unsigned char* w0 = F.lds + n * WROW + 16 * q;
        f32x4 acc0 = {0.f, 0.f, 0.f, 0.f}, acc1 = {0.f, 0.f, 0.f, 0.f}; float ssq = 0.f, amax = 0.f;
        for (int S0 = 0; S0 < 32; S0 += 16) {
            v4u xw[16];
#pragma unroll
            for (int s = 0; s < 16; ++s) xw[s] = xr[4 * (S0 + s)];
#pragma unroll
            for (int s = 0; s < 16; ++s) { const bf16x8 xb8 = __builtin_bit_cast(bf16x8, xw[s]); const LAS unsigned char* wp = w0 + (S0 + s) * 64;
                const unsigned u[4] = {xw[s].x, xw[s].y, xw[s].z, xw[s].w};
#pragma unroll
                for (int j = 0; j < 4; ++j) { const float a = bflo(u[j]), b = bfhi(u[j]); ssq += a * a + b * b; amax = fmaxf(amax, fmaxf(fabsf(a), fabsf(b))); }
                acc0 = __builtin_amdgcn_mfma_f32_16x16x32_bf16(*(const LAS bf16x8*)(wp), xb8, acc0, 0, 0, 0);
                acc0 = __builtin_amdgcn_mfma_f32_16x16x32_bf16(*(const LAS bf16x8*)(wp + WIMG), xb8, acc0, 0, 0, 0);
                acc1 = __builtin_amdgcn_mfma_f32_16x16x32_bf16(*(const LAS bf16x8*)(wp + 16 * WROW), xb8, acc1, 0, 0, 0);
                acc1 = __builtin_amdgcn_mfma_f32_16x16x32_bf16(*(const LAS bf16x8*)(wp + WIMG + 16 * WROW), xb8, acc1, 0, 0, 0); }
        }
        ssq = quad_sum(ssq); amax = quad_max(amax);
        const float rs = 1.0f / sqrtf(ssq * (1.f / D) + 1e-6f);
        float lg[8];
#pragma unroll
        for (int i = 0; i < 4; ++i) { lg[i] = acc0[i] * rs + br[4 * q + i]; lg[4 + i] = acc1[i] * rs + br[16 + 4 * q + i]; }
        float tv[4]; int ti[4];
#pragma unroll
        for (int r = 0; r < 4; ++r) {
            float bv = -3.0e38f; int bi = 0;
#pragma unroll
            for (int j = 0; j < 8; ++j) { const int e = (j < 4 ? 0 : 16) + 4 * q + (j & 3); if (lg[j] > bv) { bv = lg[j]; bi = e; } }
#pragma unroll
            for (int o = 16; o <= 32; o <<= 1) { const float ov = __shfl_xor(bv, o); const int oi = __shfl_xor(bi, o); if (ov > bv || (ov == bv && oi < bi)) { bv = ov; bi = oi; } }
            tv[r] = bv; ti[r] = bi;
#pragma unroll
            for (int j = 0; j < 8; ++j) { const int e = (j < 4 ? 0 : 16) + 4 * q + (j & 3); if (e == bi) lg[j] = -3.0e38f; }
        }
        if (q == 0) {
            const float e1 = __expf(tv[1] - tv[0]), e2 = __expf(tv[2] - tv[0]), e3 = __expf(tv[3] - tv[0]); const float inv = 1.0f / (1.0f + e1 + e2 + e3);
            int lr[4];
#pragma unroll
            for (int r = 0; r < 4; ++r) lr[r] = atomicAdd((int*)&hist[ti[r]], 1);
            *(int4*)(eidx + (size_t)tok * 4) = make_int4(ti[0], ti[1], ti[2], ti[3]);
            *(float4*)(gate + (size_t)tok * 4) = make_float4(inv, e1 * inv, e2 * inv, e3 * inv);
            *(int4*)(lrank + (size_t)tok * 4) = make_int4(lr[0], lr[1], lr[2], lr[3]);
            rstd[tok] = rs * amax * (1.0f / 127.0f);
        }
        { const float qinv = amax > 0.f ? 127.0f / amax : 0.f; unsigned char* xq = ws + WS_XQ;
            for (int i0 = 0; i0 < 16; i0 += 4) { v4u xa[4], xb2[4];
#pragma unroll
                for (int i = 0; i < 4; ++i) { const v4u* p = (const v4u*)(x1 + (size_t)(tile * 128 + F.wave * 16 + i0 + i) * D) + 2 * F.lane; xa[i] = p[0]; xb2[i] = p[1]; }
#pragma unroll
                for (int i = 0; i < 4; ++i) { const float sc = __builtin_bit_cast(float, __builtin_amdgcn_readlane(__builtin_bit_cast(int, qinv), i0 + i));
                    const unsigned u[8] = {xa[i].x, xa[i].y, xa[i].z, xa[i].w, xb2[i].x, xb2[i].y, xb2[i].z, xb2[i].w}; v4u o;
#pragma unroll
                    for (int d = 0; d < 4; ++d) { const f32x2 lo = {bflo(u[2 * d]), bfhi(u[2 * d])}, hi = {bflo(u[2 * d + 1]), bfhi(u[2 * d + 1])};
                        const f32x2 ql = lo * sc + Q_MAGIC, qh = hi * sc + Q_MAGIC; o[d] = q_pack4(ql.x, ql.y, qh.x, qh.y); }
                    *((v4u*)(xq + (size_t)(tile * 128 + F.wave * 16 + i0 + i) * D) + F.lane) = o; } }
        }
        __syncthreads();
        if (F.tid < 32) cnt[tile * 32 + F.tid] = hist[F.tid];
        __syncthreads();
    }
}

DI void p7_permute(const Frame& F, const Args& a) {
    unsigned char* ws = a.ws; const int* cnt = (const int*)(ws + WS_CNT); int* meta = (int*)(ws + WS_META);
    const int* eidx = (const int*)(ws + WS_EIDX); const int* lrank = (const int*)(ws + WS_LRANK); int* inv = (int*)(ws + WS_INV);
    const float* rstd = (const float*)(ws + WS_RSTD); float* rowrstd = (float*)(ws + WS_ROWRSTD);
    bf16* xb = (bf16*)(ws + WS_XN); int* rowtok = (int*)(ws + WS_ROWTOK);
    LAS int* s_tot = (LAS int*)F.lds; LAS int* s_pst = s_tot + 32; LAS int* s_base = s_tot + 64; LAS int* s_part = s_tot + 128;
    { const int e = F.tid & 31, part = F.tid >> 5; int s = 0; for (int t = part * 16; t < part * 16 + 16; ++t) s += cnt[t * 32 + e]; s_part[part * 32 + e] = s; }
    __syncthreads();
    if (F.tid < 32) { int s = 0; for (int p = 0; p < 16; ++p) s += s_part[p * 32 + F.tid]; s_tot[F.tid] = s; }
    __syncthreads();
    if (F.tid < 32) { int ps = 0; for (int e = 0; e < F.tid; ++e) ps += (s_tot[e] + 255) / 256 * 256; s_pst[F.tid] = ps; }
    __syncthreads();
    if (F.bid == 0 && F.tid < 32) { const int e = F.tid, nb = (s_tot[e] + 255) / 256, rb0 = s_pst[e] / 256; for (int i = 0; i < nb; ++i) meta[16 + rb0 + i] = e; if (e == 31) meta[0] = rb0 + nb; }
    if (F.bid < 32) { const int e = F.bid, r0 = s_pst[e] + s_tot[e], r1 = s_pst[e] + (s_tot[e] + 255) / 256 * 256;
        for (int r = r0 + F.tid; r < r1; r += NWAVES * 64) { rowtok[r] = T; rowrstd[r] = 0.f; } }
    if (F.bid == 0 && F.tid < 64) { const v4u z = {0u, 0u, 0u, 0u}; *((v4u*)(ws + WS_XQ + (size_t)T * D) + F.tid) = z; }
    for (int tile = F.bid; tile < T / 128; tile += F.G) {
        __syncthreads();
        if (F.tid < 32) { int s = 0; for (int t = 0; t < tile; ++t) s += cnt[t * 32 + F.tid]; s_base[F.tid] = s_pst[F.tid] + s; }
        __syncthreads();
        { const int i = F.tid;
            const int tok = tile * 128 + (i >> 2), k = i & 3; const int e = eidx[tok * 4 + k]; const int dest = s_base[e] + lrank[tok * 4 + k];
            inv[tok * 4 + k] = dest; rowtok[dest] = tok; rowrstd[dest] = rstd[tok];
        }
    }
}

DI void p10_combine(const Frame& F, const Args& a) {
    unsigned char* ws = a.ws; const int* inv = (const int*)(ws + WS_INV); const float* gate = (const float*)(ws + WS_GATE); const bf16* yr = (const bf16*)(ws + WS_YR); const bf16* xb = (const bf16*)(ws + WS_XN); float* out = a.out;
    const int gw = F.bid * NWAVES + F.wave, NGW = F.G * NWAVES;
    for (int t = gw; t < T; t += NGW) {
        const int4 iv = *(const int4*)(inv + (size_t)t * 4); const float4 gv = *(const float4*)(gate + (size_t)t * 4);
        const int rows[4] = {iv.x, iv.y, iv.z, iv.w}; const float gs[4] = {gv.x, gv.y, gv.z, gv.w};
        f32x4* o = (f32x4*)(out + (size_t)t * D) + F.lane; const v2u* xr = (const v2u*)(xb + (size_t)t * D) + F.lane;
#pragma unroll
        for (int j = 0; j < 4; ++j) {
            const v2u xw = xr[64 * j]; f32x4 acc = {bflo(xw.x), bfhi(xw.x), bflo(xw.y), bfhi(xw.y)};
#pragma unroll
            for (int k = 0; k < 4; ++k) { const int w = (int)__builtin_nontemporal_load((const unsigned*)((const unsigned char*)yr + (size_t)rows[k] * D) + F.lane + 64 * j);
                const auto lo = __builtin_amdgcn_cvt_pk_f32_fp8(w, false), hi = __builtin_amdgcn_cvt_pk_f32_fp8(w, true);
                acc.x += gs[k] * lo[0]; acc.y += gs[k] * lo[1]; acc.z += gs[k] * hi[0]; acc.w += gs[k] * hi[1]; }
            __builtin_nontemporal_store(acc, o + 64 * j);
        }
    }
}

constexpr int N_PHASES = 11;
__global__ void __launch_bounds__(NWAVES * 64, 2) fwd(Args args) {
    extern __shared__ __attribute__((aligned(16))) unsigned char lds[];
    Frame F;
    F.lds = (LAS unsigned char*)lds;
    F.tid = threadIdx.x; F.lane = F.tid & 63; F.wave = __builtin_amdgcn_readfirstlane(F.tid >> 6);
    F.G = gridDim.x; F.bid = blockIdx.x;
    volatile LAS unsigned* MISC = (volatile LAS unsigned*)(F.lds + MISC_OFF);
    if (F.tid < 64) MISC[F.tid] = 0u;
    __syncthreads();
    unsigned char* ws = args.ws;
    unsigned* ctl = (unsigned*)(ws + WS_CTL);
    XcdBarrier bar; bar.bar = ctl + CW_BAR; bar.x = 0; bar.st = nullptr;
    if (MK_N_LAUNCHES == 1) bar = xcd_barrier_post(ctl + CW_BAR, MISC + 8);
    const int lo = args.ph_lo, hi = args.ph_hi;
#ifndef PHASE_MASK
#define PHASE_MASK 0xffff
#endif
#define IN(k) (((PHASE_MASK >> (k)) & 1) && lo <= (k) && (k) < hi)
#ifndef DUP_PHASE
#define DUP_PHASE -1
#endif
#define REPS(k) ((DUP_PHASE >= 0 && (k) == DUP_PHASE) ? args.ph_rep : 1)
#define SEAM(k) do { if (IN(k) && IN((k) + 1)) xcd_barrier(bar); { int t_ = threadIdx.x; asm volatile("" : "+v"(t_)); F.tid = t_; F.lane = t_ & 63; } } while (0)

    for (int rep_ = 0; rep_ < REPS(0); ++rep_) { if (rep_) xcd_barrier(bar);
    if (IN(0)) { p0_prologue(F, args); } } SEAM(0);

    for (int rep_ = 0; rep_ < REPS(1); ++rep_) { if (rep_) xcd_barrier(bar);
    if (IN(1)) {
        pg8::Gemm g{(const bf16*)(ws + WS_XN), (const bf16*)(ws + WS_WIN), T, INC, D / 2}; pg8::StaticOrder S; S.init(T, INC, F.G, F.bid);
        pg8::EpiBf16Q E{(bf16*)(ws + WS_PROJ), INC, (const float*)(ws + WS_XNSC), (const float*)(ws + WS_COLSC1)};
        pg8::gemm_phase<pg8::EpiBf16Q, pg8::StaticOrder, true, true>(F.lds, g, S, E);
    } } SEAM(1);

    for (int rep_ = 0; rep_ < REPS(2); ++rep_) { if (rep_) xcd_barrier(bar);
    if (IN(2)) {
#if NAIVE_RWKV
        rwkv_naive_prep(F, args);
#else
        rwkv_phase_a(F, args);
#endif
    } } SEAM(2);

    for (int rep_ = 0; rep_ < REPS(3); ++rep_) { if (rep_) xcd_barrier(bar);
    if (IN(3)) {
#if NAIVE_RWKV
        rwkv_naive_scan(F, args);
#else
        rwkv_phase_b(F, args);
#endif
        __syncthreads();
#if NAIVE_ATT
        attn_naive(F, args);
#else
        attn_phase(F, args, rep_);
#endif
    } } SEAM(3);

    for (int rep_ = 0; rep_ < REPS(4); ++rep_) { if (rep_) xcd_barrier(bar);
    if (IN(4)) {
#if !NAIVE_RWKV
        rwkv_phase_c(F, args);
#endif
    } } SEAM(4);

    for (int rep_ = 0; rep_ < REPS(5); ++rep_) { if (rep_) xcd_barrier(bar);
    if (IN(5)) {
        pg8::Gemm g{(const bf16*)(ws + WS_MIX), (const bf16*)(ws + WS_WOUT), T, D, D}; pg8::StaticOrder S; S.init(T, D, F.G, F.bid);
        pg8::EpiResid E{args.in[I_X], nullptr, (bf16*)(ws + WS_XN), D};
        pg8::gemm_phase<pg8::EpiResid, pg8::StaticOrder, true, true>(F.lds, g, S, E);
    } } SEAM(5);

    for (int rep_ = 0; rep_ < REPS(6); ++rep_) { if (rep_) xcd_barrier(bar);
    if (IN(6)) { p6_router(F, args); } } SEAM(6);
    for (int rep_ = 0; rep_ < REPS(7); ++rep_) { if (rep_) xcd_barrier(bar);
    if (IN(7)) { p7_permute(F, args); } } SEAM(7);

    for (int rep_ = 0; rep_ < REPS(8); ++rep_) { if (rep_) xcd_barrier(bar);
    if (IN(8)) {
        pg8::Gemm g{(const bf16*)(ws + WS_XQ), (const bf16*)(ws + WS_WUP), NROWS_MAX, 2048, D / 2};
        pg8::MoeOrder<true> S{(const int*)(ws + WS_META), 8, F.G, F.bid, (const int*)(ws + WS_ROWTOK)};
        pg8::EpiSwiGLU E{(bf16*)(ws + WS_ACT), args.in[I_BUP], (const float*)(ws + WS_ROWRSTD), (const float*)(ws + WS_COLSC)};
        pg8::gemm_phase<pg8::EpiSwiGLU, pg8::MoeOrder<true>, true, true>(F.lds, g, S, E);
    } } SEAM(8);

    for (int rep_ = 0; rep_ < REPS(9); ++rep_) { if (rep_) xcd_barrier(bar);
    if (IN(9)) {
        pg8::Gemm g{(const bf16*)(ws + WS_ACT), (const bf16*)(ws + WS_WDN), NROWS_MAX, 1024, D / 2};
        pg8::MoeOrder<false> S{(const int*)(ws + WS_META), 4, F.G, F.bid, nullptr};
        pg8::EpiDown E{(bf16*)(ws + WS_YR), args.in[I_BDN], (const float*)(ws + WS_COLSC2)};
        pg8::gemm_phase<pg8::EpiDown, pg8::MoeOrder<false>, true, true>(F.lds, g, S, E);
    } } SEAM(9);

    if (IN(10)) { p10_combine(F, args); }
#undef IN
#undef SEAM
}

extern "C" void kernel_launch(void* const* d_in, const int* in_sizes, int n_in, void* d_out, int out_size, void* d_ws, size_t ws_size, hipStream_t stream) {
    static int grid = 0;
    if (grid == 0) {
        if (n_in != 25 || out_size != T * D || ws_size < WS_END) { fprintf(stderr, "kernel_launch: unexpected shapes (n_in %d out %d ws %zu)\n", n_in, out_size, ws_size); grid = -1; return; }
        int dev = 0, cus = 0, per_cu = 0;
        if (hipGetDevice(&dev) != hipSuccess || hipDeviceGetAttribute(&cus, hipDeviceAttributeMultiprocessorCount, dev) != hipSuccess) { grid = -1; return; }
        if (hipFuncSetAttribute((const void*)fwd, hipFuncAttributeMaxDynamicSharedMemorySize, LDS_BYTES) != hipSuccess) { fprintf(stderr, "kernel_launch: hipFuncSetAttribute failed\n"); grid = -1; return; }
        if (hipOccupancyMaxActiveBlocksPerMultiprocessor(&per_cu, (const void*)fwd, NWAVES * 64, LDS_BYTES) != hipSuccess || per_cu < 1) { fprintf(stderr, "kernel_launch: occupancy query says %d\n", per_cu); }
        (void)hipGetLastError();
        grid = cus;
    }
    if (grid < 0) return;
    (void)hipMemsetAsync((char*)d_ws + WS_CTL, 0, CTL_ZERO_BYTES, stream);
    Args a{};
    for (int i = 0; i < 25; ++i) a.in[i] = (const float*)d_in[i];
    a.out = (float*)d_out; a.ws = (unsigned char*)d_ws;
#if MK_N_LAUNCHES == 1
    a.ph_lo = 0; a.ph_hi = N_PHASES; a.ph_rep = 2;
    hipLaunchKernelGGL(fwd, dim3(grid), dim3(NWAVES * 64), LDS_BYTES, stream, a);
#else
    for (int p = 0; p < N_PHASES; ++p) { a.ph_lo = p; a.ph_hi = p + 1; hipLaunchKernelGGL(fwd, dim3(grid), dim3(NWAVES * 64), LDS_BYTES, stream, a); }
#endif
}
```

```cpp
#define NAIVE_RWKV 0
#define NAIVE_ATT 0
#define MK_N_LAUNCHES 1
#include <hip/hip_runtime.h>
#include <cstdio>
#include <cstdint>

#ifndef MK_N_LAUNCHES
#define MK_N_LAUNCHES 1
#endif
#ifndef NAIVE_RWKV
#define NAIVE_RWKV 0
#endif
#ifndef NAIVE_ATT
#define NAIVE_ATT 0
#endif

namespace pg8 {
#define PG8_LAS __attribute__((address_space(3)))
typedef unsigned short bf16_t;
typedef short bf16x8 __attribute__((ext_vector_type(8)));
typedef float f32x4 __attribute__((ext_vector_type(4)));
typedef unsigned u32x4 __attribute__((ext_vector_type(4)));
typedef unsigned u32x2 __attribute__((ext_vector_type(2)));
typedef float f32x2e __attribute__((ext_vector_type(2)));
typedef int i32x4 __attribute__((ext_vector_type(4)));
typedef int i32x8 __attribute__((ext_vector_type(8)));
template <bool F8> struct Frag { bf16x8 v[2]; __device__ __forceinline__ void set(bf16x8 a, bf16x8 b) { v[0] = a; v[1] = b; } };
template <> struct Frag<true> { i32x8 v; __device__ __forceinline__ void set(bf16x8 a, bf16x8 b) { v = __builtin_shufflevector(__builtin_bit_cast(i32x4, a), __builtin_bit_cast(i32x4, b), 0, 1, 2, 3, 4, 5, 6, 7); } };
__device__ __forceinline__ i32x8 cat8(bf16x8 a, bf16x8 b) { return __builtin_shufflevector(__builtin_bit_cast(i32x4, a), __builtin_bit_cast(i32x4, b), 0, 1, 2, 3, 4, 5, 6, 7); }
constexpr int BM = 256, BK = 64, HALF = 128, HTB = HALF * BK * 2  , STAGE_BYTES = 8 * HTB, NXCD = 8, WGM = 8, EPF_OFF = STAGE_BYTES  ;

__host__ __device__ __forceinline__ int lds_byte(int r, int c) { const int st = (r >> 4) * 2 + (c >> 5), rr = r & 15, cc = c & 31, ob = rr * 64 + cc * 2; return st * 1024 + (ob ^ (((ob >> 9) & 1) << 5)); }
__host__ __device__ __forceinline__ void stage_rc(int b, int& R, int& C) { const int st = b / 1024, sb = b % 1024, swz = sb ^ (((sb >> 9) & 1) << 5); R = (st >> 1) * 16 + swz / 64; C = (st & 1) * 32 + (swz % 64) / 2; }
__host__ __device__ __forceinline__ int perm32(int rho) { const int n = rho >> 4, i = rho & 15; return 8 * (i >> 2) + 4 * n + (i & 3); }

struct Unit { int pm, pn, e; };
struct Gemm { const bf16_t* A; const bf16_t* Bt; int M, N, K; };

__device__ __forceinline__ bool tile_of(int i, int G, int c, int nM, int nN, int& pm, int& pn) {
    const int nwg = nM * nN; const long L = (long)i * G + c; if (L >= nwg) return false;
    int wgid = (int)L; { const int q = nwg / NXCD, r = nwg % NXCD, xcd = wgid % NXCD, off = wgid / NXCD; wgid = (xcd < r ? xcd * (q + 1) : r * (q + 1) + (xcd - r) * q) + off; }
    const int nig = WGM * nN, gid = wgid / nig, fm = gid * WGM, gsz = (nM - fm) < WGM ? (nM - fm) : WGM;
    pm = fm + ((wgid % nig) % gsz); pn = (wgid % nig) / gsz; return true;
}
struct StaticOrder {
    int nM, nN, G, c;
    __device__ void init(int M, int N, int G_, int c_) { nM = M / BM; nN = N / BM; G = G_; c = c_; }
    __device__ __forceinline__ bool next(int i, Unit& u) const { u.e = 0; return tile_of(i, G, c, nM, nN, u.pm, u.pn); }
    __device__ __forceinline__ const char* a_base(const Gemm& g, const Unit& u) const { return (const char*)g.A + (size_t)u.pm * BM * g.K * 2; }
    __device__ __forceinline__ const char* b_base(const Gemm& g, const Unit& u) const { return (const char*)g.Bt + (size_t)u.pn * BM * g.K * 2; }
    __device__ __forceinline__ void a_off(const Gemm& g, const Unit&, const int (&R)[2], const int (&C)[2], unsigned (&vo)[2][2]) const {
#pragma unroll
        for (int h = 0; h < 2; ++h)
#pragma unroll
            for (int i = 0; i < 2; ++i) vo[h][i] = (unsigned)((h * HALF + R[i]) * g.K + C[i]) * 2u; }
    __device__ __forceinline__ void a_ready(const Unit&) const {}
    __device__ __forceinline__ void done(const Unit&) const {}
    static constexpr bool LATE = false;
    __device__ __forceinline__ void prologue(PG8_LAS unsigned char*, int) const {}
    __device__ __forceinline__ void a_req(const Unit&, PG8_LAS unsigned char*, int, int, int) const {}
    __device__ __forceinline__ void a_off_lds(const Gemm&, const PG8_LAS unsigned char*, int, const int (&)[2], const int (&)[2], unsigned (&)[2][2]) const {}
};
constexpr int SCH_META_OFF = EPF_OFF + 4096, SCH_ROW_OFF = EPF_OFF + 8192;
template <bool GATHER>
struct MoeOrder {
    const int* meta; int nN, G, c;
    const int* rowtok;
    const PG8_LAS int* lmeta;
    static constexpr bool LATE = GATHER;
    __device__ __forceinline__ void prologue(PG8_LAS unsigned char* lds, int tid) { PG8_LAS int* lm = (PG8_LAS int*)(lds + SCH_META_OFF);
        for (int i = tid; i < 16 + 544; i += 512) lm[i] = meta[i];
        __syncthreads(); lmeta = lm; }
    __device__ __forceinline__ bool next(int i, Unit& u) const {
        const int nM = __builtin_amdgcn_readfirstlane(lmeta[0]);
        if (!tile_of(i, G, c, nM, nN, u.pm, u.pn)) return false;
        u.e = __builtin_amdgcn_readfirstlane(lmeta[16 + u.pm]); return true;
    }
    __device__ __forceinline__ const char* a_base(const Gemm& g, const Unit& u) const { return GATHER ? (const char*)g.A : (const char*)g.A + (size_t)u.pm * BM * g.K * 2; }
    __device__ __forceinline__ const char* b_base(const Gemm& g, const Unit& u) const { return (const char*)g.Bt + ((size_t)u.e * g.N + (size_t)u.pn * BM) * g.K * 2; }
    __device__ __forceinline__ void a_off(const Gemm& g, const Unit& u, const int (&R)[2], const int (&C)[2], unsigned (&vo)[2][2]) const {
#pragma unroll
        for (int h = 0; h < 2; ++h)
#pragma unroll
            for (int i = 0; i < 2; ++i) { const int r = h * HALF + R[i]; vo[h][i] = (unsigned)((GATHER ? rowtok[u.pm * BM + r] : r) * g.K + C[i]) * 2u; } }
    __device__ __forceinline__ void a_req(const Unit& nxt, PG8_LAS unsigned char* lds, int wid, int lane, int slot) const {
        if (GATHER && wid == 0) __builtin_amdgcn_global_load_lds((const unsigned*)(rowtok + nxt.pm * BM + 4 * lane), (PG8_LAS unsigned*)(lds + SCH_ROW_OFF + (slot & 1) * 1024), 16, 0, 0); }
    __device__ __forceinline__ void a_off_lds(const Gemm& g, const PG8_LAS unsigned char* lds, int slot, const int (&R)[2], const int (&C)[2], unsigned (&vo)[2][2]) const {
        const PG8_LAS int* lr = (const PG8_LAS int*)(lds + SCH_ROW_OFF + (slot & 1) * 1024);
#pragma unroll
        for (int h = 0; h < 2; ++h)
#pragma unroll
            for (int i = 0; i < 2; ++i) vo[h][i] = (unsigned)(lr[h * HALF + R[i]] * g.K + C[i]) * 2u; }
    __device__ __forceinline__ void a_ready(const Unit&) const {}
    __device__ __forceinline__ void done(const Unit&) const {}
};

__device__ __forceinline__ unsigned cvt_pk_bf16(float lo, float hi) { unsigned r; asm volatile("v_cvt_pk_bf16_f32 %0, %1, %2" : "=v"(r) : "v"(lo), "v"(hi)); return r; }

__device__ __forceinline__ float acc_i2f(float bits) { return (float)__builtin_bit_cast(int, bits); }
__device__ __forceinline__ void epf_dma(const float* src_lane, PG8_LAS unsigned char* dst) { __builtin_amdgcn_global_load_lds((const unsigned*)src_lane, (PG8_LAS unsigned*)dst, 16, 0, 0); }
struct EpiBf16Q {
    static constexpr int ID = 1; static constexpr bool PERM = true, AFTER_DRAIN = false, I8 = true, F8 = false, EPF = true;
    bf16_t* O; int ldc; const float* rowsc; const float* colsc;
    __device__ __forceinline__ void prefetch(const Unit& u, PG8_LAS unsigned char* ev, int lane) const {
        epf_dma(colsc + u.pn * BM + 4 * lane, ev); epf_dma(rowsc + u.pm * BM + 4 * lane, ev + 1024); }
    __device__ __forceinline__ void operator()(const f32x4 (&acc)[2][2][4][2], const Unit& u, int wr, int wc, int fr, int fq, const PG8_LAS float* ev) const {
        const int row0 = u.pm * BM + wr * 64 + fr, col0 = u.pn * BM + wc * 32 + 8 * fq;
        f32x4 cv[2][2]; float rsv[2][4];
#pragma unroll
        for (int bj = 0; bj < 2; ++bj)
#pragma unroll
            for (int n = 0; n < 2; ++n) cv[bj][n] = *(const PG8_LAS f32x4*)(ev + wc * 32 + 8 * fq + bj * HALF + 4 * n);
#pragma unroll
        for (int ai = 0; ai < 2; ++ai)
#pragma unroll
            for (int m = 0; m < 4; ++m) rsv[ai][m] = ev[256 + wr * 64 + fr + ai * HALF + m * 16];
#pragma unroll
        for (int ai = 0; ai < 2; ++ai)
#pragma unroll
            for (int m = 0; m < 4; ++m) { bf16_t* rowp = O + (size_t)(row0 + ai * HALF + m * 16) * ldc + col0; const float rs = rsv[ai][m];
#pragma unroll
                for (int bj = 0; bj < 2; ++bj) { f32x4 v0, v1;
#pragma unroll
                    for (int j = 0; j < 4; ++j) { v0[j] = acc_i2f(acc[ai][bj][m][0][j]); v1[j] = acc_i2f(acc[ai][bj][m][1][j]); }
                    v0 = (v0 * rs) * cv[bj][0]; v1 = (v1 * rs) * cv[bj][1];
                    u32x4 w; w.x = cvt_pk_bf16(v0[0], v0[1]); w.y = cvt_pk_bf16(v0[2], v0[3]); w.z = cvt_pk_bf16(v1[0], v1[1]); w.w = cvt_pk_bf16(v1[2], v1[3]);
                    *(u32x4*)(rowp + bj * HALF) = w; } }
    }
};
struct EpiBf16 {
    static constexpr int ID = 0; static constexpr bool PERM = true, AFTER_DRAIN = false, I8 = false, F8 = false, EPF = false;
    bf16_t* O; int ldc;
    __device__ __forceinline__ void operator()(const f32x4 (&acc)[2][2][4][2], const Unit& u, int wr, int wc, int fr, int fq) const {
        const int row0 = u.pm * BM + wr * 64 + fr, col0 = u.pn * BM + wc * 32 + 8 * fq;
#pragma unroll
        for (int ai = 0; ai < 2; ++ai)
#pragma unroll
            for (int m = 0; m < 4; ++m) { bf16_t* rowp = O + (size_t)(row0 + ai * HALF + m * 16) * ldc + col0;
#pragma unroll
                for (int bj = 0; bj < 2; ++bj) { const f32x4 v0 = acc[ai][bj][m][0], v1 = acc[ai][bj][m][1];
                    u32x4 w; w.x = cvt_pk_bf16(v0[0], v0[1]); w.y = cvt_pk_bf16(v0[2], v0[3]); w.z = cvt_pk_bf16(v1[0], v1[1]); w.w = cvt_pk_bf16(v1[2], v1[3]);
                    *(u32x4*)(rowp + bj * HALF) = w; } }
    }
};
struct EpiResid {
    static constexpr int ID = 5; static constexpr bool PERM = false, AFTER_DRAIN = false, I8 = false, F8 = false, EPF = false;
    const float* base; float* out; bf16_t* xb; int ldc;
    __device__ __forceinline__ void operator()(const f32x4 (&acc)[2][2][4][2], const Unit& u, int wr, int wc, int fr, int fq) const {
        const int row0 = u.pm * BM + wr * 64 + fr, col0 = u.pn * BM + wc * 32 + 4 * fq;
        f32x4 nb[4][2][2];
#define PG8_RES_LOAD(g_) do { const size_t off_ = (size_t)(row0 + ((g_) >> 2) * HALF + ((g_) & 3) * 16) * ldc + col0; _Pragma("unroll") for (int bj = 0; bj < 2; ++bj) _Pragma("unroll") for (int n = 0; n < 2; ++n) \
            nb[(g_) & 3][bj][n] = __builtin_nontemporal_load((const f32x4*)(base + off_ + bj * HALF + n * 16)); } while (0)
        PG8_RES_LOAD(0); PG8_RES_LOAD(1); PG8_RES_LOAD(2);
#pragma unroll
        for (int g = 0; g < 8; ++g) { const int ai = g >> 2, m = g & 3; const size_t off = (size_t)(row0 + ai * HALF + m * 16) * ldc + col0;
            if (g + 3 < 8) PG8_RES_LOAD(g + 3);
#pragma unroll
            for (int bj = 0; bj < 2; ++bj)
#pragma unroll
                for (int n = 0; n < 2; ++n) { const f32x4 o = nb[g & 3][bj][n] + acc[ai][bj][m][n];
                    if (out) *(f32x4*)(out + off + bj * HALF + n * 16) = o;
                    u32x2 w; w.x = cvt_pk_bf16(o[0], o[1]); w.y = cvt_pk_bf16(o[2], o[3]); *(u32x2*)(xb + off + bj * HALF + n * 16) = w; }
            asm volatile("" ::: "memory"); }
#undef PG8_RES_LOAD
    }
};
struct EpiSwiGLU {
    static constexpr int ID = 8; static constexpr bool PERM = true, AFTER_DRAIN = false, I8 = true, F8 = false, EPF = true;
    bf16_t* O; const float* b_up; const float* rowrstd; const float* colsc;
    __device__ __forceinline__ void prefetch(const Unit& u, PG8_LAS unsigned char* ev, int lane) const {
        const int off = (size_t)u.e * 2048 + u.pn * HALF + (lane >> 5) * 1024 + 4 * (lane & 31);
        epf_dma(b_up + off, ev); epf_dma(colsc + off, ev + 1024); epf_dma(rowrstd + u.pm * BM + 4 * lane, ev + 2048); }
    __device__ __forceinline__ void operator()(const f32x4 (&acc)[2][2][4][2], const Unit& u, int wr, int wc, int fr, int fq, const PG8_LAS float* ev) const {
        const int row0 = u.pm * BM + wr * 64 + fr, f0 = u.pn * HALF + wc * 32 + 8 * fq;
        const PG8_LAS float* ep = ev + wc * 32 + 8 * fq;
        const f32x4 bg0 = *(const PG8_LAS f32x4*)ep, bg1 = *(const PG8_LAS f32x4*)(ep + 4), bl0 = *(const PG8_LAS f32x4*)(ep + 128), bl1 = *(const PG8_LAS f32x4*)(ep + 132);
        const f32x4 cg0 = *(const PG8_LAS f32x4*)(ep + 256), cg1 = *(const PG8_LAS f32x4*)(ep + 260), cl0 = *(const PG8_LAS f32x4*)(ep + 384), cl1 = *(const PG8_LAS f32x4*)(ep + 388);
        float rsv[2][4];
#pragma unroll
        for (int ai = 0; ai < 2; ++ai)
#pragma unroll
            for (int m = 0; m < 4; ++m) rsv[ai][m] = ev[512 + wr * 64 + fr + ai * HALF + m * 16];
#pragma unroll
        for (int ai = 0; ai < 2; ++ai)
#pragma unroll
            for (int m = 0; m < 4; ++m) { const int row = row0 + ai * HALF + m * 16; const float rs = rsv[ai][m];
                float a[8];
#pragma unroll
                for (int n = 0; n < 2; ++n)
#pragma unroll
                    for (int j = 0; j < 4; j += 2) {
                        const f32x2e ag2 = {acc_i2f(acc[ai][0][m][n][j]), acc_i2f(acc[ai][0][m][n][j + 1])}, al2 = {acc_i2f(acc[ai][1][m][n][j]), acc_i2f(acc[ai][1][m][n][j + 1])};
                        const f32x2e cg2 = n ? (f32x2e){cg1[j], cg1[j + 1]} : (f32x2e){cg0[j], cg0[j + 1]}, cl2 = n ? (f32x2e){cl1[j], cl1[j + 1]} : (f32x2e){cl0[j], cl0[j + 1]};
                        const f32x2e bg2 = n ? (f32x2e){bg1[j], bg1[j + 1]} : (f32x2e){bg0[j], bg0[j + 1]}, bl2 = n ? (f32x2e){bl1[j], bl1[j + 1]} : (f32x2e){bl0[j], bl0[j + 1]};
                        f32x2e hg = (ag2 * rs) * cg2 + bg2, hl = (al2 * rs) * cl2 + bl2;
                        hg.x = fminf(hg.x, 7.0f); hg.y = fminf(hg.y, 7.0f); hl.x = fminf(fmaxf(hl.x, -7.0f), 7.0f); hl.y = fminf(fmaxf(hl.y, -7.0f), 7.0f);
                        const f32x2e t = hg * (-1.702f * 1.4426950408889634f);
                        f32x2e e; e.x = __builtin_amdgcn_exp2f(t.x); e.y = __builtin_amdgcn_exp2f(t.y);
                        const f32x2e d = e + 1.0f; f32x2e sg; sg.x = __builtin_amdgcn_rcpf(d.x); sg.y = __builtin_amdgcn_rcpf(d.y);
                        const f32x2e o = (hg * sg) * (hl + 1.0f);
                        a[n * 4 + j] = o.x; a[n * 4 + j + 1] = o.y; }
                u32x2 w;
                w.x = (unsigned)__builtin_amdgcn_cvt_pk_fp8_f32(a[2], a[3], __builtin_amdgcn_cvt_pk_fp8_f32(a[0], a[1], 0, false), true);
                w.y = (unsigned)__builtin_amdgcn_cvt_pk_fp8_f32(a[6], a[7], __builtin_amdgcn_cvt_pk_fp8_f32(a[4], a[5], 0, false), true);
                *(u32x2*)((unsigned char*)O + (size_t)row * 1024 + f0) = w; }
    }
};
struct EpiDown {
    static constexpr int ID = 9; static constexpr bool PERM = true, AFTER_DRAIN = false, I8 = false, F8 = true, EPF = true;
    bf16_t* O; const float* b_dn; const float* colsc;
    __device__ __forceinline__ void prefetch(const Unit& u, PG8_LAS unsigned char* ev, int lane) const {
        const int off = (size_t)u.e * 1024 + u.pn * BM + 4 * lane;
        epf_dma(b_dn + off, ev); epf_dma(colsc + off, ev + 1024); }
    __device__ __forceinline__ void operator()(const f32x4 (&acc)[2][2][4][2], const Unit& u, int wr, int wc, int fr, int fq, const PG8_LAS float* ev) const {
        const int row0 = u.pm * BM + wr * 64 + fr, col0 = u.pn * BM + wc * 32 + 8 * fq;
        f32x4 bv[2][2], cv[2][2];
#pragma unroll
        for (int bj = 0; bj < 2; ++bj)
#pragma unroll
            for (int n = 0; n < 2; ++n) { bv[bj][n] = *(const PG8_LAS f32x4*)(ev + wc * 32 + 8 * fq + bj * HALF + 4 * n); cv[bj][n] = *(const PG8_LAS f32x4*)(ev + 256 + wc * 32 + 8 * fq + bj * HALF + 4 * n); }
#pragma unroll
        for (int ai = 0; ai < 2; ++ai)
#pragma unroll
            for (int m = 0; m < 4; ++m) { unsigned char* rowp = (unsigned char*)O + (size_t)(row0 + ai * HALF + m * 16) * 1024 + col0;
#pragma unroll
                for (int bj = 0; bj < 2; ++bj) { const f32x4 v0 = acc[ai][bj][m][0] * cv[bj][0] + bv[bj][0], v1 = acc[ai][bj][m][1] * cv[bj][1] + bv[bj][1];
                    u32x2 w; w.x = (unsigned)__builtin_amdgcn_cvt_pk_fp8_f32(v0[2], v0[3], __builtin_amdgcn_cvt_pk_fp8_f32(v0[0], v0[1], 0, false), true);
                    w.y = (unsigned)__builtin_amdgcn_cvt_pk_fp8_f32(v1[2], v1[3], __builtin_amdgcn_cvt_pk_fp8_f32(v1[0], v1[1], 0, false), true);
                    *(u32x2*)(rowp + bj * HALF) = w; } }
    }
};

template <class Epi, class Sched, bool ALIGN_EPI = false, bool SP2 = false>
__device__ __forceinline__ void gemm_phase(PG8_LAS unsigned char* lds, const Gemm g, Sched S, const Epi& E) {
    int tid = threadIdx.x; asm volatile("" : "+v"(tid));
    const int wid = __builtin_amdgcn_readfirstlane(tid >> 6), lane = tid & 63, wr = wid >> 2, wc = wid & 3, fr = lane & 15, fq = lane >> 4;
    const int K = g.K, nt = K / BK;
    unsigned voffB[2]; int sR[2], sC[2];
#pragma unroll
    for (int i = 0; i < 2; ++i) { int R, C; stage_rc(tid * 16 + i * 8192, R, C); const int Rb = Epi::PERM ? ((R & ~31) + perm32(R & 31)) : R;
        sR[i] = R; sC[i] = C; voffB[i] = (unsigned)(Rb * K + C) * 2u; }
    const size_t kstep = (size_t)(BK * 2);
    const size_t hstep = (size_t)HALF * K * 2;
    const unsigned ldsw = (unsigned)wid * 1024u;
    const int aoff = lds_byte(wr * 64 + fr, fq * 8), boff = lds_byte(wc * 32 + fr, fq * 8);
#define PG8_SA(b, h) (((b) * 2 + (h)) * HTB)
#define PG8_SB(b, h) ((4 + (b) * 2 + (h)) * HTB)
#define PG8_STAGE(bufoff, gbase, voff) do { _Pragma("unroll") for (int _i = 0; _i < 2; ++_i) \
        __builtin_amdgcn_global_load_lds((const unsigned*)((const char*)(gbase) + (voff)[_i]), (PG8_LAS unsigned*)(lds + (bufoff) + ldsw + _i * 8192), 16, 0, 0); } while (0)
#define PG8_STAGE_A(bufoff, gbase, vo, h) do { _Pragma("unroll") for (int _i = 0; _i < 2; ++_i) \
        __builtin_amdgcn_global_load_lds((const unsigned*)((const char*)(gbase) + (vo)[h][_i]), (PG8_LAS unsigned*)(lds + (bufoff) + ldsw + _i * 8192), 16, 0, 0); } while (0)
#define PG8_LDA(dst, b, h) do { _Pragma("unroll") for (int m = 0; m < 4; ++m) dst[m].set(*(const PG8_LAS bf16x8*)(lds + PG8_SA(b, h) + aoff + m * 2048), *(const PG8_LAS bf16x8*)(lds + PG8_SA(b, h) + aoff + m * 2048 + 1024)); } while (0)
#define PG8_LDB(dst, b, h) do { _Pragma("unroll") for (int n = 0; n < 2; ++n) dst[n].set(*(const PG8_LAS bf16x8*)(lds + PG8_SB(b, h) + boff + n * 2048), *(const PG8_LAS bf16x8*)(lds + PG8_SB(b, h) + boff + n * 2048 + 1024)); } while (0)
#define PG8_MMA(ai, bj, At, Bt) do { __builtin_amdgcn_s_setprio(1); _Pragma("unroll") for (int m = 0; m < 4; ++m) _Pragma("unroll") for (int n = 0; n < 2; ++n) { \
        if constexpr (Epi::F8) asm volatile("v_mfma_scale_f32_16x16x128_f8f6f4 %0, %1, %2, %0, %3, %3 op_sel_hi:[0,0,0]" : "+v"(acc[ai][bj][m][n]) : "v"(Bt[n].v), "v"(At[m].v), "v"(f8scale)); \
        else { _Pragma("unroll") for (int k = 0; k < 2; ++k) { \
            if constexpr (Epi::I8) acc[ai][bj][m][n] = __builtin_bit_cast(f32x4, __builtin_amdgcn_mfma_i32_16x16x64_i8(__builtin_bit_cast(i32x4, Bt[n].v[k]), __builtin_bit_cast(i32x4, At[m].v[k]), __builtin_bit_cast(i32x4, acc[ai][bj][m][n]), 0, 0, 0)); \
            else acc[ai][bj][m][n] = __builtin_amdgcn_mfma_f32_16x16x32_bf16(Bt[n].v[k], At[m].v[k], acc[ai][bj][m][n], 0, 0, 0); } } } __builtin_amdgcn_s_setprio(0); } while (0)
#define PG8_WAIT_V(n) asm volatile("s_waitcnt vmcnt(" #n ")" ::: "memory")
#define PG8_WAIT_L(n) asm volatile("s_waitcnt lgkmcnt(" #n ")" ::: "memory")
#define PG8_BAR __builtin_amdgcn_s_barrier()
#define PG8_SCHED __builtin_amdgcn_sched_barrier(0)
    Unit cur, nxt; int ui = 0;
#ifdef GEMM_TIME
    long long gacc_ = 0;
#endif
    S.prologue(lds, tid);
    if (!S.next(0, cur)) return;
    f32x4 acc[2][2][4][2];
#pragma unroll
    for (int a = 0; a < 2; ++a)
#pragma unroll
        for (int b = 0; b < 2; ++b)
#pragma unroll
            for (int m = 0; m < 4; ++m)
#pragma unroll
                for (int n = 0; n < 2; ++n) acc[a][b][m][n] = (f32x4){0.f, 0.f, 0.f, 0.f};
    Frag<Epi::F8> At[4], B0[2], B1[2];
    const int f8scale = 0x7f7f7f7f;
    (void)f8scale;
    const char* cA = S.a_base(g, cur); const char* cB = S.b_base(g, cur);
    unsigned voC[2][2], voN[2][2];
    S.a_off(g, cur, sR, sC, voC);
    S.a_ready(cur);
    static_assert(SP2, "only the two-MFMA-blocks-per-barrier-pair loop is kept");
    PG8_STAGE(PG8_SB(0, 0), cB, voffB); PG8_STAGE(PG8_SB(0, 1), cB + hstep, voffB); PG8_STAGE_A(PG8_SA(0, 0), cA, voC, 0); PG8_STAGE_A(PG8_SA(0, 1), cA, voC, 1);
    if (wr == 1) PG8_BAR;
    PG8_WAIT_V(2); PG8_BAR;
    PG8_STAGE(PG8_SB(1, 0), cB + kstep, voffB); PG8_STAGE_A(PG8_SA(1, 0), cA + kstep, voC, 0); PG8_STAGE(PG8_SB(1, 1), cB + hstep + kstep, voffB);
    PG8_WAIT_V(6); PG8_BAR;
    for (;;) {
        const bool has_next = S.next(ui + 1, nxt);
        const char* nA = has_next ? S.a_base(g, nxt) : cA; const char* nB = has_next ? S.b_base(g, nxt) : cB;
        if (has_next && !Sched::LATE) S.a_off(g, nxt, sR, sC, voN); else {
#pragma unroll
            for (int h_ = 0; h_ < 2; ++h_) { voN[h_][0] = voC[h_][0]; voN[h_][1] = voC[h_][1]; } }
        if constexpr (Sched::LATE) { if (has_next) S.a_req(nxt, lds, wid, lane, ui + 1); }
#pragma unroll 1
        for (int t = 0; t < nt; t += 2) {
            const bool last = (t == nt - 2);
            const char* a1 = cA + (size_t)(t + 1) * kstep;
            const char* a2 = last ? nA : cA + (size_t)(t + 2) * kstep; const char* b2 = last ? nB : cB + (size_t)(t + 2) * kstep;
            const char* a3 = a2 + kstep; const char* b3 = b2 + kstep;
            if (last && has_next) S.a_ready(nxt);
            if constexpr (Sched::LATE) { if (last && has_next) S.a_off_lds(g, lds, ui + 1, sR, sC, voN); }
            if constexpr (Epi::EPF) { if (last && wid == 0) E.prefetch(cur, lds + EPF_OFF, lane); }
            unsigned vo2[2][2];
#pragma unroll
            for (int h_ = 0; h_ < 2; ++h_) { vo2[h_][0] = last ? voN[h_][0] : voC[h_][0]; vo2[h_][1] = last ? voN[h_][1] : voC[h_][1]; }
            PG8_LDB(B0, 0, 0); PG8_LDB(B1, 0, 1); PG8_SCHED; PG8_LDA(At, 0, 0); PG8_STAGE_A(PG8_SA(1, 1), a1, voC, 1);
            PG8_WAIT_V(8); PG8_WAIT_L(0); PG8_BAR; PG8_MMA(0, 0, At, B0); PG8_MMA(0, 1, At, B1); PG8_BAR; PG8_SCHED;
            PG8_LDA(At, 0, 1); PG8_STAGE(PG8_SB(0, 0), b2, voffB); PG8_STAGE(PG8_SB(0, 1), b2 + hstep, voffB); PG8_STAGE_A(PG8_SA(0, 0), a2, vo2, 0);
            PG8_WAIT_V(8); PG8_WAIT_L(0); PG8_BAR; PG8_MMA(1, 0, At, B0); PG8_MMA(1, 1, At, B1); PG8_BAR; PG8_SCHED;
            PG8_LDB(B0, 1, 0); PG8_LDB(B1, 1, 1); PG8_SCHED; PG8_LDA(At, 1, 0); PG8_STAGE_A(PG8_SA(0, 1), a2, vo2, 1);
            PG8_WAIT_V(8); PG8_WAIT_L(0); PG8_BAR; PG8_MMA(0, 0, At, B0); PG8_MMA(0, 1, At, B1); PG8_BAR; PG8_SCHED;
            PG8_LDA(At, 1, 1); PG8_STAGE(PG8_SB(1, 0), b3, voffB); PG8_STAGE(PG8_SB(1, 1), b3 + hstep, voffB); PG8_STAGE_A(PG8_SA(1, 0), a3, vo2, 0);
            PG8_WAIT_V(8); PG8_WAIT_L(0); PG8_BAR; PG8_MMA(1, 0, At, B0); PG8_MMA(1, 1, At, B1); PG8_BAR; PG8_SCHED;
        }
        if constexpr (ALIGN_EPI) { if (wr == 0) PG8_BAR; }
#ifdef GEMM_TIME
        const long long gt0_ = clock64();
#endif
        if constexpr (!Epi::AFTER_DRAIN) { if constexpr (Epi::EPF) E(acc, cur, wr, wc, fr, fq, (const PG8_LAS float*)(lds + EPF_OFF)); else E(acc, cur, wr, wc, fr, fq); S.done(cur); }
#ifdef GEMM_TIME
        if (GEMM_TIME == 100 || GEMM_TIME == Epi::ID) gacc_ += clock64() - gt0_;
#endif
        if (!has_next) break;
#pragma unroll
        for (int a = 0; a < 2; ++a)
#pragma unroll
            for (int b = 0; b < 2; ++b)
#pragma unroll
                for (int m = 0; m < 4; ++m)
#pragma unroll
                    for (int n = 0; n < 2; ++n) acc[a][b][m][n] = (f32x4){0.f, 0.f, 0.f, 0.f};
        cur = nxt; cA = nA; cB = nB; ++ui;
#pragma unroll
        for (int h_ = 0; h_ < 2; ++h_) { voC[h_][0] = voN[h_][0]; voC[h_][1] = voN[h_][1]; }
        if constexpr (ALIGN_EPI) { if (wr == 1) PG8_BAR; }
    }
    PG8_WAIT_V(0);
    if constexpr (!ALIGN_EPI) { if (wr == 0) PG8_BAR; }
    PG8_BAR;
#ifdef GEMM_TIME
    { const long long s0_ = clock64(); while (clock64() - s0_ < gacc_) __builtin_amdgcn_s_sleep(8); }
#endif
    if constexpr (Epi::AFTER_DRAIN) { E.fused(acc, cur, wr, wc, fr, fq, lds, wid, lane); S.done(cur); }
#undef PG8_SA
#undef PG8_SB
#undef PG8_STAGE
#undef PG8_STAGE_A
#undef PG8_LDA
#undef PG8_LDB
#undef PG8_MMA
#undef PG8_WAIT_V
#undef PG8_WAIT_L
#undef PG8_BAR
#undef PG8_SCHED
}
}

constexpr int NWAVES = 8;
constexpr int T = 32768, D = 1024, SEQ = 8192, NBATCH = 4, NCHUNK = SEQ / 64;
constexpr int INC = 3328;
constexpr int PRW = 1536;
constexpr int NEXP = 32, TOPK = 4;
constexpr int NRB_MAX = T * TOPK / 256 + NEXP;
constexpr int NROWS_MAX = NRB_MAX * 256;
constexpr int NITEM = NBATCH * NCHUNK * 8;

constexpr size_t MiB = 1u << 20, KiB = 1u << 10;
constexpr size_t WS_CTL = 0, CTL_ZERO_BYTES = 1 * MiB;
constexpr size_t WS_META = 1 * MiB;
constexpr size_t WS_CNT = 1 * MiB + 64 * KiB;
constexpr size_t WS_EIDX = 2 * MiB, WS_GATE = 2 * MiB + 512 * KiB, WS_LRANK = 3 * MiB, WS_INV = 3 * MiB + 512 * KiB;
constexpr size_t WS_RSTD = 4 * MiB, WS_ROWRSTD = 4 * MiB + 256 * KiB;
constexpr size_t WS_WRT = 5 * MiB;
constexpr size_t WS_PAR = 5 * MiB + 128 * KiB;
constexpr size_t WS_WDEC = 5 * MiB + 256 * KiB, WS_WAAA = WS_WDEC + 64 * KiB, WS_WGATE = WS_WAAA + 64 * KiB;
constexpr size_t WS_WIN = 6 * MiB, WS_WOUT = 13 * MiB;
constexpr size_t WS_ROWTOK = 15 * MiB;
constexpr size_t WS_WUP = 16 * MiB, WS_WDN = 144 * MiB;
constexpr size_t WS_XN = 208 * MiB;
constexpr size_t WS_PROJ = 272 * MiB;
constexpr size_t WS_MIX = 480 * MiB;
constexpr size_t WS_RW = 544 * MiB;
constexpr size_t WS_XG = 272 * MiB, WS_ACT = 544 * MiB, WS_YR = WS_XG;
constexpr size_t WS_COLSC = 15 * MiB + 640 * KiB;
constexpr size_t WS_COLSC1 = 5 * MiB + 192 * KiB;
constexpr size_t WS_XNSC = WS_RSTD;
constexpr size_t WS_COLSC2 = 15 * MiB + 896 * KiB;
constexpr size_t WS_XQ = WS_MIX;
constexpr size_t WS_END = 1000 * MiB;
constexpr int CW_ATT = 8192;
constexpr int CW_BAR = 4096;

constexpr int RING_BYTES = 131072;
constexpr int LDS_BYTES = 163840;
constexpr int MISC_OFF = LDS_BYTES - 256;

#define GAS __attribute__((address_space(1)))
#define LAS __attribute__((address_space(3)))
#define DI __device__ __forceinline__
typedef unsigned short bf16;
typedef unsigned v4u __attribute__((ext_vector_type(4)));
typedef unsigned v2u __attribute__((ext_vector_type(2)));
typedef float f32x4 __attribute__((ext_vector_type(4)));
typedef float f32x2 __attribute__((ext_vector_type(2)));
typedef short bf16x8 __attribute__((ext_vector_type(8)));
typedef __bf16 bf16x2_t __attribute__((ext_vector_type(2)));
#define LDS_WAIT() asm volatile("s_waitcnt lgkmcnt(0)" ::: "memory")
#define VM_WAIT() asm volatile("s_waitcnt vmcnt(0)" ::: "memory")
DI unsigned pk2(float lo, float hi) { const f32x2 v = {lo, hi}; const bf16x2_t b = __builtin_convertvector(v, bf16x2_t); return __builtin_bit_cast(unsigned, b); }
DI float bf2f(unsigned short b) { return __uint_as_float((unsigned)b << 16); }
DI float bflo(unsigned w) { return __uint_as_float(w << 16); }
DI float bfhi(unsigned w) { return __uint_as_float(w & 0xffff0000u); }
DI float wave_sum(float v) {
#pragma unroll
    for (int o = 1; o < 64; o <<= 1) v += __shfl_xor(v, o);
    return v;
}
DI float wave_max(float v) {
#pragma unroll
    for (int o = 1; o < 64; o <<= 1) v = fmaxf(v, __shfl_xor(v, o));
    return v;
}
DI float sigmoidf_(float x) { return 1.0f / (1.0f + __expf(-x)); }

DI float quad_sum(float x) {
    const unsigned a = __builtin_bit_cast(unsigned, x); const auto r = __builtin_amdgcn_permlane32_swap(a, a, false, false);
    const float y = __builtin_bit_cast(float, (unsigned)r[0]) + __builtin_bit_cast(float, (unsigned)r[1]);
    const unsigned b = __builtin_bit_cast(unsigned, y); const auto s = __builtin_amdgcn_permlane16_swap(b, b, false, false);
    return __builtin_bit_cast(float, (unsigned)s[0]) + __builtin_bit_cast(float, (unsigned)s[1]);
}
DI float quad_max(float x) {
    const unsigned a = __builtin_bit_cast(unsigned, x); const auto r = __builtin_amdgcn_permlane32_swap(a, a, false, false);
    const float y = fmaxf(__builtin_bit_cast(float, (unsigned)r[0]), __builtin_bit_cast(float, (unsigned)r[1]));
    const unsigned b = __builtin_bit_cast(unsigned, y); const auto s = __builtin_amdgcn_permlane16_swap(b, b, false, false);
    return fmaxf(__builtin_bit_cast(float, (unsigned)s[0]), __builtin_bit_cast(float, (unsigned)s[1]));
}
#define XB_TMO      128
#define XB_XCNT(j)  (256  + 64 * (j))
#define XB_XSUB(j)  (1280 + 64 * (j))
#define XB_XGEN(j)  (2304 + 64 * (j))
#define XB_TOP      3328
#define XB_TOPGEN   3392
#define XCD_BAR_WORDS 3456
#define XB_SPIN_CAP (NAIVE_RWKV ? (1u << 25) : (1u << 20))

__device__ __forceinline__ unsigned xb_ld(unsigned* p)              { return __hip_atomic_load(p, __ATOMIC_RELAXED, __HIP_MEMORY_SCOPE_AGENT); }
__device__ __forceinline__ unsigned xb_add(unsigned* p, unsigned v) { return __hip_atomic_fetch_add(p, v, __ATOMIC_RELAXED, __HIP_MEMORY_SCOPE_AGENT); }
__device__ __forceinline__ unsigned xb_xcc_id() { return (unsigned)__builtin_amdgcn_s_getreg((3 << 11) | 20) & 0xFu; }
#define XB_SPIN(cond, bar) do { unsigned _sp = 0; while (cond) { __builtin_amdgcn_s_sleep(1); \
    if ((++_sp & 255u) == 0u) { if (xb_ld(&(bar)[XB_TMO])) break; if (_sp > XB_SPIN_CAP) { atomicAdd(&(bar)[XB_TMO], 1u); break; } } } } while (0)

struct XcdBarrier {
    unsigned* bar; unsigned x;
    volatile LAS unsigned* st;
};

__device__ __forceinline__ XcdBarrier xcd_barrier_post(unsigned* bar, volatile LAS unsigned* st) {
    XcdBarrier b; b.bar = bar; b.x = xb_xcc_id(); b.st = st;
    if (threadIdx.x == 0) (void)xb_add(&bar[XB_XCNT(b.x)], 1u);
    return b;
}
__device__ __forceinline__ void xcd_barrier_complete(unsigned* bar, unsigned x, unsigned& nloc, unsigned& nx) {
    const unsigned G = gridDim.x * gridDim.y * gridDim.z;
    unsigned sum, cnt, mine, sp = 0u;
    for (;;) {
        sum = 0u; cnt = 0u; mine = 0u;
#pragma unroll
        for (unsigned j = 0; j < 16; ++j) { const unsigned c = xb_ld(&bar[XB_XCNT(j)]); sum += c; cnt += (c > 0u) ? 1u : 0u; mine = (j == x) ? c : mine; }
        if (sum == G) break;
        __builtin_amdgcn_s_sleep(1);
        if ((++sp & 255u) == 0u) { if (xb_ld(&bar[XB_TMO])) break; if (sp > XB_SPIN_CAP) { atomicAdd(&bar[XB_TMO], 1u); break; } }
    }
    nloc = mine > 0u ? mine : 1u; nx = cnt > 0u ? cnt : 1u;
}

__device__ __forceinline__ void xcd_barrier(const XcdBarrier& b) {
    asm volatile("s_waitcnt vmcnt(0)" ::: "memory");
    __syncthreads();
    if (threadIdx.x == 0) {
        unsigned* bar = b.bar;
        __builtin_amdgcn_s_waitcnt(0);
        unsigned nloc = b.st[0], nx = b.st[1];
        if (nloc == 0u) { xcd_barrier_complete(bar, b.x, nloc, nx); b.st[0] = nloc; b.st[1] = nx; }
        const unsigned old = xb_add(&bar[XB_XSUB(b.x)], 1u);
        const unsigned gen = old / nloc;
        if (old + 1u == (gen + 1u) * nloc) {
            __builtin_amdgcn_fence(__ATOMIC_RELEASE, "agent");
            asm volatile("s_waitcnt vmcnt(0)" ::: "memory");
            const unsigned og = xb_add(&bar[XB_TOP], 1u);
            const unsigned tg = og / nx;
            if (og + 1u == (tg + 1u) * nx) xb_add(&bar[XB_TOPGEN], 1u);
            else XB_SPIN(xb_ld(&bar[XB_TOPGEN]) == tg, bar);
            __builtin_amdgcn_fence(__ATOMIC_ACQUIRE, "agent");
            xb_add(&bar[XB_XGEN(b.x)], 1u);
            asm volatile("s_waitcnt vmcnt(0)" ::: "memory");
        } else {
            XB_SPIN(xb_ld(&bar[XB_XGEN(b.x)]) == gen, bar);
            __builtin_amdgcn_fence(__ATOMIC_ACQUIRE, "agent");
            asm volatile("s_waitcnt vmcnt(0)" ::: "memory");
        }
    }
    __syncthreads();
}

struct Args {
    const float* in[25]; float* out; unsigned char* ws; int ph_lo, ph_hi, ph_rep, pad_;
};
enum { I_X = 0, I_N1G, I_WIN, I_MU, I_QG, I_KG, I_RELB, I_W0, I_WDEC, I_A0, I_WAAA, I_WGATE, I_KK, I_KA, I_RK, I_LNG, I_LNB, I_WOUT, I_N2G, I_WR, I_BR, I_WUP, I_BUP, I_WDN, I_BDN };
struct Frame {
    LAS unsigned char* lds;
    int tid, lane, wave, G, bid;
};


struct TrRegs { f32x4 v[8]; f32x4 s0, s1; bf16* dst; int ldo; };
DI void tr_load(TrRegs& t, const float* __restrict__ W, int ldw, int k0, int n0, bf16* WT, int ldo, long drow, int lane, const float* __restrict__ ksc8 = nullptr) {
    const int r8 = lane >> 3, c4 = lane & 7;
    t.s0 = (f32x4){1.f, 1.f, 1.f, 1.f}; t.s1 = t.s0; if (ksc8) { t.s0 = *(const f32x4*)ksc8; t.s1 = *(const f32x4*)(ksc8 + 4); }
    const float* src = W + (size_t)(k0 + 8 * r8) * ldw + n0 + 4 * c4;
#pragma unroll
    for (int i = 0; i < 8; ++i) t.v[i] = __builtin_nontemporal_load((const f32x4*)(src + (size_t)i * ldw));
    t.dst = WT + (size_t)(drow + 4 * c4) * ldo + k0 + 8 * r8; t.ldo = ldo;
}
DI void tr_store(const TrRegs& t, const float* __restrict__ = nullptr) {
    const f32x4 s0 = t.s0, s1 = t.s1;
#pragma unroll
    for (int j = 0; j < 4; ++j) { const v4u o = {pk2(t.v[0][j] * s0[0], t.v[1][j] * s0[1]), pk2(t.v[2][j] * s0[2], t.v[3][j] * s0[3]), pk2(t.v[4][j] * s1[0], t.v[5][j] * s1[1]), pk2(t.v[6][j] * s1[2], t.v[7][j] * s1[3])};
        __builtin_nontemporal_store(o, (v4u*)(t.dst + (size_t)j * t.ldo)); }
}
DI void tr_item(const float* __restrict__ W, int ldw, int k0, int n0, bf16* WT, int ldo, long drow, LAS float* scr, int lane, const float* __restrict__ ksc) {
    (void)scr; TrRegs t; tr_load(t, W, ldw, k0, n0, WT, ldo, drow, lane, ksc ? ksc + k0 + 8 * (lane >> 3) : nullptr); tr_store(t);
}
constexpr int MOE_TR_UP = NEXP * 16 * 64, MOE_TR_DN = NEXP * 16 * 32, MOE_TR_ALL = MOE_TR_UP + MOE_TR_DN;
DI const float* moe_tr_load(TrRegs& t, const Args& a, int r, int lane) {
    unsigned char* ws = a.ws;
    if (r < MOE_TR_UP) { const int e = r / 1024, kb = (r % 1024) / 64, nb = r % 64, n0 = 32 * nb; const int n1 = n0 & 1023;
        const long drow = (long)(n1 / 128) * 256 + (n0 >= 1024 ? 128 : 0) + (n1 % 128);
        tr_load(t, a.in[I_WUP] + (size_t)e * 1024 * 2048, 2048, 64 * kb, n0, (bf16*)(ws + WS_WUP) + (size_t)e * 2048 * 1024, 1024, drow, lane, a.in[I_N2G] + 64 * kb + 8 * (lane >> 3));
        return nullptr; }
    r -= MOE_TR_UP; const int e = r / 512, kb = (r % 512) / 32, nb = r % 32;
    tr_load(t, a.in[I_WDN] + (size_t)e * 1024 * 1024, 1024, 64 * kb, 32 * nb, (bf16*)(ws + WS_WDN) + (size_t)e * 1024 * 1024, 1024, 32 * nb, lane);
    return nullptr;
}
DI void moe_tr_item(const Args& a, int r, LAS float* scr, int lane) { (void)scr; TrRegs t; const float* s = moe_tr_load(t, a, r, lane); tr_store(t, s); }
DI unsigned q_pack4(float a, float b, float c, float d) {
    const unsigned ua = __builtin_bit_cast(unsigned, a), ub = __builtin_bit_cast(unsigned, b), uc = __builtin_bit_cast(unsigned, c), ud = __builtin_bit_cast(unsigned, d);
    return (ua & 0xffu) | ((ub & 0xffu) << 8) | ((uc & 0xffu) << 16) | (ud << 24); }
constexpr float Q_MAGIC = 12582912.0f;
template <bool DOWN>
DI void moe_q_batch(const Args& a, int batch, int wave, int lane, LAS float* exch) {
    unsigned char* ws = a.ws;
    constexpr int LDW = DOWN ? 1024 : 2048, SPE = LDW / 32;
    constexpr float QMAX = DOWN ? 256.0f : 127.0f;
    asm volatile("" : "+v"(lane));
    const int r8 = lane >> 3, c4 = lane & 7;
    const float* gk = a.in[I_N2G] + 128 * wave + 8 * r8;
    const f32x4 one = {1.f, 1.f, 1.f, 1.f};
    f32x4 s0[2], s1[2];
#pragma unroll
    for (int t = 0; t < 2; ++t) { s0[t] = DOWN ? one : *(const f32x4*)(gk + 64 * t); s1[t] = DOWN ? one : *(const f32x4*)(gk + 64 * t + 4); }
    f32x4 v[2][2][8]; const int loff = 8 * r8 * LDW + 4 * c4;
#define MQ_LOAD(buf, s_) do { const int strip_ = batch * 4 + (s_), e_ = strip_ / SPE, n0_ = 32 * (strip_ % SPE); \
        const float* W_ = a.in[DOWN ? I_WDN : I_WUP] + (size_t)e_ * 1024 * LDW + (size_t)(128 * wave) * LDW + n0_;     \
        _Pragma("unroll") for (int t = 0; t < 2; ++t) _Pragma("unroll") for (int i = 0; i < 8; ++i) v[buf][t][i] = __builtin_nontemporal_load((const f32x4*)(W_ + (size_t)(64 * t + i) * LDW + loff)); } while (0)
    MQ_LOAD(0, 0);
#pragma unroll
    for (int s = 0; s < 4; ++s) {
        if (s < 3) MQ_LOAD((s + 1) & 1, s + 1);
        const int strip = batch * 4 + s, e = strip / SPE, n0 = 32 * (strip % SPE), n1 = n0 & 1023;
        const long drow = DOWN ? (long)n0 : (long)(n1 / 128) * 256 + (n0 >= 1024 ? 128 : 0) + (n1 % 128);
        f32x4 mx = {0.f, 0.f, 0.f, 0.f};
#pragma unroll
        for (int t = 0; t < 2; ++t)
#pragma unroll
            for (int i = 0; i < 8; ++i) { const float sc = i < 4 ? s0[t][i] : s1[t][i - 4]; const f32x4 p = v[s & 1][t][i] * sc; v[s & 1][t][i] = p;
#pragma unroll
                for (int j = 0; j < 4; ++j) mx[j] = fmaxf(mx[j], fabsf(p[j])); }
#pragma unroll
        for (int j = 0; j < 4; ++j) { float m = mx[j]; m = fmaxf(m, __shfl_xor(m, 8)); m = fmaxf(m, __shfl_xor(m, 16)); m = fmaxf(m, __shfl_xor(m, 32)); mx[j] = m; }
        LAS float* ex = exch + (s & 1) * 256;
        if (r8 == 0) *(LAS f32x4*)(ex + (wave * 8 + c4) * 4) = mx;
        __syncthreads();
#pragma unroll
        for (int w2 = 0; w2 < 8; ++w2) { const f32x4 o = *(const LAS f32x4*)(ex + (w2 * 8 + c4) * 4);
#pragma unroll
            for (int j = 0; j < 4; ++j) mx[j] = fmaxf(mx[j], o[j]); }
        if (wave == 0 && r8 == 0) *(f32x4*)((float*)(ws + (DOWN ? WS_COLSC2 : WS_COLSC)) + (size_t)e * LDW + n0 + 4 * c4) = mx * (1.0f / QMAX);
        f32x4 inv;
#pragma unroll
        for (int j = 0; j < 4; ++j) inv[j] = mx[j] > 0.f ? QMAX / mx[j] : 0.f;
        unsigned char* dst = ws + (DOWN ? WS_WDN : WS_WUP) + ((size_t)e * LDW + drow + 4 * c4) * 1024 + 128 * wave + 8 * r8;
#pragma unroll
        for (int t = 0; t < 2; ++t) {
            f32x4 (&p)[8] = v[s & 1][t];
#pragma unroll
            for (int i = 0; i < 8; ++i) p[i] = DOWN ? p[i] * inv : p[i] * inv + Q_MAGIC;
#pragma unroll
            for (int j = 0; j < 4; ++j) { v2u o;
                if (DOWN) { o.x = (unsigned)__builtin_amdgcn_cvt_pk_fp8_f32(p[2][j], p[3][j], __builtin_amdgcn_cvt_pk_fp8_f32(p[0][j], p[1][j], 0, false), true);
                            o.y = (unsigned)__builtin_amdgcn_cvt_pk_fp8_f32(p[6][j], p[7][j], __builtin_amdgcn_cvt_pk_fp8_f32(p[4][j], p[5][j], 0, false), true); }
                else { o.x = q_pack4(p[0][j], p[1][j], p[2][j], p[3][j]); o.y = q_pack4(p[4][j], p[5][j], p[6][j], p[7][j]); }
                __builtin_nontemporal_store(o, (v2u*)(dst + (size_t)j * 1024 + 64 * t)); } }
    }
#undef MQ_LOAD
}
DI void q_strip_i8_wg(const float* __restrict__ Wsrc, int ldw, int n0, unsigned char* WT, float* colsc, int wave, int lane, LAS float* exch) {
    const int r8 = lane >> 3, c4 = lane & 7;
    const float* W = Wsrc + (size_t)(128 * wave + 8 * r8) * ldw + n0 + 4 * c4;
    f32x4 v[2][8], mx = {0.f, 0.f, 0.f, 0.f};
#pragma unroll
    for (int t = 0; t < 2; ++t)
#pragma unroll
        for (int i = 0; i < 8; ++i) v[t][i] = *(const f32x4*)(W + (size_t)(64 * t + i) * ldw);
#pragma unroll
    for (int t = 0; t < 2; ++t)
#pragma unroll
        for (int i = 0; i < 8; ++i)
#pragma unroll
            for (int j = 0; j < 4; ++j) mx[j] = fmaxf(mx[j], fabsf(v[t][i][j]));
#pragma unroll
    for (int j = 0; j < 4; ++j) { float m = mx[j]; m = fmaxf(m, __shfl_xor(m, 8)); m = fmaxf(m, __shfl_xor(m, 16)); m = fmaxf(m, __shfl_xor(m, 32)); mx[j] = m; }
    if (r8 == 0) *(LAS f32x4*)(exch + (wave * 8 + c4) * 4) = mx;
    __syncthreads();
#pragma unroll
    for (int w2 = 0; w2 < 8; ++w2) { const f32x4 o = *(const LAS f32x4*)(exch + (w2 * 8 + c4) * 4);
#pragma unroll
        for (int j = 0; j < 4; ++j) mx[j] = fmaxf(mx[j], o[j]); }
    if (wave == 0 && r8 == 0) *(f32x4*)(colsc + n0 + 4 * c4) = mx * (1.0f / 127.0f);
    f32x4 inv;
#pragma unroll
    for (int j = 0; j < 4; ++j) inv[j] = mx[j] > 0.f ? 127.0f / mx[j] : 0.f;
    unsigned char* dst = WT + (size_t)(n0 + 4 * c4) * 1024 + 128 * wave + 8 * r8;
#pragma unroll
    for (int t = 0; t < 2; ++t) {
        f32x4 p[8];
#pragma unroll
        for (int i = 0; i < 8; ++i) p[i] = v[t][i] * inv + Q_MAGIC;
#pragma unroll
        for (int j = 0; j < 4; ++j) { const v2u o = {q_pack4(p[0][j], p[1][j], p[2][j], p[3][j]), q_pack4(p[4][j], p[5][j], p[6][j], p[7][j])};
            *(v2u*)(dst + (size_t)j * 1024 + 64 * t) = o; } }
}
DI void moe_tr_batch(const Args& a, int batch, int wave, int lane, LAS float* exch) {
    if (batch < MOE_TR_UP / 64) moe_q_batch<false>(a, batch, wave, lane, exch); else moe_q_batch<true>(a, batch - MOE_TR_UP / 64, wave, lane, exch);
}
constexpr int MOE_TR_BATCHES = MOE_TR_ALL / 64, MOE_TR_EARLY = 256;

#if !NAIVE_ATT
constexpr int ATT_KS = 144;
constexpr int ATT_TILE = 64 * ATT_KS;
constexpr int ATT_BIAS_OFF = 4 * ATT_TILE;
constexpr int ATT_NSLOT = (NBATCH * 8 * (NCHUNK / 2) / 8) * 11;
static_assert(NBATCH * 8 * (NCHUNK / 2) == 2048 && MOE_TR_ALL == 256 * 3 * 64, "attention / conversion work queue");
DI int att_pos(int key) { return (key & 32) + 8 * ((key >> 2) & 3) + 4 * ((key >> 4) & 1) + (key & 3); }
DI void attn_phase(const Frame& F, const Args& a, const int qid = 0) {
    const bf16* proj = (const bf16*)(a.ws + WS_PROJ); bf16* mix = (bf16*)(a.ws + WS_MIX);
    LAS unsigned char* lds = F.lds; LAS float* sbias = (LAS float*)(lds + ATT_BIAS_OFF);
    const int w = F.wave;
    const float LOG2E = 1.4426950408889634f;
    const int srow = F.tid >> 3, spc = F.tid & 7;
    float kgv[8];
#pragma unroll
    for (int j = 0; j < 8; ++j) kgv[j] = a.in[I_KG][8 * spc + j];
    const int spos = att_pos(srow);
    LAS int* s_item = (LAS int*)(lds + ATT_BIAS_OFF + 1024);
    unsigned* qhead = (unsigned*)(a.ws + WS_CTL) + CW_ATT + 64 * qid;
    int nxt_slot = 0;
#define ATT_CLAIM() do { const int one_ = 1, zo_ = 0; asm volatile("global_atomic_add %0, %1, %2, %3 sc0" : "=&v"(nxt_slot) : "v"(zo_), "v"(one_), "s"(qhead) : "memory"); } while (0)
    if (F.tid == 0) ATT_CLAIM();
    for (;;) {
        __syncthreads();
        if (F.tid == 0) { asm volatile("s_waitcnt vmcnt(0)" : "+v"(nxt_slot) :: "memory"); *s_item = nxt_slot; }
        __syncthreads();
        const int slot = *s_item;
        if (slot >= ATT_NSLOT) break;
        if (F.tid == 0) ATT_CLAIM();
        const int grp = slot / 11, sub = slot % 11;
        if (sub >= 8) { const int base = (grp * 3 + (sub - 8)) * 64 + w * 8;
            (void)base; moe_tr_batch(a, grp * 3 + (sub - 8), w, F.lane, (LAS float*)(lds + ATT_BIAS_OFF + 2048));
            continue; }
        int l = F.lane; asm volatile("" : "+v"(l));
        const int n16 = l & 15, q = l >> 4;
        const int item = grp * 8 + sub;
        const int b = item / (8 * (NCHUNK / 2)), h = (item / (NCHUNK / 2)) & 7, n0 = 2 * (item % (NCHUNK / 2));
        if (F.tid < 192) sbias[F.tid] = a.in[I_RELB][h * 192 + F.tid] * LOG2E;
        const int nq = n0 + (w >> 2), qpos = 16 * (w & 3) + n16;
        const size_t qtok = (size_t)b * SEQ + nq * 64 + qpos;
        bf16x8 qf[2];
        { const v4u q0 = *(const v4u*)(proj + qtok * INC + h * 64 + 8 * q), q1 = *(const v4u*)(proj + qtok * INC + h * 64 + 32 + 8 * q);
          float f[16]; const unsigned ww[8] = {q0.x, q0.y, q0.z, q0.w, q1.x, q1.y, q1.z, q1.w};
          float ss = 0.f;
#pragma unroll
          for (int e = 0; e < 8; ++e) { f[2 * e] = bflo(ww[e]); f[2 * e + 1] = bfhi(ww[e]); ss += f[2 * e] * f[2 * e] + f[2 * e + 1] * f[2 * e + 1]; }
          ss = quad_sum(ss);
          const float rs = (1.0f / sqrtf(ss * (1.f / 64.f) + 1e-6f)) * 0.125f * LOG2E;
          unsigned pk[8];
#pragma unroll
          for (int e = 0; e < 8; ++e) { const int d = (e < 4 ? 0 : 32) + 8 * q + 2 * (e & 3); pk[e] = pk2(f[2 * e] * rs * a.in[I_QG][d], f[2 * e + 1] * rs * a.in[I_QG][d + 1]); }
          const v4u p0 = {pk[0], pk[1], pk[2], pk[3]}, p1 = {pk[4], pk[5], pk[6], pk[7]};
          qf[0] = __builtin_bit_cast(bf16x8, p0); qf[1] = __builtin_bit_cast(bf16x8, p1); }
        f32x4 o[4];
#pragma unroll
        for (int dt = 0; dt < 4; ++dt) o[dt] = (f32x4){0.f, 0.f, 0.f, 0.f};
        float m_run = -3.0e38f, l_run = 0.f;
        v4u kreg, vreg;
        auto gload = [&](int jc) { const int kc = n0 - 8 + jc; if (kc >= 0) { const size_t tok = (size_t)b * SEQ + kc * 64 + srow;
            kreg = *(const v4u*)(proj + tok * INC + 512 + h * 64 + 8 * spc); vreg = *(const v4u*)(proj + tok * INC + 1024 + h * 64 + 8 * spc); } };
        auto lstore = [&](int jc) { const int kc = n0 - 8 + jc; if (kc >= 0) { LAS unsigned char* kb = lds + (jc & 1) * 2 * ATT_TILE; LAS unsigned char* vb = kb + ATT_TILE;
            const unsigned ww[4] = {kreg.x, kreg.y, kreg.z, kreg.w}; float f[8]; float ss = 0.f;
#pragma unroll
            for (int e = 0; e < 4; ++e) { f[2 * e] = bflo(ww[e]); f[2 * e + 1] = bfhi(ww[e]); ss += f[2 * e] * f[2 * e] + f[2 * e + 1] * f[2 * e + 1]; }
            ss += __builtin_bit_cast(float, __builtin_amdgcn_update_dpp(0, __builtin_bit_cast(int, ss), 0xB1, 0xf, 0xf, true));
            ss += __builtin_bit_cast(float, __builtin_amdgcn_update_dpp(0, __builtin_bit_cast(int, ss), 0x4E, 0xf, 0xf, true));
            ss += __builtin_bit_cast(float, __builtin_amdgcn_update_dpp(0, __builtin_bit_cast(int, ss), 0x141, 0xf, 0xf, true));
            const float rs = 1.0f / sqrtf(ss * (1.f / 64.f) + 1e-6f);
            v4u kk; kk.x = pk2(f[0] * rs * kgv[0], f[1] * rs * kgv[1]); kk.y = pk2(f[2] * rs * kgv[2], f[3] * rs * kgv[3]); kk.z = pk2(f[4] * rs * kgv[4], f[5] * rs * kgv[5]); kk.w = pk2(f[6] * rs * kgv[6], f[7] * rs * kgv[7]);
            *(LAS v4u*)(kb + srow * ATT_KS + 16 * spc) = kk;
            const unsigned vv[4] = {vreg.x, vreg.y, vreg.z, vreg.w};
#pragma unroll
            for (int e = 0; e < 4; ++e) { *(LAS unsigned short*)(vb + (8 * spc + 2 * e) * ATT_KS + 2 * spos) = (unsigned short)(vv[e] & 0xffffu);
                                          *(LAS unsigned short*)(vb + (8 * spc + 2 * e + 1) * ATT_KS + 2 * spos) = (unsigned short)(vv[e] >> 16); } } };
        gload(0); lstore(0);
        __syncthreads();
        for (int jc = 0; jc < 10; ++jc) {
            if (jc + 1 < 10) gload(jc + 1);
            const int kc = n0 - 8 + jc, dj = jc - (w >> 2);
            if (kc >= 0 && dj >= 0 && dj <= 8) {
                const LAS unsigned char* kb = lds + (jc & 1) * 2 * ATT_TILE; const LAS unsigned char* vb = kb + ATT_TILE;
                f32x4 sc[4];
#pragma unroll
                for (int mt = 0; mt < 4; ++mt) { sc[mt] = (f32x4){0.f, 0.f, 0.f, 0.f};
#pragma unroll
                    for (int ks = 0; ks < 2; ++ks) { const bf16x8 kf = *(const LAS bf16x8*)(kb + (16 * mt + n16) * ATT_KS + 64 * ks + 16 * q);
                        sc[mt] = __builtin_amdgcn_mfma_f32_16x16x32_bf16(kf, qf[ks], sc[mt], 0, 0, 0); } }
                float boff = 0.f;
                if (dj <= 5) boff = sbias[0];
                else { const int base = (dj - 8) * 64 - qpos + 128;
#pragma unroll
                    for (int mt = 0; mt < 4; ++mt)
#pragma unroll
                        for (int i = 0; i < 4; ++i) { int idx = base + 16 * mt + 4 * q + i; idx = idx < 0 ? 0 : idx; const float bv_ = sbias[idx];
                            sc[mt][i] += bv_; } }
                float mx = sc[0][0];
#pragma unroll
                for (int mt = 0; mt < 4; ++mt)
#pragma unroll
                    for (int i = 0; i < 4; ++i) mx = fmaxf(mx, sc[mt][i]);
                mx = quad_max(mx);
                const float m_new = fmaxf(m_run, mx + boff), alpha = __builtin_amdgcn_exp2f(m_run - m_new), msub = m_new - boff;
                const bool moved = __builtin_amdgcn_ballot_w64(m_new != m_run) != 0ull;
                m_run = m_new; float ls = 0.f;
#pragma unroll
                for (int mt = 0; mt < 4; ++mt)
#pragma unroll
                    for (int i = 0; i < 4; ++i) { sc[mt][i] = __builtin_amdgcn_exp2f(sc[mt][i] - msub); ls += sc[mt][i]; }
                if (moved) { l_run *= alpha;
#pragma unroll
                    for (int dt = 0; dt < 4; ++dt) o[dt] = o[dt] * alpha; }
                l_run += ls;
#pragma unroll
                for (int s = 0; s < 2; ++s) {
                    const v4u pp = {pk2(sc[2 * s][0], sc[2 * s][1]), pk2(sc[2 * s][2], sc[2 * s][3]), pk2(sc[2 * s + 1][0], sc[2 * s + 1][1]), pk2(sc[2 * s + 1][2], sc[2 * s + 1][3])};
                    const bf16x8 pf = __builtin_bit_cast(bf16x8, pp);
#pragma unroll
                    for (int dt = 0; dt < 4; ++dt) { const bf16x8 vf = *(const LAS bf16x8*)(vb + (16 * dt + n16) * ATT_KS + 64 * s + 16 * q);
                        o[dt] = __builtin_amdgcn_mfma_f32_16x16x32_bf16(vf, pf, o[dt], 0, 0, 0); } }
            }
            if (jc + 1 < 10) lstore(jc + 1);
            __syncthreads();
        }
        l_run = quad_sum(l_run);
        const float inv = 1.0f / l_run;
#pragma unroll
        for (int dt = 0; dt < 4; ++dt) { v2u ov; ov.x = pk2(o[dt][0] * inv, o[dt][1] * inv); ov.y = pk2(o[dt][2] * inv, o[dt][3] * inv);
            *(v2u*)(mix + qtok * 1024 + h * 64 + 16 * dt + 4 * q) = ov; }
    }
}
#endif

#if !NAIVE_RWKV
constexpr int RA_HALF = 80896;
constexpr int RA_RT = 0, RA_KT = 9216, RA_BT = 18432, RA_AT = 27648;
constexpr int RA_VT = 36864, RA_KH = 46080, RA_BH = 55296;
constexpr int RA_AAB = 64512;
constexpr int RA_XWD = 0, RA_XAD = 9216, RA_XGD = 18432;
constexpr int RA_RHS2 = 0, RA_GEND = 17408;
constexpr int RA_W1T = 18432, RA_W2T = 27648;
constexpr int RA_WT = RA_AAB;
constexpr int RB_REC = 65536, RB_YLT = 0, RB_PCT = 8192, RB_G1T = 16384, RB_E2T = 24576, RB_MC = 32768, RB_CC = 40960, RB_SC = 57344;
static_assert(2 * RA_HALF <= MISC_OFF, "rwkv phase A LDS");

DI void ld8f(const bf16* p, float (&f)[8]) { const v4u w = *(const v4u*)p; f[0] = bflo(w.x); f[1] = bfhi(w.x); f[2] = bflo(w.y); f[3] = bfhi(w.y); f[4] = bflo(w.z); f[5] = bfhi(w.z); f[6] = bflo(w.w); f[7] = bfhi(w.w); }
DI void ld4f(const bf16* p, float (&f)[4]) { const v2u w = *(const v2u*)p; f[0] = bflo(w.x); f[1] = bfhi(w.x); f[2] = bflo(w.y); f[3] = bfhi(w.y); }
DI bf16x8 pack8(const f32x4& a, const f32x4& b) { const v4u p = {pk2(a[0], a[1]), pk2(a[2], a[3]), pk2(b[0], b[1]), pk2(b[2], b[3])}; return __builtin_bit_cast(bf16x8, p); }
DI float fast_sigmoid(float x) { return __builtin_amdgcn_rcpf(1.0f + __builtin_amdgcn_exp2f(-1.4426950408889634f * x)); }
DI float fast_tanh(float x) { return 1.0f - 2.0f * __builtin_amdgcn_rcpf(1.0f + __builtin_amdgcn_exp2f(2.8853900817779268f * x)); }
#define MFMA16(a, b, c) __builtin_amdgcn_mfma_f32_16x16x32_bf16((a), (b), (c), 0, 0, 0)

DI void rwkv_phase_a(const Frame& F, const Args& a) {
    unsigned char* ws = a.ws; unsigned char* rb = ws + WS_RW;
    const bf16* wdec = (const bf16*)(ws + WS_WDEC); const bf16* waaa = (const bf16*)(ws + WS_WAAA); const bf16* wgate = (const bf16*)(ws + WS_WGATE);
    const float* mu = a.in[I_MU]; const float* par = (const float*)(ws + WS_PAR);
    const int hb = F.wave >> 2, w4 = F.wave & 3;
    LAS unsigned char* hbase = F.lds + hb * RA_HALF;
    const float LOG2E = 1.4426950408889634f;
    v4u s0c[4];
#define RA_REQUEST(pair_) do { const int item_ = 2 * (pair_) + hb, c_ = (item_ >> 3) & 127, b_ = item_ >> 10; const size_t tok0_ = (size_t)b_ * SEQ + c_ * 64; \
        int lq_ = F.lane; asm volatile("" : "+v"(lq_)); size_t wsq_ = (size_t)ws; asm volatile("" : "+s"(wsq_)); const int t9q_ = (hb << 8) | (w4 << 6) | lq_; \
        const bf16* cur_ = (const bf16*)(wsq_ + WS_PROJ) + (tok0_ + (t9q_ >> 3)) * INC + PRW + 1536 + 32 * (t9q_ & 7); \
        _Pragma("unroll") for (int g8 = 0; g8 < 4; ++g8) s0c[g8] = *(const v4u*)(cur_ + 8 * g8); } while (0)
    if (F.bid < NITEM / 2) RA_REQUEST(F.bid);
    for (int pair = F.bid; pair < NITEM / 2; pair += F.G) {
        size_t wsb = (size_t)ws; asm volatile("" : "+s"(wsb)); const bf16* proj = (const bf16*)(wsb + WS_PROJ);
        int l = F.lane; asm volatile("" : "+v"(l));
        const int n16 = l & 15, q = l >> 4, t4 = (hb << 8 | (F.wave & 3) << 6 | l) & 255;
        const int tokl = 16 * w4 + n16;
        const int tslot = (tokl & 32) + 8 * ((tokl >> 2) & 3) + 4 * ((tokl >> 4) & 1) + (tokl & 3);
        const int item = 2 * pair + hb, h = item & 7, c = (item >> 3) & 127, b = item >> 10;
        const size_t tok0 = (size_t)b * SEQ + c * 64; unsigned char* rbi = rb + (size_t)item * RB_REC;
        const int t9 = (hb << 8) | t4, tk0 = t9 >> 3, part = t9 & 7;
        v4u s0p[4];
        { const bool first = (c == 0 && tk0 == 0); const bf16* prv = proj + (tok0 + tk0) * INC + PRW + 1536 + 32 * part - INC;
#pragma unroll
          for (int g8 = 0; g8 < 4; ++g8) { s0p[g8] = (v4u){0u, 0u, 0u, 0u}; if (!first) s0p[g8] = *(const v4u*)(prv + 8 * g8); } }
        v2u rawc[3][4], rawp[3][4];
        { const bool first = (c == 0 && tokl == 0); const bf16* cur = proj + (tok0 + tokl) * INC + PRW + h * 64 + 4 * q; const bf16* prv = cur - INC;
#pragma unroll
          for (int m = 0; m < 3; ++m)
#pragma unroll
              for (int ct = 0; ct < 4; ++ct) { rawc[m][ct] = *(const v2u*)(cur + 512 * m + 16 * ct); rawp[m][ct] = (v2u){0u, 0u}; if (!first) rawp[m][ct] = *(const v2u*)(prv + 512 * m + 16 * ct); } }
        bf16x8 wfr[2][8];
#define RA_WLOAD(dst, ctv) do { const int row_ = h * 64 + 16 * (ctv) + n16; \
            dst[0] = *(const bf16x8*)(wdec + row_ * 64 + 8 * q); dst[1] = *(const bf16x8*)(wdec + row_ * 64 + 32 + 8 * q); \
            dst[2] = *(const bf16x8*)(waaa + row_ * 64 + 8 * q); dst[3] = *(const bf16x8*)(waaa + row_ * 64 + 32 + 8 * q); \
            _Pragma("unroll") for (int ks_ = 0; ks_ < 4; ++ks_) dst[4 + ks_] = *(const bf16x8*)(wgate + row_ * 128 + 32 * ks_ + 8 * q); } while (0)
        RA_WLOAD(wfr[0], 0); RA_WLOAD(wfr[1], 1);
        __syncthreads();
        { const float esc = part < 2 ? 2.8853900817779268f : -1.4426950408889634f;
          LAS unsigned char* dst = F.lds + (part < 2 ? RA_XWD + tk0 * 144 + part * 64 : (part < 4 ? RA_XAD + tk0 * 144 + (part - 2) * 64 : RA_XGD + tk0 * 272 + (part - 4) * 64));
#pragma unroll
          for (int g8 = 0; g8 < 4; ++g8) {
              const unsigned xw[4] = {s0c[g8].x, s0c[g8].y, s0c[g8].z, s0c[g8].w}, pw[4] = {s0p[g8].x, s0p[g8].y, s0p[g8].z, s0p[g8].w};
              const f32x4 m0 = *(const f32x4*)(mu + 1536 + 32 * part + 8 * g8), m1 = *(const f32x4*)(mu + 1536 + 32 * part + 8 * g8 + 4);
              float y[8];
#pragma unroll
              for (int j = 0; j < 8; ++j) { const float x = (j & 1) ? bfhi(xw[j >> 1]) : bflo(xw[j >> 1]), p = (j & 1) ? bfhi(pw[j >> 1]) : bflo(pw[j >> 1]);
                  const float xs = x + (p - x) * (j < 4 ? m0[j & 3] : m1[j & 3]);
                  const float rc = __builtin_amdgcn_rcpf(1.0f + __builtin_amdgcn_exp2f(esc * xs));
                  y[j] = part < 2 ? 1.0f - 2.0f * rc : (part < 4 ? xs : rc); }
              const v4u o = {pk2(y[0], y[1]), pk2(y[2], y[3]), pk2(y[4], y[5]), pk2(y[6], y[7])};
              *(LAS v4u*)(dst + 16 * g8) = o; } }
        v2u shv[3][4];
#pragma unroll
        for (int m = 0; m < 3; ++m)
#pragma unroll
            for (int ct = 0; ct < 4; ++ct) { const v2u xw = rawc[m][ct], pw = rawp[m][ct];
                const f32x4 mm = *(const f32x4*)(mu + 512 * m + h * 64 + 16 * ct + 4 * q);
                const float x0 = bflo(xw.x), x1 = bfhi(xw.x), x2 = bflo(xw.y), x3 = bfhi(xw.y);
                shv[m][ct].x = pk2(x0 + (bflo(pw.x) - x0) * mm[0], x1 + (bfhi(pw.x) - x1) * mm[1]); shv[m][ct].y = pk2(x2 + (bflo(pw.y) - x2) * mm[2], x3 + (bfhi(pw.y) - x3) * mm[3]); }
        __syncthreads();
        f32x4 awl[4], aal[4], ag[4];
        { bf16x8 bwd[2], bad[2], bgd[4], wf2[2][8];
          RA_WLOAD(wf2[0], 2); RA_WLOAD(wf2[1], 3);
#pragma unroll
          for (int ks = 0; ks < 2; ++ks) { bwd[ks] = *(const LAS bf16x8*)(F.lds + RA_XWD + tokl * 144 + 64 * ks + 16 * q); bad[ks] = *(const LAS bf16x8*)(F.lds + RA_XAD + tokl * 144 + 64 * ks + 16 * q); }
#pragma unroll
          for (int ks = 0; ks < 4; ++ks) bgd[ks] = *(const LAS bf16x8*)(F.lds + RA_XGD + tokl * 272 + 64 * ks + 16 * q);
#pragma unroll
          for (int ct = 0; ct < 4; ++ct) { const bf16x8* wv = ct < 2 ? wfr[ct] : wf2[ct - 2];
              awl[ct] = (f32x4){0.f, 0.f, 0.f, 0.f}; aal[ct] = awl[ct]; ag[ct] = awl[ct];
#pragma unroll
              for (int ks = 0; ks < 2; ++ks) { awl[ct] = MFMA16(wv[ks], bwd[ks], awl[ct]); aal[ct] = MFMA16(wv[2 + ks], bad[ks], aal[ct]); }
#pragma unroll
              for (int ks = 0; ks < 4; ++ks) ag[ct] = MFMA16(wv[4 + ks], bgd[ks], ag[ct]); } }
#undef RA_WLOAD
        v2u rtp[4];
        {
#define RA_SHIFT(dst, pcol, ctv) do { const v2u w_ = shv[(pcol) / 512][ctv]; dst[0] = bflo(w_.x); dst[1] = bfhi(w_.x); dst[2] = bflo(w_.y); dst[3] = bfhi(w_.y); } while (0)
          float nrm = 0.f, bd = 0.f;
#pragma unroll
          for (int ct = 0; ct < 4; ++ct) { const int ch = h * 64 + 16 * ct + 4 * q;
              float r4[4], k4[4]; RA_SHIFT(r4, 0, ct); RA_SHIFT(k4, 512, ct);
              const f32x4 a0v = *(const f32x4*)(par + 512 + ch), kkv = *(const f32x4*)(par + 1024 + ch), kav = *(const f32x4*)(par + 1536 + ch), rkv = *(const f32x4*)(par + 2048 + ch);
#pragma unroll
              for (int i = 0; i < 4; ++i) { const float av = fast_sigmoid(a0v[i] + aal[ct][i]); const float kk = k4[i] * kkv[i]; nrm += kk * kk;
                  bd += r4[i] * (k4[i] * (1.0f + (av - 1.0f) * kav[i])) * rkv[i]; } }
          nrm = quad_sum(nrm); bd = quad_sum(bd);
          const float kinv = 1.0f / fmaxf(sqrtf(nrm), 1e-12f);
          float lw[4][4], lg[4][4], lgend[4][4];
#pragma unroll
          for (int ct = 0; ct < 4; ++ct) { const f32x4 w0v = *(const f32x4*)(par + h * 64 + 16 * ct + 4 * q);
#pragma unroll
              for (int i = 0; i < 4; ++i) { lw[ct][i] = (-0.6065306597126334f * LOG2E) * fast_sigmoid(w0v[i] + awl[ct][i]); float x = lw[ct][i];
                  x += __builtin_bit_cast(float, __builtin_amdgcn_update_dpp(0, __builtin_bit_cast(int, x), 0x111, 0xf, 0xf, false));
                  x += __builtin_bit_cast(float, __builtin_amdgcn_update_dpp(0, __builtin_bit_cast(int, x), 0x112, 0xf, 0xf, false));
                  x += __builtin_bit_cast(float, __builtin_amdgcn_update_dpp(0, __builtin_bit_cast(int, x), 0x114, 0xf, 0xf, false));
                  x += __builtin_bit_cast(float, __builtin_amdgcn_update_dpp(0, __builtin_bit_cast(int, x), 0x118, 0xf, 0xf, false));
                  lg[ct][i] = x; } }
          LAS float* wt = (LAS float*)(hbase + RA_WT);
          if (n16 == 15) {
#pragma unroll
              for (int ct = 0; ct < 4; ++ct) *(LAS f32x4*)(wt + w4 * 64 + 16 * ct + 4 * q) = (f32x4){lg[ct][0], lg[ct][1], lg[ct][2], lg[ct][3]}; }
          __syncthreads();
#pragma unroll
          for (int ct = 0; ct < 4; ++ct) { f32x4 off = {0.f, 0.f, 0.f, 0.f}, tot = {0.f, 0.f, 0.f, 0.f};
#pragma unroll
              for (int w = 0; w < 4; ++w) { const f32x4 t = *(const LAS f32x4*)(wt + w * 64 + 16 * ct + 4 * q); tot = tot + t; if (w < w4) off = off + t; }
#pragma unroll
              for (int i = 0; i < 4; ++i) { lg[ct][i] += off[i]; lgend[ct][i] = tot[i]; } }
#pragma unroll
          for (int ct = 0; ct < 4; ++ct) { const int ch = h * 64 + 16 * ct + 4 * q;
              float r4[4], k4[4], v4[4]; RA_SHIFT(r4, 0, ct); RA_SHIFT(k4, 512, ct); RA_SHIFT(v4, 1024, ct);
              const f32x4 a0v = *(const f32x4*)(par + 512 + ch), kkv = *(const f32x4*)(par + 1024 + ch), kav = *(const f32x4*)(par + 1536 + ch);
              const f32x4 lg_ = *(const f32x4*)(par + 2560 + ch), lb_ = *(const f32x4*)(par + 3072 + ch);
              float rtl[4], ktl[4], btl[4], atl[4], khh[4], bhh[4], g1[4], e2[4];
#pragma unroll
              for (int i = 0; i < 4; ++i) {
                  const float av = fast_sigmoid(a0v[i] + aal[ct][i]); const float k2 = k4[i] * (1.0f + (av - 1.0f) * kav[i]);
                  const float kkn = k4[i] * kkv[i] * kinv, bb = kkn * av;
                  const float gam = __builtin_amdgcn_exp2f(lg[ct][i]), gpv = __builtin_amdgcn_exp2f(lg[ct][i] - lw[ct][i]), gin = __builtin_amdgcn_exp2f(-lg[ct][i]), ger = __builtin_amdgcn_exp2f(lgend[ct][i] - lg[ct][i]);
                  rtl[i] = r4[i] * gam; ktl[i] = k2 * gin; btl[i] = bb * gin; atl[i] = -kkn * gpv; khh[i] = k2 * ger; bhh[i] = bb * ger;
                  const float g = ag[ct][i]; g1[i] = lg_[i] * g; e2[i] = (lb_[i] + bd * v4[i]) * g;
              }
              const int fo = ((w4 * 4 + ct) * 64 + l) * 8;
              v2u o; o.x = pk2(g1[0], g1[1]); o.y = pk2(g1[2], g1[3]); __builtin_nontemporal_store(o, (v2u*)(rbi + RB_G1T + fo));
              o.x = pk2(e2[0], e2[1]); o.y = pk2(e2[2], e2[3]); __builtin_nontemporal_store(o, (v2u*)(rbi + RB_E2T + fo));
              const int co = tokl * 144 + (16 * ct + 4 * q) * 2;
              o.x = pk2(rtl[0], rtl[1]); o.y = pk2(rtl[2], rtl[3]); *(LAS v2u*)(hbase + RA_RT + co) = o; rtp[ct] = o;
              o.x = pk2(ktl[0], ktl[1]); o.y = pk2(ktl[2], ktl[3]); *(LAS v2u*)(hbase + RA_KT + co) = o;
              o.x = pk2(btl[0], btl[1]); o.y = pk2(btl[2], btl[3]); *(LAS v2u*)(hbase + RA_BT + co) = o;
              o.x = pk2(atl[0], atl[1]); o.y = pk2(atl[2], atl[3]); *(LAS v2u*)(hbase + RA_AT + co) = o;
#pragma unroll
              for (int i = 0; i < 4; ++i) { const int ro = (16 * ct + 4 * q + i) * 144 + 2 * tslot;
                  if (tokl == 0) *(LAS float*)(hbase + RA_VT + (16 * ct + 4 * q + i) * 144 + 128) = __builtin_amdgcn_exp2f(lgend[ct][i]);
                  *(LAS unsigned short*)(hbase + RA_VT + ro) = (unsigned short)(pk2(v4[i], 0.f) & 0xffffu);
                  *(LAS unsigned short*)(hbase + RA_KH + ro) = (unsigned short)(pk2(khh[i], 0.f) & 0xffffu);
                  *(LAS unsigned short*)(hbase + RA_BH + ro) = (unsigned short)(pk2(bhh[i], 0.f) & 0xffffu); }
              asm volatile("" ::: "memory");
          }
#undef RA_SHIFT
        }
        __syncthreads();
        bf16x8 akp[2], rkp[2], rbp[2];
        { bf16x8 fa[2], fr[2];
#pragma unroll
          for (int ks = 0; ks < 2; ++ks) { fa[ks] = *(const LAS bf16x8*)(hbase + RA_AT + tokl * 144 + 64 * ks + 16 * q); fr[ks] = *(const LAS bf16x8*)(hbase + RA_RT + tokl * 144 + 64 * ks + 16 * q); }
          f32x4 aak[4], arkk[4], arb[4];
#pragma unroll
          for (int jt = 0; jt < 4; ++jt) {
              f32x4 tab = {0.f, 0.f, 0.f, 0.f}; aak[jt] = tab; arkk[jt] = tab; arb[jt] = tab;
              if (jt <= w4) {
#pragma unroll
                  for (int ks = 0; ks < 2; ++ks) { const bf16x8 fk = *(const LAS bf16x8*)(hbase + RA_KT + (16 * jt + n16) * 144 + 64 * ks + 16 * q), fb = *(const LAS bf16x8*)(hbase + RA_BT + (16 * jt + n16) * 144 + 64 * ks + 16 * q);
                      aak[jt] = MFMA16(fk, fa[ks], aak[jt]); tab = MFMA16(fb, fa[ks], tab); arkk[jt] = MFMA16(fk, fr[ks], arkk[jt]); arb[jt] = MFMA16(fb, fr[ks], arb[jt]); }
                  if (jt == w4) {
#pragma unroll
                      for (int i = 0; i < 4; ++i) { const int j = 4 * q + i; if (j >= n16) { aak[jt][i] = 0.f; tab[i] = 0.f; } if (j > n16) { arkk[jt][i] = 0.f; arb[jt][i] = 0.f; } } }
                  *(LAS f32x4*)(hbase + RA_AAB + tokl * 256 + (16 * jt + 4 * q) * 4) = tab;
              }
          }
#pragma unroll
          for (int s = 0; s < 2; ++s) { akp[s] = pack8(aak[2 * s], aak[2 * s + 1]); rkp[s] = pack8(arkk[2 * s], arkk[2 * s + 1]); rbp[s] = pack8(arb[2 * s], arb[2 * s + 1]); } }
        { f32x4 akv[4];
#pragma unroll
          for (int vt = 0; vt < 4; ++vt) { akv[vt] = (f32x4){0.f, 0.f, 0.f, 0.f};
#pragma unroll
              for (int s = 0; s < 2; ++s) { const bf16x8 fv = *(const LAS bf16x8*)(hbase + RA_VT + (16 * vt + n16) * 144 + 64 * s + 16 * q); akv[vt] = MFMA16(akp[s], fv, akv[vt]); } }
          __syncthreads();
#pragma unroll
          for (int vt = 0; vt < 4; ++vt) *(LAS f32x4*)(hbase + RA_RHS2 + (16 * vt + n16) * 272 + (16 * w4 + 4 * q) * 4) = akv[vt]; }
        if (pair + F.G < NITEM / 2) RA_REQUEST(pair + F.G);
        { const LAS unsigned char* aab = hbase + RA_AAB + (16 * w4) * 256 + (16 * w4) * 4;
          LAS unsigned char* ti = hbase + RA_BT;
          if (q == 0) { float t[16];
#pragma unroll
              for (int r_ = 0; r_ < 16; ++r_) { float acc = (r_ == n16) ? 1.0f : 0.0f;
#pragma unroll
                  for (int j4 = 0; j4 < (r_ + 3) / 4; ++j4) { const f32x4 av = *(const LAS f32x4*)(aab + r_ * 256 + j4 * 16);
#pragma unroll
                      for (int e = 0; e < 4; ++e) if (4 * j4 + e < r_) acc += av[e] * t[4 * j4 + e]; }
                  t[r_] = acc; *(LAS unsigned short*)(ti + w4 * 512 + r_ * 32 + 2 * n16) = (unsigned short)(pk2(acc, 0.f) & 0xffffu); } }
          __syncthreads();
          bf16x8 a10, a20, a30, a31, tf[4];
          { const LAS unsigned char* ab = hbase + RA_AAB + n16 * 256 + 16 * q; const f32x4 z4 = {0.f, 0.f, 0.f, 0.f};
            const f32x4 l10 = *(const LAS f32x4*)(ab + 16 * 256), l20 = *(const LAS f32x4*)(ab + 32 * 256), l21 = *(const LAS f32x4*)(ab + 32 * 256 + 64);
            const f32x4 l30 = *(const LAS f32x4*)(ab + 48 * 256), l31 = *(const LAS f32x4*)(ab + 48 * 256 + 64), l32 = *(const LAS f32x4*)(ab + 48 * 256 + 128);
            a10 = pack8(l10, z4); a20 = pack8(l20, l21); a30 = pack8(l30, l31); a31 = pack8(l32, z4);
#pragma unroll
            for (int I = 0; I < 4; ++I) { const v2u tw = *(const LAS v2u*)(ti + I * 512 + n16 * 32 + 8 * q); const v4u t4 = {tw.x, tw.y, 0u, 0u}; tf[I] = __builtin_bit_cast(bf16x8, t4); } }
          v4u xw[2][2];
#pragma unroll
          for (int m = 0; m < 2; ++m) {
              v4u x0 = {0u, 0u, 0u, 0u}, x1 = {0u, 0u, 0u, 0u};
#pragma unroll
              for (int I = 0; I < 4; ++I) {
                  f32x4 z;
                  if (m == 0) {
#pragma unroll
                      for (int i = 0; i < 4; ++i) z[i] = bf2f(*(const LAS unsigned short*)(hbase + RA_AT + (16 * I + 4 * q + i) * 144 + 2 * tokl)); }
                  else z = *(const LAS f32x4*)(hbase + RA_RHS2 + tokl * 272 + (16 * I + 4 * q) * 4);
                  if (I == 1) z = MFMA16(a10, __builtin_bit_cast(bf16x8, x0), z);
                  if (I == 2) z = MFMA16(a20, __builtin_bit_cast(bf16x8, x0), z);
                  if (I == 3) { z = MFMA16(a30, __builtin_bit_cast(bf16x8, x0), z); z = MFMA16(a31, __builtin_bit_cast(bf16x8, x1), z); }
                  const v4u zb = {pk2(z[0], z[1]), pk2(z[2], z[3]), 0u, 0u};
                  const f32x4 x = MFMA16(tf[I], __builtin_bit_cast(bf16x8, zb), ((f32x4){0.f, 0.f, 0.f, 0.f}));
                  const unsigned p0 = pk2(x[0], x[1]), p1 = pk2(x[2], x[3]);
                  if (I == 0) { x0.x = p0; x0.y = p1; } if (I == 1) { x0.z = p0; x0.w = p1; } if (I == 2) { x1.x = p0; x1.y = p1; } if (I == 3) { x1.z = p0; x1.w = p1; }
              }
              xw[m][0] = x0; xw[m][1] = x1;
          }
          __syncthreads();
#pragma unroll
          for (int s = 0; s < 2; ++s) { *(LAS v4u*)(hbase + RA_W1T + tokl * 144 + 64 * s + 16 * q) = xw[0][s]; *(LAS v4u*)(hbase + RA_W2T + tokl * 144 + 64 * s + 16 * q) = xw[1][s]; }
        }
        __syncthreads();
        {
          f32x4 pc[4], y0[4];
#pragma unroll
          for (int t = 0; t < 4; ++t) { pc[t] = (f32x4){bflo(rtp[t].x), bfhi(rtp[t].x), bflo(rtp[t].y), bfhi(rtp[t].y)}; y0[t] = (f32x4){0.f, 0.f, 0.f, 0.f};
#pragma unroll
              for (int s = 0; s < 2; ++s) { y0[t] = MFMA16(*(const LAS bf16x8*)(hbase + RA_VT + (16 * t + n16) * 144 + 64 * s + 16 * q), rkp[s], y0[t]);
                                            y0[t] = MFMA16(*(const LAS bf16x8*)(hbase + RA_W2T + (16 * t + n16) * 144 + 64 * s + 16 * q), rbp[s], y0[t]);
                                            pc[t] = MFMA16(*(const LAS bf16x8*)(hbase + RA_W1T + (16 * t + n16) * 144 + 64 * s + 16 * q), rbp[s], pc[t]); } }
#pragma unroll
          for (int vt = 0; vt < 4; ++vt) { v2u o; o.x = pk2(y0[vt][0], y0[vt][1]); o.y = pk2(y0[vt][2], y0[vt][3]); __builtin_nontemporal_store(o, (v2u*)(rbi + RB_YLT + ((w4 * 4 + vt) * 64 + l) * 8)); }
#pragma unroll
          for (int s = 0; s < 2; ++s) __builtin_nontemporal_store(pack8(pc[2 * s], pc[2 * s + 1]), (bf16x8*)(rbi + RB_PCT + ((w4 * 2 + s) * 64 + l) * 16));
          f32x4 mc[4]; bf16x8 fb[2], fvv[2];
#pragma unroll
          for (int s = 0; s < 2; ++s) { fb[s] = *(const LAS bf16x8*)(hbase + RA_BH + tokl * 144 + 64 * s + 16 * q); fvv[s] = *(const LAS bf16x8*)(hbase + RA_VT + tokl * 144 + 64 * s + 16 * q); }
          const float gend_k = *(const LAS float*)(hbase + RA_VT + tokl * 144 + 128);
#pragma unroll
          for (int t = 0; t < 4; ++t) { mc[t] = (f32x4){0.f, 0.f, 0.f, 0.f};
#pragma unroll
              for (int s = 0; s < 2; ++s) mc[t] = MFMA16(*(const LAS bf16x8*)(hbase + RA_W1T + (16 * t + n16) * 144 + 64 * s + 16 * q), fb[s], mc[t]);
              if (t == w4) {
#pragma unroll
                  for (int i = 0; i < 4; ++i) if (4 * q + i == n16) mc[t][i] += gend_k; } }
#pragma unroll
          for (int s = 0; s < 2; ++s) __builtin_nontemporal_store(pack8(mc[2 * s], mc[2 * s + 1]), (bf16x8*)(rbi + RB_MC + ((w4 * 2 + s) * 64 + l) * 16));
          bf16x8 fw2[2];
#pragma unroll
          for (int s = 0; s < 2; ++s) fw2[s] = *(const LAS bf16x8*)(hbase + RA_W2T + tokl * 144 + 64 * s + 16 * q);
#pragma unroll
          for (int kt = 0; kt < 4; ++kt) { f32x4 cc = {0.f, 0.f, 0.f, 0.f};
#pragma unroll
              for (int s = 0; s < 2; ++s) { cc = MFMA16(*(const LAS bf16x8*)(hbase + RA_KH + (16 * kt + n16) * 144 + 64 * s + 16 * q), fvv[s], cc);
                                            cc = MFMA16(*(const LAS bf16x8*)(hbase + RA_BH + (16 * kt + n16) * 144 + 64 * s + 16 * q), fw2[s], cc); }
              v2u cw; cw.x = pk2(cc[0], cc[1]); cw.y = pk2(cc[2], cc[3]); __builtin_nontemporal_store(cw, (v2u*)(rbi + RB_CC + ((w4 * 4 + kt) * 64 + l) * 8)); } }
    }
}

constexpr int RBK_NS = 9, RBK_D = 8, RBK_SLOT = 16384, RBK_BLOCKS = 32;
static_assert(RBK_NS * RBK_SLOT <= MISC_OFF && RBK_D == RBK_NS - 1, "phase B ring");
DI void rwkv_phase_b(const Frame& F, const Args& a) {
    if (F.bid >= RBK_BLOCKS) return;
    unsigned char* rb = a.ws + WS_RW; const int l = F.lane, w = F.wave;
    const int h = F.bid & 7, b = F.bid >> 3;
    LAS unsigned char* lds = F.lds;
    if (w >= 4) {
        const int j = w - 4;
#define RBK_ISSUE(cc_) do { const int c_ = (cc_) < NCHUNK ? (cc_) : NCHUNK - 1; const unsigned char* r_ = rb + (size_t)(((b * 128 + c_) << 3) + h) * RB_REC; \
            LAS unsigned char* slot_ = lds + ((cc_) % RBK_NS) * RBK_SLOT; \
            _Pragma("unroll") for (int k_ = 0; k_ < 4; ++k_) { const int blk_ = 4 * j + k_; \
                const unsigned char* src_ = blk_ < 8 ? r_ + RB_MC + blk_ * 1024 : r_ + RB_CC + (blk_ - 8) * 1024; \
                __builtin_amdgcn_global_load_lds((const unsigned*)(src_ + l * 16), (LAS unsigned*)(slot_ + blk_ * 1024), 16, 0, 0); } } while (0)
        for (int c = 0; c < RBK_D; ++c) RBK_ISSUE(c);
        for (int c = 0; c < NCHUNK; ++c) {
            asm volatile("s_waitcnt vmcnt(28)" ::: "memory");
            __builtin_amdgcn_s_barrier();
            RBK_ISSUE(c + RBK_D);
        }
        asm volatile("s_waitcnt vmcnt(0)" ::: "memory");
        __builtin_amdgcn_s_barrier();
#undef RBK_ISSUE
    } else {
        const int vs = w;
        f32x4 st[4];
#pragma unroll
        for (int kt = 0; kt < 4; ++kt) st[kt] = (f32x4){0.f, 0.f, 0.f, 0.f};
        for (int c = 0; c < NCHUNK; ++c) {
            unsigned char* rbi = rb + (size_t)(((b * 128 + c) << 3) + h) * RB_REC;
            bf16x8 sb[2];
#pragma unroll
            for (int s = 0; s < 2; ++s) { sb[s] = pack8(st[2 * s], st[2 * s + 1]); *(bf16x8*)(rbi + RB_SC + ((vs * 2 + s) * 64 + l) * 16) = sb[s]; }
            __builtin_amdgcn_s_barrier();
            const LAS unsigned char* slot = lds + (c % RBK_NS) * RBK_SLOT;
#pragma unroll
            for (int kt = 0; kt < 4; ++kt) { const v2u cw = *(const LAS v2u*)(slot + 8192 + ((vs * 4 + kt) * 64 + l) * 8);
                f32x4 n = {bflo(cw.x), bfhi(cw.x), bflo(cw.y), bfhi(cw.y)};
#pragma unroll
                for (int s = 0; s < 2; ++s) n = MFMA16(*(const LAS bf16x8*)(slot + ((kt * 2 + s) * 64 + l) * 16), sb[s], n);
                st[kt] = n; }
        }
        __builtin_amdgcn_s_barrier();
    }
}

struct RcOps { bf16x8 pc[2]; v2u yl[4]; bf16x8 sc[4][2]; v2u g1[4], e2[4]; };
DI void rc_load(RcOps& o, const unsigned char* rb, int task, int l) {
    const int item = task >> 2, it = task & 3; const unsigned char* rbi = rb + (size_t)item * RB_REC;
#pragma unroll
    for (int s = 0; s < 2; ++s) o.pc[s] = __builtin_nontemporal_load((const bf16x8*)(rbi + RB_PCT + ((it * 2 + s) * 64 + l) * 16));
#pragma unroll
    for (int vt = 0; vt < 4; ++vt) { const int fo = ((it * 4 + vt) * 64 + l) * 8;
        o.yl[vt] = __builtin_nontemporal_load((const v2u*)(rbi + RB_YLT + fo)); o.g1[vt] = __builtin_nontemporal_load((const v2u*)(rbi + RB_G1T + fo)); o.e2[vt] = __builtin_nontemporal_load((const v2u*)(rbi + RB_E2T + fo));
#pragma unroll
        for (int s = 0; s < 2; ++s) o.sc[vt][s] = __builtin_nontemporal_load((const bf16x8*)(rbi + RB_SC + ((vt * 2 + s) * 64 + l) * 16)); }
}
DI void rwkv_phase_c(const Frame& F, const Args& a) {
    const unsigned char* rb = a.ws + WS_RW; bf16* mix = (bf16*)(a.ws + WS_MIX);
    const int l = F.lane, n16 = l & 15, q = l >> 4;
    const int gw = F.bid * NWAVES + F.wave, NGW = F.G * NWAVES;
    RcOps cur, nxt;
    if (gw < NITEM * 4) rc_load(cur, rb, gw, l);
    for (int task = gw; task < NITEM * 4; task += NGW) {
        const int item = task >> 2, it = task & 3, h = item & 7, c = (item >> 3) & 127, b = item >> 10;
        if (task + NGW < NITEM * 4) rc_load(nxt, rb, task + NGW, l);
        f32x4 y[4]; float sum = 0.f;
#pragma unroll
        for (int vt = 0; vt < 4; ++vt) { y[vt] = (f32x4){bflo(cur.yl[vt].x), bfhi(cur.yl[vt].x), bflo(cur.yl[vt].y), bfhi(cur.yl[vt].y)};
#pragma unroll
            for (int s = 0; s < 2; ++s) y[vt] = MFMA16(cur.sc[vt][s], cur.pc[s], y[vt]);
            sum += (y[vt][0] + y[vt][1]) + (y[vt][2] + y[vt][3]); }
        sum = quad_sum(sum);
        const float mean = sum * (1.f / 64.f); float sq = 0.f;
#pragma unroll
        for (int vt = 0; vt < 4; ++vt) { y[vt] = y[vt] - mean; sq += (y[vt][0] * y[vt][0] + y[vt][1] * y[vt][1]) + (y[vt][2] * y[vt][2] + y[vt][3] * y[vt][3]); }
        sq = quad_sum(sq);
        const float rstd = 1.0f / sqrtf(sq * (1.f / 64.f) + 64e-5f);
        const size_t tok = (size_t)b * SEQ + c * 64 + 16 * it + n16;
#pragma unroll
        for (int vt = 0; vt < 4; ++vt) { const v2u g = cur.g1[vt], e = cur.e2[vt];
            v2u o; o.x = pk2(y[vt][0] * rstd * bflo(g.x) + bflo(e.x), y[vt][1] * rstd * bfhi(g.x) + bfhi(e.x)); o.y = pk2(y[vt][2] * rstd * bflo(g.y) + bflo(e.y), y[vt][3] * rstd * bfhi(g.y) + bfhi(e.y));
            *(v2u*)(mix + tok * 1024 + 512 + h * 64 + 16 * vt + 4 * q) = o; }
        cur = nxt;
    }
}
#endif

DI void p0_prologue(const Frame& F, const Args& a) {
    unsigned char* ws = a.ws;
    LAS float* scr = (LAS float*)(F.lds + F.wave * 16384);
    const int gw = F.bid * NWAVES + F.wave, NGW = F.G * NWAVES;
    constexpr int I_IN = 0, I_OUT = 16 * 32, I_DEC = 16, I_AAA = 16, I_GATE = 32;
    constexpr int NITEMS = I_IN + I_OUT + I_DEC + I_AAA + I_GATE;
    for (int s = F.G - 1 - F.bid; s < INC / 32; s += F.G) { q_strip_i8_wg(a.in[I_WIN], INC, 32 * s, ws + WS_WIN, (float*)(ws + WS_COLSC1), F.wave, F.lane, (LAS float*)F.lds); __syncthreads(); }
    for (int it = gw; it < NITEMS; it += NGW) {
        int r = it;
        if (r < I_OUT) { const int kb = r / 32, nb = r % 32; tr_item(a.in[I_WOUT], 1024, 64 * kb, 32 * nb, (bf16*)(ws + WS_WOUT), 1024, 32 * nb, scr, F.lane, nullptr); continue; } r -= I_OUT;
        if (r < I_DEC) { tr_item(a.in[I_WDEC], 512, 0, 32 * r, (bf16*)(ws + WS_WDEC), 64, 32 * r, scr, F.lane, nullptr); continue; } r -= I_DEC;
        if (r < I_AAA) { tr_item(a.in[I_WAAA], 512, 0, 32 * r, (bf16*)(ws + WS_WAAA), 64, 32 * r, scr, F.lane, nullptr); continue; } r -= I_AAA;
        { const int kb = r / 16, nb = r % 16; tr_item(a.in[I_WGATE], 512, 64 * kb, 32 * nb, (bf16*)(ws + WS_WGATE), 128, 32 * nb, scr, F.lane, nullptr); }
    }
    { float* wrt = (float*)(ws + WS_WRT); const float* wr = a.in[I_WR]; const float* g2 = a.in[I_N2G];
      for (int i = F.bid * 512 + F.tid; i < 32 * 1024; i += F.G * 512) { const int e = i >> 10, k = i & 1023; wrt[i] = g2[k] * wr[k * 32 + e]; } }
    { float* par = (float*)(ws + WS_PAR); const int srcs[7] = {I_W0, I_A0, I_KK, I_KA, I_RK, I_LNG, I_LNB};
      for (int i = F.bid * 512 + F.tid; i < 7 * 512; i += F.G * 512) { const int k = i >> 9; float v = 0.f;
#pragma unroll
          for (int j = 0; j < 7; ++j) if (k == j) v = a.in[srcs[j]][i & 511];
          par[i] = v; } }
    { const float* x = a.in[I_X]; const float* g1 = a.in[I_N1G]; bf16* xn = (bf16*)(ws + WS_XN);
      f32x4 gv[4];
#pragma unroll
      for (int j = 0; j < 4; ++j) gv[j] = *((const f32x4*)g1 + F.lane + 64 * j);
      for (int m0 = 2 * gw; m0 < T; m0 += 2 * NGW) {
          f32x4 v[2][4];
#pragma unroll
          for (int r = 0; r < 2; ++r) { const f32x4* xr = (const f32x4*)(x + (size_t)(m0 + r) * D) + F.lane;
#pragma unroll
              for (int j = 0; j < 4; ++j) v[r][j] = __builtin_nontemporal_load(xr + 64 * j); }
#pragma unroll
          for (int r = 0; r < 2; ++r) { float s = 0.f;
#pragma unroll
              for (int j = 0; j < 4; ++j) s += (v[r][j].x * v[r][j].x + v[r][j].y * v[r][j].y) + (v[r][j].z * v[r][j].z + v[r][j].w * v[r][j].w);
              const float rs = 1.0f / sqrtf(wave_sum(s) * (1.f / D) + 1e-6f);
              f32x4 y[4]; float am = 0.f;
#pragma unroll
              for (int j = 0; j < 4; ++j) { y[j] = (v[r][j] * rs) * gv[j]; am = fmaxf(fmaxf(am, fmaxf(fabsf(y[j].x), fabsf(y[j].y))), fmaxf(fabsf(y[j].z), fabsf(y[j].w))); }
              am = wave_max(am); const float qi = am > 0.f ? 127.0f / am : 0.f;
              if (F.lane == 0) ((float*)(ws + WS_XNSC))[m0 + r] = am * (1.0f / 127.0f);
              unsigned* o4 = (unsigned*)((unsigned char*)xn + (size_t)(m0 + r) * D) + F.lane;
#pragma unroll
              for (int j = 0; j < 4; ++j) { const f32x4 qv = y[j] * qi + Q_MAGIC; o4[64 * j] = q_pack4(qv.x, qv.y, qv.z, qv.w); } }
      } }
}

#if NAIVE_RWKV
DI void rwkv_naive_prep(const Frame& F, const Args& a) {
    const bf16* proj = (const bf16*)(a.ws + WS_PROJ); LAS float* sx = (LAS float*)F.lds;
    float* RW = (float*)(a.ws + WS_RW); float* GG = (float*)(a.ws + WS_XN);
    const float* mu = a.in[I_MU]; const int c = F.tid;
    for (int t = F.bid; t < T; t += F.G) {
        const bool first = (t % SEQ) == 0; const bf16* cur = proj + (size_t)t * INC + PRW; const bf16* prv = cur - INC;
#define SH_(col) ({ const float x_ = bf2f(cur[col]); const float p_ = first ? 0.f : bf2f(prv[col]); x_ + (p_ - x_) * mu[col]; })
        if (c < 256) { const float v = SH_(1536 + c); sx[c] = c < 64 ? tanhf(v) : (c < 128 ? v : sigmoidf_(v)); }
        __syncthreads();
        const float r = SH_(c), k = SH_(512 + c), v = SH_(1024 + c);
#undef SH_
        float wl = a.in[I_W0][c], al = a.in[I_A0][c], g = 0.f;
        const float* wdec = a.in[I_WDEC] + c; const float* waaa = a.in[I_WAAA] + c; const float* wgate = a.in[I_WGATE] + c;
#pragma unroll 4
        for (int j = 0; j < 64; ++j) { wl += sx[j] * wdec[j * 512]; al += sx[64 + j] * waaa[j * 512]; }
#pragma unroll 4
        for (int j = 0; j < 128; ++j) g += sx[128 + j] * wgate[j * 512];
        const float dec = __expf(-0.6065306597126334f * sigmoidf_(wl)), av = sigmoidf_(al);
        float kk = k * a.in[I_KK][c]; const float n2 = wave_sum(kk * kk); kk = kk / fmaxf(sqrtf(n2), 1e-12f);
        const float k2 = k * (1.0f + (av - 1.0f) * a.in[I_KA][c]);
        const size_t o = (size_t)t * 512 + c; const size_t S1 = (size_t)T * 512;
        RW[o] = r; RW[S1 + o] = dec; RW[2 * S1 + o] = k2; RW[3 * S1 + o] = v; RW[4 * S1 + o] = kk; RW[5 * S1 + o] = av; GG[o] = g;
        __syncthreads();
    }
}
DI void rwkv_naive_scan(const Frame& F, const Args& a) {
    if (F.bid >= 32 || F.wave != 0) return;
    const int b = F.bid >> 3, h = F.bid & 7, l = F.lane, c = h * 64 + l;
    const float* RW = (const float*)(a.ws + WS_RW); const float* GG = (const float*)(a.ws + WS_XN); bf16* mix = (bf16*)(a.ws + WS_MIX);
    const size_t S1 = (size_t)T * 512; LAS float* sh = (LAS float*)F.lds;
    LAS float* st = sh + 512 + l;
    for (int k = 0; k < 64; ++k) st[64 * k] = 0.f;
    const float rk = a.in[I_RK][c], lg = a.in[I_LNG][c], lb = a.in[I_LNB][c];
    for (int s = 0; s < SEQ; ++s) {
        const size_t o = (size_t)(b * SEQ + s) * 512 + c;
        const float r = RW[o], w = RW[S1 + o], k2 = RW[2 * S1 + o], v = RW[3 * S1 + o], kk = RW[4 * S1 + o], av = RW[5 * S1 + o], g = GG[o];
        sh[l] = r; sh[64 + l] = w; sh[128 + l] = k2; sh[192 + l] = kk; sh[256 + l] = kk * av;
        LDS_WAIT();
        float sa = 0.f;
#pragma unroll 8
        for (int k = 0; k < 64; ++k) sa -= st[64 * k] * sh[192 + k];
        float y = 0.f;
#pragma unroll 8
        for (int k = 0; k < 64; ++k) { const float nv = st[64 * k] * sh[64 + k] + sa * sh[256 + k] + v * sh[128 + k]; st[64 * k] = nv; y += nv * sh[k]; }
        LDS_WAIT();
        const float mean = wave_sum(y) * (1.f / 64.f); const float d = y - mean; const float var = wave_sum(d * d) * (1.f / 64.f);
        const float yn = d * (1.0f / sqrtf(var + 64e-5f));
        const float bonus = wave_sum(r * k2 * rk) * v;
        const float outv = (yn * lg + lb + bonus) * g;
        mix[(size_t)(b * SEQ + s) * 1024 + 512 + c] = (bf16)(pk2(outv, 0.f) & 0xffffu);
    }
}
#endif
#if NAIVE_ATT
DI void attn_naive(const Frame& F, const Args& a) {
    const bf16* proj = (const bf16*)(a.ws + WS_PROJ); bf16* mix = (bf16*)(a.ws + WS_MIX);
    LAS float* sq = (LAS float*)(F.lds + F.wave * 1024);
    const int gw = F.bid * NWAVES + F.wave, NGW = F.G * NWAVES, l = F.lane;
    const float qg = a.in[I_QG][l];
    for (int it = gw; it < T * 8; it += NGW) {
        const int t = it >> 3, h = it & 7, b = t / SEQ, s = t % SEQ, n = s >> 6;
        const float qd = bf2f(proj[(size_t)t * INC + h * 64 + l]);
        const float qn = qd * (1.0f / sqrtf(wave_sum(qd * qd) * (1.f / 64.f) + 1e-6f)) * qg * 0.125f;
        sq[l] = qn; LDS_WAIT();
        float sc[9]; float mx = -3.0e38f;
#pragma unroll
        for (int r = 0; r < 9; ++r) {
            const int kp = (n - 8) * 64 + 64 * r + l; float v = -3.0e38f;
            if (kp >= 0) {
                const v4u* kr = (const v4u*)(proj + (size_t)(b * SEQ + kp) * INC + 512 + h * 64);
                float ss = 0.f, dot = 0.f;
#pragma unroll
                for (int j = 0; j < 8; ++j) { const v4u w = kr[j]; const unsigned ww[4] = {w.x, w.y, w.z, w.w};
#pragma unroll
                    for (int e = 0; e < 4; ++e) { const float k0 = bflo(ww[e]), k1 = bfhi(ww[e]); const int d0 = 8 * j + 2 * e;
                        ss += k0 * k0 + k1 * k1; dot += sq[d0] * a.in[I_KG][d0] * k0 + sq[d0 + 1] * a.in[I_KG][d0 + 1] * k1; } }
                int rel = kp - s; rel = rel < -128 ? -128 : (rel > 63 ? 63 : rel);
                v = dot * (1.0f / sqrtf(ss * (1.f / 64.f) + 1e-6f)) + a.in[I_RELB][h * 192 + rel + 128];
            }
            sc[r] = v; mx = fmaxf(mx, v);
        }
        mx = wave_max(mx); float sum = 0.f;
#pragma unroll
        for (int r = 0; r < 9; ++r) { sc[r] = (sc[r] > -1.0e38f) ? __expf(sc[r] - mx) : 0.f; sum += sc[r]; }
        sum = wave_sum(sum);
        float o = 0.f;
#pragma unroll
        for (int r = 0; r < 9; ++r) {
            const int kp0 = (n - 8) * 64 + 64 * r;
            if (kp0 >= 0) {
                const bf16* vp = proj + (size_t)(b * SEQ + kp0) * INC + 1024 + h * 64 + l;
                for (int key = 0; key < 64; ++key) o += __shfl(sc[r], key) * bf2f(vp[(size_t)key * INC]);
            }
        }
        mix[(size_t)t * 1024 + h * 64 + l] = (bf16)(pk2(o / sum, 0.f) & 0xffffu);
        LDS_WAIT();
    }
}
#endif

DI void p6_router(const Frame& F, const Args& a) {
    unsigned char* ws = a.ws; const bf16* x1 = (const bf16*)(ws + WS_XN); const float* wrt = (const float*)(ws + WS_WRT); const float* br = a.in[I_BR];
    int* eidx = (int*)(ws + WS_EIDX); float* gate = (float*)(ws + WS_GATE); int* lrank = (int*)(ws + WS_LRANK); float* rstd = (float*)(ws + WS_RSTD); int* cnt = (int*)(ws + WS_CNT);
    constexpr int WROW = 2064, WIMG = 32 * WROW;
    LAS int* hist = (LAS int*)(F.lds + 2 * WIMG);
    const int n = F.lane & 15, q = F.lane >> 4;
    for (int i = F.tid; i < 32 * 256; i += NWAVES * 64) { const int e = i >> 8, c4 = i & 255; const f32x4 w = *((const f32x4*)(wrt + (size_t)e * D) + c4);
        v2u hi, lo; hi.x = pk2(w[0], w[1]); hi.y = pk2(w[2], w[3]);
        lo.x = pk2(w[0] - bflo(hi.x), w[1] - bfhi(hi.x)); lo.y = pk2(w[2] - bflo(hi.y), w[3] - bfhi(hi.y));
        *(LAS v2u*)(F.lds + e * WROW + c4 * 8) = hi; *(LAS v2u*)(F.lds + WIMG + e * WROW + c4 * 8) = lo; }
    __syncthreads();
    for (int tile = F.bid; tile < T / 128; tile += F.G) {
        if (F.tid < 32) hist[F.tid] = 0;
        __syncthreads();
        const int tok = tile * 128 + F.wave * 16 + n;
        const v4u* xr = (const v4u*)(x1 + (size_t)tok * D) + q; const LAS unsigned char* w0 = F.lds + n * WROW + 16 * q;
        f32x4 acc0 = {0.f, 0.f, 0.f, 0.f}, acc1 = {0.f, 0.f, 0.f, 0.f}; float ssq = 0.f, amax = 0.f;
        for (int S0 = 0; S0 < 32; S0 += 16) {
            v4u xw[16];
#pragma unroll
            for (int s = 0; s < 16; ++s) xw[s] = xr[4 * (S0 + s)];
#pragma unroll
            for (int s = 0; s < 16; ++s) { const bf16x8 xb8 = __builtin_bit_cast(bf16x8, xw[s]); const LAS unsigned char* wp = w0 + (S0 + s) * 64;
                const unsigned u[4] = {xw[s].x, xw[s].y, xw[s].z, xw[s].w};
#pragma unroll
                for (int j = 0; j < 4; ++j) { const float a = bflo(u[j]), b = bfhi(u[j]); ssq += a * a + b * b; amax = fmaxf(amax, fmaxf(fabsf(a), fabsf(b))); }
                acc0 = __builtin_amdgcn_mfma_f32_16x16x32_bf16(*(const LAS bf16x8*)(wp), xb8, acc0, 0, 0, 0);
                acc0 = __builtin_amdgcn_mfma_f32_16x16x32_bf16(*(const LAS bf16x8*)(wp + WIMG), xb8, acc0, 0, 0, 0);
                acc1 = __builtin_amdgcn_mfma_f32_16x16x32_bf16(*(const LAS bf16x8*)(wp + 16 * WROW), xb8, acc1, 0, 0, 0);
                acc1 = __builtin_amdgcn_mfma_f32_16x16x32_bf16(*(const LAS bf16x8*)(wp + WIMG + 16 * WROW), xb8, acc1, 0, 0, 0); }
        }
        ssq = quad_sum(ssq); amax = quad_max(amax);
        const float rs = 1.0f / sqrtf(ssq * (1.f / D) + 1e-6f);
        float lg[8];
#pragma unroll
        for (int i = 0; i < 4; ++i) { lg[i] = acc0[i] * rs + br[4 * q + i]; lg[4 + i] = acc1[i] * rs + br[16 + 4 * q + i]; }
        float tv[4]; int ti[4];
#pragma unroll
        for (int r = 0; r < 4; ++r) {
            float bv = -3.0e38f; int bi = 0;
#pragma unroll
            for (int j = 0; j < 8; ++j) { const int e = (j < 4 ? 0 : 16) + 4 * q + (j & 3); if (lg[j] > bv) { bv = lg[j]; bi = e; } }
#pragma unroll
            for (int o = 16; o <= 32; o <<= 1) { const float ov = __shfl_xor(bv, o); const int oi = __shfl_xor(bi, o); if (ov > bv || (ov == bv && oi < bi)) { bv = ov; bi = oi; } }
            tv[r] = bv; ti[r] = bi;
#pragma unroll
            for (int j = 0; j < 8; ++j) { const int e = (j < 4 ? 0 : 16) + 4 * q + (j & 3); if (e == bi) lg[j] = -3.0e38f; }
        }
        if (q == 0) {
            const float e1 = __expf(tv[1] - tv[0]), e2 = __expf(tv[2] - tv[0]), e3 = __expf(tv[3] - tv[0]); const float inv = 1.0f / (1.0f + e1 + e2 + e3);
            int lr[4];
#pragma unroll
            for (int r = 0; r < 4; ++r) lr[r] = atomicAdd((int*)&hist[ti[r]], 1);
            *(int4*)(eidx + (size_t)tok * 4) = make_int4(ti[0], ti[1], ti[2], ti[3]);
            *(float4*)(gate + (size_t)tok * 4) = make_float4(inv, e1 * inv, e2 * inv, e3 * inv);
            *(int4*)(lrank + (size_t)tok * 4) = make_int4(lr[0], lr[1], lr[2], lr[3]);
            rstd[tok] = rs * amax * (1.0f / 127.0f);
        }
        { const float qinv = amax > 0.f ? 127.0f / amax : 0.f; unsigned char* xq = ws + WS_XQ;
            for (int i0 = 0; i0 < 16; i0 += 4) { v4u xa[4], xb2[4];
#pragma unroll
                for (int i = 0; i < 4; ++i) { const v4u* p = (const v4u*)(x1 + (size_t)(tile * 128 + F.wave * 16 + i0 + i) * D) + 2 * F.lane; xa[i] = p[0]; xb2[i] = p[1]; }
#pragma unroll
                for (int i = 0; i < 4; ++i) { const float sc = __builtin_bit_cast(float, __builtin_amdgcn_readlane(__builtin_bit_cast(int, qinv), i0 + i));
                    const unsigned u[8] = {xa[i].x, xa[i].y, xa[i].z, xa[i].w, xb2[i].x, xb2[i].y, xb2[i].z, xb2[i].w}; v4u o;
#pragma unroll
                    for (int d = 0; d < 4; ++d) { const f32x2 lo = {bflo(u[2 * d]), bfhi(u[2 * d])}, hi = {bflo(u[2 * d + 1]), bfhi(u[2 * d + 1])};
                        const f32x2 ql = lo * sc + Q_MAGIC, qh = hi * sc + Q_MAGIC; o[d] = q_pack4(ql.x, ql.y, qh.x, qh.y); }
                    *((v4u*)(xq + (size_t)(tile * 128 + F.wave * 16 + i0 + i) * D) + F.lane) = o; } }
        }
        __syncthreads();
        if (F.tid < 32) cnt[tile * 32 + F.tid] = hist[F.tid];
        __syncthreads();
    }
}

DI void p7_permute(const Frame& F, const Args& a) {
    unsigned char* ws = a.ws; const int* cnt = (const int*)(ws + WS_CNT); int* meta = (int*)(ws + WS_META);
    const int* eidx = (const int*)(ws + WS_EIDX); const int* lrank = (const int*)(ws + WS_LRANK); int* inv = (int*)(ws + WS_INV);
    const float* rstd = (const float*)(ws + WS_RSTD); float* rowrstd = (float*)(ws + WS_ROWRSTD);
    bf16* xb = (bf16*)(ws + WS_XN); int* rowtok = (int*)(ws + WS_ROWTOK);
    LAS int* s_tot = (LAS int*)F.lds; LAS int* s_pst = s_tot + 32; LAS int* s_base = s_tot + 64; LAS int* s_part = s_tot + 128;
    { const int e = F.tid & 31, part = F.tid >> 5; int s = 0; for (int t = part * 16; t < part * 16 + 16; ++t) s += cnt[t * 32 + e]; s_part[part * 32 + e] = s; }
    __syncthreads();
    if (F.tid < 32) { int s = 0; for (int p = 0; p < 16; ++p) s += s_part[p * 32 + F.tid]; s_tot[F.tid] = s; }
    __syncthreads();
    if (F.tid < 32) { int ps = 0; for (int e = 0; e < F.tid; ++e) ps += (s_tot[e] + 255) / 256 * 256; s_pst[F.tid] = ps; }
    __syncthreads();
    if (F.bid == 0 && F.tid < 32) { const int e = F.tid, nb = (s_tot[e] + 255) / 256, rb0 = s_pst[e] / 256; for (int i = 0; i < nb; ++i) meta[16 + rb0 + i] = e; if (e == 31) meta[0] = rb0 + nb; }
    if (F.bid < 32) { const int e = F.bid, r0 = s_pst[e] + s_tot[e], r1 = s_pst[e] + (s_tot[e] + 255) / 256 * 256;
        for (int r = r0 + F.tid; r < r1; r += NWAVES * 64) { rowtok[r] = T; rowrstd[r] = 0.f; } }
    if (F.bid == 0 && F.tid < 64) { const v4u z = {0u, 0u, 0u, 0u}; *((v4u*)(ws + WS_XQ + (size_t)T * D) + F.tid) = z; }
    for (int tile = F.bid; tile < T / 128; tile += F.G) {
        __syncthreads();
        if (F.tid < 32) { int s = 0; for (int t = 0; t < tile; ++t) s += cnt[t * 32 + F.tid]; s_base[F.tid] = s_pst[F.tid] + s; }
        __syncthreads();
        { const int i = F.tid;
            const int tok = tile * 128 + (i >> 2), k = i & 3; const int e = eidx[tok * 4 + k]; const int dest = s_base[e] + lrank[tok * 4 + k];
            inv[tok * 4 + k] = dest; rowtok[dest] = tok; rowrstd[dest] = rstd[tok];
        }
    }
}

DI void p10_combine(const Frame& F, const Args& a) {
    unsigned char* ws = a.ws; const int* inv = (const int*)(ws + WS_INV); const float* gate = (const float*)(ws + WS_GATE); const bf16* yr = (const bf16*)(ws + WS_YR); const bf16* xb = (const bf16*)(ws + WS_XN); float* out = a.out;
    const int gw = F.bid * NWAVES + F.wave, NGW = F.G * NWAVES;
    for (int t = gw; t < T; t += NGW) {
        const int4 iv = *(const int4*)(inv + (size_t)t * 4); const float4 gv = *(const float4*)(gate + (size_t)t * 4);
        const int rows[4] = {iv.x, iv.y, iv.z, iv.w}; const float gs[4] = {gv.x, gv.y, gv.z, gv.w};
        f32x4* o = (f32x4*)(out + (size_t)t * D) + F.lane; const v2u* xr = (const v2u*)(xb + (size_t)t * D) + F.lane;
#pragma unroll
        for (int j = 0; j < 4; ++j) {
            const v2u xw = xr[64 * j]; f32x4 acc = {bflo(xw.x), bfhi(xw.x), bflo(xw.y), bfhi(xw.y)};
#pragma unroll
            for (int k = 0; k < 4; ++k) { const int w = (int)__builtin_nontemporal_load((const unsigned*)((const unsigned char*)yr + (size_t)rows[k] * D) + F.lane + 64 * j);
                const auto lo = __builtin_amdgcn_cvt_pk_f32_fp8(w, false), hi = __builtin_amdgcn_cvt_pk_f32_fp8(w, true);
                acc.x += gs[k] * lo[0]; acc.y += gs[k] * lo[1]; acc.z += gs[k] * hi[0]; acc.w += gs[k] * hi[1]; }
            __builtin_nontemporal_store(acc, o + 64 * j);
        }
    }
}

constexpr int N_PHASES = 11;
__global__ void __launch_bounds__(NWAVES * 64, 2) fwd(Args args) {
    extern __shared__ __attribute__((aligned(16))) unsigned char lds[];
    Frame F;
    F.lds = (LAS unsigned char*)lds;
    F.tid = threadIdx.x; F.lane = F.tid & 63; F.wave = __builtin_amdgcn_readfirstlane(F.tid >> 6);
    F.G = gridDim.x; F.bid = blockIdx.x;
    volatile LAS unsigned* MISC = (volatile LAS unsigned*)(F.lds + MISC_OFF);
    if (F.tid < 64) MISC[F.tid] = 0u;
    __syncthreads();
    unsigned char* ws = args.ws;
    unsigned* ctl = (unsigned*)(ws + WS_CTL);
    XcdBarrier bar; bar.bar = ctl + CW_BAR; bar.x = 0; bar.st = nullptr;
    if (MK_N_LAUNCHES == 1) bar = xcd_barrier_post(ctl + CW_BAR, MISC + 8);
    const int lo = args.ph_lo, hi = args.ph_hi;
#ifndef PHASE_MASK
#define PHASE_MASK 0xffff
#endif
#define IN(k) (((PHASE_MASK >> (k)) & 1) && lo <= (k) && (k) < hi)
#ifndef DUP_PHASE
#define DUP_PHASE -1
#endif
#define REPS(k) ((DUP_PHASE >= 0 && (k) == DUP_PHASE) ? args.ph_rep : 1)
#define SEAM(k) do { if (IN(k) && IN((k) + 1)) xcd_barrier(bar); { int t_ = threadIdx.x; asm volatile("" : "+v"(t_)); F.tid = t_; F.lane = t_ & 63; } } while (0)

    for (int rep_ = 0; rep_ < REPS(0); ++rep_) { if (rep_) xcd_barrier(bar);
    if (IN(0)) { p0_prologue(F, args); } } SEAM(0);

    for (int rep_ = 0; rep_ < REPS(1); ++rep_) { if (rep_) xcd_barrier(bar);
    if (IN(1)) {
        pg8::Gemm g{(const bf16*)(ws + WS_XN), (const bf16*)(ws + WS_WIN), T, INC, D / 2}; pg8::StaticOrder S; S.init(T, INC, F.G, F.bid);
        pg8::EpiBf16Q E{(bf16*)(ws + WS_PROJ), INC, (const float*)(ws + WS_XNSC), (const float*)(ws + WS_COLSC1)};
        pg8::gemm_phase<pg8::EpiBf16Q, pg8::StaticOrder, true, true>(F.lds, g, S, E);
    } } SEAM(1);

    for (int rep_ = 0; rep_ < REPS(2); ++rep_) { if (rep_) xcd_barrier(bar);
    if (IN(2)) {
#if NAIVE_RWKV
        rwkv_naive_prep(F, args);
#else
        rwkv_phase_a(F, args);
#endif
    } } SEAM(2);

    for (int rep_ = 0; rep_ < REPS(3); ++rep_) { if (rep_) xcd_barrier(bar);
    if (IN(3)) {
#if NAIVE_RWKV
        rwkv_naive_scan(F, args);
#else
        rwkv_phase_b(F, args);
#endif
        __syncthreads();
#if NAIVE_ATT
        attn_naive(F, args);
#else
        attn_phase(F, args, rep_);
#endif
    } } SEAM(3);

    for (int rep_ = 0; rep_ < REPS(4); ++rep_) { if (rep_) xcd_barrier(bar);
    if (IN(4)) {
#if !NAIVE_RWKV
        rwkv_phase_c(F, args);
#endif
    } } SEAM(4);

    for (int rep_ = 0; rep_ < REPS(5); ++rep_) { if (rep_) xcd_barrier(bar);
    if (IN(5)) {
        pg8::Gemm g{(const bf16*)(ws + WS_MIX), (const bf16*)(ws + WS_WOUT), T, D, D}; pg8::StaticOrder S; S.init(T, D, F.G, F.bid);
        pg8::EpiResid E{args.in[I_X], nullptr, (bf16*)(ws + WS_XN), D};
        pg8::gemm_phase<pg8::EpiResid, pg8::StaticOrder, true, true>(F.lds, g, S, E);
    } } SEAM(5);

    for (int rep_ = 0; rep_ < REPS(6); ++rep_) { if (rep_) xcd_barrier(bar);
    if (IN(6)) { p6_router(F, args); } } SEAM(6);
    for (int rep_ = 0; rep_ < REPS(7); ++rep_) { if (rep_) xcd_barrier(bar);
    if (IN(7)) { p7_permute(F, args); } } SEAM(7);

    for (int rep_ = 0; rep_ < REPS(8); ++rep_) { if (rep_) xcd_barrier(bar);
    if (IN(8)) {
        pg8::Gemm g{(const bf16*)(ws + WS_XQ), (const bf16*)(ws + WS_WUP), NROWS_MAX, 2048, D / 2};
        pg8::MoeOrder<true> S{(const int*)(ws + WS_META), 8, F.G, F.bid, (const int*)(ws + WS_ROWTOK)};
        pg8::EpiSwiGLU E{(bf16*)(ws + WS_ACT), args.in[I_BUP], (const float*)(ws + WS_ROWRSTD), (const float*)(ws + WS_COLSC)};
        pg8::gemm_phase<pg8::EpiSwiGLU, pg8::MoeOrder<true>, true, true>(F.lds, g, S, E);
    } } SEAM(8);

    for (int rep_ = 0; rep_ < REPS(9); ++rep_) { if (rep_) xcd_barrier(bar);
    if (IN(9)) {
        pg8::Gemm g{(const bf16*)(ws + WS_ACT), (const bf16*)(ws + WS_WDN), NROWS_MAX, 1024, D / 2};
        pg8::MoeOrder<false> S{(const int*)(ws + WS_META), 4, F.G, F.bid, nullptr};
        pg8::EpiDown E{(bf16*)(ws + WS_YR), args.in[I_BDN], (const float*)(ws + WS_COLSC2)};
        pg8::gemm_phase<pg8::EpiDown, pg8::MoeOrder<false>, true, true>(F.lds, g, S, E);
    } } SEAM(9);

    if (IN(10)) { p10_combine(F, args); }
#undef IN
#undef SEAM
}

extern "C" void kernel_launch(void* const* d_in, const int* in_sizes, int n_in, void* d_out, int out_size, void* d_ws, size_t ws_size, hipStream_t stream) {
    static int grid = 0;
    if (grid == 0) {
        if (n_in != 25 || out_size != T * D || ws_size < WS_END) { fprintf(stderr, "kernel_launch: unexpected shapes (n_in %d out %d ws %zu)\n", n_in, out_size, ws_size); grid = -1; return; }
        int dev = 0, cus = 0, per_cu = 0;
        if (hipGetDevice(&dev) != hipSuccess || hipDeviceGetAttribute(&cus, hipDeviceAttributeMultiprocessorCount, dev) != hipSuccess) { grid = -1; return; }
        if (hipFuncSetAttribute((const void*)fwd, hipFuncAttributeMaxDynamicSharedMemorySize, LDS_BYTES) != hipSuccess) { fprintf(stderr, "kernel_launch: hipFuncSetAttribute failed\n"); grid = -1; return; }
        if (hipOccupancyMaxActiveBlocksPerMultiprocessor(&per_cu, (const void*)fwd, NWAVES * 64, LDS_BYTES) != hipSuccess || per_cu < 1) { fprintf(stderr, "kernel_launch: occupancy query says %d\n", per_cu); }
        (void)hipGetLastError();
        grid = cus;
    }
    if (grid < 0) return;
    (void)hipMemsetAsync((char*)d_ws + WS_CTL, 0, CTL_ZERO_BYTES, stream);
    Args a{};
    for (int i = 0; i < 25; ++i) a.in[i] = (const float*)d_in[i];
    a.out = (float*)d_out; a.ws = (unsigned char*)d_ws;
#if MK_N_LAUNCHES == 1
    a.ph_lo = 0; a.ph_hi = N_PHASES; a.ph_rep = 2;
    hipLaunchKernelGGL(fwd, dim3(grid), dim3(NWAVES * 64), LDS_BYTES, stream, a);
#else
    for (int p = 0; p < N_PHASES; ++p) { a.ph_lo = p; a.ph_hi = p + 1; hipLaunchKernelGGL(fwd, dim3(grid), dim3(NWAVES * 64), LDS_BYTES, stream, a); }
#endif
}
```

```cpp
#define NAIVE_RWKV 0
#define NAIVE_ATT 0
#define MK_N_LAUNCHES 1
#include <hip/hip_runtime.h>
#include <cstdio>
#include <cstdint>

#ifndef MK_N_LAUNCHES
#define MK_N_LAUNCHES 1
#endif
#ifndef NAIVE_RWKV
#define NAIVE_RWKV 0
#endif
#ifndef NAIVE_ATT
#define NAIVE_ATT 0
#endif

namespace pg8 {
#define PG8_LAS __attribute__((address_space(3)))
typedef unsigned short bf16_t;
typedef short bf16x8 __attribute__((ext_vector_type(8)));
typedef float f32x4 __attribute__((ext_vector_type(4)));
typedef unsigned u32x4 __attribute__((ext_vector_type(4)));
typedef unsigned u32x2 __attribute__((ext_vector_type(2)));
typedef float f32x2e __attribute__((ext_vector_type(2)));
typedef int i32x4 __attribute__((ext_vector_type(4)));
typedef int i32x8 __attribute__((ext_vector_type(8)));
template <bool F8> struct Frag { bf16x8 v[2]; __device__ __forceinline__ void set(bf16x8 a, bf16x8 b) { v[0] = a; v[1] = b; } };
template <> struct Frag<true> { i32x8 v; __device__ __forceinline__ void set(bf16x8 a, bf16x8 b) { v = __builtin_shufflevector(__builtin_bit_cast(i32x4, a), __builtin_bit_cast(i32x4, b), 0, 1, 2, 3, 4, 5, 6, 7); } };
__device__ __forceinline__ i32x8 cat8(bf16x8 a, bf16x8 b) { return __builtin_shufflevector(__builtin_bit_cast(i32x4, a), __builtin_bit_cast(i32x4, b), 0, 1, 2, 3, 4, 5, 6, 7); }
constexpr int BM = 256, BK = 64, HALF = 128, HTB = HALF * BK * 2  , STAGE_BYTES = 8 * HTB, NXCD = 8, WGM = 8, EPF_OFF = STAGE_BYTES  ;

__host__ __device__ __forceinline__ int lds_byte(int r, int c) { const int st = (r >> 4) * 2 + (c >> 5), rr = r & 15, cc = c & 31, ob = rr * 64 + cc * 2; return st * 1024 + (ob ^ (((ob >> 9) & 1) << 5)); }
__host__ __device__ __forceinline__ void stage_rc(int b, int& R, int& C) { const int st = b / 1024, sb = b % 1024, swz = sb ^ (((sb >> 9) & 1) << 5); R = (st >> 1) * 16 + swz / 64; C = (st & 1) * 32 + (swz % 64) / 2; }
__host__ __device__ __forceinline__ int perm32(int rho) { const int n = rho >> 4, i = rho & 15; return 8 * (i >> 2) + 4 * n + (i & 3); }

struct Unit { int pm, pn, e; };
struct Gemm { const bf16_t* A; const bf16_t* Bt; int M, N, K; };

__device__ __forceinline__ bool tile_of(int i, int G, int c, int nM, int nN, int& pm, int& pn) {
    const int nwg = nM * nN; const long L = (long)i * G + c; if (L >= nwg) return false;
    int wgid = (int)L; { const int q = nwg / NXCD, r = nwg % NXCD, xcd = wgid % NXCD, off = wgid / NXCD; wgid = (xcd < r ? xcd * (q + 1) : r * (q + 1) + (xcd - r) * q) + off; }
    const int nig = WGM * nN, gid = wgid / nig, fm = gid * WGM, gsz = (nM - fm) < WGM ? (nM - fm) : WGM;
    pm = fm + ((wgid % nig) % gsz); pn = (wgid % nig) / gsz; return true;
}
struct StaticOrder {
    int nM, nN, G, c;
    __device__ void init(int M, int N, int G_, int c_) { nM = M / BM; nN = N / BM; G = G_; c = c_; }
    __device__ __forceinline__ bool next(int i, Unit& u) const { u.e = 0; return tile_of(i, G, c, nM, nN, u.pm, u.pn); }
    __device__ __forceinline__ const char* a_base(const Gemm& g, const Unit& u) const { return (const char*)g.A + (size_t)u.pm * BM * g.K * 2; }
    __device__ __forceinline__ const char* b_base(const Gemm& g, const Unit& u) const { return (const char*)g.Bt + (size_t)u.pn * BM * g.K * 2; }
    __device__ __forceinline__ void a_off(const Gemm& g, const Unit&, const int (&R)[2], const int (&C)[2], unsigned (&vo)[2][2]) const {
#pragma unroll
        for (int h = 0; h < 2; ++h)
#pragma unroll
            for (int i = 0; i < 2; ++i) vo[h][i] = (unsigned)((h * HALF + R[i]) * g.K + C[i]) * 2u; }
    __device__ __forceinline__ void a_ready(const Unit&) const {}
    __device__ __forceinline__ void done(const Unit&) const {}
    static constexpr bool LATE = false;
    __device__ __forceinline__ void prologue(PG8_LAS unsigned char*, int) const {}
    __device__ __forceinline__ void a_req(const Unit&, PG8_LAS unsigned char*, int, int, int) const {}
    __device__ __forceinline__ void a_off_lds(const Gemm&, const PG8_LAS unsigned char*, int, const int (&)[2], const int (&)[2], unsigned (&)[2][2]) const {}
};
constexpr int SCH_META_OFF = EPF_OFF + 4096, SCH_ROW_OFF = EPF_OFF + 8192;
template <bool GATHER>
struct MoeOrder {
    const int* meta; int nN, G, c;
    const int* rowtok;
    const PG8_LAS int* lmeta;
    static constexpr bool LATE = GATHER;
    __device__ __forceinline__ void prologue(PG8_LAS unsigned char* lds, int tid) { PG8_LAS int* lm = (PG8_LAS int*)(lds + SCH_META_OFF);
        for (int i = tid; i < 16 + 544; i += 512) lm[i] = meta[i];
        __syncthreads(); lmeta = lm; }
    __device__ __forceinline__ bool next(int i, Unit& u) const {
        const int nM = __builtin_amdgcn_readfirstlane(lmeta[0]);
        if (!tile_of(i, G, c, nM, nN, u.pm, u.pn)) return false;
        u.e = __builtin_amdgcn_readfirstlane(lmeta[16 + u.pm]); return true;
    }
    __device__ __forceinline__ const char* a_base(const Gemm& g, const Unit& u) const { return GATHER ? (const char*)g.A : (const char*)g.A + (size_t)u.pm * BM * g.K * 2; }
    __device__ __forceinline__ const char* b_base(const Gemm& g, const Unit& u) const { return (const char*)g.Bt + ((size_t)u.e * g.N + (size_t)u.pn * BM) * g.K * 2; }
    __device__ __forceinline__ void a_off(const Gemm& g, const Unit& u, const int (&R)[2], const int (&C)[2], unsigned (&vo)[2][2]) const {
#pragma unroll
        for (int h = 0; h < 2; ++h)
#pragma unroll
            for (int i = 0; i < 2; ++i) { const int r = h * HALF + R[i]; vo[h][i] = (unsigned)((GATHER ? rowtok[u.pm * BM + r] : r) * g.K + C[i]) * 2u; } }
    __device__ __forceinline__ void a_req(const Unit& nxt, PG8_LAS unsigned char* lds, int wid, int lane, int slot) const {
        if (GATHER && wid == 0) __builtin_amdgcn_global_load_lds((const unsigned*)(rowtok + nxt.pm * BM + 4 * lane), (PG8_LAS unsigned*)(lds + SCH_ROW_OFF + (slot & 1) * 1024), 16, 0, 0); }
    __device__ __forceinline__ void a_off_lds(const Gemm& g, const PG8_LAS unsigned char* lds, int slot, const int (&R)[2], const int (&C)[2], unsigned (&vo)[2][2]) const {
        const PG8_LAS int* lr = (const PG8_LAS int*)(lds + SCH_ROW_OFF + (slot & 1) * 1024);
#pragma unroll
        for (int h = 0; h < 2; ++h)
#pragma unroll
            for (int i = 0; i < 2; ++i) vo[h][i] = (unsigned)(lr[h * HALF + R[i]] * g.K + C[i]) * 2u; }
    __device__ __forceinline__ void a_ready(const Unit&) const {}
    __device__ __forceinline__ void done(const Unit&) const {}
};

__device__ __forceinline__ unsigned cvt_pk_bf16(float lo, float hi) { unsigned r; asm volatile("v_cvt_pk_bf16_f32 %0, %1, %2" : "=v"(r) : "v"(lo), "v"(hi)); return r; }

__device__ __forceinline__ float acc_i2f(float bits) { return (float)__builtin_bit_cast(int, bits); }
__device__ __forceinline__ void epf_dma(const float* src_lane, PG8_LAS unsigned char* dst) { __builtin_amdgcn_global_load_lds((const unsigned*)src_lane, (PG8_LAS unsigned*)dst, 16, 0, 0); }
struct EpiBf16Q {
    static constexpr int ID = 1; static constexpr bool PERM = true, AFTER_DRAIN = false, I8 = true, F8 = false, EPF = true;
    bf16_t* O; int ldc; const float* rowsc; const float* colsc;
    __device__ __forceinline__ void prefetch(const Unit& u, PG8_LAS unsigned char* ev, int lane) const {
        epf_dma(colsc + u.pn * BM + 4 * lane, ev); epf_dma(rowsc + u.pm * BM + 4 * lane, ev + 1024); }
    __device__ __forceinline__ void operator()(const f32x4 (&acc)[2][2][4][2], const Unit& u, int wr, int wc, int fr, int fq, const PG8_LAS float* ev) const {
        const int row0 = u.pm * BM + wr * 64 + fr, col0 = u.pn * BM + wc * 32 + 8 * fq;
        f32x4 cv[2][2]; float rsv[2][4];
#pragma unroll
        for (int bj = 0; bj < 2; ++bj)
#pragma unroll
            for (int n = 0; n < 2; ++n) cv[bj][n] = *(const PG8_LAS f32x4*)(ev + wc * 32 + 8 * fq + bj * HALF + 4 * n);
#pragma unroll
        for (int ai = 0; ai < 2; ++ai)
#pragma unroll
            for (int m = 0; m < 4; ++m) rsv[ai][m] = ev[256 + wr * 64 + fr + ai * HALF + m * 16];
#pragma unroll
        for (int ai = 0; ai < 2; ++ai)
#pragma unroll
            for (int m = 0; m < 4; ++m) { bf16_t* rowp = O + (size_t)(row0 + ai * HALF + m * 16) * ldc + col0; const float rs = rsv[ai][m];
#pragma unroll
                for (int bj = 0; bj < 2; ++bj) { f32x4 v0, v1;
#pragma unroll
                    for (int j = 0; j < 4; ++j) { v0[j] = acc_i2f(acc[ai][bj][m][0][j]); v1[j] = acc_i2f(acc[ai][bj][m][1][j]); }
                    v0 = (v0 * rs) * cv[bj][0]; v1 = (v1 * rs) * cv[bj][1];
                    u32x4 w; w.x = cvt_pk_bf16(v0[0], v0[1]); w.y = cvt_pk_bf16(v0[2], v0[3]); w.z = cvt_pk_bf16(v1[0], v1[1]); w.w = cvt_pk_bf16(v1[2], v1[3]);
                    *(u32x4*)(rowp + bj * HALF) = w; } }
    }
};
struct EpiBf16 {
    static constexpr int ID = 0; static constexpr bool PERM = true, AFTER_DRAIN = false, I8 = false, F8 = false, EPF = false;
    bf16_t* O; int ldc;
    __device__ __forceinline__ void operator()(const f32x4 (&acc)[2][2][4][2], const Unit& u, int wr, int wc, int fr, int fq) const {
        const int row0 = u.pm * BM + wr * 64 + fr, col0 = u.pn * BM + wc * 32 + 8 * fq;
#pragma unroll
        for (int ai = 0; ai < 2; ++ai)
#pragma unroll
            for (int m = 0; m < 4; ++m) { bf16_t* rowp = O + (size_t)(row0 + ai * HALF + m * 16) * ldc + col0;
#pragma unroll
                for (int bj = 0; bj < 2; ++bj) { const f32x4 v0 = acc[ai][bj][m][0], v1 = acc[ai][bj][m][1];
                    u32x4 w; w.x = cvt_pk_bf16(v0[0], v0[1]); w.y = cvt_pk_bf16(v0[2], v0[3]); w.z = cvt_pk_bf16(v1[0], v1[1]); w.w = cvt_pk_bf16(v1[2], v1[3]);
                    *(u32x4*)(rowp + bj * HALF) = w; } }
    }
};
struct EpiResid {
    static constexpr int ID = 5; static constexpr bool PERM = false, AFTER_DRAIN = false, I8 = false, F8 = false, EPF = false;
    const float* base; float* out; bf16_t* xb; int ldc;
    __device__ __forceinline__ void operator()(const f32x4 (&acc)[2][2][4][2], const Unit& u, int wr, int wc, int fr, int fq) const {
        const int row0 = u.pm * BM + wr * 64 + fr, col0 = u.pn * BM + wc * 32 + 4 * fq;
        f32x4 nb[4][2][2];
#define PG8_RES_LOAD(g_) do { const size_t off_ = (size_t)(row0 + ((g_) >> 2) * HALF + ((g_) & 3) * 16) * ldc + col0; _Pragma("unroll") for (int bj = 0; bj < 2; ++bj) _Pragma("unroll") for (int n = 0; n < 2; ++n) \
            nb[(g_) & 3][bj][n] = __builtin_nontemporal_load((const f32x4*)(base + off_ + bj * HALF + n * 16)); } while (0)
        PG8_RES_LOAD(0); PG8_RES_LOAD(1); PG8_RES_LOAD(2);
#pragma unroll
        for (int g = 0; g < 8; ++g) { const int ai = g >> 2, m = g & 3; const size_t off = (size_t)(row0 + ai * HALF + m * 16) * ldc + col0;
            if (g + 3 < 8) PG8_RES_LOAD(g + 3);
#pragma unroll
            for (int bj = 0; bj < 2; ++bj)
#pragma unroll
                for (int n = 0; n < 2; ++n) { const f32x4 o = nb[g & 3][bj][n] + acc[ai][bj][m][n];
                    if (out) *(f32x4*)(out + off + bj * HALF + n * 16) = o;
                    u32x2 w; w.x = cvt_pk_bf16(o[0], o[1]); w.y = cvt_pk_bf16(o[2], o[3]); *(u32x2*)(xb + off + bj * HALF + n * 16) = w; }
            asm volatile("" ::: "memory"); }
#undef PG8_RES_LOAD
    }
};
struct EpiSwiGLU {
    static constexpr int ID = 8; static constexpr bool PERM = true, AFTER_DRAIN = false, I8 = true, F8 = false, EPF = true;
    bf16_t* O; const float* b_up; const float* rowrstd; const float* colsc;
    __device__ __forceinline__ void prefetch(const Unit& u, PG8_LAS unsigned char* ev, int lane) const {
        const int off = (size_t)u.e * 2048 + u.pn * HALF + (lane >> 5) * 1024 + 4 * (lane & 31);
        epf_dma(b_up + off, ev); epf_dma(colsc + off, ev + 1024); epf_dma(rowrstd + u.pm * BM + 4 * lane, ev + 2048); }
    __device__ __forceinline__ void operator()(const f32x4 (&acc)[2][2][4][2], const Unit& u, int wr, int wc, int fr, int fq, const PG8_LAS float* ev) const {
        const int row0 = u.pm * BM + wr * 64 + fr, f0 = u.pn * HALF + wc * 32 + 8 * fq;
        const PG8_LAS float* ep = ev + wc * 32 + 8 * fq;
        const f32x4 bg0 = *(const PG8_LAS f32x4*)ep, bg1 = *(const PG8_LAS f32x4*)(ep + 4), bl0 = *(const PG8_LAS f32x4*)(ep + 128), bl1 = *(const PG8_LAS f32x4*)(ep + 132);
        const f32x4 cg0 = *(const PG8_LAS f32x4*)(ep + 256), cg1 = *(const PG8_LAS f32x4*)(ep + 260), cl0 = *(const PG8_LAS f32x4*)(ep + 384), cl1 = *(const PG8_LAS f32x4*)(ep + 388);
        float rsv[2][4];
#pragma unroll
        for (int ai = 0; ai < 2; ++ai)
#pragma unroll
            for (int m = 0; m < 4; ++m) rsv[ai][m] = ev[512 + wr * 64 + fr + ai * HALF + m * 16];
#pragma unroll
        for (int ai = 0; ai < 2; ++ai)
#pragma unroll
            for (int m = 0; m < 4; ++m) { const int row = row0 + ai * HALF + m * 16; const float rs = rsv[ai][m];
                float a[8];
#pragma unroll
                for (int n = 0; n < 2; ++n)
#pragma unroll
                    for (int j = 0; j < 4; j += 2) {
                        const f32x2e ag2 = {acc_i2f(acc[ai][0][m][n][j]), acc_i2f(acc[ai][0][m][n][j + 1])}, al2 = {acc_i2f(acc[ai][1][m][n][j]), acc_i2f(acc[ai][1][m][n][j + 1])};
                        const f32x2e cg2 = n ? (f32x2e){cg1[j], cg1[j + 1]} : (f32x2e){cg0[j], cg0[j + 1]}, cl2 = n ? (f32x2e){cl1[j], cl1[j + 1]} : (f32x2e){cl0[j], cl0[j + 1]};
                        const f32x2e bg2 = n ? (f32x2e){bg1[j], bg1[j + 1]} : (f32x2e){bg0[j], bg0[j + 1]}, bl2 = n ? (f32x2e){bl1[j], bl1[j + 1]} : (f32x2e){bl0[j], bl0[j + 1]};
                        f32x2e hg = (ag2 * rs) * cg2 + bg2, hl = (al2 * rs) * cl2 + bl2;
                        hg.x = fminf(hg.x, 7.0f); hg.y = fminf(hg.y, 7.0f); hl.x = fminf(fmaxf(hl.x, -7.0f), 7.0f); hl.y = fminf(fmaxf(hl.y, -7.0f), 7.0f);
                        const f32x2e t = hg * (-1.702f * 1.4426950408889634f);
                        f32x2e e; e.x = __builtin_amdgcn_exp2f(t.x); e.y = __builtin_amdgcn_exp2f(t.y);
                        const f32x2e d = e + 1.0f; f32x2e sg; sg.x = __builtin_amdgcn_rcpf(d.x); sg.y = __builtin_amdgcn_rcpf(d.y);
                        const f32x2e o = (hg * sg) * (hl + 1.0f);
                        a[n * 4 + j] = o.x; a[n * 4 + j + 1] = o.y; }
                u32x2 w;
                w.x = (unsigned)__builtin_amdgcn_cvt_pk_fp8_f32(a[2], a[3], __builtin_amdgcn_cvt_pk_fp8_f32(a[0], a[1], 0, false), true);
                w.y = (unsigned)__builtin_amdgcn_cvt_pk_fp8_f32(a[6], a[7], __builtin_amdgcn_cvt_pk_fp8_f32(a[4], a[5], 0, false), true);
                *(u32x2*)((unsigned char*)O + (size_t)row * 1024 + f0) = w; }
    }
};
struct EpiDown {
    static constexpr int ID = 9; static constexpr bool PERM = true, AFTER_DRAIN = false, I8 = false, F8 = true, EPF = true;
    bf16_t* O; const float* b_dn; const float* colsc;
    __device__ __forceinline__ void prefetch(const Unit& u, PG8_LAS unsigned char* ev, int lane) const {
        const int off = (size_t)u.e * 1024 + u.pn * BM + 4 * lane;
        epf_dma(b_dn + off, ev); epf_dma(colsc + off, ev + 1024); }
    __device__ __forceinline__ void operator()(const f32x4 (&acc)[2][2][4][2], const Unit& u, int wr, int wc, int fr, int fq, const PG8_LAS float* ev) const {
        const int row0 = u.pm * BM + wr * 64 + fr, col0 = u.pn * BM + wc * 32 + 8 * fq;
        f32x4 bv[2][2], cv[2][2];
#pragma unroll
        for (int bj = 0; bj < 2; ++bj)
#pragma unroll
            for (int n = 0; n < 2; ++n) { bv[bj][n] = *(const PG8_LAS f32x4*)(ev + wc * 32 + 8 * fq + bj * HALF + 4 * n); cv[bj][n] = *(const PG8_LAS f32x4*)(ev + 256 + wc * 32 + 8 * fq + bj * HALF + 4 * n); }
#pragma unroll
        for (int ai = 0; ai < 2; ++ai)
#pragma unroll
            for (int m = 0; m < 4; ++m) { unsigned char* rowp = (unsigned char*)O + (size_t)(row0 + ai * HALF + m * 16) * 1024 + col0;
#pragma unroll
                for (int bj = 0; bj < 2; ++bj) { const f32x4 v0 = acc[ai][bj][m][0] * cv[bj][0] + bv[bj][0], v1 = acc[ai][bj][m][1] * cv[bj][1] + bv[bj][1];
                    u32x2 w; w.x = (unsigned)__builtin_amdgcn_cvt_pk_fp8_f32(v0[2], v0[3], __builtin_amdgcn_cvt_pk_fp8_f32(v0[0], v0[1], 0, false), true);
                    w.y = (unsigned)__builtin_amdgcn_cvt_pk_fp8_f32(v1[2], v1[3], __builtin_amdgcn_cvt_pk_fp8_f32(v1[0], v1[1], 0, false), true);
                    *(u32x2*)(rowp + bj * HALF) = w; } }
    }
};

template <class Epi, class Sched, bool ALIGN_EPI = false, bool SP2 = false>
__device__ __forceinline__ void gemm_phase(PG8_LAS unsigned char* lds, const Gemm g, Sched S, const Epi& E) {
    int tid = threadIdx.x; asm volatile("" : "+v"(tid));
    const int wid = __builtin_amdgcn_readfirstlane(tid >> 6), lane = tid & 63, wr = wid >> 2, wc = wid & 3, fr = lane & 15, fq = lane >> 4;
    const int K = g.K, nt = K / BK;
    unsigned voffB[2]; int sR[2], sC[2];
#pragma unroll
    for (int i = 0; i < 2; ++i) { int R, C; stage_rc(tid * 16 + i * 8192, R, C); const int Rb = Epi::PERM ? ((R & ~31) + perm32(R & 31)) : R;
        sR[i] = R; sC[i] = C; voffB[i] = (unsigned)(Rb * K + C) * 2u; }
    const size_t kstep = (size_t)(BK * 2);
    const size_t hstep = (size_t)HALF * K * 2;
    const unsigned ldsw = (unsigned)wid * 1024u;
    const int aoff = lds_byte(wr * 64 + fr, fq * 8), boff = lds_byte(wc * 32 + fr, fq * 8);
#define PG8_SA(b, h) (((b) * 2 + (h)) * HTB)
#define PG8_SB(b, h) ((4 + (b) * 2 + (h)) * HTB)
#define PG8_STAGE(bufoff, gbase, voff) do { _Pragma("unroll") for (int _i = 0; _i < 2; ++_i) \
        __builtin_amdgcn_global_load_lds((const unsigned*)((const char*)(gbase) + (voff)[_i]), (PG8_LAS unsigned*)(lds + (bufoff) + ldsw + _i * 8192), 16, 0, 0); } while (0)
#define PG8_STAGE_A(bufoff, gbase, vo, h) do { _Pragma("unroll") for (int _i = 0; _i < 2; ++_i) \
        __builtin_amdgcn_global_load_lds((const unsigned*)((const char*)(gbase) + (vo)[h][_i]), (PG8_LAS unsigned*)(lds + (bufoff) + ldsw + _i * 8192), 16, 0, 0); } while (0)
#define PG8_LDA(dst, b, h) do { _Pragma("unroll") for (int m = 0; m < 4; ++m) dst[m].set(*(const PG8_LAS bf16x8*)(lds + PG8_SA(b, h) + aoff + m * 2048), *(const PG8_LAS bf16x8*)(lds + PG8_SA(b, h) + aoff + m * 2048 + 1024)); } while (0)
#define PG8_LDB(dst, b, h) do { _Pragma("unroll") for (int n = 0; n < 2; ++n) dst[n].set(*(const PG8_LAS bf16x8*)(lds + PG8_SB(b, h) + boff + n * 2048), *(const PG8_LAS bf16x8*)(lds + PG8_SB(b, h) + boff + n * 2048 + 1024)); } while (0)
#define PG8_MMA(ai, bj, At, Bt) do { __builtin_amdgcn_s_setprio(1); _Pragma("unroll") for (int m = 0; m < 4; ++m) _Pragma("unroll") for (int n = 0; n < 2; ++n) { \
        if constexpr (Epi::F8) asm volatile("v_mfma_scale_f32_16x16x128_f8f6f4 %0, %1, %2, %0, %3, %3 op_sel_hi:[0,0,0]" : "+v"(acc[ai][bj][m][n]) : "v"(Bt[n].v), "v"(At[m].v), "v"(f8scale)); \
        else { _Pragma("unroll") for (int k = 0; k < 2; ++k) { \
            if constexpr (Epi::I8) acc[ai][bj][m][n] = __builtin_bit_cast(f32x4, __builtin_amdgcn_mfma_i32_16x16x64_i8(__builtin_bit_cast(i32x4, Bt[n].v[k]), __builtin_bit_cast(i32x4, At[m].v[k]), __builtin_bit_cast(i32x4, acc[ai][bj][m][n]), 0, 0, 0)); \
            else acc[ai][bj][m][n] = __builtin_amdgcn_mfma_f32_16x16x32_bf16(Bt[n].v[k], At[m].v[k], acc[ai][bj][m][n], 0, 0, 0); } } } __builtin_amdgcn_s_setprio(0); } while (0)
#define PG8_WAIT_V(n) asm volatile("s_waitcnt vmcnt(" #n ")" ::: "memory")
#define PG8_WAIT_L(n) asm volatile("s_waitcnt lgkmcnt(" #n ")" ::: "memory")
#define PG8_BAR __builtin_amdgcn_s_barrier()
#define PG8_SCHED __builtin_amdgcn_sched_barrier(0)
    Unit cur, nxt; int ui = 0;
#ifdef GEMM_TIME
    long long gacc_ = 0;
#endif
    S.prologue(lds, tid);
    if (!S.next(0, cur)) return;
    f32x4 acc[2][2][4][2];
#pragma unroll
    for (int a = 0; a < 2; ++a)
#pragma unroll
        for (int b = 0; b < 2; ++b)
#pragma unroll
            for (int m = 0; m < 4; ++m)
#pragma unroll
                for (int n = 0; n < 2; ++n) acc[a][b][m][n] = (f32x4){0.f, 0.f, 0.f, 0.f};
    Frag<Epi::F8> At[4], B0[2], B1[2];
    const int f8scale = 0x7f7f7f7f;
    (void)f8scale;
    const char* cA = S.a_base(g, cur); const char* cB = S.b_base(g, cur);
    unsigned voC[2][2], voN[2][2];
    S.a_off(g, cur, sR, sC, voC);
    S.a_ready(cur);
    static_assert(SP2, "only the two-MFMA-blocks-per-barrier-pair loop is kept");
    PG8_STAGE(PG8_SB(0, 0), cB, voffB); PG8_STAGE(PG8_SB(0, 1), cB + hstep, voffB); PG8_STAGE_A(PG8_SA(0, 0), cA, voC, 0); PG8_STAGE_A(PG8_SA(0, 1), cA, voC, 1);
    if (wr == 1) PG8_BAR;
    PG8_WAIT_V(2); PG8_BAR;
    PG8_STAGE(PG8_SB(1, 0), cB + kstep, voffB); PG8_STAGE_A(PG8_SA(1, 0), cA + kstep, voC, 0); PG8_STAGE(PG8_SB(1, 1), cB + hstep + kstep, voffB);
    PG8_WAIT_V(6); PG8_BAR;
    for (;;) {
        const bool has_next = S.next(ui + 1, nxt);
        const char* nA = has_next ? S.a_base(g, nxt) : cA; const char* nB = has_next ? S.b_base(g, nxt) : cB;
        if (has_next && !Sched::LATE) S.a_off(g, nxt, sR, sC, voN); else {
#pragma unroll
            for (int h_ = 0; h_ < 2; ++h_) { voN[h_][0] = voC[h_][0]; voN[h_][1] = voC[h_][1]; } }
        if constexpr (Sched::LATE) { if (has_next) S.a_req(nxt, lds, wid, lane, ui + 1); }
#pragma unroll 1
        for (int t = 0; t < nt; t += 2) {
            const bool last = (t == nt - 2);
            const char* a1 = cA + (size_t)(t + 1) * kstep;
            const char* a2 = last ? nA : cA + (size_t)(t + 2) * kstep; const char* b2 = last ? nB : cB + (size_t)(t + 2) * kstep;
            const char* a3 = a2 + kstep; const char* b3 = b2 + kstep;
            if (last && has_next) S.a_ready(nxt);
            if constexpr (Sched::LATE) { if (last && has_next) S.a_off_lds(g, lds, ui + 1, sR, sC, voN); }
            if constexpr (Epi::EPF) { if (last && wid == 0) E.prefetch(cur, lds + EPF_OFF, lane); }
            unsigned vo2[2][2];
#pragma unroll
            for (int h_ = 0; h_ < 2; ++h_) { vo2[h_][0] = last ? voN[h_][0] : voC[h_][0]; vo2[h_][1] = last ? voN[h_][1] : voC[h_][1]; }
            PG8_LDB(B0, 0, 0); PG8_LDB(B1, 0, 1); PG8_SCHED; PG8_LDA(At, 0, 0); PG8_STAGE_A(PG8_SA(1, 1), a1, voC, 1);
            PG8_WAIT_V(8); PG8_WAIT_L(0); PG8_BAR; PG8_MMA(0, 0, At, B0); PG8_MMA(0, 1, At, B1); PG8_BAR; PG8_SCHED;
            PG8_LDA(At, 0, 1); PG8_STAGE(PG8_SB(0, 0), b2, voffB); PG8_STAGE(PG8_SB(0, 1), b2 + hstep, voffB); PG8_STAGE_A(PG8_SA(0, 0), a2, vo2, 0);
            PG8_WAIT_V(8); PG8_WAIT_L(0); PG8_BAR; PG8_MMA(1, 0, At, B0); PG8_MMA(1, 1, At, B1); PG8_BAR; PG8_SCHED;
            PG8_LDB(B0, 1, 0); PG8_LDB(B1, 1, 1); PG8_SCHED; PG8_LDA(At, 1, 0); PG8_STAGE_A(PG8_SA(0, 1), a2, vo2, 1);
            PG8_WAIT_V(8); PG8_WAIT_L(0); PG8_BAR; PG8_MMA(0, 0, At, B0); PG8_MMA(0, 1, At, B1); PG8_BAR; PG8_SCHED;
            PG8_LDA(At, 1, 1); PG8_STAGE(PG8_SB(1, 0), b3, voffB); PG8_STAGE(PG8_SB(1, 1), b3 + hstep, voffB); PG8_STAGE_A(PG8_SA(1, 0), a3, vo2, 0);
            PG8_WAIT_V(8); PG8_WAIT_L(0); PG8_BAR; PG8_MMA(1, 0, At, B0); PG8_MMA(1, 1, At, B1); PG8_BAR; PG8_SCHED;
        }
        if constexpr (ALIGN_EPI) { if (wr == 0) PG8_BAR; }
#ifdef GEMM_TIME
        const long long gt0_ = clock64();
#endif
        if constexpr (!Epi::AFTER_DRAIN) { if constexpr (Epi::EPF) E(acc, cur, wr, wc, fr, fq, (const PG8_LAS float*)(lds + EPF_OFF)); else E(acc, cur, wr, wc, fr, fq); S.done(cur); }
#ifdef GEMM_TIME
        if (GEMM_TIME == 100 || GEMM_TIME == Epi::ID) gacc_ += clock64() - gt0_;
#endif
        if (!has_next) break;
#pragma unroll
        for (int a = 0; a < 2; ++a)
#pragma unroll
            for (int b = 0; b < 2; ++b)
#pragma unroll
                for (int m = 0; m < 4; ++m)
#pragma unroll
                    for (int n = 0; n < 2; ++n) acc[a][b][m][n] = (f32x4){0.f, 0.f, 0.f, 0.f};
        cur = nxt; cA = nA; cB = nB; ++ui;
#pragma unroll
        for (int h_ = 0; h_ < 2; ++h_) { voC[h_][0] = voN[h_][0]; voC[h_][1] = voN[h_][1]; }
        if constexpr (ALIGN_EPI) { if (wr == 1) PG8_BAR; }
    }
    PG8_WAIT_V(0);
    if constexpr (!ALIGN_EPI) { if (wr == 0) PG8_BAR; }
    PG8_BAR;
#ifdef GEMM_TIME
    { const long long s0_ = clock64(); while (clock64() - s0_ < gacc_) __builtin_amdgcn_s_sleep(8); }
#endif
    if constexpr (Epi::AFTER_DRAIN) { E.fused(acc, cur, wr, wc, fr, fq, lds, wid, lane); S.done(cur); }
#undef PG8_SA
#undef PG8_SB
#undef PG8_STAGE
#undef PG8_STAGE_A
#undef PG8_LDA
#undef PG8_LDB
#undef PG8_MMA
#undef PG8_WAIT_V
#undef PG8_WAIT_L
#undef PG8_BAR
#undef PG8_SCHED
}
}

constexpr int NWAVES = 8;
constexpr int T = 32768, D = 1024, SEQ = 8192, NBATCH = 4, NCHUNK = SEQ / 64;
constexpr int INC = 3328;
constexpr int PRW = 1536;
constexpr int NEXP = 32, TOPK = 4;
constexpr int NRB_MAX = T * TOPK / 256 + NEXP;
constexpr int NROWS_MAX = NRB_MAX * 256;
constexpr int NITEM = NBATCH * NCHUNK * 8;

constexpr size_t MiB = 1u << 20, KiB = 1u << 10;
constexpr size_t WS_CTL = 0, CTL_ZERO_BYTES = 1 * MiB;
constexpr size_t WS_META = 1 * MiB;
constexpr size_t WS_CNT = 1 * MiB + 64 * KiB;
constexpr size_t WS_EIDX = 2 * MiB, WS_GATE = 2 * MiB + 512 * KiB, WS_LRANK = 3 * MiB, WS_INV = 3 * MiB + 512 * KiB;
constexpr size_t WS_RSTD = 4 * MiB, WS_ROWRSTD = 4 * MiB + 256 * KiB;
constexpr size_t WS_WRT = 5 * MiB;
constexpr size_t WS_PAR = 5 * MiB + 128 * KiB;
constexpr size_t WS_WDEC = 5 * MiB + 256 * KiB, WS_WAAA = WS_WDEC + 64 * KiB, WS_WGATE = WS_WAAA + 64 * KiB;
constexpr size_t WS_WIN = 6 * MiB, WS_WOUT = 13 * MiB;
constexpr size_t WS_ROWTOK = 15 * MiB;
constexpr size_t WS_WUP = 16 * MiB, WS_WDN = 144 * MiB;
constexpr size_t WS_XN = 208 * MiB;
constexpr size_t WS_PROJ = 272 * MiB;
constexpr size_t WS_MIX = 480 * MiB;
constexpr size_t WS_RW = 544 * MiB;
constexpr size_t WS_XG = 272 * MiB, WS_ACT = 544 * MiB, WS_YR = WS_XG;
constexpr size_t WS_COLSC = 15 * MiB + 640 * KiB;
constexpr size_t WS_COLSC1 = 5 * MiB + 192 * KiB;
constexpr size_t WS_XNSC = WS_RSTD;
constexpr size_t WS_COLSC2 = 15 * MiB + 896 * KiB;
constexpr size_t WS_XQ = WS_MIX;
constexpr size_t WS_END = 1000 * MiB;
constexpr int CW_ATT = 8192;
constexpr int CW_BAR = 4096;

constexpr int RING_BYTES = 131072;
constexpr int LDS_BYTES = 163840;
constexpr int MISC_OFF = LDS_BYTES - 256;

#define GAS __attribute__((address_space(1)))
#define LAS __attribute__((address_space(3)))
#define DI __device__ __forceinline__
typedef unsigned short bf16;
typedef unsigned v4u __attribute__((ext_vector_type(4)));
typedef unsigned v2u __attribute__((ext_vector_type(2)));
typedef float f32x4 __attribute__((ext_vector_type(4)));
typedef float f32x2 __attribute__((ext_vector_type(2)));
typedef short bf16x8 __attribute__((ext_vector_type(8)));
typedef __bf16 bf16x2_t __attribute__((ext_vector_type(2)));
#define LDS_WAIT() asm volatile("s_waitcnt lgkmcnt(0)" ::: "memory")
#define VM_WAIT() asm volatile("s_waitcnt vmcnt(0)" ::: "memory")
DI unsigned pk2(float lo, float hi) { const f32x2 v = {lo, hi}; const bf16x2_t b = __builtin_convertvector(v, bf16x2_t); return __builtin_bit_cast(unsigned, b); }
DI float bf2f(unsigned short b) { return __uint_as_float((unsigned)b << 16); }
DI float bflo(unsigned w) { return __uint_as_float(w << 16); }
DI float bfhi(unsigned w) { return __uint_as_float(w & 0xffff0000u); }
DI float wave_sum(float v) {
#pragma unroll
    for (int o = 1; o < 64; o <<= 1) v += __shfl_xor(v, o);
    return v;
}
DI float wave_max(float v) {
#pragma unroll
    for (int o = 1; o < 64; o <<= 1) v = fmaxf(v, __shfl_xor(v, o));
    return v;
}
DI float sigmoidf_(float x) { return 1.0f / (1.0f + __expf(-x)); }

DI float quad_sum(float x) {
    const unsigned a = __builtin_bit_cast(unsigned, x); const auto r = __builtin_amdgcn_permlane32_swap(a, a, false, false);
    const float y = __builtin_bit_cast(float, (unsigned)r[0]) + __builtin_bit_cast(float, (unsigned)r[1]);
    const unsigned b = __builtin_bit_cast(unsigned, y); const auto s = __builtin_amdgcn_permlane16_swap(b, b, false, false);
    return __builtin_bit_cast(float, (unsigned)s[0]) + __builtin_bit_cast(float, (unsigned)s[1]);
}
DI float quad_max(float x) {
    const unsigned a = __builtin_bit_cast(unsigned, x); const auto r = __builtin_amdgcn_permlane32_swap(a, a, false, false);
    const float y = fmaxf(__builtin_bit_cast(float, (unsigned)r[0]), __builtin_bit_cast(float, (unsigned)r[1]));
    const unsigned b = __builtin_bit_cast(unsigned, y); const auto s = __builtin_amdgcn_permlane16_swap(b, b, false, false);
    return fmaxf(__builtin_bit_cast(float, (unsigned)s[0]), __builtin_bit_cast(float, (unsigned)s[1]));
}
#define XB_TMO      128
#define XB_XCNT(j)  (256  + 64 * (j))
#define XB_XSUB(j)  (1280 + 64 * (j))
#define XB_XGEN(j)  (2304 + 64 * (j))
#define XB_TOP      3328
#define XB_TOPGEN   3392
#define XCD_BAR_WORDS 3456
#define XB_SPIN_CAP (NAIVE_RWKV ? (1u << 25) : (1u << 20))

__device__ __forceinline__ unsigned xb_ld(unsigned* p)              { return __hip_atomic_load(p, __ATOMIC_RELAXED, __HIP_MEMORY_SCOPE_AGENT); }
__device__ __forceinline__ unsigned xb_add(unsigned* p, unsigned v) { return __hip_atomic_fetch_add(p, v, __ATOMIC_RELAXED, __HIP_MEMORY_SCOPE_AGENT); }
__device__ __forceinline__ unsigned xb_xcc_id() { return (unsigned)__builtin_amdgcn_s_getreg((3 << 11) | 20) & 0xFu; }
#define XB_SPIN(cond, bar) do { unsigned _sp = 0; while (cond) { __builtin_amdgcn_s_sleep(1); \
    if ((++_sp & 255u) == 0u) { if (xb_ld(&(bar)[XB_TMO])) break; if (_sp > XB_SPIN_CAP) { atomicAdd(&(bar)[XB_TMO], 1u); break; } } } } while (0)

struct XcdBarrier {
    unsigned* bar; unsigned x;
    volatile LAS unsigned* st;
};

__device__ __forceinline__ XcdBarrier xcd_barrier_post(unsigned* bar, volatile LAS unsigned* st) {
    XcdBarrier b; b.bar = bar; b.x = xb_xcc_id(); b.st = st;
    if (threadIdx.x == 0) (void)xb_add(&bar[XB_XCNT(b.x)], 1u);
    return b;
}
__device__ __forceinline__ void xcd_barrier_complete(unsigned* bar, unsigned x, unsigned& nloc, unsigned& nx) {
    const unsigned G = gridDim.x * gridDim.y * gridDim.z;
    unsigned sum, cnt, mine, sp = 0u;
    for (;;) {
        sum = 0u; cnt = 0u; mine = 0u;
#pragma unroll
        for (unsigned j = 0; j < 16; ++j) { const unsigned c = xb_ld(&bar[XB_XCNT(j)]); sum += c; cnt += (c > 0u) ? 1u : 0u; mine = (j == x) ? c : mine; }
        if (sum == G) break;
        __builtin_amdgcn_s_sleep(1);
        if ((++sp & 255u) == 0u) { if (xb_ld(&bar[XB_TMO])) break; if (sp > XB_SPIN_CAP) { atomicAdd(&bar[XB_TMO], 1u); break; } }
    }
    nloc = mine > 0u ? mine : 1u; nx = cnt > 0u ? cnt : 1u;
}

__device__ __forceinline__ void xcd_barrier(const XcdBarrier& b) {
    asm volatile("s_waitcnt vmcnt(0)" ::: "memory");
    __syncthreads();
    if (threadIdx.x == 0) {
        unsigned* bar = b.bar;
        __builtin_amdgcn_s_waitcnt(0);
        unsigned nloc = b.st[0], nx = b.st[1];
        if (nloc == 0u) { xcd_barrier_complete(bar, b.x, nloc, nx); b.st[0] = nloc; b.st[1] = nx; }
        const unsigned old = xb_add(&bar[XB_XSUB(b.x)], 1u);
        const unsigned gen = old / nloc;
        if (old + 1u == (gen + 1u) * nloc) {
            __builtin_amdgcn_fence(__ATOMIC_RELEASE, "agent");
            asm volatile("s_waitcnt vmcnt(0)" ::: "memory");
            const unsigned og = xb_add(&bar[XB_TOP], 1u);
            const unsigned tg = og / nx;
            if (og + 1u == (tg + 1u) * nx) xb_add(&bar[XB_TOPGEN], 1u);
            else XB_SPIN(xb_ld(&bar[XB_TOPGEN]) == tg, bar);
            __builtin_amdgcn_fence(__ATOMIC_ACQUIRE, "agent");
            xb_add(&bar[XB_XGEN(b.x)], 1u);
            asm volatile("s_waitcnt vmcnt(0)" ::: "memory");
        } else {
            XB_SPIN(xb_ld(&bar[XB_XGEN(b.x)]) == gen, bar);
            __builtin_amdgcn_fence(__ATOMIC_ACQUIRE, "agent");
            asm volatile("s_waitcnt vmcnt(0)" ::: "memory");
        }
    }
    __syncthreads();
}

struct Args {
    const float* in[25]; float* out; unsigned char* ws; int ph_lo, ph_hi, ph_rep, pad_;
};
enum { I_X = 0, I_N1G, I_WIN, I_MU, I_QG, I_KG, I_RELB, I_W0, I_WDEC, I_A0, I_WAAA, I_WGATE, I_KK, I_KA, I_RK, I_LNG, I_LNB, I_WOUT, I_N2G, I_WR, I_BR, I_WUP, I_BUP, I_WDN, I_BDN };
struct Frame {
    LAS unsigned char* lds;
    int tid, lane, wave, G, bid;
};


struct TrRegs { f32x4 v[8]; f32x4 s0, s1; bf16* dst; int ldo; };
DI void tr_load(TrRegs& t, const float* __restrict__ W, int ldw, int k0, int n0, bf16* WT, int ldo, long drow, int lane, const float* __restrict__ ksc8 = nullptr) {
    const int r8 = lane >> 3, c4 = lane & 7;
    t.s0 = (f32x4){1.f, 1.f, 1.f, 1.f}; t.s1 = t.s0; if (ksc8) { t.s0 = *(const f32x4*)ksc8; t.s1 = *(const f32x4*)(ksc8 + 4); }
    const float* src = W + (size_t)(k0 + 8 * r8) * ldw + n0 + 4 * c4;
#pragma unroll
    for (int i = 0; i < 8; ++i) t.v[i] = __builtin_nontemporal_load((const f32x4*)(src + (size_t)i * ldw));
    t.dst = WT + (size_t)(drow + 4 * c4) * ldo + k0 + 8 * r8; t.ldo = ldo;
}
DI void tr_store(const TrRegs& t, const float* __restrict__ = nullptr) {
    const f32x4 s0 = t.s0, s1 = t.s1;
#pragma unroll
    for (int j = 0; j < 4; ++j) { const v4u o = {pk2(t.v[0][j] * s0[0], t.v[1][j] * s0[1]), pk2(t.v[2][j] * s0[2], t.v[3][j] * s0[3]), pk2(t.v[4][j] * s1[0], t.v[5][j] * s1[1]), pk2(t.v[6][j] * s1[2], t.v[7][j] * s1[3])};
        __builtin_nontemporal_store(o, (v4u*)(t.dst + (size_t)j * t.ldo)); }
}
DI void tr_item(const float* __restrict__ W, int ldw, int k0, int n0, bf16* WT, int ldo, long drow, LAS float* scr, int lane, const float* __restrict__ ksc) {
    (void)scr; TrRegs t; tr_load(t, W, ldw, k0, n0, WT, ldo, drow, lane, ksc ? ksc + k0 + 8 * (lane >> 3) : nullptr); tr_store(t);
}
constexpr int MOE_TR_UP = NEXP * 16 * 64, MOE_TR_DN = NEXP * 16 * 32, MOE_TR_ALL = MOE_TR_UP + MOE_TR_DN;
DI const float* moe_tr_load(TrRegs& t, const Args& a, int r, int lane) {
    unsigned char* ws = a.ws;
    if (r < MOE_TR_UP) { const int e = r / 1024, kb = (r % 1024) / 64, nb = r % 64, n0 = 32 * nb; const int n1 = n0 & 1023;
        const long drow = (long)(n1 / 128) * 256 + (n0 >= 1024 ? 128 : 0) + (n1 % 128);
        tr_load(t, a.in[I_WUP] + (size_t)e * 1024 * 2048, 2048, 64 * kb, n0, (bf16*)(ws + WS_WUP) + (size_t)e * 2048 * 1024, 1024, drow, lane, a.in[I_N2G] + 64 * kb + 8 * (lane >> 3));
        return nullptr; }
    r -= MOE_TR_UP; const int e = r / 512, kb = (r % 512) / 32, nb = r % 32;
    tr_load(t, a.in[I_WDN] + (size_t)e * 1024 * 1024, 1024, 64 * kb, 32 * nb, (bf16*)(ws + WS_WDN) + (size_t)e * 1024 * 1024, 1024, 32 * nb, lane);
    return nullptr;
}
DI void moe_tr_item(const Args& a, int r, LAS float* scr, int lane) { (void)scr; TrRegs t; const float* s = moe_tr_load(t, a, r, lane); tr_store(t, s); }
DI unsigned q_pack4(float a, float b, float c, float d) {
    const unsigned ua = __builtin_bit_cast(unsigned, a), ub = __builtin_bit_cast(unsigned, b), uc = __builtin_bit_cast(unsigned, c), ud = __builtin_bit_cast(unsigned, d);
    return (ua & 0xffu) | ((ub & 0xffu) << 8) | ((uc & 0xffu) << 16) | (ud << 24); }
constexpr float Q_MAGIC = 12582912.0f;
template <bool DOWN>
DI void moe_q_batch(const Args& a, int batch, int wave, int lane, LAS float* exch) {
    unsigned char* ws = a.ws;
    constexpr int LDW = DOWN ? 1024 : 2048, SPE = LDW / 32;
    constexpr float QMAX = DOWN ? 256.0f : 127.0f;
    asm volatile("" : "+v"(lane));
    const int r8 = lane >> 3, c4 = lane & 7;
    const float* gk = a.in[I_N2G] + 128 * wave + 8 * r8;
    const f32x4 one = {1.f, 1.f, 1.f, 1.f};
    f32x4 s0[2], s1[2];
#pragma unroll
    for (int t = 0; t < 2; ++t) { s0[t] = DOWN ? one : *(const f32x4*)(gk + 64 * t); s1[t] = DOWN ? one : *(const f32x4*)(gk + 64 * t + 4); }
    f32x4 v[2][2][8]; const int loff = 8 * r8 * LDW + 4 * c4;
#define MQ_LOAD(buf, s_) do { const int strip_ = batch * 4 + (s_), e_ = strip_ / SPE, n0_ = 32 * (strip_ % SPE); \
        const float* W_ = a.in[DOWN ? I_WDN : I_WUP] + (size_t)e_ * 1024 * LDW + (size_t)(128 * wave) * LDW + n0_;     \
        _Pragma("unroll") for (int t = 0; t < 2; ++t) _Pragma("unroll") for (int i = 0; i < 8; ++i) v[buf][t][i] = __builtin_nontemporal_load((const f32x4*)(W_ + (size_t)(64 * t + i) * LDW + loff)); } while (0)
    MQ_LOAD(0, 0);
#pragma unroll
    for (int s = 0; s < 4; ++s) {
        if (s < 3) MQ_LOAD((s + 1) & 1, s + 1);
        const int strip = batch * 4 + s, e = strip / SPE, n0 = 32 * (strip % SPE), n1 = n0 & 1023;
        const long drow = DOWN ? (long)n0 : (long)(n1 / 128) * 256 + (n0 >= 1024 ? 128 : 0) + (n1 % 128);
        f32x4 mx = {0.f, 0.f, 0.f, 0.f};
#pragma unroll
        for (int t = 0; t < 2; ++t)
#pragma unroll
            for (int i = 0; i < 8; ++i) { const float sc = i < 4 ? s0[t][i] : s1[t][i - 4]; const f32x4 p = v[s & 1][t][i] * sc; v[s & 1][t][i] = p;
#pragma unroll
                for (int j = 0; j < 4; ++j) mx[j] = fmaxf(mx[j], fabsf(p[j])); }
#pragma unroll
        for (int j = 0; j < 4; ++j) { float m = mx[j]; m = fmaxf(m, __shfl_xor(m, 8)); m = fmaxf(m, __shfl_xor(m, 16)); m = fmaxf(m, __shfl_xor(m, 32)); mx[j] = m; }
        LAS float* ex = exch + (s & 1) * 256;
        if (r8 == 0) *(LAS f32x4*)(ex + (wave * 8 + c4) * 4) = mx;
        __syncthreads();
#pragma unroll
        for (int w2 = 0; w2 < 8; ++w2) { const f32x4 o = *(const LAS f32x4*)(ex + (w2 * 8 + c4) * 4);
#pragma unroll
            for (int j = 0; j < 4; ++j) mx[j] = fmaxf(mx[j], o[j]); }
        if (wave == 0 && r8 == 0) *(f32x4*)((float*)(ws + (DOWN ? WS_COLSC2 : WS_COLSC)) + (size_t)e * LDW + n0 + 4 * c4) = mx * (1.0f / QMAX);
        f32x4 inv;
#pragma unroll
        for (int j = 0; j < 4; ++j) inv[j] = mx[j] > 0.f ? QMAX / mx[j] : 0.f;
        unsigned char* dst = ws + (DOWN ? WS_WDN : WS_WUP) + ((size_t)e * LDW + drow + 4 * c4) * 1024 + 128 * wave + 8 * r8;
#pragma unroll
        for (int t = 0; t < 2; ++t) {
            f32x4 (&p)[8] = v[s & 1][t];
#pragma unroll
            for (int i = 0; i < 8; ++i) p[i] = DOWN ? p[i] * inv : p[i] * inv + Q_MAGIC;
#pragma unroll
            for (int j = 0; j < 4; ++j) { v2u o;
                if (DOWN) { o.x = (unsigned)__builtin_amdgcn_cvt_pk_fp8_f32(p[2][j], p[3][j], __builtin_amdgcn_cvt_pk_fp8_f32(p[0][j], p[1][j], 0, false), true);
                            o.y = (unsigned)__builtin_amdgcn_cvt_pk_fp8_f32(p[6][j], p[7][j], __builtin_amdgcn_cvt_pk_fp8_f32(p[4][j], p[5][j], 0, false), true); }
                else { o.x = q_pack4(p[0][j], p[1][j], p[2][j], p[3][j]); o.y = q_pack4(p[4][j], p[5][j], p[6][j], p[7][j]); }
                __builtin_nontemporal_store(o, (v2u*)(dst + (size_t)j * 1024 + 64 * t)); } }
    }
#undef MQ_LOAD
}
DI void q_strip_i8_wg(const float* __restrict__ Wsrc, int ldw, int n0, unsigned char* WT, float* colsc, int wave, int lane, LAS float* exch) {
    const int r8 = lane >> 3, c4 = lane & 7;
    const float* W = Wsrc + (size_t)(128 * wave + 8 * r8) * ldw + n0 + 4 * c4;
    f32x4 v[2][8], mx = {0.f, 0.f, 0.f, 0.f};
#pragma unroll
    for (int t = 0; t < 2; ++t)
#pragma unroll
        for (int i = 0; i < 8; ++i) v[t][i] = *(const f32x4*)(W + (size_t)(64 * t + i) * ldw);
#pragma unroll
    for (int t = 0; t < 2; ++t)
#pragma unroll
        for (int i = 0; i < 8; ++i)
#pragma unroll
            for (int j = 0; j < 4; ++j) mx[j] = fmaxf(mx[j], fabsf(v[t][i][j]));
#pragma unroll
    for (int j = 0; j < 4; ++j) { float m = mx[j]; m = fmaxf(m, __shfl_xor(m, 8)); m = fmaxf(m, __shfl_xor(m, 16)); m = fmaxf(m, __shfl_xor(m, 32)); mx[j] = m; }
    if (r8 == 0) *(LAS f32x4*)(exch + (wave * 8 + c4) * 4) = mx;
    __syncthreads();
#pragma unroll
    for (int w2 = 0; w2 < 8; ++w2) { const f32x4 o = *(const LAS f32x4*)(exch + (w2 * 8 + c4) * 4);
#pragma unroll
        for (int j = 0; j < 4; ++j) mx[j] = fmaxf(mx[j], o[j]); }
    if (wave == 0 && r8 == 0) *(f32x4*)(colsc + n0 + 4 * c4) = mx * (1.0f / 127.0f);
    f32x4 inv;
#pragma unroll
    for (int j = 0; j < 4; ++j) inv[j] = mx[j] > 0.f ? 127.0f / mx[j] : 0.f;
    unsigned char* dst = WT + (size_t)(n0 + 4 * c4) * 1024 + 128 * wave + 8 * r8;
#pragma unroll
    for (int t = 0; t < 2; ++t) {
        f32x4 p[8];
#pragma unroll
        for (int i = 0; i < 8; ++i) p[i] = v[t][i] * inv + Q_MAGIC;
#pragma unroll
        for (int j = 0; j < 4; ++j) { const v2u o = {q_pack4(p[0][j], p[1][j], p[2][j], p[3][j]), q_pack4(p[4][j], p[5][j], p[6][j], p[7][j])};
            *(v2u*)(dst + (size_t)j * 1024 + 64 * t) = o; } }
}
DI void moe_tr_batch(const Args& a, int batch, int wave, int lane, LAS float* exch) {
    if (batch < MOE_TR_UP / 64) moe_q_batch<false>(a, batch, wave, lane, exch); else moe_q_batch<true>(a, batch - MOE_TR_UP / 64, wave, lane, exch);
}
constexpr int MOE_TR_BATCHES = MOE_TR_ALL / 64, MOE_TR_EARLY = 256;

#if !NAIVE_ATT
constexpr int ATT_KS = 144;
constexpr int ATT_TILE = 64 * ATT_KS;
constexpr int ATT_BIAS_OFF = 4 * ATT_TILE;
constexpr int ATT_QC = 4;
constexpr int ATT_NSLOT = (NBATCH * 8 * (NCHUNK / ATT_QC) / 4) * 7;
static_assert(NBATCH * 8 * (NCHUNK / ATT_QC) == 1024 && MOE_TR_ALL == 256 * 3 * 64, "attention / conversion work queue");
DI int att_pos(int key) { return (key & 32) + 8 * ((key >> 2) & 3) + 4 * ((key >> 4) & 1) + (key & 3); }
DI void attn_phase(const Frame& F, const Args& a, const int qid = 0) {
    const bf16* proj = (const bf16*)(a.ws + WS_PROJ); bf16* mix = (bf16*)(a.ws + WS_MIX);
    LAS unsigned char* lds = F.lds; LAS float* sbias = (LAS float*)(lds + ATT_BIAS_OFF);
    const int w = F.wave;
    const float LOG2E = 1.4426950408889634f;
    const int srow = F.tid >> 3, spc = F.tid & 7;
    float kgv[8];
#pragma unroll
    for (int j = 0; j < 8; ++j) kgv[j] = a.in[I_KG][8 * spc + j];
    const int spos = att_pos(srow);
    LAS int* s_item = (LAS int*)(lds + ATT_BIAS_OFF + 1024);
    unsigned* qhead = (unsigned*)(a.ws + WS_CTL) + CW_ATT + 64 * qid;
    int nxt_slot = 0;
#define ATT_CLAIM() do { const int one_ = 1, zo_ = 0; asm volatile("global_atomic_add %0, %1, %2, %3 sc0" : "=&v"(nxt_slot) : "v"(zo_), "v"(one_), "s"(qhead) : "memory"); } while (0)
    if (F.tid == 0) ATT_CLAIM();
    for (;;) {
        __syncthreads();
        if (F.tid == 0) { asm volatile("s_waitcnt vmcnt(0)" : "+v"(nxt_slot) :: "memory"); *s_item = nxt_slot; }
        __syncthreads();
        const int slot = *s_item;
        if (slot >= ATT_NSLOT) break;
        if (F.tid == 0) ATT_CLAIM();
        const int grp = slot / 7, sub = slot % 7;
        if (sub >= 4) { moe_tr_batch(a, grp * 3 + (sub - 4), w, F.lane, (LAS float*)(lds + ATT_BIAS_OFF + 2048));
            continue; }
        int l = F.lane; asm volatile("" : "+v"(l));
        const int n16 = l & 15, q = l >> 4;
        const int item = grp * 4 + sub;
        const int b = item / (8 * (NCHUNK / ATT_QC)), h = (item / (NCHUNK / ATT_QC)) & 7, n0 = ATT_QC * (item % (NCHUNK / ATT_QC));
        if (F.tid < 192) sbias[F.tid] = a.in[I_RELB][h * 192 + F.tid] * LOG2E;
        const int nq = n0 + (w >> 1);
        int qpos[2]; size_t qtok[2]; bf16x8 qf[2][2];
#pragma unroll
        for (int u = 0; u < 2; ++u) { qpos[u] = 16 * (2 * (w & 1) + u) + n16; qtok[u] = (size_t)b * SEQ + nq * 64 + qpos[u];
          const v4u q0 = *(const v4u*)(proj + qtok[u] * INC + h * 64 + 8 * q), q1 = *(const v4u*)(proj + qtok[u] * INC + h * 64 + 32 + 8 * q);
          float f[16]; const unsigned ww[8] = {q0.x, q0.y, q0.z, q0.w, q1.x, q1.y, q1.z, q1.w};
          float ss = 0.f;
#pragma unroll
          for (int e = 0; e < 8; ++e) { f[2 * e] = bflo(ww[e]); f[2 * e + 1] = bfhi(ww[e]); ss += f[2 * e] * f[2 * e] + f[2 * e + 1] * f[2 * e + 1]; }
          ss = quad_sum(ss);
          const float rs = __builtin_amdgcn_rsqf(ss * (1.f / 64.f) + 1e-6f) * (0.125f * LOG2E);
          unsigned pk[8];
#pragma unroll
          for (int e = 0; e < 8; ++e) { const int d = (e < 4 ? 0 : 32) + 8 * q + 2 * (e & 3); pk[e] = pk2(f[2 * e] * rs * a.in[I_QG][d], f[2 * e + 1] * rs * a.in[I_QG][d + 1]); }
          const v4u p0 = {pk[0], pk[1], pk[2], pk[3]}, p1 = {pk[4], pk[5], pk[6], pk[7]};
          qf[u][0] = __builtin_bit_cast(bf16x8, p0); qf[u][1] = __builtin_bit_cast(bf16x8, p1); }
        f32x4 o[2][4];
#pragma unroll
        for (int u = 0; u < 2; ++u)
#pragma unroll
            for (int dt = 0; dt < 4; ++dt) o[u][dt] = (f32x4){0.f, 0.f, 0.f, 0.f};
        float m_run[2] = {-3.0e38f, -3.0e38f}, l_run[2] = {0.f, 0.f};
        constexpr int NKC = 8 + ATT_QC;
        v4u kreg, vreg;
        auto gload = [&](int jc) { const int kc = n0 - 8 + jc; if (kc >= 0) { const size_t tok = (size_t)b * SEQ + kc * 64 + srow;
            kreg = *(const v4u*)(proj + tok * INC + 512 + h * 64 + 8 * spc); vreg = *(const v4u*)(proj + tok * INC + 1024 + h * 64 + 8 * spc); } };
        auto lstore = [&](int jc) { const int kc = n0 - 8 + jc; if (kc >= 0) { LAS unsigned char* kb = lds + (jc & 1) * 2 * ATT_TILE; LAS unsigned char* vb = kb + ATT_TILE;
            const unsigned ww[4] = {kreg.x, kreg.y, kreg.z, kreg.w}; float f[8]; float ss = 0.f;
#pragma unroll
            for (int e = 0; e < 4; ++e) { f[2 * e] = bflo(ww[e]); f[2 * e + 1] = bfhi(ww[e]); ss += f[2 * e] * f[2 * e] + f[2 * e + 1] * f[2 * e + 1]; }
            ss += __builtin_bit_cast(float, __builtin_amdgcn_update_dpp(0, __builtin_bit_cast(int, ss), 0xB1, 0xf, 0xf, true));
            ss += __builtin_bit_cast(float, __builtin_amdgcn_update_dpp(0, __builtin_bit_cast(int, ss), 0x4E, 0xf, 0xf, true));
            ss += __builtin_bit_cast(float, __builtin_amdgcn_update_dpp(0, __builtin_bit_cast(int, ss), 0x141, 0xf, 0xf, true));
            const float rs = __builtin_amdgcn_rsqf(ss * (1.f / 64.f) + 1e-6f);
            v4u kk; kk.x = pk2(f[0] * rs * kgv[0], f[1] * rs * kgv[1]); kk.y = pk2(f[2] * rs * kgv[2], f[3] * rs * kgv[3]); kk.z = pk2(f[4] * rs * kgv[4], f[5] * rs * kgv[5]); kk.w = pk2(f[6] * rs * kgv[6], f[7] * rs * kgv[7]);
            *(LAS v4u*)(kb + srow * ATT_KS + 16 * spc) = kk;
            const unsigned vv[4] = {vreg.x, vreg.y, vreg.z, vreg.w};
#pragma unroll
            for (int e = 0; e < 4; ++e) { *(LAS unsigned short*)(vb + (8 * spc + 2 * e) * ATT_KS + 2 * spos) = (unsigned short)(vv[e] & 0xffffu);
                                          *(LAS unsigned short*)(vb + (8 * spc + 2 * e + 1) * ATT_KS + 2 * spos) = (unsigned short)(vv[e] >> 16); } } };
        gload(0); lstore(0);
        __syncthreads();
        for (int jc = 0; jc < NKC; ++jc) {
            if (jc + 1 < NKC) gload(jc + 1);
            const int kc = n0 - 8 + jc, dj = jc - (w >> 1);
            if (kc >= 0 && dj >= 0 && dj <= 8) {
                const LAS unsigned char* kb = lds + (jc & 1) * 2 * ATT_TILE; const LAS unsigned char* vb = kb + ATT_TILE;
                f32x4 sc[2][4];
#pragma unroll
                for (int mt = 0; mt < 4; ++mt) { sc[0][mt] = (f32x4){0.f, 0.f, 0.f, 0.f}; sc[1][mt] = sc[0][mt];
#pragma unroll
                    for (int ks = 0; ks < 2; ++ks) { const bf16x8 kf = *(const LAS bf16x8*)(kb + (16 * mt + n16) * ATT_KS + 64 * ks + 16 * q);
                        sc[0][mt] = __builtin_amdgcn_mfma_f32_16x16x32_bf16(kf, qf[0][ks], sc[0][mt], 0, 0, 0);
                        sc[1][mt] = __builtin_amdgcn_mfma_f32_16x16x32_bf16(kf, qf[1][ks], sc[1][mt], 0, 0, 0); } }
                float boff = 0.f;
                if (dj <= 5) boff = sbias[0];
                else {
#pragma unroll
                    for (int u = 0; u < 2; ++u) { const int base = (dj - 8) * 64 - qpos[u] + 128;
#pragma unroll
                        for (int mt = 0; mt < 4; ++mt)
#pragma unroll
                            for (int i = 0; i < 4; ++i) { int idx = base + 16 * mt + 4 * q + i; idx = idx < 0 ? 0 : idx; const float bv_ = sbias[idx];
                                sc[u][mt][i] += bv_; } } }
                bf16x8 pf[2][2];
#pragma unroll
                for (int u = 0; u < 2; ++u) {
                    float mx = sc[u][0][0];
#pragma unroll
                    for (int mt = 0; mt < 4; ++mt)
#pragma unroll
                        for (int i = 0; i < 4; ++i) mx = fmaxf(mx, sc[u][mt][i]);
                    mx = quad_max(mx);
                    const float m_new = fmaxf(m_run[u], mx + boff), alpha = __builtin_amdgcn_exp2f(m_run[u] - m_new), msub = m_new - boff;
                    const bool moved = __builtin_amdgcn_ballot_w64(m_new != m_run[u]) != 0ull;
                    m_run[u] = m_new; float ls = 0.f;
#pragma unroll
                    for (int mt = 0; mt < 4; ++mt)
#pragma unroll
                        for (int i = 0; i < 4; ++i) { sc[u][mt][i] = __builtin_amdgcn_exp2f(sc[u][mt][i] - msub); ls += sc[u][mt][i]; }
                    if (moved) { l_run[u] *= alpha;
#pragma unroll
                        for (int dt = 0; dt < 4; ++dt) o[u][dt] = o[u][dt] * alpha; }
                    l_run[u] += ls;
#pragma unroll
                    for (int s = 0; s < 2; ++s) {
                        const v4u pp = {pk2(sc[u][2 * s][0], sc[u][2 * s][1]), pk2(sc[u][2 * s][2], sc[u][2 * s][3]), pk2(sc[u][2 * s + 1][0], sc[u][2 * s + 1][1]), pk2(sc[u][2 * s + 1][2], sc[u][2 * s + 1][3])};
                        pf[u][s] = __builtin_bit_cast(bf16x8, pp); } }
#pragma unroll
                for (int s = 0; s < 2; ++s)
#pragma unroll
                    for (int dt = 0; dt < 4; ++dt) { const bf16x8 vf = *(const LAS bf16x8*)(vb + (16 * dt + n16) * ATT_KS + 64 * s + 16 * q);
                        o[0][dt] = __builtin_amdgcn_mfma_f32_16x16x32_bf16(vf, pf[0][s], o[0][dt], 0, 0, 0);
                        o[1][dt] = __builtin_amdgcn_mfma_f32_16x16x32_bf16(vf, pf[1][s], o[1][dt], 0, 0, 0); }
            }
            if (jc + 1 < NKC) lstore(jc + 1);
            __syncthreads();
        }
#pragma unroll
        for (int u = 0; u < 2; ++u) {
            const float lr = quad_sum(l_run[u]);
            const float inv = __builtin_amdgcn_rcpf(lr);
#pragma unroll
            for (int dt = 0; dt < 4; ++dt) { v2u ov; ov.x = pk2(o[u][dt][0] * inv, o[u][dt][1] * inv); ov.y = pk2(o[u][dt][2] * inv, o[u][dt][3] * inv);
                *(v2u*)(mix + qtok[u] * 1024 + h * 64 + 16 * dt + 4 * q) = ov; } }
    }
}
#endif

#if !NAIVE_RWKV
constexpr int RA_HALF = 80896;
constexpr int RA_RT = 0, RA_KT = 9216, RA_BT = 18432, RA_AT = 27648;
constexpr int RA_VT = 36864, RA_KH = 46080, RA_BH = 55296;
constexpr int RA_AAB = 64512;
constexpr int RA_XWD = 0, RA_XAD = 9216, RA_XGD = 18432;
constexpr int RA_RHS2 = 0, RA_GEND = 17408;
constexpr int RA_W1T = 18432, RA_W2T = 27648;
constexpr int RA_WT = RA_AAB;
constexpr int RB_REC = 65536, RB_YLT = 0, RB_PCT = 8192, RB_G1T = 16384, RB_E2T = 24576, RB_MC = 32768, RB_CC = 40960, RB_SC = 57344;
static_assert(2 * RA_HALF <= MISC_OFF, "rwkv phase A LDS");

DI void ld8f(const bf16* p, float (&f)[8]) { const v4u w = *(const v4u*)p; f[0] = bflo(w.x); f[1] = bfhi(w.x); f[2] = bflo(w.y); f[3] = bfhi(w.y); f[4] = bflo(w.z); f[5] = bfhi(w.z); f[6] = bflo(w.w); f[7] = bfhi(w.w); }
DI void ld4f(const bf16* p, float (&f)[4]) { const v2u w = *(const v2u*)p; f[0] = bflo(w.x); f[1] = bfhi(w.x); f[2] = bflo(w.y); f[3] = bfhi(w.y); }
DI bf16x8 pack8(const f32x4& a, const f32x4& b) { const v4u p = {pk2(a[0], a[1]), pk2(a[2], a[3]), pk2(b[0], b[1]), pk2(b[2], b[3])}; return __builtin_bit_cast(bf16x8, p); }
DI float fast_sigmoid(float x) { return __builtin_amdgcn_rcpf(1.0f + __builtin_amdgcn_exp2f(-1.4426950408889634f * x)); }
DI float fast_tanh(float x) { return 1.0f - 2.0f * __builtin_amdgcn_rcpf(1.0f + __builtin_amdgcn_exp2f(2.8853900817779268f * x)); }
#define MFMA16(a, b, c) __builtin_amdgcn_mfma_f32_16x16x32_bf16((a), (b), (c), 0, 0, 0)

DI void rwkv_phase_a(const Frame& F, const Args& a) {
    unsigned char* ws = a.ws; unsigned char* rb = ws + WS_RW;
    const bf16* wdec = (const bf16*)(ws + WS_WDEC); const bf16* waaa = (const bf16*)(ws + WS_WAAA); const bf16* wgate = (const bf16*)(ws + WS_WGATE);
    const float* mu = a.in[I_MU]; const float* par = (const float*)(ws + WS_PAR);
    const int hb = F.wave >> 2, w4 = F.wave & 3;
    LAS unsigned char* hbase = F.lds + hb * RA_HALF;
    const float LOG2E = 1.4426950408889634f;
    v4u s0c[4];
#define RA_REQUEST(pair_) do { const int item_ = 2 * (pair_) + hb, c_ = (item_ >> 3) & 127, b_ = item_ >> 10; const size_t tok0_ = (size_t)b_ * SEQ + c_ * 64; \
        int lq_ = F.lane; asm volatile("" : "+v"(lq_)); size_t wsq_ = (size_t)ws; asm volatile("" : "+s"(wsq_)); const int t9q_ = (hb << 8) | (w4 << 6) | lq_; \
        const bf16* cur_ = (const bf16*)(wsq_ + WS_PROJ) + (tok0_ + (t9q_ >> 3)) * INC + PRW + 1536 + 32 * (t9q_ & 7); \
        _Pragma("unroll") for (int g8 = 0; g8 < 4; ++g8) s0c[g8] = *(const v4u*)(cur_ + 8 * g8); } while (0)
    if (F.bid < NITEM / 2) RA_REQUEST(F.bid);
    for (int pair = F.bid; pair < NITEM / 2; pair += F.G) {
        size_t wsb = (size_t)ws; asm volatile("" : "+s"(wsb)); const bf16* proj = (const bf16*)(wsb + WS_PROJ);
        int l = F.lane; asm volatile("" : "+v"(l));
        const int n16 = l & 15, q = l >> 4, t4 = (hb << 8 | (F.wave & 3) << 6 | l) & 255;
        const int tokl = 16 * w4 + n16;
        const int tslot = (tokl & 32) + 8 * ((tokl >> 2) & 3) + 4 * ((tokl >> 4) & 1) + (tokl & 3);
        const int item = 2 * pair + hb, h = item & 7, c = (item >> 3) & 127, b = item >> 10;
        const size_t tok0 = (size_t)b * SEQ + c * 64; unsigned char* rbi = rb + (size_t)item * RB_REC;
        const int t9 = (hb << 8) | t4, tk0 = t9 >> 3, part = t9 & 7;
        v4u s0p[4];
        { const bool first = (c == 0 && tk0 == 0); const bf16* prv = proj + (tok0 + tk0) * INC + PRW + 1536 + 32 * part - INC;
#pragma unroll
          for (int g8 = 0; g8 < 4; ++g8) { s0p[g8] = (v4u){0u, 0u, 0u, 0u}; if (!first) s0p[g8] = *(const v4u*)(prv + 8 * g8); } }
        v2u rawc[3][4], rawp[3][4];
        { const bool first = (c == 0 && tokl == 0); const bf16* cur = proj + (tok0 + tokl) * INC + PRW + h * 64 + 4 * q; const bf16* prv = cur - INC;
#pragma unroll
          for (int m = 0; m < 3; ++m)
#pragma unroll
              for (int ct = 0; ct < 4; ++ct) { rawc[m][ct] = *(const v2u*)(cur + 512 * m + 16 * ct); rawp[m][ct] = (v2u){0u, 0u}; if (!first) rawp[m][ct] = *(const v2u*)(prv + 512 * m + 16 * ct); } }
        bf16x8 wfr[2][8];
#define RA_WLOAD(dst, ctv) do { const int row_ = h * 64 + 16 * (ctv) + n16; \
            dst[0] = *(const bf16x8*)(wdec + row_ * 64 + 8 * q); dst[1] = *(const bf16x8*)(wdec + row_ * 64 + 32 + 8 * q); \
            dst[2] = *(const bf16x8*)(waaa + row_ * 64 + 8 * q); dst[3] = *(const bf16x8*)(waaa + row_ * 64 + 32 + 8 * q); \
            _Pragma("unroll") for (int ks_ = 0; ks_ < 4; ++ks_) dst[4 + ks_] = *(const bf16x8*)(wgate + row_ * 128 + 32 * ks_ + 8 * q); } while (0)
        RA_WLOAD(wfr[0], 0); RA_WLOAD(wfr[1], 1);
        __syncthreads();
        { const float esc = part < 2 ? 2.8853900817779268f : -1.4426950408889634f;
          LAS unsigned char* dst = F.lds + (part < 2 ? RA_XWD + tk0 * 144 + part * 64 : (part < 4 ? RA_XAD + tk0 * 144 + (part - 2) * 64 : RA_XGD + tk0 * 272 + (part - 4) * 64));
#pragma unroll
          for (int g8 = 0; g8 < 4; ++g8) {
              const unsigned xw[4] = {s0c[g8].x, s0c[g8].y, s0c[g8].z, s0c[g8].w}, pw[4] = {s0p[g8].x, s0p[g8].y, s0p[g8].z, s0p[g8].w};
              const f32x4 m0 = *(const f32x4*)(mu + 1536 + 32 * part + 8 * g8), m1 = *(const f32x4*)(mu + 1536 + 32 * part + 8 * g8 + 4);
              float y[8];
#pragma unroll
              for (int j = 0; j < 8; ++j) { const float x = (j & 1) ? bfhi(xw[j >> 1]) : bflo(xw[j >> 1]), p = (j & 1) ? bfhi(pw[j >> 1]) : bflo(pw[j >> 1]);
                  const float xs = x + (p - x) * (j < 4 ? m0[j & 3] : m1[j & 3]);
                  const float rc = __builtin_amdgcn_rcpf(1.0f + __builtin_amdgcn_exp2f(esc * xs));
                  y[j] = part < 2 ? 1.0f - 2.0f * rc : (part < 4 ? xs : rc); }
              const v4u o = {pk2(y[0], y[1]), pk2(y[2], y[3]), pk2(y[4], y[5]), pk2(y[6], y[7])};
              *(LAS v4u*)(dst + 16 * g8) = o; } }
        v2u shv[3][4];
#pragma unroll
        for (int m = 0; m < 3; ++m)
#pragma unroll
            for (int ct = 0; ct < 4; ++ct) { const v2u xw = rawc[m][ct], pw = rawp[m][ct];
                const f32x4 mm = *(const f32x4*)(mu + 512 * m + h * 64 + 16 * ct + 4 * q);
                const float x0 = bflo(xw.x), x1 = bfhi(xw.x), x2 = bflo(xw.y), x3 = bfhi(xw.y);
                shv[m][ct].x = pk2(x0 + (bflo(pw.x) - x0) * mm[0], x1 + (bfhi(pw.x) - x1) * mm[1]); shv[m][ct].y = pk2(x2 + (bflo(pw.y) - x2) * mm[2], x3 + (bfhi(pw.y) - x3) * mm[3]); }
        __syncthreads();
        f32x4 awl[4], aal[4], ag[4];
        { bf16x8 bwd[2], bad[2], bgd[4], wf2[2][8];
          RA_WLOAD(wf2[0], 2); RA_WLOAD(wf2[1], 3);
#pragma unroll
          for (int ks = 0; ks < 2; ++ks) { bwd[ks] = *(const LAS bf16x8*)(F.lds + RA_XWD + tokl * 144 + 64 * ks + 16 * q); bad[ks] = *(const LAS bf16x8*)(F.lds + RA_XAD + tokl * 144 + 64 * ks + 16 * q); }
#pragma unroll
          for (int ks = 0; ks < 4; ++ks) bgd[ks] = *(const LAS bf16x8*)(F.lds + RA_XGD + tokl * 272 + 64 * ks + 16 * q);
#pragma unroll
          for (int ct = 0; ct < 4; ++ct) { const bf16x8* wv = ct < 2 ? wfr[ct] : wf2[ct - 2];
              awl[ct] = (f32x4){0.f, 0.f, 0.f, 0.f}; aal[ct] = awl[ct]; ag[ct] = awl[ct];
#pragma unroll
              for (int ks = 0; ks < 2; ++ks) { awl[ct] = MFMA16(wv[ks], bwd[ks], awl[ct]); aal[ct] = MFMA16(wv[2 + ks], bad[ks], aal[ct]); }
#pragma unroll
              for (int ks = 0; ks < 4; ++ks) ag[ct] = MFMA16(wv[4 + ks], bgd[ks], ag[ct]); } }
#undef RA_WLOAD
        v2u rtp[4];
        {
#define RA_SHIFT(dst, pcol, ctv) do { const v2u w_ = shv[(pcol) / 512][ctv]; dst[0] = bflo(w_.x); dst[1] = bfhi(w_.x); dst[2] = bflo(w_.y); dst[3] = bfhi(w_.y); } while (0)
          float nrm = 0.f, bd = 0.f;
#pragma unroll
          for (int ct = 0; ct < 4; ++ct) { const int ch = h * 64 + 16 * ct + 4 * q;
              float r4[4], k4[4]; RA_SHIFT(r4, 0, ct); RA_SHIFT(k4, 512, ct);
              const f32x4 a0v = *(const f32x4*)(par + 512 + ch), kkv = *(const f32x4*)(par + 1024 + ch), kav = *(const f32x4*)(par + 1536 + ch), rkv = *(const f32x4*)(par + 2048 + ch);
#pragma unroll
              for (int i = 0; i < 4; ++i) { const float av = fast_sigmoid(a0v[i] + aal[ct][i]); const float kk = k4[i] * kkv[i]; nrm += kk * kk;
                  bd += r4[i] * (k4[i] * (1.0f + (av - 1.0f) * kav[i])) * rkv[i]; } }
          nrm = quad_sum(nrm); bd = quad_sum(bd);
          const float kinv = 1.0f / fmaxf(sqrtf(nrm), 1e-12f);
          float lw[4][4], lg[4][4], lgend[4][4];
#pragma unroll
          for (int ct = 0; ct < 4; ++ct) { const f32x4 w0v = *(const f32x4*)(par + h * 64 + 16 * ct + 4 * q);
#pragma unroll
              for (int i = 0; i < 4; ++i) { lw[ct][i] = (-0.6065306597126334f * LOG2E) * fast_sigmoid(w0v[i] + awl[ct][i]); float x = lw[ct][i];
                  x += __builtin_bit_cast(float, __builtin_amdgcn_update_dpp(0, __builtin_bit_cast(int, x), 0x111, 0xf, 0xf, false));
                  x += __builtin_bit_cast(float, __builtin_amdgcn_update_dpp(0, __builtin_bit_cast(int, x), 0x112, 0xf, 0xf, false));
                  x += __builtin_bit_cast(float, __builtin_amdgcn_update_dpp(0, __builtin_bit_cast(int, x), 0x114, 0xf, 0xf, false));
                  x += __builtin_bit_cast(float, __builtin_amdgcn_update_dpp(0, __builtin_bit_cast(int, x), 0x118, 0xf, 0xf, false));
                  lg[ct][i] = x; } }
          LAS float* wt = (LAS float*)(hbase + RA_WT);
          if (n16 == 15) {
#pragma unroll
              for (int ct = 0; ct < 4; ++ct) *(LAS f32x4*)(wt + w4 * 64 + 16 * ct + 4 * q) = (f32x4){lg[ct][0], lg[ct][1], lg[ct][2], lg[ct][3]}; }
          __syncthreads();
#pragma unroll
          for (int ct = 0; ct < 4; ++ct) { f32x4 off = {0.f, 0.f, 0.f, 0.f}, tot = {0.f, 0.f, 0.f, 0.f};
#pragma unroll
              for (int w = 0; w < 4; ++w) { const f32x4 t = *(const LAS f32x4*)(wt + w * 64 + 16 * ct + 4 * q); tot = tot + t; if (w < w4) off = off + t; }
#pragma unroll
              for (int i = 0; i < 4; ++i) { lg[ct][i] += off[i]; lgend[ct][i] = tot[i]; } }
#pragma unroll
          for (int ct = 0; ct < 4; ++ct) { const int ch = h * 64 + 16 * ct + 4 * q;
              float r4[4], k4[4], v4[4]; RA_SHIFT(r4, 0, ct); RA_SHIFT(k4, 512, ct); RA_SHIFT(v4, 1024, ct);
              const f32x4 a0v = *(const f32x4*)(par + 512 + ch), kkv = *(const f32x4*)(par + 1024 + ch), kav = *(const f32x4*)(par + 1536 + ch);
              const f32x4 lg_ = *(const f32x4*)(par + 2560 + ch), lb_ = *(const f32x4*)(par + 3072 + ch);
              float rtl[4], ktl[4], btl[4], atl[4], khh[4], bhh[4], g1[4], e2[4];
#pragma unroll
              for (int i = 0; i < 4; ++i) {
                  const float av = fast_sigmoid(a0v[i] + aal[ct][i]); const float k2 = k4[i] * (1.0f + (av - 1.0f) * kav[i]);
                  const float kkn = k4[i] * kkv[i] * kinv, bb = kkn * av;
                  const float gam = __builtin_amdgcn_exp2f(lg[ct][i]), gpv = __builtin_amdgcn_exp2f(lg[ct][i] - lw[ct][i]), gin = __builtin_amdgcn_exp2f(-lg[ct][i]), ger = __builtin_amdgcn_exp2f(lgend[ct][i] - lg[ct][i]);
                  rtl[i] = r4[i] * gam; ktl[i] = k2 * gin; btl[i] = bb * gin; atl[i] = -kkn * gpv; khh[i] = k2 * ger; bhh[i] = bb * ger;
                  const float g = ag[ct][i]; g1[i] = lg_[i] * g; e2[i] = (lb_[i] + bd * v4[i]) * g;
              }
              const int fo = ((w4 * 4 + ct) * 64 + l) * 8;
              v2u o; o.x = pk2(g1[0], g1[1]); o.y = pk2(g1[2], g1[3]); __builtin_nontemporal_store(o, (v2u*)(rbi + RB_G1T + fo));
              o.x = pk2(e2[0], e2[1]); o.y = pk2(e2[2], e2[3]); __builtin_nontemporal_store(o, (v2u*)(rbi + RB_E2T + fo));
              const int co = tokl * 144 + (16 * ct + 4 * q) * 2;
              o.x = pk2(rtl[0], rtl[1]); o.y = pk2(rtl[2], rtl[3]); *(LAS v2u*)(hbase + RA_RT + co) = o; rtp[ct] = o;
              o.x = pk2(ktl[0], ktl[1]); o.y = pk2(ktl[2], ktl[3]); *(LAS v2u*)(hbase + RA_KT + co) = o;
              o.x = pk2(btl[0], btl[1]); o.y = pk2(btl[2], btl[3]); *(LAS v2u*)(hbase + RA_BT + co) = o;
              o.x = pk2(atl[0], atl[1]); o.y = pk2(atl[2], atl[3]); *(LAS v2u*)(hbase + RA_AT + co) = o;
#pragma unroll
              for (int i = 0; i < 4; ++i) { const int ro = (16 * ct + 4 * q + i) * 144 + 2 * tslot;
                  if (tokl == 0) *(LAS float*)(hbase + RA_VT + (16 * ct + 4 * q + i) * 144 + 128) = __builtin_amdgcn_exp2f(lgend[ct][i]);
                  *(LAS unsigned short*)(hbase + RA_VT + ro) = (unsigned short)(pk2(v4[i], 0.f) & 0xffffu);
                  *(LAS unsigned short*)(hbase + RA_KH + ro) = (unsigned short)(pk2(khh[i], 0.f) & 0xffffu);
                  *(LAS unsigned short*)(hbase + RA_BH + ro) = (unsigned short)(pk2(bhh[i], 0.f) & 0xffffu); }
              asm volatile("" ::: "memory");
          }
#undef RA_SHIFT
        }
        __syncthreads();
        bf16x8 akp[2], rkp[2], rbp[2];
        { bf16x8 fa[2], fr[2];
#pragma unroll
          for (int ks = 0; ks < 2; ++ks) { fa[ks] = *(const LAS bf16x8*)(hbase + RA_AT + tokl * 144 + 64 * ks + 16 * q); fr[ks] = *(const LAS bf16x8*)(hbase + RA_RT + tokl * 144 + 64 * ks + 16 * q); }
          f32x4 aak[4], arkk[4], arb[4];
#pragma unroll
          for (int jt = 0; jt < 4; ++jt) {
              f32x4 tab = {0.f, 0.f, 0.f, 0.f}; aak[jt] = tab; arkk[jt] = tab; arb[jt] = tab;
              if (jt <= w4) {
#pragma unroll
                  for (int ks = 0; ks < 2; ++ks) { const bf16x8 fk = *(const LAS bf16x8*)(hbase + RA_KT + (16 * jt + n16) * 144 + 64 * ks + 16 * q), fb = *(const LAS bf16x8*)(hbase + RA_BT + (16 * jt + n16) * 144 + 64 * ks + 16 * q);
                      aak[jt] = MFMA16(fk, fa[ks], aak[jt]); tab = MFMA16(fb, fa[ks], tab); arkk[jt] = MFMA16(fk, fr[ks], arkk[jt]); arb[jt] = MFMA16(fb, fr[ks], arb[jt]); }
                  if (jt == w4) {
#pragma unroll
                      for (int i = 0; i < 4; ++i) { const int j = 4 * q + i; if (j >= n16) { aak[jt][i] = 0.f; tab[i] = 0.f; } if (j > n16) { arkk[jt][i] = 0.f; arb[jt][i] = 0.f; } } }
                  *(LAS f32x4*)(hbase + RA_AAB + tokl * 256 + (16 * jt + 4 * q) * 4) = tab;
              }
          }
#pragma unroll
          for (int s = 0; s < 2; ++s) { akp[s] = pack8(aak[2 * s], aak[2 * s + 1]); rkp[s] = pack8(arkk[2 * s], arkk[2 * s + 1]); rbp[s] = pack8(arb[2 * s], arb[2 * s + 1]); } }
        { f32x4 akv[4];
#pragma unroll
          for (int vt = 0; vt < 4; ++vt) { akv[vt] = (f32x4){0.f, 0.f, 0.f, 0.f};
#pragma unroll
              for (int s = 0; s < 2; ++s) { const bf16x8 fv = *(const LAS bf16x8*)(hbase + RA_VT + (16 * vt + n16) * 144 + 64 * s + 16 * q); akv[vt] = MFMA16(akp[s], fv, akv[vt]); } }
          __syncthreads();
#pragma unroll
          for (int vt = 0; vt < 4; ++vt) *(LAS f32x4*)(hbase + RA_RHS2 + (16 * vt + n16) * 272 + (16 * w4 + 4 * q) * 4) = akv[vt]; }
        if (pair + F.G < NITEM / 2) RA_REQUEST(pair + F.G);
        { const LAS unsigned char* aab = hbase + RA_AAB + (16 * w4) * 256 + (16 * w4) * 4;
          LAS unsigned char* ti = hbase + RA_BT;
          if (q == 0) { float t[16];
#pragma unroll
              for (int r_ = 0; r_ < 16; ++r_) { float acc = (r_ == n16) ? 1.0f : 0.0f;
#pragma unroll
                  for (int j4 = 0; j4 < (r_ + 3) / 4; ++j4) { const f32x4 av = *(const LAS f32x4*)(aab + r_ * 256 + j4 * 16);
#pragma unroll
                      for (int e = 0; e < 4; ++e) if (4 * j4 + e < r_) acc += av[e] * t[4 * j4 + e]; }
                  t[r_] = acc; *(LAS unsigned short*)(ti + w4 * 512 + r_ * 32 + 2 * n16) = (unsigned short)(pk2(acc, 0.f) & 0xffffu); } }
          __syncthreads();
          bf16x8 a10, a20, a30, a31, tf[4];
          { const LAS unsigned char* ab = hbase + RA_AAB + n16 * 256 + 16 * q; const f32x4 z4 = {0.f, 0.f, 0.f, 0.f};
            const f32x4 l10 = *(const LAS f32x4*)(ab + 16 * 256), l20 = *(const LAS f32x4*)(ab + 32 * 256), l21 = *(const LAS f32x4*)(ab + 32 * 256 + 64);
            const f32x4 l30 = *(const LAS f32x4*)(ab + 48 * 256), l31 = *(const LAS f32x4*)(ab + 48 * 256 + 64), l32 = *(const LAS f32x4*)(ab + 48 * 256 + 128);
            a10 = pack8(l10, z4); a20 = pack8(l20, l21); a30 = pack8(l30, l31); a31 = pack8(l32, z4);
#pragma unroll
            for (int I = 0; I < 4; ++I) { const v2u tw = *(const LAS v2u*)(ti + I * 512 + n16 * 32 + 8 * q); const v4u t4 = {tw.x, tw.y, 0u, 0u}; tf[I] = __builtin_bit_cast(bf16x8, t4); } }
          v4u xw[2][2];
#pragma unroll
          for (int m = 0; m < 2; ++m) {
              v4u x0 = {0u, 0u, 0u, 0u}, x1 = {0u, 0u, 0u, 0u};
#pragma unroll
              for (int I = 0; I < 4; ++I) {
                  f32x4 z;
                  if (m == 0) {
#pragma unroll
                      for (int i = 0; i < 4; ++i) z[i] = bf2f(*(const LAS unsigned short*)(hbase + RA_AT + (16 * I + 4 * q + i) * 144 + 2 * tokl)); }
                  else z = *(const LAS f32x4*)(hbase + RA_RHS2 + tokl * 272 + (16 * I + 4 * q) * 4);
                  if (I == 1) z = MFMA16(a10, __builtin_bit_cast(bf16x8, x0), z);
                  if (I == 2) z = MFMA16(a20, __builtin_bit_cast(bf16x8, x0), z);
                  if (I == 3) { z = MFMA16(a30, __builtin_bit_cast(bf16x8, x0), z); z = MFMA16(a31, __builtin_bit_cast(bf16x8, x1), z); }
                  const v4u zb = {pk2(z[0], z[1]), pk2(z[2], z[3]), 0u, 0u};
                  const f32x4 x = MFMA16(tf[I], __builtin_bit_cast(bf16x8, zb), ((f32x4){0.f, 0.f, 0.f, 0.f}));
                  const unsigned p0 = pk2(x[0], x[1]), p1 = pk2(x[2], x[3]);
                  if (I == 0) { x0.x = p0; x0.y = p1; } if (I == 1) { x0.z = p0; x0.w = p1; } if (I == 2) { x1.x = p0; x1.y = p1; } if (I == 3) { x1.z = p0; x1.w = p1; }
              }
              xw[m][0] = x0; xw[m][1] = x1;
          }
          __syncthreads();
#pragma unroll
          for (int s = 0; s < 2; ++s) { *(LAS v4u*)(hbase + RA_W1T + tokl * 144 + 64 * s + 16 * q) = xw[0][s]; *(LAS v4u*)(hbase + RA_W2T + tokl * 144 + 64 * s + 16 * q) = xw[1][s]; }
        }
        __syncthreads();
        {
          f32x4 pc[4], y0[4];
#pragma unroll
          for (int t = 0; t < 4; ++t) { pc[t] = (f32x4){bflo(rtp[t].x), bfhi(rtp[t].x), bflo(rtp[t].y), bfhi(rtp[t].y)}; y0[t] = (f32x4){0.f, 0.f, 0.f, 0.f};
#pragma unroll
              for (int s = 0; s < 2; ++s) { y0[t] = MFMA16(*(const LAS bf16x8*)(hbase + RA_VT + (16 * t + n16) * 144 + 64 * s + 16 * q), rkp[s], y0[t]);
                                            y0[t] = MFMA16(*(const LAS bf16x8*)(hbase + RA_W2T + (16 * t + n16) * 144 + 64 * s + 16 * q), rbp[s], y0[t]);
                                            pc[t] = MFMA16(*(const LAS bf16x8*)(hbase + RA_W1T + (16 * t + n16) * 144 + 64 * s + 16 * q), rbp[s], pc[t]); } }
#pragma unroll
          for (int vt = 0; vt < 4; ++vt) { v2u o; o.x = pk2(y0[vt][0], y0[vt][1]); o.y = pk2(y0[vt][2], y0[vt][3]); __builtin_nontemporal_store(o, (v2u*)(rbi + RB_YLT + ((w4 * 4 + vt) * 64 + l) * 8)); }
#pragma unroll
          for (int s = 0; s < 2; ++s) __builtin_nontemporal_store(pack8(pc[2 * s], pc[2 * s + 1]), (bf16x8*)(rbi + RB_PCT + ((w4 * 2 + s) * 64 + l) * 16));
          f32x4 mc[4]; bf16x8 fb[2], fvv[2];
#pragma unroll
          for (int s = 0; s < 2; ++s) { fb[s] = *(const LAS bf16x8*)(hbase + RA_BH + tokl * 144 + 64 * s + 16 * q); fvv[s] = *(const LAS bf16x8*)(hbase + RA_VT + tokl * 144 + 64 * s + 16 * q); }
          const float gend_k = *(const LAS float*)(hbase + RA_VT + tokl * 144 + 128);
#pragma unroll
          for (int t = 0; t < 4; ++t) { mc[t] = (f32x4){0.f, 0.f, 0.f, 0.f};
#pragma unroll
              for (int s = 0; s < 2; ++s) mc[t] = MFMA16(*(const LAS bf16x8*)(hbase + RA_W1T + (16 * t + n16) * 144 + 64 * s + 16 * q), fb[s], mc[t]);
              if (t == w4) {
#pragma unroll
                  for (int i = 0; i < 4; ++i) if (4 * q + i == n16) mc[t][i] += gend_k; } }
#pragma unroll
          for (int s = 0; s < 2; ++s) __builtin_nontemporal_store(pack8(mc[2 * s], mc[2 * s + 1]), (bf16x8*)(rbi + RB_MC + ((w4 * 2 + s) * 64 + l) * 16));
          bf16x8 fw2[2];
#pragma unroll
          for (int s = 0; s < 2; ++s) fw2[s] = *(const LAS bf16x8*)(hbase + RA_W2T + tokl * 144 + 64 * s + 16 * q);
#pragma unroll
          for (int kt = 0; kt < 4; ++kt) { f32x4 cc = {0.f, 0.f, 0.f, 0.f};
#pragma unroll
              for (int s = 0; s < 2; ++s) { cc = MFMA16(*(const LAS bf16x8*)(hbase + RA_KH + (16 * kt + n16) * 144 + 64 * s + 16 * q), fvv[s], cc);
                                            cc = MFMA16(*(const LAS bf16x8*)(hbase + RA_BH + (16 * kt + n16) * 144 + 64 * s + 16 * q), fw2[s], cc); }
              v2u cw; cw.x = pk2(cc[0], cc[1]); cw.y = pk2(cc[2], cc[3]); __builtin_nontemporal_store(cw, (v2u*)(rbi + RB_CC + ((w4 * 4 + kt) * 64 + l) * 8)); } }
    }
}

constexpr int RBK_NS = 9, RBK_D = 8, RBK_SLOT = 16384, RBK_BLOCKS = 32;
static_assert(RBK_NS * RBK_SLOT <= MISC_OFF && RBK_D == RBK_NS - 1, "phase B ring");
DI void rwkv_phase_b(const Frame& F, const Args& a) {
    if (F.bid >= RBK_BLOCKS) return;
    unsigned char* rb = a.ws + WS_RW; const int l = F.lane, w = F.wave;
    const int h = F.bid & 7, b = F.bid >> 3;
    LAS unsigned char* lds = F.lds;
    if (w >= 4) {
        const int j = w - 4;
#define RBK_ISSUE(cc_) do { const int c_ = (cc_) < NCHUNK ? (cc_) : NCHUNK - 1; const unsigned char* r_ = rb + (size_t)(((b * 128 + c_) << 3) + h) * RB_REC; \
            LAS unsigned char* slot_ = lds + ((cc_) % RBK_NS) * RBK_SLOT; \
            _Pragma("unroll") for (int k_ = 0; k_ < 4; ++k_) { const int blk_ = 4 * j + k_; \
                const unsigned char* src_ = blk_ < 8 ? r_ + RB_MC + blk_ * 1024 : r_ + RB_CC + (blk_ - 8) * 1024; \
                __builtin_amdgcn_global_load_lds((const unsigned*)(src_ + l * 16), (LAS unsigned*)(slot_ + blk_ * 1024), 16, 0, 0); } } while (0)
        for (int c = 0; c < RBK_D; ++c) RBK_ISSUE(c);
        for (int c = 0; c < NCHUNK; ++c) {
            asm volatile("s_waitcnt vmcnt(28)" ::: "memory");
            __builtin_amdgcn_s_barrier();
            RBK_ISSUE(c + RBK_D);
        }
        asm volatile("s_waitcnt vmcnt(0)" ::: "memory");
        __builtin_amdgcn_s_barrier();
#undef RBK_ISSUE
    } else {
        const int vs = w;
        f32x4 st[4];
#pragma unroll
        for (int kt = 0; kt < 4; ++kt) st[kt] = (f32x4){0.f, 0.f, 0.f, 0.f};
        for (int c = 0; c < NCHUNK; ++c) {
            unsigned char* rbi = rb + (size_t)(((b * 128 + c) << 3) + h) * RB_REC;
            bf16x8 sb[2];
#pragma unroll
            for (int s = 0; s < 2; ++s) { sb[s] = pack8(st[2 * s], st[2 * s + 1]); *(bf16x8*)(rbi + RB_SC + ((vs * 2 + s) * 64 + l) * 16) = sb[s]; }
            __builtin_amdgcn_s_barrier();
            const LAS unsigned char* slot = lds + (c % RBK_NS) * RBK_SLOT;
#pragma unroll
            for (int kt = 0; kt < 4; ++kt) { const v2u cw = *(const LAS v2u*)(slot + 8192 + ((vs * 4 + kt) * 64 + l) * 8);
                f32x4 n = {bflo(cw.x), bfhi(cw.x), bflo(cw.y), bfhi(cw.y)};
#pragma unroll
                for (int s = 0; s < 2; ++s) n = MFMA16(*(const LAS bf16x8*)(slot + ((kt * 2 + s) * 64 + l) * 16), sb[s], n);
                st[kt] = n; }
        }
        __builtin_amdgcn_s_barrier();
    }
}

struct RcOps { bf16x8 pc[2]; v2u yl[4]; bf16x8 sc[4][2]; v2u g1[4], e2[4]; };
DI void rc_load(RcOps& o, const unsigned char* rb, int task, int l) {
    const int item = task >> 2, it = task & 3; const unsigned char* rbi = rb + (size_t)item * RB_REC;
#pragma unroll
    for (int s = 0; s < 2; ++s) o.pc[s] = __builtin_nontemporal_load((const bf16x8*)(rbi + RB_PCT + ((it * 2 + s) * 64 + l) * 16));
#pragma unroll
    for (int vt = 0; vt < 4; ++vt) { const int fo = ((it * 4 + vt) * 64 + l) * 8;
        o.yl[vt] = __builtin_nontemporal_load((const v2u*)(rbi + RB_YLT + fo)); o.g1[vt] = __builtin_nontemporal_load((const v2u*)(rbi + RB_G1T + fo)); o.e2[vt] = __builtin_nontemporal_load((const v2u*)(rbi + RB_E2T + fo));
#pragma unroll
        for (int s = 0; s < 2; ++s) o.sc[vt][s] = __builtin_nontemporal_load((const bf16x8*)(rbi + RB_SC + ((vt * 2 + s) * 64 + l) * 16)); }
}
DI void rwkv_phase_c(const Frame& F, const Args& a) {
    const unsigned char* rb = a.ws + WS_RW; bf16* mix = (bf16*)(a.ws + WS_MIX);
    const int l = F.lane, n16 = l & 15, q = l >> 4;
    const int gw = F.bid * NWAVES + F.wave, NGW = F.G * NWAVES;
    RcOps cur, nxt;
    if (gw < NITEM * 4) rc_load(cur, rb, gw, l);
    for (int task = gw; task < NITEM * 4; task += NGW) {
        const int item = task >> 2, it = task & 3, h = item & 7, c = (item >> 3) & 127, b = item >> 10;
        if (task + NGW < NITEM * 4) rc_load(nxt, rb, task + NGW, l);
        f32x4 y[4]; float sum = 0.f;
#pragma unroll
        for (int vt = 0; vt < 4; ++vt) { y[vt] = (f32x4){bflo(cur.yl[vt].x), bfhi(cur.yl[vt].x), bflo(cur.yl[vt].y), bfhi(cur.yl[vt].y)};
#pragma unroll
            for (int s = 0; s < 2; ++s) y[vt] = MFMA16(cur.sc[vt][s], cur.pc[s], y[vt]);
            sum += (y[vt][0] + y[vt][1]) + (y[vt][2] + y[vt][3]); }
        sum = quad_sum(sum);
        const float mean = sum * (1.f / 64.f); float sq = 0.f;
#pragma unroll
        for (int vt = 0; vt < 4; ++vt) { y[vt] = y[vt] - mean; sq += (y[vt][0] * y[vt][0] + y[vt][1] * y[vt][1]) + (y[vt][2] * y[vt][2] + y[vt][3] * y[vt][3]); }
        sq = quad_sum(sq);
        const float rstd = 1.0f / sqrtf(sq * (1.f / 64.f) + 64e-5f);
        const size_t tok = (size_t)b * SEQ + c * 64 + 16 * it + n16;
#pragma unroll
        for (int vt = 0; vt < 4; ++vt) { const v2u g = cur.g1[vt], e = cur.e2[vt];
            v2u o; o.x = pk2(y[vt][0] * rstd * bflo(g.x) + bflo(e.x), y[vt][1] * rstd * bfhi(g.x) + bfhi(e.x)); o.y = pk2(y[vt][2] * rstd * bflo(g.y) + bflo(e.y), y[vt][3] * rstd * bfhi(g.y) + bfhi(e.y));
            *(v2u*)(mix + tok * 1024 + 512 + h * 64 + 16 * vt + 4 * q) = o; }
        cur = nxt;
    }
}
#endif

DI void p0_prologue(const Frame& F, const Args& a) {
    unsigned char* ws = a.ws;
    LAS float* scr = (LAS float*)(F.lds + F.wave * 16384);
    const int gw = F.bid * NWAVES + F.wave, NGW = F.G * NWAVES;
    constexpr int I_IN = 0, I_OUT = 16 * 32, I_DEC = 16, I_AAA = 16, I_GATE = 32;
    constexpr int NITEMS = I_IN + I_OUT + I_DEC + I_AAA + I_GATE;
    for (int s = F.G - 1 - F.bid; s < INC / 32; s += F.G) { q_strip_i8_wg(a.in[I_WIN], INC, 32 * s, ws + WS_WIN, (float*)(ws + WS_COLSC1), F.wave, F.lane, (LAS float*)F.lds); __syncthreads(); }
    for (int it = gw; it < NITEMS; it += NGW) {
        int r = it;
        if (r < I_OUT) { const int kb = r / 32, nb = r % 32; tr_item(a.in[I_WOUT], 1024, 64 * kb, 32 * nb, (bf16*)(ws + WS_WOUT), 1024, 32 * nb, scr, F.lane, nullptr); continue; } r -= I_OUT;
        if (r < I_DEC) { tr_item(a.in[I_WDEC], 512, 0, 32 * r, (bf16*)(ws + WS_WDEC), 64, 32 * r, scr, F.lane, nullptr); continue; } r -= I_DEC;
        if (r < I_AAA) { tr_item(a.in[I_WAAA], 512, 0, 32 * r, (bf16*)(ws + WS_WAAA), 64, 32 * r, scr, F.lane, nullptr); continue; } r -= I_AAA;
        { const int kb = r / 16, nb = r % 16; tr_item(a.in[I_WGATE], 512, 64 * kb, 32 * nb, (bf16*)(ws + WS_WGATE), 128, 32 * nb, scr, F.lane, nullptr); }
    }
    { float* wrt = (float*)(ws + WS_WRT); const float* wr = a.in[I_WR]; const float* g2 = a.in[I_N2G];
      for (int i = F.bid * 512 + F.tid; i < 32 * 1024; i += F.G * 512) { const int e = i >> 10, k = i & 1023; wrt[i] = g2[k] * wr[k * 32 + e]; } }
    { float* par = (float*)(ws + WS_PAR); const int srcs[7] = {I_W0, I_A0, I_KK, I_KA, I_RK, I_LNG, I_LNB};
      for (int i = F.bid * 512 + F.tid; i < 7 * 512; i += F.G * 512) { const int k = i >> 9; float v = 0.f;
#pragma unroll
          for (int j = 0; j < 7; ++j) if (k == j) v = a.in[srcs[j]][i & 511];
          par[i] = v; } }
    { const float* x = a.in[I_X]; const float* g1 = a.in[I_N1G]; bf16* xn = (bf16*)(ws + WS_XN);
      f32x4 gv[4];
#pragma unroll
      for (int j = 0; j < 4; ++j) gv[j] = *((const f32x4*)g1 + F.lane + 64 * j);
      for (int m0 = 2 * gw; m0 < T; m0 += 2 * NGW) {
          f32x4 v[2][4];
#pragma unroll
          for (int r = 0; r < 2; ++r) { const f32x4* xr = (const f32x4*)(x + (size_t)(m0 + r) * D) + F.lane;
#pragma unroll
              for (int j = 0; j < 4; ++j) v[r][j] = __builtin_nontemporal_load(xr + 64 * j); }
#pragma unroll
          for (int r = 0; r < 2; ++r) { float s = 0.f;
#pragma unroll
              for (int j = 0; j < 4; ++j) s += (v[r][j].x * v[r][j].x + v[r][j].y * v[r][j].y) + (v[r][j].z * v[r][j].z + v[r][j].w * v[r][j].w);
              const float rs = 1.0f / sqrtf(wave_sum(s) * (1.f / D) + 1e-6f);
              f32x4 y[4]; float am = 0.f;
#pragma unroll
              for (int j = 0; j < 4; ++j) { y[j] = (v[r][j] * rs) * gv[j]; am = fmaxf(fmaxf(am, fmaxf(fabsf(y[j].x), fabsf(y[j].y))), fmaxf(fabsf(y[j].z), fabsf(y[j].w))); }
              am = wave_max(am); const float qi = am > 0.f ? 127.0f / am : 0.f;
              if (F.lane == 0) ((float*)(ws + WS_XNSC))[m0 + r] = am * (1.0f / 127.0f);
              unsigned* o4 = (unsigned*)((unsigned char*)xn + (size_t)(m0 + r) * D) + F.lane;
#pragma unroll
              for (int j = 0; j < 4; ++j) { const f32x4 qv = y[j] * qi + Q_MAGIC; o4[64 * j] = q_pack4(qv.x, qv.y, qv.z, qv.w); } }
      } }
}

#if NAIVE_RWKV
DI void rwkv_naive_prep(const Frame& F, const Args& a) {
    const bf16* proj = (const bf16*)(a.ws + WS_PROJ); LAS float* sx = (LAS float*)F.lds;
    float* RW = (float*)(a.ws + WS_RW); float* GG = (float*)(a.ws + WS_XN);
    const float* mu = a.in[I_MU]; const int c = F.tid;
    for (int t = F.bid; t < T; t += F.G) {
        const bool first = (t % SEQ) == 0; const bf16* cur = proj + (size_t)t * INC + PRW; const bf16* prv = cur - INC;
#define SH_(col) ({ const float x_ = bf2f(cur[col]); const float p_ = first ? 0.f : bf2f(prv[col]); x_ + (p_ - x_) * mu[col]; })
        if (c < 256) { const float v = SH_(1536 + c); sx[c] = c < 64 ? tanhf(v) : (c < 128 ? v : sigmoidf_(v)); }
        __syncthreads();
        const float r = SH_(c), k = SH_(512 + c), v = SH_(1024 + c);
#undef SH_
        float wl = a.in[I_W0][c], al = a.in[I_A0][c], g = 0.f;
        const float* wdec = a.in[I_WDEC] + c; const float* waaa = a.in[I_WAAA] + c; const float* wgate = a.in[I_WGATE] + c;
#pragma unroll 4
        for (int j = 0; j < 64; ++j) { wl += sx[j] * wdec[j * 512]; al += sx[64 + j] * waaa[j * 512]; }
#pragma unroll 4
        for (int j = 0; j < 128; ++j) g += sx[128 + j] * wgate[j * 512];
        const float dec = __expf(-0.6065306597126334f * sigmoidf_(wl)), av = sigmoidf_(al);
        float kk = k * a.in[I_KK][c]; const float n2 = wave_sum(kk * kk); kk = kk / fmaxf(sqrtf(n2), 1e-12f);
        const float k2 = k * (1.0f + (av - 1.0f) * a.in[I_KA][c]);
        const size_t o = (size_t)t * 512 + c; const size_t S1 = (size_t)T * 512;
        RW[o] = r; RW[S1 + o] = dec; RW[2 * S1 + o] = k2; RW[3 * S1 + o] = v; RW[4 * S1 + o] = kk; RW[5 * S1 + o] = av; GG[o] = g;
        __syncthreads();
    }
}
DI void rwkv_naive_scan(const Frame& F, const Args& a) {
    if (F.bid >= 32 || F.wave != 0) return;
    const int b = F.bid >> 3, h = F.bid & 7, l = F.lane, c = h * 64 + l;
    const float* RW = (const float*)(a.ws + WS_RW); const float* GG = (const float*)(a.ws + WS_XN); bf16* mix = (bf16*)(a.ws + WS_MIX);
    const size_t S1 = (size_t)T * 512; LAS float* sh = (LAS float*)F.lds;
    LAS float* st = sh + 512 + l;
    for (int k = 0; k < 64; ++k) st[64 * k] = 0.f;
    const float rk = a.in[I_RK][c], lg = a.in[I_LNG][c], lb = a.in[I_LNB][c];
    for (int s = 0; s < SEQ; ++s) {
        const size_t o = (size_t)(b * SEQ + s) * 512 + c;
        const float r = RW[o], w = RW[S1 + o], k2 = RW[2 * S1 + o], v = RW[3 * S1 + o], kk = RW[4 * S1 + o], av = RW[5 * S1 + o], g = GG[o];
        sh[l] = r; sh[64 + l] = w; sh[128 + l] = k2; sh[192 + l] = kk; sh[256 + l] = kk * av;
        LDS_WAIT();
        float sa = 0.f;
#pragma unroll 8
        for (int k = 0; k < 64; ++k) sa -= st[64 * k] * sh[192 + k];
        float y = 0.f;
#pragma unroll 8
        for (int k = 0; k < 64; ++k) { const float nv = st[64 * k] * sh[64 + k] + sa * sh[256 + k] + v * sh[128 + k]; st[64 * k] = nv; y += nv * sh[k]; }
        LDS_WAIT();
        const float mean = wave_sum(y) * (1.f / 64.f); const float d = y - mean; const float var = wave_sum(d * d) * (1.f / 64.f);
        const float yn = d * (1.0f / sqrtf(var + 64e-5f));
        const float bonus = wave_sum(r * k2 * rk) * v;
        const float outv = (yn * lg + lb + bonus) * g;
        mix[(size_t)(b * SEQ + s) * 1024 + 512 + c] = (bf16)(pk2(outv, 0.f) & 0xffffu);
    }
}
#endif
#if NAIVE_ATT
DI void attn_naive(const Frame& F, const Args& a) {
    const bf16* proj = (const bf16*)(a.ws + WS_PROJ); bf16* mix = (bf16*)(a.ws + WS_MIX);
    LAS float* sq = (LAS float*)(F.lds + F.wave * 1024);
    const int gw = F.bid * NWAVES + F.wave, NGW = F.G * NWAVES, l = F.lane;
    const float qg = a.in[I_QG][l];
    for (int it = gw; it < T * 8; it += NGW) {
        const int t = it >> 3, h = it & 7, b = t / SEQ, s = t % SEQ, n = s >> 6;
        const float qd = bf2f(proj[(size_t)t * INC + h * 64 + l]);
        const float qn = qd * (1.0f / sqrtf(wave_sum(qd * qd) * (1.f / 64.f) + 1e-6f)) * qg * 0.125f;
        sq[l] = qn; LDS_WAIT();
        float sc[9]; float mx = -3.0e38f;
#pragma unroll
        for (int r = 0; r < 9; ++r) {
            const int kp = (n - 8) * 64 + 64 * r + l; float v = -3.0e38f;
            if (kp >= 0) {
                const v4u* kr = (const v4u*)(proj + (size_t)(b * SEQ + kp) * INC + 512 + h * 64);
                float ss = 0.f, dot = 0.f;
#pragma unroll
                for (int j = 0; j < 8; ++j) { const v4u w = kr[j]; const unsigned ww[4] = {w.x, w.y, w.z, w.w};
#pragma unroll
                    for (int e = 0; e < 4; ++e) { const float k0 = bflo(ww[e]), k1 = bfhi(ww[e]); const int d0 = 8 * j + 2 * e;
                        ss += k0 * k0 + k1 * k1; dot += sq[d0] * a.in[I_KG][d0] * k0 + sq[d0 + 1] * a.in[I_KG][d0 + 1] * k1; } }
                int rel = kp - s; rel = rel < -128 ? -128 : (rel > 63 ? 63 : rel);
                v = dot * (1.0f / sqrtf(ss * (1.f / 64.f) + 1e-6f)) + a.in[I_RELB][h * 192 + rel + 128];
            }
            sc[r] = v; mx = fmaxf(mx, v);
        }
        mx = wave_max(mx); float sum = 0.f;
#pragma unroll
        for (int r = 0; r < 9; ++r) { sc[r] = (sc[r] > -1.0e38f) ? __expf(sc[r] - mx) : 0.f; sum += sc[r]; }
        sum = wave_sum(sum);
        float o = 0.f;
#pragma unroll
        for (int r = 0; r < 9; ++r) {
            const int kp0 = (n - 8) * 64 + 64 * r;
            if (kp0 >= 0) {
                const bf16* vp = proj + (size_t)(b * SEQ + kp0) * INC + 1024 + h * 64 + l;
                for (int key = 0; key < 64; ++key) o += __shfl(sc[r], key) * bf2f(vp[(size_t)key * INC]);
            }
        }
        mix[(size_t)t * 1024 + h * 64 + l] = (bf16)(pk2(o / sum, 0.f) & 0xffffu);
        LDS_WAIT();
    }
}
#endif

DI void p6_router(const Frame& F, const Args& a) {
    unsigned char* ws = a.ws; const bf16* x1 = (const bf16*)(ws + WS_XN); const float* wrt = (const float*)(ws + WS_WRT); const float* br = a.in[I_BR];
    int* eidx = (int*)(ws + WS_EIDX); float* gate = (float*)(ws + WS_GATE); int* lrank = (int*)(ws + WS_LRANK); float* rstd = (float*)(ws + WS_RSTD); int* cnt = (int*)(ws + WS_CNT);
    constexpr int WROW = 2064, WIMG = 32 * WROW;
    LAS int* hist = (LAS int*)(F.lds + 2 * WIMG);
    const int n = F.lane & 15, q = F.lane >> 4;
    for (int i = F.tid; i < 32 * 256; i += NWAVES * 64) { const int e = i >> 8, c4 = i & 255; const f32x4 w = *((const f32x4*)(wrt + (size_t)e * D) + c4);
        v2u hi, lo; hi.x = pk2(w[0], w[1]); hi.y = pk2(w[2], w[3]);
        lo.x = pk2(w[0] - bflo(hi.x), w[1] - bfhi(hi.x)); lo.y = pk2(w[2] - bflo(hi.y), w[3] - bfhi(hi.y));
        *(LAS v2u*)(F.lds + e * WROW + c4 * 8) = hi; *(LAS v2u*)(F.lds + WIMG + e * WROW + c4 * 8) = lo; }
    __syncthreads();
    for (int tile = F.bid; tile < T / 128; tile += F.G) {
        if (F.tid < 32) hist[F.tid] = 0;
        __syncthreads();
        const int tok = tile * 128 + F.wave * 16 + n;
        const v4u* xr = (const v4u*)(x1 + (size_t)tok * D) + q; const LAS unsigned char* w0 = F.lds + n * WROW + 16 * q;
        f32x4 acc0 = {0.f, 0.f, 0.f, 0.f}, acc1 = {0.f, 0.f, 0.f, 0.f}; float ssq = 0.f, amax = 0.f;
        for (int S0 = 0; S0 < 32; S0 += 16) {
            v4u xw[16];
#pragma unroll
            for (int s = 0; s < 16; ++s) xw[s] = xr[4 * (S0 + s)];
#pragma unroll
            for (int s = 0; s < 16; ++s) { const bf16x8 xb8 = __builtin_bit_cast(bf16x8, xw[s]); const LAS unsigned char* wp = w0 + (S0 + s) * 64;
                const unsigned u[4] = {xw[s].x, xw[s].y, xw[s].z, xw[s].w};
#pragma unroll
                for (int j = 0; j < 4; ++j) { const float a = bflo(u[j]), b = bfhi(u[j]); ssq += a * a + b * b; amax = fmaxf(amax, fmaxf(fabsf(a), fabsf(b))); }
                acc0 = __builtin_amdgcn_mfma_f32_16x16x32_bf16(*(const LAS bf16x8*)(wp), xb8, acc0, 0, 0, 0);
                acc0 = __builtin_amdgcn_mfma_f32_16x16x32_bf16(*(const LAS bf16x8*)(wp + WIMG), xb8, acc0, 0, 0, 0);
                acc1 = __builtin_amdgcn_mfma_f32_16x16x32_bf16(*(const LAS bf16x8*)(wp + 16 * WROW), xb8, acc1, 0, 0, 0);
                acc1 = __builtin_amdgcn_mfma_f32_16x16x32_bf16(*(const LAS bf16x8*)(wp + WIMG + 16 * WROW), xb8, acc1, 0, 0, 0); }
        }
        ssq = quad_sum(ssq); amax = quad_max(amax);
        const float rs = 1.0f / sqrtf(ssq * (1.f / D) + 1e-6f);
        float lg[8];
#pragma unroll
        for (int i = 0; i < 4; ++i) { lg[i] = acc0[i] * rs + br[4 * q + i]; lg[4 + i] = acc1[i] * rs + br[16 + 4 * q + i]; }
        float tv[4]; int ti[4];
#pragma unroll
        for (int r = 0; r < 4; ++r) {
            float bv = -3.0e38f; int bi = 0;
#pragma unroll
            for (int j = 0; j < 8; ++j) { const int e = (j < 4 ? 0 : 16) + 4 * q + (j & 3); if (lg[j] > bv) { bv = lg[j]; bi = e; } }
#pragma unroll
            for (int o = 16; o <= 32; o <<= 1) { const float ov = __shfl_xor(bv, o); const int oi = __shfl_xor(bi, o); if (ov > bv || (ov == bv && oi < bi)) { bv = ov; bi = oi; } }
            tv[r] = bv; ti[r] = bi;
#pragma unroll
            for (int j = 0; j < 8; ++j) { const int e = (j < 4 ? 0 : 16) + 4 * q + (j & 3); if (e == bi) lg[j] = -3.0e38f; }
        }
        if (q == 0) {
            const float e1 = __expf(tv[1] - tv[0]), e2 = __expf(tv[2] - tv[0]), e3 = __expf(tv[3] - tv[0]); const float inv = 1.0f / (1.0f + e1 + e2 + e3);
            int lr[4];
#pragma unroll
            for (int r = 0; r < 4; ++r) lr[r] = atomicAdd((int*)&hist[ti[r]], 1);
            *(int4*)(eidx + (size_t)tok * 4) = make_int4(ti[0], ti[1], ti[2], ti[3]);
            *(float4*)(gate + (size_t)tok * 4) = make_float4(inv, e1 * inv, e2 * inv, e3 * inv);
            *(int4*)(lrank + (size_t)tok * 4) = make_int4(lr[0], lr[1], lr[2], lr[3]);
            rstd[tok] = rs * amax * (1.0f / 127.0f);
        }
        { const float qinv = amax > 0.f ? 127.0f / amax : 0.f; unsigned char* xq = ws + WS_XQ;
            for (int i0 = 0; i0 < 16; i0 += 4) { v4u xa[4], xb2[4];
#pragma unroll
                for (int i = 0; i < 4; ++i) { const v4u* p = (const v4u*)(x1 + (size_t)(tile * 128 + F.wave * 16 + i0 + i) * D) + 2 * F.lane; xa[i] = p[0]; xb2[i] = p[1]; }
#pragma unroll
                for (int i = 0; i < 4; ++i) { const float sc = __builtin_bit_cast(float, __builtin_amdgcn_readlane(__builtin_bit_cast(int, qinv), i0 + i));
                    const unsigned u[8] = {xa[i].x, xa[i].y, xa[i].z, xa[i].w, xb2[i].x, xb2[i].y, xb2[i].z, xb2[i].w}; v4u o;
#pragma unroll
                    for (int d = 0; d < 4; ++d) { const f32x2 lo = {bflo(u[2 * d]), bfhi(u[2 * d])}, hi = {bflo(u[2 * d + 1]), bfhi(u[2 * d + 1])};
                        const f32x2 ql = lo * sc + Q_MAGIC, qh = hi * sc + Q_MAGIC; o[d] = q_pack4(ql.x, ql.y, qh.x, qh.y); }
                    *((v4u*)(xq + (size_t)(tile * 128 + F.wave * 16 + i0 + i) * D) + F.lane) = o; } }
        }
        __syncthreads();
        if (F.tid < 32) cnt[tile * 32 + F.tid] = hist[F.tid];
        __syncthreads();
    }
}

DI void p7_permute(const Frame& F, const Args& a) {
    unsigned char* ws = a.ws; const int* cnt = (const int*)(ws + WS_CNT); int* meta = (int*)(ws + WS_META);
    const int* eidx = (const int*)(ws + WS_EIDX); const int* lrank = (const int*)(ws + WS_LRANK); int* inv = (int*)(ws + WS_INV);
    const float* rstd = (const float*)(ws + WS_RSTD); float* rowrstd = (float*)(ws + WS_ROWRSTD);
    bf16* xb = (bf16*)(ws + WS_XN); int* rowtok = (int*)(ws + WS_ROWTOK);
    LAS int* s_tot = (LAS int*)F.lds; LAS int* s_pst = s_tot + 32; LAS int* s_base = s_tot + 64; LAS int* s_part = s_tot + 128;
    { const int e = F.tid & 31, part = F.tid >> 5; int s = 0; for (int t = part * 16; t < part * 16 + 16; ++t) s += cnt[t * 32 + e]; s_part[part * 32 + e] = s; }
    __syncthreads();
    if (F.tid < 32) { int s = 0; for (int p = 0; p < 16; ++p) s += s_part[p * 32 + F.tid]; s_tot[F.tid] = s; }
    __syncthreads();
    if (F.tid < 32) { int ps = 0; for (int e = 0; e < F.tid; ++e) ps += (s_tot[e] + 255) / 256 * 256; s_pst[F.tid] = ps; }
    __syncthreads();
    if (F.bid == 0 && F.tid < 32) { const int e = F.tid, nb = (s_tot[e] + 255) / 256, rb0 = s_pst[e] / 256; for (int i = 0; i < nb; ++i) meta[16 + rb0 + i] = e; if (e == 31) meta[0] = rb0 + nb; }
    if (F.bid < 32) { const int e = F.bid, r0 = s_pst[e] + s_tot[e], r1 = s_pst[e] + (s_tot[e] + 255) / 256 * 256;
        for (int r = r0 + F.tid; r < r1; r += NWAVES * 64) { rowtok[r] = T; rowrstd[r] = 0.f; } }
    if (F.bid == 0 && F.tid < 64) { const v4u z = {0u, 0u, 0u, 0u}; *((v4u*)(ws + WS_XQ + (size_t)T * D) + F.tid) = z; }
    for (int tile = F.bid; tile < T / 128; tile += F.G) {
        __syncthreads();
        if (F.tid < 32) { int s = 0; for (int t = 0; t < tile; ++t) s += cnt[t * 32 + F.tid]; s_base[F.tid] = s_pst[F.tid] + s; }
        __syncthreads();
        { const int i = F.tid;
            const int tok = tile * 128 + (i >> 2), k = i & 3; const int e = eidx[tok * 4 + k]; const int dest = s_base[e] + lrank[tok * 4 + k];
            inv[tok * 4 + k] = dest; rowtok[dest] = tok; rowrstd[dest] = rstd[tok];
        }
    }
}

DI void p10_combine(const Frame& F, const Args& a) {
    unsigned char* ws = a.ws; const int* inv = (const int*)(ws + WS_INV); const float* gate = (const float*)(ws + WS_GATE); const bf16* yr = (const bf16*)(ws + WS_YR); const bf16* xb = (const bf16*)(ws + WS_XN); float* out = a.out;
    const int gw = F.bid * NWAVES + F.wave, NGW = F.G * NWAVES;
    for (int t = gw; t < T; t += NGW) {
        const int4 iv = *(const int4*)(inv + (size_t)t * 4); const float4 gv = *(const float4*)(gate + (size_t)t * 4);
        const int rows[4] = {iv.x, iv.y, iv.z, iv.w}; const float gs[4] = {gv.x, gv.y, gv.z, gv.w};
        f32x4* o = (f32x4*)(out + (size_t)t * D) + F.lane; const v2u* xr = (const v2u*)(xb + (size_t)t * D) + F.lane;
#pragma unroll
        for (int j = 0; j < 4; ++j) {
            const v2u xw = xr[64 * j]; f32x4 acc = {bflo(xw.x), bfhi(xw.x), bflo(xw.y), bfhi(xw.y)};
#pragma unroll
            for (int k = 0; k < 4; ++k) { const int w = (int)__builtin_nontemporal_load((const unsigned*)((const unsigned char*)yr + (size_t)rows[k] * D) + F.lane + 64 * j);
                const auto lo = __builtin_amdgcn_cvt_pk_f32_fp8(w, false), hi = __builtin_amdgcn_cvt_pk_f32_fp8(w, true);
                acc.x += gs[k] * lo[0]; acc.y += gs[k] * lo[1]; acc.z += gs[k] * hi[0]; acc.w += gs[k] * hi[1]; }
            __builtin_nontemporal_store(acc, o + 64 * j);
        }
    }
}

constexpr int N_PHASES = 11;
__global__ void __launch_bounds__(NWAVES * 64, 2) fwd(Args args) {
    extern __shared__ __attribute__((aligned(16))) unsigned char lds[];
    Frame F;
    F.lds = (LAS unsigned char*)lds;
    F.tid = threadIdx.x; F.lane = F.tid & 63; F.wave = __builtin_amdgcn_readfirstlane(F.tid >> 6);
    F.G = gridDim.x; F.bid = blockIdx.x;
    volatile LAS unsigned* MISC = (volatile LAS unsigned*)(F.lds + MISC_OFF);
    if (F.tid < 64) MISC[F.tid] = 0u;
    __syncthreads();
    unsigned char* ws = args.ws;
    unsigned* ctl = (unsigned*)(ws + WS_CTL);
    XcdBarrier bar; bar.bar = ctl + CW_BAR; bar.x = 0; bar.st = nullptr;
    if (MK_N_LAUNCHES == 1) bar = xcd_barrier_post(ctl + CW_BAR, MISC + 8);
    const int lo = args.ph_lo, hi = args.ph_hi;
#ifndef PHASE_MASK
#define PHASE_MASK 0xffff
#endif
#define IN(k) (((PHASE_MASK >> (k)) & 1) && lo <= (k) && (k) < hi)
#ifndef DUP_PHASE
#define DUP_PHASE -1
#endif
#define REPS(k) ((DUP_PHASE >= 0 && (k) == DUP_PHASE) ? args.ph_rep : 1)
#define SEAM(k) do { if (IN(k) && IN((k) + 1)) xcd_barrier(bar); { int t_ = threadIdx.x; asm volatile("" : "+v"(t_)); F.tid = t_; F.lane = t_ & 63; } } while (0)

    for (int rep_ = 0; rep_ < REPS(0); ++rep_) { if (rep_) xcd_barrier(bar);
    if (IN(0)) { p0_prologue(F, args); } } SEAM(0);

    for (int rep_ = 0; rep_ < REPS(1); ++rep_) { if (rep_) xcd_barrier(bar);
    if (IN(1)) {
        pg8::Gemm g{(const bf16*)(ws + WS_XN), (const bf16*)(ws + WS_WIN), T, INC, D / 2}; pg8::StaticOrder S; S.init(T, INC, F.G, F.bid);
        pg8::EpiBf16Q E{(bf16*)(ws + WS_PROJ), INC, (const float*)(ws + WS_XNSC), (const float*)(ws + WS_COLSC1)};
        pg8::gemm_phase<pg8::EpiBf16Q, pg8::StaticOrder, true, true>(F.lds, g, S, E);
    } } SEAM(1);

    for (int rep_ = 0; rep_ < REPS(2); ++rep_) { if (rep_) xcd_barrier(bar);
    if (IN(2)) {
#if NAIVE_RWKV
        rwkv_naive_prep(F, args);
#else
        rwkv_phase_a(F, args);
#endif
    } } SEAM(2);

    for (int rep_ = 0; rep_ < REPS(3); ++rep_) { if (rep_) xcd_barrier(bar);
    if (IN(3)) {
#if NAIVE_RWKV
        rwkv_naive_scan(F, args);
#else
        rwkv_phase_b(F, args);
#endif
        __syncthreads();
#if NAIVE_ATT
        attn_naive(F, args);
#else
        attn_phase(F, args, rep_);
#endif
    } } SEAM(3);

    for (int rep_ = 0; rep_ < REPS(4); ++rep_) { if (rep_) xcd_barrier(bar);
    if (IN(4)) {
#if !NAIVE_RWKV
        rwkv_phase_c(F, args);
#endif
    } } SEAM(4);

    for (int rep_ = 0; rep_ < REPS(5); ++rep_) { if (rep_) xcd_barrier(bar);
    if (IN(5)) {
        pg8::Gemm g{(const bf16*)(ws + WS_MIX), (const bf16*)(ws + WS_WOUT), T, D, D}; pg8::StaticOrder S; S.init(T, D, F.G, F.bid);
        pg8::EpiResid E{args.in[I_X], nullptr, (bf16*)(ws + WS_XN), D};
        pg8::gemm_phase<pg8::EpiResid, pg8::StaticOrder, true, true>(F.lds, g, S, E);
    } } SEAM(5);

    for (int rep_ = 0; rep_ < REPS(6); ++rep_) { if (rep_) xcd_barrier(bar);
    if (IN(6)) { p6_router(F, args); } } SEAM(6);
    for (int rep_ = 0; rep_ < REPS(7); ++rep_) { if (rep_) xcd_barrier(bar);
    if (IN(7)) { p7_permute(F, args); } } SEAM(7);

    for (int rep_ = 0; rep_ < REPS(8); ++rep_) { if (rep_) xcd_barrier(bar);
    if (IN(8)) {
        pg8::Gemm g{(const bf16*)(ws + WS_XQ), (const bf16*)(ws + WS_WUP), NROWS_MAX, 2048, D / 2};
        pg8::MoeOrder<true> S{(const int*)(ws + WS_META), 8, F.G, F.bid, (const int*)(ws + WS_ROWTOK)};
        pg8::EpiSwiGLU E{(bf16*)(ws + WS_ACT), args.in[I_BUP], (const float*)(ws + WS_ROWRSTD), (const float*)(ws + WS_COLSC)};
        pg8::gemm_phase<pg8::EpiSwiGLU, pg8::MoeOrder<true>, true, true>(F.lds, g, S, E);
    } } SEAM(8);

    for (int rep_ = 0; rep_ < REPS(9); ++rep_) { if (rep_) xcd_barrier(bar);
    if (IN(9)) {
        pg8::Gemm g{(const bf16*)(ws + WS_ACT), (const bf16*)(ws + WS_WDN), NROWS_MAX, 1024, D / 2};
        pg8::MoeOrder<false> S{(const int*)(ws + WS_META), 4, F.G, F.bid, nullptr};
        pg8::EpiDown E{(bf16*)(ws + WS_YR), args.in[I_BDN], (const float*)(ws + WS_COLSC2)};
        pg8::gemm_phase<pg8::EpiDown, pg8::MoeOrder<false>, true, true>(F.lds, g, S, E);
    } } SEAM(9);

    if (IN(10)) { p10_combine(F, args); }
#undef IN
#undef SEAM
}

extern "C" void kernel_launch(void* const* d_in, const int* in_sizes, int n_in, void* d_out, int out_size, void* d_ws, size_t ws_size, hipStream_t stream) {
    static int grid = 0;
    if (grid == 0) {
        if (n_in != 25 || out_size != T * D || ws_size < WS_END) { fprintf(stderr, "kernel_launch: unexpected shapes (n_in %d out %d ws %zu)\n", n_in, out_size, ws_size); grid = -1; return; }
        int dev = 0, cus = 0, per_cu = 0;
        if (hipGetDevice(&dev) != hipSuccess || hipDeviceGetAttribute(&cus, hipDeviceAttributeMultiprocessorCount, dev) != hipSuccess) { grid = -1; return; }
        if (hipFuncSetAttribute((const void*)fwd, hipFuncAttributeMaxDynamicSharedMemorySize, LDS_BYTES) != hipSuccess) { fprintf(stderr, "kernel_launch: hipFuncSetAttribute failed\n"); grid = -1; return; }
        if (hipOccupancyMaxActiveBlocksPerMultiprocessor(&per_cu, (const void*)fwd, NWAVES * 64, LDS_BYTES) != hipSuccess || per_cu < 1) { fprintf(stderr, "kernel_launch: occupancy query says %d\n", per_cu); }
        (void)hipGetLastError();
        grid = cus;
    }
    if (grid < 0) return;
    (void)hipMemsetAsync((char*)d_ws + WS_CTL, 0, CTL_ZERO_BYTES, stream);
    Args a{};
    for (int i = 0; i < 25; ++i) a.in[i] = (const float*)d_in[i];
    a.out = (float*)d_out; a.ws = (unsigned char*)d_ws;
#if MK_N_LAUNCHES == 1
    a.ph_lo = 0; a.ph_hi = N_PHASES; a.ph_rep = 2;
    hipLaunchKernelGGL(fwd, dim3(grid), dim3(NWAVES * 64), LDS_BYTES, stream, a);
#else
    for (int p = 0; p < N_PHASES; ++p) { a.ph_lo = p; a.ph_hi = p + 1; hipLaunchKernelGGL(fwd, dim3(grid), dim3(NWAVES * 64), LDS_BYTES, stream, a); }
#endif
}
```

```cpp
#define NAIVE_RWKV 0
#define NAIVE_ATT 0
#define MK_N_LAUNCHES 1
#include <hip/hip_runtime.h>
#include <cstdio>
#include <cstdint>

#ifndef MK_N_LAUNCHES
#define MK_N_LAUNCHES 1
#endif
#ifndef NAIVE_RWKV
#define NAIVE_RWKV 0
#endif
#ifndef NAIVE_ATT
#define NAIVE_ATT 0
#endif

namespace pg8 {
#define PG8_LAS __attribute__((address_space(3)))
typedef unsigned short bf16_t;
typedef short bf16x8 __attribute__((ext_vector_type(8)));
typedef float f32x4 __attribute__((ext_vector_type(4)));
typedef unsigned u32x4 __attribute__((ext_vector_type(4)));
typedef unsigned u32x2 __attribute__((ext_vector_type(2)));
typedef float f32x2e __attribute__((ext_vector_type(2)));
typedef int i32x4 __attribute__((ext_vector_type(4)));
typedef int i32x8 __attribute__((ext_vector_type(8)));
template <bool F8> struct Frag { bf16x8 v[2]; __device__ __forceinline__ void set(bf16x8 a, bf16x8 b) { v[0] = a; v[1] = b; } };
template <> struct Frag<true> { i32x8 v; __device__ __forceinline__ void set(bf16x8 a, bf16x8 b) { v = __builtin_shufflevector(__builtin_bit_cast(i32x4, a), __builtin_bit_cast(i32x4, b), 0, 1, 2, 3, 4, 5, 6, 7); } };
__device__ __forceinline__ i32x8 cat8(bf16x8 a, bf16x8 b) { return __builtin_shufflevector(__builtin_bit_cast(i32x4, a), __builtin_bit_cast(i32x4, b), 0, 1, 2, 3, 4, 5, 6, 7); }
constexpr int BM = 256, BK = 64, HALF = 128, HTB = HALF * BK * 2  , STAGE_BYTES = 8 * HTB, NXCD = 8, WGM = 8, EPF_OFF = STAGE_BYTES  ;

__host__ __device__ __forceinline__ int lds_byte(int r, int c) { const int st = (r >> 4) * 2 + (c >> 5), rr = r & 15, cc = c & 31, ob = rr * 64 + cc * 2; return st * 1024 + (ob ^ (((ob >> 9) & 1) << 5)); }
__host__ __device__ __forceinline__ void stage_rc(int b, int& R, int& C) { const int st = b / 1024, sb = b % 1024, swz = sb ^ (((sb >> 9) & 1) << 5); R = (st >> 1) * 16 + swz / 64; C = (st & 1) * 32 + (swz % 64) / 2; }
__host__ __device__ __forceinline__ int perm32(int rho) { const int n = rho >> 4, i = rho & 15; return 8 * (i >> 2) + 4 * n + (i & 3); }

struct Unit { int pm, pn, e, aim, bjm; };
struct Gemm { const bf16_t* A; const bf16_t* Bt; int M, N, K; };

__device__ __forceinline__ bool tile_of(int i, int G, int c, int nM, int nN, int& pm, int& pn) {
    const int nwg = nM * nN; const long L = (long)i * G + c; if (L >= nwg) return false;
    int wgid = (int)L; { const int q = nwg / NXCD, r = nwg % NXCD, xcd = wgid % NXCD, off = wgid / NXCD; wgid = (xcd < r ? xcd * (q + 1) : r * (q + 1) + (xcd - r) * q) + off; }
    const int nig = WGM * nN, gid = wgid / nig, fm = gid * WGM, gsz = (nM - fm) < WGM ? (nM - fm) : WGM;
    pm = fm + ((wgid % nig) % gsz); pn = (wgid % nig) / gsz; return true;
}
__device__ __forceinline__ bool tile_split(int i, int G, int c, int nM, int nN, int smax, Unit& u) {
    const int nwg = nM * nN, full = (nwg / G) * G; u.aim = 3; u.bjm = 3;
    if (i * G + c < full) return tile_of(i, G, c, nM, nN, u.pm, u.pn);
    const int rem = nwg - full; if (i != nwg / G || rem == 0) return false;
    if (smax < 2 || rem * 2 > G) return tile_of(i, G, c, nM, nN, u.pm, u.pn);
    const int s = (smax >= 4 && rem * 4 <= G) ? 4 : ((smax >= 2 && rem * 2 <= G) ? 2 : 1);
    const int t = c / s, part = c - t * s; if (t >= rem) return false;
    if (s == 2) u.aim = 1 << part; if (s == 4) { u.aim = 1 << (part >> 1); u.bjm = 1 << (part & 1); }
    return tile_of(0, 1 << 30, full + t, nM, nN, u.pm, u.pn);
}
struct StaticOrder {
    int nM, nN, G, c;
    __device__ void init(int M, int N, int G_, int c_) { nM = M / BM; nN = N / BM; G = G_; c = c_; }
    int smax = 4;
    __device__ __forceinline__ bool next(int i, Unit& u) const { u.e = 0; return tile_split(i, G, c, nM, nN, smax, u); }
    __device__ __forceinline__ const char* a_base(const Gemm& g, const Unit& u) const { return (const char*)g.A + (size_t)u.pm * BM * g.K * 2; }
    __device__ __forceinline__ const char* b_base(const Gemm& g, const Unit& u) const { return (const char*)g.Bt + (size_t)u.pn * BM * g.K * 2; }
    __device__ __forceinline__ void a_off(const Gemm& g, const Unit&, const int (&R)[2], const int (&C)[2], unsigned (&vo)[2][2]) const {
#pragma unroll
        for (int h = 0; h < 2; ++h)
#pragma unroll
            for (int i = 0; i < 2; ++i) vo[h][i] = (unsigned)((h * HALF + R[i]) * g.K + C[i]) * 2u; }
    __device__ __forceinline__ void a_ready(const Unit&) const {}
    __device__ __forceinline__ void done(const Unit&) const {}
    static constexpr bool LATE = false;
    __device__ __forceinline__ void prologue(PG8_LAS unsigned char*, int) const {}
    __device__ __forceinline__ void a_req(const Unit&, PG8_LAS unsigned char*, int, int, int) const {}
    __device__ __forceinline__ void a_off_lds(const Gemm&, const PG8_LAS unsigned char*, int, const int (&)[2], const int (&)[2], unsigned (&)[2][2]) const {}
};
constexpr int SCH_META_OFF = EPF_OFF + 4096, SCH_ROW_OFF = EPF_OFF + 8192;
template <bool GATHER>
struct MoeOrder {
    const int* meta; int nN, G, c;
    const int* rowtok;
    const PG8_LAS int* lmeta;
    static constexpr bool LATE = GATHER;
    bool reuse = false;
    __device__ __forceinline__ void prologue(PG8_LAS unsigned char* lds, int tid) { PG8_LAS int* lm = (PG8_LAS int*)(lds + SCH_META_OFF);
        static_assert(16 + 544 <= 1024, "meta copy: two pieces per thread");
        if (!reuse) { const int v0 = meta[tid]; const int v1 = tid < 16 + 544 - 512 ? meta[512 + tid] : 0;
            lm[tid] = v0; if (tid < 16 + 544 - 512) lm[512 + tid] = v1;
            __syncthreads(); }
        lmeta = lm; }
    __device__ __forceinline__ bool next(int i, Unit& u) const {
        const int nM = __builtin_amdgcn_readfirstlane(lmeta[0]);
        if (!tile_split(i, G, c, nM, nN, GATHER ? 2 : 4, u)) return false;
        u.e = __builtin_amdgcn_readfirstlane(lmeta[16 + u.pm]); return true;
    }
    __device__ __forceinline__ const char* a_base(const Gemm& g, const Unit& u) const { return GATHER ? (const char*)g.A : (const char*)g.A + (size_t)u.pm * BM * g.K * 2; }
    __device__ __forceinline__ const char* b_base(const Gemm& g, const Unit& u) const { return (const char*)g.Bt + ((size_t)u.e * g.N + (size_t)u.pn * BM) * g.K * 2; }
    __device__ __forceinline__ void a_off(const Gemm& g, const Unit& u, const int (&R)[2], const int (&C)[2], unsigned (&vo)[2][2]) const {
#pragma unroll
        for (int h = 0; h < 2; ++h)
#pragma unroll
            for (int i = 0; i < 2; ++i) { const int r = h * HALF + R[i]; vo[h][i] = (unsigned)((GATHER ? rowtok[u.pm * BM + r] : r) * g.K + C[i]) * 2u; } }
    __device__ __forceinline__ void a_req(const Unit& nxt, PG8_LAS unsigned char* lds, int wid, int lane, int slot) const {
        if (GATHER && wid == 0) __builtin_amdgcn_global_load_lds((const unsigned*)(rowtok + nxt.pm * BM + 4 * lane), (PG8_LAS unsigned*)(lds + SCH_ROW_OFF + (slot & 1) * 1024), 16, 0, 0); }
    __device__ __forceinline__ void a_off_lds(const Gemm& g, const PG8_LAS unsigned char* lds, int slot, const int (&R)[2], const int (&C)[2], unsigned (&vo)[2][2]) const {
        const PG8_LAS int* lr = (const PG8_LAS int*)(lds + SCH_ROW_OFF + (slot & 1) * 1024);
#pragma unroll
        for (int h = 0; h < 2; ++h)
#pragma unroll
            for (int i = 0; i < 2; ++i) vo[h][i] = (unsigned)(lr[h * HALF + R[i]] * g.K + C[i]) * 2u; }
    __device__ __forceinline__ void a_ready(const Unit&) const {}
    __device__ __forceinline__ void done(const Unit&) const {}
};

__device__ __forceinline__ unsigned cvt_pk_bf16(float lo, float hi) { unsigned r; asm volatile("v_cvt_pk_bf16_f32 %0, %1, %2" : "=v"(r) : "v"(lo), "v"(hi)); return r; }

__device__ __forceinline__ float acc_i2f(float bits) { return (float)__builtin_bit_cast(int, bits); }
__device__ __forceinline__ void epf_dma(const float* src_lane, PG8_LAS unsigned char* dst) { __builtin_amdgcn_global_load_lds((const unsigned*)src_lane, (PG8_LAS unsigned*)dst, 16, 0, 0); }
struct EpiBf16Q {
    static constexpr int ID = 1; static constexpr bool PERM = true, AFTER_DRAIN = false, I8 = true, F8 = false, EPF = true;
    bf16_t* O; int ldc; const float* rowsc; const float* colsc;
    __device__ __forceinline__ void prefetch(const Unit& u, PG8_LAS unsigned char* ev, int lane) const {
        epf_dma(colsc + u.pn * BM + 4 * lane, ev); epf_dma(rowsc + u.pm * BM + 4 * lane, ev + 1024); }
    __device__ __forceinline__ void operator()(const f32x4 (&acc)[2][2][4][2], const Unit& u, int wr, int wc, int fr, int fq, const PG8_LAS float* ev) const {
        const int row0 = u.pm * BM + wr * 64 + fr, col0 = u.pn * BM + wc * 32 + 8 * fq;
        f32x4 cv[2][2]; float rsv[2][4];
#pragma unroll
        for (int bj = 0; bj < 2; ++bj)
#pragma unroll
            for (int n = 0; n < 2; ++n) cv[bj][n] = *(const PG8_LAS f32x4*)(ev + wc * 32 + 8 * fq + bj * HALF + 4 * n);
#pragma unroll
        for (int ai = 0; ai < 2; ++ai)
#pragma unroll
            for (int m = 0; m < 4; ++m) rsv[ai][m] = ev[256 + wr * 64 + fr + ai * HALF + m * 16];
#pragma unroll
        for (int ai = 0; ai < 2; ++ai)
#pragma unroll
            for (int m = 0; m < 4; ++m) { bf16_t* rowp = O + (size_t)(row0 + ai * HALF + m * 16) * ldc + col0; const float rs = rsv[ai][m];
                if (!((u.aim >> ai) & 1)) continue;
#pragma unroll
                for (int bj = 0; bj < 2; ++bj) { f32x4 v0, v1; if (!((u.bjm >> bj) & 1)) continue;
#pragma unroll
                    for (int j = 0; j < 4; ++j) { v0[j] = acc_i2f(acc[ai][bj][m][0][j]); v1[j] = acc_i2f(acc[ai][bj][m][1][j]); }
                    v0 = (v0 * rs) * cv[bj][0]; v1 = (v1 * rs) * cv[bj][1];
                    u32x4 w; w.x = cvt_pk_bf16(v0[0], v0[1]); w.y = cvt_pk_bf16(v0[2], v0[3]); w.z = cvt_pk_bf16(v1[0], v1[1]); w.w = cvt_pk_bf16(v1[2], v1[3]);
                    *(u32x4*)(rowp + bj * HALF) = w; } }
    }
};
struct EpiBf16 {
    static constexpr int ID = 0; static constexpr bool PERM = true, AFTER_DRAIN = false, I8 = false, F8 = false, EPF = false;
    bf16_t* O; int ldc;
    __device__ __forceinline__ void operator()(const f32x4 (&acc)[2][2][4][2], const Unit& u, int wr, int wc, int fr, int fq) const {
        const int row0 = u.pm * BM + wr * 64 + fr, col0 = u.pn * BM + wc * 32 + 8 * fq;
#pragma unroll
        for (int ai = 0; ai < 2; ++ai)
#pragma unroll
            for (int m = 0; m < 4; ++m) { bf16_t* rowp = O + (size_t)(row0 + ai * HALF + m * 16) * ldc + col0;
#pragma unroll
                for (int bj = 0; bj < 2; ++bj) { const f32x4 v0 = acc[ai][bj][m][0], v1 = acc[ai][bj][m][1];
                    u32x4 w; w.x = cvt_pk_bf16(v0[0], v0[1]); w.y = cvt_pk_bf16(v0[2], v0[3]); w.z = cvt_pk_bf16(v1[0], v1[1]); w.w = cvt_pk_bf16(v1[2], v1[3]);
                    *(u32x4*)(rowp + bj * HALF) = w; } }
    }
};
struct EpiResid {
    static constexpr int ID = 5; static constexpr bool PERM = false, AFTER_DRAIN = false, I8 = false, F8 = false, EPF = false;
    const float* base; float* out; bf16_t* xb; int ldc;
    __device__ __forceinline__ void operator()(const f32x4 (&acc)[2][2][4][2], const Unit& u, int wr, int wc, int fr, int fq) const {
        const int row0 = u.pm * BM + wr * 64 + fr, col0 = u.pn * BM + wc * 32 + 4 * fq;
        f32x4 nb[4][2][2];
#define PG8_RES_LOAD(g_) do { const size_t off_ = (size_t)(row0 + ((g_) >> 2) * HALF + ((g_) & 3) * 16) * ldc + col0; _Pragma("unroll") for (int bj = 0; bj < 2; ++bj) _Pragma("unroll") for (int n = 0; n < 2; ++n) \
            nb[(g_) & 3][bj][n] = __builtin_nontemporal_load((const f32x4*)(base + off_ + bj * HALF + n * 16)); } while (0)
        PG8_RES_LOAD(0); PG8_RES_LOAD(1); PG8_RES_LOAD(2);
#pragma unroll
        for (int g = 0; g < 8; ++g) { const int ai = g >> 2, m = g & 3; const size_t off = (size_t)(row0 + ai * HALF + m * 16) * ldc + col0;
            if (g + 3 < 8) PG8_RES_LOAD(g + 3);
#pragma unroll
            for (int bj = 0; bj < 2; ++bj)
#pragma unroll
                for (int n = 0; n < 2; ++n) { const f32x4 o = nb[g & 3][bj][n] + acc[ai][bj][m][n];
                    if (out) *(f32x4*)(out + off + bj * HALF + n * 16) = o;
                    u32x2 w; w.x = cvt_pk_bf16(o[0], o[1]); w.y = cvt_pk_bf16(o[2], o[3]); *(u32x2*)(xb + off + bj * HALF + n * 16) = w; }
            asm volatile("" ::: "memory"); }
#undef PG8_RES_LOAD
    }
};
struct EpiSwiGLU {
    static constexpr int ID = 8; static constexpr bool PERM = true, AFTER_DRAIN = false, I8 = true, F8 = false, EPF = true;
    bf16_t* O; const float* b_up; const float* rowrstd; const float* colsc;
    __device__ __forceinline__ void prefetch(const Unit& u, PG8_LAS unsigned char* ev, int lane) const {
        const int off = (size_t)u.e * 2048 + u.pn * HALF + (lane >> 5) * 1024 + 4 * (lane & 31);
        epf_dma(b_up + off, ev); epf_dma(colsc + off, ev + 1024); epf_dma(rowrstd + u.pm * BM + 4 * lane, ev + 2048); }
    __device__ __forceinline__ void operator()(const f32x4 (&acc)[2][2][4][2], const Unit& u, int wr, int wc, int fr, int fq, const PG8_LAS float* ev) const {
        const int row0 = u.pm * BM + wr * 64 + fr, f0 = u.pn * HALF + wc * 32 + 8 * fq;
        const PG8_LAS float* ep = ev + wc * 32 + 8 * fq;
        const f32x4 bg0 = *(const PG8_LAS f32x4*)ep, bg1 = *(const PG8_LAS f32x4*)(ep + 4), bl0 = *(const PG8_LAS f32x4*)(ep + 128), bl1 = *(const PG8_LAS f32x4*)(ep + 132);
        const float csg = ev[256 + wc * 32], csl = ev[384 + wc * 32];
        float rsv[2][4];
#pragma unroll
        for (int ai = 0; ai < 2; ++ai)
#pragma unroll
            for (int m = 0; m < 4; ++m) rsv[ai][m] = ev[512 + wr * 64 + fr + ai * HALF + m * 16];
#pragma unroll
        for (int ai = 0; ai < 2; ++ai)
#pragma unroll
            for (int m = 0; m < 4; ++m) { const int row = row0 + ai * HALF + m * 16; const float rs = rsv[ai][m];
                if (!((u.aim >> ai) & 1)) continue;
                const float rsg = rs * csg, rsl = rs * csl;
                float a[8];
#pragma unroll
                for (int n = 0; n < 2; ++n)
#pragma unroll
                    for (int j = 0; j < 4; j += 2) {
                        const f32x2e ag2 = {acc_i2f(acc[ai][0][m][n][j]), acc_i2f(acc[ai][0][m][n][j + 1])}, al2 = {acc_i2f(acc[ai][1][m][n][j]), acc_i2f(acc[ai][1][m][n][j + 1])};
                        const f32x2e bg2 = n ? (f32x2e){bg1[j], bg1[j + 1]} : (f32x2e){bg0[j], bg0[j + 1]}, bl2 = n ? (f32x2e){bl1[j], bl1[j + 1]} : (f32x2e){bl0[j], bl0[j + 1]};
                        f32x2e hg = ag2 * rsg + bg2, hl = al2 * rsl + bl2;
                        hg.x = fminf(hg.x, 7.0f); hg.y = fminf(hg.y, 7.0f); hl.x = fminf(fmaxf(hl.x, -7.0f), 7.0f); hl.y = fminf(fmaxf(hl.y, -7.0f), 7.0f);
                        const f32x2e t = hg * (-1.702f * 1.4426950408889634f);
                        f32x2e e; e.x = __builtin_amdgcn_exp2f(t.x); e.y = __builtin_amdgcn_exp2f(t.y);
                        const f32x2e d = e + 1.0f; f32x2e sg; sg.x = __builtin_amdgcn_rcpf(d.x); sg.y = __builtin_amdgcn_rcpf(d.y);
                        const f32x2e o = (hg * sg) * (hl + 1.0f);
                        a[n * 4 + j] = o.x; a[n * 4 + j + 1] = o.y; }
                u32x2 w;
                w.x = (unsigned)__builtin_amdgcn_cvt_pk_fp8_f32(a[2], a[3], __builtin_amdgcn_cvt_pk_fp8_f32(a[0], a[1], 0, false), true);
                w.y = (unsigned)__builtin_amdgcn_cvt_pk_fp8_f32(a[6], a[7], __builtin_amdgcn_cvt_pk_fp8_f32(a[4], a[5], 0, false), true);
                *(u32x2*)((unsigned char*)O + (size_t)row * 1024 + f0) = w; }
    }
};
struct EpiDown {
    static constexpr int ID = 9; static constexpr bool PERM = true, AFTER_DRAIN = false, I8 = false, F8 = true, EPF = true;
    bf16_t* O; const float* b_dn; const float* colsc;
    __device__ __forceinline__ void prefetch(const Unit& u, PG8_LAS unsigned char* ev, int lane) const {
        const int off = (size_t)u.e * 1024 + u.pn * BM + 4 * lane;
        epf_dma(b_dn + off, ev); epf_dma(colsc + off, ev + 1024); }
    __device__ __forceinline__ void operator()(const f32x4 (&acc)[2][2][4][2], const Unit& u, int wr, int wc, int fr, int fq, const PG8_LAS float* ev) const {
        const int row0 = u.pm * BM + wr * 64 + fr, col0 = u.pn * BM + wc * 32 + 8 * fq;
        f32x4 bv[2][2], cv[2][2];
#pragma unroll
        for (int bj = 0; bj < 2; ++bj)
#pragma unroll
            for (int n = 0; n < 2; ++n) { bv[bj][n] = *(const PG8_LAS f32x4*)(ev + wc * 32 + 8 * fq + bj * HALF + 4 * n); cv[bj][n] = *(const PG8_LAS f32x4*)(ev + 256 + wc * 32 + 8 * fq + bj * HALF + 4 * n); }
#pragma unroll
        for (int ai = 0; ai < 2; ++ai)
#pragma unroll
            for (int m = 0; m < 4; ++m) { if (!((u.aim >> ai) & 1)) continue;
                unsigned char* rowp = (unsigned char*)O + (size_t)(row0 + ai * HALF + m * 16) * 1024 + col0;
#pragma unroll
                for (int bj = 0; bj < 2; ++bj) { if (!((u.bjm >> bj) & 1)) continue;
                    const f32x4 v0 = acc[ai][bj][m][0] * cv[bj][0] + bv[bj][0], v1 = acc[ai][bj][m][1] * cv[bj][1] + bv[bj][1];
                    u32x2 w; w.x = (unsigned)__builtin_amdgcn_cvt_pk_fp8_f32(v0[2], v0[3], __builtin_amdgcn_cvt_pk_fp8_f32(v0[0], v0[1], 0, false), true);
                    w.y = (unsigned)__builtin_amdgcn_cvt_pk_fp8_f32(v1[2], v1[3], __builtin_amdgcn_cvt_pk_fp8_f32(v1[0], v1[1], 0, false), true);
                    *(u32x2*)(rowp + bj * HALF) = w; } }
    }
};

template <class Epi, class Sched, bool ALIGN_EPI = false, bool SP2 = false>
__device__ __forceinline__ void gemm_phase(PG8_LAS unsigned char* lds, const Gemm g, Sched S, const Epi& E) {
    int tid = threadIdx.x; asm volatile("" : "+v"(tid));
    const int wid = __builtin_amdgcn_readfirstlane(tid >> 6), lane = tid & 63, wr = wid >> 2, wc = wid & 3, fr = lane & 15, fq = lane >> 4;
    const int K = g.K, nt = K / BK;
    unsigned voffB[2]; int sR[2], sC[2];
#pragma unroll
    for (int i = 0; i < 2; ++i) { int R, C; stage_rc(tid * 16 + i * 8192, R, C); const int Rb = Epi::PERM ? ((R & ~31) + perm32(R & 31)) : R;
        sR[i] = R; sC[i] = C; voffB[i] = (unsigned)(Rb * K + C) * 2u; }
    const size_t kstep = (size_t)(BK * 2);
    const size_t hstep = (size_t)HALF * K * 2;
    const unsigned ldsw = (unsigned)wid * 1024u;
    const int aoff = lds_byte(wr * 64 + fr, fq * 8), boff = lds_byte(wc * 32 + fr, fq * 8);
#define PG8_SA(b, h) (((b) * 2 + (h)) * HTB)
#define PG8_SB(b, h) ((4 + (b) * 2 + (h)) * HTB)
#define PG8_STAGE(bufoff, gbase, voff) do { _Pragma("unroll") for (int _i = 0; _i < 2; ++_i) \
        __builtin_amdgcn_global_load_lds((const unsigned*)((const char*)(gbase) + (voff)[_i]), (PG8_LAS unsigned*)(lds + (bufoff) + ldsw + _i * 8192), 16, 0, 0); } while (0)
#define PG8_STAGE_A(bufoff, gbase, vo, h) do { _Pragma("unroll") for (int _i = 0; _i < 2; ++_i) \
        __builtin_amdgcn_global_load_lds((const unsigned*)((const char*)(gbase) + (vo)[h][_i]), (PG8_LAS unsigned*)(lds + (bufoff) + ldsw + _i * 8192), 16, 0, 0); } while (0)
#define PG8_LDA(dst, b, h) do { _Pragma("unroll") for (int m = 0; m < 4; ++m) dst[m].set(*(const PG8_LAS bf16x8*)(lds + PG8_SA(b, h) + aoff + m * 2048), *(const PG8_LAS bf16x8*)(lds + PG8_SA(b, h) + aoff + m * 2048 + 1024)); } while (0)
#define PG8_LDB(dst, b, h) do { _Pragma("unroll") for (int n = 0; n < 2; ++n) dst[n].set(*(const PG8_LAS bf16x8*)(lds + PG8_SB(b, h) + boff + n * 2048), *(const PG8_LAS bf16x8*)(lds + PG8_SB(b, h) + boff + n * 2048 + 1024)); } while (0)
#define PG8_MMA(ai, bj, At, Bt) do { __builtin_amdgcn_s_setprio(1); _Pragma("unroll") for (int m = 0; m < 4; ++m) _Pragma("unroll") for (int n = 0; n < 2; ++n) { \
        if constexpr (Epi::F8) asm volatile("v_mfma_scale_f32_16x16x128_f8f6f4 %0, %1, %2, %0, %3, %3 op_sel_hi:[0,0,0]" : "+v"(acc[ai][bj][m][n]) : "v"(Bt[n].v), "v"(At[m].v), "v"(f8scale)); \
        else { _Pragma("unroll") for (int k = 0; k < 2; ++k) { \
            if constexpr (Epi::I8) acc[ai][bj][m][n] = __builtin_bit_cast(f32x4, __builtin_amdgcn_mfma_i32_16x16x64_i8(__builtin_bit_cast(i32x4, Bt[n].v[k]), __builtin_bit_cast(i32x4, At[m].v[k]), __builtin_bit_cast(i32x4, acc[ai][bj][m][n]), 0, 0, 0)); \
            else acc[ai][bj][m][n] = __builtin_amdgcn_mfma_f32_16x16x32_bf16(Bt[n].v[k], At[m].v[k], acc[ai][bj][m][n], 0, 0, 0); } } } __builtin_amdgcn_s_setprio(0); } while (0)
#define PG8_WAIT_V(n) asm volatile("s_waitcnt vmcnt(" #n ")" ::: "memory")
#define PG8_WAIT_L(n) asm volatile("s_waitcnt lgkmcnt(" #n ")" ::: "memory")
#define PG8_BAR __builtin_amdgcn_s_barrier()
#define PG8_SCHED __builtin_amdgcn_sched_barrier(0)
    Unit cur, nxt; int ui = 0;
#ifdef GEMM_TIME
    long long gacc_ = 0;
#endif
    S.prologue(lds, tid);
    if (!S.next(0, cur)) return;
    f32x4 acc[2][2][4][2];
#pragma unroll
    for (int a = 0; a < 2; ++a)
#pragma unroll
        for (int b = 0; b < 2; ++b)
#pragma unroll
            for (int m = 0; m < 4; ++m)
#pragma unroll
                for (int n = 0; n < 2; ++n) acc[a][b][m][n] = (f32x4){0.f, 0.f, 0.f, 0.f};
    Frag<Epi::F8> At[4], B0[2], B1[2];
    const int f8scale = 0x7f7f7f7f;
    (void)f8scale;
    const char* cA = S.a_base(g, cur); const char* cB = S.b_base(g, cur);
    unsigned voC[2][2], voN[2][2];
    S.a_off(g, cur, sR, sC, voC);
    S.a_ready(cur);
    static_assert(SP2, "only the two-MFMA-blocks-per-barrier-pair loop is kept");
    PG8_STAGE(PG8_SB(0, 0), cB, voffB); PG8_STAGE(PG8_SB(0, 1), cB + hstep, voffB); PG8_STAGE_A(PG8_SA(0, 0), cA, voC, 0); PG8_STAGE_A(PG8_SA(0, 1), cA, voC, 1);
    if (wr == 1) PG8_BAR;
    PG8_WAIT_V(2); PG8_BAR;
    PG8_STAGE(PG8_SB(1, 0), cB + kstep, voffB); PG8_STAGE_A(PG8_SA(1, 0), cA + kstep, voC, 0); PG8_STAGE(PG8_SB(1, 1), cB + hstep + kstep, voffB);
    PG8_WAIT_V(6); PG8_BAR;
    for (;;) {
        const bool has_next = S.next(ui + 1, nxt);
        const char* nA = has_next ? S.a_base(g, nxt) : cA; const char* nB = has_next ? S.b_base(g, nxt) : cB;
        if (has_next && !Sched::LATE) S.a_off(g, nxt, sR, sC, voN); else {
#pragma unroll
            for (int h_ = 0; h_ < 2; ++h_) { voN[h_][0] = voC[h_][0]; voN[h_][1] = voC[h_][1]; } }
        if constexpr (Sched::LATE) { if (has_next) S.a_req(nxt, lds, wid, lane, ui + 1); }
#pragma unroll 1
        for (int t = 0; t < nt; t += 2) {
            const bool last = (t == nt - 2);
            const char* a1 = cA + (size_t)(t + 1) * kstep;
            const char* a2 = last ? nA : cA + (size_t)(t + 2) * kstep; const char* b2 = last ? nB : cB + (size_t)(t + 2) * kstep;
            const char* a3 = a2 + kstep; const char* b3 = b2 + kstep;
            if (last && has_next) S.a_ready(nxt);
            if constexpr (Sched::LATE) { if (last && has_next) S.a_off_lds(g, lds, ui + 1, sR, sC, voN); }
            if constexpr (Epi::EPF) { if (last && wid == 0) E.prefetch(cur, lds + EPF_OFF, lane); }
            unsigned vo2[2][2];
#pragma unroll
            for (int h_ = 0; h_ < 2; ++h_) { vo2[h_][0] = last ? voN[h_][0] : voC[h_][0]; vo2[h_][1] = last ? voN[h_][1] : voC[h_][1]; }
            PG8_LDB(B0, 0, 0); PG8_LDB(B1, 0, 1); PG8_SCHED; PG8_LDA(At, 0, 0); PG8_STAGE_A(PG8_SA(1, 1), a1, voC, 1);
            PG8_WAIT_V(8); PG8_WAIT_L(0); PG8_BAR; if ((cur.aim >> 0) & 1) { if (cur.bjm & 1) PG8_MMA(0, 0, At, B0); if (cur.bjm & 2) PG8_MMA(0, 1, At, B1); } PG8_BAR; PG8_SCHED;
            PG8_LDA(At, 0, 1); PG8_STAGE(PG8_SB(0, 0), b2, voffB); PG8_STAGE(PG8_SB(0, 1), b2 + hstep, voffB); PG8_STAGE_A(PG8_SA(0, 0), a2, vo2, 0);
            PG8_WAIT_V(8); PG8_WAIT_L(0); PG8_BAR; if ((cur.aim >> 1) & 1) { if (cur.bjm & 1) PG8_MMA(1, 0, At, B0); if (cur.bjm & 2) PG8_MMA(1, 1, At, B1); } PG8_BAR; PG8_SCHED;
            PG8_LDB(B0, 1, 0); PG8_LDB(B1, 1, 1); PG8_SCHED; PG8_LDA(At, 1, 0); PG8_STAGE_A(PG8_SA(0, 1), a2, vo2, 1);
            PG8_WAIT_V(8); PG8_WAIT_L(0); PG8_BAR; if ((cur.aim >> 0) & 1) { if (cur.bjm & 1) PG8_MMA(0, 0, At, B0); if (cur.bjm & 2) PG8_MMA(0, 1, At, B1); } PG8_BAR; PG8_SCHED;
            PG8_LDA(At, 1, 1); PG8_STAGE(PG8_SB(1, 0), b3, voffB); PG8_STAGE(PG8_SB(1, 1), b3 + hstep, voffB); PG8_STAGE_A(PG8_SA(1, 0), a3, vo2, 0);
            PG8_WAIT_V(8); PG8_WAIT_L(0); PG8_BAR; if ((cur.aim >> 1) & 1) { if (cur.bjm & 1) PG8_MMA(1, 0, At, B0); if (cur.bjm & 2) PG8_MMA(1, 1, At, B1); } PG8_BAR; PG8_SCHED;
        }
        if constexpr (ALIGN_EPI) { if (wr == 0) PG8_BAR; }
#ifdef GEMM_TIME
        const long long gt0_ = clock64();
#endif
        if constexpr (!Epi::AFTER_DRAIN) { if constexpr (Epi::EPF) E(acc, cur, wr, wc, fr, fq, (const PG8_LAS float*)(lds + EPF_OFF)); else E(acc, cur, wr, wc, fr, fq); S.done(cur); }
#ifdef GEMM_TIME
        if (GEMM_TIME == 100 || GEMM_TIME == Epi::ID) gacc_ += clock64() - gt0_;
#endif
        if (!has_next) break;
#pragma unroll
        for (int a = 0; a < 2; ++a)
#pragma unroll
            for (int b = 0; b < 2; ++b)
#pragma unroll
                for (int m = 0; m < 4; ++m)
#pragma unroll
                    for (int n = 0; n < 2; ++n) acc[a][b][m][n] = (f32x4){0.f, 0.f, 0.f, 0.f};
        cur = nxt; cA = nA; cB = nB; ++ui;
#pragma unroll
        for (int h_ = 0; h_ < 2; ++h_) { voC[h_][0] = voN[h_][0]; voC[h_][1] = voN[h_][1]; }
        if constexpr (ALIGN_EPI) { if (wr == 1) PG8_BAR; }
    }
    PG8_WAIT_V(0);
    if constexpr (!ALIGN_EPI) { if (wr == 0) PG8_BAR; }
    PG8_BAR;
#ifdef GEMM_TIME
    { const long long s0_ = clock64(); while (clock64() - s0_ < gacc_) __builtin_amdgcn_s_sleep(8); }
#endif
    if constexpr (Epi::AFTER_DRAIN) { E.fused(acc, cur, wr, wc, fr, fq, lds, wid, lane); S.done(cur); }
#undef PG8_SA
#undef PG8_SB
#undef PG8_STAGE
#undef PG8_STAGE_A
#undef PG8_LDA
#undef PG8_LDB
#undef PG8_MMA
#undef PG8_WAIT_V
#undef PG8_WAIT_L
#undef PG8_BAR
#undef PG8_SCHED
}
}

constexpr int NWAVES = 8;
constexpr int T = 32768, D = 1024, SEQ = 8192, NBATCH = 4, NCHUNK = SEQ / 64;
constexpr int INC = 3328;
constexpr int PRW = 1536;
constexpr int NEXP = 32, TOPK = 4;
constexpr int NRB_MAX = T * TOPK / 256 + NEXP;
constexpr int NROWS_MAX = NRB_MAX * 256;
constexpr int NITEM = NBATCH * NCHUNK * 8;

constexpr size_t MiB = 1u << 20, KiB = 1u << 10;
constexpr size_t WS_CTL = 0, CTL_ZERO_BYTES = 1 * MiB;
constexpr size_t WS_META = 1 * MiB;
constexpr size_t WS_CNT = 1 * MiB + 64 * KiB;
constexpr size_t WS_EIDX = 2 * MiB, WS_GATE = 2 * MiB + 512 * KiB, WS_LRANK = 3 * MiB, WS_INV = 3 * MiB + 512 * KiB;
constexpr size_t WS_RSTD = 4 * MiB, WS_ROWRSTD = 4 * MiB + 256 * KiB;
constexpr size_t WS_WRT = 5 * MiB;
constexpr size_t WS_PAR = 5 * MiB + 128 * KiB;
constexpr size_t WS_WDEC = 5 * MiB + 256 * KiB, WS_WAAA = WS_WDEC + 64 * KiB, WS_WGATE = WS_WAAA + 64 * KiB;
constexpr size_t WS_WIN = 6 * MiB, WS_WOUT = 13 * MiB;
constexpr size_t WS_ROWTOK = 15 * MiB;
constexpr size_t WS_WUP = 16 * MiB, WS_WDN = 144 * MiB;
constexpr size_t WS_XN = 208 * MiB;
constexpr size_t WS_PROJ = 272 * MiB;
constexpr size_t WS_MIX = 480 * MiB;
constexpr size_t WS_RW = 544 * MiB;
constexpr size_t WS_XG = 272 * MiB, WS_ACT = 544 * MiB, WS_YR = WS_XG;
constexpr size_t WS_COLSC = 15 * MiB + 640 * KiB;
constexpr size_t WS_COLSC1 = 5 * MiB + 192 * KiB;
constexpr size_t WS_XNSC = WS_RSTD;
constexpr size_t WS_COLSC2 = 15 * MiB + 896 * KiB;
constexpr size_t WS_XQ = WS_MIX;
constexpr size_t WS_END = 1000 * MiB;
constexpr int CW_ATT = 8192;
constexpr int CW_BAR = 4096;

constexpr int RING_BYTES = 131072;
constexpr int LDS_BYTES = 163840;
constexpr int MISC_OFF = LDS_BYTES - 256;

#define GAS __attribute__((address_space(1)))
#define LAS __attribute__((address_space(3)))
#define DI __device__ __forceinline__
typedef unsigned short bf16;
typedef unsigned v4u __attribute__((ext_vector_type(4)));
typedef unsigned v2u __attribute__((ext_vector_type(2)));
typedef float f32x4 __attribute__((ext_vector_type(4)));
typedef float f32x2 __attribute__((ext_vector_type(2)));
typedef short bf16x8 __attribute__((ext_vector_type(8)));
typedef __bf16 bf16x2_t __attribute__((ext_vector_type(2)));
#define LDS_WAIT() asm volatile("s_waitcnt lgkmcnt(0)" ::: "memory")
#define VM_WAIT() asm volatile("s_waitcnt vmcnt(0)" ::: "memory")
DI unsigned pk2(float lo, float hi) { const f32x2 v = {lo, hi}; const bf16x2_t b = __builtin_convertvector(v, bf16x2_t); return __builtin_bit_cast(unsigned, b); }
DI float bf2f(unsigned short b) { return __uint_as_float((unsigned)b << 16); }
DI float bflo(unsigned w) { return __uint_as_float(w << 16); }
DI float bfhi(unsigned w) { return __uint_as_float(w & 0xffff0000u); }
DI float wave_sum(float v) {
#pragma unroll
    for (int o = 1; o < 64; o <<= 1) v += __shfl_xor(v, o);
    return v;
}
DI float wave_max(float v) {
#pragma unroll
    for (int o = 1; o < 64; o <<= 1) v = fmaxf(v, __shfl_xor(v, o));
    return v;
}
DI float sigmoidf_(float x) { return 1.0f / (1.0f + __expf(-x)); }

DI float quad_sum(float x) {
    const unsigned a = __builtin_bit_cast(unsigned, x); const auto r = __builtin_amdgcn_permlane32_swap(a, a, false, false);
    const float y = __builtin_bit_cast(float, (unsigned)r[0]) + __builtin_bit_cast(float, (unsigned)r[1]);
    const unsigned b = __builtin_bit_cast(unsigned, y); const auto s = __builtin_amdgcn_permlane16_swap(b, b, false, false);
    return __builtin_bit_cast(float, (unsigned)s[0]) + __builtin_bit_cast(float, (unsigned)s[1]);
}
DI float quad_max(float x) {
    const unsigned a = __builtin_bit_cast(unsigned, x); const auto r = __builtin_amdgcn_permlane32_swap(a, a, false, false);
    const float y = fmaxf(__builtin_bit_cast(float, (unsigned)r[0]), __builtin_bit_cast(float, (unsigned)r[1]));
    const unsigned b = __builtin_bit_cast(unsigned, y); const auto s = __builtin_amdgcn_permlane16_swap(b, b, false, false);
    return fmaxf(__builtin_bit_cast(float, (unsigned)s[0]), __builtin_bit_cast(float, (unsigned)s[1]));
}
#define XB_TMO      128
#define XB_XCNT(j)  (256  + 64 * (j))
#define XB_XSUB(j)  (1280 + 64 * (j))
#define XB_XGEN(j)  (2304 + 64 * (j))
#define XB_TOP      3328
#define XB_TOPGEN   3392
#define XCD_BAR_WORDS 3456
#define XB_SPIN_CAP (NAIVE_RWKV ? (1u << 25) : (1u << 20))

__device__ __forceinline__ unsigned xb_ld(unsigned* p)              { return __hip_atomic_load(p, __ATOMIC_RELAXED, __HIP_MEMORY_SCOPE_AGENT); }
__device__ __forceinline__ unsigned xb_add(unsigned* p, unsigned v) { return __hip_atomic_fetch_add(p, v, __ATOMIC_RELAXED, __HIP_MEMORY_SCOPE_AGENT); }
__device__ __forceinline__ unsigned xb_xcc_id() { return (unsigned)__builtin_amdgcn_s_getreg((3 << 11) | 20) & 0xFu; }
#define XB_SPIN(cond, bar) do { unsigned _sp = 0; while (cond) { __builtin_amdgcn_s_sleep(1); \
    if ((++_sp & 255u) == 0u) { if (xb_ld(&(bar)[XB_TMO])) break; if (_sp > XB_SPIN_CAP) { atomicAdd(&(bar)[XB_TMO], 1u); break; } } } } while (0)

struct XcdBarrier {
    unsigned* bar; unsigned x;
    volatile LAS unsigned* st;
};

__device__ __forceinline__ XcdBarrier xcd_barrier_post(unsigned* bar, volatile LAS unsigned* st) {
    XcdBarrier b; b.bar = bar; b.x = xb_xcc_id(); b.st = st;
    if (threadIdx.x == 0) (void)xb_add(&bar[XB_XCNT(b.x)], 1u);
    return b;
}
__device__ __forceinline__ void xcd_barrier_complete(unsigned* bar, unsigned x, unsigned& nloc, unsigned& nx) {
    const unsigned G = gridDim.x * gridDim.y * gridDim.z;
    unsigned sum, cnt, mine, sp = 0u;
    for (;;) {
        sum = 0u; cnt = 0u; mine = 0u;
#pragma unroll
        for (unsigned j = 0; j < 16; ++j) { const unsigned c = xb_ld(&bar[XB_XCNT(j)]); sum += c; cnt += (c > 0u) ? 1u : 0u; mine = (j == x) ? c : mine; }
        if (sum == G) break;
        __builtin_amdgcn_s_sleep(1);
        if ((++sp & 255u) == 0u) { if (xb_ld(&bar[XB_TMO])) break; if (sp > XB_SPIN_CAP) { atomicAdd(&bar[XB_TMO], 1u); break; } }
    }
    nloc = mine > 0u ? mine : 1u; nx = cnt > 0u ? cnt : 1u;
}

__device__ __forceinline__ void xcd_barrier(const XcdBarrier& b) {
    asm volatile("s_waitcnt vmcnt(0)" ::: "memory");
    __syncthreads();
    if (threadIdx.x == 0) {
        unsigned* bar = b.bar;
        __builtin_amdgcn_s_waitcnt(0);
        unsigned nloc = b.st[0], nx = b.st[1];
        if (nloc == 0u) { xcd_barrier_complete(bar, b.x, nloc, nx); b.st[0] = nloc; b.st[1] = nx; }
        const unsigned old = xb_add(&bar[XB_XSUB(b.x)], 1u);
        const unsigned gen = old / nloc;
        if (old + 1u == (gen + 1u) * nloc) {
            __builtin_amdgcn_fence(__ATOMIC_RELEASE, "agent");
            asm volatile("s_waitcnt vmcnt(0)" ::: "memory");
            const unsigned og = xb_add(&bar[XB_TOP], 1u);
            const unsigned tg = og / nx;
            if (og + 1u == (tg + 1u) * nx) xb_add(&bar[XB_TOPGEN], 1u);
            else XB_SPIN(xb_ld(&bar[XB_TOPGEN]) == tg, bar);
            __builtin_amdgcn_fence(__ATOMIC_ACQUIRE, "agent");
            xb_add(&bar[XB_XGEN(b.x)], 1u);
            asm volatile("s_waitcnt vmcnt(0)" ::: "memory");
        } else {
            XB_SPIN(xb_ld(&bar[XB_XGEN(b.x)]) == gen, bar);
            __builtin_amdgcn_fence(__ATOMIC_ACQUIRE, "agent");
            asm volatile("s_waitcnt vmcnt(0)" ::: "memory");
        }
    }
    __syncthreads();
}

constexpr int CW_S2 = 16384;
__device__ __forceinline__ void seam_arrive(const XcdBarrier& b, unsigned* s, bool wait) {
    asm volatile("s_waitcnt vmcnt(0)" ::: "memory");
    __syncthreads();
    if (threadIdx.x == 0) {
        __builtin_amdgcn_s_waitcnt(0);
        unsigned nloc = b.st[0], nx = b.st[1];
        if (nloc == 0u) { xcd_barrier_complete(b.bar, b.x, nloc, nx); b.st[0] = nloc; b.st[1] = nx; }
        const unsigned old = xb_add(&s[64 * b.x], 1u);
        if (old + 1u == nloc) { __builtin_amdgcn_fence(__ATOMIC_RELEASE, "agent"); asm volatile("s_waitcnt vmcnt(0)" ::: "memory"); (void)xb_add(&s[1024], 1u); }
        if (wait) { XB_SPIN(xb_ld(&s[1024]) != nx, b.bar); __builtin_amdgcn_fence(__ATOMIC_ACQUIRE, "agent"); asm volatile("s_waitcnt vmcnt(0)" ::: "memory"); }
    }
    if (wait) __syncthreads();
}
__device__ __forceinline__ void seam_signal(unsigned* word) {
    asm volatile("s_waitcnt vmcnt(0)" ::: "memory");
    __syncthreads();
    if (threadIdx.x == 0) { __builtin_amdgcn_fence(__ATOMIC_RELEASE, "agent"); asm volatile("s_waitcnt vmcnt(0)" ::: "memory"); (void)xb_add(word, 1u); }
}
__device__ __forceinline__ void seam_wait(const XcdBarrier& b, unsigned* word, unsigned n, bool drain = false) {
    if (drain) asm volatile("s_waitcnt vmcnt(0)" ::: "memory");
    __syncthreads();
    if (threadIdx.x == 0) { XB_SPIN(xb_ld(word) != n, b.bar); __builtin_amdgcn_fence(__ATOMIC_ACQUIRE, "agent"); asm volatile("s_waitcnt vmcnt(0)" ::: "memory"); }
    __syncthreads();
}

struct Args {
    const float* in[25]; float* out; unsigned char* ws; int ph_lo, ph_hi, ph_rep, pad_;
};
typedef const __attribute__((address_space(4))) Args CArgs;
enum { I_X = 0, I_N1G, I_WIN, I_MU, I_QG, I_KG, I_RELB, I_W0, I_WDEC, I_A0, I_WAAA, I_WGATE, I_KK, I_KA, I_RK, I_LNG, I_LNB, I_WOUT, I_N2G, I_WR, I_BR, I_WUP, I_BUP, I_WDN, I_BDN };
struct Frame {
    LAS unsigned char* lds;
    int tid, lane, wave, G, bid;
};


struct TrRegs { f32x4 v[8]; f32x4 s0, s1; bf16* dst; int ldo; };
DI void tr_load(TrRegs& t, const float* __restrict__ W, int ldw, int k0, int n0, bf16* WT, int ldo, long drow, int lane, const float* __restrict__ ksc8 = nullptr) {
    const int r8 = lane >> 3, c4 = lane & 7;
    t.s0 = (f32x4){1.f, 1.f, 1.f, 1.f}; t.s1 = t.s0; if (ksc8) { t.s0 = *(const f32x4*)ksc8; t.s1 = *(const f32x4*)(ksc8 + 4); }
    const float* src = W + (size_t)(k0 + 8 * r8) * ldw + n0 + 4 * c4;
#pragma unroll
    for (int i = 0; i < 8; ++i) t.v[i] = __builtin_nontemporal_load((const f32x4*)(src + (size_t)i * ldw));
    t.dst = WT + (size_t)(drow + 4 * c4) * ldo + k0 + 8 * r8; t.ldo = ldo;
}
DI void tr_store(const TrRegs& t, const float* __restrict__ = nullptr) {
    const f32x4 s0 = t.s0, s1 = t.s1;
#pragma unroll
    for (int j = 0; j < 4; ++j) { const v4u o = {pk2(t.v[0][j] * s0[0], t.v[1][j] * s0[1]), pk2(t.v[2][j] * s0[2], t.v[3][j] * s0[3]), pk2(t.v[4][j] * s1[0], t.v[5][j] * s1[1]), pk2(t.v[6][j] * s1[2], t.v[7][j] * s1[3])};
        __builtin_nontemporal_store(o, (v4u*)(t.dst + (size_t)j * t.ldo)); }
}
DI void tr_item(const float* __restrict__ W, int ldw, int k0, int n0, bf16* WT, int ldo, long drow, LAS float* scr, int lane, const float* __restrict__ ksc) {
    (void)scr; TrRegs t; tr_load(t, W, ldw, k0, n0, WT, ldo, drow, lane, ksc ? ksc + k0 + 8 * (lane >> 3) : nullptr); tr_store(t);
}
constexpr int MOE_TR_UP = NEXP * 16 * 64, MOE_TR_DN = NEXP * 16 * 32, MOE_TR_ALL = MOE_TR_UP + MOE_TR_DN;
DI const float* moe_tr_load(TrRegs& t, CArgs& a, int r, int lane) {
    unsigned char* ws = a.ws;
    if (r < MOE_TR_UP) { const int e = r / 1024, kb = (r % 1024) / 64, nb = r % 64, n0 = 32 * nb; const int n1 = n0 & 1023;
        const long drow = (long)(n1 / 128) * 256 + (n0 >= 1024 ? 128 : 0) + (n1 % 128);
        tr_load(t, a.in[I_WUP] + (size_t)e * 1024 * 2048, 2048, 64 * kb, n0, (bf16*)(ws + WS_WUP) + (size_t)e * 2048 * 1024, 1024, drow, lane, a.in[I_N2G] + 64 * kb + 8 * (lane >> 3));
        return nullptr; }
    r -= MOE_TR_UP; const int e = r / 512, kb = (r % 512) / 32, nb = r % 32;
    tr_load(t, a.in[I_WDN] + (size_t)e * 1024 * 1024, 1024, 64 * kb, 32 * nb, (bf16*)(ws + WS_WDN) + (size_t)e * 1024 * 1024, 1024, 32 * nb, lane);
    return nullptr;
}
DI void moe_tr_item(CArgs& a, int r, LAS float* scr, int lane) { (void)scr; TrRegs t; const float* s = moe_tr_load(t, a, r, lane); tr_store(t, s); }
DI unsigned q_pack4(float a, float b, float c, float d) {
    const unsigned ua = __builtin_bit_cast(unsigned, a), ub = __builtin_bit_cast(unsigned, b), uc = __builtin_bit_cast(unsigned, c), ud = __builtin_bit_cast(unsigned, d);
    return (ua & 0xffu) | ((ub & 0xffu) << 8) | ((uc & 0xffu) << 16) | (ud << 24); }
constexpr float Q_MAGIC = 12582912.0f;
template <bool DOWN>
DI void moe_q_batch(CArgs& a, int batch, int wave, int lane, LAS float* exch) {
    unsigned char* ws = a.ws;
    constexpr int LDW = DOWN ? 1024 : 2048, SPE = LDW / 32;
    constexpr float QMAX = DOWN ? 256.0f : 127.0f;
    asm volatile("" : "+v"(lane));
    const int r8 = lane >> 3, c4 = lane & 7;
    const float* gk = a.in[I_N2G] + 128 * wave + 8 * r8;
    const f32x4 one = {1.f, 1.f, 1.f, 1.f};
    f32x4 s0[2], s1[2];
#pragma unroll
    for (int t = 0; t < 2; ++t) { s0[t] = DOWN ? one : *(const f32x4*)(gk + 64 * t); s1[t] = DOWN ? one : *(const f32x4*)(gk + 64 * t + 4); }
    f32x4 v[2][2][8]; const int loff = 8 * r8 * LDW + 4 * c4;
#define MQ_LOAD(buf, s_) do { const int strip_ = batch * 4 + (s_), e_ = strip_ / SPE, n0_ = 32 * (strip_ % SPE); \
        const float* W_ = a.in[DOWN ? I_WDN : I_WUP] + (size_t)e_ * 1024 * LDW + (size_t)(128 * wave) * LDW + n0_;     \
        _Pragma("unroll") for (int t = 0; t < 2; ++t) _Pragma("unroll") for (int i = 0; i < 8; ++i) v[buf][t][i] = __builtin_nontemporal_load((const f32x4*)(W_ + (size_t)(64 * t + i) * LDW + loff)); } while (0)
    MQ_LOAD(0, 0);
#pragma unroll
    for (int s = 0; s < 4; ++s) {
        if (s < 3) MQ_LOAD((s + 1) & 1, s + 1);
        const int strip = batch * 4 + s, e = strip / SPE, n0 = 32 * (strip % SPE), n1 = n0 & 1023;
        const long drow = DOWN ? (long)n0 : (long)(n1 / 128) * 256 + (n0 >= 1024 ? 128 : 0) + (n1 % 128);
        f32x4 mx = {0.f, 0.f, 0.f, 0.f};
#pragma unroll
        for (int t = 0; t < 2; ++t)
#pragma unroll
            for (int i = 0; i < 8; ++i) { const float sc = i < 4 ? s0[t][i] : s1[t][i - 4]; const f32x4 p = v[s & 1][t][i] * sc; v[s & 1][t][i] = p;
#pragma unroll
                for (int j = 0; j < 4; ++j) mx[j] = fmaxf(mx[j], fabsf(p[j])); }
#pragma unroll
        for (int j = 0; j < 4; ++j) { float m = mx[j]; m = fmaxf(m, __shfl_xor(m, 8)); m = fmaxf(m, __shfl_xor(m, 16)); m = fmaxf(m, __shfl_xor(m, 32)); mx[j] = m; }
        LAS float* ex = exch + (s & 1) * 256;
        if (r8 == 0) *(LAS f32x4*)(ex + (wave * 8 + c4) * 4) = mx;
        __syncthreads();
#pragma unroll
        for (int w2 = 0; w2 < 8; ++w2) { const f32x4 o = *(const LAS f32x4*)(ex + (w2 * 8 + c4) * 4);
#pragma unroll
            for (int j = 0; j < 4; ++j) mx[j] = fmaxf(mx[j], o[j]); }
        if (!DOWN) {
            float m = fmaxf(fmaxf(mx[0], mx[1]), fmaxf(mx[2], mx[3])); m = fmaxf(m, __shfl_xor(m, 1)); m = fmaxf(m, __shfl_xor(m, 2)); m = fmaxf(m, __shfl_xor(m, 4));
            mx = (f32x4){m, m, m, m}; }
        if (wave == 0 && r8 == 0) *(f32x4*)((float*)(ws + (DOWN ? WS_COLSC2 : WS_COLSC)) + (size_t)e * LDW + n0 + 4 * c4) = mx * (1.0f / QMAX);
        f32x4 inv;
#pragma unroll
        for (int j = 0; j < 4; ++j) inv[j] = mx[j] > 0.f ? QMAX / mx[j] : 0.f;
        unsigned char* dst = ws + (DOWN ? WS_WDN : WS_WUP) + ((size_t)e * LDW + drow + 4 * c4) * 1024 + 128 * wave + 8 * r8;
#pragma unroll
        for (int t = 0; t < 2; ++t) {
            f32x4 (&p)[8] = v[s & 1][t];
#pragma unroll
            for (int i = 0; i < 8; ++i) p[i] = DOWN ? p[i] * inv : p[i] * inv + Q_MAGIC;
#pragma unroll
            for (int j = 0; j < 4; ++j) { v2u o;
                if (DOWN) { o.x = (unsigned)__builtin_amdgcn_cvt_pk_fp8_f32(p[2][j], p[3][j], __builtin_amdgcn_cvt_pk_fp8_f32(p[0][j], p[1][j], 0, false), true);
                            o.y = (unsigned)__builtin_amdgcn_cvt_pk_fp8_f32(p[6][j], p[7][j], __builtin_amdgcn_cvt_pk_fp8_f32(p[4][j], p[5][j], 0, false), true); }
                else { o.x = q_pack4(p[0][j], p[1][j], p[2][j], p[3][j]); o.y = q_pack4(p[4][j], p[5][j], p[6][j], p[7][j]); }
                __builtin_nontemporal_store(o, (v2u*)(dst + (size_t)j * 1024 + 64 * t)); } }
    }
#undef MQ_LOAD
}
DI void q_strip_i8_wg(const float* __restrict__ Wsrc, int ldw, int n0, unsigned char* WT, float* colsc, int wave, int lane, LAS float* exch) {
    const int r8 = lane >> 3, c4 = lane & 7;
    const float* W = Wsrc + (size_t)(128 * wave + 8 * r8) * ldw + n0 + 4 * c4;
    f32x4 v[2][8], mx = {0.f, 0.f, 0.f, 0.f};
#pragma unroll
    for (int t = 0; t < 2; ++t)
#pragma unroll
        for (int i = 0; i < 8; ++i) v[t][i] = *(const f32x4*)(W + (size_t)(64 * t + i) * ldw);
#pragma unroll
    for (int t = 0; t < 2; ++t)
#pragma unroll
        for (int i = 0; i < 8; ++i)
#pragma unroll
            for (int j = 0; j < 4; ++j) mx[j] = fmaxf(mx[j], fabsf(v[t][i][j]));
#pragma unroll
    for (int j = 0; j < 4; ++j) { float m = mx[j]; m = fmaxf(m, __shfl_xor(m, 8)); m = fmaxf(m, __shfl_xor(m, 16)); m = fmaxf(m, __shfl_xor(m, 32)); mx[j] = m; }
    if (r8 == 0) *(LAS f32x4*)(exch + (wave * 8 + c4) * 4) = mx;
    __syncthreads();
#pragma unroll
    for (int w2 = 0; w2 < 8; ++w2) { const f32x4 o = *(const LAS f32x4*)(exch + (w2 * 8 + c4) * 4);
#pragma unroll
        for (int j = 0; j < 4; ++j) mx[j] = fmaxf(mx[j], o[j]); }
    if (wave == 0 && r8 == 0) *(f32x4*)(colsc + n0 + 4 * c4) = mx * (1.0f / 127.0f);
    f32x4 inv;
#pragma unroll
    for (int j = 0; j < 4; ++j) inv[j] = mx[j] > 0.f ? 127.0f / mx[j] : 0.f;
    unsigned char* dst = WT + (size_t)(n0 + 4 * c4) * 1024 + 128 * wave + 8 * r8;
#pragma unroll
    for (int t = 0; t < 2; ++t) {
        f32x4 p[8];
#pragma unroll
        for (int i = 0; i < 8; ++i) p[i] = v[t][i] * inv + Q_MAGIC;
#pragma unroll
        for (int j = 0; j < 4; ++j) { const v2u o = {q_pack4(p[0][j], p[1][j], p[2][j], p[3][j]), q_pack4(p[4][j], p[5][j], p[6][j], p[7][j])};
            *(v2u*)(dst + (size_t)j * 1024 + 64 * t) = o; } }
}
DI void moe_tr_batch(CArgs& a, int batch, int wave, int lane, LAS float* exch) {
    if (batch < MOE_TR_UP / 64) moe_q_batch<false>(a, batch, wave, lane, exch); else moe_q_batch<true>(a, batch - MOE_TR_UP / 64, wave, lane, exch);
}
constexpr int MOE_TR_BATCHES = MOE_TR_ALL / 64, MOE_TR_EARLY = 256;

#if !NAIVE_ATT
typedef short v4s16 __attribute__((ext_vector_type(4)));
constexpr int ATT_KS = 144;
constexpr int ATT_TILE = 64 * ATT_KS;
constexpr int ATT_BIAS_OFF = 4 * ATT_TILE;
constexpr int ATT_QC = 4;
constexpr int ATT_NSLOT = (NBATCH * 8 * (NCHUNK / ATT_QC) / 4) * 7;
static_assert(NBATCH * 8 * (NCHUNK / ATT_QC) == 1024 && MOE_TR_ALL == 256 * 3 * 64, "attention / conversion work queue");
DI int att_pos(int key) { return (key & 32) + 8 * ((key >> 2) & 3) + 4 * ((key >> 4) & 1) + (key & 3); }
DI void attn_phase(const Frame& F, CArgs& a, const int qid = 0) {
    const bf16* proj = (const bf16*)(a.ws + WS_PROJ); bf16* mix = (bf16*)(a.ws + WS_MIX);
    LAS unsigned char* lds = F.lds; LAS float* sbias = (LAS float*)(lds + ATT_BIAS_OFF);
    const int w = F.wave;
    const float LOG2E = 1.4426950408889634f;
    LAS float* skg = (LAS float*)(lds + ATT_BIAS_OFF + 4096);
    if (F.tid < 64) skg[F.tid] = a.in[I_KG][F.tid];
    LAS int* s_item = (LAS int*)(lds + ATT_BIAS_OFF + 1024);
    unsigned* qhead = (unsigned*)(a.ws + WS_CTL) + CW_ATT + 64 * qid;
    int nxt_slot = 0;
#define ATT_CLAIM() do { const int one_ = 1, zo_ = 0; asm volatile("global_atomic_add %0, %1, %2, %3 sc0" : "=&v"(nxt_slot) : "v"(zo_), "v"(one_), "s"(qhead) : "memory"); } while (0)
    if (F.tid == 0) ATT_CLAIM();
    for (;;) {
        __syncthreads();
        if (F.tid == 0) { asm volatile("s_waitcnt vmcnt(0)" : "+v"(nxt_slot) :: "memory"); *s_item = nxt_slot; }
        __syncthreads();
        const int slot = *s_item;
        if (slot >= ATT_NSLOT) break;
        if (F.tid == 0) ATT_CLAIM();
        const int grp = slot / 7, sub = slot % 7;
        if (sub >= 4) { moe_tr_batch(a, grp * 3 + (sub - 4), w, F.lane, (LAS float*)(lds + ATT_BIAS_OFF + 2048));
            continue; }
        int l = F.lane; asm volatile("" : "+v"(l));
        const int n16 = l & 15, q = l >> 4;
        const int tid_ = (w << 6) | l, srow = tid_ >> 3, spc = tid_ & 7, spos = att_pos(srow);
        const int item = grp * 4 + sub;
        const int bh = item < 960 ? item / 30 : (item - 960) >> 1, ng = item < 960 ? item - 30 * bh + 2 : (item - 960) & 1;
        const int b = bh >> 3, h = bh & 7, n0 = ATT_QC * ng;
        if (F.tid < 192) sbias[F.tid] = a.in[I_RELB][h * 192 + F.tid] * LOG2E;
        const int nq = n0 + (w >> 1);
        int qpos[2]; size_t qtok[2]; bf16x8 qf[2][2];
#pragma unroll
        for (int u = 0; u < 2; ++u) { qpos[u] = 16 * (2 * (w & 1) + u) + n16; qtok[u] = (size_t)b * SEQ + nq * 64 + qpos[u];
          const v4u q0 = *(const v4u*)(proj + qtok[u] * INC + h * 64 + 8 * q), q1 = *(const v4u*)(proj + qtok[u] * INC + h * 64 + 32 + 8 * q);
          float f[16]; const unsigned ww[8] = {q0.x, q0.y, q0.z, q0.w, q1.x, q1.y, q1.z, q1.w};
          float ss = 0.f;
#pragma unroll
          for (int e = 0; e < 8; ++e) { f[2 * e] = bflo(ww[e]); f[2 * e + 1] = bfhi(ww[e]); ss += f[2 * e] * f[2 * e] + f[2 * e + 1] * f[2 * e + 1]; }
          ss = quad_sum(ss);
          const float rs = __builtin_amdgcn_rsqf(ss * (1.f / 64.f) + 1e-6f) * (0.125f * LOG2E);
          unsigned pk[8];
#pragma unroll
          for (int e = 0; e < 8; ++e) { const int d = (e < 4 ? 0 : 32) + 8 * q + 2 * (e & 3); pk[e] = pk2(f[2 * e] * rs * a.in[I_QG][d], f[2 * e + 1] * rs * a.in[I_QG][d + 1]); }
          const v4u p0 = {pk[0], pk[1], pk[2], pk[3]}, p1 = {pk[4], pk[5], pk[6], pk[7]};
          qf[u][0] = __builtin_bit_cast(bf16x8, p0); qf[u][1] = __builtin_bit_cast(bf16x8, p1); }
        f32x4 o[2][4];
#pragma unroll
        for (int u = 0; u < 2; ++u)
#pragma unroll
            for (int dt = 0; dt < 4; ++dt) o[u][dt] = (f32x4){0.f, 0.f, 0.f, 0.f};
        float m_run[2] = {-3.0e38f, -3.0e38f}, l_run[2] = {0.f, 0.f};
        constexpr int NKC = 8 + ATT_QC;
        v4u kreg, vreg;
        auto gload = [&](int jc) { const int kc = n0 - 8 + jc; if (kc >= 0) { const size_t tok = (size_t)b * SEQ + kc * 64 + srow;
            kreg = *(const v4u*)(proj + tok * INC + 512 + h * 64 + 8 * spc); vreg = *(const v4u*)(proj + tok * INC + 1024 + h * 64 + 8 * spc); } };
        auto lstore = [&](int jc) { const int kc = n0 - 8 + jc; if (kc >= 0) { LAS unsigned char* kb = lds + (jc & 1) * 2 * ATT_TILE; LAS unsigned char* vb = kb + ATT_TILE;
            const unsigned ww[4] = {kreg.x, kreg.y, kreg.z, kreg.w}; float f[8]; float ss = 0.f;
#pragma unroll
            for (int e = 0; e < 4; ++e) { f[2 * e] = bflo(ww[e]); f[2 * e + 1] = bfhi(ww[e]); ss += f[2 * e] * f[2 * e] + f[2 * e + 1] * f[2 * e + 1]; }
            ss += __builtin_bit_cast(float, __builtin_amdgcn_update_dpp(0, __builtin_bit_cast(int, ss), 0xB1, 0xf, 0xf, true));
            ss += __builtin_bit_cast(float, __builtin_amdgcn_update_dpp(0, __builtin_bit_cast(int, ss), 0x4E, 0xf, 0xf, true));
            ss += __builtin_bit_cast(float, __builtin_amdgcn_update_dpp(0, __builtin_bit_cast(int, ss), 0x141, 0xf, 0xf, true));
            const float rs = __builtin_amdgcn_rsqf(ss * (1.f / 64.f) + 1e-6f);
            const f32x4 kg0 = *(const LAS f32x4*)(skg + 8 * spc), kg1 = *(const LAS f32x4*)(skg + 8 * spc + 4);
            v4u kk; kk.x = pk2(f[0] * rs * kg0[0], f[1] * rs * kg0[1]); kk.y = pk2(f[2] * rs * kg0[2], f[3] * rs * kg0[3]); kk.z = pk2(f[4] * rs * kg1[0], f[5] * rs * kg1[1]); kk.w = pk2(f[6] * rs * kg1[2], f[7] * rs * kg1[3]);
            *(LAS v4u*)(kb + srow * ATT_KS + 16 * spc) = kk;
            *(LAS v4u*)(vb + srow * ATT_KS + 16 * spc) = vreg; } };
        gload(0); lstore(0);
        __syncthreads();
        for (int jc = 0; jc < NKC; ++jc) {
            if (jc + 1 < NKC) gload(jc + 1);
            const int kc = n0 - 8 + jc, dj = jc - (w >> 1);
            if (kc >= 0 && dj >= 0 && dj <= 8) {
                const LAS unsigned char* kb = lds + (jc & 1) * 2 * ATT_TILE; const LAS unsigned char* vb = kb + ATT_TILE;
                f32x4 sc[2][4];
#pragma unroll
                for (int mt = 0; mt < 4; ++mt) { sc[0][mt] = (f32x4){0.f, 0.f, 0.f, 0.f}; sc[1][mt] = sc[0][mt];
#pragma unroll
                    for (int ks = 0; ks < 2; ++ks) { const bf16x8 kf = *(const LAS bf16x8*)(kb + (16 * mt + n16) * ATT_KS + 64 * ks + 16 * q);
                        sc[0][mt] = __builtin_amdgcn_mfma_f32_16x16x32_bf16(kf, qf[0][ks], sc[0][mt], 0, 0, 0);
                        sc[1][mt] = __builtin_amdgcn_mfma_f32_16x16x32_bf16(kf, qf[1][ks], sc[1][mt], 0, 0, 0); } }
                float boff = 0.f;
                if (dj <= 5) boff = sbias[0];
                else {
#pragma unroll
                    for (int u = 0; u < 2; ++u) { const int base = (dj - 8) * 64 - qpos[u] + 128;
#pragma unroll
                        for (int mt = 0; mt < 4; ++mt)
#pragma unroll
                            for (int i = 0; i < 4; ++i) { int idx = base + 16 * mt + 4 * q + i; idx = idx < 0 ? 0 : idx; const float bv_ = sbias[idx];
                                sc[u][mt][i] += bv_; } } }
                bf16x8 pf[2][2];
#pragma unroll
                for (int u = 0; u < 2; ++u) {
                    float mx = sc[u][0][0];
#pragma unroll
                    for (int mt = 0; mt < 4; ++mt)
#pragma unroll
                        for (int i = 0; i < 4; ++i) mx = fmaxf(mx, sc[u][mt][i]);
                    mx = quad_max(mx);
                    const float m_new = fmaxf(m_run[u], mx + boff), alpha = __builtin_amdgcn_exp2f(m_run[u] - m_new), msub = m_new - boff;
                    const bool moved = __builtin_amdgcn_ballot_w64(m_new != m_run[u]) != 0ull;
                    m_run[u] = m_new; float ls = 0.f;
#pragma unroll
                    for (int mt = 0; mt < 4; ++mt)
#pragma unroll
                        for (int i = 0; i < 4; ++i) { sc[u][mt][i] = __builtin_amdgcn_exp2f(sc[u][mt][i] - msub); ls += sc[u][mt][i]; }
                    if (moved) { l_run[u] *= alpha;
#pragma unroll
                        for (int dt = 0; dt < 4; ++dt) o[u][dt] = o[u][dt] * alpha; }
                    l_run[u] += ls;
#pragma unroll
                    for (int s = 0; s < 2; ++s) {
                        const v4u pp = {pk2(sc[u][2 * s][0], sc[u][2 * s][1]), pk2(sc[u][2 * s][2], sc[u][2 * s][3]), pk2(sc[u][2 * s + 1][0], sc[u][2 * s + 1][1]), pk2(sc[u][2 * s + 1][2], sc[u][2 * s + 1][3])};
                        pf[u][s] = __builtin_bit_cast(bf16x8, pp); } }
#pragma unroll
                for (int s = 0; s < 2; ++s)
#pragma unroll
                    for (int dt = 0; dt < 4; ++dt) {
                        const LAS unsigned char* va_ = vb + (32 * s + 4 * q + ((l & 15) >> 2)) * ATT_KS + 32 * dt + 8 * (l & 3);
                        const v4s16 t0_ = __builtin_amdgcn_ds_read_tr16_b64_v4i16((LAS v4s16*)va_), t1_ = __builtin_amdgcn_ds_read_tr16_b64_v4i16((LAS v4s16*)(va_ + 16 * ATT_KS));
                        const bf16x8 vf = __builtin_shufflevector(t0_, t1_, 0, 1, 2, 3, 4, 5, 6, 7);
                        o[0][dt] = __builtin_amdgcn_mfma_f32_16x16x32_bf16(vf, pf[0][s], o[0][dt], 0, 0, 0);
                        o[1][dt] = __builtin_amdgcn_mfma_f32_16x16x32_bf16(vf, pf[1][s], o[1][dt], 0, 0, 0); }
            }
            if (jc + 1 < NKC) lstore(jc + 1);
            __syncthreads();
        }
#pragma unroll
        for (int u = 0; u < 2; ++u) {
            const float lr = quad_sum(l_run[u]);
            const float inv = __builtin_amdgcn_rcpf(lr);
#pragma unroll
            for (int dt = 0; dt < 4; ++dt) { v2u ov; ov.x = pk2(o[u][dt][0] * inv, o[u][dt][1] * inv); ov.y = pk2(o[u][dt][2] * inv, o[u][dt][3] * inv);
                *(v2u*)(mix + qtok[u] * 1024 + h * 64 + 16 * dt + 4 * q) = ov; } }
    }
}
#endif

#if !NAIVE_RWKV
constexpr int RA_HALF = 80896;
constexpr int RA_RT = 0, RA_KT = 9216, RA_BT = 18432, RA_AT = 27648;
constexpr int RA_VT = 36864, RA_KH = 46080, RA_BH = 55296;
constexpr int RA_AAB = 64512;
constexpr int RA_XWD = 0, RA_XAD = 9216, RA_XGD = 18432;
constexpr int RA_RHS2 = 0, RA_GEND = 17408;
constexpr int RA_W1T = 18432, RA_W2T = 27648;
constexpr int RA_PARW = RA_AAB + 1024 + 5 * 1024;
constexpr int RA_WT = RA_AAB;
constexpr int RB_REC = 65536, RB_YLT = 0, RB_PCT = 8192, RB_G1T = 16384, RB_E2T = 24576, RB_MC = 32768, RB_CC = 40960, RB_SC = 57344;
static_assert(2 * RA_HALF <= MISC_OFF, "rwkv phase A LDS");

DI void ld8f(const bf16* p, float (&f)[8]) { const v4u w = *(const v4u*)p; f[0] = bflo(w.x); f[1] = bfhi(w.x); f[2] = bflo(w.y); f[3] = bfhi(w.y); f[4] = bflo(w.z); f[5] = bfhi(w.z); f[6] = bflo(w.w); f[7] = bfhi(w.w); }
DI void ld4f(const bf16* p, float (&f)[4]) { const v2u w = *(const v2u*)p; f[0] = bflo(w.x); f[1] = bfhi(w.x); f[2] = bflo(w.y); f[3] = bfhi(w.y); }
DI bf16x8 pack8(const f32x4& a, const f32x4& b) { const v4u p = {pk2(a[0], a[1]), pk2(a[2], a[3]), pk2(b[0], b[1]), pk2(b[2], b[3])}; return __builtin_bit_cast(bf16x8, p); }
DI float fast_sigmoid(float x) { return __builtin_amdgcn_rcpf(1.0f + __builtin_amdgcn_exp2f(-1.4426950408889634f * x)); }
DI float fast_tanh(float x) { return 1.0f - 2.0f * __builtin_amdgcn_rcpf(1.0f + __builtin_amdgcn_exp2f(2.8853900817779268f * x)); }
#define MFMA16(a, b, c) __builtin_amdgcn_mfma_f32_16x16x32_bf16((a), (b), (c), 0, 0, 0)

#define RGAS __attribute__((address_space(1)))
DI unsigned row_shl_k(unsigned v, int k) {
#define RSK_(n) case n: return (unsigned)__builtin_amdgcn_update_dpp(0, (int)v, 0x100 + n, 0xf, 0xf, false);
    switch (k) { RSK_(1) RSK_(2) RSK_(3) RSK_(4) RSK_(5) RSK_(6) RSK_(7) RSK_(8) RSK_(9) RSK_(10) RSK_(11) default: return v; }
#undef RSK_
}
DI void rwkv_phase_a(const Frame& F, CArgs& a) {
    unsigned char* ws = a.ws; unsigned char* rb = ws + WS_RW;
    const bf16* wdec = (const bf16*)(ws + WS_WDEC); const bf16* waaa = (const bf16*)(ws + WS_WAAA); const bf16* wgate = (const bf16*)(ws + WS_WGATE);
    const float* mu = a.in[I_MU]; const float* par = (const float*)(ws + WS_PAR);
    const int hb = F.wave >> 2, w4 = F.wave & 3;
    LAS unsigned char* hbase = F.lds + hb * RA_HALF;
    const float LOG2E = 1.4426950408889634f;
    v4u s0c[4];
#define RA_REQUEST(pair_) do { const int item_ = 2 * (pair_) + hb, c_ = (item_ >> 3) & 127, b_ = item_ >> 10; const size_t tok0_ = (size_t)b_ * SEQ + c_ * 64; \
        int lq_ = F.lane; asm volatile("" : "+v"(lq_)); size_t wsq_ = (size_t)ws; asm volatile("" : "+s"(wsq_)); const int t9q_ = (hb << 8) | (w4 << 6) | lq_; \
        const RGAS bf16* cur_ = (const RGAS bf16*)(wsq_ + WS_PROJ) + (tok0_ + (t9q_ >> 3)) * INC + PRW + 1536 + 8 * (t9q_ & 7); \
        _Pragma("unroll") for (int g8 = 0; g8 < 4; ++g8) s0c[g8] = *(const RGAS v4u*)(cur_ + 64 * g8); } while (0)
    if (F.bid < NITEM / 2) RA_REQUEST(F.bid);
    for (int pair = F.bid; pair < NITEM / 2; pair += F.G) {
        size_t wsb = (size_t)ws; asm volatile("" : "+s"(wsb)); const RGAS bf16* proj = (const RGAS bf16*)(wsb + WS_PROJ);
        int l = F.lane; asm volatile("" : "+v"(l));
        const int n16 = l & 15, q = l >> 4, t4 = (hb << 8 | (F.wave & 3) << 6 | l) & 255;
        const int tokl = 16 * w4 + n16;
        const int tslot = (tokl & 32) + 8 * ((tokl >> 2) & 3) + 4 * ((tokl >> 4) & 1) + (tokl & 3);
        const int item = 2 * pair + hb, h = item & 7, c = (item >> 3) & 127, b = item >> 10;
        const size_t tok0 = (size_t)b * SEQ + c * 64; unsigned char* rbi = rb + (size_t)item * RB_REC;
        const int t9 = (hb << 8) | t4, tk0 = t9 >> 3, part = t9 & 7;
        f32x4 mu0[4][2];
#pragma unroll
        for (int g8 = 0; g8 < 4; ++g8) { mu0[g8][0] = *(const f32x4*)(mu + 1536 + 64 * g8 + 8 * part); mu0[g8][1] = *(const f32x4*)(mu + 1536 + 64 * g8 + 8 * part + 4); }
        v4u s0p[4];
        { const bool first = (c == 0 && tk0 == 0); const RGAS bf16* prv = proj + (tok0 + tk0) * INC + PRW + 1536 + 8 * part - (first ? 0 : INC);
#pragma unroll
          for (int g8 = 0; g8 < 4; ++g8) { const v4u t_ = *(const RGAS v4u*)(prv + 64 * g8); s0p[g8] = first ? (v4u){0u, 0u, 0u, 0u} : t_; } }
        v4u rawL[3][2]; v2u pfix;
        {
          const RGAS bf16* cur8 = proj + (tok0 + tokl) * INC + PRW + h * 64 + 4 * (q & 2) + 32 * (q & 1);
#pragma unroll
          for (int m = 0; m < 3; ++m) { rawL[m][0] = *(const RGAS v4u*)(cur8 + 512 * m); rawL[m][1] = *(const RGAS v4u*)(cur8 + 512 * m + 16); }
          const bool nofix = (c == 0 && w4 == 0) || n16 >= 12;
          const RGAS bf16* pp = proj + (tok0 + 16 * w4 - (nofix ? 0 : 1)) * INC + PRW + h * 64 + 4 * q + 512 * (n16 >> 2 & 3) + 16 * (n16 & 3);
          const v2u t_ = *(const RGAS v2u*)pp; pfix = nofix ? (v2u){0u, 0u} : t_; }
        __syncthreads();
#define RA_WOFF(f_) ((f_) < 27 ? RA_VT + (f_) * 1024 : RA_AAB + 1024 + ((f_) - 27) * 1024)
        LAS unsigned char* pbase = hbase + RA_PARW + w4 * 2560;
        { const int sl_ = l >> 4, c4_ = 4 * (l & 15);
#pragma unroll
          for (int j = 0; j < 3; ++j) { const int k_ = 4 * j + sl_;
              const float* s_ = k_ < 7 ? par + k_ * 512 + h * 64 + c4_ : (k_ < 10 ? mu + 512 * (k_ - 7) + h * 64 + c4_ : par + (k_ - 10) * 512 + h * 64 + c4_);
              __builtin_amdgcn_global_load_lds((const unsigned*)s_, (LAS unsigned*)(pbase + j * 1024), 16, 0, 0); } }
        { const int row_ = h * 64 + 16 * w4 + n16;
          const bf16* src_[8] = {wdec + row_ * 64 + 8 * q, wdec + row_ * 64 + 32 + 8 * q, waaa + row_ * 64 + 8 * q, waaa + row_ * 64 + 32 + 8 * q,
                                 wgate + row_ * 128 + 8 * q, wgate + row_ * 128 + 32 + 8 * q, wgate + row_ * 128 + 64 + 8 * q, wgate + row_ * 128 + 96 + 8 * q};
#pragma unroll
          for (int p = 0; p < 8; ++p) { const int f_ = w4 * 8 + p;
              __builtin_amdgcn_global_load_lds((const unsigned*)src_[p], (LAS unsigned*)(hbase + (f_ < 27 ? RA_VT + f_ * 1024 : RA_AAB + 1024 + (f_ - 27) * 1024)), 16, 0, 0); } }
        {
#pragma unroll
          for (int g8 = 0; g8 < 4; ++g8) {
              const float esc = g8 == 0 ? 2.8853900817779268f : -1.4426950408889634f;
              LAS unsigned char* dst = F.lds + (g8 == 0 ? RA_XWD + tk0 * 144 : (g8 == 1 ? RA_XAD + tk0 * 144 : RA_XGD + tk0 * 272 + (g8 - 2) * 128)) + part * 16;
              const unsigned xw[4] = {s0c[g8].x, s0c[g8].y, s0c[g8].z, s0c[g8].w}, pw[4] = {s0p[g8].x, s0p[g8].y, s0p[g8].z, s0p[g8].w};
              const f32x4 m0 = mu0[g8][0], m1 = mu0[g8][1];
              float y[8];
#pragma unroll
              for (int j = 0; j < 8; ++j) { const float x = (j & 1) ? bfhi(xw[j >> 1]) : bflo(xw[j >> 1]), p = (j & 1) ? bfhi(pw[j >> 1]) : bflo(pw[j >> 1]);
                  const float xs = x + (p - x) * (j < 4 ? m0[j & 3] : m1[j & 3]);
                  if (g8 == 1) y[j] = xs;
                  else { const float rc = __builtin_amdgcn_rcpf(1.0f + __builtin_amdgcn_exp2f(esc * xs)); y[j] = g8 == 0 ? 1.0f - 2.0f * rc : rc; } }
              const v4u o = {pk2(y[0], y[1]), pk2(y[2], y[3]), pk2(y[4], y[5]), pk2(y[6], y[7])};
              *(LAS v4u*)dst = o; } }
        asm volatile("s_waitcnt vmcnt(0)" ::: "memory");
        v2u shv[3][4];
#pragma unroll
        for (int m = 0; m < 3; ++m) { v2u rawc[4];
            { const v4u L0 = rawL[m][0], L1 = rawL[m][1];
              const auto a0 = __builtin_amdgcn_permlane16_swap(L0.x, L0.z, false, false), a1 = __builtin_amdgcn_permlane16_swap(L0.y, L0.w, false, false);
              const auto b0 = __builtin_amdgcn_permlane16_swap(L1.x, L1.z, false, false), b1 = __builtin_amdgcn_permlane16_swap(L1.y, L1.w, false, false);
              rawc[0] = (v2u){(unsigned)a0[0], (unsigned)a1[0]}; rawc[2] = (v2u){(unsigned)a0[1], (unsigned)a1[1]};
              rawc[1] = (v2u){(unsigned)b0[0], (unsigned)b1[0]}; rawc[3] = (v2u){(unsigned)b0[1], (unsigned)b1[1]}; }
#pragma unroll
            for (int ct = 0; ct < 4; ++ct) { const v2u xw = rawc[ct]; v2u pw;
                { constexpr int NOP_ = 0; (void)NOP_; const int k_ = 4 * m + ct;
                  unsigned fx = pfix.x, fy = pfix.y;
                  if (k_ > 0) { fx = row_shl_k(pfix.x, k_); fy = row_shl_k(pfix.y, k_); }
                  pw.x = (unsigned)__builtin_amdgcn_update_dpp((int)fx, (int)xw.x, 0x111, 0xf, 0xf, false); pw.y = (unsigned)__builtin_amdgcn_update_dpp((int)fy, (int)xw.y, 0x111, 0xf, 0xf, false); }
                const f32x4 mm = *(const LAS f32x4*)(pbase + (7 + m) * 256 + (16 * ct + 4 * q) * 4);
                const float x0 = bflo(xw.x), x1 = bfhi(xw.x), x2 = bflo(xw.y), x3 = bfhi(xw.y);
                shv[m][ct].x = pk2(x0 + (bflo(pw.x) - x0) * mm[0], x1 + (bfhi(pw.x) - x1) * mm[1]); shv[m][ct].y = pk2(x2 + (bflo(pw.y) - x2) * mm[2], x3 + (bfhi(pw.y) - x3) * mm[3]); } }
        asm volatile("s_waitcnt vmcnt(0)" ::: "memory");
        __syncthreads();
        f32x4 awl[4], aal[4], ag[4];
        { bf16x8 bwd[2], bad[2], bgd[4];
#pragma unroll
          for (int ks = 0; ks < 2; ++ks) { bwd[ks] = *(const LAS bf16x8*)(F.lds + RA_XWD + tokl * 144 + 64 * ks + 16 * q); bad[ks] = *(const LAS bf16x8*)(F.lds + RA_XAD + tokl * 144 + 64 * ks + 16 * q); }
#pragma unroll
          for (int ks = 0; ks < 4; ++ks) bgd[ks] = *(const LAS bf16x8*)(F.lds + RA_XGD + tokl * 272 + 64 * ks + 16 * q);
#pragma unroll
          for (int ct = 0; ct < 4; ++ct) { bf16x8 wv[8];
#pragma unroll
              for (int p = 0; p < 8; ++p) wv[p] = *(const LAS bf16x8*)(hbase + RA_WOFF(ct * 8 + p) + l * 16);
              awl[ct] = (f32x4){0.f, 0.f, 0.f, 0.f}; aal[ct] = awl[ct]; ag[ct] = awl[ct];
#pragma unroll
              for (int ks = 0; ks < 2; ++ks) { awl[ct] = MFMA16(wv[ks], bwd[ks], awl[ct]); aal[ct] = MFMA16(wv[2 + ks], bad[ks], aal[ct]); }
#pragma unroll
              for (int ks = 0; ks < 4; ++ks) ag[ct] = MFMA16(wv[4 + ks], bgd[ks], ag[ct]); } }
#undef RA_WOFF
        v2u rtp[4];
        {
#define RA_SHIFT(dst, pcol, ctv) do { const v2u w_ = shv[(pcol) / 512][ctv]; dst[0] = bflo(w_.x); dst[1] = bfhi(w_.x); dst[2] = bflo(w_.y); dst[3] = bfhi(w_.y); } while (0)
          float nrm = 0.f, bd = 0.f;
#pragma unroll
          for (int ct = 0; ct < 4; ++ct) { const int ch = h * 64 + 16 * ct + 4 * q;
              float r4[4], k4[4]; RA_SHIFT(r4, 0, ct); RA_SHIFT(k4, 512, ct);
              const LAS unsigned char* pc_ = pbase + (16 * ct + 4 * q) * 4; (void)ch;
              const f32x4 a0v = *(const LAS f32x4*)(pc_ + 256), kkv = *(const LAS f32x4*)(pc_ + 512), kav = *(const LAS f32x4*)(pc_ + 768), rkv = *(const LAS f32x4*)(pc_ + 1024);
#pragma unroll
              for (int i = 0; i < 4; ++i) { const float av = fast_sigmoid(a0v[i] + aal[ct][i]); const float kk = k4[i] * kkv[i]; nrm += kk * kk;
                  bd += r4[i] * (k4[i] * (1.0f + (av - 1.0f) * kav[i])) * rkv[i]; } }
          nrm = quad_sum(nrm); bd = quad_sum(bd);
          const float kinv = 1.0f / fmaxf(sqrtf(nrm), 1e-12f);
          float lw[4][4], lg[4][4], lgend[4][4];
#pragma unroll
          for (int ct = 0; ct < 4; ++ct) { const f32x4 w0v = *(const LAS f32x4*)(pbase + (16 * ct + 4 * q) * 4);
#pragma unroll
              for (int i = 0; i < 4; ++i) { lw[ct][i] = (-0.6065306597126334f * LOG2E) * fast_sigmoid(w0v[i] + awl[ct][i]); float x = lw[ct][i];
                  x += __builtin_bit_cast(float, __builtin_amdgcn_update_dpp(0, __builtin_bit_cast(int, x), 0x111, 0xf, 0xf, false));
                  x += __builtin_bit_cast(float, __builtin_amdgcn_update_dpp(0, __builtin_bit_cast(int, x), 0x112, 0xf, 0xf, false));
                  x += __builtin_bit_cast(float, __builtin_amdgcn_update_dpp(0, __builtin_bit_cast(int, x), 0x114, 0xf, 0xf, false));
                  x += __builtin_bit_cast(float, __builtin_amdgcn_update_dpp(0, __builtin_bit_cast(int, x), 0x118, 0xf, 0xf, false));
                  lg[ct][i] = x; } }
          LAS float* wt = (LAS float*)(hbase + RA_WT);
          if (n16 == 15) {
#pragma unroll
              for (int ct = 0; ct < 4; ++ct) *(LAS f32x4*)(wt + w4 * 64 + 16 * ct + 4 * q) = (f32x4){lg[ct][0], lg[ct][1], lg[ct][2], lg[ct][3]}; }
          __syncthreads();
#pragma unroll
          for (int ct = 0; ct < 4; ++ct) { f32x4 off = {0.f, 0.f, 0.f, 0.f}, tot = {0.f, 0.f, 0.f, 0.f};
#pragma unroll
              for (int w = 0; w < 4; ++w) { const f32x4 t = *(const LAS f32x4*)(wt + w * 64 + 16 * ct + 4 * q); tot = tot + t; if (w < w4) off = off + t; }
#pragma unroll
              for (int i = 0; i < 4; ++i) { lg[ct][i] += off[i]; lgend[ct][i] = tot[i]; } }
#pragma unroll
          for (int ct = 0; ct < 4; ++ct) { const int ch = h * 64 + 16 * ct + 4 * q;
              float r4[4], k4[4], v4[4]; RA_SHIFT(r4, 0, ct); RA_SHIFT(k4, 512, ct); RA_SHIFT(v4, 1024, ct);
              const LAS unsigned char* pc_ = pbase + (16 * ct + 4 * q) * 4; (void)ch;
              const f32x4 a0v = *(const LAS f32x4*)(pc_ + 256), kkv = *(const LAS f32x4*)(pc_ + 512), kav = *(const LAS f32x4*)(pc_ + 768);
              const f32x4 lg_ = *(const LAS f32x4*)(pc_ + 1280), lb_ = *(const LAS f32x4*)(pc_ + 1536);
              float rtl[4], ktl[4], btl[4], atl[4], khh[4], bhh[4], g1[4], e2[4];
#pragma unroll
              for (int i = 0; i < 4; ++i) {
                  const float av = fast_sigmoid(a0v[i] + aal[ct][i]); const float k2 = k4[i] * (1.0f + (av - 1.0f) * kav[i]);
                  const float kkn = k4[i] * kkv[i] * kinv, bb = kkn * av;
                  const float gam = __builtin_amdgcn_exp2f(lg[ct][i]), gpv = __builtin_amdgcn_exp2f(lg[ct][i] - lw[ct][i]), gin = __builtin_amdgcn_exp2f(-lg[ct][i]), ger = __builtin_amdgcn_exp2f(lgend[ct][i] - lg[ct][i]);
                  rtl[i] = r4[i] * gam; ktl[i] = k2 * gin; btl[i] = bb * gin; atl[i] = -kkn * gpv; khh[i] = k2 * ger; bhh[i] = bb * ger;
                  const float g = ag[ct][i]; g1[i] = lg_[i] * g; e2[i] = (lb_[i] + bd * v4[i]) * g;
              }
              const int fo = ((w4 * 4 + ct) * 64 + l) * 8;
              v2u o; o.x = pk2(g1[0], g1[1]); o.y = pk2(g1[2], g1[3]); __builtin_nontemporal_store(o, (v2u*)(rbi + RB_G1T + fo));
              o.x = pk2(e2[0], e2[1]); o.y = pk2(e2[2], e2[3]); __builtin_nontemporal_store(o, (v2u*)(rbi + RB_E2T + fo));
              const int co = tokl * 144 + (16 * ct + 4 * q) * 2;
              o.x = pk2(rtl[0], rtl[1]); o.y = pk2(rtl[2], rtl[3]); *(LAS v2u*)(hbase + RA_RT + co) = o; rtp[ct] = o;
              o.x = pk2(ktl[0], ktl[1]); o.y = pk2(ktl[2], ktl[3]); *(LAS v2u*)(hbase + RA_KT + co) = o;
              o.x = pk2(btl[0], btl[1]); o.y = pk2(btl[2], btl[3]); *(LAS v2u*)(hbase + RA_BT + co) = o;
              o.x = pk2(atl[0], atl[1]); o.y = pk2(atl[2], atl[3]); *(LAS v2u*)(hbase + RA_AT + co) = o;
#pragma unroll
              for (int i = 0; i < 4; ++i) { const int ro = (16 * ct + 4 * q + i) * 144 + 2 * tslot;
                  if (tokl == 0) *(LAS float*)(hbase + RA_VT + (16 * ct + 4 * q + i) * 144 + 128) = __builtin_amdgcn_exp2f(lgend[ct][i]);
                  *(LAS unsigned short*)(hbase + RA_VT + ro) = (unsigned short)(pk2(v4[i], 0.f) & 0xffffu);
                  *(LAS unsigned short*)(hbase + RA_KH + ro) = (unsigned short)(pk2(khh[i], 0.f) & 0xffffu);
                  *(LAS unsigned short*)(hbase + RA_BH + ro) = (unsigned short)(pk2(bhh[i], 0.f) & 0xffffu); }
              asm volatile("" ::: "memory");
          }
#undef RA_SHIFT
        }
        __syncthreads();
        bf16x8 akp[2], rkp[2], rbp[2];
        { bf16x8 fa[2], fr[2];
#pragma unroll
          for (int ks = 0; ks < 2; ++ks) { fa[ks] = *(const LAS bf16x8*)(hbase + RA_AT + tokl * 144 + 64 * ks + 16 * q); fr[ks] = *(const LAS bf16x8*)(hbase + RA_RT + tokl * 144 + 64 * ks + 16 * q); }
          f32x4 aak[4], arkk[4], arb[4];
#pragma unroll
          for (int jt = 0; jt < 4; ++jt) {
              f32x4 tab = {0.f, 0.f, 0.f, 0.f}; aak[jt] = tab; arkk[jt] = tab; arb[jt] = tab;
              if (jt <= w4) {
#pragma unroll
                  for (int ks = 0; ks < 2; ++ks) { const bf16x8 fk = *(const LAS bf16x8*)(hbase + RA_KT + (16 * jt + n16) * 144 + 64 * ks + 16 * q), fb = *(const LAS bf16x8*)(hbase + RA_BT + (16 * jt + n16) * 144 + 64 * ks + 16 * q);
                      aak[jt] = MFMA16(fk, fa[ks], aak[jt]); tab = MFMA16(fb, fa[ks], tab); arkk[jt] = MFMA16(fk, fr[ks], arkk[jt]); arb[jt] = MFMA16(fb, fr[ks], arb[jt]); }
                  if (jt == w4) {
#pragma unroll
                      for (int i = 0; i < 4; ++i) { const int j = 4 * q + i; if (j >= n16) { aak[jt][i] = 0.f; tab[i] = 0.f; } if (j > n16) { arkk[jt][i] = 0.f; arb[jt][i] = 0.f; } } }
                  *(LAS f32x4*)(hbase + RA_AAB + tokl * 256 + (16 * jt + 4 * q) * 4) = tab;
              }
          }
#pragma unroll
          for (int s = 0; s < 2; ++s) { akp[s] = pack8(aak[2 * s], aak[2 * s + 1]); rkp[s] = pack8(arkk[2 * s], arkk[2 * s + 1]); rbp[s] = pack8(arb[2 * s], arb[2 * s + 1]); } }
        { f32x4 akv[4];
#pragma unroll
          for (int vt = 0; vt < 4; ++vt) { akv[vt] = (f32x4){0.f, 0.f, 0.f, 0.f};
#pragma unroll
              for (int s = 0; s < 2; ++s) { const bf16x8 fv = *(const LAS bf16x8*)(hbase + RA_VT + (16 * vt + n16) * 144 + 64 * s + 16 * q); akv[vt] = MFMA16(akp[s], fv, akv[vt]); } }
          __syncthreads();
#pragma unroll
          for (int vt = 0; vt < 4; ++vt) *(LAS f32x4*)(hbase + RA_RHS2 + (16 * vt + n16) * 272 + (16 * w4 + 4 * q) * 4) = akv[vt]; }
        if (pair + F.G < NITEM / 2) RA_REQUEST(pair + F.G);
        { const LAS unsigned char* aab = hbase + RA_AAB + (16 * w4) * 256 + (16 * w4) * 4;
          LAS unsigned char* ti = hbase + RA_BT;
          if (q == 0) { float t[16];
#pragma unroll
              for (int r_ = 0; r_ < 16; ++r_) { float acc = (r_ == n16) ? 1.0f : 0.0f;
#pragma unroll
                  for (int j4 = 0; j4 < (r_ + 3) / 4; ++j4) { const f32x4 av = *(const LAS f32x4*)(aab + r_ * 256 + j4 * 16);
#pragma unroll
                      for (int e = 0; e < 4; ++e) if (4 * j4 + e < r_) acc += av[e] * t[4 * j4 + e]; }
                  t[r_] = acc; *(LAS unsigned short*)(ti + w4 * 512 + r_ * 32 + 2 * n16) = (unsigned short)(pk2(acc, 0.f) & 0xffffu); } }
          __syncthreads();
          bf16x8 a10, a20, a30, a31, tf[4];
          { const LAS unsigned char* ab = hbase + RA_AAB + n16 * 256 + 16 * q; const f32x4 z4 = {0.f, 0.f, 0.f, 0.f};
            const f32x4 l10 = *(const LAS f32x4*)(ab + 16 * 256), l20 = *(const LAS f32x4*)(ab + 32 * 256), l21 = *(const LAS f32x4*)(ab + 32 * 256 + 64);
            const f32x4 l30 = *(const LAS f32x4*)(ab + 48 * 256), l31 = *(const LAS f32x4*)(ab + 48 * 256 + 64), l32 = *(const LAS f32x4*)(ab + 48 * 256 + 128);
            a10 = pack8(l10, z4); a20 = pack8(l20, l21); a30 = pack8(l30, l31); a31 = pack8(l32, z4);
#pragma unroll
            for (int I = 0; I < 4; ++I) { const v2u tw = *(const LAS v2u*)(ti + I * 512 + n16 * 32 + 8 * q); const v4u t4 = {tw.x, tw.y, 0u, 0u}; tf[I] = __builtin_bit_cast(bf16x8, t4); } }
          v4u xw[2][2];
#pragma unroll
          for (int m = 0; m < 2; ++m) {
              v4u x0 = {0u, 0u, 0u, 0u}, x1 = {0u, 0u, 0u, 0u};
#pragma unroll
              for (int I = 0; I < 4; ++I) {
                  f32x4 z;
                  if (m == 0) {
#pragma unroll
                      for (int i = 0; i < 4; ++i) z[i] = bf2f(*(const LAS unsigned short*)(hbase + RA_AT + (16 * I + 4 * q + i) * 144 + 2 * tokl)); }
                  else z = *(const LAS f32x4*)(hbase + RA_RHS2 + tokl * 272 + (16 * I + 4 * q) * 4);
                  if (I == 1) z = MFMA16(a10, __builtin_bit_cast(bf16x8, x0), z);
                  if (I == 2) z = MFMA16(a20, __builtin_bit_cast(bf16x8, x0), z);
                  if (I == 3) { z = MFMA16(a30, __builtin_bit_cast(bf16x8, x0), z); z = MFMA16(a31, __builtin_bit_cast(bf16x8, x1), z); }
                  const v4u zb = {pk2(z[0], z[1]), pk2(z[2], z[3]), 0u, 0u};
                  const f32x4 x = MFMA16(tf[I], __builtin_bit_cast(bf16x8, zb), ((f32x4){0.f, 0.f, 0.f, 0.f}));
                  const unsigned p0 = pk2(x[0], x[1]), p1 = pk2(x[2], x[3]);
                  if (I == 0) { x0.x = p0; x0.y = p1; } if (I == 1) { x0.z = p0; x0.w = p1; } if (I == 2) { x1.x = p0; x1.y = p1; } if (I == 3) { x1.z = p0; x1.w = p1; }
              }
              xw[m][0] = x0; xw[m][1] = x1;
          }
          __syncthreads();
#pragma unroll
          for (int s = 0; s < 2; ++s) { *(LAS v4u*)(hbase + RA_W1T + tokl * 144 + 64 * s + 16 * q) = xw[0][s]; *(LAS v4u*)(hbase + RA_W2T + tokl * 144 + 64 * s + 16 * q) = xw[1][s]; }
        }
        __syncthreads();
        {
          f32x4 pc[4], y0[4];
#pragma unroll
          for (int t = 0; t < 4; ++t) { pc[t] = (f32x4){bflo(rtp[t].x), bfhi(rtp[t].x), bflo(rtp[t].y), bfhi(rtp[t].y)}; y0[t] = (f32x4){0.f, 0.f, 0.f, 0.f};
#pragma unroll
              for (int s = 0; s < 2; ++s) { y0[t] = MFMA16(*(const LAS bf16x8*)(hbase + RA_VT + (16 * t + n16) * 144 + 64 * s + 16 * q), rkp[s], y0[t]);
                                            y0[t] = MFMA16(*(const LAS bf16x8*)(hbase + RA_W2T + (16 * t + n16) * 144 + 64 * s + 16 * q), rbp[s], y0[t]);
                                            pc[t] = MFMA16(*(const LAS bf16x8*)(hbase + RA_W1T + (16 * t + n16) * 144 + 64 * s + 16 * q), rbp[s], pc[t]); } }
#pragma unroll
          for (int vt = 0; vt < 4; ++vt) { v2u o; o.x = pk2(y0[vt][0], y0[vt][1]); o.y = pk2(y0[vt][2], y0[vt][3]); __builtin_nontemporal_store(o, (v2u*)(rbi + RB_YLT + ((w4 * 4 + vt) * 64 + l) * 8)); }
#pragma unroll
          for (int s = 0; s < 2; ++s) __builtin_nontemporal_store(pack8(pc[2 * s], pc[2 * s + 1]), (bf16x8*)(rbi + RB_PCT + ((w4 * 2 + s) * 64 + l) * 16));
          f32x4 mc[4]; bf16x8 fb[2], fvv[2];
#pragma unroll
          for (int s = 0; s < 2; ++s) { fb[s] = *(const LAS bf16x8*)(hbase + RA_BH + tokl * 144 + 64 * s + 16 * q); fvv[s] = *(const LAS bf16x8*)(hbase + RA_VT + tokl * 144 + 64 * s + 16 * q); }
          const float gend_k = *(const LAS float*)(hbase + RA_VT + tokl * 144 + 128);
#pragma unroll
          for (int t = 0; t < 4; ++t) { mc[t] = (f32x4){0.f, 0.f, 0.f, 0.f};
#pragma unroll
              for (int s = 0; s < 2; ++s) mc[t] = MFMA16(*(const LAS bf16x8*)(hbase + RA_W1T + (16 * t + n16) * 144 + 64 * s + 16 * q), fb[s], mc[t]);
              if (t == w4) {
#pragma unroll
                  for (int i = 0; i < 4; ++i) if (4 * q + i == n16) mc[t][i] += gend_k; } }
#pragma unroll
          for (int s = 0; s < 2; ++s) __builtin_nontemporal_store(pack8(mc[2 * s], mc[2 * s + 1]), (bf16x8*)(rbi + RB_MC + ((w4 * 2 + s) * 64 + l) * 16));
          bf16x8 fw2[2];
#pragma unroll
          for (int s = 0; s < 2; ++s) fw2[s] = *(const LAS bf16x8*)(hbase + RA_W2T + tokl * 144 + 64 * s + 16 * q);
#pragma unroll
          for (int kt = 0; kt < 4; ++kt) { f32x4 cc = {0.f, 0.f, 0.f, 0.f};
#pragma unroll
              for (int s = 0; s < 2; ++s) { cc = MFMA16(*(const LAS bf16x8*)(hbase + RA_KH + (16 * kt + n16) * 144 + 64 * s + 16 * q), fvv[s], cc);
                                            cc = MFMA16(*(const LAS bf16x8*)(hbase + RA_BH + (16 * kt + n16) * 144 + 64 * s + 16 * q), fw2[s], cc); }
              v2u cw; cw.x = pk2(cc[0], cc[1]); cw.y = pk2(cc[2], cc[3]); __builtin_nontemporal_store(cw, (v2u*)(rbi + RB_CC + ((w4 * 4 + kt) * 64 + l) * 8)); } }
    }
}

constexpr int RBK_NS = 9, RBK_D = 8, RBK_SLOT = 16384, RBK_BLOCKS = 32;
static_assert(RBK_NS * RBK_SLOT <= MISC_OFF && RBK_D == RBK_NS - 1, "phase B ring");
DI void rwkv_phase_b(const Frame& F, CArgs& a) {
    if (F.bid >= RBK_BLOCKS) return;
    unsigned char* rb = a.ws + WS_RW; const int l = F.lane, w = F.wave;
    const int h = F.bid & 7, b = F.bid >> 3;
    LAS unsigned char* lds = F.lds;
    if (w >= 4) {
        const int j = w - 4;
#define RBK_ISSUE(cc_) do { const int c_ = (cc_) < NCHUNK ? (cc_) : NCHUNK - 1; const unsigned char* r_ = rb + (size_t)(((b * 128 + c_) << 3) + h) * RB_REC; \
            LAS unsigned char* slot_ = lds + ((cc_) % RBK_NS) * RBK_SLOT; \
            _Pragma("unroll") for (int k_ = 0; k_ < 4; ++k_) { const int blk_ = 4 * j + k_; \
                const unsigned char* src_ = blk_ < 8 ? r_ + RB_MC + blk_ * 1024 : r_ + RB_CC + (blk_ - 8) * 1024; \
                __builtin_amdgcn_global_load_lds((const unsigned*)(src_ + l * 16), (LAS unsigned*)(slot_ + blk_ * 1024), 16, 0, 0); } } while (0)
#pragma unroll 1
        for (int c = 0; c < RBK_D; ++c) RBK_ISSUE(c);
        for (int c = 0; c < NCHUNK; ++c) {
            asm volatile("s_waitcnt vmcnt(28)" ::: "memory");
            __builtin_amdgcn_s_barrier();
            RBK_ISSUE(c + RBK_D);
        }
        asm volatile("s_waitcnt vmcnt(0)" ::: "memory");
        __builtin_amdgcn_s_barrier();
#undef RBK_ISSUE
    } else {
        const int vs = w;
        f32x4 st[4];
#pragma unroll
        for (int kt = 0; kt < 4; ++kt) st[kt] = (f32x4){0.f, 0.f, 0.f, 0.f};
        for (int c = 0; c < NCHUNK; ++c) {
            unsigned char* rbi = rb + (size_t)(((b * 128 + c) << 3) + h) * RB_REC;
            bf16x8 sb[2];
#pragma unroll
            for (int s = 0; s < 2; ++s) { sb[s] = pack8(st[2 * s], st[2 * s + 1]); *(bf16x8*)(rbi + RB_SC + ((vs * 2 + s) * 64 + l) * 16) = sb[s]; }
            __builtin_amdgcn_s_barrier();
            const LAS unsigned char* slot = lds + (c % RBK_NS) * RBK_SLOT;
#pragma unroll
            for (int kt = 0; kt < 4; ++kt) { const v2u cw = *(const LAS v2u*)(slot + 8192 + ((vs * 4 + kt) * 64 + l) * 8);
                f32x4 n = {bflo(cw.x), bfhi(cw.x), bflo(cw.y), bfhi(cw.y)};
#pragma unroll
                for (int s = 0; s < 2; ++s) n = MFMA16(*(const LAS bf16x8*)(slot + ((kt * 2 + s) * 64 + l) * 16), sb[s], n);
                st[kt] = n; }
        }
        __builtin_amdgcn_s_barrier();
    }
}

struct RcOps { bf16x8 pc[2]; v2u yl[4]; bf16x8 sc[4][2]; v2u g1[4], e2[4]; };
DI void rc_load(RcOps& o, const unsigned char* rb, int task, int l) {
    const int item = task >> 2, it = task & 3; const unsigned char* rbi = rb + (size_t)item * RB_REC;
#pragma unroll
    for (int s = 0; s < 2; ++s) o.pc[s] = __builtin_nontemporal_load((const bf16x8*)(rbi + RB_PCT + ((it * 2 + s) * 64 + l) * 16));
#pragma unroll
    for (int vt = 0; vt < 4; ++vt) { const int fo = ((it * 4 + vt) * 64 + l) * 8;
        o.yl[vt] = __builtin_nontemporal_load((const v2u*)(rbi + RB_YLT + fo)); o.g1[vt] = __builtin_nontemporal_load((const v2u*)(rbi + RB_G1T + fo)); o.e2[vt] = __builtin_nontemporal_load((const v2u*)(rbi + RB_E2T + fo));
#pragma unroll
        for (int s = 0; s < 2; ++s) o.sc[vt][s] = __builtin_nontemporal_load((const bf16x8*)(rbi + RB_SC + ((vt * 2 + s) * 64 + l) * 16)); }
}
DI void rwkv_phase_c(const Frame& F, CArgs& a, int ticket) {
    const unsigned char* rb = a.ws + WS_RW; bf16* mix = (bf16*)(a.ws + WS_MIX);
    const int l = F.lane, n16 = l & 15, q = l >> 4;
    const int gw = F.bid * NWAVES + F.wave, NGW = F.G * NWAVES;
    constexpr int RC_NT = NITEM * 4;
    static_assert(RC_NT / 8 == 32 * 64, "phase C shares: 2048 units");
    int first = gw, stride = NGW, nst = gw < RC_NT ? (RC_NT - gw + NGW - 1) / NGW : 0;
    if (ticket >= 0 && ticket < 256 && F.G == 256 && NWAVES == 8) { const int cls = ticket >> 4, pos = ticket & 15;
        const int nu = (int)((0x556677888899aabbull >> (4 * cls)) & 15ull), pre = (int)(((cls < 8 ? 0x443c332a20160b00ull : 0x7b76706a635c544cull) >> (8 * (cls & 7))) & 255ull);
        first = (16 * pre + pos * nu) * 8 + F.wave; stride = 8; nst = nu; }
    RcOps cur, nxt;
    if (nst > 0) rc_load(cur, rb, first, l);
    for (int k = 0; k < nst; ++k) { const int task = first + k * stride;
        const int item = task >> 2, it = task & 3, h = item & 7, c = (item >> 3) & 127, b = item >> 10;
        if (k + 1 < nst) rc_load(nxt, rb, task + stride, l);
        f32x4 y[4]; float sum = 0.f;
#pragma unroll
        for (int vt = 0; vt < 4; ++vt) { y[vt] = (f32x4){bflo(cur.yl[vt].x), bfhi(cur.yl[vt].x), bflo(cur.yl[vt].y), bfhi(cur.yl[vt].y)};
#pragma unroll
            for (int s = 0; s < 2; ++s) y[vt] = MFMA16(cur.sc[vt][s], cur.pc[s], y[vt]);
            sum += (y[vt][0] + y[vt][1]) + (y[vt][2] + y[vt][3]); }
        sum = quad_sum(sum);
        const float mean = sum * (1.f / 64.f); float sq = 0.f;
#pragma unroll
        for (int vt = 0; vt < 4; ++vt) { y[vt] = y[vt] - mean; sq += (y[vt][0] * y[vt][0] + y[vt][1] * y[vt][1]) + (y[vt][2] * y[vt][2] + y[vt][3] * y[vt][3]); }
        sq = quad_sum(sq);
        const float rstd = 1.0f / sqrtf(sq * (1.f / 64.f) + 64e-5f);
        const size_t tok = (size_t)b * SEQ + c * 64 + 16 * it + n16;
#pragma unroll
        for (int vt = 0; vt < 4; ++vt) { const v2u g = cur.g1[vt], e = cur.e2[vt];
            v2u o; o.x = pk2(y[vt][0] * rstd * bflo(g.x) + bflo(e.x), y[vt][1] * rstd * bfhi(g.x) + bfhi(e.x)); o.y = pk2(y[vt][2] * rstd * bflo(g.y) + bflo(e.y), y[vt][3] * rstd * bfhi(g.y) + bfhi(e.y));
            *(v2u*)(mix + tok * 1024 + 512 + h * 64 + 16 * vt + 4 * q) = o; }
        cur = nxt;
    }
}
#endif

DI void p0_prologue(const Frame& F, CArgs& a) {
    unsigned char* ws = a.ws;
    LAS float* scr = (LAS float*)(F.lds + F.wave * 16384);
    const int gw = F.bid * NWAVES + F.wave, NGW = F.G * NWAVES;
    constexpr int I_IN = 0, I_OUT = 16 * 32, I_DEC = 16, I_AAA = 16, I_GATE = 32;
    constexpr int NITEMS = I_IN + I_OUT + I_DEC + I_AAA + I_GATE;
    for (int s = F.G - 1 - F.bid; s < INC / 32; s += F.G) { q_strip_i8_wg(a.in[I_WIN], INC, 32 * s, ws + WS_WIN, (float*)(ws + WS_COLSC1), F.wave, F.lane, (LAS float*)F.lds); __syncthreads(); }
    for (int it = gw; it < NITEMS; it += NGW) {
        int r = it;
        if (r < I_OUT) { const int kb = r / 32, nb = r % 32; tr_item(a.in[I_WOUT], 1024, 64 * kb, 32 * nb, (bf16*)(ws + WS_WOUT), 1024, 32 * nb, scr, F.lane, nullptr); continue; } r -= I_OUT;
        if (r < I_DEC) { tr_item(a.in[I_WDEC], 512, 0, 32 * r, (bf16*)(ws + WS_WDEC), 64, 32 * r, scr, F.lane, nullptr); continue; } r -= I_DEC;
        if (r < I_AAA) { tr_item(a.in[I_WAAA], 512, 0, 32 * r, (bf16*)(ws + WS_WAAA), 64, 32 * r, scr, F.lane, nullptr); continue; } r -= I_AAA;
        { const int kb = r / 16, nb = r % 16; tr_item(a.in[I_WGATE], 512, 64 * kb, 32 * nb, (bf16*)(ws + WS_WGATE), 128, 32 * nb, scr, F.lane, nullptr); }
    }
    { float* wrt = (float*)(ws + WS_WRT); const float* wr = a.in[I_WR]; const float* g2 = a.in[I_N2G];
      for (int i = F.bid * 512 + F.tid; i < 32 * 1024; i += F.G * 512) { const int e = i >> 10, k = i & 1023; wrt[i] = g2[k] * wr[k * 32 + e]; } }
    { float* par = (float*)(ws + WS_PAR); const int srcs[7] = {I_W0, I_A0, I_KK, I_KA, I_RK, I_LNG, I_LNB};
      for (int i = F.bid * 512 + F.tid; i < 7 * 512; i += F.G * 512) { const int k = i >> 9; float v = 0.f;
#pragma unroll
          for (int j = 0; j < 7; ++j) if (k == j) v = a.in[srcs[j]][i & 511];
          par[i] = v; } }
    { const float* x = a.in[I_X]; const float* g1 = a.in[I_N1G]; bf16* xn = (bf16*)(ws + WS_XN);
      f32x4 gv[4];
#pragma unroll
      for (int j = 0; j < 4; ++j) gv[j] = *((const f32x4*)g1 + F.lane + 64 * j);
      f32x4 v[2][4], vn[2][4];
#define P0_LOAD(dst_, m_) do { _Pragma("unroll") for (int r = 0; r < 2; ++r) { const f32x4* xr = (const f32x4*)(x + (size_t)((m_) + r) * D) + F.lane; \
          _Pragma("unroll") for (int j = 0; j < 4; ++j) dst_[r][j] = __builtin_nontemporal_load(xr + 64 * j); } } while (0)
      if (2 * gw < T) P0_LOAD(v, 2 * gw);
      for (int m0 = 2 * gw; m0 < T; m0 += 2 * NGW) {
          const int m1 = m0 + 2 * NGW;
          if (m1 < T) P0_LOAD(vn, m1);
#pragma unroll
          for (int r = 0; r < 2; ++r) { float s = 0.f;
#pragma unroll
              for (int j = 0; j < 4; ++j) s += (v[r][j].x * v[r][j].x + v[r][j].y * v[r][j].y) + (v[r][j].z * v[r][j].z + v[r][j].w * v[r][j].w);
              const float rs = 1.0f / sqrtf(wave_sum(s) * (1.f / D) + 1e-6f);
              f32x4 y[4]; float am = 0.f;
#pragma unroll
              for (int j = 0; j < 4; ++j) { y[j] = (v[r][j] * rs) * gv[j]; am = fmaxf(fmaxf(am, fmaxf(fabsf(y[j].x), fabsf(y[j].y))), fmaxf(fabsf(y[j].z), fabsf(y[j].w))); }
              am = wave_max(am); const float qi = am > 0.f ? 127.0f / am : 0.f;
              if (F.lane == 0) ((float*)(ws + WS_XNSC))[m0 + r] = am * (1.0f / 127.0f);
              unsigned* o4 = (unsigned*)((unsigned char*)xn + (size_t)(m0 + r) * D) + F.lane;
#pragma unroll
              for (int j = 0; j < 4; ++j) { const f32x4 qv = y[j] * qi + Q_MAGIC; o4[64 * j] = q_pack4(qv.x, qv.y, qv.z, qv.w); } }
#pragma unroll
          for (int r = 0; r < 2; ++r)
#pragma unroll
              for (int j = 0; j < 4; ++j) v[r][j] = vn[r][j];
      }
#undef P0_LOAD
    }
}

#if NAIVE_RWKV
DI void rwkv_naive_prep(const Frame& F, CArgs& a) {
    const bf16* proj = (const bf16*)(a.ws + WS_PROJ); LAS float* sx = (LAS float*)F.lds;
    float* RW = (float*)(a.ws + WS_RW); float* GG = (float*)(a.ws + WS_XN);
    const float* mu = a.in[I_MU]; const int c = F.tid;
    for (int t = F.bid; t < T; t += F.G) {
        const bool first = (t % SEQ) == 0; const bf16* cur = proj + (size_t)t * INC + PRW; const bf16* prv = cur - INC;
#define SH_(col) ({ const float x_ = bf2f(cur[col]); const float p_ = first ? 0.f : bf2f(prv[col]); x_ + (p_ - x_) * mu[col]; })
        if (c < 256) { const float v = SH_(1536 + c); sx[c] = c < 64 ? tanhf(v) : (c < 128 ? v : sigmoidf_(v)); }
        __syncthreads();
        const float r = SH_(c), k = SH_(512 + c), v = SH_(1024 + c);
#undef SH_
        float wl = a.in[I_W0][c], al = a.in[I_A0][c], g = 0.f;
        const float* wdec = a.in[I_WDEC] + c; const float* waaa = a.in[I_WAAA] + c; const float* wgate = a.in[I_WGATE] + c;
#pragma unroll 4
        for (int j = 0; j < 64; ++j) { wl += sx[j] * wdec[j * 512]; al += sx[64 + j] * waaa[j * 512]; }
#pragma unroll 4
        for (int j = 0; j < 128; ++j) g += sx[128 + j] * wgate[j * 512];
        const float dec = __expf(-0.6065306597126334f * sigmoidf_(wl)), av = sigmoidf_(al);
        float kk = k * a.in[I_KK][c]; const float n2 = wave_sum(kk * kk); kk = kk / fmaxf(sqrtf(n2), 1e-12f);
        const float k2 = k * (1.0f + (av - 1.0f) * a.in[I_KA][c]);
        const size_t o = (size_t)t * 512 + c; const size_t S1 = (size_t)T * 512;
        RW[o] = r; RW[S1 + o] = dec; RW[2 * S1 + o] = k2; RW[3 * S1 + o] = v; RW[4 * S1 + o] = kk; RW[5 * S1 + o] = av; GG[o] = g;
        __syncthreads();
    }
}
DI void rwkv_naive_scan(const Frame& F, CArgs& a) {
    if (F.bid >= 32 || F.wave != 0) return;
    const int b = F.bid >> 3, h = F.bid & 7, l = F.lane, c = h * 64 + l;
    const float* RW = (const float*)(a.ws + WS_RW); const float* GG = (const float*)(a.ws + WS_XN); bf16* mix = (bf16*)(a.ws + WS_MIX);
    const size_t S1 = (size_t)T * 512; LAS float* sh = (LAS float*)F.lds;
    LAS float* st = sh + 512 + l;
    for (int k = 0; k < 64; ++k) st[64 * k] = 0.f;
    const float rk = a.in[I_RK][c], lg = a.in[I_LNG][c], lb = a.in[I_LNB][c];
    for (int s = 0; s < SEQ; ++s) {
        const size_t o = (size_t)(b * SEQ + s) * 512 + c;
        const float r = RW[o], w = RW[S1 + o], k2 = RW[2 * S1 + o], v = RW[3 * S1 + o], kk = RW[4 * S1 + o], av = RW[5 * S1 + o], g = GG[o];
        sh[l] = r; sh[64 + l] = w; sh[128 + l] = k2; sh[192 + l] = kk; sh[256 + l] = kk * av;
        LDS_WAIT();
        float sa = 0.f;
#pragma unroll 8
        for (int k = 0; k < 64; ++k) sa -= st[64 * k] * sh[192 + k];
        float y = 0.f;
#pragma unroll 8
        for (int k = 0; k < 64; ++k) { const float nv = st[64 * k] * sh[64 + k] + sa * sh[256 + k] + v * sh[128 + k]; st[64 * k] = nv; y += nv * sh[k]; }
        LDS_WAIT();
        const float mean = wave_sum(y) * (1.f / 64.f); const float d = y - mean; const float var = wave_sum(d * d) * (1.f / 64.f);
        const float yn = d * (1.0f / sqrtf(var + 64e-5f));
        const float bonus = wave_sum(r * k2 * rk) * v;
        const float outv = (yn * lg + lb + bonus) * g;
        mix[(size_t)(b * SEQ + s) * 1024 + 512 + c] = (bf16)(pk2(outv, 0.f) & 0xffffu);
    }
}
#endif
#if NAIVE_ATT
DI void attn_naive(const Frame& F, CArgs& a) {
    const bf16* proj = (const bf16*)(a.ws + WS_PROJ); bf16* mix = (bf16*)(a.ws + WS_MIX);
    LAS float* sq = (LAS float*)(F.lds + F.wave * 1024);
    const int gw = F.bid * NWAVES + F.wave, NGW = F.G * NWAVES, l = F.lane;
    const float qg = a.in[I_QG][l];
    for (int it = gw; it < T * 8; it += NGW) {
        const int t = it >> 3, h = it & 7, b = t / SEQ, s = t % SEQ, n = s >> 6;
        const float qd = bf2f(proj[(size_t)t * INC + h * 64 + l]);
        const float qn = qd * (1.0f / sqrtf(wave_sum(qd * qd) * (1.f / 64.f) + 1e-6f)) * qg * 0.125f;
        sq[l] = qn; LDS_WAIT();
        float sc[9]; float mx = -3.0e38f;
#pragma unroll
        for (int r = 0; r < 9; ++r) {
            const int kp = (n - 8) * 64 + 64 * r + l; float v = -3.0e38f;
            if (kp >= 0) {
                const v4u* kr = (const v4u*)(proj + (size_t)(b * SEQ + kp) * INC + 512 + h * 64);
                float ss = 0.f, dot = 0.f;
#pragma unroll
                for (int j = 0; j < 8; ++j) { const v4u w = kr[j]; const unsigned ww[4] = {w.x, w.y, w.z, w.w};
#pragma unroll
                    for (int e = 0; e < 4; ++e) { const float k0 = bflo(ww[e]), k1 = bfhi(ww[e]); const int d0 = 8 * j + 2 * e;
                        ss += k0 * k0 + k1 * k1; dot += sq[d0] * a.in[I_KG][d0] * k0 + sq[d0 + 1] * a.in[I_KG][d0 + 1] * k1; } }
                int rel = kp - s; rel = rel < -128 ? -128 : (rel > 63 ? 63 : rel);
                v = dot * (1.0f / sqrtf(ss * (1.f / 64.f) + 1e-6f)) + a.in[I_RELB][h * 192 + rel + 128];
            }
            sc[r] = v; mx = fmaxf(mx, v);
        }
        mx = wave_max(mx); float sum = 0.f;
#pragma unroll
        for (int r = 0; r < 9; ++r) { sc[r] = (sc[r] > -1.0e38f) ? __expf(sc[r] - mx) : 0.f; sum += sc[r]; }
        sum = wave_sum(sum);
        float o = 0.f;
#pragma unroll
        for (int r = 0; r < 9; ++r) {
            const int kp0 = (n - 8) * 64 + 64 * r;
            if (kp0 >= 0) {
                const bf16* vp = proj + (size_t)(b * SEQ + kp0) * INC + 1024 + h * 64 + l;
                for (int key = 0; key < 64; ++key) o += __shfl(sc[r], key) * bf2f(vp[(size_t)key * INC]);
            }
        }
        mix[(size_t)t * 1024 + h * 64 + l] = (bf16)(pk2(o / sum, 0.f) & 0xffffu);
        LDS_WAIT();
    }
}
#endif

DI void p6_router(const Frame& F, CArgs& a) {
    unsigned char* ws = a.ws; const bf16* x1 = (const bf16*)(ws + WS_XN); const float* wrt = (const float*)(ws + WS_WRT); const float* br = a.in[I_BR];
    int* eidx = (int*)(ws + WS_EIDX); float* gate = (float*)(ws + WS_GATE); int* lrank = (int*)(ws + WS_LRANK); float* rstd = (float*)(ws + WS_RSTD); int* cnt = (int*)(ws + WS_CNT);
    constexpr int WROW = 2064, WIMG = 32 * WROW;
    LAS int* hist = (LAS int*)(F.lds + 2 * WIMG);
    const int n = F.lane & 15, q = F.lane >> 4;
    v4u xh[2][16];
    { const int tok_ = (F.bid < T / 128 ? F.bid : 0) * 128 + F.wave * 16 + n; const v4u* xr_ = (const v4u*)(x1 + (size_t)tok_ * D) + q;
#pragma unroll
      for (int s = 0; s < 32; ++s) xh[s >> 4][s & 15] = xr_[4 * s]; }
    static_assert(32 * 256 == 16 * NWAVES * 64, "router image: 16 pieces per thread");
    { f32x4 wv[16];
#pragma unroll
      for (int j = 0; j < 16; ++j) { const int i = F.tid + j * (NWAVES * 64); wv[j] = *((const f32x4*)(wrt + (size_t)(i >> 8) * D) + (i & 255)); }
#pragma unroll
      for (int j = 0; j < 16; ++j) { const int i = F.tid + j * (NWAVES * 64); const int e = i >> 8, c4 = i & 255; const f32x4 w = wv[j];
        v2u hi, lo; hi.x = pk2(w[0], w[1]); hi.y = pk2(w[2], w[3]);
        lo.x = pk2(w[0] - bflo(hi.x), w[1] - bfhi(hi.x)); lo.y = pk2(w[2] - bflo(hi.y), w[3] - bfhi(hi.y));
        *(LAS v2u*)(F.lds + e * WROW + c4 * 8) = hi; *(LAS v2u*)(F.lds + WIMG + e * WROW + c4 * 8) = lo; } }
    __syncthreads();
    for (int tile = F.bid; tile < T / 128; tile += F.G) {
        if (F.tid < 32) hist[F.tid] = 0;
        __syncthreads();
        const int tok = tile * 128 + F.wave * 16 + n;
        const v4u* xr = (const v4u*)(x1 + (size_t)tok * D) + q; const LAS unsigned char* w0 = F.lds + n * WROW + 16 * q;
        f32x4 acc0 = {0.f, 0.f, 0.f, 0.f}, acc1 = {0.f, 0.f, 0.f, 0.f}; float ssq = 0.f, amax = 0.f;
#pragma unroll
        for (int S0 = 0; S0 < 32; S0 += 16) {
            const v4u (&xw)[16] = xh[S0 >> 4];
#pragma unroll
            for (int s = 0; s < 16; ++s) { const bf16x8 xb8 = __builtin_bit_cast(bf16x8, xw[s]); const LAS unsigned char* wp = w0 + (S0 + s) * 64;
                const unsigned u[4] = {xw[s].x, xw[s].y, xw[s].z, xw[s].w};
#pragma unroll
                for (int j = 0; j < 4; ++j) { const float a = bflo(u[j]), b = bfhi(u[j]); ssq += a * a + b * b; amax = fmaxf(amax, fmaxf(fabsf(a), fabsf(b))); }
                acc0 = __builtin_amdgcn_mfma_f32_16x16x32_bf16(*(const LAS bf16x8*)(wp), xb8, acc0, 0, 0, 0);
                acc0 = __builtin_amdgcn_mfma_f32_16x16x32_bf16(*(const LAS bf16x8*)(wp + WIMG), xb8, acc0, 0, 0, 0);
                acc1 = __builtin_amdgcn_mfma_f32_16x16x32_bf16(*(const LAS bf16x8*)(wp + 16 * WROW), xb8, acc1, 0, 0, 0);
                acc1 = __builtin_amdgcn_mfma_f32_16x16x32_bf16(*(const LAS bf16x8*)(wp + WIMG + 16 * WROW), xb8, acc1, 0, 0, 0); }
        }
        ssq = quad_sum(ssq); amax = quad_max(amax);
        const float rs = 1.0f / sqrtf(ssq * (1.f / D) + 1e-6f);
        float lg[8];
#pragma unroll
        for (int i = 0; i < 4; ++i) { lg[i] = acc0[i] * rs + br[4 * q + i]; lg[4 + i] = acc1[i] * rs + br[16 + 4 * q + i]; }
        float tv[4]; int ti[4];
#pragma unroll
        for (int r = 0; r < 4; ++r) {
            float bv = -3.0e38f; int bi = 0;
#pragma unroll
            for (int j = 0; j < 8; ++j) { const int e = (j < 4 ? 0 : 16) + 4 * q + (j & 3); if (lg[j] > bv) { bv = lg[j]; bi = e; } }
#pragma unroll
            for (int o = 16; o <= 32; o <<= 1) { const float ov = __shfl_xor(bv, o); const int oi = __shfl_xor(bi, o); if (ov > bv || (ov == bv && oi < bi)) { bv = ov; bi = oi; } }
            tv[r] = bv; ti[r] = bi;
#pragma unroll
            for (int j = 0; j < 8; ++j) { const int e = (j < 4 ? 0 : 16) + 4 * q + (j & 3); if (e == bi) lg[j] = -3.0e38f; }
        }
        if (q == 0) {
            const float e1 = __expf(tv[1] - tv[0]), e2 = __expf(tv[2] - tv[0]), e3 = __expf(tv[3] - tv[0]); const float inv = 1.0f / (1.0f + e1 + e2 + e3);
            int lr[4];
#pragma unroll
            for (int r = 0; r < 4; ++r) lr[r] = atomicAdd((int*)&hist[ti[r]], 1);
            *(int4*)(eidx + (size_t)tok * 4) = make_int4(ti[0], ti[1], ti[2], ti[3]);
            *(float4*)(gate + (size_t)tok * 4) = make_float4(inv, e1 * inv, e2 * inv, e3 * inv);
            *(int4*)(lrank + (size_t)tok * 4) = make_int4(lr[0], lr[1], lr[2], lr[3]);
            rstd[tok] = rs * amax * (1.0f / 127.0f);
        }
        __syncthreads();
        if (F.tid < 32) __hip_atomic_store(&cnt[tile * 32 + F.tid], hist[F.tid], __ATOMIC_RELAXED, __HIP_MEMORY_SCOPE_AGENT);
        asm volatile("s_waitcnt vmcnt(0)" ::: "memory");
        __syncthreads();
        if (F.tid == 0) (void)xb_add((unsigned*)(ws + WS_CTL) + CW_S2 + 1152, 1u);
        { const float qinv = amax > 0.f ? 127.0f / amax : 0.f; unsigned char* xq = ws + WS_XQ;
#pragma unroll
            for (int i0 = 0; i0 < 16; i0 += 8) { v4u xa[8], xb2[8];
#pragma unroll
                for (int i = 0; i < 8; ++i) { const v4u* p = (const v4u*)(x1 + (size_t)(tile * 128 + F.wave * 16 + i0 + i) * D) + 2 * F.lane; xa[i] = p[0]; xb2[i] = p[1]; }
#pragma unroll
                for (int i = 0; i < 8; ++i) { const float sc = __builtin_bit_cast(float, __builtin_amdgcn_readlane(__builtin_bit_cast(int, qinv), i0 + i));
                    const unsigned u[8] = {xa[i].x, xa[i].y, xa[i].z, xa[i].w, xb2[i].x, xb2[i].y, xb2[i].z, xb2[i].w}; v4u o;
#pragma unroll
                    for (int d = 0; d < 4; ++d) { const f32x2 lo = {bflo(u[2 * d]), bfhi(u[2 * d])}, hi = {bflo(u[2 * d + 1]), bfhi(u[2 * d + 1])};
                        const f32x2 ql = lo * sc + Q_MAGIC, qh = hi * sc + Q_MAGIC; o[d] = q_pack4(ql.x, ql.y, qh.x, qh.y); }
                    *((v4u*)(xq + (size_t)(tile * 128 + F.wave * 16 + i0 + i) * D) + F.lane) = o; } }
        }
        if (tile + F.G < T / 128) { const v4u* xrn = (const v4u*)(x1 + (size_t)((tile + F.G) * 128 + F.wave * 16 + n) * D) + q;
#pragma unroll
            for (int s = 0; s < 32; ++s) xh[s >> 4][s & 15] = xrn[4 * s]; }
        __syncthreads();
    }
}

DI void p7_permute(const Frame& F, CArgs& a) {
    unsigned char* ws = a.ws; int* cnt = (int*)(ws + WS_CNT); int* meta = (int*)(ws + WS_META);
    const int* eidx = (const int*)(ws + WS_EIDX); const int* lrank = (const int*)(ws + WS_LRANK); int* inv = (int*)(ws + WS_INV);
    const float* rstd = (const float*)(ws + WS_RSTD); float* rowrstd = (float*)(ws + WS_ROWRSTD);
    bf16* xb = (bf16*)(ws + WS_XN); int* rowtok = (int*)(ws + WS_ROWTOK);
    LAS int* s_tot = (LAS int*)F.lds; LAS int* s_pst = s_tot + 32; LAS int* s_base = s_tot + 64; LAS int* s_b0 = s_tot + 96; LAS int* s_part = s_tot + 128; LAS int* s_pb = s_tot + 640;
    const int tile0 = F.bid, tok0 = tile0 * 128 + (F.tid >> 2), k0 = F.tid & 3;
    int e0 = 0, lr0 = 0; float rs0 = 0.f;
    if (tile0 < T / 128) { e0 = eidx[tok0 * 4 + k0]; lr0 = lrank[tok0 * 4 + k0]; rs0 = rstd[tok0]; }
    { const int e = F.tid & 31, part = F.tid >> 5; int v[16];
#pragma unroll
      for (int i = 0; i < 16; ++i) v[i] = (int)xb_ld((unsigned*)&cnt[(part * 16 + i) * 32 + e]);
      int s = 0, sb = 0;
#pragma unroll
      for (int i = 0; i < 16; ++i) { s += v[i]; sb += (part * 16 + i < tile0) ? v[i] : 0; }
      s_part[part * 32 + e] = s; s_pb[part * 32 + e] = sb; }
    __syncthreads();
    if (F.tid < 32) { int s = 0, sb = 0;
#pragma unroll
        for (int p = 0; p < 16; ++p) { s += s_part[p * 32 + F.tid]; sb += s_pb[p * 32 + F.tid]; }
        s_tot[F.tid] = s; s_b0[F.tid] = sb;
        const int v = (s + 255) / 256 * 256; int ps = v;
#pragma unroll
        for (int o = 1; o < 32; o <<= 1) { const int t = __shfl_up(ps, o); if (F.tid >= o) ps += t; }
        s_pst[F.tid] = ps - v; }
    __syncthreads();
    if (F.tid < 32) { LAS int* lm = (LAS int*)(F.lds + pg8::SCH_META_OFF); const int e = F.tid, nb = (s_tot[e] + 255) / 256, rb0 = s_pst[e] / 256; for (int i = 0; i < nb; ++i) lm[16 + rb0 + i] = e; if (e == 31) lm[0] = rb0 + nb; }
    if (F.bid == 0 && F.tid < 32) { const int e = F.tid, nb = (s_tot[e] + 255) / 256, rb0 = s_pst[e] / 256; for (int i = 0; i < nb; ++i) meta[16 + rb0 + i] = e; if (e == 31) meta[0] = rb0 + nb; }
    if (F.bid < 32) { const int e = F.bid, r0 = s_pst[e] + s_tot[e], r1 = s_pst[e] + (s_tot[e] + 255) / 256 * 256;
        for (int r = r0 + F.tid; r < r1; r += NWAVES * 64) { rowtok[r] = T; rowrstd[r] = 0.f; } }
    if (F.bid == 0 && F.tid < 64) { const v4u z = {0u, 0u, 0u, 0u}; *((v4u*)(ws + WS_XQ + (size_t)T * D) + F.tid) = z; }
    for (int tile = F.bid; tile < T / 128; tile += F.G) {
        __syncthreads();
        if (F.tid < 32) { int s;
            if (tile == tile0) s = s_b0[F.tid];
            else { s = 0; for (int p = 0; p < (tile >> 4); ++p) s += s_part[p * 32 + F.tid];
                for (int t = tile & ~15; t < tile; ++t) s += (int)xb_ld((unsigned*)&cnt[t * 32 + F.tid]); }
            s_base[F.tid] = s_pst[F.tid] + s; }
        __syncthreads();
        { const int i = F.tid;
            const int tok = tile * 128 + (i >> 2), k = i & 3; int e = e0, lr = lr0; float rs = rs0;
            if (tile != tile0) { e = eidx[tok * 4 + k]; lr = lrank[tok * 4 + k]; rs = rstd[tok]; }
            const int dest = s_base[e] + lr;
            inv[tok * 4 + k] = dest; rowtok[dest] = tok; rowrstd[dest] = rs;
        }
    }
}

DI void p10_combine(const Frame& F, CArgs& a) {
    unsigned char* ws = a.ws; const int* inv = (const int*)(ws + WS_INV); const float* gate = (const float*)(ws + WS_GATE); const unsigned char* yr = (const unsigned char*)(ws + WS_YR); const bf16* xb = (const bf16*)(ws + WS_XN); float* out = a.out;
    const int gw = F.bid * NWAVES + F.wave, NGW = F.G * NWAVES;
    int4 ivn[2]; float4 gvn[2];
#pragma unroll
    for (int u = 0; u < 2; ++u) { const int t = gw + u * NGW; if (t < T) { ivn[u] = *(const int4*)(inv + (size_t)t * 4); gvn[u] = *(const float4*)(gate + (size_t)t * 4); } }
    for (int t0 = gw; t0 < T; t0 += 2 * NGW) {
        int4 iv[2]; float4 gv[2];
#pragma unroll
        for (int u = 0; u < 2; ++u) { iv[u] = ivn[u]; gv[u] = gvn[u]; }
        v2u xw[2][4]; unsigned yw[2][4][4];
#pragma unroll
        for (int u = 0; u < 2; ++u) { const int t = t0 + u * NGW; if (t < T) {
            const int rows[4] = {iv[u].x, iv[u].y, iv[u].z, iv[u].w};
            const v2u* xr = (const v2u*)(xb + (size_t)t * D) + F.lane;
#pragma unroll
            for (int j = 0; j < 4; ++j) { xw[u][j] = xr[64 * j];
#pragma unroll
                for (int k = 0; k < 4; ++k) yw[u][k][j] = __builtin_nontemporal_load((const unsigned*)(yr + (size_t)rows[k] * D) + F.lane + 64 * j); } } }
#pragma unroll
        for (int u = 0; u < 2; ++u) { const int t = t0 + 2 * NGW + u * NGW; if (t < T) { ivn[u] = *(const int4*)(inv + (size_t)t * 4); gvn[u] = *(const float4*)(gate + (size_t)t * 4); } }
#pragma unroll
        for (int u = 0; u < 2; ++u) { const int t = t0 + u * NGW; if (t < T) {
            const float gs[4] = {gv[u].x, gv[u].y, gv[u].z, gv[u].w};
            f32x4* o = (f32x4*)(out + (size_t)t * D) + F.lane;
#pragma unroll
            for (int j = 0; j < 4; ++j) { f32x4 acc = {bflo(xw[u][j].x), bfhi(xw[u][j].x), bflo(xw[u][j].y), bfhi(xw[u][j].y)};
#pragma unroll
                for (int k = 0; k < 4; ++k) { const int w = (int)yw[u][k][j];
                    const auto lo = __builtin_amdgcn_cvt_pk_f32_fp8(w, false), hi = __builtin_amdgcn_cvt_pk_f32_fp8(w, true);
                    acc.x += gs[k] * lo[0]; acc.y += gs[k] * lo[1]; acc.z += gs[k] * hi[0]; acc.w += gs[k] * hi[1]; }
                __builtin_nontemporal_store(acc, o + 64 * j); } } }
    }
}

constexpr int N_PHASES = 11;
__global__ void __launch_bounds__(NWAVES * 64, 2) fwd(Args args_by_value) {
    extern __shared__ __attribute__((aligned(16))) unsigned char lds[];
    Frame F;
    F.lds = (LAS unsigned char*)lds;
    F.tid = threadIdx.x; F.lane = F.tid & 63; F.wave = __builtin_amdgcn_readfirstlane(F.tid >> 6);
    F.G = gridDim.x; F.bid = blockIdx.x;
    volatile LAS unsigned* MISC = (volatile LAS unsigned*)(F.lds + MISC_OFF);
    if (F.tid < 64) MISC[F.tid] = 0u;
    __syncthreads();
    CArgs* const kap_ = (CArgs*)__builtin_amdgcn_kernarg_segment_ptr();
#define args (*({ CArgs* p_ = kap_; asm volatile("" : "+s"(p_)); p_; }))
    unsigned char* ws = args.ws;
    unsigned* ctl = (unsigned*)(ws + WS_CTL);
    XcdBarrier bar; bar.bar = ctl + CW_BAR; bar.x = 0; bar.st = nullptr;
    if (MK_N_LAUNCHES == 1) bar = xcd_barrier_post(ctl + CW_BAR, MISC + 8);
    const int lo = args.ph_lo, hi = args.ph_hi;
#ifndef PHASE_MASK
#define PHASE_MASK 0xffff
#endif
#define IN(k) (((PHASE_MASK >> (k)) & 1) && lo <= (k) && (k) < hi)
#ifndef DUP_PHASE
#define DUP_PHASE -1
#endif
#define REPS(k) ((DUP_PHASE >= 0 && (k) == DUP_PHASE) ? args.ph_rep : 1)
#define SEAM(k) do { if (IN(k) && IN((k) + 1)) xcd_barrier(bar); { int t_ = threadIdx.x; asm volatile("" : "+v"(t_)); F.tid = t_; F.lane = t_ & 63; } } while (0)

    for (int rep_ = 0; rep_ < REPS(0); ++rep_) { if (rep_) xcd_barrier(bar);
    if (IN(0)) { p0_prologue(F, args); } } SEAM(0);

    for (int rep_ = 0; rep_ < REPS(1); ++rep_) { if (rep_) xcd_barrier(bar);
    if (IN(1)) {
        pg8::Gemm g{(const bf16*)(ws + WS_XN), (const bf16*)(ws + WS_WIN), T, INC, D / 2}; pg8::StaticOrder S; S.init(T, INC, F.G, F.bid);
        pg8::EpiBf16Q E{(bf16*)(ws + WS_PROJ), INC, (const float*)(ws + WS_XNSC), (const float*)(ws + WS_COLSC1)};
        pg8::gemm_phase<pg8::EpiBf16Q, pg8::StaticOrder, true, true>(F.lds, g, S, E);
    } } SEAM(1);

    for (int rep_ = 0; rep_ < REPS(2); ++rep_) { if (rep_) xcd_barrier(bar);
    if (IN(2)) {
#ifdef PH_TIME2
        const long long pt2_ = clock64();
#endif
#if NAIVE_RWKV
        rwkv_naive_prep(F, args);
#else
        rwkv_phase_a(F, args);
#endif
#ifdef PH_TIME2
        { const long long d_ = clock64() - pt2_, s0_ = clock64(); while (clock64() - s0_ < d_) __builtin_amdgcn_s_sleep(8); }
#endif
    } }
    do { if (IN(2) && IN(3)) seam_arrive(bar, ctl + CW_S2, F.bid < RBK_BLOCKS); { int t_ = threadIdx.x; asm volatile("" : "+v"(t_)); F.tid = t_; F.lane = t_ & 63; } } while (0);

    for (int rep_ = 0; rep_ < REPS(3); ++rep_) { if (rep_) xcd_barrier(bar);
    if (IN(3)) {
#ifdef PH_TIME3
        const long long pt3_ = clock64();
#endif
#if NAIVE_RWKV
        rwkv_naive_scan(F, args);
#else
        rwkv_phase_b(F, args);
        if (F.bid < RBK_BLOCKS) seam_signal(ctl + CW_S2 + 1088);
#endif
        __syncthreads();
#if NAIVE_ATT
        attn_naive(F, args);
#else
        attn_phase(F, args, rep_);
#endif
#ifdef PH_TIME3
        { const long long d_ = clock64() - pt3_, s0_ = clock64(); while (clock64() - s0_ < d_) __builtin_amdgcn_s_sleep(8); }
#endif
    } }
    int pc_ticket = -1;
    if (IN(3) && IN(4) && F.tid == 0) MISC[10] = xb_add(ctl + CW_S2 + 1280, 1u);
    do { if (IN(3) && IN(4)) { seam_wait(bar, ctl + CW_S2 + 1088, RBK_BLOCKS); pc_ticket = (int)MISC[10]; } { int t_ = threadIdx.x; asm volatile("" : "+v"(t_)); F.tid = t_; F.lane = t_ & 63; } } while (0);

    for (int rep_ = 0; rep_ < REPS(4); ++rep_) { if (rep_) xcd_barrier(bar);
    if (IN(4)) {
#if !NAIVE_RWKV
        rwkv_phase_c(F, args, REPS(4) == 1 ? pc_ticket : -1);
#endif
    } } SEAM(4);

    for (int rep_ = 0; rep_ < REPS(5); ++rep_) { if (rep_) xcd_barrier(bar);
    if (IN(5)) {
        pg8::Gemm g{(const bf16*)(ws + WS_MIX), (const bf16*)(ws + WS_WOUT), T, D, D}; pg8::StaticOrder S; S.init(T, D, F.G, F.bid); S.smax = 1;
        pg8::EpiResid E{args.in[I_X], nullptr, (bf16*)(ws + WS_XN), D};
        pg8::gemm_phase<pg8::EpiResid, pg8::StaticOrder, true, true>(F.lds, g, S, E);
    } } SEAM(5);

    for (int rep_ = 0; rep_ < REPS(6); ++rep_) { if (rep_) xcd_barrier(bar);
    if (IN(6)) { p6_router(F, args); } }
    do { if (IN(6) && IN(7)) seam_wait(bar, ctl + CW_S2 + 1152, (unsigned)(T / 128), true); { int t_ = threadIdx.x; asm volatile("" : "+v"(t_)); F.tid = t_; F.lane = t_ & 63; } } while (0);
    for (int rep_ = 0; rep_ < REPS(7); ++rep_) { if (rep_) xcd_barrier(bar);
    if (IN(7)) { p7_permute(F, args); } } SEAM(7);

    for (int rep_ = 0; rep_ < REPS(8); ++rep_) { if (rep_) xcd_barrier(bar);
    if (IN(8)) {
        pg8::Gemm g{(const bf16*)(ws + WS_XQ), (const bf16*)(ws + WS_WUP), NROWS_MAX, 2048, D / 2};
        pg8::MoeOrder<true> S{(const int*)(ws + WS_META), 8, F.G, F.bid, (const int*)(ws + WS_ROWTOK)}; S.reuse = IN(7);
        pg8::EpiSwiGLU E{(bf16*)(ws + WS_ACT), args.in[I_BUP], (const float*)(ws + WS_ROWRSTD), (const float*)(ws + WS_COLSC)};
        pg8::gemm_phase<pg8::EpiSwiGLU, pg8::MoeOrder<true>, true, true>(F.lds, g, S, E);
    } } SEAM(8);

    for (int rep_ = 0; rep_ < REPS(9); ++rep_) { if (rep_) xcd_barrier(bar);
    if (IN(9)) {
        pg8::Gemm g{(const bf16*)(ws + WS_ACT), (const bf16*)(ws + WS_WDN), NROWS_MAX, 1024, D / 2};
        pg8::MoeOrder<false> S{(const int*)(ws + WS_META), 4, F.G, F.bid, nullptr}; S.reuse = IN(8);
        pg8::EpiDown E{(bf16*)(ws + WS_YR), args.in[I_BDN], (const float*)(ws + WS_COLSC2)};
        pg8::gemm_phase<pg8::EpiDown, pg8::MoeOrder<false>, true, true>(F.lds, g, S, E);
    } } SEAM(9);

    for (int rep_ = 0; rep_ < REPS(10); ++rep_) { if (rep_) xcd_barrier(bar);
    if (IN(10)) { p10_combine(F, args); } }
#undef IN
#undef SEAM
#undef args
}

extern "C" void kernel_launch(void* const* d_in, const int* in_sizes, int n_in, void* d_out, int out_size, void* d_ws, size_t ws_size, hipStream_t stream) {
    static int grid = 0;
    if (grid == 0) {
        if (n_in != 25 || out_size != T * D || ws_size < WS_END) { fprintf(stderr, "kernel_launch: unexpected shapes (n_in %d out %d ws %zu)\n", n_in, out_size, ws_size); grid = -1; return; }
        int dev = 0, cus = 0, per_cu = 0;
        if (hipGetDevice(&dev) != hipSuccess || hipDeviceGetAttribute(&cus, hipDeviceAttributeMultiprocessorCount, dev) != hipSuccess) { grid = -1; return; }
        if (hipFuncSetAttribute((const void*)fwd, hipFuncAttributeMaxDynamicSharedMemorySize, LDS_BYTES) != hipSuccess) { fprintf(stderr, "kernel_launch: hipFuncSetAttribute failed\n"); grid = -1; return; }
        if (hipOccupancyMaxActiveBlocksPerMultiprocessor(&per_cu, (const void*)fwd, NWAVES * 64, LDS_BYTES) != hipSuccess || per_cu < 1) { fprintf(stderr, "kernel_launch: occupancy query says %d\n", per_cu); }
        (void)hipGetLastError();
        grid = cus;
    }
    if (grid < 0) return;
    (void)hipMemsetAsync((char*)d_ws + WS_CTL, 0, CTL_ZERO_BYTES, stream);
    Args a{};
    for (int i = 0; i < 25; ++i) a.in[i] = (const float*)d_in[i];
    a.out = (float*)d_out; a.ws = (unsigned char*)d_ws;
#if MK_N_LAUNCHES == 1
    a.ph_lo = 0; a.ph_hi = N_PHASES; a.ph_rep = 2;
    hipLaunchKernelGGL(fwd, dim3(grid), dim3(NWAVES * 64), LDS_BYTES, stream, a);
#else
    for (int p = 0; p < N_PHASES; ++p) { a.ph_lo = p; a.ph_hi = p + 1; hipLaunchKernelGGL(fwd, dim3(grid), dim3(NWAVES * 64), LDS_BYTES, stream, a); }
#endif
}
```
